# Optimizing an MI355X kernel written in HIP

```python
import jax, jax.numpy as jnp
from jax import lax
import numpy as np

D_MODEL = 2048
BATCH = 4
SEQ = 4096
DEPTH = 2

CHUNK = 64
N_MEM = 256
CONV_W = 768
CONV_TAPS = 3
HG_HEADS = 6
HG_DK = 128
HG_W = HG_HEADS * HG_DK
XA_HEADS = 4
XA_DH = 128
XA_W = XA_HEADS * XA_DH
IN_SPLITS = (CONV_W, CONV_W, CONV_W, HG_W, HG_W, HG_W, HG_W, XA_W, D_MODEL, D_MODEL, D_MODEL)
IN_COLS = sum(IN_SPLITS)
N_EXPERTS = 64
TOP_K = 8
N_GROUPS = 8
TOPK_GROUPS = 4
EXPERT_HID = 512
SHARED_HID = 512
ROUTED_SCALE = 2.5
EXPERT_BLOCK = 128
DN_ALPHA = (2 * DEPTH) ** 0.25
DN_BETA = (8 * DEPTH) ** -0.25
LN_EPS = 1e-5
RMS_EPS = 1e-6

kernel_name = 'hybrid_conv_hgrn2_memattn_moe_deepnorm'


def _layer_norm(x, g, b):
    x32 = x.astype(jnp.float32)
    mu = jnp.mean(x32, axis=-1, keepdims=True)
    xc = x32 - mu
    var = jnp.mean(xc * xc, axis=-1, keepdims=True)
    y = xc * lax.rsqrt(var + LN_EPS) * g.astype(jnp.float32) + b.astype(jnp.float32)
    return y.astype(x.dtype)


def _causal_dwconv(u, w):
    return lax.conv_general_dilated(
        u, w[:, None, :].astype(u.dtype), window_strides=(1,),
        padding=[(CONV_TAPS - 1, 0)], dimension_numbers=('NWC', 'WIO', 'NWC'),
        feature_group_count=u.shape[-1])


def _hgrn2_chunkwise(q, f_logit, v, lb):
    bsz, seq, _ = q.shape
    n_chunks = seq // CHUNK
    f32 = jnp.float32
    lb = lb.astype(f32)
    log_f = jnp.logaddexp(jnp.log(lb), jnp.log1p(-lb) + jax.nn.log_sigmoid(f_logit.astype(f32)))
    k = -jnp.expm1(log_f)

    def to_chunks(t):
        return t.astype(f32).reshape(bsz, n_chunks, CHUNK, HG_HEADS, HG_DK).transpose(1, 0, 3, 2, 4)

    tri = jnp.tril(jnp.ones((CHUNK, CHUNK), dtype=bool))[:, :, None]

    def step(state, inp):
        qb, kb, ab, vb = inp
        b = jnp.cumsum(ab, axis=2)
        b_last = b[:, :, -1:, :]
        o_inter = jnp.einsum('bhtk,bhkv->bhtv', qb * jnp.exp(b), state)
        diff = b[:, :, :, None, :] - b[:, :, None, :, :]
        decay = jnp.where(tri, jnp.exp(jnp.where(tri, diff, 0.0)), 0.0)
        scores = jnp.einsum('bhtk,bhsk,bhtsk->bhts', qb, kb, decay)
        o = o_inter + jnp.einsum('bhts,bhsv->bhtv', scores, vb)
        state = (jnp.exp(b_last[:, :, 0, :])[..., None] * state
                 + jnp.einsum('bhsk,bhsv->bhkv', kb * jnp.exp(b_last - b), vb))
        return state, o

    state0 = jnp.zeros((bsz, HG_HEADS, HG_DK, HG_DK), f32)
    _, o = lax.scan(step, state0, (to_chunks(q), to_chunks(k), to_chunks(log_f), to_chunks(v)))
    return o.transpose(1, 0, 3, 2, 4).reshape(bsz, seq, HG_HEADS, HG_DK)


def _gated_head_rmsnorm(o, g, gain):
    bsz, seq = o.shape[:2]
    o = o * lax.rsqrt(jnp.mean(o * o, axis=-1, keepdims=True) + RMS_EPS)
    o = o.reshape(bsz, seq, HG_W) * gain.astype(jnp.float32)
    return (o * jax.nn.silu(g.astype(jnp.float32))).astype(g.dtype)


def _memory_attention(q, mem, wk, wv):
    bsz, seq, _ = q.shape
    n_mem = mem.shape[1]
    kh = (mem @ wk).reshape(bsz, n_mem, XA_HEADS, XA_DH)
    vh = (mem @ wv).reshape(bsz, n_mem, XA_HEADS, XA_DH)
    qh = q.reshape(bsz, seq, XA_HEADS, XA_DH)
    s = jnp.einsum('bshd,bmhd->bhsm', qh, kh).astype(jnp.float32) * (XA_DH ** -0.5)
    p = jax.nn.softmax(s, axis=-1).astype(q.dtype)
    return jnp.einsum('bhsm,bmhd->bshd', p, vh).reshape(bsz, seq, XA_W)


def _swiglu(h, wg, wu, wd):
    return (jax.nn.silu(h @ wg) * (h @ wu)) @ wd


def _routed_experts(h, eidx, gate, wg, wu, wd):
    n, d = h.shape
    m = n * TOP_K
    flat_e = eidx.reshape(-1)
    flat_t = jnp.broadcast_to(jnp.arange(n, dtype=jnp.int32)[:, None], (n, TOP_K)).reshape(-1)
    flat_w = gate.reshape(-1)
    order = jnp.argsort(flat_e)
    se, st, sw = flat_e[order], flat_t[order], flat_w[order]
    counts = jnp.bincount(flat_e, length=N_EXPERTS)
    padded = ((counts + EXPERT_BLOCK - 1) // EXPERT_BLOCK) * EXPERT_BLOCK
    pad_end = jnp.cumsum(padded)
    pad_start = pad_end - padded
    start = jnp.cumsum(counts) - counts
    dest = pad_start[se] + (jnp.arange(m, dtype=jnp.int32) - start[se])
    n_blocks = (m + N_EXPERTS * (EXPERT_BLOCK - 1) + EXPERT_BLOCK - 1) // EXPERT_BLOCK
    rows = n_blocks * EXPERT_BLOCK
    row_tok = jnp.full((rows,), n, dtype=jnp.int32).at[dest].set(st)
    row_w = jnp.zeros((rows,), h.dtype).at[dest].set(sw.astype(h.dtype))
    blk_start = jnp.arange(n_blocks, dtype=jnp.int32) * EXPERT_BLOCK
    blk_exp = jnp.minimum(jnp.searchsorted(pad_end, blk_start, side='right'), N_EXPERTS - 1)
    hpad = jnp.concatenate([h, jnp.zeros((1, d), h.dtype)], axis=0)

    def step(out, inp):
        e, tok, wt = inp
        xb = hpad[tok]
        y = _swiglu(xb, wg[e], wu[e], wd[e])
        return out.at[tok].add(y * wt[:, None]), None

    out, _ = lax.scan(step, jnp.zeros((n + 1, d), h.dtype),
                      (blk_exp, row_tok.reshape(n_blocks, EXPERT_BLOCK), row_w.reshape(n_blocks, EXPERT_BLOCK)))
    return out[:n]


def _moe_ffn(h, router_w, router_b, wg, wu, wd, sg, su, sd):
    n = h.shape[0]
    s = jax.nn.sigmoid((h @ router_w).astype(jnp.float32))
    sel = s + router_b.astype(jnp.float32)
    grp = sel.reshape(n, N_GROUPS, N_EXPERTS // N_GROUPS)
    grp_score = lax.top_k(grp, 2)[0].sum(-1)
    _, gidx = lax.top_k(grp_score, TOPK_GROUPS)
    gmask = jax.nn.one_hot(gidx, N_GROUPS, dtype=jnp.float32).sum(1) > 0
    emask = jnp.repeat(gmask, N_EXPERTS // N_GROUPS, axis=1)
    _, eidx = lax.top_k(jnp.where(emask, sel, -jnp.inf), TOP_K)
    w = jnp.take_along_axis(s, eidx, axis=-1)
    w = (w / jnp.sum(w, axis=-1, keepdims=True) * ROUTED_SCALE).astype(h.dtype)
    return _swiglu(h, sg, su, sd) + _routed_experts(h, eidx, w, wg, wu, wd)


def setup_inputs(seed: int = 0) -> dict:
    key = jax.random.key(seed)
    ks = jax.random.split(key, 32)

    def nrm(k, shape, scale):
        return jax.random.normal(k, shape, jnp.float32) * scale

    L, D = DEPTH, D_MODEL
    return {
        'x': nrm(ks[0], (BATCH, SEQ, D), 1.0),
        'mem': nrm(ks[1], (BATCH, N_MEM, D), 1.0),
        'w_in': nrm(ks[2], (L, D, IN_COLS), D ** -0.5),
        'conv_w': nrm(ks[3], (L, CONV_TAPS, CONV_W), CONV_TAPS ** -0.5),
        'w_conv_out': nrm(ks[4], (L, CONV_W, D), CONV_W ** -0.5 * DN_BETA),
        'hg_lb_logits': nrm(ks[5], (L, HG_W), 0.5),
        'hg_norm_g': 1.0 + nrm(ks[6], (L, HG_W), 0.02),
        'w_hg_out': nrm(ks[7], (L, HG_W, D), HG_W ** -0.5 * DN_BETA),
        'w_mem_k': nrm(ks[8], (L, D, XA_W), D ** -0.5),
        'w_mem_v': nrm(ks[9], (L, D, XA_W), D ** -0.5 * DN_BETA),
        'w_xa_out': nrm(ks[10], (L, XA_W, D), XA_W ** -0.5 * DN_BETA),
        'w_o': nrm(ks[11], (L, D, D), D ** -0.5 * DN_BETA),
        'ln1_g': 1.0 + nrm(ks[12], (L, D), 0.02),
        'ln1_b': nrm(ks[13], (L, D), 0.02),
        'router_w': nrm(ks[14], (L, D, N_EXPERTS), D ** -0.5),
        'router_b': nrm(ks[15], (L, N_EXPERTS), 0.01),
        'exp_wg': nrm(ks[16], (L, N_EXPERTS, D, EXPERT_HID), D ** -0.5),
        'exp_wu': nrm(ks[17], (L, N_EXPERTS, D, EXPERT_HID), D ** -0.5),
        'exp_wd': nrm(ks[18], (L, N_EXPERTS, EXPERT_HID, D), EXPERT_HID ** -0.5 * DN_BETA),
        'sh_wg': nrm(ks[19], (L, D, SHARED_HID), D ** -0.5),
        'sh_wu': nrm(ks[20], (L, D, SHARED_HID), D ** -0.5),
        'sh_wd': nrm(ks[21], (L, SHARED_HID, D), SHARED_HID ** -0.5 * DN_BETA),
        'ln2_g': 1.0 + nrm(ks[22], (L, D), 0.02),
        'ln2_b': nrm(ks[23], (L, D), 0.02),
    }


def reference(x, mem, w_in, conv_w, w_conv_out, hg_lb_logits, hg_norm_g, w_hg_out, w_mem_k, w_mem_v,
              w_xa_out, w_o, ln1_g, ln1_b, router_w, router_b, exp_wg, exp_wu, exp_wd,
              sh_wg, sh_wu, sh_wd, ln2_g, ln2_b):
    bsz, seq, d = x.shape
    lb_all = jnp.cumsum(jax.nn.softmax(hg_lb_logits.astype(jnp.float32), axis=0), axis=0)
    lb_all = lb_all - lb_all[0:1]
    split_pts = [int(p) for p in np.cumsum(np.array(IN_SPLITS))[:-1]]
    for l in range(DEPTH):
        proj = x @ w_in[l]
        (u_c, b_c, c_c, q_h, f_h, i_h, g_h, q_x, g_a, g_b, g_x) = jnp.split(proj, split_pts, axis=-1)
        y_a = b_c * _causal_dwconv(c_c * u_c, conv_w[l])
        o_h = _hgrn2_chunkwise(q_h, f_h, i_h, lb_all[l])
        y_b = _gated_head_rmsnorm(o_h, g_h, hg_norm_g[l])
        y_x = _memory_attention(q_x, mem, w_mem_k[l], w_mem_v[l])
        merged = (jax.nn.sigmoid(g_a) * (y_a @ w_conv_out[l])
                  + jax.nn.sigmoid(g_b) * (y_b @ w_hg_out[l])
                  + jax.nn.sigmoid(g_x) * (y_x @ w_xa_out[l]))
        x = _layer_norm(DN_ALPHA * x + merged @ w_o[l], ln1_g[l], ln1_b[l])
        h = x.reshape(bsz * seq, d)
        f2 = _moe_ffn(h, router_w[l], router_b[l], exp_wg[l], exp_wu[l], exp_wd[l],
                      sh_wg[l], sh_wu[l], sh_wd[l]).reshape(bsz, seq, d)
        x = _layer_norm(DN_ALPHA * x + f2, ln2_g[l], ln2_b[l])
    return x
```

```cpp
#include <hip/hip_runtime.h>
#include <stdint.h>
#include <stdio.h>

typedef unsigned short bf16;
__device__ __forceinline__ float bf2f(bf16 v) { return __uint_as_float(((unsigned)v) << 16); }
__device__ __forceinline__ bf16 f2bf(float f) { unsigned u = __float_as_uint(f); return (bf16)((u + 0x7fffu + ((u >> 16) & 1u)) >> 16); }

constexpr int NB = 4, SEQ = 4096, NTOK = NB * SEQ, D = 2048, NMEM = 256;
constexpr int CW = 768, HGW = 768, HGH = 6, HGD = 128, XAW = 512, XAH = 4, XAD = 128;
constexpr int INC = 12032;
constexpr int C_U = 0, C_B = 768, C_C = 1536, C_Q = 2304, C_F = 3072, C_I = 3840, C_G = 4608, C_QX = 5376, C_GA = 5888, C_GB = 7936, C_GX = 9984;
constexpr int NE = 64, TOPK = 8, EH = 512;
constexpr float ALPHA = 1.41421356237f, LN_EPS = 1e-5f, RMS_EPS = 1e-6f, RSCALE = 2.5f;
constexpr int LISTCAP = 16384;

constexpr size_t MiB = 1u << 20;
constexpr size_t WS_CTL = 0, CTL_BYTES = 1 * MiB;
constexpr size_t WS_MEMBF = 136 * MiB, WS_KV = 140 * MiB;
constexpr size_t WS_XBF = 534 * MiB, WS_X1F = 598 * MiB, WS_X1BF = 726 * MiB, WS_ZF = 790 * MiB, WS_MERGED = 918 * MiB;
constexpr size_t WS_YA = 982 * MiB, WS_YB = 1006 * MiB, WS_YX = 1030 * MiB;
constexpr size_t WS_R2 = 1046 * MiB;
constexpr size_t WS_R1 = 1214 * MiB;
constexpr size_t WS_LIST = 1854 * MiB, WS_TOKSLOT = 1858 * MiB, WS_TOKW = 1859 * MiB, WS_END = 1860 * MiB;
constexpr int CW_CNT = 1024;
constexpr int CW_PLAN = 2048;

template <bool DUAL, class Epi>
__device__ __forceinline__ void gemm_tile_ref(const bf16* A, int lda, const int* rowidx, int M, int m0,
                                              const float* W, const float* W2, int ldw, int n0, int K, const Epi& E) {
    __shared__ float sA[8][128 + 4];
    __shared__ float sB[8][128 + 4];
    __shared__ float sB2[DUAL ? 8 : 1][128 + 4];
    const int tid = threadIdx.x, tx = tid & 15, ty = tid >> 4;
    float acc[8][8], acc2[DUAL ? 8 : 1][8];
#pragma unroll
    for (int i = 0; i < 8; ++i)
#pragma unroll
        for (int j = 0; j < 8; ++j) { acc[i][j] = 0.f; if (DUAL) acc2[i][j] = 0.f; }
    for (int k0 = 0; k0 < K; k0 += 8) {
#pragma unroll
        for (int r = 0; r < 4; ++r) {
            const int i = tid + r * 256, m = i >> 3, k = i & 7, gm = m0 + m;
            float v = 0.f;
            if (gm < M) { const int row = rowidx ? rowidx[gm] : gm; v = bf2f(A[(size_t)row * lda + k0 + k]); }
            sA[k][m] = v;
        }
#pragma unroll
        for (int r = 0; r < 4; ++r) {
            const int i = tid + r * 256, k = i >> 7, n = i & 127;
            sB[k][n] = W[(size_t)(k0 + k) * ldw + n0 + n];
            if (DUAL) sB2[k][n] = W2[(size_t)(k0 + k) * ldw + n0 + n];
        }
        __syncthreads();
#pragma unroll
        for (int k = 0; k < 8; ++k) {
            float a[8], b[8], b2[8];
#pragma unroll
            for (int i = 0; i < 8; ++i) a[i] = sA[k][ty * 8 + i];
#pragma unroll
            for (int j = 0; j < 8; ++j) { b[j] = sB[k][tx * 8 + j]; if (DUAL) b2[j] = sB2[k][tx * 8 + j]; }
#pragma unroll
            for (int i = 0; i < 8; ++i)
#pragma unroll
                for (int j = 0; j < 8; ++j) { acc[i][j] += a[i] * b[j]; if (DUAL) acc2[i][j] += a[i] * b2[j]; }
        }
        __syncthreads();
    }
#pragma unroll
    for (int i = 0; i < 8; ++i) {
        const int gm = m0 + ty * 8 + i;
        if (gm < M) {
#pragma unroll
            for (int j = 0; j < 8; ++j) E(gm, n0 + tx * 8 + j, acc[i][j], DUAL ? acc2[i][j] : 0.f);
        }
    }
}

struct EpiStoreBf16 { bf16* out; int ldo; int coff;
    __device__ __forceinline__ void operator()(int m, int n, float a, float) const { out[(size_t)m * ldo + coff + n] = f2bf(a); } };
struct EpiGate { const bf16* proj; float* part; bf16* merged; int gcol; int mode;
    __device__ __forceinline__ void operator()(int m, int n, float a, float) const {
        const float g = bf2f(proj[(size_t)m * INC + gcol + n]); const float v = a / (1.f + __expf(-g));
        const size_t o = (size_t)m * D + n;
        if (mode == 0) part[o] = v; else if (mode == 1) part[o] += v; else merged[o] = f2bf(part[o] + v); } };
struct EpiResid { const float* xres; float* z;
    __device__ __forceinline__ void operator()(int m, int n, float a, float) const { const size_t o = (size_t)m * D + n; z[o] = ALPHA * xres[o] + a; } };
struct EpiSwiglu { bf16* h; int rowbase;
    __device__ __forceinline__ void operator()(int m, int n, float g, float u) const { h[(size_t)(rowbase + m) * EH + n] = f2bf(g / (1.f + __expf(-g)) * u); } };
struct EpiY { bf16* y; int rowbase;
    __device__ __forceinline__ void operator()(int m, int n, float a, float) const { y[(size_t)(rowbase + m) * D + n] = f2bf(a); } };

template <class Epi>
__global__ __launch_bounds__(256) void k_gemm_ref(const bf16* A, int lda, const float* W, int ldw, int M, int N, int K, Epi E) {
    gemm_tile_ref<false, Epi>(A, lda, nullptr, M, blockIdx.y * 128, W, nullptr, ldw, blockIdx.x * 128, K, E);
}
__global__ __launch_bounds__(256) void k_moe_gu_ref(const bf16* X1BF, const float* wg, const float* wu, const float* sg, const float* su,
                                                    const unsigned* cnt, const unsigned* plan, const int* list, bf16* H) {
    const int e = blockIdx.z; const int M = e < NE ? (int)cnt[e] : NTOK; const int m0 = blockIdx.y * 128;
    if (m0 >= M) return;
    const float* W = e < NE ? wg + (size_t)e * D * EH : sg; const float* W2 = e < NE ? wu + (size_t)e * D * EH : su;
    EpiSwiglu E{H, (int)plan[e] * 256};
    gemm_tile_ref<true, EpiSwiglu>(X1BF, D, e < NE ? list + (size_t)e * LISTCAP : nullptr, M, m0, W, W2, EH, blockIdx.x * 128, D, E);
}
__global__ __launch_bounds__(256) void k_moe_down_ref(const bf16* H, const float* wd, const float* sd, const unsigned* cnt, const unsigned* plan, bf16* Y) {
    const int e = blockIdx.z; const int M = e < NE ? (int)cnt[e] : NTOK; const int m0 = blockIdx.y * 128;
    if (m0 >= M) return;
    const float* W = e < NE ? wd + (size_t)e * EH * D : sd;
    const int rb = (int)plan[e] * 256;
    EpiY E{Y, rb};
    gemm_tile_ref<false, EpiY>(H + (size_t)rb * EH, EH, nullptr, M, m0, W, nullptr, D, blockIdx.x * 128, EH, E);
}

__global__ void k_cvt(const float* in, bf16* out, size_t n) {
    for (size_t i = (size_t)blockIdx.x * blockDim.x + threadIdx.x; i < n; i += (size_t)gridDim.x * blockDim.x) out[i] = f2bf(in[i]);
}
__global__ void k_conv_ref(const bf16* proj, const float* cw, bf16* YA) {
    for (size_t i = (size_t)blockIdx.x * blockDim.x + threadIdx.x; i < (size_t)NTOK * CW; i += (size_t)gridDim.x * blockDim.x) {
        const int t = (int)(i / CW), c = (int)(i % CW), pos = t % SEQ;
        const bf16* r = proj + (size_t)t * INC;
        float s = cw[2 * CW + c] * bf2f(r[C_C + c]) * bf2f(r[C_U + c]);
        if (pos >= 1) s += cw[1 * CW + c] * bf2f(r[C_C + c - INC]) * bf2f(r[C_U + c - INC]);
        if (pos >= 2) s += cw[0 * CW + c] * bf2f(r[C_C + c - 2 * INC]) * bf2f(r[C_U + c - 2 * INC]);
        YA[i] = f2bf(bf2f(r[C_B + c]) * s);
    }
}
__global__ __launch_bounds__(128) void k_hgrn_ref(const bf16* proj, const float* lbl, int layer, float* O) {
    __shared__ float sQ[2][128], sF[2][128], sK[2][128];
    const int b = blockIdx.x / HGH, h = blockIdx.x % HGH, v = threadIdx.x, c = h * HGD + v;
    float lb = 0.f;
    if (layer == 1) lb = 1.f / (1.f + __expf(lbl[c] - lbl[HGW + c]));
    float S[128];
#pragma unroll
    for (int k = 0; k < 128; ++k) S[k] = 0.f;
    for (int t = 0; t < SEQ; ++t) {
        const bf16* r = proj + (size_t)(b * SEQ + t) * INC;
        const int p = t & 1;
        const float z = bf2f(r[C_F + c]);
        const float sg = 1.f / (1.f + __expf(-z));
        sF[p][v] = lb + (1.f - lb) * sg;
        sK[p][v] = (1.f - lb) / (1.f + __expf(z));
        sQ[p][v] = bf2f(r[C_Q + c]);
        const float iv = bf2f(r[C_I + c]);
        __syncthreads();
        float o = 0.f;
#pragma unroll
        for (int k = 0; k < 128; ++k) { S[k] = sF[p][k] * S[k] + sK[p][k] * iv; o += S[k] * sQ[p][k]; }
        O[(size_t)(b * SEQ + t) * HGW + c] = o;
    }
}
__global__ void k_hgrn_norm_ref(const float* O, const bf16* proj, const float* gain, bf16* YB) {
    const int w = (blockIdx.x * blockDim.x + threadIdx.x) >> 6, lane = threadIdx.x & 63;
    if (w >= NTOK * HGH) return;
    const int t = w / HGH, h = w % HGH;
    const float a = O[(size_t)t * HGW + h * HGD + lane], b = O[(size_t)t * HGW + h * HGD + 64 + lane];
    float s = a * a + b * b;
#pragma unroll
    for (int o = 1; o < 64; o <<= 1) s += __shfl_xor(s, o);
    const float r = rsqrtf(s * (1.f / 128.f) + RMS_EPS);
    const int c0 = h * HGD + lane, c1 = c0 + 64;
    const float g0 = bf2f(proj[(size_t)t * INC + C_G + c0]), g1 = bf2f(proj[(size_t)t * INC + C_G + c1]);
    YB[(size_t)t * HGW + c0] = f2bf(a * r * gain[c0] * g0 / (1.f + __expf(-g0)));
    YB[(size_t)t * HGW + c1] = f2bf(b * r * gain[c1] * g1 / (1.f + __expf(-g1)));
}
__global__ __launch_bounds__(256) void k_memattn_ref(const bf16* proj, const bf16* KV, int layer, bf16* YX) {
    __shared__ float sq[4][128], sp[4][256];
    const int t = blockIdx.x, h = threadIdx.x >> 6, lane = threadIdx.x & 63, b = t / SEQ;
    sq[h][lane] = bf2f(proj[(size_t)t * INC + C_QX + h * 128 + lane]);
    sq[h][lane + 64] = bf2f(proj[(size_t)t * INC + C_QX + h * 128 + 64 + lane]);
    __syncthreads();
    float sc[4], mx = -1e30f;
#pragma unroll
    for (int j = 0; j < 4; ++j) {
        const int m = lane + 64 * j; const bf16* kr = KV + (size_t)(b * NMEM + m) * 2048 + layer * 1024 + h * 128;
        float s = 0.f;
        for (int d = 0; d < 128; ++d) s += sq[h][d] * bf2f(kr[d]);
        sc[j] = s * 0.08838834764831845f; mx = fmaxf(mx, sc[j]);
    }
#pragma unroll
    for (int o = 1; o < 64; o <<= 1) mx = fmaxf(mx, __shfl_xor(mx, o));
    float sum = 0.f;
#pragma unroll
    for (int j = 0; j < 4; ++j) { sc[j] = __expf(sc[j] - mx); sum += sc[j]; }
#pragma unroll
    for (int o = 1; o < 64; o <<= 1) sum += __shfl_xor(sum, o);
    const float inv = 1.f / sum;
#pragma unroll
    for (int j = 0; j < 4; ++j) sp[h][lane + 64 * j] = sc[j] * inv;
    __syncthreads();
    float o0 = 0.f, o1 = 0.f;
    for (int m = 0; m < 256; ++m) {
        const bf16* vr = KV + (size_t)(b * NMEM + m) * 2048 + layer * 1024 + 512 + h * 128;
        const float p = sp[h][m]; o0 += p * bf2f(vr[lane]); o1 += p * bf2f(vr[lane + 64]);
    }
    YX[(size_t)t * XAW + h * 128 + lane] = f2bf(o0); YX[(size_t)t * XAW + h * 128 + 64 + lane] = f2bf(o1);
}
__device__ __forceinline__ float block_sum256(float v, float* red) {
#pragma unroll
    for (int o = 1; o < 64; o <<= 1) v += __shfl_xor(v, o);
    __syncthreads();
    if ((threadIdx.x & 63) == 0) red[threadIdx.x >> 6] = v;
    __syncthreads();
    return red[0] + red[1] + red[2] + red[3];
}
__global__ __launch_bounds__(256) void k_ln_router_ref(const float* Z, const float* g, const float* bb, const float* rw, const float* rb,
                                                       float* X1F, bf16* X1BF, unsigned* cnt, int* list, int* tokslot, float* tokw) {
    __shared__ float sx[D]; __shared__ float red[4]; __shared__ float part[4][64]; __shared__ float ssel[64], ssc[64], sgs[8];
    const int t = blockIdx.x, tid = threadIdx.x;
    float v[8], s = 0.f;
#pragma unroll
    for (int j = 0; j < 8; ++j) { v[j] = Z[(size_t)t * D + tid + 256 * j]; s += v[j]; }
    const float mean = block_sum256(s, red) * (1.f / D);
    float q = 0.f;
#pragma unroll
    for (int j = 0; j < 8; ++j) { v[j] -= mean; q += v[j] * v[j]; }
    const float rstd = rsqrtf(block_sum256(q, red) * (1.f / D) + LN_EPS);
#pragma unroll
    for (int j = 0; j < 8; ++j) { const int c = tid + 256 * j; const float y = v[j] * rstd * g[c] + bb[c]; sx[c] = y; X1F[(size_t)t * D + c] = y; X1BF[(size_t)t * D + c] = f2bf(y); }
    __syncthreads();
    { const int e = tid & 63, p = tid >> 6; float a = 0.f; for (int k = p * 512; k < p * 512 + 512; ++k) a += sx[k] * rw[(size_t)k * NE + e]; part[p][e] = a; }
    __syncthreads();
    if (tid < 64) { const float lg = part[0][tid] + part[1][tid] + part[2][tid] + part[3][tid]; const float sc = 1.f / (1.f + __expf(-lg)); ssc[tid] = sc; ssel[tid] = sc + rb[tid]; }
    __syncthreads();
    if (tid < 8) { float m1 = -INFINITY, m2 = -INFINITY; for (int j = 0; j < 8; ++j) { const float x = ssel[tid * 8 + j]; if (x > m1) { m2 = m1; m1 = x; } else if (x > m2) m2 = x; } sgs[tid] = m1 + m2; }
    __syncthreads();
    if (tid == 0) {
        unsigned gmask = 0;
        for (int i = 0; i < 4; ++i) { int best = 0; float bv = -INFINITY; for (int gq = 0; gq < 8; ++gq) if (!((gmask >> gq) & 1u) && sgs[gq] > bv) { bv = sgs[gq]; best = gq; } gmask |= 1u << best; }
        unsigned long long chosen = 0ull; float wsum = 0.f; int ei[8];
#pragma unroll
        for (int i = 0; i < 8; ++i) { int best = 0; float bv = -INFINITY;
            for (int e = 0; e < 64; ++e) if (((gmask >> (e >> 3)) & 1u) && !((chosen >> e) & 1ull) && ssel[e] > bv) { bv = ssel[e]; best = e; }
            chosen |= 1ull << best; ei[i] = best; wsum += ssc[best]; }
#pragma unroll
        for (int i = 0; i < 8; ++i) { const int e = ei[i]; const unsigned pos = atomicAdd(&cnt[e], 1u);
            list[(size_t)e * LISTCAP + pos] = t; tokslot[t * 8 + i] = e * LISTCAP + (int)pos; tokw[t * 8 + i] = ssc[e] / wsum * RSCALE; }
    }
}
__global__ void k_moe_plan(const unsigned* cnt, unsigned* plan) {
    if (threadIdx.x == 0 && blockIdx.x == 0) { unsigned run = 0; for (int e = 0; e < NE; ++e) { plan[e] = run; run += (cnt[e] + 255u) / 256u; } plan[NE] = run; plan[NE + 1] = run + NTOK / 256; }
}
__global__ __launch_bounds__(256) void k_combine_ln_ref(const float* X1F, const bf16* Y, const unsigned* plan, const int* tokslot, const float* tokw,
                                                        const float* g, const float* bb, float* OUT, bf16* XBF) {
    __shared__ float red[4];
    const int t = blockIdx.x, tid = threadIdx.x;
    int rowi[9]; float wt[9];
#pragma unroll
    for (int i = 0; i < 8; ++i) { const int sl = tokslot[t * 8 + i]; rowi[i] = (int)plan[sl / LISTCAP] * 256 + (sl % LISTCAP); wt[i] = tokw[t * 8 + i]; }
    rowi[8] = (int)plan[NE] * 256 + t; wt[8] = 1.f;
    float v[8], s = 0.f;
#pragma unroll
    for (int j = 0; j < 8; ++j) { const int c = tid + 256 * j; float a = ALPHA * X1F[(size_t)t * D + c];
#pragma unroll
        for (int i = 0; i < 9; ++i) a += wt[i] * bf2f(Y[(size_t)rowi[i] * D + c]);
        v[j] = a; s += a; }
    const float mean = block_sum256(s, red) * (1.f / D);
    float q = 0.f;
#pragma unroll
    for (int j = 0; j < 8; ++j) { v[j] -= mean; q += v[j] * v[j]; }
    const float rstd = rsqrtf(block_sum256(q, red) * (1.f / D) + LN_EPS);
#pragma unroll
    for (int j = 0; j < 8; ++j) { const int c = tid + 256 * j; const float y = v[j] * rstd * g[c] + bb[c]; OUT[(size_t)t * D + c] = y; XBF[(size_t)t * D + c] = f2bf(y); }
}

extern "C" void kernel_launch(void* const* d_in, const int* in_sizes, int n_in, void* d_out, int out_size, void* d_ws, size_t ws_size, hipStream_t stream) {
    if (n_in != 24 || out_size != NTOK * D || ws_size < WS_END) { fprintf(stderr, "kernel_launch: unexpected sizes n_in %d out %d ws %zu\n", n_in, out_size, ws_size); return; }
    const float* x = (const float*)d_in[0]; const float* mem = (const float*)d_in[1]; const float* w_in = (const float*)d_in[2];
    const float* conv_w = (const float*)d_in[3]; const float* w_conv_out = (const float*)d_in[4]; const float* lbl = (const float*)d_in[5];
    const float* hg_g = (const float*)d_in[6]; const float* w_hg_out = (const float*)d_in[7]; const float* w_mem_k = (const float*)d_in[8];
    const float* w_mem_v = (const float*)d_in[9]; const float* w_xa_out = (const float*)d_in[10]; const float* w_o = (const float*)d_in[11];
    const float* ln1_g = (const float*)d_in[12]; const float* ln1_b = (const float*)d_in[13]; const float* router_w = (const float*)d_in[14];
    const float* router_b = (const float*)d_in[15]; const float* exp_wg = (const float*)d_in[16]; const float* exp_wu = (const float*)d_in[17];
    const float* exp_wd = (const float*)d_in[18]; const float* sh_wg = (const float*)d_in[19]; const float* sh_wu = (const float*)d_in[20];
    const float* sh_wd = (const float*)d_in[21]; const float* ln2_g = (const float*)d_in[22]; const float* ln2_b = (const float*)d_in[23];
    unsigned char* ws = (unsigned char*)d_ws; float* out = (float*)d_out;
    unsigned* ctl = (unsigned*)(ws + WS_CTL);
    bf16* MEMBF = (bf16*)(ws + WS_MEMBF); bf16* KV = (bf16*)(ws + WS_KV); bf16* XBF = (bf16*)(ws + WS_XBF); float* X1F = (float*)(ws + WS_X1F);
    bf16* X1BF = (bf16*)(ws + WS_X1BF); float* ZF = (float*)(ws + WS_ZF); bf16* MERGED = (bf16*)(ws + WS_MERGED);
    bf16* YA = (bf16*)(ws + WS_YA); bf16* YB = (bf16*)(ws + WS_YB); bf16* YX = (bf16*)(ws + WS_YX);
    bf16* H = (bf16*)(ws + WS_R2); float* OH = (float*)(ws + WS_R2); bf16* PROJ = (bf16*)(ws + WS_R1); bf16* Y = (bf16*)(ws + WS_R1);
    int* LIST = (int*)(ws + WS_LIST); int* TOKSLOT = (int*)(ws + WS_TOKSLOT); float* TOKW = (float*)(ws + WS_TOKW);

    (void)hipMemsetAsync(ws + WS_CTL, 0, CTL_BYTES, stream);
    k_cvt<<<2048, 256, 0, stream>>>(x, XBF, (size_t)NTOK * D);
    k_cvt<<<512, 256, 0, stream>>>(mem, MEMBF, (size_t)NB * NMEM * D);
    for (int l = 0; l < 2; ++l) {
        k_gemm_ref<EpiStoreBf16><<<dim3(XAW / 128, NB * NMEM / 128), 256, 0, stream>>>(MEMBF, D, w_mem_k + (size_t)l * D * XAW, XAW, NB * NMEM, XAW, D, EpiStoreBf16{KV, 2048, l * 1024});
        k_gemm_ref<EpiStoreBf16><<<dim3(XAW / 128, NB * NMEM / 128), 256, 0, stream>>>(MEMBF, D, w_mem_v + (size_t)l * D * XAW, XAW, NB * NMEM, XAW, D, EpiStoreBf16{KV, 2048, l * 1024 + 512});
    }
    for (int l = 0; l < 2; ++l) {
        unsigned* cnt = ctl + CW_CNT + l * 64; unsigned* plan = ctl + CW_PLAN + l * 128;
        const float* xres = l == 0 ? x : out;
        k_gemm_ref<EpiStoreBf16><<<dim3(INC / 128, NTOK / 128), 256, 0, stream>>>(XBF, D, w_in + (size_t)l * D * INC, INC, NTOK, INC, D, EpiStoreBf16{PROJ, INC, 0});
        k_conv_ref<<<2048, 256, 0, stream>>>(PROJ, conv_w + (size_t)l * 3 * CW, YA);
        k_hgrn_ref<<<NB * HGH, 128, 0, stream>>>(PROJ, lbl, l, OH);
        k_hgrn_norm_ref<<<NTOK * HGH / 4, 256, 0, stream>>>(OH, PROJ, hg_g + (size_t)l * HGW, YB);
        k_memattn_ref<<<NTOK, 256, 0, stream>>>(PROJ, KV, l, YX);
        k_gemm_ref<EpiGate><<<dim3(D / 128, NTOK / 128), 256, 0, stream>>>(YA, CW, w_conv_out + (size_t)l * CW * D, D, NTOK, D, CW, EpiGate{PROJ, ZF, MERGED, C_GA, 0});
        k_gemm_ref<EpiGate><<<dim3(D / 128, NTOK / 128), 256, 0, stream>>>(YB, HGW, w_hg_out + (size_t)l * HGW * D, D, NTOK, D, HGW, EpiGate{PROJ, ZF, MERGED, C_GB, 1});
        k_gemm_ref<EpiGate><<<dim3(D / 128, NTOK / 128), 256, 0, stream>>>(YX, XAW, w_xa_out + (size_t)l * XAW * D, D, NTOK, D, XAW, EpiGate{PROJ, ZF, MERGED, C_GX, 2});
        k_gemm_ref<EpiResid><<<dim3(D / 128, NTOK / 128), 256, 0, stream>>>(MERGED, D, w_o + (size_t)l * D * D, D, NTOK, D, D, EpiResid{xres, ZF});
        k_ln_router_ref<<<NTOK, 256, 0, stream>>>(ZF, ln1_g + (size_t)l * D, ln1_b + (size_t)l * D, router_w + (size_t)l * D * NE, router_b + (size_t)l * NE, X1F, X1BF, cnt, LIST, TOKSLOT, TOKW);
        k_moe_plan<<<1, 64, 0, stream>>>(cnt, plan);
        k_moe_gu_ref<<<dim3(EH / 128, NTOK / 128, NE + 1), 256, 0, stream>>>(X1BF, exp_wg + (size_t)l * NE * D * EH, exp_wu + (size_t)l * NE * D * EH, sh_wg + (size_t)l * D * EH, sh_wu + (size_t)l * D * EH, cnt, plan, LIST, H);
        k_moe_down_ref<<<dim3(D / 128, NTOK / 128, NE + 1), 256, 0, stream>>>(H, exp_wd + (size_t)l * NE * EH * D, sh_wd + (size_t)l * EH * D, cnt, plan, Y);
        k_combine_ln_ref<<<NTOK, 256, 0, stream>>>(X1F, Y, plan, TOKSLOT, TOKW, ln2_g + (size_t)l * D, ln2_b + (size_t)l * D, out, XBF);
    }
}
```

```cpp
#include <hip/hip_runtime.h>
#include <stdint.h>
#include <stdio.h>

typedef unsigned short bf16;
__device__ __forceinline__ float bf2f(bf16 v) { return __uint_as_float(((unsigned)v) << 16); }
__device__ __forceinline__ bf16 f2bf(float f) { unsigned u = __float_as_uint(f); return (bf16)((u + 0x7fffu + ((u >> 16) & 1u)) >> 16); }

constexpr int NB = 4, SEQ = 4096, NTOK = NB * SEQ, D = 2048, NMEM = 256;
constexpr int CW = 768, HGW = 768, HGH = 6, HGD = 128, XAW = 512, XAH = 4, XAD = 128;
constexpr int INC = 12032;
constexpr int C_U = 0, C_B = 768, C_C = 1536, C_Q = 2304, C_F = 3072, C_I = 3840, C_G = 4608, C_QX = 5376, C_GA = 5888, C_GB = 7936, C_GX = 9984;
constexpr int NE = 64, TOPK = 8, EH = 512;
constexpr float ALPHA = 1.41421356237f, LN_EPS = 1e-5f, RMS_EPS = 1e-6f, RSCALE = 2.5f;
constexpr int LISTCAP = 16384;

constexpr size_t MiB = 1u << 20;
constexpr size_t WS_CTL = 0, CTL_BYTES = 1 * MiB;
constexpr size_t WS_WIN_T = 2 * MiB, WIN_T_L = 47 * MiB;
constexpr size_t WS_WBR_T = 96 * MiB, WBR_T_L = 8 * MiB;
constexpr size_t WS_WO_T = 112 * MiB, WO_T_L = 8 * MiB;
constexpr size_t WS_WKV_T = 128 * MiB;
constexpr size_t WS_MEMBF = 136 * MiB, WS_KV = 140 * MiB;
constexpr size_t WS_WGU = 144 * MiB, WGU_E = 4 * MiB;
constexpr size_t WS_WDN = 404 * MiB, WDN_E = 2 * MiB;
constexpr size_t WS_XBF = 534 * MiB, WS_X1F = 598 * MiB, WS_X1BF = 726 * MiB, WS_ZF = 790 * MiB, WS_MERGED = 918 * MiB;
constexpr size_t WS_YA = 982 * MiB, WS_YB = 1006 * MiB, WS_YX = 1030 * MiB;
constexpr size_t WS_R2 = 1046 * MiB;
constexpr size_t WS_R1 = 1214 * MiB;
constexpr size_t WS_LIST = 1854 * MiB, WS_TOKSLOT = 1858 * MiB, WS_TOKW = 1859 * MiB, WS_END = 1860 * MiB;
constexpr int CW_CNT = 1024;
constexpr int CW_PLAN = 2048;
constexpr int CW_BAR = 4096;
#ifndef DBG_MASK
#define DBG_MASK 7
#endif
namespace pg8 {
#define PG8_LAS __attribute__((address_space(3)))
typedef unsigned short bf16_t;
typedef short bf16x8 __attribute__((ext_vector_type(8)));
typedef float f32x4 __attribute__((ext_vector_type(4)));
typedef unsigned u32x4 __attribute__((ext_vector_type(4)));
typedef unsigned u32x2 __attribute__((ext_vector_type(2)));
constexpr int PG8_NVO_OFF = 147456 + 1024;
constexpr int BM = 256, BK = 64, HALF = 128, HTB = HALF * BK * 2  , STAGE_BYTES = 8 * HTB, NXCD = 8, WGM = 8;

__host__ __device__ __forceinline__ int lds_byte(int r, int c) { const int st = (r >> 4) * 2 + (c >> 5), rr = r & 15, cc = c & 31, ob = rr * 64 + cc * 2; return st * 1024 + (ob ^ (((ob >> 9) & 1) << 5)); }
__host__ __device__ __forceinline__ void stage_rc(int b, int& R, int& C) { const int st = b / 1024, sb = b % 1024, swz = sb ^ (((sb >> 9) & 1) << 5); R = (st >> 1) * 16 + swz / 64; C = (st & 1) * 32 + (swz % 64) / 2; }
__host__ __device__ __forceinline__ int perm32(int rho) { const int n = rho >> 4, i = rho & 15; return 8 * (i >> 2) + 4 * n + (i & 3); }

struct Unit { const char* A; const char* B; int pm, pn; const int* list; int m0, cnt; };

typedef float f32x2_ __attribute__((ext_vector_type(2)));
typedef __bf16 bf16x2_ __attribute__((ext_vector_type(2)));
__device__ __forceinline__ unsigned cvt_pk_bf16(float lo, float hi) { const f32x2_ v = {lo, hi}; const bf16x2_ b = __builtin_convertvector(v, bf16x2_); return __builtin_bit_cast(unsigned, b); }
__device__ __forceinline__ float bf_lo(unsigned w) { return __uint_as_float(w << 16); }
__device__ __forceinline__ float bf_hi(unsigned w) { return __uint_as_float(w & 0xffff0000u); }
__device__ __forceinline__ float sigmoidf_(float x) { return __builtin_amdgcn_rcpf(1.f + __expf(-x)); }

typedef f32x4 Acc[2][2][4][2];

template <class Epi, class Sched, bool ALIGN_EPI>
__device__ __forceinline__ void gemm_phase(PG8_LAS unsigned char* lds, const int K_in, const Sched& S, const Epi& E) {
    int tid_o = threadIdx.x; asm volatile("" : "+v"(tid_o));
    const int tid = tid_o, wid = __builtin_amdgcn_readfirstlane(tid >> 6), lane = tid & 63, wr = wid >> 2, wc = wid & 3, fr = lane & 15, fq = lane >> 4;
    int K = K_in; asm volatile("" : "+s"(K));
    const int nt = K / BK;
    unsigned voffB[2];
#pragma unroll
    for (int i = 0; i < 2; ++i) { int R, C; stage_rc(tid * 16 + i * 8192, R, C); const int Rb = Epi::PERM ? ((R & ~31) + perm32(R & 31)) : R; voffB[i] = (unsigned)(Rb * K + C) * 2u; }
    const size_t kstep = (size_t)(BK * 2);
    const size_t hstep = (size_t)HALF * K * 2;
    const unsigned ldsw = (unsigned)wid * 1024u;
    const int aoff = lds_byte(wr * 64 + fr, fq * 8), boff = lds_byte(wc * 32 + fr, fq * 8);
#define PG8_SA(b, h) (((b) * 2 + (h)) * HTB)
#define PG8_SB(b, h) ((4 + (b) * 2 + (h)) * HTB)
#define PG8_STAGE2(bufoff, gbase, v0, v1) do { \
        __builtin_amdgcn_global_load_lds((const unsigned*)((const char*)(gbase) + (v0)), (PG8_LAS unsigned*)(lds + (bufoff) + ldsw), 16, 0, 0); \
        __builtin_amdgcn_global_load_lds((const unsigned*)((const char*)(gbase) + (v1)), (PG8_LAS unsigned*)(lds + (bufoff) + ldsw + 8192), 16, 0, 0); } while (0)
#define PG8_STAGEB(bufoff, gbase) PG8_STAGE2(bufoff, gbase, voffB[0], voffB[1])
#define PG8_LDA(dst, b, h) do { _Pragma("unroll") for (int m = 0; m < 4; ++m) _Pragma("unroll") for (int k = 0; k < 2; ++k) dst[m][k] = *(const PG8_LAS bf16x8*)(lds + PG8_SA(b, h) + aoff + m * 2048 + k * 1024); } while (0)
#define PG8_LDB(dst, b, h) do { _Pragma("unroll") for (int n = 0; n < 2; ++n) _Pragma("unroll") for (int k = 0; k < 2; ++k) dst[n][k] = *(const PG8_LAS bf16x8*)(lds + PG8_SB(b, h) + boff + n * 2048 + k * 1024); } while (0)
#define PG8_MMA(ai, bj, At, Bt) do { __builtin_amdgcn_s_setprio(1); _Pragma("unroll") for (int m = 0; m < 4; ++m) _Pragma("unroll") for (int n = 0; n < 2; ++n) _Pragma("unroll") for (int k = 0; k < 2; ++k) \
        acc[ai][bj][m][n] = __builtin_amdgcn_mfma_f32_16x16x32_bf16(Bt[n][k], At[m][k], acc[ai][bj][m][n], 0, 0, 0); __builtin_amdgcn_s_setprio(0); } while (0)
#define PG8_WAIT_V(n) asm volatile("s_waitcnt vmcnt(" #n ")" ::: "memory")
#define PG8_WAIT_L(n) asm volatile("s_waitcnt lgkmcnt(" #n ")" ::: "memory")
#define PG8_BAR __builtin_amdgcn_s_barrier()
#define PG8_SCHED __builtin_amdgcn_sched_barrier(0)
    Unit cur, nxt; int ui = 0;
    if (!S.next(0, cur)) return;
    Acc acc;
#pragma unroll
    for (int a = 0; a < 2; ++a)
#pragma unroll
        for (int b = 0; b < 2; ++b)
#pragma unroll
            for (int m = 0; m < 4; ++m)
#pragma unroll
                for (int n = 0; n < 2; ++n) acc[a][b][m][n] = (f32x4){0.f, 0.f, 0.f, 0.f};
    bf16x8 At[4][2], B0[2][2], B1[2][2];
    constexpr bool GA = Sched::GATHER;
    unsigned c00, c01, c10 = 0, c11 = 0;
    PG8_LAS unsigned* nvo = (PG8_LAS unsigned*)(lds + PG8_NVO_OFF) + tid * 4;
    { int R0, C0, R1, C1; stage_rc(tid * 16, R0, C0); stage_rc(tid * 16 + 8192, R1, C1);
      c00 = S.avoff(cur, 0, R0, C0, K); c01 = S.avoff(cur, 0, R1, C1, K); if constexpr (GA) { c10 = S.avoff(cur, 1, R0, C0, K); c11 = S.avoff(cur, 1, R1, C1, K); } }
    const size_t hA = GA ? (size_t)0 : hstep;
#define PG8_STAGEA0(bufoff, gbase) PG8_STAGE2(bufoff, gbase, c00, c01)
#define PG8_STAGEA1(bufoff, gbase) do { if constexpr (GA) PG8_STAGE2(bufoff, gbase, c10, c11); else PG8_STAGE2(bufoff, (gbase) + hA, c00, c01); } while (0)
    const char* cA = cur.A; const char* cB = cur.B;
    PG8_STAGEB(PG8_SB(0, 0), cB); PG8_STAGEB(PG8_SB(0, 1), cB + hstep); PG8_STAGEA0(PG8_SA(0, 0), cA); PG8_STAGEA1(PG8_SA(0, 1), cA);
    if (wr == 1) PG8_BAR;
    PG8_WAIT_V(2); PG8_BAR;
    PG8_STAGEB(PG8_SB(1, 0), cB + kstep); PG8_STAGEA0(PG8_SA(1, 0), cA + kstep); PG8_STAGEB(PG8_SB(1, 1), cB + hstep + kstep);
    PG8_WAIT_V(6); PG8_BAR;
    for (;;) {
        const bool has_next = S.next(ui + 1, nxt);
        const char* nA = has_next ? nxt.A : cA; const char* nB = has_next ? nxt.B : cB;
        for (int t = 0; t < nt; t += 2) {
            const bool last = (t == nt - 2);
            const char* a1 = cA + (size_t)(t + 1) * kstep;
            const char* a2 = last ? nA : cA + (size_t)(t + 2) * kstep; const char* b2 = last ? nB : cB + (size_t)(t + 2) * kstep;
            const char* a3 = a2 + kstep; const char* b3 = b2 + kstep;
            const bool nx = GA && last && has_next;
            if (nx) { int R0, C0, R1, C1; stage_rc(tid * 16, R0, C0); stage_rc(tid * 16 + 8192, R1, C1);
                nvo[0] = S.avoff(nxt, 0, R0, C0, K); nvo[1] = S.avoff(nxt, 0, R1, C1, K); nvo[2] = S.avoff(nxt, 1, R0, C0, K); nvo[3] = S.avoff(nxt, 1, R1, C1, K); }
#define PG8_STAGEA0N(bufoff, gbase) do { if (nx) { const unsigned q0 = nvo[0], q1 = nvo[1]; PG8_STAGE2(bufoff, gbase, q0, q1); } else PG8_STAGEA0(bufoff, gbase); } while (0)
#define PG8_STAGEA1N(bufoff, gbase) do { if (nx) { const unsigned q0 = nvo[2], q1 = nvo[3]; PG8_STAGE2(bufoff, gbase, q0, q1); } else PG8_STAGEA1(bufoff, gbase); } while (0)
            PG8_LDB(B0, 0, 0); PG8_LDB(B1, 0, 1); PG8_SCHED; PG8_LDA(At, 0, 0); PG8_STAGEA1(PG8_SA(1, 1), a1);
            PG8_WAIT_V(8); PG8_WAIT_L(0); PG8_BAR; PG8_MMA(0, 0, At, B0); PG8_MMA(0, 1, At, B1); PG8_BAR; PG8_SCHED;
            PG8_LDA(At, 0, 1); PG8_STAGEB(PG8_SB(0, 0), b2); PG8_STAGEB(PG8_SB(0, 1), b2 + hstep); PG8_STAGEA0N(PG8_SA(0, 0), a2);
            PG8_WAIT_V(8); PG8_WAIT_L(0); PG8_BAR; PG8_MMA(1, 0, At, B0); PG8_MMA(1, 1, At, B1); PG8_BAR; PG8_SCHED;
            PG8_LDB(B0, 1, 0); PG8_LDB(B1, 1, 1); PG8_SCHED; PG8_LDA(At, 1, 0); PG8_STAGEA1N(PG8_SA(0, 1), a2);
            PG8_WAIT_V(8); PG8_WAIT_L(0); PG8_BAR; PG8_MMA(0, 0, At, B0); PG8_MMA(0, 1, At, B1); PG8_BAR; PG8_SCHED;
            PG8_LDA(At, 1, 1); PG8_STAGEB(PG8_SB(1, 0), b3); PG8_STAGEB(PG8_SB(1, 1), b3 + hstep); PG8_STAGEA0N(PG8_SA(1, 0), a3);
            PG8_WAIT_V(8); PG8_WAIT_L(0); PG8_BAR; PG8_MMA(1, 0, At, B0); PG8_MMA(1, 1, At, B1); PG8_BAR; PG8_SCHED;
#undef PG8_STAGEA0N
#undef PG8_STAGEA1N
        }
        if constexpr (ALIGN_EPI) { if (wr == 0) PG8_BAR; }
        E(acc, cur, wr, wc, fr, fq);
        if (!has_next) break;
#pragma unroll
        for (int a = 0; a < 2; ++a)
#pragma unroll
            for (int b = 0; b < 2; ++b)
#pragma unroll
                for (int m = 0; m < 4; ++m)
#pragma unroll
                    for (int n = 0; n < 2; ++n) acc[a][b][m][n] = (f32x4){0.f, 0.f, 0.f, 0.f};
        cur = nxt; cA = nA; cB = nB; ++ui; if constexpr (GA) { c00 = nvo[0]; c01 = nvo[1]; c10 = nvo[2]; c11 = nvo[3]; }
        if constexpr (ALIGN_EPI) { if (wr == 1) PG8_BAR; }
    }
    PG8_WAIT_V(0);
    if constexpr (!ALIGN_EPI) { if (wr == 0) PG8_BAR; }
    PG8_BAR;
#undef PG8_SA
#undef PG8_SB
#undef PG8_STAGE2
#undef PG8_STAGEB
#undef PG8_STAGEA0
#undef PG8_STAGEA1
#undef PG8_LDA
#undef PG8_LDB
#undef PG8_MMA
#undef PG8_WAIT_V
#undef PG8_WAIT_L
#undef PG8_BAR
#undef PG8_SCHED
}
}
#define GAS __attribute__((address_space(1)))
#define LAS __attribute__((address_space(3)))
typedef unsigned v4u __attribute__((ext_vector_type(4)));
typedef unsigned v2u __attribute__((ext_vector_type(2)));
typedef float f32x4 __attribute__((ext_vector_type(4)));
typedef short bf16x8 __attribute__((ext_vector_type(8)));
typedef GAS unsigned gu32;
#define RLX_AGENT __ATOMIC_RELAXED, __HIP_MEMORY_SCOPE_AGENT
#define LDS_WAIT() asm volatile("s_waitcnt lgkmcnt(0)" ::: "memory")
#define VM_WAIT() asm volatile("s_waitcnt vmcnt(0)" ::: "memory")
__device__ __forceinline__ int opaque_v(int x) { asm volatile("" : "+v"(x)); return x; }
__device__ __forceinline__ float shx(float v, int o, int lane) { return __int_as_float(__builtin_amdgcn_ds_bpermute((lane ^ o) << 2, __float_as_int(v))); }
__device__ __forceinline__ unsigned pk2(float lo, float hi) { return pg8::cvt_pk_bf16(lo, hi); }

#define XB_TMO      128
#define XB_XCNT(j)  (256  + 64 * (j))
#define XB_XSUB(j)  (1280 + 64 * (j))
#define XB_XGEN(j)  (2304 + 64 * (j))
#define XB_TOP      3328
#define XB_TOPGEN   3392
#define XCD_BAR_WORDS 3456
#define XB_SPIN_CAP (1u << 18)
__device__ __forceinline__ unsigned xb_ld(unsigned* p)              { return __hip_atomic_load(p, __ATOMIC_RELAXED, __HIP_MEMORY_SCOPE_AGENT); }
__device__ __forceinline__ unsigned xb_add(unsigned* p, unsigned v) { return __hip_atomic_fetch_add(p, v, __ATOMIC_RELAXED, __HIP_MEMORY_SCOPE_AGENT); }
__device__ __forceinline__ unsigned xb_xcc_id() { return (unsigned)__builtin_amdgcn_s_getreg((3 << 11) | 20) & 0xFu; }
#define XB_SPIN(cond, bar) do { unsigned _sp = 0; while (cond) { __builtin_amdgcn_s_sleep(1); \
    if ((++_sp & 255u) == 0u) { if (xb_ld(&(bar)[XB_TMO])) break; if (_sp > XB_SPIN_CAP) { atomicAdd(&(bar)[XB_TMO], 1u); break; } } } } while (0)
struct XcdBarrier { unsigned* bar; unsigned x; volatile LAS unsigned* st; };
__device__ __forceinline__ XcdBarrier xcd_barrier_post(unsigned* bar, volatile LAS unsigned* st) {
    XcdBarrier b; b.bar = bar; b.x = xb_xcc_id(); b.st = st;
    if (threadIdx.x == 0) (void)xb_add(&bar[XB_XCNT(b.x)], 1u);
    return b;
}
__device__ __forceinline__ void xcd_barrier_complete(unsigned* bar, unsigned x, unsigned& nloc, unsigned& nx) {
    const unsigned G = gridDim.x * gridDim.y * gridDim.z;
    unsigned sum, cnt, mine, sp = 0u;
    for (;;) {
        sum = 0u; cnt = 0u; mine = 0u;
#pragma unroll
        for (unsigned j = 0; j < 16; ++j) { const unsigned c = xb_ld(&bar[XB_XCNT(j)]); sum += c; cnt += (c > 0u) ? 1u : 0u; mine = (j == x) ? c : mine; }
        if (sum == G) break;
        __builtin_amdgcn_s_sleep(1);
        if ((++sp & 255u) == 0u) { if (xb_ld(&bar[XB_TMO])) break; if (sp > XB_SPIN_CAP) { atomicAdd(&bar[XB_TMO], 1u); break; } }
    }
    nloc = mine > 0u ? mine : 1u; nx = cnt > 0u ? cnt : 1u;
}
__device__ __forceinline__ void xcd_barrier(const XcdBarrier& b_in) {
    asm volatile("s_waitcnt vmcnt(0)" ::: "memory");
    __syncthreads();
    if (threadIdx.x == 0) {
        XcdBarrier b = b_in; asm volatile("" : "+s"(b.x));
        unsigned* bar = b.bar; asm volatile("" : "+s"(bar));
        __builtin_amdgcn_s_waitcnt(0);
        unsigned nloc = b.st[0], nx = b.st[1];
        if (nloc == 0u) { xcd_barrier_complete(bar, b.x, nloc, nx); b.st[0] = nloc; b.st[1] = nx; }
        const unsigned old = xb_add(&bar[XB_XSUB(b.x)], 1u);
        const unsigned gen = old / nloc;
        if (old + 1u == (gen + 1u) * nloc) {
            __builtin_amdgcn_fence(__ATOMIC_RELEASE, "agent");
            asm volatile("s_waitcnt vmcnt(0)" ::: "memory");
            const unsigned og = xb_add(&bar[XB_TOP], 1u);
            const unsigned tg = og / nx;
            if (og + 1u == (tg + 1u) * nx) xb_add(&bar[XB_TOPGEN], 1u);
            else XB_SPIN(xb_ld(&bar[XB_TOPGEN]) == tg, bar);
            __builtin_amdgcn_fence(__ATOMIC_ACQUIRE, "agent");
            xb_add(&bar[XB_XGEN(b.x)], 1u);
            asm volatile("s_waitcnt vmcnt(0)" ::: "memory");
        } else {
            XB_SPIN(xb_ld(&bar[XB_XGEN(b.x)]) == gen, bar);
            __builtin_amdgcn_fence(__ATOMIC_ACQUIRE, "agent");
            asm volatile("s_waitcnt vmcnt(0)" ::: "memory");
        }
    }
    __syncthreads();
}
using pg8::Unit; using pg8::Acc;
struct DenseSched { static constexpr bool GATHER = false;
    const char* A; const char* B; int nM, nN, nwg, G, c, K;
    __device__ __forceinline__ void init(const void* A_, const void* B_, int M, int N, int K_, int G_, int c_) { A = (const char*)A_; B = (const char*)B_; nM = M / 256; nN = N / 256; nwg = nM * nN; G = G_; c = c_; K = K_; }
    __device__ __forceinline__ bool next(int i, Unit& u) const {
        const long L = (long)i * G + c; if (L >= nwg) return false;
        int wgid = (int)L; { const int q = nwg / 8, r = nwg % 8, xcd = wgid % 8, off = wgid / 8; wgid = (xcd < r ? xcd * (q + 1) : r * (q + 1) + (xcd - r) * q) + off; }
        const int nig = 8 * nN, gid = wgid / nig, fm = gid * 8, gsz = (nM - fm) < 8 ? (nM - fm) : 8;
        u.pm = fm + ((wgid % nig) % gsz); u.pn = (wgid % nig) / gsz;
        u.A = A + (size_t)u.pm * 256 * K * 2; u.B = B + (size_t)u.pn * 256 * K * 2; u.list = nullptr; u.m0 = 0; u.cnt = 0; return true;
    }
    __device__ __forceinline__ unsigned avoff(const Unit&, int h, int R, int C, int K_) const { return (unsigned)(((h * 128 + R) * K_ + C) * 2); }
};
struct EpiBf16Plain { static constexpr bool PERM = true; bf16* O; int ldc;
    __device__ __forceinline__ void operator()(const Acc& acc, const Unit& u, int wr, int wc, int fr, int fq) const {
        const int row0 = u.pm * 256 + wr * 64 + fr, col0 = u.pn * 256 + wc * 32 + 8 * fq;
#pragma unroll
        for (int ai = 0; ai < 2; ++ai)
#pragma unroll
            for (int m = 0; m < 4; ++m) { bf16* rowp = O + (size_t)(row0 + ai * 128 + m * 16) * ldc + col0;
#pragma unroll
                for (int bj = 0; bj < 2; ++bj) { const f32x4 v0 = acc[ai][bj][m][0], v1 = acc[ai][bj][m][1];
                    v4u w; w.x = pk2(v0[0], v0[1]); w.y = pk2(v0[2], v0[3]); w.z = pk2(v1[0], v1[1]); w.w = pk2(v1[2], v1[3]);
                    *(v4u*)(rowp + bj * 128) = w; } }
    }
};
template <int MODE> struct EpiGate { static constexpr bool PERM = true; const bf16* proj; float* part; bf16* merged; int gcol;
    __device__ __forceinline__ void operator()(const Acc& acc, const Unit& u, int wr, int wc, int fr, int fq) const {
        const int row0 = u.pm * 256 + wr * 64 + fr, col0 = u.pn * 256 + wc * 32 + 8 * fq;
#pragma unroll
        for (int ai = 0; ai < 2; ++ai)
#pragma unroll
            for (int m = 0; m < 4; ++m) { const size_t row = (size_t)(row0 + ai * 128 + m * 16);
#pragma unroll
                for (int bj = 0; bj < 2; ++bj) { const int col = col0 + bj * 128;
                    const v4u gw = *(const v4u*)(proj + row * INC + gcol + col);
                    f32x4 v0 = acc[ai][bj][m][0], v1 = acc[ai][bj][m][1];
                    v0[0] *= pg8::sigmoidf_(pg8::bf_lo(gw.x)); v0[1] *= pg8::sigmoidf_(pg8::bf_hi(gw.x)); v0[2] *= pg8::sigmoidf_(pg8::bf_lo(gw.y)); v0[3] *= pg8::sigmoidf_(pg8::bf_hi(gw.y));
                    v1[0] *= pg8::sigmoidf_(pg8::bf_lo(gw.z)); v1[1] *= pg8::sigmoidf_(pg8::bf_hi(gw.z)); v1[2] *= pg8::sigmoidf_(pg8::bf_lo(gw.w)); v1[3] *= pg8::sigmoidf_(pg8::bf_hi(gw.w));
                    float* pp = part + row * D + col;
                    if (MODE >= 1) { v0 += *(const f32x4*)pp; v1 += *(const f32x4*)(pp + 4); }
                    if (MODE <= 1) { *(f32x4*)pp = v0; *(f32x4*)(pp + 4) = v1; }
                    else { v4u w; w.x = pk2(v0[0], v0[1]); w.y = pk2(v0[2], v0[3]); w.z = pk2(v1[0], v1[1]); w.w = pk2(v1[2], v1[3]); *(v4u*)(merged + row * D + col) = w; } }
                asm volatile("" ::: "memory"); }
    }
};
struct EpiResid { static constexpr bool PERM = false; const float* xres; float* z;
    __device__ __forceinline__ void operator()(const Acc& acc, const Unit& u, int wr, int wc, int fr, int fq) const {
        const int row0 = u.pm * 256 + wr * 64 + fr, col0 = u.pn * 256 + wc * 32 + 4 * fq;
#pragma unroll
        for (int ai = 0; ai < 2; ++ai)
#pragma unroll
            for (int m = 0; m < 4; ++m) { const size_t off = (size_t)(row0 + ai * 128 + m * 16) * D + col0;
#pragma unroll
                for (int bj = 0; bj < 2; ++bj)
#pragma unroll
                    for (int n = 0; n < 2; ++n) { const f32x4 xr = *(const f32x4*)(xres + off + bj * 128 + n * 16); *(f32x4*)(z + off + bj * 128 + n * 16) = xr * ALPHA + acc[ai][bj][m][n]; }
                asm volatile("" ::: "memory"); }
    }
};

constexpr int NWAVES = 8;
constexpr int RING_OFF = 0, RING_BYTES = 131072;
constexpr int SCR_BYTES = 147456;
constexpr int MISC_OFF = SCR_BYTES;
constexpr int LDS_BYTES = 163840;
constexpr int PH_CVT = 0, PH_MEMKV = 1, PH_L0 = 2, PH_PER_LAYER = 10;
constexpr int P_INPROJ = 0, P_MIX = 1, P_SCAN = 2, P_HOUT = 3, P_BRANCH = 4, P_WO = 5, P_ROUTE = 6, P_GU = 7, P_DOWN = 8, P_COMB = 9;
constexpr int N_PHASES = PH_L0 + 2 * PH_PER_LAYER;

struct Frame { LAS unsigned char* lds; int tid, lane, wave, G, gw, NGW; };

__device__ __forceinline__ void xpose_item(const float* W, int N, int k0, int n0, bf16* WTrow0, int ldk, LAS float* scr, int lane) {
    const int kk = lane >> 3, nn = (lane & 7) * 4;
    f32x4 v[8];
#pragma unroll
    for (int i = 0; i < 8; ++i) v[i] = *(const f32x4*)(W + (size_t)(k0 + kk + 8 * i) * N + n0 + nn);
#pragma unroll
    for (int i = 0; i < 8; ++i) { LAS float* s = scr + (kk + 8 * i) * 33 + nn; s[0] = v[i][0]; s[1] = v[i][1]; s[2] = v[i][2]; s[3] = v[i][3]; }
    LDS_WAIT(); asm volatile("" ::: "memory");
    const int c = lane & 7;
#pragma unroll
    for (int j = 0; j < 4; ++j) { const int n = (lane >> 3) + 8 * j; const LAS float* s = scr + (8 * c) * 33 + n;
        v4u o; o.x = pk2(s[0 * 33], s[1 * 33]); o.y = pk2(s[2 * 33], s[3 * 33]); o.z = pk2(s[4 * 33], s[5 * 33]); o.w = pk2(s[6 * 33], s[7 * 33]);
        *(v4u*)(WTrow0 + (size_t)n * ldk + 8 * c) = o; }
    LDS_WAIT(); asm volatile("" ::: "memory");
}
__device__ __forceinline__ void xpose_matrix(const Frame& F, const float* W, int K, int N, bf16* WT, int ldk, int mode, unsigned& gbase) {
    const int nblk = N / 32, nitems = (K / 64) * nblk;
    LAS float* scr = (LAS float*)(F.lds + RING_OFF + F.wave * 8704);
    int it = (int)(((unsigned)F.gw + (unsigned)F.NGW - gbase % (unsigned)F.NGW) % (unsigned)F.NGW);
    for (; it < nitems; it += F.NGW) {
        const int kb = it / nblk, nb = it % nblk, n0 = nb * 32, k0 = kb * 64;
        const int drow = mode == 0 ? n0 : ((n0 >> 7) * 256 + (n0 & 127) + (mode == 2 ? 128 : 0));
        xpose_item(W, N, k0, n0, WT + (size_t)drow * ldk + k0, ldk, scr, F.lane);
    }
    gbase += (unsigned)nitems;
}
__device__ __forceinline__ void cvt_rows(const Frame& F, const float* in, bf16* out, size_t n8) {
    for (size_t i = (size_t)blockIdx.x * 512 + F.tid; i < n8; i += (size_t)F.G * 512) {
        const f32x4 a = *(const f32x4*)(in + i * 8), b = *(const f32x4*)(in + i * 8 + 4);
        v4u w; w.x = pk2(a[0], a[1]); w.y = pk2(a[2], a[3]); w.z = pk2(b[0], b[1]); w.w = pk2(b[2], b[3]);
        *(v4u*)(out + i * 8) = w; }
}
__device__ __forceinline__ void cvt_experts(const Frame& F, const float* wg, const float* wu, const float* wd, const float* sg, const float* su, const float* sd, unsigned char* ws, unsigned& gbase) {
    for (int e = 0; e <= NE; ++e) {
        const float* g = e < NE ? wg + (size_t)e * D * EH : sg; const float* u = e < NE ? wu + (size_t)e * D * EH : su; const float* d = e < NE ? wd + (size_t)e * EH * D : sd;
        xpose_matrix(F, g, D, EH, (bf16*)(ws + WS_WGU + (size_t)e * WGU_E), D, 1, gbase);
        xpose_matrix(F, u, D, EH, (bf16*)(ws + WS_WGU + (size_t)e * WGU_E), D, 2, gbase);
        xpose_matrix(F, d, EH, D, (bf16*)(ws + WS_WDN + (size_t)e * WDN_E), EH, 0, gbase);
    }
}

constexpr int NVO_OFF = MISC_OFF + 1024;  static_assert(NVO_OFF == pg8::PG8_NVO_OFF, "nvo");
constexpr int PLAN_OFF = NVO_OFF + 8192;
constexpr int PLAN_TB = PLAN_OFF, PLAN_CN = PLAN_OFF + 66 * 4, PLAN_TE = PLAN_OFF + 132 * 4;
constexpr int MAXTILES = 640;
static_assert(PLAN_TE + MAXTILES * 4 <= LDS_BYTES, "LDS map");

__device__ __forceinline__ float wave_sum(float v, int lane) {
#pragma unroll
    for (int o = 1; o < 64; o <<= 1) v += shx(v, o, lane);
    return v;
}
__device__ __forceinline__ void moe_plan(const Frame& F, const unsigned* cnt) {
    LAS unsigned* tb = (LAS unsigned*)(F.lds + PLAN_TB); LAS unsigned* cn = (LAS unsigned*)(F.lds + PLAN_CN); LAS unsigned* te = (LAS unsigned*)(F.lds + PLAN_TE);
    __syncthreads();
    if (F.tid <= NE) { unsigned run = 0; for (int e = 0; e < F.tid; ++e) run += (__hip_atomic_load(cnt + e, RLX_AGENT) + 255u) >> 8;
        tb[F.tid] = run; cn[F.tid] = F.tid < NE ? __hip_atomic_load(cnt + F.tid, RLX_AGENT) : (unsigned)NTOK; if (F.tid == NE) tb[NE + 1] = run + NTOK / 256; }
    __syncthreads();
    for (int t = F.tid; t < MAXTILES; t += NWAVES * 64) { unsigned e = 0; for (int q = 1; q <= NE; ++q) if (tb[q] <= (unsigned)t) e = q; te[t] = e; }
    __syncthreads();
}
template <bool GU> struct MoeSched { static constexpr bool GATHER = GU;
    const LAS unsigned* tb; const LAS unsigned* cn; const LAS unsigned* te; int nunits, nN, G, c; const char* Abase; const char* Bbase; const int* list;
    __device__ __forceinline__ void init(const Frame& F, const void* A_, const void* B_, const int* list_) {
        tb = (const LAS unsigned*)(F.lds + PLAN_TB); cn = (const LAS unsigned*)(F.lds + PLAN_CN); te = (const LAS unsigned*)(F.lds + PLAN_TE);
        nN = GU ? 4 : 8; nunits = (int)tb[NE + 1] * nN; G = F.G; const int bx = blockIdx.x; c = (G % 8 == 0) ? (bx % 8) * (G / 8) + bx / 8 : bx;
        Abase = (const char*)A_; Bbase = (const char*)B_; list = list_; }
    __device__ __forceinline__ bool next(int i, Unit& u) const {
        const int L = i * G + c; if (L >= nunits) return false;
        const int tile = L / nN, pn = L % nN; const int e = (int)te[tile];
        u.pm = tile; u.pn = pn;
        if (GU) { u.A = Abase; u.B = Bbase + (size_t)e * WGU_E + (size_t)pn * 256 * D * 2; u.list = e < NE ? list + (size_t)e * LISTCAP : nullptr; u.m0 = (tile - (int)tb[e]) * 256; u.cnt = (int)cn[e]; }
        else { u.A = Abase + (size_t)tile * 256 * EH * 2; u.B = Bbase + (size_t)e * WDN_E + (size_t)pn * 256 * EH * 2; u.list = nullptr; u.m0 = 0; u.cnt = 0; }
        return true; }
    __device__ __forceinline__ unsigned avoff(const Unit& u, int h, int R, int C, int K_) const {
        if (GU) { const int pos = u.m0 + h * 128 + R; int row = 0; if (pos < u.cnt) row = u.list ? u.list[pos] : pos; return (unsigned)((row * K_ + C) * 2); }
        else return (unsigned)(((h * 128 + R) * K_ + C) * 2); }
};
struct EpiSwiGLU { static constexpr bool PERM = true; bf16* H;
    __device__ __forceinline__ void operator()(const Acc& acc, const Unit& u, int wr, int wc, int fr, int fq) const {
        const int row0 = u.pm * 256 + wr * 64 + fr, col0 = u.pn * 128 + wc * 32 + 8 * fq;
#pragma unroll
        for (int ai = 0; ai < 2; ++ai)
#pragma unroll
            for (int m = 0; m < 4; ++m) { bf16* rowp = H + (size_t)(row0 + ai * 128 + m * 16) * EH + col0;
                float hv[8];
#pragma unroll
                for (int n = 0; n < 2; ++n)
#pragma unroll
                    for (int j = 0; j < 4; ++j) { const float g = acc[ai][0][m][n][j], uu = acc[ai][1][m][n][j]; hv[n * 4 + j] = g * pg8::sigmoidf_(g) * uu; }
                v4u w; w.x = pk2(hv[0], hv[1]); w.y = pk2(hv[2], hv[3]); w.z = pk2(hv[4], hv[5]); w.w = pk2(hv[6], hv[7]);
                *(v4u*)rowp = w; }
    }
};

__device__ __forceinline__ void route_phase(const Frame& F0, const float* Z, const float* g, const float* bb, const float* rw, const float* rb,
                                            float* X1F, bf16* X1BF, unsigned* cnt, int* list, int* tokslot, float* tokw) {
    Frame F = F0; F.tid = opaque_v(F0.tid); F.lane = F.tid & 63;
    LAS float* lg = (LAS float*)(F.lds + RING_OFF);
    LAS float* sl = lg + 64 * 65;
    LAS unsigned* cntL = (LAS unsigned*)(sl + 64 * 65);
    LAS unsigned* baseL = cntL + 64;
    LAS unsigned* ee = baseL + 64;
    LAS unsigned* pl = ee + 512;
    LAS float* ww = (LAS float*)(pl + 512);
    for (int grp = blockIdx.x; grp < NTOK / 64; grp += F.G) {
        const int t0 = grp * 64;
        if (F.tid < 64) cntL[F.tid] = 0u;
        for (int q = 0; q < 8; ++q) {
            const int t = t0 + F.wave * 8 + q;
            const f32x4* zr = (const f32x4*)(Z + (size_t)t * D) + F.lane;
            f32x4 v[8]; float s = 0.f;
#pragma unroll
            for (int j = 0; j < 8; ++j) { v[j] = zr[64 * j]; s += (v[j][0] + v[j][1]) + (v[j][2] + v[j][3]); }
            const float mean = wave_sum(s, F.lane) * (1.f / D); float s2 = 0.f;
#pragma unroll
            for (int j = 0; j < 8; ++j) { v[j] = v[j] - mean; s2 += (v[j][0] * v[j][0] + v[j][1] * v[j][1]) + (v[j][2] * v[j][2] + v[j][3] * v[j][3]); }
            const float rstd = 1.f / sqrtf(wave_sum(s2, F.lane) * (1.f / D) + LN_EPS);
            f32x4* xo = (f32x4*)(X1F + (size_t)t * D) + F.lane; v2u* xb = (v2u*)(X1BF + (size_t)t * D) + F.lane;
#pragma unroll
            for (int j = 0; j < 8; ++j) { const f32x4 gg = ((const f32x4*)g)[F.lane + 64 * j], bv = ((const f32x4*)bb)[F.lane + 64 * j];
                const f32x4 y = v[j] * rstd * gg + bv; xo[64 * j] = y; v2u w; w.x = pk2(y[0], y[1]); w.y = pk2(y[2], y[3]); xb[64 * j] = w; }
        }
        VM_WAIT(); __syncthreads();
        if (F.wave < 4) {
            const int r = F.lane & 15, q = F.lane >> 4;
            const float* xa = X1F + (size_t)(t0 + F.wave * 16 + r) * D + 4 * q;
            const float* wb = rw + (size_t)(4 * q) * NE + 4 * r;
            f32x4 a0 = {0.f, 0.f, 0.f, 0.f}, a1 = a0, a2 = a0, a3 = a0;
#pragma unroll 2
            for (int i = 0; i < D / 16; ++i) {
                const f32x4 xv = *(const f32x4*)(xa + 16 * i);
#pragma unroll
                for (int jj = 0; jj < 4; ++jj) { const f32x4 wv = *(const f32x4*)(wb + (size_t)(16 * i + jj) * NE);
                    a0 = __builtin_amdgcn_mfma_f32_16x16x4f32(xv[jj], wv[0], a0, 0, 0, 0); a1 = __builtin_amdgcn_mfma_f32_16x16x4f32(xv[jj], wv[1], a1, 0, 0, 0);
                    a2 = __builtin_amdgcn_mfma_f32_16x16x4f32(xv[jj], wv[2], a2, 0, 0, 0); a3 = __builtin_amdgcn_mfma_f32_16x16x4f32(xv[jj], wv[3], a3, 0, 0, 0); }
            }
#pragma unroll
            for (int reg = 0; reg < 4; ++reg) { LAS float* o = lg + (F.wave * 16 + 4 * q + reg) * 65 + 4 * r; o[0] = a0[reg]; o[1] = a1[reg]; o[2] = a2[reg]; o[3] = a3[reg]; }
        }
        __syncthreads();
        for (int i = F.tid; i < 64 * 64; i += NWAVES * 64) { const int tk = i >> 6, e = i & 63; const float sc = 1.f / (1.f + __expf(-lg[tk * 65 + e])); lg[tk * 65 + e] = sc; sl[tk * 65 + e] = sc + rb[e]; }
        __syncthreads();
        if (F.tid < 64) {
            const LAS float* srow = sl + F.tid * 65; const LAS float* crow = lg + F.tid * 65;
            float gs[8];
#pragma unroll
            for (int gq = 0; gq < 8; ++gq) { float m1 = -INFINITY, m2 = -INFINITY;
#pragma unroll
                for (int j = 0; j < 8; ++j) { const float x = srow[gq * 8 + j]; if (x > m1) { m2 = m1; m1 = x; } else if (x > m2) m2 = x; }
                gs[gq] = m1 + m2; }
            unsigned gmask = 0;
#pragma unroll
            for (int i = 0; i < 4; ++i) { int best = 0; float bv = -INFINITY;
#pragma unroll
                for (int gq = 0; gq < 8; ++gq) { const bool ok = !((gmask >> gq) & 1u) && gs[gq] > bv; bv = ok ? gs[gq] : bv; best = ok ? gq : best; }
                gmask |= 1u << best; }
            unsigned long long chosen = 0ull; float wsum = 0.f;
            for (int i = 0; i < 8; ++i) { int best = 0; float bv = -INFINITY;
                for (int e = 0; e < 64; ++e) { const float x = srow[e]; const bool ok = ((gmask >> (e >> 3)) & 1u) && !((chosen >> e) & 1ull) && x > bv; bv = ok ? x : bv; best = ok ? e : best; }
                chosen |= 1ull << best; const float sc = crow[best]; wsum += sc;
                ee[F.tid * 8 + i] = (unsigned)best; ww[F.tid * 8 + i] = sc; pl[F.tid * 8 + i] = __hip_atomic_fetch_add(cntL + best, 1u, __ATOMIC_RELAXED, __HIP_MEMORY_SCOPE_WORKGROUP); }
            const float inv = RSCALE / wsum;
            for (int i = 0; i < 8; ++i) ww[F.tid * 8 + i] *= inv;
        }
        __syncthreads();
        if (F.tid < 64) { const unsigned n = cntL[F.tid]; baseL[F.tid] = n ? __hip_atomic_fetch_add(cnt + F.tid, n, RLX_AGENT) : 0u; }
        __syncthreads();
        { const int tk = F.tid >> 3, i = F.tid & 7; const unsigned e = ee[F.tid]; const unsigned pos = baseL[e] + pl[F.tid]; const int t = t0 + tk;
          list[(size_t)e * LISTCAP + pos] = t; tokslot[t * 8 + i] = (int)(e * LISTCAP + pos); tokw[t * 8 + i] = ww[F.tid]; }
        __syncthreads();
    }
}
__device__ __forceinline__ void combine_phase(const Frame& F0, const float* X1F, const bf16* Y, const int* tokslot, const float* tokw, const float* g, const float* bb, float* OUT, bf16* XBF) {
    Frame F = F0; F.tid = opaque_v(F0.tid); F.lane = F.tid & 63;
    const LAS unsigned* tb = (const LAS unsigned*)(F.lds + PLAN_TB);
    for (int t = F.gw; t < NTOK; t += F.NGW) {
        int rowi[9]; float wt[9];
#pragma unroll
        for (int i = 0; i < 8; ++i) { const int sl = tokslot[t * 8 + i]; rowi[i] = (int)tb[sl / LISTCAP] * 256 + (sl % LISTCAP); wt[i] = tokw[t * 8 + i]; }
        rowi[8] = (int)tb[NE] * 256 + t; wt[8] = 1.f;
        const f32x4* xr = (const f32x4*)(X1F + (size_t)t * D) + F.lane;
        f32x4 v[8]; float s = 0.f;
#pragma unroll
        for (int j = 0; j < 8; ++j) v[j] = xr[64 * j] * ALPHA;
#pragma unroll
        for (int i = 0; i < 9; ++i) { const v2u* yr = (const v2u*)(Y + (size_t)rowi[i] * D) + F.lane;
#pragma unroll
            for (int j = 0; j < 8; ++j) { const v2u w = yr[64 * j]; v[j][0] += wt[i] * pg8::bf_lo(w.x); v[j][1] += wt[i] * pg8::bf_hi(w.x); v[j][2] += wt[i] * pg8::bf_lo(w.y); v[j][3] += wt[i] * pg8::bf_hi(w.y); } }
#pragma unroll
        for (int j = 0; j < 8; ++j) s += (v[j][0] + v[j][1]) + (v[j][2] + v[j][3]);
        const float mean = wave_sum(s, F.lane) * (1.f / D); float s2 = 0.f;
#pragma unroll
        for (int j = 0; j < 8; ++j) { v[j] = v[j] - mean; s2 += (v[j][0] * v[j][0] + v[j][1] * v[j][1]) + (v[j][2] * v[j][2] + v[j][3] * v[j][3]); }
        const float rstd = 1.f / sqrtf(wave_sum(s2, F.lane) * (1.f / D) + LN_EPS);
        f32x4* xo = (f32x4*)(OUT + (size_t)t * D) + F.lane; v2u* xb = (v2u*)(XBF + (size_t)t * D) + F.lane;
#pragma unroll
        for (int j = 0; j < 8; ++j) { const f32x4 gg = ((const f32x4*)g)[F.lane + 64 * j], bv = ((const f32x4*)bb)[F.lane + 64 * j];
            const f32x4 y = v[j] * rstd * gg + bv; xo[64 * j] = y; v2u w; w.x = pk2(y[0], y[1]); w.y = pk2(y[2], y[3]); xb[64 * j] = w; }
    }
}
constexpr size_t R2_UT = 0, R2_OI = 48 * MiB, R2_QP = 96 * MiB, R2_DEC = 120 * MiB;
constexpr int NHU = NB * HGH * (SEQ / 64);
typedef __attribute__((address_space(3))) bf16 lbf16;
__device__ __forceinline__ void unpack8(const v4u w, float (&f)[8]) {
    f[0] = pg8::bf_lo(w.x); f[1] = pg8::bf_hi(w.x); f[2] = pg8::bf_lo(w.y); f[3] = pg8::bf_hi(w.y); f[4] = pg8::bf_lo(w.z); f[5] = pg8::bf_hi(w.z); f[6] = pg8::bf_lo(w.w); f[7] = pg8::bf_hi(w.w); }
__device__ __forceinline__ float exp_c(float x) { return __expf(fminf(x, 80.f)); }

__device__ __forceinline__ void conv_part(const Frame& F, const bf16* proj, const float* cw, bf16* YA) {
    for (int i = blockIdx.x * 512 + F.tid; i < NTOK * (CW / 8); i += F.G * 512) {
        const int t = i / (CW / 8), c = (i % (CW / 8)) * 8, pos = t & (SEQ - 1);
        const bf16* r = proj + (size_t)t * INC;
        float u0[8], c0[8], b0[8], u1[8], c1[8], u2[8], c2[8], w0[8], w1[8], w2[8];
        unpack8(*(const v4u*)(r + C_U + c), u0); unpack8(*(const v4u*)(r + C_C + c), c0); unpack8(*(const v4u*)(r + C_B + c), b0);
        const v4u z4 = {0u, 0u, 0u, 0u};
        unpack8(pos >= 1 ? *(const v4u*)(r - INC + C_U + c) : z4, u1); unpack8(pos >= 1 ? *(const v4u*)(r - INC + C_C + c) : z4, c1);
        unpack8(pos >= 2 ? *(const v4u*)(r - 2 * INC + C_U + c) : z4, u2); unpack8(pos >= 2 ? *(const v4u*)(r - 2 * INC + C_C + c) : z4, c2);
#pragma unroll
        for (int j = 0; j < 8; ++j) { w0[j] = cw[c + j]; w1[j] = cw[CW + c + j]; w2[j] = cw[2 * CW + c + j]; }
        float o[8];
#pragma unroll
        for (int j = 0; j < 8; ++j) o[j] = b0[j] * (w2[j] * c0[j] * u0[j] + w1[j] * c1[j] * u1[j] + w0[j] * c2[j] * u2[j]);
        v4u w; w.x = pk2(o[0], o[1]); w.y = pk2(o[2], o[3]); w.z = pk2(o[4], o[5]); w.w = pk2(o[6], o[7]);
        *(v4u*)(YA + (size_t)t * CW + c) = w;
    }
}

__device__ __forceinline__ void hgrn_local(const Frame& F, const bf16* proj, const float* lbl, int layer, unsigned char* r2) {
    lbf16* QS = (lbf16*)(F.lds);
    lbf16* KS = QS + 64 * 136;
    lbf16* KPT = KS + 64 * 136;
    lbf16* VT = KPT + 128 * 72;
    lbf16* PS = VT + 128 * 72;
    LAS float* SEG = (LAS float*)(PS + 64 * 72);
    bf16* UT = (bf16*)(r2 + R2_UT); float* OI = (float*)(r2 + R2_OI); bf16* QP = (bf16*)(r2 + R2_QP); float* DEC = (float*)(r2 + R2_DEC);
    const int lane = F.lane, wv = F.wave, r = lane & 15, kq = lane >> 4;
    for (int unit = blockIdx.x; unit < NHU; unit += F.G) {
        const int b = unit / (HGH * 64), h = (unit / 64) % HGH, c = unit % 64, t0 = b * SEQ + c * 64;
        { const int col = F.tid & 127, seg = F.tid >> 7, ch = h * HGD + col;
          float lb = 0.f; if (layer == 1) lb = 1.f / (1.f + __expf(lbl[ch] - lbl[HGW + ch]));
          float a[16], kk[16], qv[16], vv[16]; float run = 0.f;
#pragma unroll
          for (int i = 0; i < 16; ++i) { const bf16* p = proj + (size_t)(t0 + seg * 16 + i) * INC;
              const float z = bf2f(p[C_F + ch]); const float ez = __expf(-z); const float sg = 1.f / (1.f + ez);
              const float f = lb + (1.f - lb) * sg; kk[i] = (1.f - lb) * ez * sg; run += fmaxf(__logf(f), -60.f); a[i] = run;
              qv[i] = bf2f(p[C_Q + ch]); vv[i] = bf2f(p[C_I + ch]); }
          SEG[seg * 128 + col] = run;
          __syncthreads();
          const float s0 = SEG[col], s1 = SEG[128 + col], s2 = SEG[256 + col], s3 = SEG[384 + col];
          const float base = seg == 0 ? 0.f : (seg == 1 ? s0 : (seg == 2 ? s0 + s1 : s0 + s1 + s2)), bm = s0 + s1, bl = (s0 + s1) + (s2 + s3);
          float kp[16];
#pragma unroll
          for (int i = 0; i < 16; ++i) { const float bb = base + a[i]; const int t = seg * 16 + i;
              QS[t * 136 + col] = f2bf(qv[i] * exp_c(bb - bm)); KS[t * 136 + col] = f2bf(kk[i] * exp_c(bm - bb)); kp[i] = kk[i] * exp_c(bl - bb);
              QP[(size_t)(t0 + t) * HGW + ch] = f2bf(qv[i] * exp_c(bb)); }
          v4u w0, w1; w0.x = pk2(kp[0], kp[1]); w0.y = pk2(kp[2], kp[3]); w0.z = pk2(kp[4], kp[5]); w0.w = pk2(kp[6], kp[7]); w1.x = pk2(kp[8], kp[9]); w1.y = pk2(kp[10], kp[11]); w1.z = pk2(kp[12], kp[13]); w1.w = pk2(kp[14], kp[15]);
          *(LAS v4u*)(KPT + col * 72 + seg * 16) = w0; *(LAS v4u*)(KPT + col * 72 + seg * 16 + 8) = w1;
          w0.x = pk2(vv[0], vv[1]); w0.y = pk2(vv[2], vv[3]); w0.z = pk2(vv[4], vv[5]); w0.w = pk2(vv[6], vv[7]); w1.x = pk2(vv[8], vv[9]); w1.y = pk2(vv[10], vv[11]); w1.z = pk2(vv[12], vv[13]); w1.w = pk2(vv[14], vv[15]);
          *(LAS v4u*)(VT + col * 72 + seg * 16) = w0; *(LAS v4u*)(VT + col * 72 + seg * 16 + 8) = w1;
          if (seg == 0) DEC[(size_t)unit * 128 + col] = exp_c(bl);
        }
        __syncthreads();
        { const int tm = wv >> 1, tn0 = (wv & 1) * 2;
          bf16x8 af[4];
#pragma unroll
          for (int ks = 0; ks < 4; ++ks) af[ks] = *(const LAS bf16x8*)(QS + (tm * 16 + r) * 136 + ks * 32 + kq * 8);
#pragma unroll
          for (int jn = 0; jn < 2; ++jn) { const int tn = tn0 + jn; f32x4 acc = {0.f, 0.f, 0.f, 0.f};
              if (tn <= tm) {
#pragma unroll
                  for (int ks = 0; ks < 4; ++ks) { const bf16x8 bf = *(const LAS bf16x8*)(KS + (tn * 16 + r) * 136 + ks * 32 + kq * 8); acc = __builtin_amdgcn_mfma_f32_16x16x32_bf16(af[ks], bf, acc, 0, 0, 0); } }
#pragma unroll
              for (int g = 0; g < 4; ++g) { const int t = tm * 16 + 4 * kq + g, s = tn * 16 + r; PS[t * 72 + s] = f2bf(s <= t ? acc[g] : 0.f); } } }
        { bf16x8 af[2];
#pragma unroll
          for (int ks = 0; ks < 2; ++ks) af[ks] = *(const LAS bf16x8*)(KPT + (wv * 16 + r) * 72 + ks * 32 + kq * 8);
#pragma unroll
          for (int tv = 0; tv < 8; ++tv) { f32x4 acc = {0.f, 0.f, 0.f, 0.f};
#pragma unroll
              for (int ks = 0; ks < 2; ++ks) { const bf16x8 bf = *(const LAS bf16x8*)(VT + (tv * 16 + r) * 72 + ks * 32 + kq * 8); acc = __builtin_amdgcn_mfma_f32_16x16x32_bf16(af[ks], bf, acc, 0, 0, 0); }
              v2u w; w.x = pk2(acc[0], acc[1]); w.y = pk2(acc[2], acc[3]);
              *(v2u*)(UT + (size_t)unit * 16384 + (tv * 16 + r) * 128 + wv * 16 + 4 * kq) = w; } }
        __syncthreads();
        { const int tm = wv & 3, tvg = wv >> 2;
          bf16x8 af[2];
#pragma unroll
          for (int ks = 0; ks < 2; ++ks) af[ks] = *(const LAS bf16x8*)(PS + (tm * 16 + r) * 72 + ks * 32 + kq * 8);
#pragma unroll
          for (int j = 0; j < 4; ++j) { const int tv = tvg * 4 + j; f32x4 acc = {0.f, 0.f, 0.f, 0.f};
#pragma unroll
              for (int ks = 0; ks < 2; ++ks) { const bf16x8 bf = *(const LAS bf16x8*)(VT + (tv * 16 + r) * 72 + ks * 32 + kq * 8); acc = __builtin_amdgcn_mfma_f32_16x16x32_bf16(af[ks], bf, acc, 0, 0, 0); }
#pragma unroll
              for (int g = 0; g < 4; ++g) OI[(size_t)(t0 + tm * 16 + 4 * kq + g) * HGW + h * HGD + tv * 16 + r] = acc[g]; } }
        __syncthreads();
    }
}
__device__ __forceinline__ void hgrn_scan(const Frame& F, const unsigned char* r2, unsigned* __restrict__ SB32) {
    const unsigned* __restrict__ UT32 = (const unsigned*)(r2 + R2_UT); const float* __restrict__ DEC = (const float*)(r2 + R2_DEC);
    for (int it = blockIdx.x * 512 + F.tid; it < NB * HGH * 128 * 64; it += F.G * 512) {
        const int bh = it >> 13, v = (it >> 6) & 127, k2 = it & 63;
        float s0 = 0.f, s1 = 0.f;
#pragma unroll 8
        for (int c = 0; c < 64; ++c) { const size_t unit = (size_t)bh * 64 + c; const size_t idx = unit * 8192 + v * 64 + k2;
            const unsigned w = UT32[idx]; const float d0 = DEC[unit * 128 + 2 * k2], d1 = DEC[unit * 128 + 2 * k2 + 1];
            SB32[idx] = pk2(s0, s1);
            s0 = d0 * s0 + pg8::bf_lo(w); s1 = d1 * s1 + pg8::bf_hi(w); }
    }
}
__device__ __forceinline__ void hgrn_out(const Frame& F, const bf16* proj, const unsigned char* r2, const bf16* SB, const float* gain, bf16* YB) {
    LAS float* SSQ = (LAS float*)F.lds;
    const float* OI = (const float*)(r2 + R2_OI); const bf16* QP = (const bf16*)(r2 + R2_QP);
    const int lane = F.lane, wv = F.wave, r = lane & 15, kq = lane >> 4, tm = wv & 3, tvg = wv >> 2;
    for (int unit = blockIdx.x; unit < NHU; unit += F.G) {
        const int b = unit / (HGH * 64), h = (unit / 64) % HGH, c = unit % 64, t0 = b * SEQ + c * 64;
        f32x4 acc[4];
#pragma unroll
        for (int j = 0; j < 4; ++j) acc[j] = (f32x4){0.f, 0.f, 0.f, 0.f};
        if (c > 0) {
            bf16x8 af[4];
#pragma unroll
            for (int ks = 0; ks < 4; ++ks) af[ks] = *(const bf16x8*)(QP + (size_t)(t0 + tm * 16 + r) * HGW + h * HGD + ks * 32 + kq * 8);
#pragma unroll
            for (int j = 0; j < 4; ++j)
#pragma unroll
                for (int ks = 0; ks < 4; ++ks) { const bf16x8 bf = *(const bf16x8*)(SB + (size_t)unit * 16384 + ((tvg * 4 + j) * 16 + r) * 128 + ks * 32 + kq * 8);
                    acc[j] = __builtin_amdgcn_mfma_f32_16x16x32_bf16(af[ks], bf, acc[j], 0, 0, 0); }
        }
        float q[4];
#pragma unroll
        for (int g = 0; g < 4; ++g) { q[g] = 0.f;
#pragma unroll
            for (int j = 0; j < 4; ++j) { const float o = acc[j][g] + OI[(size_t)(t0 + tm * 16 + 4 * kq + g) * HGW + h * HGD + (tvg * 4 + j) * 16 + r]; acc[j][g] = o; q[g] += o * o; }
            q[g] += shx(q[g], 1, lane); q[g] += shx(q[g], 2, lane); q[g] += shx(q[g], 4, lane); q[g] += shx(q[g], 8, lane);
            if (r == 0) SSQ[tvg * 64 + tm * 16 + 4 * kq + g] = q[g]; }
        __syncthreads();
#pragma unroll
        for (int g = 0; g < 4; ++g) { const int t = tm * 16 + 4 * kq + g; const float rs = rsqrtf((SSQ[t] + SSQ[64 + t]) * (1.f / 128.f) + RMS_EPS);
#pragma unroll
            for (int j = 0; j < 4; ++j) { const int ch = h * HGD + (tvg * 4 + j) * 16 + r; const float gt = bf2f(proj[(size_t)(t0 + t) * INC + C_G + ch]);
                YB[(size_t)(t0 + t) * HGW + ch] = f2bf(acc[j][g] * rs * gain[ch] * gt * pg8::sigmoidf_(gt)); } }
        __syncthreads();
    }
}
__device__ __forceinline__ void memattn(const Frame& F, const bf16* proj, const bf16* KV, int layer, bf16* YX) {
    lbf16* Ks = (lbf16*)F.lds;
    lbf16* VTs = Ks + 256 * 136;
    const int lane = F.lane, wv = F.wave, r = lane & 15, kq = lane >> 4;
    for (int unit = blockIdx.x; unit < NB * XAH * (SEQ / 256); unit += F.G) {
        const int b = unit >> 6, hd = (unit >> 4) & 3, qt = unit & 15;
#pragma unroll
        for (int i = 0; i < 8; ++i) { const int p = F.tid + 512 * i, key = p >> 4, dc = (p & 15) * 8;
            const bf16* src = KV + (size_t)(b * NMEM + key) * 2048 + layer * 1024 + hd * XAD + dc;
            *(LAS v4u*)(Ks + key * 136 + dc) = *(const v4u*)src;
            const v4u w = *(const v4u*)(src + 512);
            const int k5 = key & 31, pos = (key & ~31) + 8 * ((k5 >> 2) & 3) + 4 * ((k5 >> 4) & 1) + (k5 & 3);
            lbf16* d = VTs + dc * 264 + pos;
            d[0] = (bf16)(w.x & 0xffffu); d[264] = (bf16)(w.x >> 16); d[2 * 264] = (bf16)(w.y & 0xffffu); d[3 * 264] = (bf16)(w.y >> 16);
            d[4 * 264] = (bf16)(w.z & 0xffffu); d[5 * 264] = (bf16)(w.z >> 16); d[6 * 264] = (bf16)(w.w & 0xffffu); d[7 * 264] = (bf16)(w.w >> 16); }
        __syncthreads();
#pragma unroll 1
        for (int g = 0; g < 2; ++g) {
            const int t = b * SEQ + qt * 256 + wv * 32 + g * 16 + r;
            bf16x8 qf[4];
#pragma unroll
            for (int ks = 0; ks < 4; ++ks) qf[ks] = *(const bf16x8*)(proj + (size_t)t * INC + C_QX + hd * XAD + ks * 32 + kq * 8);
            f32x4 s[16];
#pragma unroll
            for (int kt = 0; kt < 16; ++kt) { s[kt] = (f32x4){0.f, 0.f, 0.f, 0.f};
#pragma unroll
                for (int ks = 0; ks < 4; ++ks) { const bf16x8 a = *(const LAS bf16x8*)(Ks + (kt * 16 + r) * 136 + ks * 32 + kq * 8); s[kt] = __builtin_amdgcn_mfma_f32_16x16x32_bf16(a, qf[ks], s[kt], 0, 0, 0); }
                if (kt & 1) __builtin_amdgcn_sched_barrier(0); }
            float m = -1e30f;
#pragma unroll
            for (int kt = 0; kt < 16; ++kt) m = fmaxf(m, fmaxf(fmaxf(s[kt][0], s[kt][1]), fmaxf(s[kt][2], s[kt][3])));
            m = fmaxf(m, shx(m, 16, lane)); m = fmaxf(m, shx(m, 32, lane));
            const float cs = 0.08838834764831845f * 1.4426950408889634f; float l = 0.f;
#pragma unroll
            for (int kt = 0; kt < 16; ++kt)
#pragma unroll
                for (int e = 0; e < 4; ++e) { const float p = __builtin_amdgcn_exp2f((s[kt][e] - m) * cs); s[kt][e] = p; l += p; }
            l += shx(l, 16, lane); l += shx(l, 32, lane);
            f32x4 o[8];
#pragma unroll
            for (int dt = 0; dt < 8; ++dt) o[dt] = (f32x4){0.f, 0.f, 0.f, 0.f};
#pragma unroll
            for (int j = 0; j < 8; ++j) {
                v4u pw; pw.x = pk2(s[2 * j][0], s[2 * j][1]); pw.y = pk2(s[2 * j][2], s[2 * j][3]); pw.z = pk2(s[2 * j + 1][0], s[2 * j + 1][1]); pw.w = pk2(s[2 * j + 1][2], s[2 * j + 1][3]);
                const bf16x8 pf = __builtin_bit_cast(bf16x8, pw);
#pragma unroll
                for (int dt = 0; dt < 8; ++dt) { const bf16x8 a = *(const LAS bf16x8*)(VTs + (dt * 16 + r) * 264 + j * 32 + kq * 8); o[dt] = __builtin_amdgcn_mfma_f32_16x16x32_bf16(a, pf, o[dt], 0, 0, 0); }
                __builtin_amdgcn_sched_barrier(0); }
            const float inv = 1.f / l;
#pragma unroll
            for (int dt = 0; dt < 8; ++dt) { v2u w; w.x = pk2(o[dt][0] * inv, o[dt][1] * inv); w.y = pk2(o[dt][2] * inv, o[dt][3] * inv);
                *(v2u*)(YX + (size_t)t * XAW + hd * XAD + dt * 16 + 4 * kq) = w; }
        }
        __syncthreads();
    }
}
struct Args { const float* in[24]; float* out; unsigned char* ws; int ph_lo, ph_hi, mask, pad; };
typedef const __attribute__((address_space(4))) Args* KArgs;
__device__ __forceinline__ KArgs kargs() { KArgs p = (KArgs)__builtin_amdgcn_kernarg_segment_ptr(); asm volatile("" : "+s"(p)); return p; }
#define WSP(T, off) ((T*)(ws + (off)))
__global__ void __launch_bounds__(NWAVES * 64, 2) mk_fwd(Args args) {
    extern __shared__ __attribute__((aligned(16))) unsigned char lds_raw[];
    Frame F0; F0.lds = (LAS unsigned char*)lds_raw; F0.tid = threadIdx.x; F0.lane = F0.tid & 63; F0.wave = __builtin_amdgcn_readfirstlane(F0.tid >> 6);
    F0.G = gridDim.x; F0.gw = blockIdx.x * NWAVES + F0.wave; F0.NGW = F0.G * NWAVES;
    volatile LAS unsigned* MISC = (volatile LAS unsigned*)(F0.lds + MISC_OFF);
    for (int u = F0.tid; u < (LDS_BYTES - MISC_OFF) / 4; u += NWAVES * 64) ((LAS unsigned*)(F0.lds + MISC_OFF))[u] = 0u;
    __syncthreads();
    const int lo = args.ph_lo, hi = args.ph_hi;
    const bool multi = (hi - lo) > 1;
    XcdBarrier bar; bar.bar = (unsigned*)(args.ws + WS_CTL) + CW_BAR; bar.x = 0; bar.st = nullptr;
    if (multi) bar = xcd_barrier_post((unsigned*)(args.ws + WS_CTL) + CW_BAR, MISC + 8);
#define IN(k) (lo <= (k) && (k) < hi)
#define SEAM(k) do { if (IN((k) + 1)) xcd_barrier(bar); } while (0)
#define PH_BEGIN KArgs ka = kargs(); unsigned char* ws = ka->ws; (void)ws; Frame F = F0; F.tid = opaque_v(F0.tid); F.lane = F.tid & 63

    if (IN(PH_CVT)) { PH_BEGIN;
        unsigned gb = 0;
        for (int l = 0; l < 2; ++l) {
            xpose_matrix(F, ka->in[2] + (size_t)l * D * INC, D, INC, (bf16*)(ws + WS_WIN_T + l * WIN_T_L), D, 0, gb);
            xpose_matrix(F, ka->in[4] + (size_t)l * CW * D, CW, D, (bf16*)(ws + WS_WBR_T + l * WBR_T_L), CW, 0, gb);
            xpose_matrix(F, ka->in[7] + (size_t)l * HGW * D, HGW, D, (bf16*)(ws + WS_WBR_T + l * WBR_T_L + 3 * MiB), HGW, 0, gb);
            xpose_matrix(F, ka->in[10] + (size_t)l * XAW * D, XAW, D, (bf16*)(ws + WS_WBR_T + l * WBR_T_L + 6 * MiB), XAW, 0, gb);
            xpose_matrix(F, ka->in[11] + (size_t)l * D * D, D, D, (bf16*)(ws + WS_WO_T + l * WO_T_L), D, 0, gb);
            xpose_matrix(F, ka->in[8] + (size_t)l * D * XAW, D, XAW, (bf16*)(ws + WS_WKV_T) + (size_t)(l * 1024) * D, D, 0, gb);
            xpose_matrix(F, ka->in[9] + (size_t)l * D * XAW, D, XAW, (bf16*)(ws + WS_WKV_T) + (size_t)(l * 1024 + 512) * D, D, 0, gb);
        }
        cvt_experts(F, ka->in[16], ka->in[17], ka->in[18], ka->in[19], ka->in[20], ka->in[21], ws, gb);
        cvt_rows(F, ka->in[0], WSP(bf16, WS_XBF), (size_t)NTOK * D / 8);
        cvt_rows(F, ka->in[1], WSP(bf16, WS_MEMBF), (size_t)NB * NMEM * D / 8);
        SEAM(PH_CVT);
    }
    if (IN(PH_MEMKV)) { PH_BEGIN;
        DenseSched S; S.init(ws + WS_MEMBF, ws + WS_WKV_T, NB * NMEM, 2048, D, F.G, (int)blockIdx.x);
        EpiBf16Plain E{WSP(bf16, WS_KV), 2048};
        pg8::gemm_phase<EpiBf16Plain, DenseSched, true>(F.lds + RING_OFF, D, S, E);
        SEAM(PH_MEMKV);
    }
    for (int l = 0; l < 2; ++l) {
        const int pb = PH_L0 + l * PH_PER_LAYER;
        if (IN(pb + P_INPROJ)) { PH_BEGIN;
            DenseSched S; S.init(ws + WS_XBF, ws + WS_WIN_T + l * WIN_T_L, NTOK, INC, D, F.G, (int)blockIdx.x);
            EpiBf16Plain E{WSP(bf16, WS_R1), INC};
            pg8::gemm_phase<EpiBf16Plain, DenseSched, true>(F.lds + RING_OFF, D, S, E);
            SEAM(pb + P_INPROJ);
        }
        if (IN(pb + P_MIX)) { PH_BEGIN;
            const int mask = ka->mask;
            if (mask & 1) memattn(F, WSP(bf16, WS_R1), WSP(bf16, WS_KV), l, WSP(bf16, WS_YX));
            if (mask & 2) hgrn_local(F, WSP(bf16, WS_R1), ka->in[5], l, ws + WS_R2);
            if (mask & 4) conv_part(F, WSP(bf16, WS_R1), ka->in[3] + (size_t)l * 3 * CW, WSP(bf16, WS_YA));
            if (l == 1) { unsigned gb = 0; cvt_experts(F, ka->in[16] + (size_t)NE * D * EH, ka->in[17] + (size_t)NE * D * EH, ka->in[18] + (size_t)NE * EH * D, ka->in[19] + (size_t)D * EH, ka->in[20] + (size_t)D * EH, ka->in[21] + (size_t)EH * D, ws, gb); }
            SEAM(pb + P_MIX);
        }
        if (IN(pb + P_SCAN)) { PH_BEGIN;
            hgrn_scan(F, ws + WS_R2, WSP(unsigned, WS_ZF));
            SEAM(pb + P_SCAN);
        }
        if (IN(pb + P_HOUT)) { PH_BEGIN;
            hgrn_out(F, WSP(bf16, WS_R1), ws + WS_R2, WSP(bf16, WS_ZF), ka->in[6] + (size_t)l * HGW, WSP(bf16, WS_YB));
            SEAM(pb + P_HOUT);
        }
        if (IN(pb + P_BRANCH)) { PH_BEGIN;
            { DenseSched S; S.init(ws + WS_YA, ws + WS_WBR_T + l * WBR_T_L, NTOK, D, CW, F.G, (int)blockIdx.x); EpiGate<0> E{WSP(bf16, WS_R1), WSP(float, WS_ZF), WSP(bf16, WS_MERGED), C_GA};
              pg8::gemm_phase<EpiGate<0>, DenseSched, true>(F.lds + RING_OFF, CW, S, E); }
            { DenseSched S; S.init(ws + WS_YB, ws + WS_WBR_T + l * WBR_T_L + 3 * MiB, NTOK, D, HGW, F.G, (int)blockIdx.x); EpiGate<1> E{WSP(bf16, WS_R1), WSP(float, WS_ZF), WSP(bf16, WS_MERGED), C_GB};
              pg8::gemm_phase<EpiGate<1>, DenseSched, true>(F.lds + RING_OFF, HGW, S, E); }
            { DenseSched S; S.init(ws + WS_YX, ws + WS_WBR_T + l * WBR_T_L + 6 * MiB, NTOK, D, XAW, F.G, (int)blockIdx.x); EpiGate<2> E{WSP(bf16, WS_R1), WSP(float, WS_ZF), WSP(bf16, WS_MERGED), C_GX};
              pg8::gemm_phase<EpiGate<2>, DenseSched, true>(F.lds + RING_OFF, XAW, S, E); }
            SEAM(pb + P_BRANCH);
        }
        if (IN(pb + P_WO)) { PH_BEGIN;
            DenseSched S; S.init(ws + WS_MERGED, ws + WS_WO_T + l * WO_T_L, NTOK, D, D, F.G, (int)blockIdx.x);
            EpiResid E{l == 0 ? ka->in[0] : (const float*)ka->out, WSP(float, WS_ZF)};
            pg8::gemm_phase<EpiResid, DenseSched, true>(F.lds + RING_OFF, D, S, E);
            SEAM(pb + P_WO);
        }
        if (IN(pb + P_ROUTE)) { PH_BEGIN;
            route_phase(F, WSP(float, WS_ZF), ka->in[12] + (size_t)l * D, ka->in[13] + (size_t)l * D, ka->in[14] + (size_t)l * D * NE, ka->in[15] + (size_t)l * NE, WSP(float, WS_X1F), WSP(bf16, WS_X1BF),
                        WSP(unsigned, WS_CTL) + CW_CNT + l * 64, WSP(int, WS_LIST), WSP(int, WS_TOKSLOT), WSP(float, WS_TOKW));
            SEAM(pb + P_ROUTE);
        }
        if (IN(pb + P_GU)) { PH_BEGIN;
            moe_plan(F, WSP(unsigned, WS_CTL) + CW_CNT + l * 64);
            MoeSched<true> S; S.init(F, ws + WS_X1BF, ws + WS_WGU, WSP(int, WS_LIST)); EpiSwiGLU E{WSP(bf16, WS_R2)};
            pg8::gemm_phase<EpiSwiGLU, MoeSched<true>, true>(F.lds + RING_OFF, D, S, E);
            SEAM(pb + P_GU);
        }
        if (IN(pb + P_DOWN)) { PH_BEGIN;
            moe_plan(F, WSP(unsigned, WS_CTL) + CW_CNT + l * 64);
            MoeSched<false> S; S.init(F, ws + WS_R2, ws + WS_WDN, nullptr); EpiBf16Plain E{WSP(bf16, WS_R1), D};
            pg8::gemm_phase<EpiBf16Plain, MoeSched<false>, true>(F.lds + RING_OFF, EH, S, E);
            SEAM(pb + P_DOWN);
        }
        if (IN(pb + P_COMB)) { PH_BEGIN;
            moe_plan(F, WSP(unsigned, WS_CTL) + CW_CNT + l * 64);
            combine_phase(F, WSP(float, WS_X1F), WSP(bf16, WS_R1), WSP(int, WS_TOKSLOT), WSP(float, WS_TOKW), ka->in[22] + (size_t)l * D, ka->in[23] + (size_t)l * D, ka->out, WSP(bf16, WS_XBF));
            SEAM(pb + P_COMB);
        }
    }
#undef IN
#undef SEAM
}
static void launch_mk(Args a, int lo, int hi, int grid, hipStream_t stream) {
    a.ph_lo = lo; a.ph_hi = hi;
    hipLaunchKernelGGL(mk_fwd, dim3(grid), dim3(NWAVES * 64), LDS_BYTES, stream, a);
}
extern "C" void kernel_launch(void* const* d_in, const int* in_sizes, int n_in, void* d_out, int out_size, void* d_ws, size_t ws_size, hipStream_t stream) {
    static int grid = 0;
    if (grid == 0) {
        if (n_in != 24 || out_size != NTOK * D || ws_size < WS_END) { fprintf(stderr, "kernel_launch: unexpected sizes n_in %d out %d ws %zu\n", n_in, out_size, ws_size); grid = -1; return; }
        int dev = 0, cus = 0;
        if (hipGetDevice(&dev) != hipSuccess || hipDeviceGetAttribute(&cus, hipDeviceAttributeMultiprocessorCount, dev) != hipSuccess) { grid = -1; return; }
        if (hipFuncSetAttribute((const void*)mk_fwd, hipFuncAttributeMaxDynamicSharedMemorySize, LDS_BYTES) != hipSuccess) { fprintf(stderr, "kernel_launch: hipFuncSetAttribute failed\n"); grid = -1; return; }
        int per_cu = 0; (void)hipOccupancyMaxActiveBlocksPerMultiprocessor(&per_cu, (const void*)mk_fwd, NWAVES * 64, LDS_BYTES); (void)hipGetLastError();
        if (per_cu < 1) fprintf(stderr, "kernel_launch: occupancy query says %d\n", per_cu);
        grid = cus;
    }
    if (grid < 0) return;
    const float* x = (const float*)d_in[0];
    const float* conv_w = (const float*)d_in[3]; const float* lbl = (const float*)d_in[5];
    const float* hg_g = (const float*)d_in[6];
    const float* ln1_g = (const float*)d_in[12]; const float* ln1_b = (const float*)d_in[13]; const float* router_w = (const float*)d_in[14];
    const float* router_b = (const float*)d_in[15]; const float* exp_wg = (const float*)d_in[16]; const float* exp_wu = (const float*)d_in[17];
    const float* exp_wd = (const float*)d_in[18]; const float* sh_wg = (const float*)d_in[19]; const float* sh_wu = (const float*)d_in[20];
    const float* sh_wd = (const float*)d_in[21]; const float* ln2_g = (const float*)d_in[22]; const float* ln2_b = (const float*)d_in[23];
    unsigned char* ws = (unsigned char*)d_ws; float* out = (float*)d_out;
    unsigned* ctl = (unsigned*)(ws + WS_CTL);
    bf16* KV = (bf16*)(ws + WS_KV); bf16* XBF = (bf16*)(ws + WS_XBF); float* X1F = (float*)(ws + WS_X1F);
    bf16* X1BF = (bf16*)(ws + WS_X1BF); float* ZF = (float*)(ws + WS_ZF);
    bf16* YA = (bf16*)(ws + WS_YA); bf16* YB = (bf16*)(ws + WS_YB); bf16* YX = (bf16*)(ws + WS_YX);
    bf16* H = (bf16*)(ws + WS_R2); float* OH = (float*)(ws + WS_R2); bf16* PROJ = (bf16*)(ws + WS_R1); bf16* Y = (bf16*)(ws + WS_R1);
    int* LIST = (int*)(ws + WS_LIST); int* TOKSLOT = (int*)(ws + WS_TOKSLOT); float* TOKW = (float*)(ws + WS_TOKW);
    Args a{};
    for (int i = 0; i < 24; ++i) a.in[i] = (const float*)d_in[i];
    a.out = out; a.ws = ws;

    (void)hipMemsetAsync(ws + WS_CTL, 0, CTL_BYTES, stream);
    a.mask = 7;
    launch_mk(a, 0, N_PHASES, grid, stream);
}
```

```cpp
#include <hip/hip_runtime.h>
#include <stdint.h>
#include <stdio.h>

typedef unsigned short bf16;
__device__ __forceinline__ float bf2f(bf16 v) { return __uint_as_float(((unsigned)v) << 16); }
__device__ __forceinline__ bf16 f2bf(float f) { unsigned u = __float_as_uint(f); return (bf16)((u + 0x7fffu + ((u >> 16) & 1u)) >> 16); }

constexpr int NB = 4, SEQ = 4096, NTOK = NB * SEQ, D = 2048, NMEM = 256;
constexpr int CW = 768, HGW = 768, HGH = 6, HGD = 128, XAW = 512, XAH = 4, XAD = 128;
constexpr int INC = 12032, YXW = 768, GW8 = 3 * 2048, PN_GATE = 23;
constexpr int C_U = 0, C_B = 768, C_C = 1536, C_Q = 2304, C_F = 3072, C_I = 3840, C_G = 4608, C_QX = 5376, C_GA = 5888, C_GB = 7936, C_GX = 9984;
constexpr int NE = 64, TOPK = 8, EH = 512;
constexpr float ALPHA = 1.41421356237f, LN_EPS = 1e-5f, RMS_EPS = 1e-6f, RSCALE = 2.5f;
constexpr int LISTCAP = 16384;

constexpr size_t MiB = 1u << 20;
constexpr size_t WS_CTL = 0, CTL_BYTES = 1 * MiB;
constexpr size_t WS_RW = 1 * MiB, RW_L = 512 * 1024;
constexpr size_t WS_WIN_T = 2 * MiB, WIN_T_L = 47 * MiB;
constexpr size_t WS_WBR_T = 1932 * MiB, WBR_T_L = 9 * MiB;
constexpr size_t WS_WO_T = 112 * MiB, WO_T_L = 8 * MiB;
constexpr size_t WS_WKV_T = 128 * MiB;
constexpr size_t WS_MEMBF = 136 * MiB, WS_KV = 140 * MiB;
constexpr size_t WS_WGU = 144 * MiB, WGU_E = 4 * MiB;
constexpr size_t WS_WDN = 404 * MiB, WDN_E = 2 * MiB;
constexpr size_t WS_XBF = 534 * MiB, WS_X1F = 598 * MiB, WS_X1BF = 726 * MiB, WS_ZF = 790 * MiB, WS_MERGED = 918 * MiB;
constexpr size_t WS_YA = 1860 * MiB, WS_YB = 1884 * MiB, WS_YX = 1908 * MiB;
constexpr size_t WS_R2 = 1046 * MiB;
constexpr size_t WS_R1 = 1214 * MiB;
constexpr size_t WS_LIST = 1854 * MiB, WS_TOKSLOT = 1858 * MiB, WS_TOKW = 1859 * MiB, WS_GATE8 = 1950 * MiB, WS_END = 2046 * MiB;
constexpr int CW_CNT = 1024;
constexpr int CW_PLAN = 2048;
constexpr int CW_BAR = 4096;
#ifndef DBG_MASK
#define DBG_MASK 7
#endif
namespace pg8 {
#define PG8_LAS __attribute__((address_space(3)))
typedef unsigned short bf16_t;
typedef short bf16x8 __attribute__((ext_vector_type(8)));
typedef float f32x4 __attribute__((ext_vector_type(4)));
typedef unsigned u32x4 __attribute__((ext_vector_type(4)));
typedef unsigned u32x2 __attribute__((ext_vector_type(2)));
constexpr int PG8_NVO_OFF = 147456 + 1024;
constexpr int BM = 256, BK = 64, HALF = 128, HTB = HALF * BK * 2  , STAGE_BYTES = 8 * HTB, NXCD = 8, WGM = 8;

__host__ __device__ __forceinline__ int lds_byte(int r, int c) { const int st = (r >> 4) * 2 + (c >> 5), rr = r & 15, cc = c & 31, ob = rr * 64 + cc * 2; return st * 1024 + (ob ^ (((ob >> 9) & 1) << 5)); }
__host__ __device__ __forceinline__ void stage_rc(int b, int& R, int& C) { const int st = b / 1024, sb = b % 1024, swz = sb ^ (((sb >> 9) & 1) << 5); R = (st >> 1) * 16 + swz / 64; C = (st & 1) * 32 + (swz % 64) / 2; }
__host__ __device__ __forceinline__ int perm32(int rho) { const int n = rho >> 4, i = rho & 15; return 8 * (i >> 2) + 4 * n + (i & 3); }

struct Unit { const char* A; const char* B; int pm, pn; const int* list; int m0, cnt; };

typedef float f32x2_ __attribute__((ext_vector_type(2)));
typedef __bf16 bf16x2_ __attribute__((ext_vector_type(2)));
__device__ __forceinline__ unsigned cvt_pk_bf16(float lo, float hi) { const f32x2_ v = {lo, hi}; const bf16x2_ b = __builtin_convertvector(v, bf16x2_); return __builtin_bit_cast(unsigned, b); }
__device__ __forceinline__ int lane_id_opaque() { unsigned m = ~0u; asm volatile("" : "+s"(m)); return (int)__builtin_amdgcn_mbcnt_hi(m, __builtin_amdgcn_mbcnt_lo(m, 0u)); }
__device__ __forceinline__ float bf_lo(unsigned w) { return __uint_as_float(w << 16); }
__device__ __forceinline__ float bf_hi(unsigned w) { return __uint_as_float(w & 0xffff0000u); }
__device__ __forceinline__ float sigmoidf_(float x) { return __builtin_amdgcn_rcpf(1.f + __expf(-x)); }

typedef f32x4 Acc[2][2][4][2];

template <class Epi, class Sched, bool ALIGN_EPI>
__device__ __forceinline__ void gemm_phase(PG8_LAS unsigned char* lds, const int wave, const int K_in, const Sched& S, const Epi& E) {
    const int lane = lane_id_opaque(), wid = wave, tid = wid * 64 + lane, wr = wid >> 2, wc = wid & 3, fr = lane & 15, fq = lane >> 4;
    int K = K_in; asm volatile("" : "+s"(K));
    const int nt = K / BK;
    unsigned voffB[2];
#pragma unroll
    for (int i = 0; i < 2; ++i) { int R, C; stage_rc(tid * 16 + i * 8192, R, C); const int Rb = Epi::PERM ? ((R & ~31) + perm32(R & 31)) : R; voffB[i] = (unsigned)(Rb * K + C) * 2u; }
    const size_t kstep = (size_t)(BK * 2);
    const size_t hstep = (size_t)HALF * K * 2;
    const unsigned ldsw = (unsigned)wid * 1024u;
    const int aoff = lds_byte(wr * 64 + fr, fq * 8), boff = lds_byte(wc * 32 + fr, fq * 8);
#define PG8_SA(b, h) (((b) * 2 + (h)) * HTB)
#define PG8_SB(b, h) ((4 + (b) * 2 + (h)) * HTB)
#define PG8_STAGE2(bufoff, gbase, v0, v1) do { \
        __builtin_amdgcn_global_load_lds((const unsigned*)((const char*)(gbase) + (v0)), (PG8_LAS unsigned*)(lds + (bufoff) + ldsw), 16, 0, 0); \
        __builtin_amdgcn_global_load_lds((const unsigned*)((const char*)(gbase) + (v1)), (PG8_LAS unsigned*)(lds + (bufoff) + ldsw + 8192), 16, 0, 0); } while (0)
#define PG8_STAGEB(bufoff, gbase) PG8_STAGE2(bufoff, gbase, voffB[0], voffB[1])
#define PG8_LDA(dst, b, h) do { _Pragma("unroll") for (int m = 0; m < 4; ++m) _Pragma("unroll") for (int k = 0; k < 2; ++k) dst[m][k] = *(const PG8_LAS bf16x8*)(lds + PG8_SA(b, h) + aoff + m * 2048 + k * 1024); } while (0)
#define PG8_LDB(dst, b, h) do { _Pragma("unroll") for (int n = 0; n < 2; ++n) _Pragma("unroll") for (int k = 0; k < 2; ++k) dst[n][k] = *(const PG8_LAS bf16x8*)(lds + PG8_SB(b, h) + boff + n * 2048 + k * 1024); } while (0)
#define PG8_MMA(ai, bj, At, Bt) do { __builtin_amdgcn_s_setprio(1); _Pragma("unroll") for (int m = 0; m < 4; ++m) _Pragma("unroll") for (int n = 0; n < 2; ++n) _Pragma("unroll") for (int k = 0; k < 2; ++k) \
        acc[ai][bj][m][n] = __builtin_amdgcn_mfma_f32_16x16x32_bf16(Bt[n][k], At[m][k], acc[ai][bj][m][n], 0, 0, 0); __builtin_amdgcn_s_setprio(0); } while (0)
#define PG8_WAIT_V(n) asm volatile("s_waitcnt vmcnt(" #n ")" ::: "memory")
#define PG8_WAIT_L(n) asm volatile("s_waitcnt lgkmcnt(" #n ")" ::: "memory")
#define PG8_BAR __builtin_amdgcn_s_barrier()
#define PG8_SCHED __builtin_amdgcn_sched_barrier(0)
    Unit cur, nxt; int ui = 0;
    if (!S.next(0, cur)) return;
    Acc acc;
#pragma unroll
    for (int a = 0; a < 2; ++a)
#pragma unroll
        for (int b = 0; b < 2; ++b)
#pragma unroll
            for (int m = 0; m < 4; ++m)
#pragma unroll
                for (int n = 0; n < 2; ++n) acc[a][b][m][n] = (f32x4){0.f, 0.f, 0.f, 0.f};
    bf16x8 At[4][2], B0[2][2], B1[2][2];
    constexpr bool GA = Sched::GATHER;
    unsigned c00, c01, c10 = 0, c11 = 0;
    PG8_LAS unsigned* nvo = (PG8_LAS unsigned*)(lds + PG8_NVO_OFF) + tid * 4;
    { int R0, C0, R1, C1; stage_rc(tid * 16, R0, C0); stage_rc(tid * 16 + 8192, R1, C1);
      c00 = S.avoff(cur, 0, R0, C0, K); c01 = S.avoff(cur, 0, R1, C1, K); if constexpr (GA) { c10 = S.avoff(cur, 1, R0, C0, K); c11 = S.avoff(cur, 1, R1, C1, K); } }
    const size_t hA = GA ? (size_t)0 : hstep;
#define PG8_STAGEA0(bufoff, gbase) PG8_STAGE2(bufoff, gbase, c00, c01)
#define PG8_STAGEA1(bufoff, gbase) do { if constexpr (GA) PG8_STAGE2(bufoff, gbase, c10, c11); else PG8_STAGE2(bufoff, (gbase) + hA, c00, c01); } while (0)
    const char* cA = cur.A; const char* cB = cur.B;
    PG8_STAGEB(PG8_SB(0, 0), cB); PG8_STAGEB(PG8_SB(0, 1), cB + hstep); PG8_STAGEA0(PG8_SA(0, 0), cA); PG8_STAGEA1(PG8_SA(0, 1), cA);
    if (wr == 1) PG8_BAR;
    PG8_WAIT_V(2); PG8_BAR;
    PG8_STAGEB(PG8_SB(1, 0), cB + kstep); PG8_STAGEA0(PG8_SA(1, 0), cA + kstep); PG8_STAGEB(PG8_SB(1, 1), cB + hstep + kstep);
    PG8_WAIT_V(6); PG8_BAR;
    for (;;) {
        const bool has_next = S.next(ui + 1, nxt);
        const char* nA = has_next ? nxt.A : cA; const char* nB = has_next ? nxt.B : cB;
        if constexpr (GA) { if (has_next) {
            int R0, C0, R1, C1; stage_rc(tid * 16, R0, C0); stage_rc(tid * 16 + 8192, R1, C1);
            nvo[0] = S.avoff(nxt, 0, R0, C0, K); nvo[1] = S.avoff(nxt, 0, R1, C1, K); nvo[2] = S.avoff(nxt, 1, R0, C0, K); nvo[3] = S.avoff(nxt, 1, R1, C1, K); } }
        for (int t = 0; t < nt; t += 2) {
            const bool last = (t == nt - 2);
            const char* a1 = cA + (size_t)(t + 1) * kstep;
            const char* a2 = last ? nA : cA + (size_t)(t + 2) * kstep; const char* b2 = last ? nB : cB + (size_t)(t + 2) * kstep;
            const char* a3 = a2 + kstep; const char* b3 = b2 + kstep;
            const bool nx = GA && last && has_next;
#define PG8_STAGEA0N(bufoff, gbase) do { if (nx) { const unsigned q0 = nvo[0], q1 = nvo[1]; PG8_STAGE2(bufoff, gbase, q0, q1); } else PG8_STAGEA0(bufoff, gbase); } while (0)
#define PG8_STAGEA1N(bufoff, gbase) do { if (nx) { const unsigned q0 = nvo[2], q1 = nvo[3]; PG8_STAGE2(bufoff, gbase, q0, q1); } else PG8_STAGEA1(bufoff, gbase); } while (0)
            PG8_LDB(B0, 0, 0); PG8_LDB(B1, 0, 1); PG8_SCHED; PG8_LDA(At, 0, 0); PG8_STAGEA1(PG8_SA(1, 1), a1);
            PG8_WAIT_V(8); PG8_WAIT_L(0); PG8_BAR; PG8_MMA(0, 0, At, B0); PG8_MMA(0, 1, At, B1); PG8_BAR; PG8_SCHED;
            PG8_LDA(At, 0, 1); PG8_STAGEB(PG8_SB(0, 0), b2); PG8_STAGEB(PG8_SB(0, 1), b2 + hstep); PG8_STAGEA0N(PG8_SA(0, 0), a2);
            PG8_WAIT_V(8); PG8_WAIT_L(0); PG8_BAR; PG8_MMA(1, 0, At, B0); PG8_MMA(1, 1, At, B1); PG8_BAR; PG8_SCHED;
            PG8_LDB(B0, 1, 0); PG8_LDB(B1, 1, 1); PG8_SCHED; PG8_LDA(At, 1, 0); PG8_STAGEA1N(PG8_SA(0, 1), a2);
            PG8_WAIT_V(8); PG8_WAIT_L(0); PG8_BAR; PG8_MMA(0, 0, At, B0); PG8_MMA(0, 1, At, B1); PG8_BAR; PG8_SCHED;
            PG8_LDA(At, 1, 1); PG8_STAGEB(PG8_SB(1, 0), b3); PG8_STAGEB(PG8_SB(1, 1), b3 + hstep); PG8_STAGEA0N(PG8_SA(1, 0), a3);
            PG8_WAIT_V(8); PG8_WAIT_L(0); PG8_BAR; PG8_MMA(1, 0, At, B0); PG8_MMA(1, 1, At, B1); PG8_BAR; PG8_SCHED;
#undef PG8_STAGEA0N
#undef PG8_STAGEA1N
        }
        if constexpr (ALIGN_EPI) { if (wr == 0) PG8_BAR; }
        E(acc, cur, wr, wc, fr, fq);
        if (!has_next) break;
#pragma unroll
        for (int a = 0; a < 2; ++a)
#pragma unroll
            for (int b = 0; b < 2; ++b)
#pragma unroll
                for (int m = 0; m < 4; ++m)
#pragma unroll
                    for (int n = 0; n < 2; ++n) acc[a][b][m][n] = (f32x4){0.f, 0.f, 0.f, 0.f};
        cur = nxt; cA = nA; cB = nB; ++ui; if constexpr (GA) { c00 = nvo[0]; c01 = nvo[1]; c10 = nvo[2]; c11 = nvo[3]; }
        if constexpr (ALIGN_EPI) { if (wr == 1) PG8_BAR; }
    }
    PG8_WAIT_V(0);
    if constexpr (!ALIGN_EPI) { if (wr == 0) PG8_BAR; }
    PG8_BAR;
#undef PG8_SA
#undef PG8_SB
#undef PG8_STAGE2
#undef PG8_STAGEB
#undef PG8_STAGEA0
#undef PG8_STAGEA1
#undef PG8_LDA
#undef PG8_LDB
#undef PG8_MMA
#undef PG8_WAIT_V
#undef PG8_WAIT_L
#undef PG8_BAR
#undef PG8_SCHED
}
}
#define GAS __attribute__((address_space(1)))
#define LAS __attribute__((address_space(3)))
typedef unsigned v4u __attribute__((ext_vector_type(4)));
typedef unsigned v2u __attribute__((ext_vector_type(2)));
typedef float f32x4 __attribute__((ext_vector_type(4)));
typedef short bf16x8 __attribute__((ext_vector_type(8)));
typedef GAS unsigned gu32;
#define RLX_AGENT __ATOMIC_RELAXED, __HIP_MEMORY_SCOPE_AGENT
#define LDS_WAIT() asm volatile("s_waitcnt lgkmcnt(0)" ::: "memory")
#define VM_WAIT() asm volatile("s_waitcnt vmcnt(0)" ::: "memory")
__device__ __forceinline__ int opaque_v(int x) { asm volatile("" : "+v"(x)); return x; }
__device__ __forceinline__ float shx(float v, int o, int lane) { return __int_as_float(__builtin_amdgcn_ds_bpermute((lane ^ o) << 2, __float_as_int(v))); }
__device__ __forceinline__ unsigned pk2(float lo, float hi) { return pg8::cvt_pk_bf16(lo, hi); }

#define XB_TMO      128
#define XB_XCNT(j)  (256  + 64 * (j))
#define XB_XSUB(j)  (1280 + 64 * (j))
#define XB_XGEN(j)  (2304 + 64 * (j))
#define XB_TOP      3328
#define XB_TOPGEN   3392
#define XCD_BAR_WORDS 3456
#define XB_SPIN_CAP (1u << 18)
__device__ __forceinline__ unsigned xb_ld(unsigned* p)              { return __hip_atomic_load(p, __ATOMIC_RELAXED, __HIP_MEMORY_SCOPE_AGENT); }
__device__ __forceinline__ unsigned xb_add(unsigned* p, unsigned v) { return __hip_atomic_fetch_add(p, v, __ATOMIC_RELAXED, __HIP_MEMORY_SCOPE_AGENT); }
__device__ __forceinline__ unsigned xb_xcc_id() { return (unsigned)__builtin_amdgcn_s_getreg((3 << 11) | 20) & 0xFu; }
#define XB_SPIN(cond, bar) do { unsigned _sp = 0; while (cond) { __builtin_amdgcn_s_sleep(1); \
    if ((++_sp & 255u) == 0u) { if (xb_ld(&(bar)[XB_TMO])) break; if (_sp > XB_SPIN_CAP) { atomicAdd(&(bar)[XB_TMO], 1u); break; } } } } while (0)
struct XcdBarrier { unsigned* bar; unsigned x; volatile LAS unsigned* st; };
__device__ __forceinline__ XcdBarrier xcd_barrier_post(unsigned* bar, volatile LAS unsigned* st) {
    XcdBarrier b; b.bar = bar; b.x = xb_xcc_id(); b.st = st;
    if (threadIdx.x == 0) (void)xb_add(&bar[XB_XCNT(b.x)], 1u);
    return b;
}
__device__ __forceinline__ void xcd_barrier_complete(unsigned* bar, unsigned x, unsigned& nloc, unsigned& nx) {
    const unsigned G = gridDim.x * gridDim.y * gridDim.z;
    unsigned sum, cnt, mine, sp = 0u;
    for (;;) {
        sum = 0u; cnt = 0u; mine = 0u;
#pragma unroll
        for (unsigned j = 0; j < 16; ++j) { const unsigned c = xb_ld(&bar[XB_XCNT(j)]); sum += c; cnt += (c > 0u) ? 1u : 0u; mine = (j == x) ? c : mine; }
        if (sum == G) break;
        __builtin_amdgcn_s_sleep(1);
        if ((++sp & 255u) == 0u) { if (xb_ld(&bar[XB_TMO])) break; if (sp > XB_SPIN_CAP) { atomicAdd(&bar[XB_TMO], 1u); break; } }
    }
    nloc = mine > 0u ? mine : 1u; nx = cnt > 0u ? cnt : 1u;
}
__device__ __forceinline__ void xcd_barrier(const XcdBarrier& b_in) {
    asm volatile("s_waitcnt vmcnt(0)" ::: "memory");
    __syncthreads();
    if (threadIdx.x == 0) {
        XcdBarrier b = b_in; asm volatile("" : "+s"(b.x));
        unsigned* bar = b.bar; asm volatile("" : "+s"(bar));
        __builtin_amdgcn_s_waitcnt(0);
        unsigned nloc = b.st[0], nx = b.st[1];
        if (nloc == 0u) { xcd_barrier_complete(bar, b.x, nloc, nx); b.st[0] = nloc; b.st[1] = nx; }
        const unsigned old = xb_add(&bar[XB_XSUB(b.x)], 1u);
        const unsigned gen = old / nloc;
        if (old + 1u == (gen + 1u) * nloc) {
            __builtin_amdgcn_fence(__ATOMIC_RELEASE, "agent");
            asm volatile("s_waitcnt vmcnt(0)" ::: "memory");
            const unsigned og = xb_add(&bar[XB_TOP], 1u);
            const unsigned tg = og / nx;
            if (og + 1u == (tg + 1u) * nx) xb_add(&bar[XB_TOPGEN], 1u);
            else XB_SPIN(xb_ld(&bar[XB_TOPGEN]) == tg, bar);
            __builtin_amdgcn_fence(__ATOMIC_ACQUIRE, "agent");
            xb_add(&bar[XB_XGEN(b.x)], 1u);
            asm volatile("s_waitcnt vmcnt(0)" ::: "memory");
        } else {
            XB_SPIN(xb_ld(&bar[XB_XGEN(b.x)]) == gen, bar);
            __builtin_amdgcn_fence(__ATOMIC_ACQUIRE, "agent");
            asm volatile("s_waitcnt vmcnt(0)" ::: "memory");
        }
    }
    __syncthreads();
}
using pg8::Unit; using pg8::Acc;
struct DenseSched { static constexpr bool GATHER = false;
    const char* A; const char* B; int nM, nN, nwg, G, c, K; int L0 = 0, cnt = 1 << 30;
    __device__ __forceinline__ void init(const void* A_, const void* B_, int M, int N, int K_, int G_, int c_) { A = (const char*)A_; B = (const char*)B_; nM = M / 256; nN = N / 256; nwg = nM * nN; G = G_; c = c_; K = K_; }
    __device__ __forceinline__ bool next(int i, Unit& u) const {
        const long L = (long)L0 + (long)i * G + c; if (c < 0 || i >= cnt || L >= nwg) return false;
        int wgid = (int)L; { const int q = nwg / 8, r = nwg % 8, xcd = wgid % 8, off = wgid / 8; wgid = (xcd < r ? xcd * (q + 1) : r * (q + 1) + (xcd - r) * q) + off; }
        const int nig = 8 * nN, gid = wgid / nig, fm = gid * 8, gsz = (nM - fm) < 8 ? (nM - fm) : 8;
        u.pm = fm + ((wgid % nig) % gsz); u.pn = (wgid % nig) / gsz;
        u.A = A + (size_t)u.pm * 256 * K * 2; u.B = B + (size_t)u.pn * 256 * K * 2; u.list = nullptr; u.m0 = 0; u.cnt = 0; return true;
    }
    __device__ __forceinline__ unsigned avoff(const Unit&, int h, int R, int C, int K_) const { return (unsigned)(((h * 128 + R) * K_ + C) * 2); }
};
struct EpiBf16Plain { static constexpr bool PERM = true; bf16* O; int ldc;
    __device__ __forceinline__ void operator()(const Acc& acc, const Unit& u, int wr, int wc, int fr, int fq) const {
        const int row0 = u.pm * 256 + wr * 64 + fr, col0 = u.pn * 256 + wc * 32 + 8 * fq;
#pragma unroll
        for (int ai = 0; ai < 2; ++ai)
#pragma unroll
            for (int m = 0; m < 4; ++m) { bf16* rowp = O + (size_t)(row0 + ai * 128 + m * 16) * ldc + col0;
#pragma unroll
                for (int bj = 0; bj < 2; ++bj) { const f32x4 v0 = acc[ai][bj][m][0], v1 = acc[ai][bj][m][1];
                    v4u w; w.x = pk2(v0[0], v0[1]); w.y = pk2(v0[2], v0[3]); w.z = pk2(v1[0], v1[1]); w.w = pk2(v1[2], v1[3]);
                    *(v4u*)(rowp + bj * 128) = w; } }
    }
};
struct EpiProj { static constexpr bool PERM = true; bf16* O; unsigned char* G8;
    __device__ __forceinline__ void operator()(const Acc& acc, const Unit& u, int wr, int wc, int fr, int fq) const {
        const int row0 = u.pm * 256 + wr * 64 + fr;
        if (u.pn < PN_GATE) { const int col0 = u.pn * 256 + wc * 32 + 8 * fq;
#pragma unroll
            for (int ai = 0; ai < 2; ++ai)
#pragma unroll
                for (int m = 0; m < 4; ++m) { bf16* rowp = O + (size_t)(row0 + ai * 128 + m * 16) * INC + col0;
#pragma unroll
                    for (int bj = 0; bj < 2; ++bj) { const f32x4 v0 = acc[ai][bj][m][0], v1 = acc[ai][bj][m][1];
                        v4u w; w.x = pk2(v0[0], v0[1]); w.y = pk2(v0[2], v0[3]); w.z = pk2(v1[0], v1[1]); w.w = pk2(v1[2], v1[3]);
                        *(v4u*)(rowp + bj * 128) = w; } }
        } else { const int col0 = (u.pn - PN_GATE) * 256 + wc * 32 + 8 * fq;
#pragma unroll
            for (int ai = 0; ai < 2; ++ai)
#pragma unroll
                for (int m = 0; m < 4; ++m) { unsigned char* rowp = G8 + (size_t)(row0 + ai * 128 + m * 16) * GW8 + col0;
#pragma unroll
                    for (int bj = 0; bj < 2; ++bj) { const f32x4 v0 = acc[ai][bj][m][0], v1 = acc[ai][bj][m][1];
                        unsigned q[8];
#pragma unroll
                        for (int j = 0; j < 4; ++j) { q[j] = (unsigned)(pg8::sigmoidf_(v0[j]) * 255.f + 0.5f); q[4 + j] = (unsigned)(pg8::sigmoidf_(v1[j]) * 255.f + 0.5f); }
                        v2u w; w.x = q[0] | (q[1] << 8) | (q[2] << 16) | (q[3] << 24); w.y = q[4] | (q[5] << 8) | (q[6] << 16) | (q[7] << 24);
                        *(v2u*)(rowp + bj * 128) = w; } }
        }
    }
};
struct BranchSched { static constexpr bool GATHER = false;
    const char* A0; const char* B; int G, c;
    __device__ __forceinline__ void init(const void* ya, const void* w, int G_, int c_) { A0 = (const char*)ya; B = (const char*)w; G = G_; c = c_; }
    __device__ __forceinline__ bool next(int i, Unit& u) const {
        const int j = i / 3, seg = i - 3 * j; constexpr int nM = NTOK / 256, nN = D / 256, nwg = nM * nN;
        const int L = j * G + c; if (L >= nwg) return false;
        int wgid = L; { const int q = nwg / 8, xcd = wgid % 8, off = wgid / 8; wgid = xcd * q + off; }
        const int nig = 8 * nN; u.pm = (wgid / nig) * 8 + ((wgid % nig) % 8); u.pn = (wgid % nig) / 8;
        u.A = A0 + (size_t)seg * (WS_YB - WS_YA) + (size_t)u.pm * 256 * CW * 2; u.B = B + (size_t)seg * 3 * MiB + (size_t)u.pn * 256 * CW * 2; u.list = nullptr; u.m0 = seg; u.cnt = 0; return true; }
    __device__ __forceinline__ unsigned avoff(const Unit&, int h, int R, int C, int K_) const { return (unsigned)(((h * 128 + R) * K_ + C) * 2); }
};
struct EpiGateRT { static constexpr bool PERM = true; const unsigned char* g8; bf16* merged;
    __device__ __forceinline__ void operator()(const Acc& acc, const Unit& u, int wr, int wc, int fr, int fq) const {
        const int row0 = u.pm * 256 + wr * 64 + fr, col0 = u.pn * 256 + wc * 32 + 8 * fq; const int seg = u.m0, gcol = seg * D;
#pragma unroll
        for (int ai = 0; ai < 2; ++ai) {
            v2u gw[4][2]; v4u pw[4][2];
#pragma unroll
            for (int m = 0; m < 4; ++m)
#pragma unroll
                for (int bj = 0; bj < 2; ++bj) { const size_t row = (size_t)(row0 + ai * 128 + m * 16); const int col = col0 + bj * 128;
                    gw[m][bj] = *(const v2u*)(g8 + row * GW8 + gcol + col);
                    pw[m][bj] = (v4u){0u, 0u, 0u, 0u}; if (seg) pw[m][bj] = *(const v4u*)(merged + row * D + col); }
            asm volatile("" ::: "memory");
#pragma unroll
            for (int m = 0; m < 4; ++m)
#pragma unroll
                for (int bj = 0; bj < 2; ++bj) { const size_t row = (size_t)(row0 + ai * 128 + m * 16); const int col = col0 + bj * 128;
                    const v2u g = gw[m][bj]; const v4u p = pw[m][bj]; f32x4 v0 = acc[ai][bj][m][0], v1 = acc[ai][bj][m][1]; constexpr float s8 = 1.f / 255.f;
                    v0[0] = v0[0] * ((float)(g.x & 255u) * s8) + pg8::bf_lo(p.x); v0[1] = v0[1] * ((float)((g.x >> 8) & 255u) * s8) + pg8::bf_hi(p.x);
                    v0[2] = v0[2] * ((float)((g.x >> 16) & 255u) * s8) + pg8::bf_lo(p.y); v0[3] = v0[3] * ((float)(g.x >> 24) * s8) + pg8::bf_hi(p.y);
                    v1[0] = v1[0] * ((float)(g.y & 255u) * s8) + pg8::bf_lo(p.z); v1[1] = v1[1] * ((float)((g.y >> 8) & 255u) * s8) + pg8::bf_hi(p.z);
                    v1[2] = v1[2] * ((float)((g.y >> 16) & 255u) * s8) + pg8::bf_lo(p.w); v1[3] = v1[3] * ((float)(g.y >> 24) * s8) + pg8::bf_hi(p.w);
                    v4u w; w.x = pk2(v0[0], v0[1]); w.y = pk2(v0[2], v0[3]); w.z = pk2(v1[0], v1[1]); w.w = pk2(v1[2], v1[3]); *(v4u*)(merged + row * D + col) = w; }
            asm volatile("" ::: "memory");
        }
    }
};
template <bool RB16> struct EpiResid { static constexpr bool PERM = true; const void* xres; bf16* z;
    __device__ __forceinline__ void operator()(const Acc& acc, const Unit& u, int wr, int wc, int fr, int fq) const {
        const int row0 = u.pm * 256 + wr * 64 + fr, col0 = u.pn * 256 + wc * 32 + 8 * fq;
#pragma unroll
        for (int ai = 0; ai < 2; ++ai) {
            f32x4 xr[4][2][2];
#pragma unroll
            for (int m = 0; m < 4; ++m) { const size_t off = (size_t)(row0 + ai * 128 + m * 16) * D + col0;
#pragma unroll
                for (int bj = 0; bj < 2; ++bj) {
                    if constexpr (RB16) { const v4u w = *(const v4u*)((const bf16*)xres + off + bj * 128);
                        xr[m][bj][0] = (f32x4){pg8::bf_lo(w.x), pg8::bf_hi(w.x), pg8::bf_lo(w.y), pg8::bf_hi(w.y)}; xr[m][bj][1] = (f32x4){pg8::bf_lo(w.z), pg8::bf_hi(w.z), pg8::bf_lo(w.w), pg8::bf_hi(w.w)}; }
                    else {
#pragma unroll
                        for (int n = 0; n < 2; ++n) xr[m][bj][n] = *(const f32x4*)((const float*)xres + off + bj * 128 + n * 4); } } }
            asm volatile("" ::: "memory");
#pragma unroll
            for (int m = 0; m < 4; ++m) { const size_t off = (size_t)(row0 + ai * 128 + m * 16) * D + col0;
#pragma unroll
                for (int bj = 0; bj < 2; ++bj) { const f32x4 v0 = xr[m][bj][0] * ALPHA + acc[ai][bj][m][0], v1 = xr[m][bj][1] * ALPHA + acc[ai][bj][m][1];
                    v4u w; w.x = pk2(v0[0], v0[1]); w.y = pk2(v0[2], v0[3]); w.z = pk2(v1[0], v1[1]); w.w = pk2(v1[2], v1[3]); *(v4u*)(z + off + bj * 128) = w; } }
            asm volatile("" ::: "memory");
        }
    }
};

constexpr int NWAVES = 8;
constexpr int RING_OFF = 0, RING_BYTES = 131072;
constexpr int SCR_BYTES = 147456;
constexpr int MISC_OFF = SCR_BYTES;
constexpr int LDS_BYTES = 163840;
constexpr int PH_CVT = 0, PH_L0 = 1, PH_PER_LAYER = 10;
constexpr int P_INPROJ = 0, P_MIX = 1, P_SCAN = 2, P_HOUT = 3, P_BRANCH = 4, P_WO = 5, P_ROUTE = 6, P_GU = 7, P_DOWN = 8, P_COMB = 9;
constexpr int N_PHASES = PH_L0 + 2 * PH_PER_LAYER;

constexpr int NCV = 64;
#define CV_UNITS 5
#define GM_UNITS 14
struct Frame { LAS unsigned char* lds; int tid, lane, wave, G, gw, NGW; };

__device__ __forceinline__ void xpose_item(const float* W, int N, int k0, int n0, bf16* WTrow0, int ldk, LAS float* scr, int lane) {
    const int kk = lane >> 3, nn = (lane & 7) * 4;
    f32x4 v[8];
#pragma unroll
    for (int i = 0; i < 8; ++i) v[i] = *(const f32x4*)(W + (size_t)(k0 + kk + 8 * i) * N + n0 + nn);
#pragma unroll
    for (int i = 0; i < 8; ++i) { LAS float* s = scr + (kk + 8 * i) * 33 + nn; s[0] = v[i][0]; s[1] = v[i][1]; s[2] = v[i][2]; s[3] = v[i][3]; }
    LDS_WAIT(); asm volatile("" ::: "memory");
    const int c = lane & 7;
#pragma unroll
    for (int j = 0; j < 4; ++j) { const int n = (lane >> 3) + 8 * j; const LAS float* s = scr + (8 * c) * 33 + n;
        v4u o; o.x = pk2(s[0 * 33], s[1 * 33]); o.y = pk2(s[2 * 33], s[3 * 33]); o.z = pk2(s[4 * 33], s[5 * 33]); o.w = pk2(s[6 * 33], s[7 * 33]);
        *(v4u*)(WTrow0 + (size_t)n * ldk + 8 * c) = o; }
    LDS_WAIT(); asm volatile("" ::: "memory");
}
__device__ __forceinline__ void xpose_matrix(const Frame& F, const float* W, int K, int N, bf16* WT, int ldk, int mode, unsigned& gbase) {
    const int nblk = N / 32, nitems = (K / 64) * nblk;
    LAS float* scr = (LAS float*)(F.lds + RING_OFF + F.wave * 8704);
    int it = (int)(((unsigned)F.gw + (unsigned)F.NGW - gbase % (unsigned)F.NGW) % (unsigned)F.NGW);
    for (; it < nitems; it += F.NGW) {
        const int kb = it / nblk, nb = it % nblk, n0 = nb * 32, k0 = kb * 64;
        const int drow = mode == 0 ? n0 : ((n0 >> 7) * 256 + (n0 & 127) + (mode == 2 ? 128 : 0));
        xpose_item(W, N, k0, n0, WT + (size_t)drow * ldk + k0, ldk, scr, F.lane);
    }
    gbase += (unsigned)nitems;
}
__device__ __forceinline__ void cvt_rows(const Frame& F, const float* in, bf16* out, size_t n8) {
    for (size_t i = (size_t)blockIdx.x * 512 + F.tid; i < n8; i += (size_t)F.G * 512) {
        const f32x4 a = *(const f32x4*)(in + i * 8), b = *(const f32x4*)(in + i * 8 + 4);
        v4u w; w.x = pk2(a[0], a[1]); w.y = pk2(a[2], a[3]); w.z = pk2(b[0], b[1]); w.w = pk2(b[2], b[3]);
        *(v4u*)(out + i * 8) = w; }
}
__device__ __forceinline__ void cvt_router(const Frame& F, const float* rw, unsigned char* ws) {
    for (int i = blockIdx.x * 512 + F.tid; i < 2 * D * NE; i += F.G * 512) { const int l = i / (D * NE), k = (i / NE) % D, e = i % NE;
        const float w = rw[i]; const bf16 h = f2bf(w); const bf16 lo = f2bf(w - bf2f(h));
        bf16* dst = (bf16*)(ws + WS_RW + l * RW_L); dst[(size_t)e * D + k] = h; dst[(size_t)(NE + e) * D + k] = lo; }
}
struct XItem { const float* src; bf16* dst; int N, ldk; };
__device__ __forceinline__ void xp_decode(int I, const float* wg, const float* wu, const float* wd, const float* sg, const float* su, const float* sd, unsigned char* ws, XItem& x) {
    const int e = I / 1536, rem = I % 1536, m = rem >> 9, it = rem & 511;
    if (m < 2) { const float* W = m == 0 ? (e < NE ? wg + (size_t)e * D * EH : sg) : (e < NE ? wu + (size_t)e * D * EH : su);
        const int kb = it >> 4, nb = it & 15, n0 = nb * 32, k0 = kb * 64; const int drow = (n0 >> 7) * 256 + (n0 & 127) + (m == 1 ? 128 : 0);
        x.src = W + (size_t)k0 * EH + n0; x.N = EH; x.ldk = D; x.dst = (bf16*)(ws + WS_WGU + (size_t)e * WGU_E) + (size_t)drow * D + k0; }
    else { const float* W = e < NE ? wd + (size_t)e * EH * D : sd; const int kb = it >> 6, nb = it & 63, n0 = nb * 32, k0 = kb * 64;
        x.src = W + (size_t)k0 * D + n0; x.N = D; x.ldk = EH; x.dst = (bf16*)(ws + WS_WDN + (size_t)e * WDN_E) + (size_t)n0 * EH + k0; }
}
__device__ __forceinline__ void xp_load(const XItem& x, int lane, f32x4 (&v)[8]) {
    const int kk = lane >> 3, nn = (lane & 7) * 4;
#pragma unroll
    for (int i = 0; i < 8; ++i) v[i] = __builtin_nontemporal_load((const f32x4*)(x.src + (size_t)(kk + 8 * i) * x.N + nn));
}
__device__ __forceinline__ void xp_store(const XItem& x, const f32x4 (&v)[8], LAS float* scr, int lane) {
    const int kk = lane >> 3, nn = (lane & 7) * 4;
#pragma unroll
    for (int i = 0; i < 8; ++i) { LAS float* s = scr + (kk + 8 * i) * 33 + nn; s[0] = v[i][0]; s[1] = v[i][1]; s[2] = v[i][2]; s[3] = v[i][3]; }
    LDS_WAIT(); asm volatile("" ::: "memory");
    const int c = lane & 7;
#pragma unroll
    for (int j = 0; j < 4; ++j) { const int n = (lane >> 3) + 8 * j; const LAS float* s = scr + (8 * c) * 33 + n;
        v4u o; o.x = pk2(s[0 * 33], s[1 * 33]); o.y = pk2(s[2 * 33], s[3 * 33]); o.z = pk2(s[4 * 33], s[5 * 33]); o.w = pk2(s[6 * 33], s[7 * 33]);
        __builtin_nontemporal_store(o, (v4u*)(x.dst + (size_t)n * x.ldk + 8 * c)); }
    LDS_WAIT(); asm volatile("" ::: "memory");
}
__device__ __forceinline__ void cvt_experts(const Frame& F, const float* wg, const float* wu, const float* wd, const float* sg, const float* su, const float* sd, unsigned char* ws, unsigned& gbase) {
    (void)gbase;
    LAS float* scr = (LAS float*)(F.lds + RING_OFF + F.wave * 8704);
    const int total = (NE + 1) * 1536;
    XItem A, B; f32x4 va[8], vb[8];
    int I = F.gw;
    if (I < total) { xp_decode(I, wg, wu, wd, sg, su, sd, ws, A); xp_load(A, F.lane, va); }
    for (; I < total; I += 2 * F.NGW) {
        const int I2 = I + F.NGW, I3 = I + 2 * F.NGW;
        if (I2 < total) { xp_decode(I2, wg, wu, wd, sg, su, sd, ws, B); xp_load(B, F.lane, vb); }
        xp_store(A, va, scr, F.lane);
        if (I2 < total) { if (I3 < total) { xp_decode(I3, wg, wu, wd, sg, su, sd, ws, A); xp_load(A, F.lane, va); }
            xp_store(B, vb, scr, F.lane); }
    }
}
constexpr int NVO_OFF = MISC_OFF + 1024;  static_assert(NVO_OFF == pg8::PG8_NVO_OFF, "nvo");
constexpr int PLAN_OFF = NVO_OFF + 8192;
constexpr int PLAN_TB = PLAN_OFF, PLAN_CN = PLAN_OFF + 66 * 4, PLAN_TE = PLAN_OFF + 132 * 4;
constexpr int MAXTILES = 640;
#ifndef ROUTE_PROBE
#define ROUTE_PROBE 0
#endif
static_assert(PLAN_TE + MAXTILES * 4 <= LDS_BYTES, "LDS map");

__device__ __forceinline__ float wave_sum(float v, int lane) {
#pragma unroll
    for (int o = 1; o < 64; o <<= 1) v += shx(v, o, lane);
    return v;
}
__device__ __forceinline__ void moe_plan(const Frame& F, const unsigned* cnt) {
    LAS unsigned* tb = (LAS unsigned*)(F.lds + PLAN_TB); LAS unsigned* cn = (LAS unsigned*)(F.lds + PLAN_CN); LAS unsigned* te = (LAS unsigned*)(F.lds + PLAN_TE);
    __syncthreads();
    if (F.tid <= NE) { unsigned run = 0; for (int e = 0; e < F.tid; ++e) run += (__hip_atomic_load(cnt + e, RLX_AGENT) + 255u) >> 8;
        tb[F.tid] = run; cn[F.tid] = F.tid < NE ? __hip_atomic_load(cnt + F.tid, RLX_AGENT) : (unsigned)NTOK; if (F.tid == NE) tb[NE + 1] = run + NTOK / 256; }
    __syncthreads();
    for (int t = F.tid; t < MAXTILES; t += NWAVES * 64) { unsigned e = 0; for (int q = 1; q <= NE; ++q) if (tb[q] <= (unsigned)t) e = q; te[t] = e; }
    __syncthreads();
}
template <bool GU> struct MoeSched { static constexpr bool GATHER = GU;
    const LAS unsigned* tb; const LAS unsigned* cn; const LAS unsigned* te; int nunits, nN, G, c; const char* Abase; const char* Bbase; const int* list;
    __device__ __forceinline__ void init(const Frame& F, const void* A_, const void* B_, const int* list_) {
        tb = (const LAS unsigned*)(F.lds + PLAN_TB); cn = (const LAS unsigned*)(F.lds + PLAN_CN); te = (const LAS unsigned*)(F.lds + PLAN_TE);
        nN = GU ? 4 : 8; nunits = (int)tb[NE + 1] * nN; G = F.G; const int bx = blockIdx.x; c = (G % 8 == 0) ? (bx % 8) * (G / 8) + bx / 8 : bx;
        Abase = (const char*)A_; Bbase = (const char*)B_; list = list_; }
    __device__ __forceinline__ bool next(int i, Unit& u) const {
        constexpr int RUN = GU ? 2 : 4; const int hs = c + G * (i / RUN), per = nN / RUN;
        const int tile = hs / per, pn = (hs % per) * RUN + (i % RUN); if (tile * nN >= nunits) return false;
        const int e = (int)te[tile];
        u.pm = tile; u.pn = pn;
        if (GU) { u.A = Abase; u.B = Bbase + (size_t)e * WGU_E + (size_t)pn * 256 * D * 2; u.list = e < NE ? list + (size_t)e * LISTCAP : nullptr; u.m0 = (tile - (int)tb[e]) * 256; u.cnt = (int)cn[e]; }
        else { u.A = Abase + (size_t)tile * 256 * EH * 2; u.B = Bbase + (size_t)e * WDN_E + (size_t)pn * 256 * EH * 2; u.list = nullptr; u.m0 = 0; u.cnt = 0; }
        return true; }
    __device__ __forceinline__ unsigned avoff(const Unit& u, int h, int R, int C, int K_) const {
        if (GU) { const int pos = u.m0 + h * 128 + R; int row = 0; if (pos < u.cnt) row = u.list ? u.list[pos] : pos; return (unsigned)((row * K_ + C) * 2); }
        else return (unsigned)(((h * 128 + R) * K_ + C) * 2); }
};
struct EpiSwiGLU { static constexpr bool PERM = true; bf16* H;
    __device__ __forceinline__ void operator()(const Acc& acc, const Unit& u, int wr, int wc, int fr, int fq) const {
        const int row0 = u.pm * 256 + wr * 64 + fr, col0 = u.pn * 128 + wc * 32 + 8 * fq;
#pragma unroll
        for (int ai = 0; ai < 2; ++ai)
#pragma unroll
            for (int m = 0; m < 4; ++m) { bf16* rowp = H + (size_t)(row0 + ai * 128 + m * 16) * EH + col0;
                float hv[8];
#pragma unroll
                for (int n = 0; n < 2; ++n)
#pragma unroll
                    for (int j = 0; j < 4; ++j) { const float g = acc[ai][0][m][n][j], uu = acc[ai][1][m][n][j]; hv[n * 4 + j] = g * pg8::sigmoidf_(g) * uu; }
                v4u w; w.x = pk2(hv[0], hv[1]); w.y = pk2(hv[2], hv[3]); w.z = pk2(hv[4], hv[5]); w.w = pk2(hv[6], hv[7]);
                *(v4u*)rowp = w; }
    }
};

__device__ __forceinline__ void route_phase(const Frame& F, const bf16* __restrict__ Z, const float* __restrict__ g, const float* __restrict__ bb, const bf16* __restrict__ rwh, const float* __restrict__ rb,
                                            bf16* __restrict__ X1L, bf16* __restrict__ X1BF, unsigned* cnt, int* list, int* tokslot, float* tokw, bool dispatch = true) {
    LAS float* part = (LAS float*)(F.lds + RING_OFF);
    LAS float* lg = part + 4 * 4096;
    LAS float* sl = lg + 64 * 65;
    LAS unsigned* cntL = (LAS unsigned*)(sl + 64 * 65);
    LAS unsigned* baseL = cntL + 64;
    LAS unsigned* ee = baseL + 64;
    LAS unsigned* pl = ee + 512;
    LAS float* ww = (LAS float*)(pl + 512);
    for (int grp = blockIdx.x; grp < NTOK / 64; grp += F.G) {
        const int t0 = grp * 64;
        if (F.tid < 64) cntL[F.tid] = 0u;
        for (int rp_ = 0; rp_ < (ROUTE_PROBE == 1 ? 2 : 1); ++rp_)
#pragma unroll 2
        for (int q = 0; q < 8; ++q) {
            const int t = t0 + F.wave * 8 + q;
            const v2u* zr = (const v2u*)(Z + (size_t)t * D) + F.lane;
            f32x4 v[8]; float s = 0.f;
#pragma unroll
            for (int j = 0; j < 8; ++j) { const v2u zw = zr[64 * j]; v[j] = (f32x4){pg8::bf_lo(zw.x), pg8::bf_hi(zw.x), pg8::bf_lo(zw.y), pg8::bf_hi(zw.y)}; s += (v[j][0] + v[j][1]) + (v[j][2] + v[j][3]); }
            const float mean = wave_sum(s, F.lane) * (1.f / D); float s2 = 0.f;
#pragma unroll
            for (int j = 0; j < 8; ++j) { v[j] = v[j] - mean; s2 += (v[j][0] * v[j][0] + v[j][1] * v[j][1]) + (v[j][2] * v[j][2] + v[j][3] * v[j][3]); }
            const float rstd = 1.f / sqrtf(wave_sum(s2, F.lane) * (1.f / D) + LN_EPS);
            v2u* xl = (v2u*)(X1L + (size_t)t * D) + F.lane; v2u* xb = (v2u*)(X1BF + (size_t)t * D) + F.lane;
#pragma unroll
            for (int j = 0; j < 8; ++j) { const f32x4 gg = ((const f32x4*)g)[F.lane + 64 * j], bv = ((const f32x4*)bb)[F.lane + 64 * j];
                const f32x4 y = v[j] * rstd * gg + bv; v2u w; w.x = pk2(y[0], y[1]); w.y = pk2(y[2], y[3]); xb[64 * j] = w;
                v2u lo; lo.x = pk2(y[0] - pg8::bf_lo(w.x), y[1] - pg8::bf_hi(w.x)); lo.y = pk2(y[2] - pg8::bf_lo(w.y), y[3] - pg8::bf_hi(w.y)); xl[64 * j] = lo; }
        }
        VM_WAIT(); __syncthreads();
        for (int rp_ = 0; rp_ < (ROUTE_PROBE == 2 ? 2 : 1); ++rp_)
        { const int r = F.lane & 15, kq = F.lane >> 4, kb = (F.wave & 3) * 512, th = F.wave >> 2;
          const bf16* xh = X1BF + (size_t)(t0 + th * 32 + r) * D + kb + 8 * kq;
          const bf16* xl = X1L + (size_t)(t0 + th * 32 + r) * D + kb + 8 * kq;
          const bf16* wh = rwh + (size_t)r * D + kb + 8 * kq;
          f32x4 acc[2][4];
#pragma unroll
          for (int tt = 0; tt < 2; ++tt)
#pragma unroll
              for (int nb = 0; nb < 4; ++nb) acc[tt][nb] = (f32x4){0.f, 0.f, 0.f, 0.f};
          bf16x8 xA[2][2], xB[2][2]; bf16x8 hA[4], lA[4], hB[4], lB[4];
#define RT_LOAD(X, H, L, ks) do { const int k_ = ((ks) < 16 ? (ks) : 15) * 32; _Pragma("unroll") for (int tt = 0; tt < 2; ++tt) { X[tt][0] = *(const bf16x8*)(xh + (size_t)tt * 16 * D + k_); X[tt][1] = *(const bf16x8*)(xl + (size_t)tt * 16 * D + k_); } \
              _Pragma("unroll") for (int nb = 0; nb < 4; ++nb) { H[nb] = *(const bf16x8*)(wh + (size_t)nb * 16 * D + k_); L[nb] = *(const bf16x8*)(wh + (size_t)(64 + nb * 16) * D + k_); } } while (0)
#define RT_MMA(X, H, L) do { \
              _Pragma("unroll") for (int tt = 0; tt < 2; ++tt) _Pragma("unroll") for (int nb = 0; nb < 4; ++nb) acc[tt][nb] = __builtin_amdgcn_mfma_f32_16x16x32_bf16(X[tt][1], H[nb], acc[tt][nb], 0, 0, 0); \
              _Pragma("unroll") for (int tt = 0; tt < 2; ++tt) _Pragma("unroll") for (int nb = 0; nb < 4; ++nb) acc[tt][nb] = __builtin_amdgcn_mfma_f32_16x16x32_bf16(X[tt][0], L[nb], acc[tt][nb], 0, 0, 0); \
              _Pragma("unroll") for (int tt = 0; tt < 2; ++tt) _Pragma("unroll") for (int nb = 0; nb < 4; ++nb) acc[tt][nb] = __builtin_amdgcn_mfma_f32_16x16x32_bf16(X[tt][0], H[nb], acc[tt][nb], 0, 0, 0); } while (0)
          RT_LOAD(xA, hA, lA, 0);
#pragma unroll 1
          for (int ks = 0; ks < 16; ks += 2) {
              RT_LOAD(xB, hB, lB, ks + 1); RT_MMA(xA, hA, lA);
              RT_LOAD(xA, hA, lA, ks + 2); RT_MMA(xB, hB, lB);
          }
#undef RT_LOAD
#undef RT_MMA
#pragma unroll
          for (int tt = 0; tt < 2; ++tt)
#pragma unroll
              for (int nb = 0; nb < 4; ++nb)
#pragma unroll
                  for (int reg = 0; reg < 4; ++reg) part[(F.wave & 3) * 4096 + (th * 32 + tt * 16 + 4 * kq + reg) * 64 + nb * 16 + r] = acc[tt][nb][reg];
        }
        __syncthreads();
        for (int i = F.tid; i < 64 * 64; i += NWAVES * 64) { const int tk = i >> 6, e = i & 63; const float lgt = (part[i] + part[4096 + i]) + (part[8192 + i] + part[12288 + i]);
            const float sc = 1.f / (1.f + __expf(-lgt)); lg[tk * 65 + e] = sc; sl[tk * 65 + e] = sc + rb[e]; }
        __syncthreads();
        for (int rp_ = 0; rp_ < (ROUTE_PROBE == 3 ? 2 : 1); ++rp_)
        { const bool lastrp = (rp_ == (ROUTE_PROBE == 3 ? 1 : 0));
          const int tk = F.wave * 8 + (F.lane >> 3), gq = F.lane & 7, lane = F.lane;
          float sv[8], cv[8];
#pragma unroll
          for (int j = 0; j < 8; ++j) { sv[j] = sl[tk * 65 + gq * 8 + j]; cv[j] = lg[tk * 65 + gq * 8 + j]; }
          float m1 = -INFINITY, m2 = -INFINITY;
#pragma unroll
          for (int j = 0; j < 8; ++j) { const float x = sv[j]; const bool g1 = x > m1; m2 = g1 ? m1 : fmaxf(m2, x); m1 = g1 ? x : m1; }
          const float gs = m1 + m2;
          int rank = 0;
#pragma unroll
          for (int o = 1; o < 8; ++o) { const float og = shx(gs, o, lane); const int oq = gq ^ o; rank += (og > gs || (og == gs && oq < gq)) ? 1 : 0; }
          const bool gsel = rank < 4;
          unsigned used = gsel ? 0u : 0xffu;
          float wsum = 0.f; float my_sc = 0.f; int my_e = 0;
#pragma unroll
          for (int i = 0; i < 8; ++i) {
              float bv = -INFINITY, bs = 0.f; int be = 64;
#pragma unroll
              for (int j = 0; j < 8; ++j) { const bool ok = !((used >> j) & 1u) && sv[j] > bv; bv = ok ? sv[j] : bv; bs = ok ? cv[j] : bs; be = ok ? gq * 8 + j : be; }
#pragma unroll
              for (int o = 1; o < 8; o <<= 1) { const float ov = shx(bv, o, lane), os = shx(bs, o, lane); const int oe = __float_as_int(shx(__int_as_float(be), o, lane));
                  const bool tk_o = ov > bv || (ov == bv && oe < be); bv = tk_o ? ov : bv; bs = tk_o ? os : bs; be = tk_o ? oe : be; }
              if ((be >> 3) == gq) used |= 1u << (be & 7);
              wsum += bs; if (gq == i) { my_sc = bs; my_e = be; }
          }
          const int slot = tk * 8 + gq;
          ee[slot] = (unsigned)my_e; ww[slot] = my_sc * (RSCALE / wsum);
          pl[slot] = __hip_atomic_fetch_add(cntL + my_e, (dispatch && lastrp) ? 1u : 0u, __ATOMIC_RELAXED, __HIP_MEMORY_SCOPE_WORKGROUP);
        }
        __syncthreads();
        if (F.tid < 64) { const unsigned n = cntL[F.tid]; baseL[F.tid] = n ? __hip_atomic_fetch_add(cnt + F.tid, n, RLX_AGENT) : 0u; }
        __syncthreads();
        if (dispatch) { const int tk = F.tid >> 3, i = F.tid & 7; const unsigned e = ee[F.tid]; const unsigned pos = baseL[e] + pl[F.tid]; const int t = t0 + tk;
          list[(size_t)e * LISTCAP + pos] = t; tokslot[t * 8 + i] = (int)(e * LISTCAP + pos); tokw[t * 8 + i] = ww[F.tid]; }
        __syncthreads();
    }
}
__device__ __forceinline__ void combine_phase(const Frame& F, const bf16* X1B, const bf16* Y, const int* tokslot, const float* tokw, const float* g, const float* bb, float* OUT, bf16* XBF, bool last) {
    const LAS unsigned* tb = (const LAS unsigned*)(F.lds + PLAN_TB);
    for (int t = F.gw; t < NTOK; t += F.NGW) {
        int rowi[9]; float wt[9];
#pragma unroll
        for (int i = 0; i < 8; ++i) { const int sl = tokslot[t * 8 + i]; rowi[i] = (int)tb[sl / LISTCAP] * 256 + (sl % LISTCAP); wt[i] = tokw[t * 8 + i]; }
        rowi[8] = (int)tb[NE] * 256 + t; wt[8] = 1.f;
        const v2u* xr = (const v2u*)(X1B + (size_t)t * D) + F.lane;
        f32x4 v[8]; float s = 0.f;
#pragma unroll
        for (int j = 0; j < 8; ++j) { const v2u xw = xr[64 * j]; v[j] = (f32x4){pg8::bf_lo(xw.x), pg8::bf_hi(xw.x), pg8::bf_lo(xw.y), pg8::bf_hi(xw.y)} * ALPHA; }
#pragma unroll
        for (int i = 0; i < 9; ++i) { const v2u* yr = (const v2u*)(Y + (size_t)rowi[i] * D) + F.lane;
#pragma unroll
            for (int j = 0; j < 8; ++j) { const v2u w = yr[64 * j]; v[j][0] += wt[i] * pg8::bf_lo(w.x); v[j][1] += wt[i] * pg8::bf_hi(w.x); v[j][2] += wt[i] * pg8::bf_lo(w.y); v[j][3] += wt[i] * pg8::bf_hi(w.y); } }
#pragma unroll
        for (int j = 0; j < 8; ++j) s += (v[j][0] + v[j][1]) + (v[j][2] + v[j][3]);
        const float mean = wave_sum(s, F.lane) * (1.f / D); float s2 = 0.f;
#pragma unroll
        for (int j = 0; j < 8; ++j) { v[j] = v[j] - mean; s2 += (v[j][0] * v[j][0] + v[j][1] * v[j][1]) + (v[j][2] * v[j][2] + v[j][3] * v[j][3]); }
        const float rstd = 1.f / sqrtf(wave_sum(s2, F.lane) * (1.f / D) + LN_EPS);
        f32x4* xo = (f32x4*)(OUT + (size_t)t * D) + F.lane; v2u* xb = (v2u*)(XBF + (size_t)t * D) + F.lane;
#pragma unroll
        for (int j = 0; j < 8; ++j) { const f32x4 gg = ((const f32x4*)g)[F.lane + 64 * j], bv = ((const f32x4*)bb)[F.lane + 64 * j];
            const f32x4 y = v[j] * rstd * gg + bv; if (last) xo[64 * j] = y; else { v2u w; w.x = pk2(y[0], y[1]); w.y = pk2(y[2], y[3]); xb[64 * j] = w; } }
    }
}
constexpr size_t R2_UT = 0, R2_OI = 48 * MiB, R2_QP = 96 * MiB, R2_DEC = 120 * MiB;
constexpr int NHU = NB * HGH * (SEQ / 64);
typedef __attribute__((address_space(3))) bf16 lbf16;
__device__ __forceinline__ void unpack8(const v4u w, float (&f)[8]) {
    f[0] = pg8::bf_lo(w.x); f[1] = pg8::bf_hi(w.x); f[2] = pg8::bf_lo(w.y); f[3] = pg8::bf_hi(w.y); f[4] = pg8::bf_lo(w.z); f[5] = pg8::bf_hi(w.z); f[6] = pg8::bf_lo(w.w); f[7] = pg8::bf_hi(w.w); }
__device__ __forceinline__ float exp_c(float x) { return __expf(fminf(x, 80.f)); }

__device__ __forceinline__ void conv_part(const Frame& F, const bf16* proj, const float* cw, bf16* YA, bf16* YX) {
    for (int i = blockIdx.x * 512 + F.tid; i < NTOK * 32; i += F.G * 512) *(v4u*)(YX + (size_t)(i >> 5) * YXW + XAW + (i & 31) * 8) = (v4u){0u, 0u, 0u, 0u};
    for (int i = blockIdx.x * 512 + F.tid; i < NTOK * (CW / 8); i += F.G * 512) {
        const int t = i / (CW / 8), c = (i % (CW / 8)) * 8, pos = t & (SEQ - 1);
        const bf16* r = proj + (size_t)t * INC;
        float u0[8], c0[8], b0[8], u1[8], c1[8], u2[8], c2[8], w0[8], w1[8], w2[8];
        unpack8(*(const v4u*)(r + C_U + c), u0); unpack8(*(const v4u*)(r + C_C + c), c0); unpack8(*(const v4u*)(r + C_B + c), b0);
        const v4u z4 = {0u, 0u, 0u, 0u};
        unpack8(pos >= 1 ? *(const v4u*)(r - INC + C_U + c) : z4, u1); unpack8(pos >= 1 ? *(const v4u*)(r - INC + C_C + c) : z4, c1);
        unpack8(pos >= 2 ? *(const v4u*)(r - 2 * INC + C_U + c) : z4, u2); unpack8(pos >= 2 ? *(const v4u*)(r - 2 * INC + C_C + c) : z4, c2);
#pragma unroll
        for (int j = 0; j < 8; ++j) { w0[j] = cw[c + j]; w1[j] = cw[CW + c + j]; w2[j] = cw[2 * CW + c + j]; }
        float o[8];
#pragma unroll
        for (int j = 0; j < 8; ++j) o[j] = b0[j] * (w2[j] * c0[j] * u0[j] + w1[j] * c1[j] * u1[j] + w0[j] * c2[j] * u2[j]);
        v4u w; w.x = pk2(o[0], o[1]); w.y = pk2(o[2], o[3]); w.z = pk2(o[4], o[5]); w.w = pk2(o[6], o[7]);
        *(v4u*)(YA + (size_t)t * CW + c) = w;
    }
}

__device__ __forceinline__ void hgrn_local(const Frame& F, const bf16* proj, const float* lbl, int layer, unsigned char* r2) {
    lbf16* QS = (lbf16*)(F.lds);
    lbf16* KS = QS + 64 * 136;
    lbf16* KPT = KS + 64 * 136;
    lbf16* VT = KPT + 128 * 72;
    lbf16* PS = VT + 128 * 72;
    LAS float* SEG = (LAS float*)(PS + 64 * 72);
    bf16* UT = (bf16*)(r2 + R2_UT); bf16* OI = (bf16*)(r2 + R2_OI); bf16* QP = (bf16*)(r2 + R2_QP); float* DEC = (float*)(r2 + R2_DEC);
    const int lane = F.lane, wv = F.wave, r = lane & 15, kq = lane >> 4;
    bf16 rf[16], rq[16], rv[16];
#define HL_LOAD(U) do { const int b_ = (U) / (HGH * 64), h_ = ((U) / 64) % HGH, c_ = (U) % 64; const bf16* p_ = proj + (size_t)(b_ * SEQ + c_ * 64 + (F.tid >> 7) * 16) * INC + h_ * HGD + (F.tid & 127); \
        _Pragma("unroll") for (int i = 0; i < 16; ++i) { rf[i] = p_[(size_t)i * INC + C_F]; rq[i] = p_[(size_t)i * INC + C_Q]; rv[i] = p_[(size_t)i * INC + C_I]; } } while (0)
    if ((int)blockIdx.x < NHU) HL_LOAD((int)blockIdx.x);
    for (int unit = blockIdx.x; unit < NHU; unit += F.G) {
        const int b = unit / (HGH * 64), h = (unit / 64) % HGH, c = unit % 64, t0 = b * SEQ + c * 64;
        { const int col = F.tid & 127, seg = F.tid >> 7, ch = h * HGD + col;
          float lb = 0.f; if (layer == 1) lb = 1.f / (1.f + __expf(lbl[ch] - lbl[HGW + ch]));
          float a[16], kk[16], qv[16], vv[16]; float run = 0.f;
#pragma unroll
          for (int i = 0; i < 16; ++i) {
              const float z = bf2f(rf[i]); const float ez = __expf(-z); const float sg = 1.f / (1.f + ez);
              const float f = lb + (1.f - lb) * sg; kk[i] = (1.f - lb) * ez * sg; run += fmaxf(__logf(f), -60.f); a[i] = run;
              qv[i] = bf2f(rq[i]); vv[i] = bf2f(rv[i]); }
          if (unit + F.G < NHU) HL_LOAD(unit + F.G);
          SEG[seg * 128 + col] = run;
          __syncthreads();
          const float s0 = SEG[col], s1 = SEG[128 + col], s2 = SEG[256 + col], s3 = SEG[384 + col];
          const float base = seg == 0 ? 0.f : (seg == 1 ? s0 : (seg == 2 ? s0 + s1 : s0 + s1 + s2)), bm = s0 + s1, bl = (s0 + s1) + (s2 + s3);
          float kp[16];
#pragma unroll
          for (int i = 0; i < 16; ++i) { const float bb = base + a[i]; const int t = seg * 16 + i;
              QS[t * 136 + col] = f2bf(qv[i] * exp_c(bb - bm)); KS[t * 136 + col] = f2bf(kk[i] * exp_c(bm - bb)); kp[i] = kk[i] * exp_c(bl - bb);
              QP[(size_t)(t0 + t) * HGW + ch] = f2bf(qv[i] * exp_c(bb)); }
          v4u w0, w1; w0.x = pk2(kp[0], kp[1]); w0.y = pk2(kp[2], kp[3]); w0.z = pk2(kp[4], kp[5]); w0.w = pk2(kp[6], kp[7]); w1.x = pk2(kp[8], kp[9]); w1.y = pk2(kp[10], kp[11]); w1.z = pk2(kp[12], kp[13]); w1.w = pk2(kp[14], kp[15]);
          *(LAS v4u*)(KPT + col * 72 + seg * 16) = w0; *(LAS v4u*)(KPT + col * 72 + seg * 16 + 8) = w1;
          w0.x = pk2(vv[0], vv[1]); w0.y = pk2(vv[2], vv[3]); w0.z = pk2(vv[4], vv[5]); w0.w = pk2(vv[6], vv[7]); w1.x = pk2(vv[8], vv[9]); w1.y = pk2(vv[10], vv[11]); w1.z = pk2(vv[12], vv[13]); w1.w = pk2(vv[14], vv[15]);
          *(LAS v4u*)(VT + col * 72 + seg * 16) = w0; *(LAS v4u*)(VT + col * 72 + seg * 16 + 8) = w1;
          if (seg == 0) DEC[(size_t)unit * 128 + col] = exp_c(bl);
        }
        __syncthreads();
        { const int tm = wv >> 1, tn0 = (wv & 1) * 2;
          bf16x8 af[4];
#pragma unroll
          for (int ks = 0; ks < 4; ++ks) af[ks] = *(const LAS bf16x8*)(QS + (tm * 16 + r) * 136 + ks * 32 + kq * 8);
#pragma unroll
          for (int jn = 0; jn < 2; ++jn) { const int tn = tn0 + jn; f32x4 acc = {0.f, 0.f, 0.f, 0.f};
              if (tn <= tm) {
#pragma unroll
                  for (int ks = 0; ks < 4; ++ks) { const bf16x8 bf = *(const LAS bf16x8*)(KS + (tn * 16 + r) * 136 + ks * 32 + kq * 8); acc = __builtin_amdgcn_mfma_f32_16x16x32_bf16(af[ks], bf, acc, 0, 0, 0); } }
#pragma unroll
              for (int g = 0; g < 4; ++g) { const int t = tm * 16 + 4 * kq + g, s = tn * 16 + r; PS[t * 72 + s] = f2bf(s <= t ? acc[g] : 0.f); } } }
        { bf16x8 af[2];
#pragma unroll
          for (int ks = 0; ks < 2; ++ks) af[ks] = *(const LAS bf16x8*)(KPT + (wv * 16 + r) * 72 + ks * 32 + kq * 8);
#pragma unroll
          for (int tv = 0; tv < 8; ++tv) { f32x4 acc = {0.f, 0.f, 0.f, 0.f};
#pragma unroll
              for (int ks = 0; ks < 2; ++ks) { const bf16x8 bf = *(const LAS bf16x8*)(VT + (tv * 16 + r) * 72 + ks * 32 + kq * 8); acc = __builtin_amdgcn_mfma_f32_16x16x32_bf16(af[ks], bf, acc, 0, 0, 0); }
              v2u w; w.x = pk2(acc[0], acc[1]); w.y = pk2(acc[2], acc[3]);
              *(v2u*)(UT + (size_t)unit * 16384 + (tv * 16 + r) * 128 + wv * 16 + 4 * kq) = w; } }
        __syncthreads();
        { const int tm = wv & 3, tvg = wv >> 2;
          bf16x8 pf[2];
#pragma unroll
          for (int ks = 0; ks < 2; ++ks) pf[ks] = *(const LAS bf16x8*)(PS + (tm * 16 + r) * 72 + ks * 32 + kq * 8);
#pragma unroll
          for (int j = 0; j < 4; ++j) { const int tv = tvg * 4 + j; f32x4 acc = {0.f, 0.f, 0.f, 0.f};
#pragma unroll
              for (int ks = 0; ks < 2; ++ks) { const bf16x8 vf = *(const LAS bf16x8*)(VT + (tv * 16 + r) * 72 + ks * 32 + kq * 8); acc = __builtin_amdgcn_mfma_f32_16x16x32_bf16(vf, pf[ks], acc, 0, 0, 0); }
              v2u ow; ow.x = pk2(acc[0], acc[1]); ow.y = pk2(acc[2], acc[3]); *(v2u*)(OI + (size_t)(t0 + tm * 16 + r) * HGW + h * HGD + tv * 16 + 4 * kq) = ow; } }
        __syncthreads();
    }
#undef HL_LOAD
}
__device__ __forceinline__ void hgrn_scan(const Frame& F, const unsigned char* r2, v2u* __restrict__ SB64) {
    const v2u* __restrict__ UT64 = (const v2u*)(r2 + R2_UT); const f32x4* __restrict__ DEC4 = (const f32x4*)(r2 + R2_DEC);
    for (int it = blockIdx.x * 512 + F.tid; it < NB * HGH * 128 * 32; it += F.G * 512) {
        const int bh = it >> 12, v = (it >> 5) & 127, k4 = it & 31;
        f32x4 s = {0.f, 0.f, 0.f, 0.f};
#pragma unroll 8
        for (int c = 0; c < 64; ++c) { const size_t unit = (size_t)bh * 64 + c; const size_t idx = unit * 4096 + v * 32 + k4;
            const v2u w = UT64[idx]; const f32x4 d = DEC4[unit * 32 + k4];
            v2u o; o.x = pk2(s[0], s[1]); o.y = pk2(s[2], s[3]); SB64[idx] = o;
            s[0] = d[0] * s[0] + pg8::bf_lo(w.x); s[1] = d[1] * s[1] + pg8::bf_hi(w.x); s[2] = d[2] * s[2] + pg8::bf_lo(w.y); s[3] = d[3] * s[3] + pg8::bf_hi(w.y); }
    }
}
struct HoutOps { bf16x8 af[4]; bf16x8 bfr[4][4]; };
__device__ __forceinline__ void hout_load(HoutOps& O, int unit, const bf16* proj, const bf16* OI, const bf16* QP, const bf16* SB, int r, int kq, int tm, int tvg) {
    const int b = unit / (HGH * 64), h = (unit / 64) % HGH, c = unit % 64, t0 = b * SEQ + c * 64;
#pragma unroll
    for (int ks = 0; ks < 4; ++ks) O.af[ks] = *(const bf16x8*)(QP + (size_t)(t0 + tm * 16 + r) * HGW + h * HGD + ks * 32 + kq * 8);
#pragma unroll
    for (int j = 0; j < 4; ++j)
#pragma unroll
        for (int ks = 0; ks < 4; ++ks) O.bfr[j][ks] = *(const bf16x8*)(SB + (size_t)unit * 16384 + ((tvg * 4 + j) * 16 + r) * 128 + ks * 32 + kq * 8);
}
__device__ __forceinline__ void hout_compute(const HoutOps& O, int unit, const bf16* proj, const bf16* OI, LAS float* SSQ, const float* gain, bf16* YB, int lane, int r, int kq, int tm, int tvg) {
    const int b = unit / (HGH * 64), h = (unit / 64) % HGH, c = unit % 64, t0 = b * SEQ + c * 64;
    const size_t t = (size_t)(t0 + tm * 16 + r);
    f32x4 oi[4]; v2u gtw[4];
#pragma unroll
    for (int j = 0; j < 4; ++j) { const int ch = h * HGD + (tvg * 4 + j) * 16 + 4 * kq; { const v2u ow = *(const v2u*)(OI + t * HGW + ch); oi[j] = (f32x4){pg8::bf_lo(ow.x), pg8::bf_hi(ow.x), pg8::bf_lo(ow.y), pg8::bf_hi(ow.y)}; } gtw[j] = *(const v2u*)(proj + t * INC + C_G + ch); }
    f32x4 acc[4]; float q = 0.f;
#pragma unroll
    for (int j = 0; j < 4; ++j) { acc[j] = (f32x4){0.f, 0.f, 0.f, 0.f};
#pragma unroll
        for (int ks = 0; ks < 4; ++ks) acc[j] = __builtin_amdgcn_mfma_f32_16x16x32_bf16(O.bfr[j][ks], O.af[ks], acc[j], 0, 0, 0); }
#pragma unroll
    for (int j = 0; j < 4; ++j) { acc[j] += oi[j]; q += (acc[j][0] * acc[j][0] + acc[j][1] * acc[j][1]) + (acc[j][2] * acc[j][2] + acc[j][3] * acc[j][3]); }
    q += shx(q, 16, lane); q += shx(q, 32, lane);
    if (kq == 0) SSQ[tvg * 64 + tm * 16 + r] = q;
    __syncthreads();
    const float rs = rsqrtf((SSQ[tm * 16 + r] + SSQ[64 + tm * 16 + r]) * (1.f / 128.f) + RMS_EPS);
#pragma unroll
    for (int j = 0; j < 4; ++j) { const int ch = h * HGD + (tvg * 4 + j) * 16 + 4 * kq; const f32x4 gn = *(const f32x4*)(gain + ch);
        const float g0 = pg8::bf_lo(gtw[j].x), g1 = pg8::bf_hi(gtw[j].x), g2 = pg8::bf_lo(gtw[j].y), g3 = pg8::bf_hi(gtw[j].y);
        v2u w; w.x = pk2(acc[j][0] * rs * gn[0] * g0 * pg8::sigmoidf_(g0), acc[j][1] * rs * gn[1] * g1 * pg8::sigmoidf_(g1));
        w.y = pk2(acc[j][2] * rs * gn[2] * g2 * pg8::sigmoidf_(g2), acc[j][3] * rs * gn[3] * g3 * pg8::sigmoidf_(g3));
        *(v2u*)(YB + t * HGW + ch) = w; }
    __syncthreads();
}
__device__ __forceinline__ void hgrn_out(const Frame& F, const bf16* proj, const unsigned char* r2, const bf16* SB, const float* gain, bf16* YB) {
    LAS float* SSQ = (LAS float*)F.lds;
    const bf16* OI = (const bf16*)(r2 + R2_OI); const bf16* QP = (const bf16*)(r2 + R2_QP);
    const int lane = F.lane, wv = F.wave, r = lane & 15, kq = lane >> 4, tm = wv & 3, tvg = wv >> 2;
    HoutOps A, B;
    int unit = blockIdx.x;
    if (unit < NHU) hout_load(A, unit, proj, OI, QP, SB, r, kq, tm, tvg);
    for (; unit < NHU; unit += 2 * F.G) {
        const int u2 = unit + F.G, u3 = unit + 2 * F.G;
        if (u2 < NHU) hout_load(B, u2, proj, OI, QP, SB, r, kq, tm, tvg);
        hout_compute(A, unit, proj, OI, SSQ, gain, YB, lane, r, kq, tm, tvg);
        if (u2 < NHU) { if (u3 < NHU) hout_load(A, u3, proj, OI, QP, SB, r, kq, tm, tvg);
            hout_compute(B, u2, proj, OI, SSQ, gain, YB, lane, r, kq, tm, tvg); }
    }
}
__device__ __forceinline__ void memattn(const Frame& F, const bf16* proj, const bf16* KV, int layer, bf16* YX) {
    lbf16* Ks = (lbf16*)F.lds;
    lbf16* VTs = Ks + 256 * 136;
    const int lane = F.lane, wv = F.wave, r = lane & 15, kq = lane >> 4;
    for (int unit = blockIdx.x; unit < NB * XAH * (SEQ / 256); unit += F.G) {
        const int b = unit >> 6, hd = (unit >> 4) & 3, qt = unit & 15;
#pragma unroll
        for (int i = 0; i < 8; ++i) { const int p = F.tid + 512 * i, key = p >> 4, dc = (p & 15) * 8;
            const bf16* src = KV + (size_t)(b * NMEM + key) * 2048 + layer * 1024 + hd * XAD + dc;
            *(LAS v4u*)(Ks + key * 136 + dc) = *(const v4u*)src;
            const v4u w = *(const v4u*)(src + 512);
            const int k5 = key & 31, pos = (key & ~31) + 8 * ((k5 >> 2) & 3) + 4 * ((k5 >> 4) & 1) + (k5 & 3);
            lbf16* d = VTs + dc * 264 + pos;
            d[0] = (bf16)(w.x & 0xffffu); d[264] = (bf16)(w.x >> 16); d[2 * 264] = (bf16)(w.y & 0xffffu); d[3 * 264] = (bf16)(w.y >> 16);
            d[4 * 264] = (bf16)(w.z & 0xffffu); d[5 * 264] = (bf16)(w.z >> 16); d[6 * 264] = (bf16)(w.w & 0xffffu); d[7 * 264] = (bf16)(w.w >> 16); }
        __syncthreads();
#pragma unroll 1
        for (int g = 0; g < 2; ++g) {
            const int t = b * SEQ + qt * 256 + wv * 32 + g * 16 + r;
            bf16x8 qf[4];
#pragma unroll
            for (int ks = 0; ks < 4; ++ks) qf[ks] = *(const bf16x8*)(proj + (size_t)t * INC + C_QX + hd * XAD + ks * 32 + kq * 8);
            f32x4 s[16];
#pragma unroll
            for (int kt = 0; kt < 16; ++kt) { s[kt] = (f32x4){0.f, 0.f, 0.f, 0.f};
#pragma unroll
                for (int ks = 0; ks < 4; ++ks) { const bf16x8 a = *(const LAS bf16x8*)(Ks + (kt * 16 + r) * 136 + ks * 32 + kq * 8); s[kt] = __builtin_amdgcn_mfma_f32_16x16x32_bf16(a, qf[ks], s[kt], 0, 0, 0); }
                if (kt & 1) __builtin_amdgcn_sched_barrier(0); }
            float m = -1e30f;
#pragma unroll
            for (int kt = 0; kt < 16; ++kt) m = fmaxf(m, fmaxf(fmaxf(s[kt][0], s[kt][1]), fmaxf(s[kt][2], s[kt][3])));
            m = fmaxf(m, shx(m, 16, lane)); m = fmaxf(m, shx(m, 32, lane));
            const float cs = 0.08838834764831845f * 1.4426950408889634f; float l = 0.f;
#pragma unroll
            for (int kt = 0; kt < 16; ++kt)
#pragma unroll
                for (int e = 0; e < 4; ++e) { const float p = __builtin_amdgcn_exp2f((s[kt][e] - m) * cs); s[kt][e] = p; l += p; }
            l += shx(l, 16, lane); l += shx(l, 32, lane);
            f32x4 o[8];
#pragma unroll
            for (int dt = 0; dt < 8; ++dt) o[dt] = (f32x4){0.f, 0.f, 0.f, 0.f};
#pragma unroll
            for (int j = 0; j < 8; ++j) {
                v4u pw; pw.x = pk2(s[2 * j][0], s[2 * j][1]); pw.y = pk2(s[2 * j][2], s[2 * j][3]); pw.z = pk2(s[2 * j + 1][0], s[2 * j + 1][1]); pw.w = pk2(s[2 * j + 1][2], s[2 * j + 1][3]);
                const bf16x8 pf = __builtin_bit_cast(bf16x8, pw);
#pragma unroll
                for (int dt = 0; dt < 8; ++dt) { const bf16x8 a = *(const LAS bf16x8*)(VTs + (dt * 16 + r) * 264 + j * 32 + kq * 8); o[dt] = __builtin_amdgcn_mfma_f32_16x16x32_bf16(a, pf, o[dt], 0, 0, 0); }
                __builtin_amdgcn_sched_barrier(0); }
            const float inv = 1.f / l;
#pragma unroll
            for (int dt = 0; dt < 8; ++dt) { v2u w; w.x = pk2(o[dt][0] * inv, o[dt][1] * inv); w.y = pk2(o[dt][2] * inv, o[dt][3] * inv);
                *(v2u*)(YX + (size_t)t * YXW + hd * XAD + dt * 16 + 4 * kq) = w; }
        }
        __syncthreads();
    }
}
struct Args { const float* in[24]; float* out; unsigned char* ws; int ph_lo, ph_hi, mask, pad; };
typedef const __attribute__((address_space(4))) Args* KArgs;
__device__ __forceinline__ KArgs kargs() { KArgs p = (KArgs)__builtin_amdgcn_kernarg_segment_ptr(); asm volatile("" : "+s"(p)); return p; }
#define WSP(T, off) ((T*)(ws + (off)))
__global__ void __launch_bounds__(NWAVES * 64, 2) mk_fwd(Args args) {
    extern __shared__ __attribute__((aligned(16))) unsigned char lds_raw[];
    Frame F0; F0.lds = (LAS unsigned char*)lds_raw; F0.tid = threadIdx.x; F0.lane = F0.tid & 63; F0.wave = __builtin_amdgcn_readfirstlane(F0.tid >> 6);
    F0.G = gridDim.x; F0.gw = blockIdx.x * NWAVES + F0.wave; F0.NGW = F0.G * NWAVES;
    volatile LAS unsigned* MISC = (volatile LAS unsigned*)(F0.lds + MISC_OFF);
    for (int u = F0.tid; u < (LDS_BYTES - MISC_OFF) / 4; u += NWAVES * 64) ((LAS unsigned*)(F0.lds + MISC_OFF))[u] = 0u;
    __syncthreads();
    const int lo = args.ph_lo, hi = args.ph_hi;
    const bool multi = (hi - lo) > 1;
    XcdBarrier bar; bar.bar = (unsigned*)(args.ws + WS_CTL) + CW_BAR; bar.x = 0; bar.st = nullptr;
    if (multi) bar = xcd_barrier_post((unsigned*)(args.ws + WS_CTL) + CW_BAR, MISC + 8);
#define IN(k) (lo <= (k) && (k) < hi)
#define SEAM(k) do { if (IN((k) + 1)) xcd_barrier(bar); } while (0)
#define PH_BEGIN KArgs ka = kargs(); unsigned char* ws = ka->ws; (void)ws; Frame F = F0; F.lane = pg8::lane_id_opaque(); F.tid = F0.wave * 64 + F.lane
    if (IN(PH_CVT)) {
        { PH_BEGIN;
        unsigned gb = 0;
        for (int l = 0; l < 2; ++l) {
            xpose_matrix(F, ka->in[2] + (size_t)l * D * INC, D, INC, (bf16*)(ws + WS_WIN_T + l * WIN_T_L), D, 0, gb);
            xpose_matrix(F, ka->in[4] + (size_t)l * CW * D, CW, D, (bf16*)(ws + WS_WBR_T + l * WBR_T_L), CW, 0, gb);
            xpose_matrix(F, ka->in[7] + (size_t)l * HGW * D, HGW, D, (bf16*)(ws + WS_WBR_T + l * WBR_T_L + 3 * MiB), HGW, 0, gb);
            xpose_matrix(F, ka->in[10] + (size_t)l * XAW * D, XAW, D, (bf16*)(ws + WS_WBR_T + l * WBR_T_L + 6 * MiB), YXW, 0, gb);
            for (int i = blockIdx.x * 512 + F.tid; i < D * 32; i += F.G * 512) *(v4u*)((bf16*)(ws + WS_WBR_T + l * WBR_T_L + 6 * MiB) + (size_t)(i >> 5) * YXW + XAW + (i & 31) * 8) = (v4u){0u, 0u, 0u, 0u};
            xpose_matrix(F, ka->in[11] + (size_t)l * D * D, D, D, (bf16*)(ws + WS_WO_T + l * WO_T_L), D, 0, gb);
            xpose_matrix(F, ka->in[8] + (size_t)l * D * XAW, D, XAW, (bf16*)(ws + WS_WKV_T) + (size_t)(l * 1024) * D, D, 0, gb);
            xpose_matrix(F, ka->in[9] + (size_t)l * D * XAW, D, XAW, (bf16*)(ws + WS_WKV_T) + (size_t)(l * 1024 + 512) * D, D, 0, gb);
        }
        cvt_router(F, ka->in[14], ws);
        cvt_rows(F, ka->in[0], WSP(bf16, WS_XBF), (size_t)NTOK * D / 8);
        cvt_rows(F, ka->in[1], WSP(bf16, WS_MEMBF), (size_t)NB * NMEM * D / 8);
        }
        SEAM(PH_CVT);
    }
    for (int l = 0; l < 2; ++l) {
        const int pb = PH_L0 + l * PH_PER_LAYER;
        if (IN(pb + P_INPROJ)) {
            { PH_BEGIN;
            const bool split = F.G == 256;
            const int oa = (int)blockIdx.x >> 3, ox = (int)blockIdx.x & 7; const bool conv = split && (oa & 3) == 3;
            const int hrank = 8 * (oa >> 2) + ox, grank = 8 * (oa - ((oa + 1) >> 2)) + ox;
            static_assert((256 - NCV) * GM_UNITS + NCV * CV_UNITS == (NTOK / 256) * (INC / 256), "in-projection unit shares");
            if (conv) { Frame Fc = F; Fc.gw = hrank * NWAVES + F.wave; Fc.NGW = NCV * NWAVES; unsigned gb = 0;
                cvt_experts(Fc, ka->in[16] + (size_t)l * NE * D * EH, ka->in[17] + (size_t)l * NE * D * EH, ka->in[18] + (size_t)l * NE * EH * D, ka->in[19] + (size_t)l * D * EH, ka->in[20] + (size_t)l * D * EH, ka->in[21] + (size_t)l * EH * D, ws, gb);
                __syncthreads(); }
            if (!split) { unsigned gb = 0; cvt_experts(F, ka->in[16] + (size_t)l * NE * D * EH, ka->in[17] + (size_t)l * NE * D * EH, ka->in[18] + (size_t)l * NE * EH * D, ka->in[19] + (size_t)l * D * EH, ka->in[20] + (size_t)l * D * EH, ka->in[21] + (size_t)l * EH * D, ws, gb); __syncthreads(); }
            DenseSched S; S.init(ws + WS_XBF, ws + WS_WIN_T + l * WIN_T_L, NTOK, INC, D, split ? (conv ? NCV : 256 - NCV) : F.G, split ? (conv ? hrank : grank) : (int)blockIdx.x);
            if (split) { S.L0 = conv ? (256 - NCV) * GM_UNITS : 0; S.cnt = conv ? CV_UNITS : GM_UNITS; }
            EpiProj E{WSP(bf16, WS_R1), WSP(unsigned char, WS_GATE8)};
            pg8::gemm_phase<EpiProj, DenseSched, true>(F.lds + RING_OFF, F.wave, D, S, E);
            if (l == 0) {
                DenseSched S2; S2.init(ws + WS_MEMBF, ws + WS_WKV_T, NB * NMEM, 2048, D, split ? 32 : F.G, split ? ((conv && hrank < 32) ? hrank : -1) : (int)blockIdx.x);
                EpiBf16Plain E2{WSP(bf16, WS_KV), 2048};
                pg8::gemm_phase<EpiBf16Plain, DenseSched, true>(F.lds + RING_OFF, F.wave, D, S2, E2);
            }
            }
            SEAM(pb + P_INPROJ);
        }
        if (IN(pb + P_MIX)) {
            { PH_BEGIN;
            memattn(F, WSP(bf16, WS_R1), WSP(bf16, WS_KV), l, WSP(bf16, WS_YX));
            hgrn_local(F, WSP(bf16, WS_R1), ka->in[5], l, ws + WS_R2);
            conv_part(F, WSP(bf16, WS_R1), ka->in[3] + (size_t)l * 3 * CW, WSP(bf16, WS_YA), WSP(bf16, WS_YX));
            }
            SEAM(pb + P_MIX);
        }
        if (IN(pb + P_SCAN)) {
            { PH_BEGIN;
            hgrn_scan(F, ws + WS_R2, WSP(v2u, WS_ZF));
            }
            SEAM(pb + P_SCAN);
        }
        if (IN(pb + P_HOUT)) {
            { PH_BEGIN;
            hgrn_out(F, WSP(bf16, WS_R1), ws + WS_R2, WSP(bf16, WS_ZF), ka->in[6] + (size_t)l * HGW, WSP(bf16, WS_YB));
            }
            SEAM(pb + P_HOUT);
        }
        if (IN(pb + P_BRANCH)) {
            { PH_BEGIN;
            static_assert(WS_YX - WS_YB == WS_YB - WS_YA, "branch inputs equally spaced");
            BranchSched S; S.init(ws + WS_YA, ws + WS_WBR_T + l * WBR_T_L, F.G, (int)blockIdx.x); EpiGateRT E{WSP(unsigned char, WS_GATE8), WSP(bf16, WS_MERGED)};
            pg8::gemm_phase<EpiGateRT, BranchSched, true>(F.lds + RING_OFF, F.wave, CW, S, E);
            }
            SEAM(pb + P_BRANCH);
        }
        if (IN(pb + P_WO)) {
            { PH_BEGIN;
            DenseSched S; S.init(ws + WS_MERGED, ws + WS_WO_T + l * WO_T_L, NTOK, D, D, F.G, (int)blockIdx.x);
            if (l == 0) { EpiResid<false> E{(const void*)ka->in[0], WSP(bf16, WS_ZF)}; pg8::gemm_phase<EpiResid<false>, DenseSched, true>(F.lds + RING_OFF, F.wave, D, S, E); }
            else { EpiResid<true> E{(const void*)WSP(bf16, WS_XBF), WSP(bf16, WS_ZF)}; pg8::gemm_phase<EpiResid<true>, DenseSched, true>(F.lds + RING_OFF, F.wave, D, S, E); }
            }
            SEAM(pb + P_WO);
        }
        if (IN(pb + P_ROUTE)) {
            { PH_BEGIN;
            route_phase(F, WSP(bf16, WS_ZF), ka->in[12] + (size_t)l * D, ka->in[13] + (size_t)l * D, WSP(bf16, WS_RW + l * RW_L), ka->in[15] + (size_t)l * NE, WSP(bf16, WS_X1F), WSP(bf16, WS_X1BF),
                        WSP(unsigned, WS_CTL) + CW_CNT + l * 64, WSP(int, WS_LIST), WSP(int, WS_TOKSLOT), WSP(float, WS_TOKW));
            }
            SEAM(pb + P_ROUTE);
        }
        if (IN(pb + P_GU)) {
            { PH_BEGIN;
            moe_plan(F, WSP(unsigned, WS_CTL) + CW_CNT + l * 64);
            MoeSched<true> S; S.init(F, ws + WS_X1BF, ws + WS_WGU, WSP(int, WS_LIST)); EpiSwiGLU E{WSP(bf16, WS_R2)};
            pg8::gemm_phase<EpiSwiGLU, MoeSched<true>, true>(F.lds + RING_OFF, F.wave, D, S, E);
            }
            SEAM(pb + P_GU);
        }
        if (IN(pb + P_DOWN)) {
            { PH_BEGIN;
            moe_plan(F, WSP(unsigned, WS_CTL) + CW_CNT + l * 64);
            MoeSched<false> S; S.init(F, ws + WS_R2, ws + WS_WDN, nullptr); EpiBf16Plain E{WSP(bf16, WS_R1), D};
            pg8::gemm_phase<EpiBf16Plain, MoeSched<false>, true>(F.lds + RING_OFF, F.wave, EH, S, E);
            }
            SEAM(pb + P_DOWN);
        }
        if (IN(pb + P_COMB)) {
            { PH_BEGIN;
            moe_plan(F, WSP(unsigned, WS_CTL) + CW_CNT + l * 64);
            combine_phase(F, WSP(bf16, WS_X1BF), WSP(bf16, WS_R1), WSP(int, WS_TOKSLOT), WSP(float, WS_TOKW), ka->in[22] + (size_t)l * D, ka->in[23] + (size_t)l * D, ka->out, WSP(bf16, WS_XBF), l == 1);
            }
            SEAM(pb + P_COMB);
        }
    }
#undef IN
#undef SEAM
}
static void launch_mk(Args a, int lo, int hi, int grid, hipStream_t stream) {
    a.ph_lo = lo; a.ph_hi = hi;
    hipLaunchKernelGGL(mk_fwd, dim3(grid), dim3(NWAVES * 64), LDS_BYTES, stream, a);
}
extern "C" void kernel_launch(void* const* d_in, const int* in_sizes, int n_in, void* d_out, int out_size, void* d_ws, size_t ws_size, hipStream_t stream) {
    static int grid = 0;
    if (grid == 0) {
        if (n_in != 24 || out_size != NTOK * D || ws_size < WS_END) { fprintf(stderr, "kernel_launch: unexpected sizes n_in %d out %d ws %zu\n", n_in, out_size, ws_size); grid = -1; return; }
        int dev = 0, cus = 0;
        if (hipGetDevice(&dev) != hipSuccess || hipDeviceGetAttribute(&cus, hipDeviceAttributeMultiprocessorCount, dev) != hipSuccess) { grid = -1; return; }
        if (hipFuncSetAttribute((const void*)mk_fwd, hipFuncAttributeMaxDynamicSharedMemorySize, LDS_BYTES) != hipSuccess) { fprintf(stderr, "kernel_launch: hipFuncSetAttribute failed\n"); grid = -1; return; }
        int per_cu = 0; (void)hipOccupancyMaxActiveBlocksPerMultiprocessor(&per_cu, (const void*)mk_fwd, NWAVES * 64, LDS_BYTES); (void)hipGetLastError();
        if (per_cu < 1) fprintf(stderr, "kernel_launch: occupancy query says %d\n", per_cu);
        grid = cus;
    }
    if (grid < 0) return;
    const float* x = (const float*)d_in[0];
    const float* conv_w = (const float*)d_in[3]; const float* lbl = (const float*)d_in[5];
    const float* hg_g = (const float*)d_in[6];
    const float* ln1_g = (const float*)d_in[12]; const float* ln1_b = (const float*)d_in[13]; const float* router_w = (const float*)d_in[14];
    const float* router_b = (const float*)d_in[15]; const float* exp_wg = (const float*)d_in[16]; const float* exp_wu = (const float*)d_in[17];
    const float* exp_wd = (const float*)d_in[18]; const float* sh_wg = (const float*)d_in[19]; const float* sh_wu = (const float*)d_in[20];
    const float* sh_wd = (const float*)d_in[21]; const float* ln2_g = (const float*)d_in[22]; const float* ln2_b = (const float*)d_in[23];
    unsigned char* ws = (unsigned char*)d_ws; float* out = (float*)d_out;
    unsigned* ctl = (unsigned*)(ws + WS_CTL);
    bf16* KV = (bf16*)(ws + WS_KV); bf16* XBF = (bf16*)(ws + WS_XBF); float* X1F = (float*)(ws + WS_X1F);
    bf16* X1BF = (bf16*)(ws + WS_X1BF); float* ZF = (float*)(ws + WS_ZF);
    bf16* YA = (bf16*)(ws + WS_YA); bf16* YB = (bf16*)(ws + WS_YB); bf16* YX = (bf16*)(ws + WS_YX);
    bf16* H = (bf16*)(ws + WS_R2); float* OH = (float*)(ws + WS_R2); bf16* PROJ = (bf16*)(ws + WS_R1); bf16* Y = (bf16*)(ws + WS_R1);
    int* LIST = (int*)(ws + WS_LIST); int* TOKSLOT = (int*)(ws + WS_TOKSLOT); float* TOKW = (float*)(ws + WS_TOKW);
    Args a{};
    for (int i = 0; i < 24; ++i) a.in[i] = (const float*)d_in[i];
    a.out = out; a.ws = ws;

    (void)hipMemsetAsync(ws + WS_CTL, 0, CTL_BYTES, stream);
    a.mask = 7;
    launch_mk(a, 0, N_PHASES, grid, stream);
}
```

```cpp
#include <hip/hip_runtime.h>
#include <stdint.h>
#include <stdio.h>

typedef unsigned short bf16;
__device__ __forceinline__ float bf2f(bf16 v) { return __uint_as_float(((unsigned)v) << 16); }
__device__ __forceinline__ bf16 f2bf(float f) { unsigned u = __float_as_uint(f); return (bf16)((u + 0x7fffu + ((u >> 16) & 1u)) >> 16); }

constexpr int NB = 4, SEQ = 4096, NTOK = NB * SEQ, D = 2048, NMEM = 256;
constexpr int CW = 768, HGW = 768, HGH = 6, HGD = 128, XAW = 512, XAH = 4, XAD = 128;
constexpr int INC = 12032, YXW = 768, GW8 = 3 * 2048, PN_GATE = 23;
constexpr int C_U = 0, C_B = 768, C_C = 1536, C_Q = 2304, C_F = 3072, C_I = 3840, C_G = 4608, C_QX = 5376, C_GA = 5888, C_GB = 7936, C_GX = 9984;
constexpr int NE = 64, TOPK = 8, EH = 512;
constexpr float ALPHA = 1.41421356237f, LN_EPS = 1e-5f, RMS_EPS = 1e-6f, RSCALE = 2.5f;
constexpr int LISTCAP = 16384;

constexpr size_t MiB = 1u << 20;
constexpr size_t WS_CTL = 0, CTL_BYTES = 1 * MiB;
constexpr size_t WS_RW = 1 * MiB, RW_L = 512 * 1024;
constexpr size_t WS_WIN_T = 2 * MiB, WIN_T_L = 47 * MiB;
constexpr size_t WS_WBR_T = 1932 * MiB, WBR_T_L = 9 * MiB;
constexpr size_t WS_WO_T = 112 * MiB, WO_T_L = 8 * MiB;
constexpr size_t WS_WKV_T = 128 * MiB;
constexpr size_t WS_MEMBF = 136 * MiB, WS_KV = 140 * MiB;
constexpr size_t WS_WGU = 144 * MiB, WGU_E = 4 * MiB;
constexpr size_t WS_WDN = 404 * MiB, WDN_E = 2 * MiB;
constexpr size_t WS_XBF = 534 * MiB, WS_X1F = 598 * MiB, WS_X1BF = 726 * MiB, WS_ZF = 790 * MiB, WS_MERGED = 918 * MiB;
constexpr size_t WS_YA = 1860 * MiB, WS_YB = 1884 * MiB, WS_YX = 1908 * MiB;
constexpr size_t WS_R2 = 1046 * MiB;
constexpr size_t WS_R1 = 1214 * MiB;
constexpr size_t R1_YS = 320 * MiB;
constexpr size_t WS_LIST = 1854 * MiB, WS_TOKSLOT = 1858 * MiB, WS_TOKW = 1859 * MiB, WS_GATE8 = 1950 * MiB, WS_END = 2046 * MiB;
constexpr int CW_CNT = 1024;
constexpr int CW_PLAN = 2048;
constexpr int CW_BAR = 4096;
#ifndef DBG_MASK
#define DBG_MASK 7
#endif
namespace pg8 {
#define PG8_LAS __attribute__((address_space(3)))
typedef unsigned short bf16_t;
typedef short bf16x8 __attribute__((ext_vector_type(8)));
typedef float f32x4 __attribute__((ext_vector_type(4)));
typedef unsigned u32x4 __attribute__((ext_vector_type(4)));
typedef unsigned u32x2 __attribute__((ext_vector_type(2)));
constexpr int PG8_NVO_OFF = 147456 + 1024;
constexpr int BM = 256, BK = 64, HALF = 128, HTB = HALF * BK * 2  , STAGE_BYTES = 8 * HTB, NXCD = 8, WGM = 8;

__host__ __device__ __forceinline__ int lds_byte(int r, int c) { const int st = (r >> 4) * 2 + (c >> 5), rr = r & 15, cc = c & 31, ob = rr * 64 + cc * 2; return st * 1024 + (ob ^ (((ob >> 9) & 1) << 5)); }
__host__ __device__ __forceinline__ void stage_rc(int b, int& R, int& C) { const int st = b / 1024, sb = b % 1024, swz = sb ^ (((sb >> 9) & 1) << 5); R = (st >> 1) * 16 + swz / 64; C = (st & 1) * 32 + (swz % 64) / 2; }
__host__ __device__ __forceinline__ int perm32(int rho) { const int n = rho >> 4, i = rho & 15; return 8 * (i >> 2) + 4 * n + (i & 3); }

struct Unit { const char* A; const char* B; int pm, pn; const int* list; int m0, cnt; };

typedef float f32x2_ __attribute__((ext_vector_type(2)));
typedef __bf16 bf16x2_ __attribute__((ext_vector_type(2)));
__device__ __forceinline__ unsigned cvt_pk_bf16(float lo, float hi) { const f32x2_ v = {lo, hi}; const bf16x2_ b = __builtin_convertvector(v, bf16x2_); return __builtin_bit_cast(unsigned, b); }
__device__ __forceinline__ int lane_id_opaque() { unsigned m = ~0u; asm volatile("" : "+s"(m)); return (int)__builtin_amdgcn_mbcnt_hi(m, __builtin_amdgcn_mbcnt_lo(m, 0u)); }
__device__ __forceinline__ float bf_lo(unsigned w) { return __uint_as_float(w << 16); }
__device__ __forceinline__ float bf_hi(unsigned w) { return __uint_as_float(w & 0xffff0000u); }
__device__ __forceinline__ float sigmoidf_(float x) { return __builtin_amdgcn_rcpf(1.f + __expf(-x)); }

typedef f32x4 Acc[2][2][4][2];

template <class Epi, class Sched, bool ALIGN_EPI>
__device__ __forceinline__ void gemm_phase(PG8_LAS unsigned char* lds, const int wave, const int K_in, const Sched& S, const Epi& E) {
    const int lane = lane_id_opaque(), wid = wave, tid = wid * 64 + lane, wr = wid >> 2, wc = wid & 3, fr = lane & 15, fq = lane >> 4;
    int K = K_in; asm volatile("" : "+s"(K));
    const int nt = K / BK;
    unsigned voffB[2];
#pragma unroll
    for (int i = 0; i < 2; ++i) { int R, C; stage_rc(tid * 16 + i * 8192, R, C); const int Rb = Epi::PERM ? ((R & ~31) + perm32(R & 31)) : R; voffB[i] = (unsigned)(Rb * K + C) * 2u; }
    const size_t kstep = (size_t)(BK * 2);
    const size_t hstep = (size_t)HALF * K * 2;
    const unsigned ldsw = (unsigned)wid * 1024u;
    const int aoff = lds_byte(wr * 64 + fr, fq * 8), boff = lds_byte(wc * 32 + fr, fq * 8);
#define PG8_SA(b, h) (((b) * 2 + (h)) * HTB)
#define PG8_SB(b, h) ((4 + (b) * 2 + (h)) * HTB)
#define PG8_STAGE2(bufoff, gbase, v0, v1) do { \
        __builtin_amdgcn_global_load_lds((const unsigned*)((const char*)(gbase) + (v0)), (PG8_LAS unsigned*)(lds + (bufoff) + ldsw), 16, 0, 0); \
        __builtin_amdgcn_global_load_lds((const unsigned*)((const char*)(gbase) + (v1)), (PG8_LAS unsigned*)(lds + (bufoff) + ldsw + 8192), 16, 0, 0); } while (0)
#define PG8_STAGEB(bufoff, gbase) PG8_STAGE2(bufoff, gbase, voffB[0], voffB[1])
#define PG8_LDA(dst, b, h) do { _Pragma("unroll") for (int m = 0; m < 4; ++m) _Pragma("unroll") for (int k = 0; k < 2; ++k) dst[m][k] = *(const PG8_LAS bf16x8*)(lds + PG8_SA(b, h) + aoff + m * 2048 + k * 1024); } while (0)
#define PG8_LDB(dst, b, h) do { _Pragma("unroll") for (int n = 0; n < 2; ++n) _Pragma("unroll") for (int k = 0; k < 2; ++k) dst[n][k] = *(const PG8_LAS bf16x8*)(lds + PG8_SB(b, h) + boff + n * 2048 + k * 1024); } while (0)
#define PG8_MMA(ai, bj, At, Bt) do { __builtin_amdgcn_s_setprio(1); _Pragma("unroll") for (int m = 0; m < 4; ++m) _Pragma("unroll") for (int n = 0; n < 2; ++n) _Pragma("unroll") for (int k = 0; k < 2; ++k) \
        acc[ai][bj][m][n] = __builtin_amdgcn_mfma_f32_16x16x32_bf16(Bt[n][k], At[m][k], acc[ai][bj][m][n], 0, 0, 0); __builtin_amdgcn_s_setprio(0); } while (0)
#define PG8_WAIT_V(n) asm volatile("s_waitcnt vmcnt(" #n ")" ::: "memory")
#define PG8_WAIT_L(n) asm volatile("s_waitcnt lgkmcnt(" #n ")" ::: "memory")
#define PG8_BAR __builtin_amdgcn_s_barrier()
#define PG8_SCHED __builtin_amdgcn_sched_barrier(0)
    Unit cur, nxt; int ui = 0;
    if (!S.next(0, cur)) return;
    Acc acc;
#pragma unroll
    for (int a = 0; a < 2; ++a)
#pragma unroll
        for (int b = 0; b < 2; ++b)
#pragma unroll
            for (int m = 0; m < 4; ++m)
#pragma unroll
                for (int n = 0; n < 2; ++n) acc[a][b][m][n] = (f32x4){0.f, 0.f, 0.f, 0.f};
    bf16x8 At[4][2], B0[2][2], B1[2][2];
    constexpr bool GA = Sched::GATHER;
    unsigned c00, c01, c10 = 0, c11 = 0;
    PG8_LAS unsigned* nvo = (PG8_LAS unsigned*)(lds + PG8_NVO_OFF) + tid * 4;
    { int R0, C0, R1, C1; stage_rc(tid * 16, R0, C0); stage_rc(tid * 16 + 8192, R1, C1);
      c00 = S.avoff(cur, 0, R0, C0, K); c01 = S.avoff(cur, 0, R1, C1, K); if constexpr (GA) { c10 = S.avoff(cur, 1, R0, C0, K); c11 = S.avoff(cur, 1, R1, C1, K); } }
    const size_t hA = GA ? (size_t)0 : hstep;
#define PG8_STAGEA0(bufoff, gbase) PG8_STAGE2(bufoff, gbase, c00, c01)
#define PG8_STAGEA1(bufoff, gbase) do { if constexpr (GA) PG8_STAGE2(bufoff, gbase, c10, c11); else PG8_STAGE2(bufoff, (gbase) + hA, c00, c01); } while (0)
    const char* cA = cur.A; const char* cB = cur.B;
    PG8_STAGEB(PG8_SB(0, 0), cB); PG8_STAGEB(PG8_SB(0, 1), cB + hstep); PG8_STAGEA0(PG8_SA(0, 0), cA); PG8_STAGEA1(PG8_SA(0, 1), cA);
    if (wr == 1) PG8_BAR;
    PG8_WAIT_V(2); PG8_BAR;
    PG8_STAGEB(PG8_SB(1, 0), cB + kstep); PG8_STAGEA0(PG8_SA(1, 0), cA + kstep); PG8_STAGEB(PG8_SB(1, 1), cB + hstep + kstep);
    PG8_WAIT_V(6); PG8_BAR;
    for (;;) {
        const bool has_next = S.next(ui + 1, nxt);
        const char* nA = has_next ? nxt.A : cA; const char* nB = has_next ? nxt.B : cB;
        if constexpr (GA) { if (has_next) {
            int R0, C0, R1, C1; stage_rc(tid * 16, R0, C0); stage_rc(tid * 16 + 8192, R1, C1);
            nvo[0] = S.avoff(nxt, 0, R0, C0, K); nvo[1] = S.avoff(nxt, 0, R1, C1, K); nvo[2] = S.avoff(nxt, 1, R0, C0, K); nvo[3] = S.avoff(nxt, 1, R1, C1, K); } }
        for (int t = 0; t < nt; t += 2) {
            const bool last = (t == nt - 2);
            const char* a1 = cA + (size_t)(t + 1) * kstep;
            const char* a2 = last ? nA : cA + (size_t)(t + 2) * kstep; const char* b2 = last ? nB : cB + (size_t)(t + 2) * kstep;
            const char* a3 = a2 + kstep; const char* b3 = b2 + kstep;
            const bool nx = GA && last && has_next;
#define PG8_STAGEA0N(bufoff, gbase) do { if (nx) { const unsigned q0 = nvo[0], q1 = nvo[1]; PG8_STAGE2(bufoff, gbase, q0, q1); } else PG8_STAGEA0(bufoff, gbase); } while (0)
#define PG8_STAGEA1N(bufoff, gbase) do { if (nx) { const unsigned q0 = nvo[2], q1 = nvo[3]; PG8_STAGE2(bufoff, gbase, q0, q1); } else PG8_STAGEA1(bufoff, gbase); } while (0)
            PG8_LDB(B0, 0, 0); PG8_LDB(B1, 0, 1); PG8_SCHED; PG8_LDA(At, 0, 0); PG8_STAGEA1(PG8_SA(1, 1), a1);
            PG8_WAIT_V(8); PG8_WAIT_L(0); PG8_BAR; PG8_MMA(0, 0, At, B0); PG8_MMA(0, 1, At, B1); PG8_BAR; PG8_SCHED;
            PG8_LDA(At, 0, 1); PG8_STAGEB(PG8_SB(0, 0), b2); PG8_STAGEB(PG8_SB(0, 1), b2 + hstep); PG8_STAGEA0N(PG8_SA(0, 0), a2);
            PG8_WAIT_V(8); PG8_WAIT_L(0); PG8_BAR; PG8_MMA(1, 0, At, B0); PG8_MMA(1, 1, At, B1); PG8_BAR; PG8_SCHED;
            PG8_LDB(B0, 1, 0); PG8_LDB(B1, 1, 1); PG8_SCHED; PG8_LDA(At, 1, 0); PG8_STAGEA1N(PG8_SA(0, 1), a2);
            PG8_WAIT_V(8); PG8_WAIT_L(0); PG8_BAR; PG8_MMA(0, 0, At, B0); PG8_MMA(0, 1, At, B1); PG8_BAR; PG8_SCHED;
            PG8_LDA(At, 1, 1); PG8_STAGEB(PG8_SB(1, 0), b3); PG8_STAGEB(PG8_SB(1, 1), b3 + hstep); PG8_STAGEA0N(PG8_SA(1, 0), a3);
            PG8_WAIT_V(8); PG8_WAIT_L(0); PG8_BAR; PG8_MMA(1, 0, At, B0); PG8_MMA(1, 1, At, B1); PG8_BAR; PG8_SCHED;
#undef PG8_STAGEA0N
#undef PG8_STAGEA1N
        }
        if constexpr (ALIGN_EPI) { if (wr == 0) PG8_BAR; }
        E(acc, cur, wr, wc, fr, fq);
        if (!has_next) break;
#pragma unroll
        for (int a = 0; a < 2; ++a)
#pragma unroll
            for (int b = 0; b < 2; ++b)
#pragma unroll
                for (int m = 0; m < 4; ++m)
#pragma unroll
                    for (int n = 0; n < 2; ++n) acc[a][b][m][n] = (f32x4){0.f, 0.f, 0.f, 0.f};
        cur = nxt; cA = nA; cB = nB; ++ui; if constexpr (GA) { c00 = nvo[0]; c01 = nvo[1]; c10 = nvo[2]; c11 = nvo[3]; }
        if constexpr (ALIGN_EPI) { if (wr == 1) PG8_BAR; }
    }
    PG8_WAIT_V(0);
    if constexpr (!ALIGN_EPI) { if (wr == 0) PG8_BAR; }
    PG8_BAR;
#undef PG8_SA
#undef PG8_SB
#undef PG8_STAGE2
#undef PG8_STAGEB
#undef PG8_STAGEA0
#undef PG8_STAGEA1
#undef PG8_LDA
#undef PG8_LDB
#undef PG8_MMA
#undef PG8_WAIT_V
#undef PG8_WAIT_L
#undef PG8_BAR
#undef PG8_SCHED
}
}
#define GAS __attribute__((address_space(1)))
#define LAS __attribute__((address_space(3)))
typedef unsigned v4u __attribute__((ext_vector_type(4)));
typedef unsigned v2u __attribute__((ext_vector_type(2)));
typedef float f32x4 __attribute__((ext_vector_type(4)));
typedef short bf16x8 __attribute__((ext_vector_type(8)));
typedef GAS unsigned gu32;
#define RLX_AGENT __ATOMIC_RELAXED, __HIP_MEMORY_SCOPE_AGENT
#define LDS_WAIT() asm volatile("s_waitcnt lgkmcnt(0)" ::: "memory")
#define VM_WAIT() asm volatile("s_waitcnt vmcnt(0)" ::: "memory")
__device__ __forceinline__ int opaque_v(int x) { asm volatile("" : "+v"(x)); return x; }
__device__ __forceinline__ float shx(float v, int o, int lane) { return __int_as_float(__builtin_amdgcn_ds_bpermute((lane ^ o) << 2, __float_as_int(v))); }
__device__ __forceinline__ unsigned pk2(float lo, float hi) { return pg8::cvt_pk_bf16(lo, hi); }

#define XB_TMO      128
#define XB_XCNT(j)  (256  + 64 * (j))
#define XB_XSUB(j)  (1280 + 64 * (j))
#define XB_XGEN(j)  (2304 + 64 * (j))
#define XB_TOP      3328
#define XB_TOPGEN   3392
#define XCD_BAR_WORDS 3456
#define XB_SPIN_CAP (1u << 18)
__device__ __forceinline__ unsigned xb_ld(unsigned* p)              { return __hip_atomic_load(p, __ATOMIC_RELAXED, __HIP_MEMORY_SCOPE_AGENT); }
__device__ __forceinline__ unsigned xb_add(unsigned* p, unsigned v) { return __hip_atomic_fetch_add(p, v, __ATOMIC_RELAXED, __HIP_MEMORY_SCOPE_AGENT); }
__device__ __forceinline__ unsigned xb_xcc_id() { return (unsigned)__builtin_amdgcn_s_getreg((3 << 11) | 20) & 0xFu; }
#define XB_SPIN(cond, bar) do { unsigned _sp = 0; while (cond) { __builtin_amdgcn_s_sleep(1); \
    if ((++_sp & 255u) == 0u) { if (xb_ld(&(bar)[XB_TMO])) break; if (_sp > XB_SPIN_CAP) { atomicAdd(&(bar)[XB_TMO], 1u); break; } } } } while (0)
struct XcdBarrier { unsigned* bar; unsigned x; volatile LAS unsigned* st; };
__device__ __forceinline__ XcdBarrier xcd_barrier_post(unsigned* bar, volatile LAS unsigned* st) {
    XcdBarrier b; b.bar = bar; b.x = xb_xcc_id(); b.st = st;
    if (threadIdx.x == 0) (void)xb_add(&bar[XB_XCNT(b.x)], 1u);
    return b;
}
__device__ __forceinline__ void xcd_barrier_complete(unsigned* bar, unsigned x, unsigned& nloc, unsigned& nx) {
    const unsigned G = gridDim.x * gridDim.y * gridDim.z;
    unsigned sum, cnt, mine, sp = 0u;
    for (;;) {
        sum = 0u; cnt = 0u; mine = 0u;
#pragma unroll
        for (unsigned j = 0; j < 16; ++j) { const unsigned c = xb_ld(&bar[XB_XCNT(j)]); sum += c; cnt += (c > 0u) ? 1u : 0u; mine = (j == x) ? c : mine; }
        if (sum == G) break;
        __builtin_amdgcn_s_sleep(1);
        if ((++sp & 255u) == 0u) { if (xb_ld(&bar[XB_TMO])) break; if (sp > XB_SPIN_CAP) { atomicAdd(&bar[XB_TMO], 1u); break; } }
    }
    nloc = mine > 0u ? mine : 1u; nx = cnt > 0u ? cnt : 1u;
}
__device__ __forceinline__ void xcd_barrier(const XcdBarrier& b_in) {
    asm volatile("s_waitcnt vmcnt(0)" ::: "memory");
    __syncthreads();
    if (threadIdx.x == 0) {
        XcdBarrier b = b_in; asm volatile("" : "+s"(b.x));
        unsigned* bar = b.bar; asm volatile("" : "+s"(bar));
        __builtin_amdgcn_s_waitcnt(0);
        unsigned nloc = b.st[0], nx = b.st[1];
        if (nloc == 0u) { xcd_barrier_complete(bar, b.x, nloc, nx); b.st[0] = nloc; b.st[1] = nx; }
        const unsigned old = xb_add(&bar[XB_XSUB(b.x)], 1u);
        const unsigned gen = old / nloc;
        if (old + 1u == (gen + 1u) * nloc) {
            __builtin_amdgcn_fence(__ATOMIC_RELEASE, "agent");
            asm volatile("s_waitcnt vmcnt(0)" ::: "memory");
            const unsigned og = xb_add(&bar[XB_TOP], 1u);
            const unsigned tg = og / nx;
            if (og + 1u == (tg + 1u) * nx) xb_add(&bar[XB_TOPGEN], 1u);
            else XB_SPIN(xb_ld(&bar[XB_TOPGEN]) == tg, bar);
            __builtin_amdgcn_fence(__ATOMIC_ACQUIRE, "agent");
            xb_add(&bar[XB_XGEN(b.x)], 1u);
            asm volatile("s_waitcnt vmcnt(0)" ::: "memory");
        } else {
            XB_SPIN(xb_ld(&bar[XB_XGEN(b.x)]) == gen, bar);
            __builtin_amdgcn_fence(__ATOMIC_ACQUIRE, "agent");
            asm volatile("s_waitcnt vmcnt(0)" ::: "memory");
        }
    }
    __syncthreads();
}
using pg8::Unit; using pg8::Acc;
struct DenseSched { static constexpr bool GATHER = false;
    const char* A; const char* B; int nM, nN, nwg, G, c, K; int L0 = 0, cnt = 1 << 30;
    __device__ __forceinline__ void init(const void* A_, const void* B_, int M, int N, int K_, int G_, int c_) { A = (const char*)A_; B = (const char*)B_; nM = M / 256; nN = N / 256; nwg = nM * nN; G = G_; c = c_; K = K_; }
    __device__ __forceinline__ bool next(int i, Unit& u) const {
        const long L = (long)L0 + (long)i * G + c; if (c < 0 || i >= cnt || L >= nwg) return false;
        int wgid = (int)L; { const int q = nwg / 8, r = nwg % 8, xcd = wgid % 8, off = wgid / 8; wgid = (xcd < r ? xcd * (q + 1) : r * (q + 1) + (xcd - r) * q) + off; }
        const int nig = 8 * nN, gid = wgid / nig, fm = gid * 8, gsz = (nM - fm) < 8 ? (nM - fm) : 8;
        u.pm = fm + ((wgid % nig) % gsz); u.pn = (wgid % nig) / gsz;
        u.A = A + (size_t)u.pm * 256 * K * 2; u.B = B + (size_t)u.pn * 256 * K * 2; u.list = nullptr; u.m0 = 0; u.cnt = 0; return true;
    }
    __device__ __forceinline__ unsigned avoff(const Unit&, int h, int R, int C, int K_) const { return (unsigned)(((h * 128 + R) * K_ + C) * 2); }
};
struct EpiBf16Plain { static constexpr bool PERM = true; bf16* O; int ldc;
    __device__ __forceinline__ void operator()(const Acc& acc, const Unit& u, int wr, int wc, int fr, int fq) const {
        const int row0 = u.pm * 256 + wr * 64 + fr, col0 = u.pn * 256 + wc * 32 + 8 * fq;
#pragma unroll
        for (int ai = 0; ai < 2; ++ai)
#pragma unroll
            for (int m = 0; m < 4; ++m) { bf16* rowp = O + (size_t)(row0 + ai * 128 + m * 16) * ldc + col0;
#pragma unroll
                for (int bj = 0; bj < 2; ++bj) { const f32x4 v0 = acc[ai][bj][m][0], v1 = acc[ai][bj][m][1];
                    v4u w; w.x = pk2(v0[0], v0[1]); w.y = pk2(v0[2], v0[3]); w.z = pk2(v1[0], v1[1]); w.w = pk2(v1[2], v1[3]);
                    *(v4u*)(rowp + bj * 128) = w; } }
    }
};
struct EpiProj { static constexpr bool PERM = true; bf16* O; unsigned char* G8;
    __device__ __forceinline__ void operator()(const Acc& acc, const Unit& u, int wr, int wc, int fr, int fq) const {
        const int row0 = u.pm * 256 + wr * 64 + fr;
        if (u.pn < PN_GATE) { const int col0 = u.pn * 256 + wc * 32 + 8 * fq;
#pragma unroll
            for (int ai = 0; ai < 2; ++ai)
#pragma unroll
                for (int m = 0; m < 4; ++m) { bf16* rowp = O + (size_t)(row0 + ai * 128 + m * 16) * INC + col0;
#pragma unroll
                    for (int bj = 0; bj < 2; ++bj) { const f32x4 v0 = acc[ai][bj][m][0], v1 = acc[ai][bj][m][1];
                        v4u w; w.x = pk2(v0[0], v0[1]); w.y = pk2(v0[2], v0[3]); w.z = pk2(v1[0], v1[1]); w.w = pk2(v1[2], v1[3]);
                        *(v4u*)(rowp + bj * 128) = w; } }
        } else { const int pos0 = (u.pn - PN_GATE) * 256 + wc * 64 + fq * 16;
#pragma unroll
            for (int ai = 0; ai < 2; ++ai)
#pragma unroll
                for (int m = 0; m < 4; ++m) { unsigned char* rowp = G8 + (size_t)(row0 + ai * 128 + m * 16) * GW8 + pos0;
                    v4u w;
#pragma unroll
                    for (int bj = 0; bj < 2; ++bj) { const f32x4 v0 = acc[ai][bj][m][0], v1 = acc[ai][bj][m][1];
                        unsigned q[8];
#pragma unroll
                        for (int j = 0; j < 4; ++j) { q[j] = (unsigned)(pg8::sigmoidf_(v0[j]) * 255.f + 0.5f); q[4 + j] = (unsigned)(pg8::sigmoidf_(v1[j]) * 255.f + 0.5f); }
                        const unsigned lo = q[0] | (q[1] << 8) | (q[2] << 16) | (q[3] << 24), hi = q[4] | (q[5] << 8) | (q[6] << 16) | (q[7] << 24);
                        if (bj == 0) { w.x = lo; w.y = hi; } else { w.z = lo; w.w = hi; } }
                    *(v4u*)rowp = w; }
        }
    }
};
struct BranchSched { static constexpr bool GATHER = false;
    const char* A0; const char* B; int G, c;
    __device__ __forceinline__ void init(const void* ya, const void* w, int G_, int c_) { A0 = (const char*)ya; B = (const char*)w; G = G_; c = c_; }
    __device__ __forceinline__ bool next(int i, Unit& u) const {
        const int j = i / 3, seg = i - 3 * j; constexpr int nM = NTOK / 256, nN = D / 256, nwg = nM * nN;
        const int L = j * G + c; if (L >= nwg) return false;
        int wgid = L; { const int q = nwg / 8, xcd = wgid % 8, off = wgid / 8; wgid = xcd * q + off; }
        const int nig = 8 * nN; u.pm = (wgid / nig) * 8 + ((wgid % nig) % 8); u.pn = (wgid % nig) / 8;
        u.A = A0 + (size_t)seg * (WS_YB - WS_YA) + (size_t)u.pm * 256 * CW * 2; u.B = B + (size_t)seg * 3 * MiB + (size_t)u.pn * 256 * CW * 2; u.list = nullptr; u.m0 = seg; u.cnt = 0; return true; }
    __device__ __forceinline__ unsigned avoff(const Unit&, int h, int R, int C, int K_) const { return (unsigned)(((h * 128 + R) * K_ + C) * 2); }
};
struct EpiGateRT { static constexpr bool PERM = true; const unsigned char* g8; bf16* merged;
    __device__ __forceinline__ void operator()(const Acc& acc, const Unit& u, int wr, int wc, int fr, int fq) const {
        const int row0 = u.pm * 256 + wr * 64 + fr, col0 = u.pn * 256 + wc * 32 + 8 * fq; const int seg = u.m0, gcol = seg * D;
#pragma unroll
        for (int ai = 0; ai < 2; ++ai) {
            v4u gw[4]; v4u pw[4][2];
#pragma unroll
            for (int m = 0; m < 4; ++m)
#pragma unroll
                for (int bj = 0; bj < 2; ++bj) { const size_t row = (size_t)(row0 + ai * 128 + m * 16); const int col = col0 + bj * 128;
                    if (bj == 0) gw[m] = *(const v4u*)(g8 + row * GW8 + gcol + u.pn * 256 + wc * 64 + fq * 16);
                    pw[m][bj] = (v4u){0u, 0u, 0u, 0u}; if (seg) pw[m][bj] = *(const v4u*)(merged + row * D + col); }
            asm volatile("" ::: "memory");
#pragma unroll
            for (int m = 0; m < 4; ++m)
#pragma unroll
                for (int bj = 0; bj < 2; ++bj) { const size_t row = (size_t)(row0 + ai * 128 + m * 16); const int col = col0 + bj * 128;
                    v2u g; g.x = bj ? gw[m].z : gw[m].x; g.y = bj ? gw[m].w : gw[m].y; const v4u p = pw[m][bj]; f32x4 v0 = acc[ai][bj][m][0], v1 = acc[ai][bj][m][1]; constexpr float s8 = 1.f / 255.f;
                    v0[0] = v0[0] * ((float)(g.x & 255u) * s8) + pg8::bf_lo(p.x); v0[1] = v0[1] * ((float)((g.x >> 8) & 255u) * s8) + pg8::bf_hi(p.x);
                    v0[2] = v0[2] * ((float)((g.x >> 16) & 255u) * s8) + pg8::bf_lo(p.y); v0[3] = v0[3] * ((float)(g.x >> 24) * s8) + pg8::bf_hi(p.y);
                    v1[0] = v1[0] * ((float)(g.y & 255u) * s8) + pg8::bf_lo(p.z); v1[1] = v1[1] * ((float)((g.y >> 8) & 255u) * s8) + pg8::bf_hi(p.z);
                    v1[2] = v1[2] * ((float)((g.y >> 16) & 255u) * s8) + pg8::bf_lo(p.w); v1[3] = v1[3] * ((float)(g.y >> 24) * s8) + pg8::bf_hi(p.w);
                    v4u w; w.x = pk2(v0[0], v0[1]); w.y = pk2(v0[2], v0[3]); w.z = pk2(v1[0], v1[1]); w.w = pk2(v1[2], v1[3]); *(v4u*)(merged + row * D + col) = w; }
            asm volatile("" ::: "memory");
        }
    }
};
template <bool RB16> struct EpiResid { static constexpr bool PERM = true; const void* xres; bf16* z;
    __device__ __forceinline__ void operator()(const Acc& acc, const Unit& u, int wr, int wc, int fr, int fq) const {
        const int row0 = u.pm * 256 + wr * 64 + fr, col0 = u.pn * 256 + wc * 32 + 8 * fq;
#pragma unroll
        for (int ai = 0; ai < 2; ++ai) {
            f32x4 xr[4][2][2];
#pragma unroll
            for (int m = 0; m < 4; ++m) { const size_t off = (size_t)(row0 + ai * 128 + m * 16) * D + col0;
#pragma unroll
                for (int bj = 0; bj < 2; ++bj) {
                    if constexpr (RB16) { const v4u w = *(const v4u*)((const bf16*)xres + off + bj * 128);
                        xr[m][bj][0] = (f32x4){pg8::bf_lo(w.x), pg8::bf_hi(w.x), pg8::bf_lo(w.y), pg8::bf_hi(w.y)}; xr[m][bj][1] = (f32x4){pg8::bf_lo(w.z), pg8::bf_hi(w.z), pg8::bf_lo(w.w), pg8::bf_hi(w.w)}; }
                    else {
#pragma unroll
                        for (int n = 0; n < 2; ++n) xr[m][bj][n] = *(const f32x4*)((const float*)xres + off + bj * 128 + n * 4); } } }
            asm volatile("" ::: "memory");
#pragma unroll
            for (int m = 0; m < 4; ++m) { const size_t off = (size_t)(row0 + ai * 128 + m * 16) * D + col0;
#pragma unroll
                for (int bj = 0; bj < 2; ++bj) { const f32x4 v0 = xr[m][bj][0] * ALPHA + acc[ai][bj][m][0], v1 = xr[m][bj][1] * ALPHA + acc[ai][bj][m][1];
                    v4u w; w.x = pk2(v0[0], v0[1]); w.y = pk2(v0[2], v0[3]); w.z = pk2(v1[0], v1[1]); w.w = pk2(v1[2], v1[3]); *(v4u*)(z + off + bj * 128) = w; } }
            asm volatile("" ::: "memory");
        }
    }
};

constexpr int NWAVES = 8;
constexpr int RING_OFF = 0, RING_BYTES = 131072;
constexpr int SCR_BYTES = 147456;
constexpr int MISC_OFF = SCR_BYTES;
constexpr int LDS_BYTES = 163840;
constexpr int PH_CVT = 0, PH_L0 = 1, PH_PER_LAYER = 10;
constexpr int P_INPROJ = 0, P_MIX = 1, P_SCAN = 2, P_HOUT = 3, P_BRANCH = 4, P_WO = 5, P_ROUTE = 6, P_GU = 7, P_DOWN = 8, P_COMB = 9;
constexpr int N_PHASES = PH_L0 + 2 * PH_PER_LAYER;

constexpr int NCV = 64;
#define CV_UNITS 5
#define GM_UNITS 14
struct Frame { LAS unsigned char* lds; int tid, lane, wave, G, gw, NGW; };

__device__ __forceinline__ void xpose_item(const float* W, int N, int k0, int n0, bf16* WTrow0, int ldk, LAS float* scr, int lane) {
    const int kk = lane >> 3, nn = (lane & 7) * 4;
    f32x4 v[8];
#pragma unroll
    for (int i = 0; i < 8; ++i) v[i] = *(const f32x4*)(W + (size_t)(k0 + kk + 8 * i) * N + n0 + nn);
#pragma unroll
    for (int i = 0; i < 8; ++i) { LAS float* s = scr + (kk + 8 * i) * 33 + nn; s[0] = v[i][0]; s[1] = v[i][1]; s[2] = v[i][2]; s[3] = v[i][3]; }
    LDS_WAIT(); asm volatile("" ::: "memory");
    const int c = lane & 7;
#pragma unroll
    for (int j = 0; j < 4; ++j) { const int n = (lane >> 3) + 8 * j; const LAS float* s = scr + (8 * c) * 33 + n;
        v4u o; o.x = pk2(s[0 * 33], s[1 * 33]); o.y = pk2(s[2 * 33], s[3 * 33]); o.z = pk2(s[4 * 33], s[5 * 33]); o.w = pk2(s[6 * 33], s[7 * 33]);
        *(v4u*)(WTrow0 + (size_t)n * ldk + 8 * c) = o; }
    LDS_WAIT(); asm volatile("" ::: "memory");
}
__device__ __forceinline__ void xpose_matrix(const Frame& F, const float* W, int K, int N, bf16* WT, int ldk, int mode, unsigned& gbase) {
    const int nblk = N / 32, nitems = (K / 64) * nblk;
    LAS float* scr = (LAS float*)(F.lds + RING_OFF + F.wave * 8704);
    int it = (int)(((unsigned)F.gw + (unsigned)F.NGW - gbase % (unsigned)F.NGW) % (unsigned)F.NGW);
    for (; it < nitems; it += F.NGW) {
        const int kb = it / nblk, nb = it % nblk, n0 = nb * 32, k0 = kb * 64;
        const int drow = mode == 0 ? n0 : ((n0 >> 7) * 256 + (n0 & 127) + (mode == 2 ? 128 : 0));
        xpose_item(W, N, k0, n0, WT + (size_t)drow * ldk + k0, ldk, scr, F.lane);
    }
    gbase += (unsigned)nitems;
}
__device__ __forceinline__ void cvt_rows(const Frame& F, const float* in, bf16* out, size_t n8) {
    for (size_t i = (size_t)blockIdx.x * 512 + F.tid; i < n8; i += (size_t)F.G * 512) {
        const f32x4 a = *(const f32x4*)(in + i * 8), b = *(const f32x4*)(in + i * 8 + 4);
        v4u w; w.x = pk2(a[0], a[1]); w.y = pk2(a[2], a[3]); w.z = pk2(b[0], b[1]); w.w = pk2(b[2], b[3]);
        *(v4u*)(out + i * 8) = w; }
}
__device__ __forceinline__ void cvt_router(const Frame& F, const float* rw, unsigned char* ws) {
    for (int i = blockIdx.x * 512 + F.tid; i < 2 * D * NE; i += F.G * 512) { const int l = i / (D * NE), k = (i / NE) % D, e = i % NE;
        const float w = rw[i]; const bf16 h = f2bf(w); const bf16 lo = f2bf(w - bf2f(h));
        bf16* dst = (bf16*)(ws + WS_RW + l * RW_L); dst[(size_t)e * D + k] = h; dst[(size_t)(NE + e) * D + k] = lo; }
}
struct XItem { const float* src; bf16* dst; int N, ldk; };
__device__ __forceinline__ void xp_decode(int I, const float* wg, const float* wu, const float* wd, const float* sg, const float* su, const float* sd, unsigned char* ws, XItem& x) {
    const int e = I / 1536, rem = I % 1536, m = rem >> 9, it = rem & 511;
    if (m < 2) { const float* W = m == 0 ? (e < NE ? wg + (size_t)e * D * EH : sg) : (e < NE ? wu + (size_t)e * D * EH : su);
        const int kb = it >> 4, nb = it & 15, n0 = nb * 32, k0 = kb * 64; const int drow = (n0 >> 7) * 256 + (n0 & 127) + (m == 1 ? 128 : 0);
        x.src = W + (size_t)k0 * EH + n0; x.N = EH; x.ldk = D; x.dst = (bf16*)(ws + WS_WGU + (size_t)e * WGU_E) + (size_t)drow * D + k0; }
    else { const float* W = e < NE ? wd + (size_t)e * EH * D : sd; const int kb = it >> 6, nb = it & 63, n0 = nb * 32, k0 = kb * 64;
        x.src = W + (size_t)k0 * D + n0; x.N = D; x.ldk = EH; x.dst = (bf16*)(ws + WS_WDN + (size_t)e * WDN_E) + (size_t)n0 * EH + k0; }
}
__device__ __forceinline__ void xp_load(const XItem& x, int lane, f32x4 (&v)[8]) {
    const int kk = lane >> 3, nn = (lane & 7) * 4;
#pragma unroll
    for (int i = 0; i < 8; ++i) v[i] = __builtin_nontemporal_load((const f32x4*)(x.src + (size_t)(kk + 8 * i) * x.N + nn));
}
__device__ __forceinline__ void xp_store(const XItem& x, const f32x4 (&v)[8], LAS float* scr, int lane) {
    const int kk = lane >> 3, nn = (lane & 7) * 4;
#pragma unroll
    for (int i = 0; i < 8; ++i) { LAS float* s = scr + (kk + 8 * i) * 33 + nn; s[0] = v[i][0]; s[1] = v[i][1]; s[2] = v[i][2]; s[3] = v[i][3]; }
    LDS_WAIT(); asm volatile("" ::: "memory");
    const int c = lane & 7;
#pragma unroll
    for (int j = 0; j < 4; ++j) { const int n = (lane >> 3) + 8 * j; const LAS float* s = scr + (8 * c) * 33 + n;
        v4u o; o.x = pk2(s[0 * 33], s[1 * 33]); o.y = pk2(s[2 * 33], s[3 * 33]); o.z = pk2(s[4 * 33], s[5 * 33]); o.w = pk2(s[6 * 33], s[7 * 33]);
        __builtin_nontemporal_store(o, (v4u*)(x.dst + (size_t)n * x.ldk + 8 * c)); }
    LDS_WAIT(); asm volatile("" ::: "memory");
}
__device__ __forceinline__ void cvt_experts(const Frame& F, const float* wg, const float* wu, const float* wd, const float* sg, const float* su, const float* sd, unsigned char* ws, unsigned& gbase) {
    (void)gbase;
    LAS float* scr = (LAS float*)(F.lds + RING_OFF + F.wave * 8704);
    const int total = (NE + 1) * 1536;
    XItem A, B; f32x4 va[8], vb[8];
    int I = F.gw;
    if (I < total) { xp_decode(I, wg, wu, wd, sg, su, sd, ws, A); xp_load(A, F.lane, va); }
    for (; I < total; I += 2 * F.NGW) {
        const int I2 = I + F.NGW, I3 = I + 2 * F.NGW;
        if (I2 < total) { xp_decode(I2, wg, wu, wd, sg, su, sd, ws, B); xp_load(B, F.lane, vb); }
        xp_store(A, va, scr, F.lane);
        if (I2 < total) { if (I3 < total) { xp_decode(I3, wg, wu, wd, sg, su, sd, ws, A); xp_load(A, F.lane, va); }
            xp_store(B, vb, scr, F.lane); }
    }
}
constexpr int NVO_OFF = MISC_OFF + 1024;  static_assert(NVO_OFF == pg8::PG8_NVO_OFF, "nvo");
constexpr int PLAN_OFF = NVO_OFF + 8192;
constexpr int PLAN_TB = PLAN_OFF, PLAN_CN = PLAN_OFF + 66 * 4, PLAN_TE = PLAN_OFF + 132 * 4;
constexpr int MAXTILES = 640;
#ifndef ROUTE_PROBE
#define ROUTE_PROBE 0
#endif
static_assert(PLAN_TE + MAXTILES * 4 <= LDS_BYTES, "LDS map");

__device__ __forceinline__ float wave_sum(float v, int lane) {
#pragma unroll
    for (int o = 1; o < 64; o <<= 1) v += shx(v, o, lane);
    return v;
}
__device__ __forceinline__ void moe_plan(const Frame& F, const unsigned* cnt) {
    LAS unsigned* tb = (LAS unsigned*)(F.lds + PLAN_TB); LAS unsigned* cn = (LAS unsigned*)(F.lds + PLAN_CN); LAS unsigned* te = (LAS unsigned*)(F.lds + PLAN_TE);
    __syncthreads();
    if (F.tid <= NE) { unsigned run = 0; for (int e = 0; e < F.tid; ++e) run += (__hip_atomic_load(cnt + e, RLX_AGENT) + 255u) >> 8;
        tb[F.tid] = run; cn[F.tid] = F.tid < NE ? __hip_atomic_load(cnt + F.tid, RLX_AGENT) : (unsigned)NTOK; if (F.tid == NE) tb[NE + 1] = run + NTOK / 256; }
    __syncthreads();
    for (int t = F.tid; t < MAXTILES; t += NWAVES * 64) { unsigned e = 0; for (int q = 1; q <= NE; ++q) if (tb[q] <= (unsigned)t) e = q; te[t] = e; }
    __syncthreads();
}
template <bool GU> struct MoeSched { static constexpr bool GATHER = GU;
    const LAS unsigned* tb; const LAS unsigned* cn; const LAS unsigned* te; int nunits, nN, G, c; const char* Abase; const char* Bbase; const int* list;
    __device__ __forceinline__ void init(const Frame& F, const void* A_, const void* B_, const int* list_) {
        tb = (const LAS unsigned*)(F.lds + PLAN_TB); cn = (const LAS unsigned*)(F.lds + PLAN_CN); te = (const LAS unsigned*)(F.lds + PLAN_TE);
        nN = GU ? 4 : 8; nunits = (int)tb[NE + 1] * nN; G = F.G; const int bx = blockIdx.x; c = (G % 8 == 0) ? (bx % 8) * (G / 8) + bx / 8 : bx;
        Abase = (const char*)A_; Bbase = (const char*)B_; list = list_; }
    __device__ __forceinline__ bool next(int i, Unit& u) const {
        constexpr int RUN = GU ? 2 : 4; const int hs = c + G * (i / RUN), per = nN / RUN;
        const int tile = hs / per, pn = (hs % per) * RUN + (i % RUN); if (tile * nN >= nunits) return false;
        const int e = (int)te[tile];
        u.pm = tile; u.pn = pn;
        if (GU) { u.A = Abase; u.B = Bbase + (size_t)e * WGU_E + (size_t)pn * 256 * D * 2; u.list = e < NE ? list + (size_t)e * LISTCAP : nullptr; u.m0 = (tile - (int)tb[e]) * 256; u.cnt = (int)cn[e]; }
        else { u.A = Abase + (size_t)tile * 256 * EH * 2; u.B = Bbase + (size_t)e * WDN_E + (size_t)pn * 256 * EH * 2; u.list = nullptr; u.m0 = 0; u.cnt = 0; }
        return true; }
    __device__ __forceinline__ unsigned avoff(const Unit& u, int h, int R, int C, int K_) const {
        if (GU) { const int pos = u.m0 + h * 128 + R; int row = 0; if (pos < u.cnt) row = u.list ? u.list[pos] : pos; return (unsigned)((row * K_ + C) * 2); }
        else return (unsigned)(((h * 128 + R) * K_ + C) * 2); }
};
struct EpiSwiGLU { static constexpr bool PERM = true; bf16* H;
    __device__ __forceinline__ void operator()(const Acc& acc, const Unit& u, int wr, int wc, int fr, int fq) const {
        const int row0 = u.pm * 256 + wr * 64 + fr, col0 = u.pn * 128 + wc * 32 + 8 * fq;
#pragma unroll
        for (int ai = 0; ai < 2; ++ai)
#pragma unroll
            for (int m = 0; m < 4; ++m) { bf16* rowp = H + (size_t)(row0 + ai * 128 + m * 16) * EH + col0;
                float hv[8];
#pragma unroll
                for (int n = 0; n < 2; ++n)
#pragma unroll
                    for (int j = 0; j < 4; ++j) { const float g = acc[ai][0][m][n][j], uu = acc[ai][1][m][n][j]; hv[n * 4 + j] = g * pg8::sigmoidf_(g) * uu; }
                v4u w; w.x = pk2(hv[0], hv[1]); w.y = pk2(hv[2], hv[3]); w.z = pk2(hv[4], hv[5]); w.w = pk2(hv[6], hv[7]);
                *(v4u*)rowp = w; }
    }
};

struct EpiY8 { static constexpr bool PERM = true; unsigned char* Y8; bf16* YS;
    __device__ __forceinline__ void operator()(const Acc& acc, const Unit& u, int wr, int wc, int fr, int fq) const {
        const int row0 = u.pm * 256 + wr * 64 + fr, pos0 = u.pn * 256 + wc * 64 + fq * 16;
#pragma unroll
        for (int ai = 0; ai < 2; ++ai)
#pragma unroll
            for (int m = 0; m < 4; ++m) { const size_t row = (size_t)(row0 + ai * 128 + m * 16);
                v4u w; unsigned sw = 0u;
#pragma unroll
                for (int bj = 0; bj < 2; ++bj) { const f32x4 v0 = acc[ai][bj][m][0], v1 = acc[ai][bj][m][1];
                    const float am = fmaxf(fmaxf(fmaxf(fabsf(v0[0]), fabsf(v0[1])), fmaxf(fabsf(v0[2]), fabsf(v0[3]))), fmaxf(fmaxf(fabsf(v1[0]), fabsf(v1[1])), fmaxf(fabsf(v1[2]), fabsf(v1[3]))));
                    const unsigned sb = f2bf(am * (1.f / 127.f)); const float sc = __uint_as_float(sb << 16); const float inv = sc > 0.f ? __builtin_amdgcn_rcpf(sc) : 0.f;
                    unsigned q[8];
#pragma unroll
                    for (int j = 0; j < 4; ++j) { q[j] = (unsigned)fminf(rintf(v0[j] * inv + 128.f), 255.f); q[4 + j] = (unsigned)fminf(rintf(v1[j] * inv + 128.f), 255.f); }
                    const unsigned lo = q[0] | (q[1] << 8) | (q[2] << 16) | (q[3] << 24), hi = q[4] | (q[5] << 8) | (q[6] << 16) | (q[7] << 24);
                    if (bj == 0) { w.x = lo; w.y = hi; sw = sb; } else { w.z = lo; w.w = hi; sw |= sb << 16; } }
                *(v4u*)(Y8 + row * D + pos0) = w; *(unsigned*)(YS + row * (D / 8) + (pos0 >> 3)) = sw; }
    }
};
__device__ __forceinline__ void route_phase(const Frame& F, const bf16* __restrict__ Z, const float* __restrict__ g, const float* __restrict__ bb, const bf16* __restrict__ rwh, const float* __restrict__ rb,
                                            bf16* __restrict__ X1L, bf16* __restrict__ X1BF, unsigned* cnt, int* list, int* tokslot, float* tokw, bool dispatch = true) {
    LAS float* part = (LAS float*)(F.lds + RING_OFF);
    LAS float* lg = part + 4 * 4096;
    LAS float* sl = lg + 64 * 65;
    LAS unsigned* cntL = (LAS unsigned*)(sl + 64 * 65);
    LAS unsigned* baseL = cntL + 64;
    LAS unsigned* ee = baseL + 64;
    LAS unsigned* pl = ee + 512;
    LAS float* ww = (LAS float*)(pl + 512);
    for (int grp = blockIdx.x; grp < NTOK / 64; grp += F.G) {
        const int t0 = grp * 64;
        if (F.tid < 64) cntL[F.tid] = 0u;
        for (int rp_ = 0; rp_ < (ROUTE_PROBE == 1 ? 2 : 1); ++rp_)
#pragma unroll 2
        for (int q = 0; q < 8; ++q) {
            const int t = t0 + F.wave * 8 + q;
            const v2u* zr = (const v2u*)(Z + (size_t)t * D) + F.lane;
            f32x4 v[8]; float s = 0.f;
#pragma unroll
            for (int j = 0; j < 8; ++j) { const v2u zw = zr[64 * j]; v[j] = (f32x4){pg8::bf_lo(zw.x), pg8::bf_hi(zw.x), pg8::bf_lo(zw.y), pg8::bf_hi(zw.y)}; s += (v[j][0] + v[j][1]) + (v[j][2] + v[j][3]); }
            const float mean = wave_sum(s, F.lane) * (1.f / D); float s2 = 0.f;
#pragma unroll
            for (int j = 0; j < 8; ++j) { v[j] = v[j] - mean; s2 += (v[j][0] * v[j][0] + v[j][1] * v[j][1]) + (v[j][2] * v[j][2] + v[j][3] * v[j][3]); }
            const float rstd = 1.f / sqrtf(wave_sum(s2, F.lane) * (1.f / D) + LN_EPS);
            v2u* xl = (v2u*)(X1L + (size_t)t * D) + F.lane; v2u* xb = (v2u*)(X1BF + (size_t)t * D) + F.lane;
#pragma unroll
            for (int j = 0; j < 8; ++j) { const f32x4 gg = ((const f32x4*)g)[F.lane + 64 * j], bv = ((const f32x4*)bb)[F.lane + 64 * j];
                const f32x4 y = v[j] * rstd * gg + bv; v2u w; w.x = pk2(y[0], y[1]); w.y = pk2(y[2], y[3]); xb[64 * j] = w;
                v2u lo; lo.x = pk2(y[0] - pg8::bf_lo(w.x), y[1] - pg8::bf_hi(w.x)); lo.y = pk2(y[2] - pg8::bf_lo(w.y), y[3] - pg8::bf_hi(w.y)); xl[64 * j] = lo; }
        }
        VM_WAIT(); __syncthreads();
        for (int rp_ = 0; rp_ < (ROUTE_PROBE == 2 ? 2 : 1); ++rp_)
        { const int r = F.lane & 15, kq = F.lane >> 4, kb = (F.wave & 3) * 512, th = F.wave >> 2;
          const bf16* xh = X1BF + (size_t)(t0 + th * 32 + r) * D + kb + 8 * kq;
          const bf16* xl = X1L + (size_t)(t0 + th * 32 + r) * D + kb + 8 * kq;
          const bf16* wh = rwh + (size_t)r * D + kb + 8 * kq;
          f32x4 acc[2][4];
#pragma unroll
          for (int tt = 0; tt < 2; ++tt)
#pragma unroll
              for (int nb = 0; nb < 4; ++nb) acc[tt][nb] = (f32x4){0.f, 0.f, 0.f, 0.f};
          bf16x8 xA[2][2], xB[2][2]; bf16x8 hA[4], lA[4], hB[4], lB[4];
#define RT_LOAD(X, H, L, ks) do { const int k_ = ((ks) < 16 ? (ks) : 15) * 32; _Pragma("unroll") for (int tt = 0; tt < 2; ++tt) { X[tt][0] = *(const bf16x8*)(xh + (size_t)tt * 16 * D + k_); X[tt][1] = *(const bf16x8*)(xl + (size_t)tt * 16 * D + k_); } \
              _Pragma("unroll") for (int nb = 0; nb < 4; ++nb) { H[nb] = *(const bf16x8*)(wh + (size_t)nb * 16 * D + k_); L[nb] = *(const bf16x8*)(wh + (size_t)(64 + nb * 16) * D + k_); } } while (0)
#define RT_MMA(X, H, L) do { \
              _Pragma("unroll") for (int tt = 0; tt < 2; ++tt) _Pragma("unroll") for (int nb = 0; nb < 4; ++nb) acc[tt][nb] = __builtin_amdgcn_mfma_f32_16x16x32_bf16(X[tt][1], H[nb], acc[tt][nb], 0, 0, 0); \
              _Pragma("unroll") for (int tt = 0; tt < 2; ++tt) _Pragma("unroll") for (int nb = 0; nb < 4; ++nb) acc[tt][nb] = __builtin_amdgcn_mfma_f32_16x16x32_bf16(X[tt][0], L[nb], acc[tt][nb], 0, 0, 0); \
              _Pragma("unroll") for (int tt = 0; tt < 2; ++tt) _Pragma("unroll") for (int nb = 0; nb < 4; ++nb) acc[tt][nb] = __builtin_amdgcn_mfma_f32_16x16x32_bf16(X[tt][0], H[nb], acc[tt][nb], 0, 0, 0); } while (0)
          RT_LOAD(xA, hA, lA, 0);
#pragma unroll 1
          for (int ks = 0; ks < 16; ks += 2) {
              RT_LOAD(xB, hB, lB, ks + 1); RT_MMA(xA, hA, lA);
              RT_LOAD(xA, hA, lA, ks + 2); RT_MMA(xB, hB, lB);
          }
#undef RT_LOAD
#undef RT_MMA
#pragma unroll
          for (int tt = 0; tt < 2; ++tt)
#pragma unroll
              for (int nb = 0; nb < 4; ++nb)
#pragma unroll
                  for (int reg = 0; reg < 4; ++reg) part[(F.wave & 3) * 4096 + (th * 32 + tt * 16 + 4 * kq + reg) * 64 + nb * 16 + r] = acc[tt][nb][reg];
        }
        __syncthreads();
        for (int i = F.tid; i < 64 * 64; i += NWAVES * 64) { const int tk = i >> 6, e = i & 63; const float lgt = (part[i] + part[4096 + i]) + (part[8192 + i] + part[12288 + i]);
            const float sc = 1.f / (1.f + __expf(-lgt)); lg[tk * 65 + e] = sc; sl[tk * 65 + e] = sc + rb[e]; }
        __syncthreads();
        for (int rp_ = 0; rp_ < (ROUTE_PROBE == 3 ? 2 : 1); ++rp_)
        { const bool lastrp = (rp_ == (ROUTE_PROBE == 3 ? 1 : 0));
          const int tk = F.wave * 8 + (F.lane >> 3), gq = F.lane & 7, lane = F.lane;
          float sv[8], cv[8];
#pragma unroll
          for (int j = 0; j < 8; ++j) { sv[j] = sl[tk * 65 + gq * 8 + j]; cv[j] = lg[tk * 65 + gq * 8 + j]; }
          float m1 = -INFINITY, m2 = -INFINITY;
#pragma unroll
          for (int j = 0; j < 8; ++j) { const float x = sv[j]; const bool g1 = x > m1; m2 = g1 ? m1 : fmaxf(m2, x); m1 = g1 ? x : m1; }
          const float gs = m1 + m2;
          int rank = 0;
#pragma unroll
          for (int o = 1; o < 8; ++o) { const float og = shx(gs, o, lane); const int oq = gq ^ o; rank += (og > gs || (og == gs && oq < gq)) ? 1 : 0; }
          const bool gsel = rank < 4;
          unsigned used = gsel ? 0u : 0xffu;
          float wsum = 0.f; float my_sc = 0.f; int my_e = 0;
#pragma unroll
          for (int i = 0; i < 8; ++i) {
              float bv = -INFINITY, bs = 0.f; int be = 64;
#pragma unroll
              for (int j = 0; j < 8; ++j) { const bool ok = !((used >> j) & 1u) && sv[j] > bv; bv = ok ? sv[j] : bv; bs = ok ? cv[j] : bs; be = ok ? gq * 8 + j : be; }
#pragma unroll
              for (int o = 1; o < 8; o <<= 1) { const float ov = shx(bv, o, lane), os = shx(bs, o, lane); const int oe = __float_as_int(shx(__int_as_float(be), o, lane));
                  const bool tk_o = ov > bv || (ov == bv && oe < be); bv = tk_o ? ov : bv; bs = tk_o ? os : bs; be = tk_o ? oe : be; }
              if ((be >> 3) == gq) used |= 1u << (be & 7);
              wsum += bs; if (gq == i) { my_sc = bs; my_e = be; }
          }
          const int slot = tk * 8 + gq;
          ee[slot] = (unsigned)my_e; ww[slot] = my_sc * (RSCALE / wsum);
          pl[slot] = __hip_atomic_fetch_add(cntL + my_e, (dispatch && lastrp) ? 1u : 0u, __ATOMIC_RELAXED, __HIP_MEMORY_SCOPE_WORKGROUP);
        }
        __syncthreads();
        if (F.tid < 64) { const unsigned n = cntL[F.tid]; baseL[F.tid] = n ? __hip_atomic_fetch_add(cnt + F.tid, n, RLX_AGENT) : 0u; }
        __syncthreads();
        if (dispatch) { const int tk = F.tid >> 3, i = F.tid & 7; const unsigned e = ee[F.tid]; const unsigned pos = baseL[e] + pl[F.tid]; const int t = t0 + tk;
          list[(size_t)e * LISTCAP + pos] = t; tokslot[t * 8 + i] = (int)(e * LISTCAP + pos); tokw[t * 8 + i] = ww[F.tid]; }
        __syncthreads();
    }
}
__device__ __forceinline__ void combine_phase(const Frame& F, const bf16* X1B, const unsigned char* Y8, const bf16* YS, const int* tokslot, const float* tokw, const float* g, const float* bb, float* OUT, bf16* XBF, bool last) {
    const LAS unsigned* tb = (const LAS unsigned*)(F.lds + PLAN_TB);
    LAS int* rw = (LAS int*)(F.lds + RING_OFF) + F.wave * 32;
#define CB_LOAD(W, S, ROW) do { const int r_ = __builtin_amdgcn_readfirstlane(ROW); const v2u* yr_ = (const v2u*)(Y8 + (size_t)r_ * D) + F.lane; const bf16* ys_ = YS + (size_t)r_ * (D / 8) + F.lane; \
        _Pragma("unroll") for (int j = 0; j < 4; ++j) { W[j] = yr_[64 * j]; S[j] = ys_[64 * j]; } } while (0)
#define CB_ACC(W, S, WT) do { const float wt_ = __int_as_float(__builtin_amdgcn_readfirstlane(WT)); _Pragma("unroll") for (int j = 0; j < 4; ++j) { const float sc = bf2f(S[j]) * wt_, c0 = -128.f * sc; const unsigned x = W[j].x, y = W[j].y; \
        v[j][0] += sc * (float)(x & 255u) + c0; v[j][1] += sc * (float)((x >> 8) & 255u) + c0; v[j][2] += sc * (float)((x >> 16) & 255u) + c0; v[j][3] += sc * (float)(x >> 24) + c0; \
        v[j][4] += sc * (float)(y & 255u) + c0; v[j][5] += sc * (float)((y >> 8) & 255u) + c0; v[j][6] += sc * (float)((y >> 16) & 255u) + c0; v[j][7] += sc * (float)(y >> 24) + c0; } } while (0)
    const int cl = (F.lane >> 5) * 256 + (F.lane & 1) * 128 + ((F.lane >> 3) & 3) * 32 + ((F.lane >> 1) & 3) * 8;
    for (int t = F.gw; t < NTOK; t += F.NGW) {
        if (F.lane < 8) { const int sl = tokslot[t * 8 + F.lane]; rw[F.lane] = (int)tb[sl / LISTCAP] * 256 + (sl % LISTCAP); rw[16 + F.lane] = __float_as_int(tokw[t * 8 + F.lane]); }
        if (F.lane == 8) { rw[8] = (int)tb[NE] * 256 + t; rw[24] = __float_as_int(1.f); }
        LDS_WAIT(); asm volatile("" ::: "memory");
        float v[4][8]; float s = 0.f;
        v2u wa[4], wb[4], wc[4]; bf16 sa[4], sb2[4], sc2[4];
        CB_LOAD(wa, sa, rw[0]); CB_LOAD(wb, sb2, rw[1]); CB_LOAD(wc, sc2, rw[2]);
#pragma unroll
        for (int j = 0; j < 4; ++j) { const v4u xw = *(const v4u*)(X1B + (size_t)t * D + 512 * j + cl);
            v[j][0] = pg8::bf_lo(xw.x) * ALPHA; v[j][1] = pg8::bf_hi(xw.x) * ALPHA; v[j][2] = pg8::bf_lo(xw.y) * ALPHA; v[j][3] = pg8::bf_hi(xw.y) * ALPHA;
            v[j][4] = pg8::bf_lo(xw.z) * ALPHA; v[j][5] = pg8::bf_hi(xw.z) * ALPHA; v[j][6] = pg8::bf_lo(xw.w) * ALPHA; v[j][7] = pg8::bf_hi(xw.w) * ALPHA; }
#pragma unroll 1
        for (int i = 0; i < 9; i += 3) {
            CB_ACC(wa, sa, rw[16 + i]); if (i < 6) CB_LOAD(wa, sa, rw[i + 3]);
            CB_ACC(wb, sb2, rw[17 + i]); if (i < 6) CB_LOAD(wb, sb2, rw[i + 4]);
            CB_ACC(wc, sc2, rw[18 + i]); if (i < 6) CB_LOAD(wc, sc2, rw[i + 5]);
        }
        asm volatile("" ::: "memory");
#pragma unroll
        for (int j = 0; j < 4; ++j)
#pragma unroll
            for (int e = 0; e < 8; ++e) s += v[j][e];
        const float mean = wave_sum(s, F.lane) * (1.f / D); float s2 = 0.f;
#pragma unroll
        for (int j = 0; j < 4; ++j)
#pragma unroll
            for (int e = 0; e < 8; ++e) { v[j][e] -= mean; s2 += v[j][e] * v[j][e]; }
        const float rstd = 1.f / sqrtf(wave_sum(s2, F.lane) * (1.f / D) + LN_EPS);
#pragma unroll
        for (int j = 0; j < 4; ++j) { const int c0 = cl + 512 * j; const f32x4 g0 = *(const f32x4*)(g + c0), g1 = *(const f32x4*)(g + c0 + 4), b0 = *(const f32x4*)(bb + c0), b1 = *(const f32x4*)(bb + c0 + 4);
            f32x4 y0, y1;
#pragma unroll
            for (int e = 0; e < 4; ++e) { y0[e] = v[j][e] * rstd * g0[e] + b0[e]; y1[e] = v[j][4 + e] * rstd * g1[e] + b1[e]; }
            if (last) { *(f32x4*)(OUT + (size_t)t * D + c0) = y0; *(f32x4*)(OUT + (size_t)t * D + c0 + 4) = y1; }
            else { v4u w; w.x = pk2(y0[0], y0[1]); w.y = pk2(y0[2], y0[3]); w.z = pk2(y1[0], y1[1]); w.w = pk2(y1[2], y1[3]); *(v4u*)(XBF + (size_t)t * D + c0) = w; } }
    }
#undef CB_LOAD
#undef CB_ACC
}
constexpr size_t R2_UT = 0, R2_OI = 48 * MiB, R2_QP = 96 * MiB, R2_DEC = 120 * MiB;
constexpr int NHU = NB * HGH * (SEQ / 64);
typedef __attribute__((address_space(3))) bf16 lbf16;
__device__ __forceinline__ void unpack8(const v4u w, float (&f)[8]) {
    f[0] = pg8::bf_lo(w.x); f[1] = pg8::bf_hi(w.x); f[2] = pg8::bf_lo(w.y); f[3] = pg8::bf_hi(w.y); f[4] = pg8::bf_lo(w.z); f[5] = pg8::bf_hi(w.z); f[6] = pg8::bf_lo(w.w); f[7] = pg8::bf_hi(w.w); }
__device__ __forceinline__ float exp_c(float x) { return __expf(fminf(x, 80.f)); }

__device__ __forceinline__ void conv_part(const Frame& F, const bf16* proj, const float* cw, bf16* YA, bf16* YX) {
    for (int i = blockIdx.x * 512 + F.tid; i < NTOK * 32; i += F.G * 512) *(v4u*)(YX + (size_t)(i >> 5) * YXW + XAW + (i & 31) * 8) = (v4u){0u, 0u, 0u, 0u};
    for (int i = blockIdx.x * 512 + F.tid; i < NTOK * (CW / 8); i += F.G * 512) {
        const int t = i / (CW / 8), c = (i % (CW / 8)) * 8, pos = t & (SEQ - 1);
        const bf16* r = proj + (size_t)t * INC;
        float u0[8], c0[8], b0[8], u1[8], c1[8], u2[8], c2[8], w0[8], w1[8], w2[8];
        unpack8(*(const v4u*)(r + C_U + c), u0); unpack8(*(const v4u*)(r + C_C + c), c0); unpack8(*(const v4u*)(r + C_B + c), b0);
        const v4u z4 = {0u, 0u, 0u, 0u};
        unpack8(pos >= 1 ? *(const v4u*)(r - INC + C_U + c) : z4, u1); unpack8(pos >= 1 ? *(const v4u*)(r - INC + C_C + c) : z4, c1);
        unpack8(pos >= 2 ? *(const v4u*)(r - 2 * INC + C_U + c) : z4, u2); unpack8(pos >= 2 ? *(const v4u*)(r - 2 * INC + C_C + c) : z4, c2);
#pragma unroll
        for (int j = 0; j < 8; ++j) { w0[j] = cw[c + j]; w1[j] = cw[CW + c + j]; w2[j] = cw[2 * CW + c + j]; }
        float o[8];
#pragma unroll
        for (int j = 0; j < 8; ++j) o[j] = b0[j] * (w2[j] * c0[j] * u0[j] + w1[j] * c1[j] * u1[j] + w0[j] * c2[j] * u2[j]);
        v4u w; w.x = pk2(o[0], o[1]); w.y = pk2(o[2], o[3]); w.z = pk2(o[4], o[5]); w.w = pk2(o[6], o[7]);
        *(v4u*)(YA + (size_t)t * CW + c) = w;
    }
}

__device__ __forceinline__ void hgrn_local(const Frame& F, const bf16* proj, const float* lbl, int layer, unsigned char* r2) {
    lbf16* QS = (lbf16*)(F.lds);
    lbf16* KS = QS + 64 * 136;
    lbf16* KPT = KS + 64 * 136;
    lbf16* VT = KPT + 128 * 72;
    lbf16* PS = VT + 128 * 72;
    LAS float* SEG = (LAS float*)(PS + 64 * 72);
    bf16* UT = (bf16*)(r2 + R2_UT); bf16* OI = (bf16*)(r2 + R2_OI); bf16* QP = (bf16*)(r2 + R2_QP); float* DEC = (float*)(r2 + R2_DEC);
    const int lane = F.lane, wv = F.wave, r = lane & 15, kq = lane >> 4;
    bf16 rf[16], rq[16], rv[16];
#define HL_LOAD(U) do { const int b_ = (U) / (HGH * 64), h_ = ((U) / 64) % HGH, c_ = (U) % 64; const bf16* p_ = proj + (size_t)(b_ * SEQ + c_ * 64 + (F.tid >> 7) * 16) * INC + h_ * HGD + (F.tid & 127); \
        _Pragma("unroll") for (int i = 0; i < 16; ++i) { rf[i] = p_[(size_t)i * INC + C_F]; rq[i] = p_[(size_t)i * INC + C_Q]; rv[i] = p_[(size_t)i * INC + C_I]; } } while (0)
    if ((int)blockIdx.x < NHU) HL_LOAD((int)blockIdx.x);
    for (int unit = blockIdx.x; unit < NHU; unit += F.G) {
        const int b = unit / (HGH * 64), h = (unit / 64) % HGH, c = unit % 64, t0 = b * SEQ + c * 64;
        { const int col = F.tid & 127, seg = F.tid >> 7, ch = h * HGD + col;
          float lb = 0.f; if (layer == 1) lb = 1.f / (1.f + __expf(lbl[ch] - lbl[HGW + ch]));
          float a[16], kk[16], qv[16], vv[16]; float run = 0.f;
#pragma unroll
          for (int i = 0; i < 16; ++i) {
              const float z = bf2f(rf[i]); const float ez = __expf(-z); const float sg = 1.f / (1.f + ez);
              const float f = lb + (1.f - lb) * sg; kk[i] = (1.f - lb) * ez * sg; run += fmaxf(__logf(f), -60.f); a[i] = run;
              qv[i] = bf2f(rq[i]); vv[i] = bf2f(rv[i]); }
          if (unit + F.G < NHU) HL_LOAD(unit + F.G);
          SEG[seg * 128 + col] = run;
          __syncthreads();
          const float s0 = SEG[col], s1 = SEG[128 + col], s2 = SEG[256 + col], s3 = SEG[384 + col];
          const float base = seg == 0 ? 0.f : (seg == 1 ? s0 : (seg == 2 ? s0 + s1 : s0 + s1 + s2)), bm = s0 + s1, bl = (s0 + s1) + (s2 + s3);
          float kp[16];
#pragma unroll
          for (int i = 0; i < 16; ++i) { const float bb = base + a[i]; const int t = seg * 16 + i;
              QS[t * 136 + col] = f2bf(qv[i] * exp_c(bb - bm)); KS[t * 136 + col] = f2bf(kk[i] * exp_c(bm - bb)); kp[i] = kk[i] * exp_c(bl - bb);
              QP[(size_t)(t0 + t) * HGW + ch] = f2bf(qv[i] * exp_c(bb)); }
          v4u w0, w1; w0.x = pk2(kp[0], kp[1]); w0.y = pk2(kp[2], kp[3]); w0.z = pk2(kp[4], kp[5]); w0.w = pk2(kp[6], kp[7]); w1.x = pk2(kp[8], kp[9]); w1.y = pk2(kp[10], kp[11]); w1.z = pk2(kp[12], kp[13]); w1.w = pk2(kp[14], kp[15]);
          *(LAS v4u*)(KPT + col * 72 + seg * 16) = w0; *(LAS v4u*)(KPT + col * 72 + seg * 16 + 8) = w1;
          w0.x = pk2(vv[0], vv[1]); w0.y = pk2(vv[2], vv[3]); w0.z = pk2(vv[4], vv[5]); w0.w = pk2(vv[6], vv[7]); w1.x = pk2(vv[8], vv[9]); w1.y = pk2(vv[10], vv[11]); w1.z = pk2(vv[12], vv[13]); w1.w = pk2(vv[14], vv[15]);
          *(LAS v4u*)(VT + col * 72 + seg * 16) = w0; *(LAS v4u*)(VT + col * 72 + seg * 16 + 8) = w1;
          if (seg == 0) DEC[(size_t)unit * 128 + col] = exp_c(bl);
        }
        __syncthreads();
        { const int tm = wv >> 1, tn0 = (wv & 1) * 2;
          bf16x8 af[4];
#pragma unroll
          for (int ks = 0; ks < 4; ++ks) af[ks] = *(const LAS bf16x8*)(QS + (tm * 16 + r) * 136 + ks * 32 + kq * 8);
#pragma unroll
          for (int jn = 0; jn < 2; ++jn) { const int tn = tn0 + jn; f32x4 acc = {0.f, 0.f, 0.f, 0.f};
              if (tn <= tm) {
#pragma unroll
                  for (int ks = 0; ks < 4; ++ks) { const bf16x8 bf = *(const LAS bf16x8*)(KS + (tn * 16 + r) * 136 + ks * 32 + kq * 8); acc = __builtin_amdgcn_mfma_f32_16x16x32_bf16(af[ks], bf, acc, 0, 0, 0); } }
#pragma unroll
              for (int g = 0; g < 4; ++g) { const int t = tm * 16 + 4 * kq + g, s = tn * 16 + r; PS[t * 72 + s] = f2bf(s <= t ? acc[g] : 0.f); } } }
        { bf16x8 af[2];
#pragma unroll
          for (int ks = 0; ks < 2; ++ks) af[ks] = *(const LAS bf16x8*)(KPT + (wv * 16 + r) * 72 + ks * 32 + kq * 8);
#pragma unroll
          for (int tv = 0; tv < 8; ++tv) { f32x4 acc = {0.f, 0.f, 0.f, 0.f};
#pragma unroll
              for (int ks = 0; ks < 2; ++ks) { const bf16x8 bf = *(const LAS bf16x8*)(VT + (tv * 16 + r) * 72 + ks * 32 + kq * 8); acc = __builtin_amdgcn_mfma_f32_16x16x32_bf16(af[ks], bf, acc, 0, 0, 0); }
              v2u w; w.x = pk2(acc[0], acc[1]); w.y = pk2(acc[2], acc[3]);
              *(v2u*)(UT + (size_t)unit * 16384 + (tv * 16 + r) * 128 + wv * 16 + 4 * kq) = w; } }
        __syncthreads();
        { const int tm = wv & 3, tvg = wv >> 2;
          bf16x8 pf[2];
#pragma unroll
          for (int ks = 0; ks < 2; ++ks) pf[ks] = *(const LAS bf16x8*)(PS + (tm * 16 + r) * 72 + ks * 32 + kq * 8);
#pragma unroll
          for (int j = 0; j < 4; ++j) { const int tv = tvg * 4 + j; f32x4 acc = {0.f, 0.f, 0.f, 0.f};
#pragma unroll
              for (int ks = 0; ks < 2; ++ks) { const bf16x8 vf = *(const LAS bf16x8*)(VT + (tv * 16 + r) * 72 + ks * 32 + kq * 8); acc = __builtin_amdgcn_mfma_f32_16x16x32_bf16(vf, pf[ks], acc, 0, 0, 0); }
              v2u ow; ow.x = pk2(acc[0], acc[1]); ow.y = pk2(acc[2], acc[3]); *(v2u*)(OI + (size_t)(t0 + tm * 16 + r) * HGW + h * HGD + tv * 16 + 4 * kq) = ow; } }
        __syncthreads();
    }
#undef HL_LOAD
}
__device__ __forceinline__ void hgrn_scan(const Frame& F, const unsigned char* r2, v2u* __restrict__ SB64) {
    const v2u* __restrict__ UT64 = (const v2u*)(r2 + R2_UT); const f32x4* __restrict__ DEC4 = (const f32x4*)(r2 + R2_DEC);
    for (int it = blockIdx.x * 512 + F.tid; it < NB * HGH * 128 * 32; it += F.G * 512) {
        const int bh = it >> 12, v = (it >> 5) & 127, k4 = it & 31;
        f32x4 s = {0.f, 0.f, 0.f, 0.f};
#pragma unroll 8
        for (int c = 0; c < 64; ++c) { const size_t unit = (size_t)bh * 64 + c; const size_t idx = unit * 4096 + v * 32 + k4;
            const v2u w = UT64[idx]; const f32x4 d = DEC4[unit * 32 + k4];
            v2u o; o.x = pk2(s[0], s[1]); o.y = pk2(s[2], s[3]); SB64[idx] = o;
            s[0] = d[0] * s[0] + pg8::bf_lo(w.x); s[1] = d[1] * s[1] + pg8::bf_hi(w.x); s[2] = d[2] * s[2] + pg8::bf_lo(w.y); s[3] = d[3] * s[3] + pg8::bf_hi(w.y); }
    }
}
struct HoutOps { bf16x8 af[4]; bf16x8 bfr[4][4]; };
__device__ __forceinline__ void hout_load(HoutOps& O, int unit, const bf16* proj, const bf16* OI, const bf16* QP, const bf16* SB, int r, int kq, int tm, int tvg) {
    const int b = unit / (HGH * 64), h = (unit / 64) % HGH, c = unit % 64, t0 = b * SEQ + c * 64;
#pragma unroll
    for (int ks = 0; ks < 4; ++ks) O.af[ks] = *(const bf16x8*)(QP + (size_t)(t0 + tm * 16 + r) * HGW + h * HGD + ks * 32 + kq * 8);
#pragma unroll
    for (int j = 0; j < 4; ++j)
#pragma unroll
        for (int ks = 0; ks < 4; ++ks) O.bfr[j][ks] = *(const bf16x8*)(SB + (size_t)unit * 16384 + ((tvg * 4 + j) * 16 + r) * 128 + ks * 32 + kq * 8);
}
__device__ __forceinline__ void hout_compute(const HoutOps& O, int unit, const bf16* proj, const bf16* OI, LAS float* SSQ, const float* gain, bf16* YB, int lane, int r, int kq, int tm, int tvg) {
    const int b = unit / (HGH * 64), h = (unit / 64) % HGH, c = unit % 64, t0 = b * SEQ + c * 64;
    const size_t t = (size_t)(t0 + tm * 16 + r);
    f32x4 oi[4]; v2u gtw[4];
#pragma unroll
    for (int j = 0; j < 4; ++j) { const int ch = h * HGD + (tvg * 4 + j) * 16 + 4 * kq; { const v2u ow = *(const v2u*)(OI + t * HGW + ch); oi[j] = (f32x4){pg8::bf_lo(ow.x), pg8::bf_hi(ow.x), pg8::bf_lo(ow.y), pg8::bf_hi(ow.y)}; } gtw[j] = *(const v2u*)(proj + t * INC + C_G + ch); }
    f32x4 acc[4]; float q = 0.f;
#pragma unroll
    for (int j = 0; j < 4; ++j) { acc[j] = (f32x4){0.f, 0.f, 0.f, 0.f};
#pragma unroll
        for (int ks = 0; ks < 4; ++ks) acc[j] = __builtin_amdgcn_mfma_f32_16x16x32_bf16(O.bfr[j][ks], O.af[ks], acc[j], 0, 0, 0); }
#pragma unroll
    for (int j = 0; j < 4; ++j) { acc[j] += oi[j]; q += (acc[j][0] * acc[j][0] + acc[j][1] * acc[j][1]) + (acc[j][2] * acc[j][2] + acc[j][3] * acc[j][3]); }
    q += shx(q, 16, lane); q += shx(q, 32, lane);
    if (kq == 0) SSQ[tvg * 64 + tm * 16 + r] = q;
    __syncthreads();
    const float rs = rsqrtf((SSQ[tm * 16 + r] + SSQ[64 + tm * 16 + r]) * (1.f / 128.f) + RMS_EPS);
#pragma unroll
    for (int j = 0; j < 4; ++j) { const int ch = h * HGD + (tvg * 4 + j) * 16 + 4 * kq; const f32x4 gn = *(const f32x4*)(gain + ch);
        const float g0 = pg8::bf_lo(gtw[j].x), g1 = pg8::bf_hi(gtw[j].x), g2 = pg8::bf_lo(gtw[j].y), g3 = pg8::bf_hi(gtw[j].y);
        v2u w; w.x = pk2(acc[j][0] * rs * gn[0] * g0 * pg8::sigmoidf_(g0), acc[j][1] * rs * gn[1] * g1 * pg8::sigmoidf_(g1));
        w.y = pk2(acc[j][2] * rs * gn[2] * g2 * pg8::sigmoidf_(g2), acc[j][3] * rs * gn[3] * g3 * pg8::sigmoidf_(g3));
        *(v2u*)(YB + t * HGW + ch) = w; }
    __syncthreads();
}
__device__ __forceinline__ void hgrn_out(const Frame& F, const bf16* proj, const unsigned char* r2, const bf16* SB, const float* gain, bf16* YB) {
    LAS float* SSQ = (LAS float*)F.lds;
    const bf16* OI = (const bf16*)(r2 + R2_OI); const bf16* QP = (const bf16*)(r2 + R2_QP);
    const int lane = F.lane, wv = F.wave, r = lane & 15, kq = lane >> 4, tm = wv & 3, tvg = wv >> 2;
    HoutOps A, B;
    int unit = blockIdx.x;
    if (unit < NHU) hout_load(A, unit, proj, OI, QP, SB, r, kq, tm, tvg);
    for (; unit < NHU; unit += 2 * F.G) {
        const int u2 = unit + F.G, u3 = unit + 2 * F.G;
        if (u2 < NHU) hout_load(B, u2, proj, OI, QP, SB, r, kq, tm, tvg);
        hout_compute(A, unit, proj, OI, SSQ, gain, YB, lane, r, kq, tm, tvg);
        if (u2 < NHU) { if (u3 < NHU) hout_load(A, u3, proj, OI, QP, SB, r, kq, tm, tvg);
            hout_compute(B, u2, proj, OI, SSQ, gain, YB, lane, r, kq, tm, tvg); }
    }
}
__device__ __forceinline__ void memattn(const Frame& F, const bf16* proj, const bf16* KV, int layer, bf16* YX) {
    lbf16* Ks = (lbf16*)F.lds;
    lbf16* VTs = Ks + 256 * 136;
    const int lane = F.lane, wv = F.wave, r = lane & 15, kq = lane >> 4;
    for (int unit = blockIdx.x; unit < NB * XAH * (SEQ / 256); unit += F.G) {
        const int b = unit >> 6, hd = (unit >> 4) & 3, qt = unit & 15;
#pragma unroll
        for (int i = 0; i < 8; ++i) { const int p = F.tid + 512 * i, key = p >> 4, dc = (p & 15) * 8;
            const bf16* src = KV + (size_t)(b * NMEM + key) * 2048 + layer * 1024 + hd * XAD + dc;
            *(LAS v4u*)(Ks + key * 136 + dc) = *(const v4u*)src;
            const v4u w = *(const v4u*)(src + 512);
            const int k5 = key & 31, pos = (key & ~31) + 8 * ((k5 >> 2) & 3) + 4 * ((k5 >> 4) & 1) + (k5 & 3);
            lbf16* d = VTs + dc * 264 + pos;
            d[0] = (bf16)(w.x & 0xffffu); d[264] = (bf16)(w.x >> 16); d[2 * 264] = (bf16)(w.y & 0xffffu); d[3 * 264] = (bf16)(w.y >> 16);
            d[4 * 264] = (bf16)(w.z & 0xffffu); d[5 * 264] = (bf16)(w.z >> 16); d[6 * 264] = (bf16)(w.w & 0xffffu); d[7 * 264] = (bf16)(w.w >> 16); }
        __syncthreads();
#pragma unroll 1
        for (int g = 0; g < 2; ++g) {
            const int t = b * SEQ + qt * 256 + wv * 32 + g * 16 + r;
            bf16x8 qf[4];
#pragma unroll
            for (int ks = 0; ks < 4; ++ks) qf[ks] = *(const bf16x8*)(proj + (size_t)t * INC + C_QX + hd * XAD + ks * 32 + kq * 8);
            f32x4 s[16];
#pragma unroll
            for (int kt = 0; kt < 16; ++kt) { s[kt] = (f32x4){0.f, 0.f, 0.f, 0.f};
#pragma unroll
                for (int ks = 0; ks < 4; ++ks) { const bf16x8 a = *(const LAS bf16x8*)(Ks + (kt * 16 + r) * 136 + ks * 32 + kq * 8); s[kt] = __builtin_amdgcn_mfma_f32_16x16x32_bf16(a, qf[ks], s[kt], 0, 0, 0); }
                if (kt & 1) __builtin_amdgcn_sched_barrier(0); }
            float m = -1e30f;
#pragma unroll
            for (int kt = 0; kt < 16; ++kt) m = fmaxf(m, fmaxf(fmaxf(s[kt][0], s[kt][1]), fmaxf(s[kt][2], s[kt][3])));
            m = fmaxf(m, shx(m, 16, lane)); m = fmaxf(m, shx(m, 32, lane));
            const float cs = 0.08838834764831845f * 1.4426950408889634f; float l = 0.f;
#pragma unroll
            for (int kt = 0; kt < 16; ++kt)
#pragma unroll
                for (int e = 0; e < 4; ++e) { const float p = __builtin_amdgcn_exp2f((s[kt][e] - m) * cs); s[kt][e] = p; l += p; }
            l += shx(l, 16, lane); l += shx(l, 32, lane);
            f32x4 o[8];
#pragma unroll
            for (int dt = 0; dt < 8; ++dt) o[dt] = (f32x4){0.f, 0.f, 0.f, 0.f};
#pragma unroll
            for (int j = 0; j < 8; ++j) {
                v4u pw; pw.x = pk2(s[2 * j][0], s[2 * j][1]); pw.y = pk2(s[2 * j][2], s[2 * j][3]); pw.z = pk2(s[2 * j + 1][0], s[2 * j + 1][1]); pw.w = pk2(s[2 * j + 1][2], s[2 * j + 1][3]);
                const bf16x8 pf = __builtin_bit_cast(bf16x8, pw);
#pragma unroll
                for (int dt = 0; dt < 8; ++dt) { const bf16x8 a = *(const LAS bf16x8*)(VTs + (dt * 16 + r) * 264 + j * 32 + kq * 8); o[dt] = __builtin_amdgcn_mfma_f32_16x16x32_bf16(a, pf, o[dt], 0, 0, 0); }
                __builtin_amdgcn_sched_barrier(0); }
            const float inv = 1.f / l;
#pragma unroll
            for (int dt = 0; dt < 8; ++dt) { v2u w; w.x = pk2(o[dt][0] * inv, o[dt][1] * inv); w.y = pk2(o[dt][2] * inv, o[dt][3] * inv);
                *(v2u*)(YX + (size_t)t * YXW + hd * XAD + dt * 16 + 4 * kq) = w; }
        }
        __syncthreads();
    }
}
struct Args { const float* in[24]; float* out; unsigned char* ws; int ph_lo, ph_hi, mask, pad; };
typedef const __attribute__((address_space(4))) Args* KArgs;
__device__ __forceinline__ KArgs kargs() { KArgs p = (KArgs)__builtin_amdgcn_kernarg_segment_ptr(); asm volatile("" : "+s"(p)); return p; }
#define WSP(T, off) ((T*)(ws + (off)))
__global__ void __launch_bounds__(NWAVES * 64, 2) mk_fwd(Args args) {
    extern __shared__ __attribute__((aligned(16))) unsigned char lds_raw[];
    Frame F0; F0.lds = (LAS unsigned char*)lds_raw; F0.tid = threadIdx.x; F0.lane = F0.tid & 63; F0.wave = __builtin_amdgcn_readfirstlane(F0.tid >> 6);
    F0.G = gridDim.x; F0.gw = blockIdx.x * NWAVES + F0.wave; F0.NGW = F0.G * NWAVES;
    volatile LAS unsigned* MISC = (volatile LAS unsigned*)(F0.lds + MISC_OFF);
    for (int u = F0.tid; u < (LDS_BYTES - MISC_OFF) / 4; u += NWAVES * 64) ((LAS unsigned*)(F0.lds + MISC_OFF))[u] = 0u;
    __syncthreads();
    const int lo = args.ph_lo, hi = args.ph_hi;
    const bool multi = (hi - lo) > 1;
    XcdBarrier bar; bar.bar = (unsigned*)(args.ws + WS_CTL) + CW_BAR; bar.x = 0; bar.st = nullptr;
    if (multi) bar = xcd_barrier_post((unsigned*)(args.ws + WS_CTL) + CW_BAR, MISC + 8);
#define IN(k) (lo <= (k) && (k) < hi)
#define SEAM(k) do { if (IN((k) + 1)) xcd_barrier(bar); } while (0)
#define PH_BEGIN KArgs ka = kargs(); unsigned char* ws = ka->ws; (void)ws; Frame F = F0; F.lane = pg8::lane_id_opaque(); F.tid = F0.wave * 64 + F.lane
    if (IN(PH_CVT)) {
        { PH_BEGIN;
        unsigned gb = 0;
        for (int l = 0; l < 2; ++l) {
            xpose_matrix(F, ka->in[2] + (size_t)l * D * INC, D, INC, (bf16*)(ws + WS_WIN_T + l * WIN_T_L), D, 0, gb);
            xpose_matrix(F, ka->in[4] + (size_t)l * CW * D, CW, D, (bf16*)(ws + WS_WBR_T + l * WBR_T_L), CW, 0, gb);
            xpose_matrix(F, ka->in[7] + (size_t)l * HGW * D, HGW, D, (bf16*)(ws + WS_WBR_T + l * WBR_T_L + 3 * MiB), HGW, 0, gb);
            xpose_matrix(F, ka->in[10] + (size_t)l * XAW * D, XAW, D, (bf16*)(ws + WS_WBR_T + l * WBR_T_L + 6 * MiB), YXW, 0, gb);
            for (int i = blockIdx.x * 512 + F.tid; i < D * 32; i += F.G * 512) *(v4u*)((bf16*)(ws + WS_WBR_T + l * WBR_T_L + 6 * MiB) + (size_t)(i >> 5) * YXW + XAW + (i & 31) * 8) = (v4u){0u, 0u, 0u, 0u};
            xpose_matrix(F, ka->in[11] + (size_t)l * D * D, D, D, (bf16*)(ws + WS_WO_T + l * WO_T_L), D, 0, gb);
            xpose_matrix(F, ka->in[8] + (size_t)l * D * XAW, D, XAW, (bf16*)(ws + WS_WKV_T) + (size_t)(l * 1024) * D, D, 0, gb);
            xpose_matrix(F, ka->in[9] + (size_t)l * D * XAW, D, XAW, (bf16*)(ws + WS_WKV_T) + (size_t)(l * 1024 + 512) * D, D, 0, gb);
        }
        cvt_router(F, ka->in[14], ws);
        cvt_rows(F, ka->in[0], WSP(bf16, WS_XBF), (size_t)NTOK * D / 8);
        cvt_rows(F, ka->in[1], WSP(bf16, WS_MEMBF), (size_t)NB * NMEM * D / 8);
        }
        SEAM(PH_CVT);
    }
    for (int l = 0; l < 2; ++l) {
        const int pb = PH_L0 + l * PH_PER_LAYER;
        if (IN(pb + P_INPROJ)) {
            { PH_BEGIN;
            const bool split = F.G == 256;
            const int oa = (int)blockIdx.x >> 3, ox = (int)blockIdx.x & 7; const bool conv = split && (oa & 3) == 3;
            const int hrank = 8 * (oa >> 2) + ox, grank = 8 * (oa - ((oa + 1) >> 2)) + ox;
            static_assert((256 - NCV) * GM_UNITS + NCV * CV_UNITS == (NTOK / 256) * (INC / 256), "in-projection unit shares");
            if (conv) { Frame Fc = F; Fc.gw = hrank * NWAVES + F.wave; Fc.NGW = NCV * NWAVES; unsigned gb = 0;
                cvt_experts(Fc, ka->in[16] + (size_t)l * NE * D * EH, ka->in[17] + (size_t)l * NE * D * EH, ka->in[18] + (size_t)l * NE * EH * D, ka->in[19] + (size_t)l * D * EH, ka->in[20] + (size_t)l * D * EH, ka->in[21] + (size_t)l * EH * D, ws, gb);
                __syncthreads(); }
            if (!split) { unsigned gb = 0; cvt_experts(F, ka->in[16] + (size_t)l * NE * D * EH, ka->in[17] + (size_t)l * NE * D * EH, ka->in[18] + (size_t)l * NE * EH * D, ka->in[19] + (size_t)l * D * EH, ka->in[20] + (size_t)l * D * EH, ka->in[21] + (size_t)l * EH * D, ws, gb); __syncthreads(); }
            DenseSched S; S.init(ws + WS_XBF, ws + WS_WIN_T + l * WIN_T_L, NTOK, INC, D, split ? (conv ? NCV : 256 - NCV) : F.G, split ? (conv ? hrank : grank) : (int)blockIdx.x);
            if (split) { S.L0 = conv ? (256 - NCV) * GM_UNITS : 0; S.cnt = conv ? CV_UNITS : GM_UNITS; }
            EpiProj E{WSP(bf16, WS_R1), WSP(unsigned char, WS_GATE8)};
            pg8::gemm_phase<EpiProj, DenseSched, true>(F.lds + RING_OFF, F.wave, D, S, E);
            if (l == 0) {
                DenseSched S2; S2.init(ws + WS_MEMBF, ws + WS_WKV_T, NB * NMEM, 2048, D, split ? 32 : F.G, split ? ((conv && hrank < 32) ? hrank : -1) : (int)blockIdx.x);
                EpiBf16Plain E2{WSP(bf16, WS_KV), 2048};
                pg8::gemm_phase<EpiBf16Plain, DenseSched, true>(F.lds + RING_OFF, F.wave, D, S2, E2);
            }
            }
            SEAM(pb + P_INPROJ);
        }
        if (IN(pb + P_MIX)) {
            { PH_BEGIN;
            memattn(F, WSP(bf16, WS_R1), WSP(bf16, WS_KV), l, WSP(bf16, WS_YX));
            hgrn_local(F, WSP(bf16, WS_R1), ka->in[5], l, ws + WS_R2);
            conv_part(F, WSP(bf16, WS_R1), ka->in[3] + (size_t)l * 3 * CW, WSP(bf16, WS_YA), WSP(bf16, WS_YX));
            }
            SEAM(pb + P_MIX);
        }
        if (IN(pb + P_SCAN)) {
            { PH_BEGIN;
            hgrn_scan(F, ws + WS_R2, WSP(v2u, WS_ZF));
            }
            SEAM(pb + P_SCAN);
        }
        if (IN(pb + P_HOUT)) {
            { PH_BEGIN;
            hgrn_out(F, WSP(bf16, WS_R1), ws + WS_R2, WSP(bf16, WS_ZF), ka->in[6] + (size_t)l * HGW, WSP(bf16, WS_YB));
            }
            SEAM(pb + P_HOUT);
        }
        if (IN(pb + P_BRANCH)) {
            { PH_BEGIN;
            static_assert(WS_YX - WS_YB == WS_YB - WS_YA, "branch inputs equally spaced");
            BranchSched S; S.init(ws + WS_YA, ws + WS_WBR_T + l * WBR_T_L, F.G, (int)blockIdx.x); EpiGateRT E{WSP(unsigned char, WS_GATE8), WSP(bf16, WS_MERGED)};
            pg8::gemm_phase<EpiGateRT, BranchSched, true>(F.lds + RING_OFF, F.wave, CW, S, E);
            }
            SEAM(pb + P_BRANCH);
        }
        if (IN(pb + P_WO)) {
            { PH_BEGIN;
            DenseSched S; S.init(ws + WS_MERGED, ws + WS_WO_T + l * WO_T_L, NTOK, D, D, F.G, (int)blockIdx.x);
            if (l == 0) { EpiResid<false> E{(const void*)ka->in[0], WSP(bf16, WS_ZF)}; pg8::gemm_phase<EpiResid<false>, DenseSched, true>(F.lds + RING_OFF, F.wave, D, S, E); }
            else { EpiResid<true> E{(const void*)WSP(bf16, WS_XBF), WSP(bf16, WS_ZF)}; pg8::gemm_phase<EpiResid<true>, DenseSched, true>(F.lds + RING_OFF, F.wave, D, S, E); }
            }
            SEAM(pb + P_WO);
        }
        if (IN(pb + P_ROUTE)) {
            { PH_BEGIN;
            route_phase(F, WSP(bf16, WS_ZF), ka->in[12] + (size_t)l * D, ka->in[13] + (size_t)l * D, WSP(bf16, WS_RW + l * RW_L), ka->in[15] + (size_t)l * NE, WSP(bf16, WS_X1F), WSP(bf16, WS_X1BF),
                        WSP(unsigned, WS_CTL) + CW_CNT + l * 64, WSP(int, WS_LIST), WSP(int, WS_TOKSLOT), WSP(float, WS_TOKW));
            }
            SEAM(pb + P_ROUTE);
        }
        if (IN(pb + P_GU)) {
            { PH_BEGIN;
            moe_plan(F, WSP(unsigned, WS_CTL) + CW_CNT + l * 64);
            MoeSched<true> S; S.init(F, ws + WS_X1BF, ws + WS_WGU, WSP(int, WS_LIST)); EpiSwiGLU E{WSP(bf16, WS_R2)};
            pg8::gemm_phase<EpiSwiGLU, MoeSched<true>, true>(F.lds + RING_OFF, F.wave, D, S, E);
            }
            SEAM(pb + P_GU);
        }
        if (IN(pb + P_DOWN)) {
            { PH_BEGIN;
            moe_plan(F, WSP(unsigned, WS_CTL) + CW_CNT + l * 64);
            MoeSched<false> S; S.init(F, ws + WS_R2, ws + WS_WDN, nullptr); EpiY8 E{WSP(unsigned char, WS_R1), WSP(bf16, WS_R1 + R1_YS)};
            pg8::gemm_phase<EpiY8, MoeSched<false>, true>(F.lds + RING_OFF, F.wave, EH, S, E);
            }
            SEAM(pb + P_DOWN);
        }
        if (IN(pb + P_COMB)) {
            { PH_BEGIN;
            moe_plan(F, WSP(unsigned, WS_CTL) + CW_CNT + l * 64);
            combine_phase(F, WSP(bf16, WS_X1BF), WSP(unsigned char, WS_R1), WSP(bf16, WS_R1 + R1_YS), WSP(int, WS_TOKSLOT), WSP(float, WS_TOKW), ka->in[22] + (size_t)l * D, ka->in[23] + (size_t)l * D, ka->out, WSP(bf16, WS_XBF), l == 1);
            }
            SEAM(pb + P_COMB);
        }
    }
#undef IN
#undef SEAM
}
static void launch_mk(Args a, int lo, int hi, int grid, hipStream_t stream) {
    a.ph_lo = lo; a.ph_hi = hi;
    hipLaunchKernelGGL(mk_fwd, dim3(grid), dim3(NWAVES * 64), LDS_BYTES, stream, a);
}
extern "C" void kernel_launch(void* const* d_in, const int* in_sizes, int n_in, void* d_out, int out_size, void* d_ws, size_t ws_size, hipStream_t stream) {
    static int grid = 0;
    if (grid == 0) {
        if (n_in != 24 || out_size != NTOK * D || ws_size < WS_END) { fprintf(stderr, "kernel_launch: unexpected sizes n_in %d out %d ws %zu\n", n_in, out_size, ws_size); grid = -1; return; }
        int dev = 0, cus = 0;
        if (hipGetDevice(&dev) != hipSuccess || hipDeviceGetAttribute(&cus, hipDeviceAttributeMultiprocessorCount, dev) != hipSuccess) { grid = -1; return; }
        if (hipFuncSetAttribute((const void*)mk_fwd, hipFuncAttributeMaxDynamicSharedMemorySize, LDS_BYTES) != hipSuccess) { fprintf(stderr, "kernel_launch: hipFuncSetAttribute failed\n"); grid = -1; return; }
        int per_cu = 0; (void)hipOccupancyMaxActiveBlocksPerMultiprocessor(&per_cu, (const void*)mk_fwd, NWAVES * 64, LDS_BYTES); (void)hipGetLastError();
        if (per_cu < 1) fprintf(stderr, "kernel_launch: occupancy query says %d\n", per_cu);
        grid = cus;
    }
    if (grid < 0) return;
    const float* x = (const float*)d_in[0];
    const float* conv_w = (const float*)d_in[3]; const float* lbl = (const float*)d_in[5];
    const float* hg_g = (const float*)d_in[6];
    const float* ln1_g = (const float*)d_in[12]; const float* ln1_b = (const float*)d_in[13]; const float* router_w = (const float*)d_in[14];
    const float* router_b = (const float*)d_in[15]; const float* exp_wg = (const float*)d_in[16]; const float* exp_wu = (const float*)d_in[17];
    const float* exp_wd = (const float*)d_in[18]; const float* sh_wg = (const float*)d_in[19]; const float* sh_wu = (const float*)d_in[20];
    const float* sh_wd = (const float*)d_in[21]; const float* ln2_g = (const float*)d_in[22]; const float* ln2_b = (const float*)d_in[23];
    unsigned char* ws = (unsigned char*)d_ws; float* out = (float*)d_out;
    unsigned* ctl = (unsigned*)(ws + WS_CTL);
    bf16* KV = (bf16*)(ws + WS_KV); bf16* XBF = (bf16*)(ws + WS_XBF); float* X1F = (float*)(ws + WS_X1F);
    bf16* X1BF = (bf16*)(ws + WS_X1BF); float* ZF = (float*)(ws + WS_ZF);
    bf16* YA = (bf16*)(ws + WS_YA); bf16* YB = (bf16*)(ws + WS_YB); bf16* YX = (bf16*)(ws + WS_YX);
    bf16* H = (bf16*)(ws + WS_R2); float* OH = (float*)(ws + WS_R2); bf16* PROJ = (bf16*)(ws + WS_R1); bf16* Y = (bf16*)(ws + WS_R1);
    int* LIST = (int*)(ws + WS_LIST); int* TOKSLOT = (int*)(ws + WS_TOKSLOT); float* TOKW = (float*)(ws + WS_TOKW);
    Args a{};
    for (int i = 0; i < 24; ++i) a.in[i] = (const float*)d_in[i];
    a.out = out; a.ws = ws;

    (void)hipMemsetAsync(ws + WS_CTL, 0, CTL_BYTES, stream);
    a.mask = 7;
    launch_mk(a, 0, N_PHASES, grid, stream);
}
```

```cpp
#include <hip/hip_runtime.h>
#include <stdint.h>
#include <stdio.h>

typedef unsigned short bf16;
__device__ __forceinline__ float bf2f(bf16 v) { return __uint_as_float(((unsigned)v) << 16); }
__device__ __forceinline__ bf16 f2bf(float f) { unsigned u = __float_as_uint(f); return (bf16)((u + 0x7fffu + ((u >> 16) & 1u)) >> 16); }

constexpr int NB = 4, SEQ = 4096, NTOK = NB * SEQ, D = 2048, NMEM = 256;
constexpr int CW = 768, HGW = 768, HGH = 6, HGD = 128, XAW = 512, XAH = 4, XAD = 128;
constexpr int INC = 12032, YXW = 768, GW8 = 3 * 2048, PN_GATE = 23;
constexpr int C_U = 0, C_B = 768, C_C = 1536, C_Q = 2304, C_F = 3072, C_I = 3840, C_G = 4608, C_QX = 5376, C_GA = 5888, C_GB = 7936, C_GX = 9984;
constexpr int NE = 64, TOPK = 8, EH = 512;
constexpr float ALPHA = 1.41421356237f, LN_EPS = 1e-5f, RMS_EPS = 1e-6f, RSCALE = 2.5f;
constexpr int LISTCAP = 16384;

constexpr size_t MiB = 1u << 20;
constexpr size_t WS_CTL = 0, CTL_BYTES = 1 * MiB;
constexpr size_t WS_RW = 1 * MiB, RW_L = 512 * 1024;
constexpr size_t WS_WIN_T = 2 * MiB, WIN_T_L = 47 * MiB;
constexpr size_t WS_WBR_T = 1932 * MiB, WBR_T_L = 9 * MiB;
constexpr size_t WS_WO_T = 112 * MiB, WO_T_L = 8 * MiB;
constexpr size_t WS_WKV_T = 128 * MiB;
constexpr size_t WS_MEMBF = 136 * MiB, WS_KV = 140 * MiB;
constexpr size_t WS_WGU = 144 * MiB, WGU_E = 4 * MiB;
constexpr size_t WS_WDN = 404 * MiB, WDN_E = 2 * MiB;
constexpr size_t WS_XBF = 534 * MiB, WS_X1F = 598 * MiB, WS_X1BF = 726 * MiB, WS_ZF = 790 * MiB, WS_MERGED = 918 * MiB;
constexpr size_t WS_YA = 1860 * MiB, WS_YB = 1884 * MiB, WS_YX = 1908 * MiB;
constexpr size_t WS_R2 = 1046 * MiB;
constexpr size_t WS_R1 = 1214 * MiB;
constexpr size_t R1_YS = 320 * MiB;
constexpr size_t WS_LIST = 1854 * MiB, WS_TOKSLOT = 1858 * MiB, WS_TOKW = 1859 * MiB, WS_GATE8 = 1950 * MiB, WS_END = 2046 * MiB;
constexpr int CW_CNT = 1024;
constexpr int CW_PLAN = 2048;
constexpr int CW_BAR = 4096;
#ifndef DBG_MASK
#define DBG_MASK 7
#endif
namespace pg8 {
#define PG8_LAS __attribute__((address_space(3)))
typedef unsigned short bf16_t;
typedef short bf16x8 __attribute__((ext_vector_type(8)));
typedef float f32x4 __attribute__((ext_vector_type(4)));
typedef unsigned u32x4 __attribute__((ext_vector_type(4)));
typedef unsigned u32x2 __attribute__((ext_vector_type(2)));
constexpr int PG8_NVO_OFF = 147456 + 1024;
constexpr int BM = 256, BK = 64, HALF = 128, HTB = HALF * BK * 2  , STAGE_BYTES = 8 * HTB, NXCD = 8, WGM = 8;

__host__ __device__ __forceinline__ int lds_byte(int r, int c) { const int st = (r >> 4) * 2 + (c >> 5), rr = r & 15, cc = c & 31, ob = rr * 64 + cc * 2; return st * 1024 + (ob ^ (((ob >> 9) & 1) << 5)); }
__host__ __device__ __forceinline__ void stage_rc(int b, int& R, int& C) { const int st = b / 1024, sb = b % 1024, swz = sb ^ (((sb >> 9) & 1) << 5); R = (st >> 1) * 16 + swz / 64; C = (st & 1) * 32 + (swz % 64) / 2; }
__host__ __device__ __forceinline__ int perm32(int rho) { const int n = rho >> 4, i = rho & 15; return 8 * (i >> 2) + 4 * n + (i & 3); }

struct Unit { const char* A; const char* B; int pm, pn; const int* list; int m0, cnt; };

typedef float f32x2_ __attribute__((ext_vector_type(2)));
typedef __bf16 bf16x2_ __attribute__((ext_vector_type(2)));
__device__ __forceinline__ unsigned cvt_pk_bf16(float lo, float hi) { const f32x2_ v = {lo, hi}; const bf16x2_ b = __builtin_convertvector(v, bf16x2_); return __builtin_bit_cast(unsigned, b); }
__device__ __forceinline__ int lane_id_opaque() { unsigned m = ~0u; asm volatile("" : "+s"(m)); return (int)__builtin_amdgcn_mbcnt_hi(m, __builtin_amdgcn_mbcnt_lo(m, 0u)); }
__device__ __forceinline__ float bf_lo(unsigned w) { return __uint_as_float(w << 16); }
__device__ __forceinline__ float bf_hi(unsigned w) { return __uint_as_float(w & 0xffff0000u); }
__device__ __forceinline__ float sigmoidf_(float x) { return __builtin_amdgcn_rcpf(1.f + __expf(-x)); }

typedef f32x4 Acc[2][2][4][2];

template <class Epi, class Sched, bool ALIGN_EPI>
__device__ __forceinline__ void gemm_phase(PG8_LAS unsigned char* lds, const int wave, const int K_in, const Sched& S, const Epi& E) {
    const int lane = lane_id_opaque(), wid = wave, tid = wid * 64 + lane, wr = wid >> 2, wc = wid & 3, fr = lane & 15, fq = lane >> 4;
    int K = K_in; asm volatile("" : "+s"(K));
    const int nt = K / BK;
    unsigned voffB[2];
#pragma unroll
    for (int i = 0; i < 2; ++i) { int R, C; stage_rc(tid * 16 + i * 8192, R, C); const int Rb = Epi::PERM ? ((R & ~31) + perm32(R & 31)) : R; voffB[i] = (unsigned)(Rb * K + C) * 2u; }
    const size_t kstep = (size_t)(BK * 2);
    const size_t hstep = (size_t)HALF * K * 2;
    const unsigned ldsw = (unsigned)wid * 1024u;
    const int aoff = lds_byte(wr * 64 + fr, fq * 8), boff = lds_byte(wc * 32 + fr, fq * 8);
#define PG8_SA(b, h) (((b) * 2 + (h)) * HTB)
#define PG8_SB(b, h) ((4 + (b) * 2 + (h)) * HTB)
#define PG8_STAGE2(bufoff, gbase, v0, v1) do { \
        __builtin_amdgcn_global_load_lds((const unsigned*)((const char*)(gbase) + (v0)), (PG8_LAS unsigned*)(lds + (bufoff) + ldsw), 16, 0, 0); \
        __builtin_amdgcn_global_load_lds((const unsigned*)((const char*)(gbase) + (v1)), (PG8_LAS unsigned*)(lds + (bufoff) + ldsw + 8192), 16, 0, 0); } while (0)
#define PG8_STAGEB(bufoff, gbase) PG8_STAGE2(bufoff, gbase, voffB[0], voffB[1])
#define PG8_LDA(dst, b, h) do { _Pragma("unroll") for (int m = 0; m < 4; ++m) _Pragma("unroll") for (int k = 0; k < 2; ++k) dst[m][k] = *(const PG8_LAS bf16x8*)(lds + PG8_SA(b, h) + aoff + m * 2048 + k * 1024); } while (0)
#define PG8_LDB(dst, b, h) do { _Pragma("unroll") for (int n = 0; n < 2; ++n) _Pragma("unroll") for (int k = 0; k < 2; ++k) dst[n][k] = *(const PG8_LAS bf16x8*)(lds + PG8_SB(b, h) + boff + n * 2048 + k * 1024); } while (0)
#define PG8_MMA(ai, bj, At, Bt) do { __builtin_amdgcn_s_setprio(1); _Pragma("unroll") for (int m = 0; m < 4; ++m) _Pragma("unroll") for (int n = 0; n < 2; ++n) _Pragma("unroll") for (int k = 0; k < 2; ++k) \
        acc[ai][bj][m][n] = __builtin_amdgcn_mfma_f32_16x16x32_bf16(Bt[n][k], At[m][k], acc[ai][bj][m][n], 0, 0, 0); __builtin_amdgcn_s_setprio(0); } while (0)
#define PG8_WAIT_V(n) asm volatile("s_waitcnt vmcnt(" #n ")" ::: "memory")
#define PG8_WAIT_L(n) asm volatile("s_waitcnt lgkmcnt(" #n ")" ::: "memory")
#define PG8_BAR __builtin_amdgcn_s_barrier()
#define PG8_SCHED __builtin_amdgcn_sched_barrier(0)
    Unit cur, nxt; int ui = 0;
    if (!S.next(0, cur)) return;
    Acc acc;
#pragma unroll
    for (int a = 0; a < 2; ++a)
#pragma unroll
        for (int b = 0; b < 2; ++b)
#pragma unroll
            for (int m = 0; m < 4; ++m)
#pragma unroll
                for (int n = 0; n < 2; ++n) acc[a][b][m][n] = (f32x4){0.f, 0.f, 0.f, 0.f};
    bf16x8 At[4][2], B0[2][2], B1[2][2];
    constexpr bool GA = Sched::GATHER;
    unsigned c00, c01, c10 = 0, c11 = 0;
    PG8_LAS unsigned* nvo = (PG8_LAS unsigned*)(lds + PG8_NVO_OFF) + tid * 4;
    { int R0, C0, R1, C1; stage_rc(tid * 16, R0, C0); stage_rc(tid * 16 + 8192, R1, C1);
      c00 = S.avoff(cur, 0, R0, C0, K); c01 = S.avoff(cur, 0, R1, C1, K); if constexpr (GA) { c10 = S.avoff(cur, 1, R0, C0, K); c11 = S.avoff(cur, 1, R1, C1, K); } }
    const size_t hA = GA ? (size_t)0 : hstep;
#define PG8_STAGEA0(bufoff, gbase) PG8_STAGE2(bufoff, gbase, c00, c01)
#define PG8_STAGEA1(bufoff, gbase) do { if constexpr (GA) PG8_STAGE2(bufoff, gbase, c10, c11); else PG8_STAGE2(bufoff, (gbase) + hA, c00, c01); } while (0)
    const char* cA = cur.A; const char* cB = cur.B;
    PG8_STAGEB(PG8_SB(0, 0), cB); PG8_STAGEB(PG8_SB(0, 1), cB + hstep); PG8_STAGEA0(PG8_SA(0, 0), cA); PG8_STAGEA1(PG8_SA(0, 1), cA);
    if (wr == 1) PG8_BAR;
    PG8_WAIT_V(2); PG8_BAR;
    PG8_STAGEB(PG8_SB(1, 0), cB + kstep); PG8_STAGEA0(PG8_SA(1, 0), cA + kstep); PG8_STAGEB(PG8_SB(1, 1), cB + hstep + kstep);
    PG8_WAIT_V(6); PG8_BAR;
    for (;;) {
        const bool has_next = S.next(ui + 1, nxt);
        const char* nA = has_next ? nxt.A : cA; const char* nB = has_next ? nxt.B : cB;
        if constexpr (GA) { if (has_next) {
            int R0, C0, R1, C1; stage_rc(tid * 16, R0, C0); stage_rc(tid * 16 + 8192, R1, C1);
            nvo[0] = S.avoff(nxt, 0, R0, C0, K); nvo[1] = S.avoff(nxt, 0, R1, C1, K); nvo[2] = S.avoff(nxt, 1, R0, C0, K); nvo[3] = S.avoff(nxt, 1, R1, C1, K); } }
        for (int t = 0; t < nt; t += 2) {
            const bool last = (t == nt - 2);
            const char* a1 = cA + (size_t)(t + 1) * kstep;
            const char* a2 = last ? nA : cA + (size_t)(t + 2) * kstep; const char* b2 = last ? nB : cB + (size_t)(t + 2) * kstep;
            const char* a3 = a2 + kstep; const char* b3 = b2 + kstep;
            const bool nx = GA && last && has_next;
#define PG8_STAGEA0N(bufoff, gbase) do { if (nx) { const unsigned q0 = nvo[0], q1 = nvo[1]; PG8_STAGE2(bufoff, gbase, q0, q1); } else PG8_STAGEA0(bufoff, gbase); } while (0)
#define PG8_STAGEA1N(bufoff, gbase) do { if (nx) { const unsigned q0 = nvo[2], q1 = nvo[3]; PG8_STAGE2(bufoff, gbase, q0, q1); } else PG8_STAGEA1(bufoff, gbase); } while (0)
            PG8_LDB(B0, 0, 0); PG8_LDB(B1, 0, 1); PG8_SCHED; PG8_LDA(At, 0, 0); PG8_STAGEA1(PG8_SA(1, 1), a1);
            PG8_WAIT_V(8); PG8_WAIT_L(0); PG8_BAR; PG8_MMA(0, 0, At, B0); PG8_MMA(0, 1, At, B1); PG8_BAR; PG8_SCHED;
            PG8_LDA(At, 0, 1); PG8_STAGEB(PG8_SB(0, 0), b2); PG8_STAGEB(PG8_SB(0, 1), b2 + hstep); PG8_STAGEA0N(PG8_SA(0, 0), a2);
            PG8_WAIT_V(8); PG8_WAIT_L(0); PG8_BAR; PG8_MMA(1, 0, At, B0); PG8_MMA(1, 1, At, B1); PG8_BAR; PG8_SCHED;
            PG8_LDB(B0, 1, 0); PG8_LDB(B1, 1, 1); PG8_SCHED; PG8_LDA(At, 1, 0); PG8_STAGEA1N(PG8_SA(0, 1), a2);
            PG8_WAIT_V(8); PG8_WAIT_L(0); PG8_BAR; PG8_MMA(0, 0, At, B0); PG8_MMA(0, 1, At, B1); PG8_BAR; PG8_SCHED;
            PG8_LDA(At, 1, 1); PG8_STAGEB(PG8_SB(1, 0), b3); PG8_STAGEB(PG8_SB(1, 1), b3 + hstep); PG8_STAGEA0N(PG8_SA(1, 0), a3);
            PG8_WAIT_V(8); PG8_WAIT_L(0); PG8_BAR; PG8_MMA(1, 0, At, B0); PG8_MMA(1, 1, At, B1); PG8_BAR; PG8_SCHED;
#undef PG8_STAGEA0N
#undef PG8_STAGEA1N
        }
        if constexpr (ALIGN_EPI) { if (wr == 0) PG8_BAR; }
        bool keep = false;
        if constexpr (Epi::INPLACE) keep = E.inplace(acc, cur, wr, wc, fr, fq); else E(acc, cur, wr, wc, fr, fq);
        if (!has_next) break;
        if (!keep)
#pragma unroll
        for (int a = 0; a < 2; ++a)
#pragma unroll
            for (int b = 0; b < 2; ++b)
#pragma unroll
                for (int m = 0; m < 4; ++m)
#pragma unroll
                    for (int n = 0; n < 2; ++n) acc[a][b][m][n] = (f32x4){0.f, 0.f, 0.f, 0.f};
        cur = nxt; cA = nA; cB = nB; ++ui; if constexpr (GA) { c00 = nvo[0]; c01 = nvo[1]; c10 = nvo[2]; c11 = nvo[3]; }
        if constexpr (ALIGN_EPI) { if (wr == 1) PG8_BAR; }
    }
    PG8_WAIT_V(0);
    if constexpr (!ALIGN_EPI) { if (wr == 0) PG8_BAR; }
    PG8_BAR;
#undef PG8_SA
#undef PG8_SB
#undef PG8_STAGE2
#undef PG8_STAGEB
#undef PG8_STAGEA0
#undef PG8_STAGEA1
#undef PG8_LDA
#undef PG8_LDB
#undef PG8_MMA
#undef PG8_WAIT_V
#undef PG8_WAIT_L
#undef PG8_BAR
#undef PG8_SCHED
}
}
#define GAS __attribute__((address_space(1)))
#define LAS __attribute__((address_space(3)))
typedef unsigned v4u __attribute__((ext_vector_type(4)));
typedef unsigned v2u __attribute__((ext_vector_type(2)));
typedef float f32x4 __attribute__((ext_vector_type(4)));
typedef short bf16x8 __attribute__((ext_vector_type(8)));
typedef GAS unsigned gu32;
#define RLX_AGENT __ATOMIC_RELAXED, __HIP_MEMORY_SCOPE_AGENT
#define LDS_WAIT() asm volatile("s_waitcnt lgkmcnt(0)" ::: "memory")
#define VM_WAIT() asm volatile("s_waitcnt vmcnt(0)" ::: "memory")
__device__ __forceinline__ int opaque_v(int x) { asm volatile("" : "+v"(x)); return x; }
__device__ __forceinline__ float shx(float v, int o, int lane) { return __int_as_float(__builtin_amdgcn_ds_bpermute((lane ^ o) << 2, __float_as_int(v))); }
__device__ __forceinline__ unsigned pk2(float lo, float hi) { return pg8::cvt_pk_bf16(lo, hi); }

#define XB_TMO      128
#define XB_XCNT(j)  (256  + 64 * (j))
#define XB_XSUB(j)  (1280 + 64 * (j))
#define XB_XGEN(j)  (2304 + 64 * (j))
#define XB_TOP      3328
#define XB_TOPGEN   3392
#define XCD_BAR_WORDS 3456
#define XB_SPIN_CAP (1u << 18)
__device__ __forceinline__ unsigned xb_ld(unsigned* p)              { return __hip_atomic_load(p, __ATOMIC_RELAXED, __HIP_MEMORY_SCOPE_AGENT); }
__device__ __forceinline__ unsigned xb_add(unsigned* p, unsigned v) { return __hip_atomic_fetch_add(p, v, __ATOMIC_RELAXED, __HIP_MEMORY_SCOPE_AGENT); }
__device__ __forceinline__ unsigned xb_xcc_id() { return (unsigned)__builtin_amdgcn_s_getreg((3 << 11) | 20) & 0xFu; }
#define XB_SPIN(cond, bar) do { unsigned _sp = 0; while (cond) { __builtin_amdgcn_s_sleep(1); \
    if ((++_sp & 255u) == 0u) { if (xb_ld(&(bar)[XB_TMO])) break; if (_sp > XB_SPIN_CAP) { atomicAdd(&(bar)[XB_TMO], 1u); break; } } } } while (0)
struct XcdBarrier { unsigned* bar; unsigned x; volatile LAS unsigned* st; };
__device__ __forceinline__ XcdBarrier xcd_barrier_post(unsigned* bar, volatile LAS unsigned* st) {
    XcdBarrier b; b.bar = bar; b.x = xb_xcc_id(); b.st = st;
    if (threadIdx.x == 0) (void)xb_add(&bar[XB_XCNT(b.x)], 1u);
    return b;
}
__device__ __forceinline__ void xcd_barrier_complete(unsigned* bar, unsigned x, unsigned& nloc, unsigned& nx) {
    const unsigned G = gridDim.x * gridDim.y * gridDim.z;
    unsigned sum, cnt, mine, sp = 0u;
    for (;;) {
        sum = 0u; cnt = 0u; mine = 0u;
#pragma unroll
        for (unsigned j = 0; j < 16; ++j) { const unsigned c = xb_ld(&bar[XB_XCNT(j)]); sum += c; cnt += (c > 0u) ? 1u : 0u; mine = (j == x) ? c : mine; }
        if (sum == G) break;
        __builtin_amdgcn_s_sleep(1);
        if ((++sp & 255u) == 0u) { if (xb_ld(&bar[XB_TMO])) break; if (sp > XB_SPIN_CAP) { atomicAdd(&bar[XB_TMO], 1u); break; } }
    }
    nloc = mine > 0u ? mine : 1u; nx = cnt > 0u ? cnt : 1u;
}
__device__ __forceinline__ void xcd_barrier(const XcdBarrier& b_in) {
    asm volatile("s_waitcnt vmcnt(0)" ::: "memory");
    __syncthreads();
    if (threadIdx.x == 0) {
        XcdBarrier b = b_in; asm volatile("" : "+s"(b.x));
        unsigned* bar = b.bar; asm volatile("" : "+s"(bar));
        __builtin_amdgcn_s_waitcnt(0);
        unsigned nloc = b.st[0], nx = b.st[1];
        if (nloc == 0u) { xcd_barrier_complete(bar, b.x, nloc, nx); b.st[0] = nloc; b.st[1] = nx; }
        const unsigned old = xb_add(&bar[XB_XSUB(b.x)], 1u);
        const unsigned gen = old / nloc;
        if (old + 1u == (gen + 1u) * nloc) {
            __builtin_amdgcn_fence(__ATOMIC_RELEASE, "agent");
            asm volatile("s_waitcnt vmcnt(0)" ::: "memory");
            const unsigned og = xb_add(&bar[XB_TOP], 1u);
            const unsigned tg = og / nx;
            if (og + 1u == (tg + 1u) * nx) xb_add(&bar[XB_TOPGEN], 1u);
            else XB_SPIN(xb_ld(&bar[XB_TOPGEN]) == tg, bar);
            __builtin_amdgcn_fence(__ATOMIC_ACQUIRE, "agent");
            xb_add(&bar[XB_XGEN(b.x)], 1u);
            asm volatile("s_waitcnt vmcnt(0)" ::: "memory");
        } else {
            XB_SPIN(xb_ld(&bar[XB_XGEN(b.x)]) == gen, bar);
            __builtin_amdgcn_fence(__ATOMIC_ACQUIRE, "agent");
            asm volatile("s_waitcnt vmcnt(0)" ::: "memory");
        }
    }
    __syncthreads();
}
using pg8::Unit; using pg8::Acc;
struct DenseSched { static constexpr bool GATHER = false;
    const char* A; const char* B; int nM, nN, nwg, G, c, K; int L0 = 0, cnt = 1 << 30;
    __device__ __forceinline__ void init(const void* A_, const void* B_, int M, int N, int K_, int G_, int c_) { A = (const char*)A_; B = (const char*)B_; nM = M / 256; nN = N / 256; nwg = nM * nN; G = G_; c = c_; K = K_; }
    __device__ __forceinline__ bool next(int i, Unit& u) const {
        const long L = (long)L0 + (long)i * G + c; if (c < 0 || i >= cnt || L >= nwg) return false;
        int wgid = (int)L; { const int q = nwg / 8, r = nwg % 8, xcd = wgid % 8, off = wgid / 8; wgid = (xcd < r ? xcd * (q + 1) : r * (q + 1) + (xcd - r) * q) + off; }
        const int nig = 8 * nN, gid = wgid / nig, fm = gid * 8, gsz = (nM - fm) < 8 ? (nM - fm) : 8;
        u.pm = fm + ((wgid % nig) % gsz); u.pn = (wgid % nig) / gsz;
        u.A = A + (size_t)u.pm * 256 * K * 2; u.B = B + (size_t)u.pn * 256 * K * 2; u.list = nullptr; u.m0 = 0; u.cnt = 0; return true;
    }
    __device__ __forceinline__ unsigned avoff(const Unit&, int h, int R, int C, int K_) const { return (unsigned)(((h * 128 + R) * K_ + C) * 2); }
};
struct EpiBf16Plain { static constexpr bool PERM = true, INPLACE = false; bf16* O; int ldc;
    __device__ __forceinline__ void operator()(const Acc& acc, const Unit& u, int wr, int wc, int fr, int fq) const {
        const int row0 = u.pm * 256 + wr * 64 + fr, col0 = u.pn * 256 + wc * 32 + 8 * fq;
#pragma unroll
        for (int ai = 0; ai < 2; ++ai)
#pragma unroll
            for (int m = 0; m < 4; ++m) { bf16* rowp = O + (size_t)(row0 + ai * 128 + m * 16) * ldc + col0;
#pragma unroll
                for (int bj = 0; bj < 2; ++bj) { const f32x4 v0 = acc[ai][bj][m][0], v1 = acc[ai][bj][m][1];
                    v4u w; w.x = pk2(v0[0], v0[1]); w.y = pk2(v0[2], v0[3]); w.z = pk2(v1[0], v1[1]); w.w = pk2(v1[2], v1[3]);
                    *(v4u*)(rowp + bj * 128) = w; } }
    }
};
struct EpiProj { static constexpr bool PERM = true, INPLACE = false; bf16* O; unsigned char* G8;
    __device__ __forceinline__ void operator()(const Acc& acc, const Unit& u, int wr, int wc, int fr, int fq) const {
        const int row0 = u.pm * 256 + wr * 64 + fr;
        if (u.pn < PN_GATE) { const int col0 = u.pn * 256 + wc * 32 + 8 * fq;
#pragma unroll
            for (int ai = 0; ai < 2; ++ai)
#pragma unroll
                for (int m = 0; m < 4; ++m) { bf16* rowp = O + (size_t)(row0 + ai * 128 + m * 16) * INC + col0;
#pragma unroll
                    for (int bj = 0; bj < 2; ++bj) { const f32x4 v0 = acc[ai][bj][m][0], v1 = acc[ai][bj][m][1];
                        v4u w; w.x = pk2(v0[0], v0[1]); w.y = pk2(v0[2], v0[3]); w.z = pk2(v1[0], v1[1]); w.w = pk2(v1[2], v1[3]);
                        *(v4u*)(rowp + bj * 128) = w; } }
        } else { const int pos0 = (u.pn - PN_GATE) * 256 + wc * 64 + fq * 16;
#pragma unroll
            for (int ai = 0; ai < 2; ++ai)
#pragma unroll
                for (int m = 0; m < 4; ++m) { unsigned char* rowp = G8 + (size_t)(row0 + ai * 128 + m * 16) * GW8 + pos0;
                    v4u w;
#pragma unroll
                    for (int bj = 0; bj < 2; ++bj) { const f32x4 v0 = acc[ai][bj][m][0], v1 = acc[ai][bj][m][1];
                        unsigned q[8];
#pragma unroll
                        for (int j = 0; j < 4; ++j) { q[j] = (unsigned)fmaxf(pg8::sigmoidf_(v0[j]) * 255.f + 0.5f, 1.f); q[4 + j] = (unsigned)fmaxf(pg8::sigmoidf_(v1[j]) * 255.f + 0.5f, 1.f); }
                        const unsigned lo = q[0] | (q[1] << 8) | (q[2] << 16) | (q[3] << 24), hi = q[4] | (q[5] << 8) | (q[6] << 16) | (q[7] << 24);
                        if (bj == 0) { w.x = lo; w.y = hi; } else { w.z = lo; w.w = hi; } }
                    *(v4u*)rowp = w; }
        }
    }
};
struct BranchSched { static constexpr bool GATHER = false;
    const char* A0; const char* B; int G, c;
    __device__ __forceinline__ void init(const void* ya, const void* w, int G_, int c_) { A0 = (const char*)ya; B = (const char*)w; G = G_; c = c_; }
    __device__ __forceinline__ bool next(int i, Unit& u) const {
        const int j = i / 3, seg = i - 3 * j; constexpr int nM = NTOK / 256, nN = D / 256, nwg = nM * nN;
        const int L = j * G + c; if (L >= nwg) return false;
        int wgid = L; { const int q = nwg / 8, xcd = wgid % 8, off = wgid / 8; wgid = xcd * q + off; }
        const int nig = 8 * nN; u.pm = (wgid / nig) * 8 + ((wgid % nig) % 8); u.pn = (wgid % nig) / 8;
        u.A = A0 + (size_t)seg * (WS_YB - WS_YA) + (size_t)u.pm * 256 * CW * 2; u.B = B + (size_t)seg * 3 * MiB + (size_t)u.pn * 256 * CW * 2; u.list = nullptr; u.m0 = seg; u.cnt = 0; return true; }
    __device__ __forceinline__ unsigned avoff(const Unit&, int h, int R, int C, int K_) const { return (unsigned)(((h * 128 + R) * K_ + C) * 2); }
};
struct EpiGateRT { static constexpr bool PERM = true, INPLACE = true; const unsigned char* g8; bf16* merged;
    __device__ __forceinline__ bool inplace(Acc& acc, const Unit& u, int wr, int wc, int fr, int fq) const {
        const int row0 = u.pm * 256 + wr * 64 + fr, col0 = u.pn * 256 + wc * 32 + 8 * fq, pos0 = u.pn * 256 + wc * 64 + fq * 16; const int seg = u.m0;
#pragma unroll
        for (int ai = 0; ai < 2; ++ai) {
            v4u ga[4], gb[4];
#pragma unroll
            for (int m = 0; m < 4; ++m) { const size_t row = (size_t)(row0 + ai * 128 + m * 16);
                ga[m] = *(const v4u*)(g8 + row * GW8 + seg * D + pos0); gb[m] = ga[m]; if (seg < 2) gb[m] = *(const v4u*)(g8 + row * GW8 + (seg + 1) * D + pos0); }
            asm volatile("" ::: "memory");
#pragma unroll
            for (int m = 0; m < 4; ++m) { const size_t row = (size_t)(row0 + ai * 128 + m * 16);
#pragma unroll
                for (int bj = 0; bj < 2; ++bj) { const unsigned ax = bj ? ga[m].z : ga[m].x, ay = bj ? ga[m].w : ga[m].y, bx = bj ? gb[m].z : gb[m].x, by = bj ? gb[m].w : gb[m].y;
                    f32x4 v0 = acc[ai][bj][m][0], v1 = acc[ai][bj][m][1];
                    if (seg < 2) {
                        v0[0] *= (float)(ax & 255u) * __builtin_amdgcn_rcpf((float)(bx & 255u)); v0[1] *= (float)((ax >> 8) & 255u) * __builtin_amdgcn_rcpf((float)((bx >> 8) & 255u));
                        v0[2] *= (float)((ax >> 16) & 255u) * __builtin_amdgcn_rcpf((float)((bx >> 16) & 255u)); v0[3] *= (float)(ax >> 24) * __builtin_amdgcn_rcpf((float)(bx >> 24));
                        v1[0] *= (float)(ay & 255u) * __builtin_amdgcn_rcpf((float)(by & 255u)); v1[1] *= (float)((ay >> 8) & 255u) * __builtin_amdgcn_rcpf((float)((by >> 8) & 255u));
                        v1[2] *= (float)((ay >> 16) & 255u) * __builtin_amdgcn_rcpf((float)((by >> 16) & 255u)); v1[3] *= (float)(ay >> 24) * __builtin_amdgcn_rcpf((float)(by >> 24));
                        acc[ai][bj][m][0] = v0; acc[ai][bj][m][1] = v1;
                    } else { constexpr float s8 = 1.f / 255.f;
                        v0[0] *= (float)(ax & 255u) * s8; v0[1] *= (float)((ax >> 8) & 255u) * s8; v0[2] *= (float)((ax >> 16) & 255u) * s8; v0[3] *= (float)(ax >> 24) * s8;
                        v1[0] *= (float)(ay & 255u) * s8; v1[1] *= (float)((ay >> 8) & 255u) * s8; v1[2] *= (float)((ay >> 16) & 255u) * s8; v1[3] *= (float)(ay >> 24) * s8;
                        v4u w; w.x = pk2(v0[0], v0[1]); w.y = pk2(v0[2], v0[3]); w.z = pk2(v1[0], v1[1]); w.w = pk2(v1[2], v1[3]); *(v4u*)(merged + row * D + col0 + bj * 128) = w; } } }
            asm volatile("" ::: "memory");
        }
        return seg < 2;
    }
};
template <bool RB16> struct EpiResid { static constexpr bool PERM = true, INPLACE = false; const void* xres; bf16* z;
    __device__ __forceinline__ void operator()(const Acc& acc, const Unit& u, int wr, int wc, int fr, int fq) const {
        const int row0 = u.pm * 256 + wr * 64 + fr, col0 = u.pn * 256 + wc * 32 + 8 * fq;
#pragma unroll
        for (int ai = 0; ai < 2; ++ai) {
            f32x4 xr[4][2][2];
#pragma unroll
            for (int m = 0; m < 4; ++m) { const size_t off = (size_t)(row0 + ai * 128 + m * 16) * D + col0;
#pragma unroll
                for (int bj = 0; bj < 2; ++bj) {
                    if constexpr (RB16) { const v4u w = *(const v4u*)((const bf16*)xres + off + bj * 128);
                        xr[m][bj][0] = (f32x4){pg8::bf_lo(w.x), pg8::bf_hi(w.x), pg8::bf_lo(w.y), pg8::bf_hi(w.y)}; xr[m][bj][1] = (f32x4){pg8::bf_lo(w.z), pg8::bf_hi(w.z), pg8::bf_lo(w.w), pg8::bf_hi(w.w)}; }
                    else {
#pragma unroll
                        for (int n = 0; n < 2; ++n) xr[m][bj][n] = *(const f32x4*)((const float*)xres + off + bj * 128 + n * 4); } } }
            asm volatile("" ::: "memory");
#pragma unroll
            for (int m = 0; m < 4; ++m) { const size_t off = (size_t)(row0 + ai * 128 + m * 16) * D + col0;
#pragma unroll
                for (int bj = 0; bj < 2; ++bj) { const f32x4 v0 = xr[m][bj][0] * ALPHA + acc[ai][bj][m][0], v1 = xr[m][bj][1] * ALPHA + acc[ai][bj][m][1];
                    v4u w; w.x = pk2(v0[0], v0[1]); w.y = pk2(v0[2], v0[3]); w.z = pk2(v1[0], v1[1]); w.w = pk2(v1[2], v1[3]); *(v4u*)(z + off + bj * 128) = w; } }
            asm volatile("" ::: "memory");
        }
    }
};

constexpr int NWAVES = 8;
constexpr int RING_OFF = 0, RING_BYTES = 131072;
constexpr int SCR_BYTES = 147456;
constexpr int MISC_OFF = SCR_BYTES;
constexpr int LDS_BYTES = 163840;
constexpr int PH_CVT = 0, PH_L0 = 1, PH_PER_LAYER = 10;
constexpr int P_INPROJ = 0, P_MIX = 1, P_SCAN = 2, P_HOUT = 3, P_BRANCH = 4, P_WO = 5, P_ROUTE = 6, P_GU = 7, P_DOWN = 8, P_COMB = 9;
constexpr int N_PHASES = PH_L0 + 2 * PH_PER_LAYER;

constexpr int NCV = 64;
#define CV_UNITS 5
#define GM_UNITS 14
struct Frame { LAS unsigned char* lds; int tid, lane, wave, G, gw, NGW; };

__device__ __forceinline__ void xpose_item(const float* W, int N, int k0, int n0, bf16* WTrow0, int ldk, LAS float* scr, int lane) {
    const int kk = lane >> 3, nn = (lane & 7) * 4;
    f32x4 v[8];
#pragma unroll
    for (int i = 0; i < 8; ++i) v[i] = *(const f32x4*)(W + (size_t)(k0 + kk + 8 * i) * N + n0 + nn);
#pragma unroll
    for (int i = 0; i < 8; ++i) { LAS float* s = scr + (kk + 8 * i) * 33 + nn; s[0] = v[i][0]; s[1] = v[i][1]; s[2] = v[i][2]; s[3] = v[i][3]; }
    LDS_WAIT(); asm volatile("" ::: "memory");
    const int c = lane & 7;
#pragma unroll
    for (int j = 0; j < 4; ++j) { const int n = (lane >> 3) + 8 * j; const LAS float* s = scr + (8 * c) * 33 + n;
        v4u o; o.x = pk2(s[0 * 33], s[1 * 33]); o.y = pk2(s[2 * 33], s[3 * 33]); o.z = pk2(s[4 * 33], s[5 * 33]); o.w = pk2(s[6 * 33], s[7 * 33]);
        *(v4u*)(WTrow0 + (size_t)n * ldk + 8 * c) = o; }
    LDS_WAIT(); asm volatile("" ::: "memory");
}
__device__ __forceinline__ void xpose_matrix(const Frame& F, const float* W, int K, int N, bf16* WT, int ldk, int mode, unsigned& gbase) {
    const int nblk = N / 32, nitems = (K / 64) * nblk;
    LAS float* scr = (LAS float*)(F.lds + RING_OFF + F.wave * 8704);
    int it = (int)(((unsigned)F.gw + (unsigned)F.NGW - gbase % (unsigned)F.NGW) % (unsigned)F.NGW);
    for (; it < nitems; it += F.NGW) {
        const int kb = it / nblk, nb = it % nblk, n0 = nb * 32, k0 = kb * 64;
        const int drow = mode == 0 ? n0 : ((n0 >> 7) * 256 + (n0 & 127) + (mode == 2 ? 128 : 0));
        xpose_item(W, N, k0, n0, WT + (size_t)drow * ldk + k0, ldk, scr, F.lane);
    }
    gbase += (unsigned)nitems;
}
__device__ __forceinline__ void cvt_rows(const Frame& F, const float* in, bf16* out, size_t n8) {
    for (size_t i = (size_t)blockIdx.x * 512 + F.tid; i < n8; i += (size_t)F.G * 512) {
        const f32x4 a = *(const f32x4*)(in + i * 8), b = *(const f32x4*)(in + i * 8 + 4);
        v4u w; w.x = pk2(a[0], a[1]); w.y = pk2(a[2], a[3]); w.z = pk2(b[0], b[1]); w.w = pk2(b[2], b[3]);
        *(v4u*)(out + i * 8) = w; }
}
__device__ __forceinline__ void cvt_router(const Frame& F, const float* rw, unsigned char* ws) {
    for (int i = blockIdx.x * 512 + F.tid; i < 2 * D * NE; i += F.G * 512) { const int l = i / (D * NE), k = (i / NE) % D, e = i % NE;
        const float w = rw[i]; const bf16 h = f2bf(w); const bf16 lo = f2bf(w - bf2f(h));
        bf16* dst = (bf16*)(ws + WS_RW + l * RW_L); dst[(size_t)e * D + k] = h; dst[(size_t)(NE + e) * D + k] = lo; }
}
struct XItem { const float* src; bf16* dst; int N, ldk; };
__device__ __forceinline__ void xp_decode(int I, const float* wg, const float* wu, const float* wd, const float* sg, const float* su, const float* sd, unsigned char* ws, XItem& x) {
    const int e = I / 1536, rem = I % 1536, m = rem >> 9, it = rem & 511;
    if (m < 2) { const float* W = m == 0 ? (e < NE ? wg + (size_t)e * D * EH : sg) : (e < NE ? wu + (size_t)e * D * EH : su);
        const int kb = it >> 4, nb = it & 15, n0 = nb * 32, k0 = kb * 64; const int drow = (n0 >> 7) * 256 + (n0 & 127) + (m == 1 ? 128 : 0);
        x.src = W + (size_t)k0 * EH + n0; x.N = EH; x.ldk = D; x.dst = (bf16*)(ws + WS_WGU + (size_t)e * WGU_E) + (size_t)drow * D + k0; }
    else { const float* W = e < NE ? wd + (size_t)e * EH * D : sd; const int kb = it >> 6, nb = it & 63, n0 = nb * 32, k0 = kb * 64;
        x.src = W + (size_t)k0 * D + n0; x.N = D; x.ldk = EH; x.dst = (bf16*)(ws + WS_WDN + (size_t)e * WDN_E) + (size_t)n0 * EH + k0; }
}
__device__ __forceinline__ void xp_load(const XItem& x, int lane, f32x4 (&v)[8]) {
    const int kk = lane >> 3, nn = (lane & 7) * 4;
#pragma unroll
    for (int i = 0; i < 8; ++i) v[i] = __builtin_nontemporal_load((const f32x4*)(x.src + (size_t)(kk + 8 * i) * x.N + nn));
}
__device__ __forceinline__ void xp_store(const XItem& x, const f32x4 (&v)[8], LAS float* scr, int lane) {
    const int kk = lane >> 3, nn = (lane & 7) * 4;
#pragma unroll
    for (int i = 0; i < 8; ++i) { LAS float* s = scr + (kk + 8 * i) * 33 + nn; s[0] = v[i][0]; s[1] = v[i][1]; s[2] = v[i][2]; s[3] = v[i][3]; }
    LDS_WAIT(); asm volatile("" ::: "memory");
    const int c = lane & 7;
#pragma unroll
    for (int j = 0; j < 4; ++j) { const int n = (lane >> 3) + 8 * j; const LAS float* s = scr + (8 * c) * 33 + n;
        v4u o; o.x = pk2(s[0 * 33], s[1 * 33]); o.y = pk2(s[2 * 33], s[3 * 33]); o.z = pk2(s[4 * 33], s[5 * 33]); o.w = pk2(s[6 * 33], s[7 * 33]);
        __builtin_nontemporal_store(o, (v4u*)(x.dst + (size_t)n * x.ldk + 8 * c)); }
    LDS_WAIT(); asm volatile("" ::: "memory");
}
__device__ __forceinline__ void cvt_experts(const Frame& F, const float* wg, const float* wu, const float* wd, const float* sg, const float* su, const float* sd, unsigned char* ws, unsigned& gbase) {
    (void)gbase;
    LAS float* scr = (LAS float*)(F.lds + RING_OFF + F.wave * 8704);
    const int total = (NE + 1) * 1536;
    XItem A, B; f32x4 va[8], vb[8];
    int I = F.gw;
    if (I < total) { xp_decode(I, wg, wu, wd, sg, su, sd, ws, A); xp_load(A, F.lane, va); }
    for (; I < total; I += 2 * F.NGW) {
        const int I2 = I + F.NGW, I3 = I + 2 * F.NGW;
        if (I2 < total) { xp_decode(I2, wg, wu, wd, sg, su, sd, ws, B); xp_load(B, F.lane, vb); }
        xp_store(A, va, scr, F.lane);
        if (I2 < total) { if (I3 < total) { xp_decode(I3, wg, wu, wd, sg, su, sd, ws, A); xp_load(A, F.lane, va); }
            xp_store(B, vb, scr, F.lane); }
    }
}
constexpr int NVO_OFF = MISC_OFF + 1024;  static_assert(NVO_OFF == pg8::PG8_NVO_OFF, "nvo");
constexpr int PLAN_OFF = NVO_OFF + 8192;
constexpr int PLAN_TB = PLAN_OFF, PLAN_CN = PLAN_OFF + 66 * 4, PLAN_TE = PLAN_OFF + 132 * 4;
constexpr int MAXTILES = 640;
#ifndef ROUTE_PROBE
#define ROUTE_PROBE 0
#endif
static_assert(PLAN_TE + MAXTILES * 4 <= LDS_BYTES, "LDS map");

__device__ __forceinline__ float wave_sum(float v, int lane) {
#pragma unroll
    for (int o = 1; o < 64; o <<= 1) v += shx(v, o, lane);
    return v;
}
__device__ __forceinline__ void moe_plan(const Frame& F, const unsigned* cnt) {
    LAS unsigned* tb = (LAS unsigned*)(F.lds + PLAN_TB); LAS unsigned* cn = (LAS unsigned*)(F.lds + PLAN_CN); LAS unsigned* te = (LAS unsigned*)(F.lds + PLAN_TE);
    __syncthreads();
    if (F.tid <= NE) { unsigned run = 0; for (int e = 0; e < F.tid; ++e) run += (__hip_atomic_load(cnt + e, RLX_AGENT) + 255u) >> 8;
        tb[F.tid] = run; cn[F.tid] = F.tid < NE ? __hip_atomic_load(cnt + F.tid, RLX_AGENT) : (unsigned)NTOK; if (F.tid == NE) tb[NE + 1] = run + NTOK / 256; }
    __syncthreads();
    for (int t = F.tid; t < MAXTILES; t += NWAVES * 64) { unsigned e = 0; for (int q = 1; q <= NE; ++q) if (tb[q] <= (unsigned)t) e = q; te[t] = e; }
    __syncthreads();
}
template <bool GU> struct MoeSched { static constexpr bool GATHER = GU;
    const LAS unsigned* tb; const LAS unsigned* cn; const LAS unsigned* te; int nunits, nN, G, c; const char* Abase; const char* Bbase; const int* list;
    __device__ __forceinline__ void init(const Frame& F, const void* A_, const void* B_, const int* list_) {
        tb = (const LAS unsigned*)(F.lds + PLAN_TB); cn = (const LAS unsigned*)(F.lds + PLAN_CN); te = (const LAS unsigned*)(F.lds + PLAN_TE);
        nN = GU ? 4 : 8; nunits = (int)tb[NE + 1] * nN; G = F.G; const int bx = blockIdx.x; c = (G % 8 == 0) ? (bx % 8) * (G / 8) + bx / 8 : bx;
        Abase = (const char*)A_; Bbase = (const char*)B_; list = list_; }
    __device__ __forceinline__ bool next(int i, Unit& u) const {
        constexpr int RUN = GU ? 2 : 4; const int hs = c + G * (i / RUN), per = nN / RUN;
        const int tile = hs / per, pn = (hs % per) * RUN + (i % RUN); if (tile * nN >= nunits) return false;
        const int e = (int)te[tile];
        u.pm = tile; u.pn = pn;
        if (GU) { u.A = Abase; u.B = Bbase + (size_t)e * WGU_E + (size_t)pn * 256 * D * 2; u.list = e < NE ? list + (size_t)e * LISTCAP : nullptr; u.m0 = (tile - (int)tb[e]) * 256; u.cnt = (int)cn[e]; }
        else { u.A = Abase + (size_t)tile * 256 * EH * 2; u.B = Bbase + (size_t)e * WDN_E + (size_t)pn * 256 * EH * 2; u.list = nullptr; u.m0 = 0; u.cnt = 0; }
        return true; }
    __device__ __forceinline__ unsigned avoff(const Unit& u, int h, int R, int C, int K_) const {
        if (GU) { const int pos = u.m0 + h * 128 + R; int row = 0; if (pos < u.cnt) row = u.list ? u.list[pos] : pos; return (unsigned)((row * K_ + C) * 2); }
        else return (unsigned)(((h * 128 + R) * K_ + C) * 2); }
};
struct EpiSwiGLU { static constexpr bool PERM = true, INPLACE = false; bf16* H;
    __device__ __forceinline__ void operator()(const Acc& acc, const Unit& u, int wr, int wc, int fr, int fq) const {
        const int row0 = u.pm * 256 + wr * 64 + fr, col0 = u.pn * 128 + wc * 32 + 8 * fq;
#pragma unroll
        for (int ai = 0; ai < 2; ++ai)
#pragma unroll
            for (int m = 0; m < 4; ++m) { bf16* rowp = H + (size_t)(row0 + ai * 128 + m * 16) * EH + col0;
                float hv[8];
#pragma unroll
                for (int n = 0; n < 2; ++n)
#pragma unroll
                    for (int j = 0; j < 4; ++j) { const float g = acc[ai][0][m][n][j], uu = acc[ai][1][m][n][j]; hv[n * 4 + j] = g * pg8::sigmoidf_(g) * uu; }
                v4u w; w.x = pk2(hv[0], hv[1]); w.y = pk2(hv[2], hv[3]); w.z = pk2(hv[4], hv[5]); w.w = pk2(hv[6], hv[7]);
                *(v4u*)rowp = w; }
    }
};

struct EpiY8 { static constexpr bool PERM = true, INPLACE = false; unsigned char* Y8; bf16* YS;
    __device__ __forceinline__ void operator()(const Acc& acc, const Unit& u, int wr, int wc, int fr, int fq) const {
        const int row0 = u.pm * 256 + wr * 64 + fr, pos0 = u.pn * 256 + wc * 64 + fq * 16;
#pragma unroll
        for (int ai = 0; ai < 2; ++ai)
#pragma unroll
            for (int m = 0; m < 4; ++m) { const size_t row = (size_t)(row0 + ai * 128 + m * 16);
                v4u w; unsigned sw = 0u;
#pragma unroll
                for (int bj = 0; bj < 2; ++bj) { const f32x4 v0 = acc[ai][bj][m][0], v1 = acc[ai][bj][m][1];
                    const float am = fmaxf(fmaxf(fmaxf(fabsf(v0[0]), fabsf(v0[1])), fmaxf(fabsf(v0[2]), fabsf(v0[3]))), fmaxf(fmaxf(fabsf(v1[0]), fabsf(v1[1])), fmaxf(fabsf(v1[2]), fabsf(v1[3]))));
                    const unsigned sb = f2bf(am * (1.f / 127.f)); const float sc = __uint_as_float(sb << 16); const float inv = sc > 0.f ? __builtin_amdgcn_rcpf(sc) : 0.f;
                    unsigned q[8];
#pragma unroll
                    for (int j = 0; j < 4; ++j) { q[j] = (unsigned)fminf(rintf(v0[j] * inv + 128.f), 255.f); q[4 + j] = (unsigned)fminf(rintf(v1[j] * inv + 128.f), 255.f); }
                    const unsigned lo = q[0] | (q[1] << 8) | (q[2] << 16) | (q[3] << 24), hi = q[4] | (q[5] << 8) | (q[6] << 16) | (q[7] << 24);
                    if (bj == 0) { w.x = lo; w.y = hi; sw = sb; } else { w.z = lo; w.w = hi; sw |= sb << 16; } }
                *(v4u*)(Y8 + row * D + pos0) = w; *(unsigned*)(YS + row * (D / 8) + (pos0 >> 3)) = sw; }
    }
};
__device__ __forceinline__ void route_phase(const Frame& F, const bf16* __restrict__ Z, const float* __restrict__ g, const float* __restrict__ bb, const bf16* __restrict__ rwh, const float* __restrict__ rb,
                                            bf16* __restrict__ X1L, bf16* __restrict__ X1BF, unsigned* cnt, int* list, int* tokslot, float* tokw, bool dispatch = true) {
    LAS float* part = (LAS float*)(F.lds + RING_OFF);
    LAS float* lg = part + 4 * 4096;
    LAS float* sl = lg + 64 * 65;
    LAS unsigned* cntL = (LAS unsigned*)(sl + 64 * 65);
    LAS unsigned* baseL = cntL + 64;
    LAS unsigned* ee = baseL + 64;
    LAS unsigned* pl = ee + 512;
    LAS float* ww = (LAS float*)(pl + 512);
    for (int grp = blockIdx.x; grp < NTOK / 64; grp += F.G) {
        const int t0 = grp * 64;
        if (F.tid < 64) cntL[F.tid] = 0u;
        for (int rp_ = 0; rp_ < (ROUTE_PROBE == 1 ? 2 : 1); ++rp_)
#pragma unroll 2
        for (int q = 0; q < 8; ++q) {
            const int t = t0 + F.wave * 8 + q;
            const v2u* zr = (const v2u*)(Z + (size_t)t * D) + F.lane;
            f32x4 v[8]; float s = 0.f;
#pragma unroll
            for (int j = 0; j < 8; ++j) { const v2u zw = zr[64 * j]; v[j] = (f32x4){pg8::bf_lo(zw.x), pg8::bf_hi(zw.x), pg8::bf_lo(zw.y), pg8::bf_hi(zw.y)}; s += (v[j][0] + v[j][1]) + (v[j][2] + v[j][3]); }
            const float mean = wave_sum(s, F.lane) * (1.f / D); float s2 = 0.f;
#pragma unroll
            for (int j = 0; j < 8; ++j) { v[j] = v[j] - mean; s2 += (v[j][0] * v[j][0] + v[j][1] * v[j][1]) + (v[j][2] * v[j][2] + v[j][3] * v[j][3]); }
            const float rstd = 1.f / sqrtf(wave_sum(s2, F.lane) * (1.f / D) + LN_EPS);
            v2u* xl = (v2u*)(X1L + (size_t)t * D) + F.lane; v2u* xb = (v2u*)(X1BF + (size_t)t * D) + F.lane;
#pragma unroll
            for (int j = 0; j < 8; ++j) { const f32x4 gg = ((const f32x4*)g)[F.lane + 64 * j], bv = ((const f32x4*)bb)[F.lane + 64 * j];
                const f32x4 y = v[j] * rstd * gg + bv; v2u w; w.x = pk2(y[0], y[1]); w.y = pk2(y[2], y[3]); xb[64 * j] = w;
                v2u lo; lo.x = pk2(y[0] - pg8::bf_lo(w.x), y[1] - pg8::bf_hi(w.x)); lo.y = pk2(y[2] - pg8::bf_lo(w.y), y[3] - pg8::bf_hi(w.y)); xl[64 * j] = lo; }
        }
        VM_WAIT(); __syncthreads();
        for (int rp_ = 0; rp_ < (ROUTE_PROBE == 2 ? 2 : 1); ++rp_)
        { const int r = F.lane & 15, kq = F.lane >> 4, kb = (F.wave & 3) * 512, th = F.wave >> 2;
          const bf16* xh = X1BF + (size_t)(t0 + th * 32 + r) * D + kb + 8 * kq;
          const bf16* xl = X1L + (size_t)(t0 + th * 32 + r) * D + kb + 8 * kq;
          const bf16* wh = rwh + (size_t)r * D + kb + 8 * kq;
          f32x4 acc[2][4];
#pragma unroll
          for (int tt = 0; tt < 2; ++tt)
#pragma unroll
              for (int nb = 0; nb < 4; ++nb) acc[tt][nb] = (f32x4){0.f, 0.f, 0.f, 0.f};
          bf16x8 xA[2][2], xB[2][2]; bf16x8 hA[4], lA[4], hB[4], lB[4];
#define RT_LOAD(X, H, L, ks) do { const int k_ = ((ks) < 16 ? (ks) : 15) * 32; _Pragma("unroll") for (int tt = 0; tt < 2; ++tt) { X[tt][0] = *(const bf16x8*)(xh + (size_t)tt * 16 * D + k_); X[tt][1] = *(const bf16x8*)(xl + (size_t)tt * 16 * D + k_); } \
              _Pragma("unroll") for (int nb = 0; nb < 4; ++nb) { H[nb] = *(const bf16x8*)(wh + (size_t)nb * 16 * D + k_); L[nb] = *(const bf16x8*)(wh + (size_t)(64 + nb * 16) * D + k_); } } while (0)
#define RT_MMA(X, H, L) do { \
              _Pragma("unroll") for (int tt = 0; tt < 2; ++tt) _Pragma("unroll") for (int nb = 0; nb < 4; ++nb) acc[tt][nb] = __builtin_amdgcn_mfma_f32_16x16x32_bf16(X[tt][1], H[nb], acc[tt][nb], 0, 0, 0); \
              _Pragma("unroll") for (int tt = 0; tt < 2; ++tt) _Pragma("unroll") for (int nb = 0; nb < 4; ++nb) acc[tt][nb] = __builtin_amdgcn_mfma_f32_16x16x32_bf16(X[tt][0], L[nb], acc[tt][nb], 0, 0, 0); \
              _Pragma("unroll") for (int tt = 0; tt < 2; ++tt) _Pragma("unroll") for (int nb = 0; nb < 4; ++nb) acc[tt][nb] = __builtin_amdgcn_mfma_f32_16x16x32_bf16(X[tt][0], H[nb], acc[tt][nb], 0, 0, 0); } while (0)
          RT_LOAD(xA, hA, lA, 0);
#pragma unroll 1
          for (int ks = 0; ks < 16; ks += 2) {
              RT_LOAD(xB, hB, lB, ks + 1); RT_MMA(xA, hA, lA);
              RT_LOAD(xA, hA, lA, ks + 2); RT_MMA(xB, hB, lB);
          }
#undef RT_LOAD
#undef RT_MMA
#pragma unroll
          for (int tt = 0; tt < 2; ++tt)
#pragma unroll
              for (int nb = 0; nb < 4; ++nb)
#pragma unroll
                  for (int reg = 0; reg < 4; ++reg) part[(F.wave & 3) * 4096 + (th * 32 + tt * 16 + 4 * kq + reg) * 64 + nb * 16 + r] = acc[tt][nb][reg];
        }
        __syncthreads();
        for (int i = F.tid; i < 64 * 64; i += NWAVES * 64) { const int tk = i >> 6, e = i & 63; const float lgt = (part[i] + part[4096 + i]) + (part[8192 + i] + part[12288 + i]);
            const float sc = 1.f / (1.f + __expf(-lgt)); lg[tk * 65 + e] = sc; sl[tk * 65 + e] = sc + rb[e]; }
        __syncthreads();
        for (int rp_ = 0; rp_ < (ROUTE_PROBE == 3 ? 2 : 1); ++rp_)
        { const bool lastrp = (rp_ == (ROUTE_PROBE == 3 ? 1 : 0));
          const int tk = F.wave * 8 + (F.lane >> 3), gq = F.lane & 7, lane = F.lane;
          float sv[8], cv[8];
#pragma unroll
          for (int j = 0; j < 8; ++j) { sv[j] = sl[tk * 65 + gq * 8 + j]; cv[j] = lg[tk * 65 + gq * 8 + j]; }
          float m1 = -INFINITY, m2 = -INFINITY;
#pragma unroll
          for (int j = 0; j < 8; ++j) { const float x = sv[j]; const bool g1 = x > m1; m2 = g1 ? m1 : fmaxf(m2, x); m1 = g1 ? x : m1; }
          const float gs = m1 + m2;
          int rank = 0;
#pragma unroll
          for (int o = 1; o < 8; ++o) { const float og = shx(gs, o, lane); const int oq = gq ^ o; rank += (og > gs || (og == gs && oq < gq)) ? 1 : 0; }
          const bool gsel = rank < 4;
          unsigned used = gsel ? 0u : 0xffu;
          float wsum = 0.f; float my_sc = 0.f; int my_e = 0;
#pragma unroll
          for (int i = 0; i < 8; ++i) {
              float bv = -INFINITY, bs = 0.f; int be = 64;
#pragma unroll
              for (int j = 0; j < 8; ++j) { const bool ok = !((used >> j) & 1u) && sv[j] > bv; bv = ok ? sv[j] : bv; bs = ok ? cv[j] : bs; be = ok ? gq * 8 + j : be; }
#pragma unroll
              for (int o = 1; o < 8; o <<= 1) { const float ov = shx(bv, o, lane), os = shx(bs, o, lane); const int oe = __float_as_int(shx(__int_as_float(be), o, lane));
                  const bool tk_o = ov > bv || (ov == bv && oe < be); bv = tk_o ? ov : bv; bs = tk_o ? os : bs; be = tk_o ? oe : be; }
              if ((be >> 3) == gq) used |= 1u << (be & 7);
              wsum += bs; if (gq == i) { my_sc = bs; my_e = be; }
          }
          const int slot = tk * 8 + gq;
          ee[slot] = (unsigned)my_e; ww[slot] = my_sc * (RSCALE / wsum);
          pl[slot] = __hip_atomic_fetch_add(cntL + my_e, (dispatch && lastrp) ? 1u : 0u, __ATOMIC_RELAXED, __HIP_MEMORY_SCOPE_WORKGROUP);
        }
        __syncthreads();
        if (F.tid < 64) { const unsigned n = cntL[F.tid]; baseL[F.tid] = n ? __hip_atomic_fetch_add(cnt + F.tid, n, RLX_AGENT) : 0u; }
        __syncthreads();
        if (dispatch) { const int tk = F.tid >> 3, i = F.tid & 7; const unsigned e = ee[F.tid]; const unsigned pos = baseL[e] + pl[F.tid]; const int t = t0 + tk;
          list[(size_t)e * LISTCAP + pos] = t; tokslot[t * 8 + i] = (int)(e * LISTCAP + pos); tokw[t * 8 + i] = ww[F.tid]; }
        __syncthreads();
    }
}
__device__ __forceinline__ void combine_phase(const Frame& F, const bf16* X1B, const unsigned char* Y8, const bf16* YS, const int* tokslot, const float* tokw, const float* g, const float* bb, float* OUT, bf16* XBF, bool last) {
    const LAS unsigned* tb = (const LAS unsigned*)(F.lds + PLAN_TB);
    LAS int* rw = (LAS int*)(F.lds + RING_OFF) + F.wave * 32;
#define CB_LOAD(W, S, ROW) do { const int r_ = __builtin_amdgcn_readfirstlane(ROW); const v2u* yr_ = (const v2u*)(Y8 + (size_t)r_ * D) + F.lane; const bf16* ys_ = YS + (size_t)r_ * (D / 8) + F.lane; \
        _Pragma("unroll") for (int j = 0; j < 4; ++j) { W[j] = yr_[64 * j]; S[j] = ys_[64 * j]; } } while (0)
#define CB_ACC(W, S, WT) do { const float wt_ = __int_as_float(__builtin_amdgcn_readfirstlane(WT)); _Pragma("unroll") for (int j = 0; j < 4; ++j) { const float sc = bf2f(S[j]) * wt_, c0 = -128.f * sc; const unsigned x = W[j].x, y = W[j].y; \
        v[j][0] += sc * (float)(x & 255u) + c0; v[j][1] += sc * (float)((x >> 8) & 255u) + c0; v[j][2] += sc * (float)((x >> 16) & 255u) + c0; v[j][3] += sc * (float)(x >> 24) + c0; \
        v[j][4] += sc * (float)(y & 255u) + c0; v[j][5] += sc * (float)((y >> 8) & 255u) + c0; v[j][6] += sc * (float)((y >> 16) & 255u) + c0; v[j][7] += sc * (float)(y >> 24) + c0; } } while (0)
    const int cl = (F.lane >> 5) * 256 + (F.lane & 1) * 128 + ((F.lane >> 3) & 3) * 32 + ((F.lane >> 1) & 3) * 8;
    for (int t = F.gw; t < NTOK; t += F.NGW) {
        if (F.lane < 8) { const int sl = tokslot[t * 8 + F.lane]; rw[F.lane] = (int)tb[sl / LISTCAP] * 256 + (sl % LISTCAP); rw[16 + F.lane] = __float_as_int(tokw[t * 8 + F.lane]); }
        if (F.lane == 8) { rw[8] = (int)tb[NE] * 256 + t; rw[24] = __float_as_int(1.f); }
        LDS_WAIT(); asm volatile("" ::: "memory");
        float v[4][8]; float s = 0.f;
        v2u wa[4], wb[4], wc[4]; bf16 sa[4], sb2[4], sc2[4];
        CB_LOAD(wa, sa, rw[0]); CB_LOAD(wb, sb2, rw[1]); CB_LOAD(wc, sc2, rw[2]);
#pragma unroll
        for (int j = 0; j < 4; ++j) { const v4u xw = *(const v4u*)(X1B + (size_t)t * D + 512 * j + cl);
            v[j][0] = pg8::bf_lo(xw.x) * ALPHA; v[j][1] = pg8::bf_hi(xw.x) * ALPHA; v[j][2] = pg8::bf_lo(xw.y) * ALPHA; v[j][3] = pg8::bf_hi(xw.y) * ALPHA;
            v[j][4] = pg8::bf_lo(xw.z) * ALPHA; v[j][5] = pg8::bf_hi(xw.z) * ALPHA; v[j][6] = pg8::bf_lo(xw.w) * ALPHA; v[j][7] = pg8::bf_hi(xw.w) * ALPHA; }
#pragma unroll 1
        for (int i = 0; i < 9; i += 3) {
            CB_ACC(wa, sa, rw[16 + i]); if (i < 6) CB_LOAD(wa, sa, rw[i + 3]);
            CB_ACC(wb, sb2, rw[17 + i]); if (i < 6) CB_LOAD(wb, sb2, rw[i + 4]);
            CB_ACC(wc, sc2, rw[18 + i]); if (i < 6) CB_LOAD(wc, sc2, rw[i + 5]);
        }
        asm volatile("" ::: "memory");
#pragma unroll
        for (int j = 0; j < 4; ++j)
#pragma unroll
            for (int e = 0; e < 8; ++e) s += v[j][e];
        const float mean = wave_sum(s, F.lane) * (1.f / D); float s2 = 0.f;
#pragma unroll
        for (int j = 0; j < 4; ++j)
#pragma unroll
            for (int e = 0; e < 8; ++e) { v[j][e] -= mean; s2 += v[j][e] * v[j][e]; }
        const float rstd = 1.f / sqrtf(wave_sum(s2, F.lane) * (1.f / D) + LN_EPS);
#pragma unroll
        for (int j = 0; j < 4; ++j) { const int c0 = cl + 512 * j; const f32x4 g0 = *(const f32x4*)(g + c0), g1 = *(const f32x4*)(g + c0 + 4), b0 = *(const f32x4*)(bb + c0), b1 = *(const f32x4*)(bb + c0 + 4);
            f32x4 y0, y1;
#pragma unroll
            for (int e = 0; e < 4; ++e) { y0[e] = v[j][e] * rstd * g0[e] + b0[e]; y1[e] = v[j][4 + e] * rstd * g1[e] + b1[e]; }
            if (last) { *(f32x4*)(OUT + (size_t)t * D + c0) = y0; *(f32x4*)(OUT + (size_t)t * D + c0 + 4) = y1; }
            else { v4u w; w.x = pk2(y0[0], y0[1]); w.y = pk2(y0[2], y0[3]); w.z = pk2(y1[0], y1[1]); w.w = pk2(y1[2], y1[3]); *(v4u*)(XBF + (size_t)t * D + c0) = w; } }
    }
#undef CB_LOAD
#undef CB_ACC
}
constexpr size_t R2_UT = 0, R2_OI = 48 * MiB, R2_QP = 96 * MiB, R2_DEC = 120 * MiB;
constexpr int NHU = NB * HGH * (SEQ / 64);
typedef __attribute__((address_space(3))) bf16 lbf16;
__device__ __forceinline__ void unpack8(const v4u w, float (&f)[8]) {
    f[0] = pg8::bf_lo(w.x); f[1] = pg8::bf_hi(w.x); f[2] = pg8::bf_lo(w.y); f[3] = pg8::bf_hi(w.y); f[4] = pg8::bf_lo(w.z); f[5] = pg8::bf_hi(w.z); f[6] = pg8::bf_lo(w.w); f[7] = pg8::bf_hi(w.w); }
__device__ __forceinline__ float exp_c(float x) { return __expf(fminf(x, 80.f)); }

__device__ __forceinline__ void conv_part(const Frame& F, const bf16* proj, const float* cw, bf16* YA, bf16* YX) {
    for (int i = blockIdx.x * 512 + F.tid; i < NTOK * 32; i += F.G * 512) *(v4u*)(YX + (size_t)(i >> 5) * YXW + XAW + (i & 31) * 8) = (v4u){0u, 0u, 0u, 0u};
    for (int i = blockIdx.x * 512 + F.tid; i < NTOK * (CW / 8); i += F.G * 512) {
        const int t = i / (CW / 8), c = (i % (CW / 8)) * 8, pos = t & (SEQ - 1);
        const bf16* r = proj + (size_t)t * INC;
        float u0[8], c0[8], b0[8], u1[8], c1[8], u2[8], c2[8], w0[8], w1[8], w2[8];
        unpack8(*(const v4u*)(r + C_U + c), u0); unpack8(*(const v4u*)(r + C_C + c), c0); unpack8(*(const v4u*)(r + C_B + c), b0);
        const v4u z4 = {0u, 0u, 0u, 0u};
        unpack8(pos >= 1 ? *(const v4u*)(r - INC + C_U + c) : z4, u1); unpack8(pos >= 1 ? *(const v4u*)(r - INC + C_C + c) : z4, c1);
        unpack8(pos >= 2 ? *(const v4u*)(r - 2 * INC + C_U + c) : z4, u2); unpack8(pos >= 2 ? *(const v4u*)(r - 2 * INC + C_C + c) : z4, c2);
#pragma unroll
        for (int j = 0; j < 8; ++j) { w0[j] = cw[c + j]; w1[j] = cw[CW + c + j]; w2[j] = cw[2 * CW + c + j]; }
        float o[8];
#pragma unroll
        for (int j = 0; j < 8; ++j) o[j] = b0[j] * (w2[j] * c0[j] * u0[j] + w1[j] * c1[j] * u1[j] + w0[j] * c2[j] * u2[j]);
        v4u w; w.x = pk2(o[0], o[1]); w.y = pk2(o[2], o[3]); w.z = pk2(o[4], o[5]); w.w = pk2(o[6], o[7]);
        *(v4u*)(YA + (size_t)t * CW + c) = w;
    }
}

__device__ __forceinline__ void hgrn_local(const Frame& F, const bf16* proj, const float* lbl, int layer, unsigned char* r2) {
    lbf16* QS = (lbf16*)(F.lds);
    lbf16* KS = QS + 64 * 136;
    lbf16* KPT = KS + 64 * 136;
    lbf16* VT = KPT + 128 * 72;
    lbf16* PS = VT + 128 * 72;
    LAS float* SEG = (LAS float*)(PS + 64 * 72);
    bf16* UT = (bf16*)(r2 + R2_UT); bf16* OI = (bf16*)(r2 + R2_OI); bf16* QP = (bf16*)(r2 + R2_QP); float* DEC = (float*)(r2 + R2_DEC);
    const int lane = F.lane, wv = F.wave, r = lane & 15, kq = lane >> 4;
    bf16 rf[16], rq[16], rv[16];
#define HL_LOAD(U) do { const int b_ = (U) / (HGH * 64), h_ = ((U) / 64) % HGH, c_ = (U) % 64; const bf16* p_ = proj + (size_t)(b_ * SEQ + c_ * 64 + (F.tid >> 7) * 16) * INC + h_ * HGD + (F.tid & 127); \
        _Pragma("unroll") for (int i = 0; i < 16; ++i) { rf[i] = p_[(size_t)i * INC + C_F]; rq[i] = p_[(size_t)i * INC + C_Q]; rv[i] = p_[(size_t)i * INC + C_I]; } } while (0)
    if ((int)blockIdx.x < NHU) HL_LOAD((int)blockIdx.x);
    for (int unit = blockIdx.x; unit < NHU; unit += F.G) {
        const int b = unit / (HGH * 64), h = (unit / 64) % HGH, c = unit % 64, t0 = b * SEQ + c * 64;
        { const int col = F.tid & 127, seg = F.tid >> 7, ch = h * HGD + col;
          float lb = 0.f; if (layer == 1) lb = 1.f / (1.f + __expf(lbl[ch] - lbl[HGW + ch]));
          float a[16], kk[16], qv[16], vv[16]; float run = 0.f;
#pragma unroll
          for (int i = 0; i < 16; ++i) {
              const float z = bf2f(rf[i]); const float ez = __expf(-z); const float sg = 1.f / (1.f + ez);
              const float f = lb + (1.f - lb) * sg; kk[i] = (1.f - lb) * ez * sg; run += fmaxf(__logf(f), -60.f); a[i] = run;
              qv[i] = bf2f(rq[i]); vv[i] = bf2f(rv[i]); }
          if (unit + F.G < NHU) HL_LOAD(unit + F.G);
          SEG[seg * 128 + col] = run;
          __syncthreads();
          const float s0 = SEG[col], s1 = SEG[128 + col], s2 = SEG[256 + col], s3 = SEG[384 + col];
          const float base = seg == 0 ? 0.f : (seg == 1 ? s0 : (seg == 2 ? s0 + s1 : s0 + s1 + s2)), bm = s0 + s1, bl = (s0 + s1) + (s2 + s3);
          float kp[16];
#pragma unroll
          for (int i = 0; i < 16; ++i) { const float bb = base + a[i]; const int t = seg * 16 + i;
              QS[t * 136 + col] = f2bf(qv[i] * exp_c(bb - bm)); KS[t * 136 + col] = f2bf(kk[i] * exp_c(bm - bb)); kp[i] = kk[i] * exp_c(bl - bb);
              QP[(size_t)(t0 + t) * HGW + ch] = f2bf(qv[i] * exp_c(bb)); }
          v4u w0, w1; w0.x = pk2(kp[0], kp[1]); w0.y = pk2(kp[2], kp[3]); w0.z = pk2(kp[4], kp[5]); w0.w = pk2(kp[6], kp[7]); w1.x = pk2(kp[8], kp[9]); w1.y = pk2(kp[10], kp[11]); w1.z = pk2(kp[12], kp[13]); w1.w = pk2(kp[14], kp[15]);
          *(LAS v4u*)(KPT + col * 72 + seg * 16) = w0; *(LAS v4u*)(KPT + col * 72 + seg * 16 + 8) = w1;
          w0.x = pk2(vv[0], vv[1]); w0.y = pk2(vv[2], vv[3]); w0.z = pk2(vv[4], vv[5]); w0.w = pk2(vv[6], vv[7]); w1.x = pk2(vv[8], vv[9]); w1.y = pk2(vv[10], vv[11]); w1.z = pk2(vv[12], vv[13]); w1.w = pk2(vv[14], vv[15]);
          *(LAS v4u*)(VT + col * 72 + seg * 16) = w0; *(LAS v4u*)(VT + col * 72 + seg * 16 + 8) = w1;
          if (seg == 0) DEC[(size_t)unit * 128 + col] = exp_c(bl);
        }
        __syncthreads();
        { const int tm = wv >> 1, tn0 = (wv & 1) * 2;
          bf16x8 af[4];
#pragma unroll
          for (int ks = 0; ks < 4; ++ks) af[ks] = *(const LAS bf16x8*)(QS + (tm * 16 + r) * 136 + ks * 32 + kq * 8);
#pragma unroll
          for (int jn = 0; jn < 2; ++jn) { const int tn = tn0 + jn; f32x4 acc = {0.f, 0.f, 0.f, 0.f};
              if (tn <= tm) {
#pragma unroll
                  for (int ks = 0; ks < 4; ++ks) { const bf16x8 bf = *(const LAS bf16x8*)(KS + (tn * 16 + r) * 136 + ks * 32 + kq * 8); acc = __builtin_amdgcn_mfma_f32_16x16x32_bf16(af[ks], bf, acc, 0, 0, 0); } }
#pragma unroll
              for (int g = 0; g < 4; ++g) { const int t = tm * 16 + 4 * kq + g, s = tn * 16 + r; PS[t * 72 + s] = f2bf(s <= t ? acc[g] : 0.f); } } }
        { bf16x8 af[2];
#pragma unroll
          for (int ks = 0; ks < 2; ++ks) af[ks] = *(const LAS bf16x8*)(KPT + (wv * 16 + r) * 72 + ks * 32 + kq * 8);
#pragma unroll
          for (int tv = 0; tv < 8; ++tv) { f32x4 acc = {0.f, 0.f, 0.f, 0.f};
#pragma unroll
              for (int ks = 0; ks < 2; ++ks) { const bf16x8 bf = *(const LAS bf16x8*)(VT + (tv * 16 + r) * 72 + ks * 32 + kq * 8); acc = __builtin_amdgcn_mfma_f32_16x16x32_bf16(af[ks], bf, acc, 0, 0, 0); }
              v2u w; w.x = pk2(acc[0], acc[1]); w.y = pk2(acc[2], acc[3]);
              *(v2u*)(UT + (size_t)unit * 16384 + (tv * 16 + r) * 128 + wv * 16 + 4 * kq) = w; } }
        __syncthreads();
        { const int tm = wv & 3, tvg = wv >> 2;
          bf16x8 pf[2];
#pragma unroll
          for (int ks = 0; ks < 2; ++ks) pf[ks] = *(const LAS bf16x8*)(PS + (tm * 16 + r) * 72 + ks * 32 + kq * 8);
#pragma unroll
          for (int j = 0; j < 4; ++j) { const int tv = tvg * 4 + j; f32x4 acc = {0.f, 0.f, 0.f, 0.f};
#pragma unroll
              for (int ks = 0; ks < 2; ++ks) { const bf16x8 vf = *(const LAS bf16x8*)(VT + (tv * 16 + r) * 72 + ks * 32 + kq * 8); acc = __builtin_amdgcn_mfma_f32_16x16x32_bf16(vf, pf[ks], acc, 0, 0, 0); }
              v2u ow; ow.x = pk2(acc[0], acc[1]); ow.y = pk2(acc[2], acc[3]); *(v2u*)(OI + (size_t)(t0 + tm * 16 + r) * HGW + h * HGD + tv * 16 + 4 * kq) = ow; } }
        __syncthreads();
    }
#undef HL_LOAD
}
__device__ __forceinline__ void hgrn_scan(const Frame& F, const unsigned char* r2, v2u* __restrict__ SB64) {
    const v2u* __restrict__ UT64 = (const v2u*)(r2 + R2_UT); const f32x4* __restrict__ DEC4 = (const f32x4*)(r2 + R2_DEC);
    for (int it = blockIdx.x * 512 + F.tid; it < NB * HGH * 128 * 32; it += F.G * 512) {
        const int bh = it >> 12, v = (it >> 5) & 127, k4 = it & 31;
        f32x4 s = {0.f, 0.f, 0.f, 0.f};
#pragma unroll 8
        for (int c = 0; c < 64; ++c) { const size_t unit = (size_t)bh * 64 + c; const size_t idx = unit * 4096 + v * 32 + k4;
            const v2u w = UT64[idx]; const f32x4 d = DEC4[unit * 32 + k4];
            v2u o; o.x = pk2(s[0], s[1]); o.y = pk2(s[2], s[3]); SB64[idx] = o;
            s[0] = d[0] * s[0] + pg8::bf_lo(w.x); s[1] = d[1] * s[1] + pg8::bf_hi(w.x); s[2] = d[2] * s[2] + pg8::bf_lo(w.y); s[3] = d[3] * s[3] + pg8::bf_hi(w.y); }
    }
}
struct HoutOps { bf16x8 af[4]; bf16x8 bfr[4][4]; };
__device__ __forceinline__ void hout_load(HoutOps& O, int unit, const bf16* proj, const bf16* OI, const bf16* QP, const bf16* SB, int r, int kq, int tm, int tvg) {
    const int b = unit / (HGH * 64), h = (unit / 64) % HGH, c = unit % 64, t0 = b * SEQ + c * 64;
#pragma unroll
    for (int ks = 0; ks < 4; ++ks) O.af[ks] = *(const bf16x8*)(QP + (size_t)(t0 + tm * 16 + r) * HGW + h * HGD + ks * 32 + kq * 8);
#pragma unroll
    for (int j = 0; j < 4; ++j)
#pragma unroll
        for (int ks = 0; ks < 4; ++ks) O.bfr[j][ks] = *(const bf16x8*)(SB + (size_t)unit * 16384 + ((tvg * 4 + j) * 16 + r) * 128 + ks * 32 + kq * 8);
}
__device__ __forceinline__ void hout_compute(const HoutOps& O, int unit, const bf16* proj, const bf16* OI, LAS float* SSQ, const float* gain, bf16* YB, int lane, int r, int kq, int tm, int tvg) {
    const int b = unit / (HGH * 64), h = (unit / 64) % HGH, c = unit % 64, t0 = b * SEQ + c * 64;
    const size_t t = (size_t)(t0 + tm * 16 + r);
    f32x4 oi[4]; v2u gtw[4];
#pragma unroll
    for (int j = 0; j < 4; ++j) { const int ch = h * HGD + (tvg * 4 + j) * 16 + 4 * kq; { const v2u ow = *(const v2u*)(OI + t * HGW + ch); oi[j] = (f32x4){pg8::bf_lo(ow.x), pg8::bf_hi(ow.x), pg8::bf_lo(ow.y), pg8::bf_hi(ow.y)}; } gtw[j] = *(const v2u*)(proj + t * INC + C_G + ch); }
    f32x4 acc[4]; float q = 0.f;
#pragma unroll
    for (int j = 0; j < 4; ++j) { acc[j] = (f32x4){0.f, 0.f, 0.f, 0.f};
#pragma unroll
        for (int ks = 0; ks < 4; ++ks) acc[j] = __builtin_amdgcn_mfma_f32_16x16x32_bf16(O.bfr[j][ks], O.af[ks], acc[j], 0, 0, 0); }
#pragma unroll
    for (int j = 0; j < 4; ++j) { acc[j] += oi[j]; q += (acc[j][0] * acc[j][0] + acc[j][1] * acc[j][1]) + (acc[j][2] * acc[j][2] + acc[j][3] * acc[j][3]); }
    q += shx(q, 16, lane); q += shx(q, 32, lane);
    if (kq == 0) SSQ[tvg * 64 + tm * 16 + r] = q;
    __syncthreads();
    const float rs = rsqrtf((SSQ[tm * 16 + r] + SSQ[64 + tm * 16 + r]) * (1.f / 128.f) + RMS_EPS);
#pragma unroll
    for (int j = 0; j < 4; ++j) { const int ch = h * HGD + (tvg * 4 + j) * 16 + 4 * kq; const f32x4 gn = *(const f32x4*)(gain + ch);
        const float g0 = pg8::bf_lo(gtw[j].x), g1 = pg8::bf_hi(gtw[j].x), g2 = pg8::bf_lo(gtw[j].y), g3 = pg8::bf_hi(gtw[j].y);
        v2u w; w.x = pk2(acc[j][0] * rs * gn[0] * g0 * pg8::sigmoidf_(g0), acc[j][1] * rs * gn[1] * g1 * pg8::sigmoidf_(g1));
        w.y = pk2(acc[j][2] * rs * gn[2] * g2 * pg8::sigmoidf_(g2), acc[j][3] * rs * gn[3] * g3 * pg8::sigmoidf_(g3));
        *(v2u*)(YB + t * HGW + ch) = w; }
    __syncthreads();
}
__device__ __forceinline__ void hgrn_out(const Frame& F, const bf16* proj, const unsigned char* r2, const bf16* SB, const float* gain, bf16* YB) {
    LAS float* SSQ = (LAS float*)F.lds;
    const bf16* OI = (const bf16*)(r2 + R2_OI); const bf16* QP = (const bf16*)(r2 + R2_QP);
    const int lane = F.lane, wv = F.wave, r = lane & 15, kq = lane >> 4, tm = wv & 3, tvg = wv >> 2;
    HoutOps A, B;
    int unit = blockIdx.x;
    if (unit < NHU) hout_load(A, unit, proj, OI, QP, SB, r, kq, tm, tvg);
    for (; unit < NHU; unit += 2 * F.G) {
        const int u2 = unit + F.G, u3 = unit + 2 * F.G;
        if (u2 < NHU) hout_load(B, u2, proj, OI, QP, SB, r, kq, tm, tvg);
        hout_compute(A, unit, proj, OI, SSQ, gain, YB, lane, r, kq, tm, tvg);
        if (u2 < NHU) { if (u3 < NHU) hout_load(A, u3, proj, OI, QP, SB, r, kq, tm, tvg);
            hout_compute(B, u2, proj, OI, SSQ, gain, YB, lane, r, kq, tm, tvg); }
    }
}
__device__ __forceinline__ void memattn(const Frame& F, const bf16* proj, const bf16* KV, int layer, bf16* YX) {
    lbf16* Ks = (lbf16*)F.lds;
    lbf16* VTs = Ks + 256 * 136;
    const int lane = F.lane, wv = F.wave, r = lane & 15, kq = lane >> 4;
    for (int unit = blockIdx.x; unit < NB * XAH * (SEQ / 256); unit += F.G) {
        const int b = unit >> 6, hd = (unit >> 4) & 3, qt = unit & 15;
#pragma unroll
        for (int i = 0; i < 8; ++i) { const int p = F.tid + 512 * i, key = p >> 4, dc = (p & 15) * 8;
            const bf16* src = KV + (size_t)(b * NMEM + key) * 2048 + layer * 1024 + hd * XAD + dc;
            *(LAS v4u*)(Ks + key * 136 + dc) = *(const v4u*)src;
            const v4u w = *(const v4u*)(src + 512);
            const int k5 = key & 31, pos = (key & ~31) + 8 * ((k5 >> 2) & 3) + 4 * ((k5 >> 4) & 1) + (k5 & 3);
            lbf16* d = VTs + dc * 264 + pos;
            d[0] = (bf16)(w.x & 0xffffu); d[264] = (bf16)(w.x >> 16); d[2 * 264] = (bf16)(w.y & 0xffffu); d[3 * 264] = (bf16)(w.y >> 16);
            d[4 * 264] = (bf16)(w.z & 0xffffu); d[5 * 264] = (bf16)(w.z >> 16); d[6 * 264] = (bf16)(w.w & 0xffffu); d[7 * 264] = (bf16)(w.w >> 16); }
        __syncthreads();
#pragma unroll 1
        for (int g = 0; g < 2; ++g) {
            const int t = b * SEQ + qt * 256 + wv * 32 + g * 16 + r;
            bf16x8 qf[4];
#pragma unroll
            for (int ks = 0; ks < 4; ++ks) qf[ks] = *(const bf16x8*)(proj + (size_t)t * INC + C_QX + hd * XAD + ks * 32 + kq * 8);
            f32x4 s[16];
#pragma unroll
            for (int kt = 0; kt < 16; ++kt) { s[kt] = (f32x4){0.f, 0.f, 0.f, 0.f};
#pragma unroll
                for (int ks = 0; ks < 4; ++ks) { const bf16x8 a = *(const LAS bf16x8*)(Ks + (kt * 16 + r) * 136 + ks * 32 + kq * 8); s[kt] = __builtin_amdgcn_mfma_f32_16x16x32_bf16(a, qf[ks], s[kt], 0, 0, 0); }
                if (kt & 1) __builtin_amdgcn_sched_barrier(0); }
            float m = -1e30f;
#pragma unroll
            for (int kt = 0; kt < 16; ++kt) m = fmaxf(m, fmaxf(fmaxf(s[kt][0], s[kt][1]), fmaxf(s[kt][2], s[kt][3])));
            m = fmaxf(m, shx(m, 16, lane)); m = fmaxf(m, shx(m, 32, lane));
            const float cs = 0.08838834764831845f * 1.4426950408889634f; float l = 0.f;
#pragma unroll
            for (int kt = 0; kt < 16; ++kt)
#pragma unroll
                for (int e = 0; e < 4; ++e) { const float p = __builtin_amdgcn_exp2f((s[kt][e] - m) * cs); s[kt][e] = p; l += p; }
            l += shx(l, 16, lane); l += shx(l, 32, lane);
            f32x4 o[8];
#pragma unroll
            for (int dt = 0; dt < 8; ++dt) o[dt] = (f32x4){0.f, 0.f, 0.f, 0.f};
#pragma unroll
            for (int j = 0; j < 8; ++j) {
                v4u pw; pw.x = pk2(s[2 * j][0], s[2 * j][1]); pw.y = pk2(s[2 * j][2], s[2 * j][3]); pw.z = pk2(s[2 * j + 1][0], s[2 * j + 1][1]); pw.w = pk2(s[2 * j + 1][2], s[2 * j + 1][3]);
                const bf16x8 pf = __builtin_bit_cast(bf16x8, pw);
#pragma unroll
                for (int dt = 0; dt < 8; ++dt) { const bf16x8 a = *(const LAS bf16x8*)(VTs + (dt * 16 + r) * 264 + j * 32 + kq * 8); o[dt] = __builtin_amdgcn_mfma_f32_16x16x32_bf16(a, pf, o[dt], 0, 0, 0); }
                __builtin_amdgcn_sched_barrier(0); }
            const float inv = 1.f / l;
#pragma unroll
            for (int dt = 0; dt < 8; ++dt) { v2u w; w.x = pk2(o[dt][0] * inv, o[dt][1] * inv); w.y = pk2(o[dt][2] * inv, o[dt][3] * inv);
                *(v2u*)(YX + (size_t)t * YXW + hd * XAD + dt * 16 + 4 * kq) = w; }
        }
        __syncthreads();
    }
}
struct Args { const float* in[24]; float* out; unsigned char* ws; int ph_lo, ph_hi, mask, pad; };
typedef const __attribute__((address_space(4))) Args* KArgs;
__device__ __forceinline__ KArgs kargs() { KArgs p = (KArgs)__builtin_amdgcn_kernarg_segment_ptr(); asm volatile("" : "+s"(p)); return p; }
#define WSP(T, off) ((T*)(ws + (off)))
__global__ void __launch_bounds__(NWAVES * 64, 2) mk_fwd(Args args) {
    extern __shared__ __attribute__((aligned(16))) unsigned char lds_raw[];
    Frame F0; F0.lds = (LAS unsigned char*)lds_raw; F0.tid = threadIdx.x; F0.lane = F0.tid & 63; F0.wave = __builtin_amdgcn_readfirstlane(F0.tid >> 6);
    F0.G = gridDim.x; F0.gw = blockIdx.x * NWAVES + F0.wave; F0.NGW = F0.G * NWAVES;
    volatile LAS unsigned* MISC = (volatile LAS unsigned*)(F0.lds + MISC_OFF);
    for (int u = F0.tid; u < (LDS_BYTES - MISC_OFF) / 4; u += NWAVES * 64) ((LAS unsigned*)(F0.lds + MISC_OFF))[u] = 0u;
    __syncthreads();
    const int lo = args.ph_lo, hi = args.ph_hi;
    const bool multi = (hi - lo) > 1;
    XcdBarrier bar; bar.bar = (unsigned*)(args.ws + WS_CTL) + CW_BAR; bar.x = 0; bar.st = nullptr;
    if (multi) bar = xcd_barrier_post((unsigned*)(args.ws + WS_CTL) + CW_BAR, MISC + 8);
#define IN(k) (lo <= (k) && (k) < hi)
#define SEAM(k) do { if (IN((k) + 1)) xcd_barrier(bar); } while (0)
#define PH_BEGIN KArgs ka = kargs(); unsigned char* ws = ka->ws; (void)ws; Frame F = F0; F.lane = pg8::lane_id_opaque(); F.tid = F0.wave * 64 + F.lane
    if (IN(PH_CVT)) {
        { PH_BEGIN;
        unsigned gb = 0;
        for (int l = 0; l < 2; ++l) {
            xpose_matrix(F, ka->in[2] + (size_t)l * D * INC, D, INC, (bf16*)(ws + WS_WIN_T + l * WIN_T_L), D, 0, gb);
            xpose_matrix(F, ka->in[4] + (size_t)l * CW * D, CW, D, (bf16*)(ws + WS_WBR_T + l * WBR_T_L), CW, 0, gb);
            xpose_matrix(F, ka->in[7] + (size_t)l * HGW * D, HGW, D, (bf16*)(ws + WS_WBR_T + l * WBR_T_L + 3 * MiB), HGW, 0, gb);
            xpose_matrix(F, ka->in[10] + (size_t)l * XAW * D, XAW, D, (bf16*)(ws + WS_WBR_T + l * WBR_T_L + 6 * MiB), YXW, 0, gb);
            for (int i = blockIdx.x * 512 + F.tid; i < D * 32; i += F.G * 512) *(v4u*)((bf16*)(ws + WS_WBR_T + l * WBR_T_L + 6 * MiB) + (size_t)(i >> 5) * YXW + XAW + (i & 31) * 8) = (v4u){0u, 0u, 0u, 0u};
            xpose_matrix(F, ka->in[11] + (size_t)l * D * D, D, D, (bf16*)(ws + WS_WO_T + l * WO_T_L), D, 0, gb);
            xpose_matrix(F, ka->in[8] + (size_t)l * D * XAW, D, XAW, (bf16*)(ws + WS_WKV_T) + (size_t)(l * 1024) * D, D, 0, gb);
            xpose_matrix(F, ka->in[9] + (size_t)l * D * XAW, D, XAW, (bf16*)(ws + WS_WKV_T) + (size_t)(l * 1024 + 512) * D, D, 0, gb);
        }
        cvt_router(F, ka->in[14], ws);
        cvt_rows(F, ka->in[0], WSP(bf16, WS_XBF), (size_t)NTOK * D / 8);
        cvt_rows(F, ka->in[1], WSP(bf16, WS_MEMBF), (size_t)NB * NMEM * D / 8);
        }
        SEAM(PH_CVT);
    }
    for (int l = 0; l < 2; ++l) {
        const int pb = PH_L0 + l * PH_PER_LAYER;
        if (IN(pb + P_INPROJ)) {
            { PH_BEGIN;
            const bool split = F.G == 256;
            const int oa = (int)blockIdx.x >> 3, ox = (int)blockIdx.x & 7; const bool conv = split && (oa & 3) == 3;
            const int hrank = 8 * (oa >> 2) + ox, grank = 8 * (oa - ((oa + 1) >> 2)) + ox;
            static_assert((256 - NCV) * GM_UNITS + NCV * CV_UNITS == (NTOK / 256) * (INC / 256), "in-projection unit shares");
            if (conv) { Frame Fc = F; Fc.gw = hrank * NWAVES + F.wave; Fc.NGW = NCV * NWAVES; unsigned gb = 0;
                cvt_experts(Fc, ka->in[16] + (size_t)l * NE * D * EH, ka->in[17] + (size_t)l * NE * D * EH, ka->in[18] + (size_t)l * NE * EH * D, ka->in[19] + (size_t)l * D * EH, ka->in[20] + (size_t)l * D * EH, ka->in[21] + (size_t)l * EH * D, ws, gb);
                __syncthreads(); }
            if (!split) { unsigned gb = 0; cvt_experts(F, ka->in[16] + (size_t)l * NE * D * EH, ka->in[17] + (size_t)l * NE * D * EH, ka->in[18] + (size_t)l * NE * EH * D, ka->in[19] + (size_t)l * D * EH, ka->in[20] + (size_t)l * D * EH, ka->in[21] + (size_t)l * EH * D, ws, gb); __syncthreads(); }
            DenseSched S; S.init(ws + WS_XBF, ws + WS_WIN_T + l * WIN_T_L, NTOK, INC, D, split ? (conv ? NCV : 256 - NCV) : F.G, split ? (conv ? hrank : grank) : (int)blockIdx.x);
            if (split) { S.L0 = conv ? (256 - NCV) * GM_UNITS : 0; S.cnt = conv ? CV_UNITS : GM_UNITS; }
            EpiProj E{WSP(bf16, WS_R1), WSP(unsigned char, WS_GATE8)};
            pg8::gemm_phase<EpiProj, DenseSched, true>(F.lds + RING_OFF, F.wave, D, S, E);
            if (l == 0) {
                DenseSched S2; S2.init(ws + WS_MEMBF, ws + WS_WKV_T, NB * NMEM, 2048, D, split ? 32 : F.G, split ? ((conv && hrank < 32) ? hrank : -1) : (int)blockIdx.x);
                EpiBf16Plain E2{WSP(bf16, WS_KV), 2048};
                pg8::gemm_phase<EpiBf16Plain, DenseSched, true>(F.lds + RING_OFF, F.wave, D, S2, E2);
            }
            }
            SEAM(pb + P_INPROJ);
        }
        if (IN(pb + P_MIX)) {
            { PH_BEGIN;
            memattn(F, WSP(bf16, WS_R1), WSP(bf16, WS_KV), l, WSP(bf16, WS_YX));
            hgrn_local(F, WSP(bf16, WS_R1), ka->in[5], l, ws + WS_R2);
            conv_part(F, WSP(bf16, WS_R1), ka->in[3] + (size_t)l * 3 * CW, WSP(bf16, WS_YA), WSP(bf16, WS_YX));
            }
            SEAM(pb + P_MIX);
        }
        if (IN(pb + P_SCAN)) {
            { PH_BEGIN;
            hgrn_scan(F, ws + WS_R2, WSP(v2u, WS_ZF));
            }
            SEAM(pb + P_SCAN);
        }
        if (IN(pb + P_HOUT)) {
            { PH_BEGIN;
            hgrn_out(F, WSP(bf16, WS_R1), ws + WS_R2, WSP(bf16, WS_ZF), ka->in[6] + (size_t)l * HGW, WSP(bf16, WS_YB));
            }
            SEAM(pb + P_HOUT);
        }
        if (IN(pb + P_BRANCH)) {
            { PH_BEGIN;
            static_assert(WS_YX - WS_YB == WS_YB - WS_YA, "branch inputs equally spaced");
            BranchSched S; S.init(ws + WS_YA, ws + WS_WBR_T + l * WBR_T_L, F.G, (int)blockIdx.x); EpiGateRT E{WSP(unsigned char, WS_GATE8), WSP(bf16, WS_MERGED)};
            pg8::gemm_phase<EpiGateRT, BranchSched, true>(F.lds + RING_OFF, F.wave, CW, S, E);
            }
            SEAM(pb + P_BRANCH);
        }
        if (IN(pb + P_WO)) {
            { PH_BEGIN;
            DenseSched S; S.init(ws + WS_MERGED, ws + WS_WO_T + l * WO_T_L, NTOK, D, D, F.G, (int)blockIdx.x);
            if (l == 0) { EpiResid<false> E{(const void*)ka->in[0], WSP(bf16, WS_ZF)}; pg8::gemm_phase<EpiResid<false>, DenseSched, true>(F.lds + RING_OFF, F.wave, D, S, E); }
            else { EpiResid<true> E{(const void*)WSP(bf16, WS_XBF), WSP(bf16, WS_ZF)}; pg8::gemm_phase<EpiResid<true>, DenseSched, true>(F.lds + RING_OFF, F.wave, D, S, E); }
            }
            SEAM(pb + P_WO);
        }
        if (IN(pb + P_ROUTE)) {
            { PH_BEGIN;
            route_phase(F, WSP(bf16, WS_ZF), ka->in[12] + (size_t)l * D, ka->in[13] + (size_t)l * D, WSP(bf16, WS_RW + l * RW_L), ka->in[15] + (size_t)l * NE, WSP(bf16, WS_X1F), WSP(bf16, WS_X1BF),
                        WSP(unsigned, WS_CTL) + CW_CNT + l * 64, WSP(int, WS_LIST), WSP(int, WS_TOKSLOT), WSP(float, WS_TOKW));
            }
            SEAM(pb + P_ROUTE);
        }
        if (IN(pb + P_GU)) {
            { PH_BEGIN;
            moe_plan(F, WSP(unsigned, WS_CTL) + CW_CNT + l * 64);
            MoeSched<true> S; S.init(F, ws + WS_X1BF, ws + WS_WGU, WSP(int, WS_LIST)); EpiSwiGLU E{WSP(bf16, WS_R2)};
            pg8::gemm_phase<EpiSwiGLU, MoeSched<true>, true>(F.lds + RING_OFF, F.wave, D, S, E);
            }
            SEAM(pb + P_GU);
        }
        if (IN(pb + P_DOWN)) {
            { PH_BEGIN;
            moe_plan(F, WSP(unsigned, WS_CTL) + CW_CNT + l * 64);
            MoeSched<false> S; S.init(F, ws + WS_R2, ws + WS_WDN, nullptr); EpiY8 E{WSP(unsigned char, WS_R1), WSP(bf16, WS_R1 + R1_YS)};
            pg8::gemm_phase<EpiY8, MoeSched<false>, true>(F.lds + RING_OFF, F.wave, EH, S, E);
            }
            SEAM(pb + P_DOWN);
        }
        if (IN(pb + P_COMB)) {
            { PH_BEGIN;
            moe_plan(F, WSP(unsigned, WS_CTL) + CW_CNT + l * 64);
            combine_phase(F, WSP(bf16, WS_X1BF), WSP(unsigned char, WS_R1), WSP(bf16, WS_R1 + R1_YS), WSP(int, WS_TOKSLOT), WSP(float, WS_TOKW), ka->in[22] + (size_t)l * D, ka->in[23] + (size_t)l * D, ka->out, WSP(bf16, WS_XBF), l == 1);
            }
            SEAM(pb + P_COMB);
        }
    }
#undef IN
#undef SEAM
}
static void launch_mk(Args a, int lo, int hi, int grid, hipStream_t stream) {
    a.ph_lo = lo; a.ph_hi = hi;
    hipLaunchKernelGGL(mk_fwd, dim3(grid), dim3(NWAVES * 64), LDS_BYTES, stream, a);
}
extern "C" void kernel_launch(void* const* d_in, const int* in_sizes, int n_in, void* d_out, int out_size, void* d_ws, size_t ws_size, hipStream_t stream) {
    static int grid = 0;
    if (grid == 0) {
        if (n_in != 24 || out_size != NTOK * D || ws_size < WS_END) { fprintf(stderr, "kernel_launch: unexpected sizes n_in %d out %d ws %zu\n", n_in, out_size, ws_size); grid = -1; return; }
        int dev = 0, cus = 0;
        if (hipGetDevice(&dev) != hipSuccess || hipDeviceGetAttribute(&cus, hipDeviceAttributeMultiprocessorCount, dev) != hipSuccess) { grid = -1; return; }
        if (hipFuncSetAttribute((const void*)mk_fwd, hipFuncAttributeMaxDynamicSharedMemorySize, LDS_BYTES) != hipSuccess) { fprintf(stderr, "kernel_launch: hipFuncSetAttribute failed\n"); grid = -1; return; }
        int per_cu = 0; (void)hipOccupancyMaxActiveBlocksPerMultiprocessor(&per_cu, (const void*)mk_fwd, NWAVES * 64, LDS_BYTES); (void)hipGetLastError();
        if (per_cu < 1) fprintf(stderr, "kernel_launch: occupancy query says %d\n", per_cu);
        grid = cus;
    }
    if (grid < 0) return;
    const float* x = (const float*)d_in[0];
    const float* conv_w = (const float*)d_in[3]; const float* lbl = (const float*)d_in[5];
    const float* hg_g = (const float*)d_in[6];
    const float* ln1_g = (const float*)d_in[12]; const float* ln1_b = (const float*)d_in[13]; const float* router_w = (const float*)d_in[14];
    const float* router_b = (const float*)d_in[15]; const float* exp_wg = (const float*)d_in[16]; const float* exp_wu = (const float*)d_in[17];
    const float* exp_wd = (const float*)d_in[18]; const float* sh_wg = (const float*)d_in[19]; const float* sh_wu = (const float*)d_in[20];
    const float* sh_wd = (const float*)d_in[21]; const float* ln2_g = (const float*)d_in[22]; const float* ln2_b = (const float*)d_in[23];
    unsigned char* ws = (unsigned char*)d_ws; float* out = (float*)d_out;
    unsigned* ctl = (unsigned*)(ws + WS_CTL);
    bf16* KV = (bf16*)(ws + WS_KV); bf16* XBF = (bf16*)(ws + WS_XBF); float* X1F = (float*)(ws + WS_X1F);
    bf16* X1BF = (bf16*)(ws + WS_X1BF); float* ZF = (float*)(ws + WS_ZF);
    bf16* YA = (bf16*)(ws + WS_YA); bf16* YB = (bf16*)(ws + WS_YB); bf16* YX = (bf16*)(ws + WS_YX);
    bf16* H = (bf16*)(ws + WS_R2); float* OH = (float*)(ws + WS_R2); bf16* PROJ = (bf16*)(ws + WS_R1); bf16* Y = (bf16*)(ws + WS_R1);
    int* LIST = (int*)(ws + WS_LIST); int* TOKSLOT = (int*)(ws + WS_TOKSLOT); float* TOKW = (float*)(ws + WS_TOKW);
    Args a{};
    for (int i = 0; i < 24; ++i) a.in[i] = (const float*)d_in[i];
    a.out = out; a.ws = ws;

    (void)hipMemsetAsync(ws + WS_CTL, 0, CTL_BYTES, stream);
    a.mask = 7;
    launch_mk(a, 0, N_PHASES, grid, stream);
}
```

```cpp
#include <hip/hip_runtime.h>
#include <stdint.h>
#include <stdio.h>

typedef unsigned short bf16;
__device__ __forceinline__ float bf2f(bf16 v) { return __uint_as_float(((unsigned)v) << 16); }
__device__ __forceinline__ bf16 f2bf(float f) { unsigned u = __float_as_uint(f); return (bf16)((u + 0x7fffu + ((u >> 16) & 1u)) >> 16); }

constexpr int NB = 4, SEQ = 4096, NTOK = NB * SEQ, D = 2048, NMEM = 256;
constexpr int CW = 768, HGW = 768, HGH = 6, HGD = 128, XAW = 512, XAH = 4, XAD = 128;
constexpr int INC = 12032, YXW = 768, GW8 = 3 * 2048, PN_GATE = 23;
constexpr int C_U = 0, C_B = 768, C_C = 1536, C_Q = 2304, C_F = 3072, C_I = 3840, C_G = 4608, C_QX = 5376, C_GA = 5888, C_GB = 7936, C_GX = 9984;
constexpr int NE = 64, TOPK = 8, EH = 512;
constexpr float ALPHA = 1.41421356237f, LN_EPS = 1e-5f, RMS_EPS = 1e-6f, RSCALE = 2.5f;
constexpr int LISTCAP = 16384;

constexpr size_t MiB = 1u << 20;
constexpr size_t WS_CTL = 0, CTL_BYTES = 1 * MiB;
constexpr size_t WS_RW = 1 * MiB, RW_L = 512 * 1024;
constexpr size_t WS_WIN_T = 2 * MiB, WIN_T_L = 47 * MiB;
constexpr size_t WS_WBR_T = 1932 * MiB, WBR_T_L = 9 * MiB;
constexpr size_t WS_WO_T = 112 * MiB, WO_T_L = 8 * MiB;
constexpr size_t WS_WKV_T = 128 * MiB;
constexpr size_t WS_MEMBF = 136 * MiB, WS_KV = 140 * MiB;
constexpr size_t WS_WGU = 144 * MiB, WGU_E = 4 * MiB;
constexpr size_t WS_WDN = 404 * MiB, WDN_E = 2 * MiB;
constexpr size_t WS_XBF = 534 * MiB, WS_X1F = 598 * MiB, WS_X1BF = 726 * MiB, WS_ZF = 790 * MiB, WS_MERGED = 918 * MiB;
constexpr size_t WS_YA = 1860 * MiB, WS_YB = 1884 * MiB, WS_YX = 1908 * MiB;
constexpr size_t WS_R2 = 1046 * MiB;
constexpr size_t WS_R1 = 1214 * MiB;
constexpr size_t R1_YS = 320 * MiB;
constexpr size_t WS_LIST = 1854 * MiB, WS_TOKSLOT = 1858 * MiB, WS_TOKW = 1859 * MiB, WS_GATE8 = 1950 * MiB, WS_END = 2046 * MiB;
constexpr int CW_CNT = 1024;
constexpr int CW_PLAN = 2048;
constexpr int CW_BAR = 4096;
#ifndef DBG_MASK
#define DBG_MASK 7
#endif
namespace pg8 {
#define PG8_LAS __attribute__((address_space(3)))
typedef unsigned short bf16_t;
typedef short bf16x8 __attribute__((ext_vector_type(8)));
typedef float f32x4 __attribute__((ext_vector_type(4)));
typedef unsigned u32x4 __attribute__((ext_vector_type(4)));
typedef unsigned u32x2 __attribute__((ext_vector_type(2)));
constexpr int PG8_NVO_OFF = 147456 + 1024;
constexpr int BM = 256, BK = 64, HALF = 128, HTB = HALF * BK * 2  , STAGE_BYTES = 8 * HTB, NXCD = 8, WGM = 8;

__host__ __device__ __forceinline__ int lds_byte(int r, int c) { const int st = (r >> 4) * 2 + (c >> 5), rr = r & 15, cc = c & 31, ob = rr * 64 + cc * 2; return st * 1024 + (ob ^ (((ob >> 9) & 1) << 5)); }
__host__ __device__ __forceinline__ void stage_rc(int b, int& R, int& C) { const int st = b / 1024, sb = b % 1024, swz = sb ^ (((sb >> 9) & 1) << 5); R = (st >> 1) * 16 + swz / 64; C = (st & 1) * 32 + (swz % 64) / 2; }
__host__ __device__ __forceinline__ int perm32(int rho) { const int n = rho >> 4, i = rho & 15; return 8 * (i >> 2) + 4 * n + (i & 3); }

struct Unit { const char* A; const char* B; int pm, pn; const int* list; int m0, cnt; };

typedef float f32x2_ __attribute__((ext_vector_type(2)));
typedef __bf16 bf16x2_ __attribute__((ext_vector_type(2)));
__device__ __forceinline__ unsigned cvt_pk_bf16(float lo, float hi) { const f32x2_ v = {lo, hi}; const bf16x2_ b = __builtin_convertvector(v, bf16x2_); return __builtin_bit_cast(unsigned, b); }
__device__ __forceinline__ int lane_id_opaque() { unsigned m = ~0u; asm volatile("" : "+s"(m)); return (int)__builtin_amdgcn_mbcnt_hi(m, __builtin_amdgcn_mbcnt_lo(m, 0u)); }
__device__ __forceinline__ float bf_lo(unsigned w) { return __uint_as_float(w << 16); }
__device__ __forceinline__ float bf_hi(unsigned w) { return __uint_as_float(w & 0xffff0000u); }
__device__ __forceinline__ float sigmoidf_(float x) { return __builtin_amdgcn_rcpf(1.f + __expf(-x)); }

typedef f32x4 Acc[2][2][4][2];

template <class Epi, class Sched, bool ALIGN_EPI>
__device__ __forceinline__ void gemm_phase(PG8_LAS unsigned char* lds, const int wave, const int K_in, const Sched& S, const Epi& E) {
    const int lane = lane_id_opaque(), wid = wave, tid = wid * 64 + lane, wr = wid >> 2, wc = wid & 3, fr = lane & 15, fq = lane >> 4;
    int K = K_in; asm volatile("" : "+s"(K));
    const int nt = K / BK;
    unsigned voffB[2];
#pragma unroll
    for (int i = 0; i < 2; ++i) { int R, C; stage_rc(tid * 16 + i * 8192, R, C); const int Rb = Epi::PERM ? ((R & ~31) + perm32(R & 31)) : R; voffB[i] = (unsigned)(Rb * K + C) * 2u; }
    const size_t kstep = (size_t)(BK * 2);
    const size_t hstep = (size_t)HALF * K * 2;
    const unsigned ldsw = (unsigned)wid * 1024u;
    const int aoff = lds_byte(wr * 64 + fr, fq * 8), boff = lds_byte(wc * 32 + fr, fq * 8);
#define PG8_SA(b, h) (((b) * 2 + (h)) * HTB)
#define PG8_SB(b, h) ((4 + (b) * 2 + (h)) * HTB)
#define PG8_STAGE2(bufoff, gbase, v0, v1) do { \
        __builtin_amdgcn_global_load_lds((const unsigned*)((const char*)(gbase) + (v0)), (PG8_LAS unsigned*)(lds + (bufoff) + ldsw), 16, 0, 0); \
        __builtin_amdgcn_global_load_lds((const unsigned*)((const char*)(gbase) + (v1)), (PG8_LAS unsigned*)(lds + (bufoff) + ldsw + 8192), 16, 0, 0); } while (0)
#define PG8_STAGEB(bufoff, gbase) PG8_STAGE2(bufoff, gbase, voffB[0], voffB[1])
#define PG8_LDA(dst, b, h) do { _Pragma("unroll") for (int m = 0; m < 4; ++m) _Pragma("unroll") for (int k = 0; k < 2; ++k) dst[m][k] = *(const PG8_LAS bf16x8*)(lds + PG8_SA(b, h) + aoff + m * 2048 + k * 1024); } while (0)
#define PG8_LDB(dst, b, h) do { _Pragma("unroll") for (int n = 0; n < 2; ++n) _Pragma("unroll") for (int k = 0; k < 2; ++k) dst[n][k] = *(const PG8_LAS bf16x8*)(lds + PG8_SB(b, h) + boff + n * 2048 + k * 1024); } while (0)
#define PG8_MMA(ai, bj, At, Bt) do { __builtin_amdgcn_s_setprio(1); _Pragma("unroll") for (int m = 0; m < 4; ++m) _Pragma("unroll") for (int n = 0; n < 2; ++n) _Pragma("unroll") for (int k = 0; k < 2; ++k) \
        acc[ai][bj][m][n] = __builtin_amdgcn_mfma_f32_16x16x32_bf16(Bt[n][k], At[m][k], acc[ai][bj][m][n], 0, 0, 0); __builtin_amdgcn_s_setprio(0); } while (0)
#define PG8_WAIT_V(n) asm volatile("s_waitcnt vmcnt(" #n ")" ::: "memory")
#define PG8_WAIT_L(n) asm volatile("s_waitcnt lgkmcnt(" #n ")" ::: "memory")
#define PG8_BAR __builtin_amdgcn_s_barrier()
#define PG8_SCHED __builtin_amdgcn_sched_barrier(0)
    Unit cur, nxt; int ui = 0;
    if (!S.next(0, cur)) return;
    Acc acc;
#pragma unroll
    for (int a = 0; a < 2; ++a)
#pragma unroll
        for (int b = 0; b < 2; ++b)
#pragma unroll
            for (int m = 0; m < 4; ++m)
#pragma unroll
                for (int n = 0; n < 2; ++n) acc[a][b][m][n] = (f32x4){0.f, 0.f, 0.f, 0.f};
    bf16x8 At[4][2], B0[2][2], B1[2][2];
    constexpr bool GA = Sched::GATHER;
    unsigned c00, c01, c10 = 0, c11 = 0;
    PG8_LAS unsigned* nvo = (PG8_LAS unsigned*)(lds + PG8_NVO_OFF) + tid * 4;
    { int R0, C0, R1, C1; stage_rc(tid * 16, R0, C0); stage_rc(tid * 16 + 8192, R1, C1);
      c00 = S.avoff(cur, 0, R0, C0, K); c01 = S.avoff(cur, 0, R1, C1, K); if constexpr (GA) { c10 = S.avoff(cur, 1, R0, C0, K); c11 = S.avoff(cur, 1, R1, C1, K); } }
    const size_t hA = GA ? (size_t)0 : hstep;
#define PG8_STAGEA0(bufoff, gbase) PG8_STAGE2(bufoff, gbase, c00, c01)
#define PG8_STAGEA1(bufoff, gbase) do { if constexpr (GA) PG8_STAGE2(bufoff, gbase, c10, c11); else PG8_STAGE2(bufoff, (gbase) + hA, c00, c01); } while (0)
    const char* cA = cur.A; const char* cB = cur.B;
    PG8_STAGEB(PG8_SB(0, 0), cB); PG8_STAGEB(PG8_SB(0, 1), cB + hstep); PG8_STAGEA0(PG8_SA(0, 0), cA); PG8_STAGEA1(PG8_SA(0, 1), cA);
    if (wr == 1) PG8_BAR;
    PG8_WAIT_V(2); PG8_BAR;
    PG8_STAGEB(PG8_SB(1, 0), cB + kstep); PG8_STAGEA0(PG8_SA(1, 0), cA + kstep); PG8_STAGEB(PG8_SB(1, 1), cB + hstep + kstep);
    PG8_WAIT_V(6); PG8_BAR;
    for (;;) {
        const bool has_next = S.next(ui + 1, nxt);
        const char* nA = has_next ? nxt.A : cA; const char* nB = has_next ? nxt.B : cB;
        if constexpr (GA) { if (has_next) {
            int R0, C0, R1, C1; stage_rc(tid * 16, R0, C0); stage_rc(tid * 16 + 8192, R1, C1);
            nvo[0] = S.avoff(nxt, 0, R0, C0, K); nvo[1] = S.avoff(nxt, 0, R1, C1, K); nvo[2] = S.avoff(nxt, 1, R0, C0, K); nvo[3] = S.avoff(nxt, 1, R1, C1, K); } }
        for (int t = 0; t < nt; t += 2) {
            const bool last = (t == nt - 2);
            const char* a1 = cA + (size_t)(t + 1) * kstep;
            const char* a2 = last ? nA : cA + (size_t)(t + 2) * kstep; const char* b2 = last ? nB : cB + (size_t)(t + 2) * kstep;
            const char* a3 = a2 + kstep; const char* b3 = b2 + kstep;
            const bool nx = GA && last && has_next;
#define PG8_STAGEA0N(bufoff, gbase) do { if (nx) { const unsigned q0 = nvo[0], q1 = nvo[1]; PG8_STAGE2(bufoff, gbase, q0, q1); } else PG8_STAGEA0(bufoff, gbase); } while (0)
#define PG8_STAGEA1N(bufoff, gbase) do { if (nx) { const unsigned q0 = nvo[2], q1 = nvo[3]; PG8_STAGE2(bufoff, gbase, q0, q1); } else PG8_STAGEA1(bufoff, gbase); } while (0)
            PG8_LDB(B0, 0, 0); PG8_LDB(B1, 0, 1); PG8_SCHED; PG8_LDA(At, 0, 0); PG8_STAGEA1(PG8_SA(1, 1), a1);
            PG8_WAIT_V(8); PG8_WAIT_L(0); PG8_BAR; PG8_MMA(0, 0, At, B0); PG8_MMA(0, 1, At, B1); PG8_BAR; PG8_SCHED;
            PG8_LDA(At, 0, 1); PG8_STAGEB(PG8_SB(0, 0), b2); PG8_STAGEB(PG8_SB(0, 1), b2 + hstep); PG8_STAGEA0N(PG8_SA(0, 0), a2);
            PG8_WAIT_V(8); PG8_WAIT_L(0); PG8_BAR; PG8_MMA(1, 0, At, B0); PG8_MMA(1, 1, At, B1); PG8_BAR; PG8_SCHED;
            PG8_LDB(B0, 1, 0); PG8_LDB(B1, 1, 1); PG8_SCHED; PG8_LDA(At, 1, 0); PG8_STAGEA1N(PG8_SA(0, 1), a2);
            PG8_WAIT_V(8); PG8_WAIT_L(0); PG8_BAR; PG8_MMA(0, 0, At, B0); PG8_MMA(0, 1, At, B1); PG8_BAR; PG8_SCHED;
            PG8_LDA(At, 1, 1); PG8_STAGEB(PG8_SB(1, 0), b3); PG8_STAGEB(PG8_SB(1, 1), b3 + hstep); PG8_STAGEA0N(PG8_SA(1, 0), a3);
            PG8_WAIT_V(8); PG8_WAIT_L(0); PG8_BAR; PG8_MMA(1, 0, At, B0); PG8_MMA(1, 1, At, B1); PG8_BAR; PG8_SCHED;
#undef PG8_STAGEA0N
#undef PG8_STAGEA1N
        }
        if constexpr (ALIGN_EPI) { if (wr == 0) PG8_BAR; }
        bool keep = false;
        if constexpr (Epi::INPLACE) keep = E.inplace(acc, cur, wr, wc, fr, fq); else E(acc, cur, wr, wc, fr, fq);
        if (!has_next) break;
        if (!keep)
#pragma unroll
        for (int a = 0; a < 2; ++a)
#pragma unroll
            for (int b = 0; b < 2; ++b)
#pragma unroll
                for (int m = 0; m < 4; ++m)
#pragma unroll
                    for (int n = 0; n < 2; ++n) acc[a][b][m][n] = (f32x4){0.f, 0.f, 0.f, 0.f};
        cur = nxt; cA = nA; cB = nB; ++ui; if constexpr (GA) { c00 = nvo[0]; c01 = nvo[1]; c10 = nvo[2]; c11 = nvo[3]; }
        if constexpr (ALIGN_EPI) { if (wr == 1) PG8_BAR; }
    }
    PG8_WAIT_V(0);
    if constexpr (!ALIGN_EPI) { if (wr == 0) PG8_BAR; }
    PG8_BAR;
#undef PG8_SA
#undef PG8_SB
#undef PG8_STAGE2
#undef PG8_STAGEB
#undef PG8_STAGEA0
#undef PG8_STAGEA1
#undef PG8_LDA
#undef PG8_LDB
#undef PG8_MMA
#undef PG8_WAIT_V
#undef PG8_WAIT_L
#undef PG8_BAR
#undef PG8_SCHED
}
}
#define GAS __attribute__((address_space(1)))
#define LAS __attribute__((address_space(3)))
typedef unsigned v4u __attribute__((ext_vector_type(4)));
typedef unsigned v2u __attribute__((ext_vector_type(2)));
typedef float f32x4 __attribute__((ext_vector_type(4)));
typedef short bf16x8 __attribute__((ext_vector_type(8)));
typedef GAS unsigned gu32;
#define RLX_AGENT __ATOMIC_RELAXED, __HIP_MEMORY_SCOPE_AGENT
#define LDS_WAIT() asm volatile("s_waitcnt lgkmcnt(0)" ::: "memory")
#define VM_WAIT() asm volatile("s_waitcnt vmcnt(0)" ::: "memory")
__device__ __forceinline__ int opaque_v(int x) { asm volatile("" : "+v"(x)); return x; }
__device__ __forceinline__ float shx(float v, int o, int lane) { return __int_as_float(__builtin_amdgcn_ds_bpermute((lane ^ o) << 2, __float_as_int(v))); }
__device__ __forceinline__ unsigned pk2(float lo, float hi) { return pg8::cvt_pk_bf16(lo, hi); }

#define XB_TMO      128
#define XB_XCNT(j)  (256  + 64 * (j))
#define XB_XSUB(j)  (1280 + 64 * (j))
#define XB_XGEN(j)  (2304 + 64 * (j))
#define XB_TOP      3328
#define XB_TOPGEN   3392
#define XCD_BAR_WORDS 3456
#define XB_SPIN_CAP (1u << 18)
__device__ __forceinline__ unsigned xb_ld(unsigned* p)              { return __hip_atomic_load(p, __ATOMIC_RELAXED, __HIP_MEMORY_SCOPE_AGENT); }
__device__ __forceinline__ unsigned xb_add(unsigned* p, unsigned v) { return __hip_atomic_fetch_add(p, v, __ATOMIC_RELAXED, __HIP_MEMORY_SCOPE_AGENT); }
__device__ __forceinline__ unsigned xb_xcc_id() { return (unsigned)__builtin_amdgcn_s_getreg((3 << 11) | 20) & 0xFu; }
#define XB_SPIN(cond, bar) do { unsigned _sp = 0; while (cond) { __builtin_amdgcn_s_sleep(1); \
    if ((++_sp & 255u) == 0u) { if (xb_ld(&(bar)[XB_TMO])) break; if (_sp > XB_SPIN_CAP) { atomicAdd(&(bar)[XB_TMO], 1u); break; } } } } while (0)
struct XcdBarrier { unsigned* bar; unsigned x; volatile LAS unsigned* st; };
__device__ __forceinline__ XcdBarrier xcd_barrier_post(unsigned* bar, volatile LAS unsigned* st) {
    XcdBarrier b; b.bar = bar; b.x = xb_xcc_id(); b.st = st;
    if (threadIdx.x == 0) (void)xb_add(&bar[XB_XCNT(b.x)], 1u);
    return b;
}
__device__ __forceinline__ void xcd_barrier_complete(unsigned* bar, unsigned x, unsigned& nloc, unsigned& nx) {
    const unsigned G = gridDim.x * gridDim.y * gridDim.z;
    unsigned sum, cnt, mine, sp = 0u;
    for (;;) {
        sum = 0u; cnt = 0u; mine = 0u;
#pragma unroll
        for (unsigned j = 0; j < 16; ++j) { const unsigned c = xb_ld(&bar[XB_XCNT(j)]); sum += c; cnt += (c > 0u) ? 1u : 0u; mine = (j == x) ? c : mine; }
        if (sum == G) break;
        __builtin_amdgcn_s_sleep(1);
        if ((++sp & 255u) == 0u) { if (xb_ld(&bar[XB_TMO])) break; if (sp > XB_SPIN_CAP) { atomicAdd(&bar[XB_TMO], 1u); break; } }
    }
    nloc = mine > 0u ? mine : 1u; nx = cnt > 0u ? cnt : 1u;
}
__device__ __forceinline__ void xcd_barrier(const XcdBarrier& b_in) {
    asm volatile("s_waitcnt vmcnt(0)" ::: "memory");
    __syncthreads();
    if (threadIdx.x == 0) {
        XcdBarrier b = b_in; asm volatile("" : "+s"(b.x));
        unsigned* bar = b.bar; asm volatile("" : "+s"(bar));
        __builtin_amdgcn_s_waitcnt(0);
        unsigned nloc = b.st[0], nx = b.st[1];
        if (nloc == 0u) { xcd_barrier_complete(bar, b.x, nloc, nx); b.st[0] = nloc; b.st[1] = nx; }
        const unsigned old = xb_add(&bar[XB_XSUB(b.x)], 1u);
        const unsigned gen = old / nloc;
        if (old + 1u == (gen + 1u) * nloc) {
            __builtin_amdgcn_fence(__ATOMIC_RELEASE, "agent");
            asm volatile("s_waitcnt vmcnt(0)" ::: "memory");
            const unsigned og = xb_add(&bar[XB_TOP], 1u);
            const unsigned tg = og / nx;
            if (og + 1u == (tg + 1u) * nx) xb_add(&bar[XB_TOPGEN], 1u);
            else XB_SPIN(xb_ld(&bar[XB_TOPGEN]) == tg, bar);
            __builtin_amdgcn_fence(__ATOMIC_ACQUIRE, "agent");
            xb_add(&bar[XB_XGEN(b.x)], 1u);
            asm volatile("s_waitcnt vmcnt(0)" ::: "memory");
        } else {
            XB_SPIN(xb_ld(&bar[XB_XGEN(b.x)]) == gen, bar);
            __builtin_amdgcn_fence(__ATOMIC_ACQUIRE, "agent");
            asm volatile("s_waitcnt vmcnt(0)" ::: "memory");
        }
    }
    __syncthreads();
}
using pg8::Unit; using pg8::Acc;
struct DenseSched { static constexpr bool GATHER = false;
    const char* A; const char* B; int nM, nN, nwg, G, c, K; int L0 = 0, cnt = 1 << 30;
    __device__ __forceinline__ void init(const void* A_, const void* B_, int M, int N, int K_, int G_, int c_) { A = (const char*)A_; B = (const char*)B_; nM = M / 256; nN = N / 256; nwg = nM * nN; G = G_; c = c_; K = K_; }
    __device__ __forceinline__ bool next(int i, Unit& u) const {
        const long L = (long)L0 + (long)i * G + c; if (c < 0 || i >= cnt || L >= nwg) return false;
        int wgid = (int)L; { const int q = nwg / 8, r = nwg % 8, xcd = wgid % 8, off = wgid / 8; wgid = (xcd < r ? xcd * (q + 1) : r * (q + 1) + (xcd - r) * q) + off; }
        const int nig = 8 * nN, gid = wgid / nig, fm = gid * 8, gsz = (nM - fm) < 8 ? (nM - fm) : 8;
        u.pm = fm + ((wgid % nig) % gsz); u.pn = (wgid % nig) / gsz;
        u.A = A + (size_t)u.pm * 256 * K * 2; u.B = B + (size_t)u.pn * 256 * K * 2; u.list = nullptr; u.m0 = 0; u.cnt = 0; return true;
    }
    __device__ __forceinline__ unsigned avoff(const Unit&, int h, int R, int C, int K_) const { return (unsigned)(((h * 128 + R) * K_ + C) * 2); }
};
struct EpiBf16Plain { static constexpr bool PERM = true, INPLACE = false; bf16* O; int ldc;
    __device__ __forceinline__ void operator()(const Acc& acc, const Unit& u, int wr, int wc, int fr, int fq) const {
        const int row0 = u.pm * 256 + wr * 64 + fr, col0 = u.pn * 256 + wc * 32 + 8 * fq;
#pragma unroll
        for (int ai = 0; ai < 2; ++ai)
#pragma unroll
            for (int m = 0; m < 4; ++m) { bf16* rowp = O + (size_t)(row0 + ai * 128 + m * 16) * ldc + col0;
#pragma unroll
                for (int bj = 0; bj < 2; ++bj) { const f32x4 v0 = acc[ai][bj][m][0], v1 = acc[ai][bj][m][1];
                    v4u w; w.x = pk2(v0[0], v0[1]); w.y = pk2(v0[2], v0[3]); w.z = pk2(v1[0], v1[1]); w.w = pk2(v1[2], v1[3]);
                    *(v4u*)(rowp + bj * 128) = w; } }
    }
};
struct EpiProj { static constexpr bool PERM = true, INPLACE = false; bf16* O; unsigned char* G8;
    __device__ __forceinline__ void operator()(const Acc& acc, const Unit& u, int wr, int wc, int fr, int fq) const {
        const int row0 = u.pm * 256 + wr * 64 + fr;
        if (u.pn < PN_GATE) { const int col0 = u.pn * 256 + wc * 32 + 8 * fq;
#pragma unroll
            for (int ai = 0; ai < 2; ++ai)
#pragma unroll
                for (int m = 0; m < 4; ++m) { bf16* rowp = O + (size_t)(row0 + ai * 128 + m * 16) * INC + col0;
#pragma unroll
                    for (int bj = 0; bj < 2; ++bj) { const f32x4 v0 = acc[ai][bj][m][0], v1 = acc[ai][bj][m][1];
                        v4u w; w.x = pk2(v0[0], v0[1]); w.y = pk2(v0[2], v0[3]); w.z = pk2(v1[0], v1[1]); w.w = pk2(v1[2], v1[3]);
                        *(v4u*)(rowp + bj * 128) = w; } }
        } else { const int pos0 = (u.pn - PN_GATE) * 256 + wc * 64 + fq * 16;
#pragma unroll
            for (int ai = 0; ai < 2; ++ai)
#pragma unroll
                for (int m = 0; m < 4; ++m) { unsigned char* rowp = G8 + (size_t)(row0 + ai * 128 + m * 16) * GW8 + pos0;
                    v4u w;
#pragma unroll
                    for (int bj = 0; bj < 2; ++bj) { const f32x4 v0 = acc[ai][bj][m][0], v1 = acc[ai][bj][m][1];
                        unsigned q[8];
#pragma unroll
                        for (int j = 0; j < 4; ++j) { q[j] = (unsigned)fmaxf(pg8::sigmoidf_(v0[j]) * 255.f + 0.5f, 1.f); q[4 + j] = (unsigned)fmaxf(pg8::sigmoidf_(v1[j]) * 255.f + 0.5f, 1.f); }
                        const unsigned lo = q[0] | (q[1] << 8) | (q[2] << 16) | (q[3] << 24), hi = q[4] | (q[5] << 8) | (q[6] << 16) | (q[7] << 24);
                        if (bj == 0) { w.x = lo; w.y = hi; } else { w.z = lo; w.w = hi; } }
                    *(v4u*)rowp = w; }
        }
    }
};
struct BranchSched { static constexpr bool GATHER = false;
    const char* A0; const char* B; int G, c;
    __device__ __forceinline__ void init(const void* ya, const void* w, int G_, int c_) { A0 = (const char*)ya; B = (const char*)w; G = G_; c = c_; }
    __device__ __forceinline__ bool next(int i, Unit& u) const {
        const int j = i / 3, seg = i - 3 * j; constexpr int nM = NTOK / 256, nN = D / 256, nwg = nM * nN;
        const int L = j * G + c; if (L >= nwg) return false;
        int wgid = L; { const int q = nwg / 8, xcd = wgid % 8, off = wgid / 8; wgid = xcd * q + off; }
        const int nig = 8 * nN; u.pm = (wgid / nig) * 8 + ((wgid % nig) % 8); u.pn = (wgid % nig) / 8;
        u.A = A0 + (size_t)seg * (WS_YB - WS_YA) + (size_t)u.pm * 256 * CW * 2; u.B = B + (size_t)seg * 3 * MiB + (size_t)u.pn * 256 * CW * 2; u.list = nullptr; u.m0 = seg; u.cnt = 0; return true; }
    __device__ __forceinline__ unsigned avoff(const Unit&, int h, int R, int C, int K_) const { return (unsigned)(((h * 128 + R) * K_ + C) * 2); }
};
struct EpiGateRT { static constexpr bool PERM = true, INPLACE = true; const unsigned char* g8; bf16* merged;
    __device__ __forceinline__ bool inplace(Acc& acc, const Unit& u, int wr, int wc, int fr, int fq) const {
        const int row0 = u.pm * 256 + wr * 64 + fr, col0 = u.pn * 256 + wc * 32 + 8 * fq, pos0 = u.pn * 256 + wc * 64 + fq * 16; const int seg = u.m0;
#pragma unroll
        for (int ai = 0; ai < 2; ++ai) {
            v4u ga[4], gb[4];
#pragma unroll
            for (int m = 0; m < 4; ++m) { const size_t row = (size_t)(row0 + ai * 128 + m * 16);
                ga[m] = *(const v4u*)(g8 + row * GW8 + seg * D + pos0); gb[m] = ga[m]; if (seg < 2) gb[m] = *(const v4u*)(g8 + row * GW8 + (seg + 1) * D + pos0); }
            asm volatile("" ::: "memory");
#pragma unroll
            for (int m = 0; m < 4; ++m) { const size_t row = (size_t)(row0 + ai * 128 + m * 16);
#pragma unroll
                for (int bj = 0; bj < 2; ++bj) { const unsigned ax = bj ? ga[m].z : ga[m].x, ay = bj ? ga[m].w : ga[m].y, bx = bj ? gb[m].z : gb[m].x, by = bj ? gb[m].w : gb[m].y;
                    f32x4 v0 = acc[ai][bj][m][0], v1 = acc[ai][bj][m][1];
                    if (seg < 2) {
                        v0[0] *= (float)(ax & 255u) * __builtin_amdgcn_rcpf((float)(bx & 255u)); v0[1] *= (float)((ax >> 8) & 255u) * __builtin_amdgcn_rcpf((float)((bx >> 8) & 255u));
                        v0[2] *= (float)((ax >> 16) & 255u) * __builtin_amdgcn_rcpf((float)((bx >> 16) & 255u)); v0[3] *= (float)(ax >> 24) * __builtin_amdgcn_rcpf((float)(bx >> 24));
                        v1[0] *= (float)(ay & 255u) * __builtin_amdgcn_rcpf((float)(by & 255u)); v1[1] *= (float)((ay >> 8) & 255u) * __builtin_amdgcn_rcpf((float)((by >> 8) & 255u));
                        v1[2] *= (float)((ay >> 16) & 255u) * __builtin_amdgcn_rcpf((float)((by >> 16) & 255u)); v1[3] *= (float)(ay >> 24) * __builtin_amdgcn_rcpf((float)(by >> 24));
                        acc[ai][bj][m][0] = v0; acc[ai][bj][m][1] = v1;
                    } else { constexpr float s8 = 1.f / 255.f;
                        v0[0] *= (float)(ax & 255u) * s8; v0[1] *= (float)((ax >> 8) & 255u) * s8; v0[2] *= (float)((ax >> 16) & 255u) * s8; v0[3] *= (float)(ax >> 24) * s8;
                        v1[0] *= (float)(ay & 255u) * s8; v1[1] *= (float)((ay >> 8) & 255u) * s8; v1[2] *= (float)((ay >> 16) & 255u) * s8; v1[3] *= (float)(ay >> 24) * s8;
                        v4u w; w.x = pk2(v0[0], v0[1]); w.y = pk2(v0[2], v0[3]); w.z = pk2(v1[0], v1[1]); w.w = pk2(v1[2], v1[3]); *(v4u*)(merged + row * D + col0 + bj * 128) = w; } } }
            asm volatile("" ::: "memory");
        }
        return seg < 2;
    }
};
template <bool RB16> struct EpiResid { static constexpr bool PERM = true, INPLACE = false; const void* xres; bf16* z;
    __device__ __forceinline__ void operator()(const Acc& acc, const Unit& u, int wr, int wc, int fr, int fq) const {
        const int row0 = u.pm * 256 + wr * 64 + fr, col0 = u.pn * 256 + wc * 32 + 8 * fq;
#pragma unroll
        for (int ai = 0; ai < 2; ++ai) {
            f32x4 xr[4][2][2];
#pragma unroll
            for (int m = 0; m < 4; ++m) { const size_t off = (size_t)(row0 + ai * 128 + m * 16) * D + col0;
#pragma unroll
                for (int bj = 0; bj < 2; ++bj) {
                    if constexpr (RB16) { const v4u w = *(const v4u*)((const bf16*)xres + off + bj * 128);
                        xr[m][bj][0] = (f32x4){pg8::bf_lo(w.x), pg8::bf_hi(w.x), pg8::bf_lo(w.y), pg8::bf_hi(w.y)}; xr[m][bj][1] = (f32x4){pg8::bf_lo(w.z), pg8::bf_hi(w.z), pg8::bf_lo(w.w), pg8::bf_hi(w.w)}; }
                    else {
#pragma unroll
                        for (int n = 0; n < 2; ++n) xr[m][bj][n] = *(const f32x4*)((const float*)xres + off + bj * 128 + n * 4); } } }
            asm volatile("" ::: "memory");
#pragma unroll
            for (int m = 0; m < 4; ++m) { const size_t off = (size_t)(row0 + ai * 128 + m * 16) * D + col0;
#pragma unroll
                for (int bj = 0; bj < 2; ++bj) { const f32x4 v0 = xr[m][bj][0] * ALPHA + acc[ai][bj][m][0], v1 = xr[m][bj][1] * ALPHA + acc[ai][bj][m][1];
                    v4u w; w.x = pk2(v0[0], v0[1]); w.y = pk2(v0[2], v0[3]); w.z = pk2(v1[0], v1[1]); w.w = pk2(v1[2], v1[3]); *(v4u*)(z + off + bj * 128) = w; } }
            asm volatile("" ::: "memory");
        }
    }
};

constexpr int NWAVES = 8;
constexpr int RING_OFF = 0, RING_BYTES = 131072;
constexpr int SCR_BYTES = 147456;
constexpr int MISC_OFF = SCR_BYTES;
constexpr int LDS_BYTES = 163840;
constexpr int PH_CVT = 0, PH_L0 = 1, PH_PER_LAYER = 10;
constexpr int P_INPROJ = 0, P_MIX = 1, P_SCAN = 2, P_HOUT = 3, P_BRANCH = 4, P_WO = 5, P_ROUTE = 6, P_GU = 7, P_DOWN = 8, P_COMB = 9;
constexpr int N_PHASES = PH_L0 + 2 * PH_PER_LAYER;

constexpr int NCV = 64;
#define CV_UNITS 5
#define GM_UNITS 14
struct Frame { LAS unsigned char* lds; int tid, lane, wave, G, gw, NGW; };

__device__ __forceinline__ void xpose_item(const float* W, int N, int k0, int n0, bf16* WTrow0, int ldk, LAS float* scr, int lane) {
    const int kk = lane >> 3, nn = (lane & 7) * 4;
    f32x4 v[8];
#pragma unroll
    for (int i = 0; i < 8; ++i) v[i] = *(const f32x4*)(W + (size_t)(k0 + kk + 8 * i) * N + n0 + nn);
#pragma unroll
    for (int i = 0; i < 8; ++i) { LAS float* s = scr + (kk + 8 * i) * 33 + nn; s[0] = v[i][0]; s[1] = v[i][1]; s[2] = v[i][2]; s[3] = v[i][3]; }
    LDS_WAIT(); asm volatile("" ::: "memory");
    const int c = lane & 7;
#pragma unroll
    for (int j = 0; j < 4; ++j) { const int n = (lane >> 3) + 8 * j; const LAS float* s = scr + (8 * c) * 33 + n;
        v4u o; o.x = pk2(s[0 * 33], s[1 * 33]); o.y = pk2(s[2 * 33], s[3 * 33]); o.z = pk2(s[4 * 33], s[5 * 33]); o.w = pk2(s[6 * 33], s[7 * 33]);
        *(v4u*)(WTrow0 + (size_t)n * ldk + 8 * c) = o; }
    LDS_WAIT(); asm volatile("" ::: "memory");
}
__device__ __forceinline__ void xpose_matrix(const Frame& F, const float* W, int K, int N, bf16* WT, int ldk, int mode, unsigned& gbase) {
    const int nblk = N / 32, nitems = (K / 64) * nblk;
    LAS float* scr = (LAS float*)(F.lds + RING_OFF + F.wave * 8704);
    int it = (int)(((unsigned)F.gw + (unsigned)F.NGW - gbase % (unsigned)F.NGW) % (unsigned)F.NGW);
    for (; it < nitems; it += F.NGW) {
        const int kb = it / nblk, nb = it % nblk, n0 = nb * 32, k0 = kb * 64;
        const int drow = mode == 0 ? n0 : ((n0 >> 7) * 256 + (n0 & 127) + (mode == 2 ? 128 : 0));
        xpose_item(W, N, k0, n0, WT + (size_t)drow * ldk + k0, ldk, scr, F.lane);
    }
    gbase += (unsigned)nitems;
}
__device__ __forceinline__ void cvt_rows(const Frame& F, const float* in, bf16* out, size_t n8) {
    for (size_t i = (size_t)blockIdx.x * 512 + F.tid; i < n8; i += (size_t)F.G * 512) {
        const f32x4 a = *(const f32x4*)(in + i * 8), b = *(const f32x4*)(in + i * 8 + 4);
        v4u w; w.x = pk2(a[0], a[1]); w.y = pk2(a[2], a[3]); w.z = pk2(b[0], b[1]); w.w = pk2(b[2], b[3]);
        *(v4u*)(out + i * 8) = w; }
}
__device__ __forceinline__ void cvt_router(const Frame& F, const float* rw, unsigned char* ws) {
    for (int i = blockIdx.x * 512 + F.tid; i < 2 * D * NE; i += F.G * 512) { const int l = i / (D * NE), k = (i / NE) % D, e = i % NE;
        const float w = rw[i]; const bf16 h = f2bf(w); const bf16 lo = f2bf(w - bf2f(h));
        bf16* dst = (bf16*)(ws + WS_RW + l * RW_L); dst[(size_t)e * D + k] = h; dst[(size_t)(NE + e) * D + k] = lo; }
}
struct XItem { const float* src; bf16* dst; int N, ldk; };
__device__ __forceinline__ void xp_decode(int I, const float* wg, const float* wu, const float* wd, const float* sg, const float* su, const float* sd, unsigned char* ws, XItem& x) {
    const int e = I / 1536, rem = I % 1536, m = rem >> 9, it = rem & 511;
    if (m < 2) { const float* W = m == 0 ? (e < NE ? wg + (size_t)e * D * EH : sg) : (e < NE ? wu + (size_t)e * D * EH : su);
        const int kb = it >> 4, nb = it & 15, n0 = nb * 32, k0 = kb * 64; const int drow = (n0 >> 7) * 256 + (n0 & 127) + (m == 1 ? 128 : 0);
        x.src = W + (size_t)k0 * EH + n0; x.N = EH; x.ldk = D; x.dst = (bf16*)(ws + WS_WGU + (size_t)e * WGU_E) + (size_t)drow * D + k0; }
    else { const float* W = e < NE ? wd + (size_t)e * EH * D : sd; const int kb = it >> 6, nb = it & 63, n0 = nb * 32, k0 = kb * 64;
        x.src = W + (size_t)k0 * D + n0; x.N = D; x.ldk = EH; x.dst = (bf16*)(ws + WS_WDN + (size_t)e * WDN_E) + (size_t)n0 * EH + k0; }
}
__device__ __forceinline__ void xp_load(const XItem& x, int lane, f32x4 (&v)[8]) {
    const int kk = lane >> 3, nn = (lane & 7) * 4;
#pragma unroll
    for (int i = 0; i < 8; ++i) v[i] = __builtin_nontemporal_load((const f32x4*)(x.src + (size_t)(kk + 8 * i) * x.N + nn));
}
__device__ __forceinline__ void xp_store(const XItem& x, const f32x4 (&v)[8], LAS float* scr, int lane) {
    const int kk = lane >> 3, nn = (lane & 7) * 4;
#pragma unroll
    for (int i = 0; i < 8; ++i) { LAS float* s = scr + (kk + 8 * i) * 33 + nn; s[0] = v[i][0]; s[1] = v[i][1]; s[2] = v[i][2]; s[3] = v[i][3]; }
    LDS_WAIT(); asm volatile("" ::: "memory");
    const int c = lane & 7;
#pragma unroll
    for (int j = 0; j < 4; ++j) { const int n = (lane >> 3) + 8 * j; const LAS float* s = scr + (8 * c) * 33 + n;
        v4u o; o.x = pk2(s[0 * 33], s[1 * 33]); o.y = pk2(s[2 * 33], s[3 * 33]); o.z = pk2(s[4 * 33], s[5 * 33]); o.w = pk2(s[6 * 33], s[7 * 33]);
        __builtin_nontemporal_store(o, (v4u*)(x.dst + (size_t)n * x.ldk + 8 * c)); }
    LDS_WAIT(); asm volatile("" ::: "memory");
}
__device__ __forceinline__ void cvt_experts(const Frame& F, const float* wg, const float* wu, const float* wd, const float* sg, const float* su, const float* sd, unsigned char* ws, unsigned& gbase) {
    (void)gbase;
    LAS float* scr = (LAS float*)(F.lds + RING_OFF + F.wave * 8704);
    const int total = (NE + 1) * 1536;
    XItem A, B; f32x4 va[8], vb[8];
    int I = F.gw;
    if (I < total) { xp_decode(I, wg, wu, wd, sg, su, sd, ws, A); xp_load(A, F.lane, va); }
    for (; I < total; I += 2 * F.NGW) {
        const int I2 = I + F.NGW, I3 = I + 2 * F.NGW;
        if (I2 < total) { xp_decode(I2, wg, wu, wd, sg, su, sd, ws, B); xp_load(B, F.lane, vb); }
        xp_store(A, va, scr, F.lane);
        if (I2 < total) { if (I3 < total) { xp_decode(I3, wg, wu, wd, sg, su, sd, ws, A); xp_load(A, F.lane, va); }
            xp_store(B, vb, scr, F.lane); }
    }
}
constexpr int NVO_OFF = MISC_OFF + 1024;  static_assert(NVO_OFF == pg8::PG8_NVO_OFF, "nvo");
constexpr int PLAN_OFF = NVO_OFF + 8192;
constexpr int PLAN_TB = PLAN_OFF, PLAN_CN = PLAN_OFF + 66 * 4, PLAN_TE = PLAN_OFF + 132 * 4;
constexpr int MAXTILES = 640;
#ifndef ROUTE_PROBE
#define ROUTE_PROBE 0
#endif
static_assert(PLAN_TE + MAXTILES * 4 <= LDS_BYTES, "LDS map");

__device__ __forceinline__ float wave_sum(float v, int lane) {
#pragma unroll
    for (int o = 1; o < 64; o <<= 1) v += shx(v, o, lane);
    return v;
}
__device__ __forceinline__ void moe_plan(const Frame& F, const unsigned* cnt) {
    LAS unsigned* tb = (LAS unsigned*)(F.lds + PLAN_TB); LAS unsigned* cn = (LAS unsigned*)(F.lds + PLAN_CN); LAS unsigned* te = (LAS unsigned*)(F.lds + PLAN_TE);
    __syncthreads();
    if (F.tid <= NE) { unsigned run = 0; for (int e = 0; e < F.tid; ++e) run += (__hip_atomic_load(cnt + e, RLX_AGENT) + 255u) >> 8;
        tb[F.tid] = run; cn[F.tid] = F.tid < NE ? __hip_atomic_load(cnt + F.tid, RLX_AGENT) : (unsigned)NTOK; if (F.tid == NE) tb[NE + 1] = run + NTOK / 256; }
    __syncthreads();
    for (int t = F.tid; t < MAXTILES; t += NWAVES * 64) { unsigned e = 0; for (int q = 1; q <= NE; ++q) if (tb[q] <= (unsigned)t) e = q; te[t] = e; }
    __syncthreads();
}
template <bool GU> struct MoeSched { static constexpr bool GATHER = GU;
    const LAS unsigned* tb; const LAS unsigned* cn; const LAS unsigned* te; int nunits, nN, G, c; const char* Abase; const char* Bbase; const int* list;
    __device__ __forceinline__ void init(const Frame& F, const void* A_, const void* B_, const int* list_) {
        tb = (const LAS unsigned*)(F.lds + PLAN_TB); cn = (const LAS unsigned*)(F.lds + PLAN_CN); te = (const LAS unsigned*)(F.lds + PLAN_TE);
        nN = GU ? 4 : 8; nunits = (int)tb[NE + 1] * nN; G = F.G; const int bx = blockIdx.x; c = (G % 8 == 0) ? (bx % 8) * (G / 8) + bx / 8 : bx;
        Abase = (const char*)A_; Bbase = (const char*)B_; list = list_; }
    __device__ __forceinline__ bool next(int i, Unit& u) const {
        constexpr int RUN = GU ? 2 : 4; const int hs = c + G * (i / RUN), per = nN / RUN;
        const int tile = hs / per, pn = (hs % per) * RUN + (i % RUN); if (tile * nN >= nunits) return false;
        const int e = (int)te[tile];
        u.pm = tile; u.pn = pn;
        if (GU) { u.A = Abase; u.B = Bbase + (size_t)e * WGU_E + (size_t)pn * 256 * D * 2; u.list = e < NE ? list + (size_t)e * LISTCAP : nullptr; u.m0 = (tile - (int)tb[e]) * 256; u.cnt = (int)cn[e]; }
        else { u.A = Abase + (size_t)tile * 256 * EH * 2; u.B = Bbase + (size_t)e * WDN_E + (size_t)pn * 256 * EH * 2; u.list = nullptr; u.m0 = 0; u.cnt = 0; }
        return true; }
    __device__ __forceinline__ unsigned avoff(const Unit& u, int h, int R, int C, int K_) const {
        if (GU) { const int pos = u.m0 + h * 128 + R; int row = 0; if (pos < u.cnt) row = u.list ? u.list[pos] : pos; return (unsigned)((row * K_ + C) * 2); }
        else return (unsigned)(((h * 128 + R) * K_ + C) * 2); }
};
struct EpiSwiGLU { static constexpr bool PERM = true, INPLACE = false; bf16* H;
    __device__ __forceinline__ void operator()(const Acc& acc, const Unit& u, int wr, int wc, int fr, int fq) const {
        const int row0 = u.pm * 256 + wr * 64 + fr, col0 = u.pn * 128 + wc * 32 + 8 * fq;
#pragma unroll
        for (int ai = 0; ai < 2; ++ai)
#pragma unroll
            for (int m = 0; m < 4; ++m) { bf16* rowp = H + (size_t)(row0 + ai * 128 + m * 16) * EH + col0;
                float hv[8];
#pragma unroll
                for (int n = 0; n < 2; ++n)
#pragma unroll
                    for (int j = 0; j < 4; ++j) { const float g = acc[ai][0][m][n][j], uu = acc[ai][1][m][n][j]; hv[n * 4 + j] = g * pg8::sigmoidf_(g) * uu; }
                v4u w; w.x = pk2(hv[0], hv[1]); w.y = pk2(hv[2], hv[3]); w.z = pk2(hv[4], hv[5]); w.w = pk2(hv[6], hv[7]);
                *(v4u*)rowp = w; }
    }
};

struct EpiY8 { static constexpr bool PERM = true, INPLACE = false; unsigned char* Y8; bf16* YS;
    __device__ __forceinline__ void operator()(const Acc& acc, const Unit& u, int wr, int wc, int fr, int fq) const {
        const int row0 = u.pm * 256 + wr * 64 + fr, pos0 = u.pn * 256 + wc * 64 + fq * 16;
#pragma unroll
        for (int ai = 0; ai < 2; ++ai)
#pragma unroll
            for (int m = 0; m < 4; ++m) { const size_t row = (size_t)(row0 + ai * 128 + m * 16);
                v4u w; unsigned sw = 0u;
#pragma unroll
                for (int bj = 0; bj < 2; ++bj) { const f32x4 v0 = acc[ai][bj][m][0], v1 = acc[ai][bj][m][1];
                    const float am = fmaxf(fmaxf(fmaxf(fabsf(v0[0]), fabsf(v0[1])), fmaxf(fabsf(v0[2]), fabsf(v0[3]))), fmaxf(fmaxf(fabsf(v1[0]), fabsf(v1[1])), fmaxf(fabsf(v1[2]), fabsf(v1[3]))));
                    const unsigned sb = f2bf(am * (1.f / 127.f)); const float sc = __uint_as_float(sb << 16); const float inv = sc > 0.f ? __builtin_amdgcn_rcpf(sc) : 0.f;
                    unsigned q[8];
#pragma unroll
                    for (int j = 0; j < 4; ++j) { q[j] = (unsigned)fminf(rintf(v0[j] * inv + 128.f), 255.f); q[4 + j] = (unsigned)fminf(rintf(v1[j] * inv + 128.f), 255.f); }
                    const unsigned lo = q[0] | (q[1] << 8) | (q[2] << 16) | (q[3] << 24), hi = q[4] | (q[5] << 8) | (q[6] << 16) | (q[7] << 24);
                    if (bj == 0) { w.x = lo; w.y = hi; sw = sb; } else { w.z = lo; w.w = hi; sw |= sb << 16; } }
                *(v4u*)(Y8 + row * D + pos0) = w; *(unsigned*)(YS + row * (D / 8) + (pos0 >> 3)) = sw; }
    }
};
__device__ __forceinline__ void route_phase(const Frame& F, const bf16* __restrict__ Z, const float* __restrict__ g, const float* __restrict__ bb, const bf16* __restrict__ rwh, const float* __restrict__ rb,
                                            bf16* __restrict__ X1L, bf16* __restrict__ X1BF, unsigned* cnt, int* list, int* tokslot, float* tokw, bool dispatch = true) {
    LAS float* part = (LAS float*)(F.lds + RING_OFF);
    LAS float* lg = part + 4 * 4096;
    LAS float* sl = lg + 64 * 65;
    LAS unsigned* cntL = (LAS unsigned*)(sl + 64 * 65);
    LAS unsigned* baseL = cntL + 64;
    LAS unsigned* ee = baseL + 64;
    LAS unsigned* pl = ee + 512;
    LAS float* ww = (LAS float*)(pl + 512);
    for (int grp = blockIdx.x; grp < NTOK / 64; grp += F.G) {
        const int t0 = grp * 64;
        if (F.tid < 64) cntL[F.tid] = 0u;
        for (int rp_ = 0; rp_ < (ROUTE_PROBE == 1 ? 2 : 1); ++rp_)
#pragma unroll 2
        for (int q = 0; q < 8; ++q) {
            const int t = t0 + F.wave * 8 + q;
            const v2u* zr = (const v2u*)(Z + (size_t)t * D) + F.lane;
            f32x4 v[8]; float s = 0.f;
#pragma unroll
            for (int j = 0; j < 8; ++j) { const v2u zw = zr[64 * j]; v[j] = (f32x4){pg8::bf_lo(zw.x), pg8::bf_hi(zw.x), pg8::bf_lo(zw.y), pg8::bf_hi(zw.y)}; s += (v[j][0] + v[j][1]) + (v[j][2] + v[j][3]); }
            const float mean = wave_sum(s, F.lane) * (1.f / D); float s2 = 0.f;
#pragma unroll
            for (int j = 0; j < 8; ++j) { v[j] = v[j] - mean; s2 += (v[j][0] * v[j][0] + v[j][1] * v[j][1]) + (v[j][2] * v[j][2] + v[j][3] * v[j][3]); }
            const float rstd = 1.f / sqrtf(wave_sum(s2, F.lane) * (1.f / D) + LN_EPS);
            v2u* xl = (v2u*)(X1L + (size_t)t * D) + F.lane; v2u* xb = (v2u*)(X1BF + (size_t)t * D) + F.lane;
#pragma unroll
            for (int j = 0; j < 8; ++j) { const f32x4 gg = ((const f32x4*)g)[F.lane + 64 * j], bv = ((const f32x4*)bb)[F.lane + 64 * j];
                const f32x4 y = v[j] * rstd * gg + bv; v2u w; w.x = pk2(y[0], y[1]); w.y = pk2(y[2], y[3]); xb[64 * j] = w;
                v2u lo; lo.x = pk2(y[0] - pg8::bf_lo(w.x), y[1] - pg8::bf_hi(w.x)); lo.y = pk2(y[2] - pg8::bf_lo(w.y), y[3] - pg8::bf_hi(w.y)); xl[64 * j] = lo; }
        }
        VM_WAIT(); __syncthreads();
        for (int rp_ = 0; rp_ < (ROUTE_PROBE == 2 ? 2 : 1); ++rp_)
        { const int r = F.lane & 15, kq = F.lane >> 4, kb = (F.wave & 3) * 512, th = F.wave >> 2;
          const bf16* xh = X1BF + (size_t)(t0 + th * 32 + r) * D + kb + 8 * kq;
          const bf16* xl = X1L + (size_t)(t0 + th * 32 + r) * D + kb + 8 * kq;
          const bf16* wh = rwh + (size_t)r * D + kb + 8 * kq;
          f32x4 acc[2][4];
#pragma unroll
          for (int tt = 0; tt < 2; ++tt)
#pragma unroll
              for (int nb = 0; nb < 4; ++nb) acc[tt][nb] = (f32x4){0.f, 0.f, 0.f, 0.f};
          bf16x8 xA[2][2], xB[2][2]; bf16x8 hA[4], lA[4], hB[4], lB[4];
#define RT_LOAD(X, H, L, ks) do { const int k_ = ((ks) < 16 ? (ks) : 15) * 32; _Pragma("unroll") for (int tt = 0; tt < 2; ++tt) { X[tt][0] = *(const bf16x8*)(xh + (size_t)tt * 16 * D + k_); X[tt][1] = *(const bf16x8*)(xl + (size_t)tt * 16 * D + k_); } \
              _Pragma("unroll") for (int nb = 0; nb < 4; ++nb) { H[nb] = *(const bf16x8*)(wh + (size_t)nb * 16 * D + k_); L[nb] = *(const bf16x8*)(wh + (size_t)(64 + nb * 16) * D + k_); } } while (0)
#define RT_MMA(X, H, L) do { \
              _Pragma("unroll") for (int tt = 0; tt < 2; ++tt) _Pragma("unroll") for (int nb = 0; nb < 4; ++nb) acc[tt][nb] = __builtin_amdgcn_mfma_f32_16x16x32_bf16(X[tt][1], H[nb], acc[tt][nb], 0, 0, 0); \
              _Pragma("unroll") for (int tt = 0; tt < 2; ++tt) _Pragma("unroll") for (int nb = 0; nb < 4; ++nb) acc[tt][nb] = __builtin_amdgcn_mfma_f32_16x16x32_bf16(X[tt][0], L[nb], acc[tt][nb], 0, 0, 0); \
              _Pragma("unroll") for (int tt = 0; tt < 2; ++tt) _Pragma("unroll") for (int nb = 0; nb < 4; ++nb) acc[tt][nb] = __builtin_amdgcn_mfma_f32_16x16x32_bf16(X[tt][0], H[nb], acc[tt][nb], 0, 0, 0); } while (0)
          RT_LOAD(xA, hA, lA, 0);
#pragma unroll 1
          for (int ks = 0; ks < 16; ks += 2) {
              RT_LOAD(xB, hB, lB, ks + 1); RT_MMA(xA, hA, lA);
              RT_LOAD(xA, hA, lA, ks + 2); RT_MMA(xB, hB, lB);
          }
#undef RT_LOAD
#undef RT_MMA
#pragma unroll
          for (int tt = 0; tt < 2; ++tt)
#pragma unroll
              for (int nb = 0; nb < 4; ++nb)
#pragma unroll
                  for (int reg = 0; reg < 4; ++reg) part[(F.wave & 3) * 4096 + (th * 32 + tt * 16 + 4 * kq + reg) * 64 + nb * 16 + r] = acc[tt][nb][reg];
        }
        __syncthreads();
        for (int i = F.tid; i < 64 * 64; i += NWAVES * 64) { const int tk = i >> 6, e = i & 63; const float lgt = (part[i] + part[4096 + i]) + (part[8192 + i] + part[12288 + i]);
            const float sc = 1.f / (1.f + __expf(-lgt)); lg[tk * 65 + e] = sc; sl[tk * 65 + e] = sc + rb[e]; }
        __syncthreads();
        for (int rp_ = 0; rp_ < (ROUTE_PROBE == 3 ? 2 : 1); ++rp_)
        { const bool lastrp = (rp_ == (ROUTE_PROBE == 3 ? 1 : 0));
          const int tk = F.wave * 8 + (F.lane >> 3), gq = F.lane & 7, lane = F.lane;
          float sv[8], cv[8];
#pragma unroll
          for (int j = 0; j < 8; ++j) { sv[j] = sl[tk * 65 + gq * 8 + j]; cv[j] = lg[tk * 65 + gq * 8 + j]; }
          float m1 = -INFINITY, m2 = -INFINITY;
#pragma unroll
          for (int j = 0; j < 8; ++j) { const float x = sv[j]; const bool g1 = x > m1; m2 = g1 ? m1 : fmaxf(m2, x); m1 = g1 ? x : m1; }
          const float gs = m1 + m2;
          int rank = 0;
#pragma unroll
          for (int o = 1; o < 8; ++o) { const float og = shx(gs, o, lane); const int oq = gq ^ o; rank += (og > gs || (og == gs && oq < gq)) ? 1 : 0; }
          const bool gsel = rank < 4;
          unsigned used = gsel ? 0u : 0xffu;
          float wsum = 0.f; float my_sc = 0.f; int my_e = 0;
#pragma unroll
          for (int i = 0; i < 8; ++i) {
              float bv = -INFINITY, bs = 0.f; int be = 64;
#pragma unroll
              for (int j = 0; j < 8; ++j) { const bool ok = !((used >> j) & 1u) && sv[j] > bv; bv = ok ? sv[j] : bv; bs = ok ? cv[j] : bs; be = ok ? gq * 8 + j : be; }
#pragma unroll
              for (int o = 1; o < 8; o <<= 1) { const float ov = shx(bv, o, lane), os = shx(bs, o, lane); const int oe = __float_as_int(shx(__int_as_float(be), o, lane));
                  const bool tk_o = ov > bv || (ov == bv && oe < be); bv = tk_o ? ov : bv; bs = tk_o ? os : bs; be = tk_o ? oe : be; }
              if ((be >> 3) == gq) used |= 1u << (be & 7);
              wsum += bs; if (gq == i) { my_sc = bs; my_e = be; }
          }
          const int slot = tk * 8 + gq;
          ee[slot] = (unsigned)my_e; ww[slot] = my_sc * (RSCALE / wsum);
          pl[slot] = __hip_atomic_fetch_add(cntL + my_e, (dispatch && lastrp) ? 1u : 0u, __ATOMIC_RELAXED, __HIP_MEMORY_SCOPE_WORKGROUP);
        }
        __syncthreads();
        if (F.tid < 64) { const unsigned n = cntL[F.tid]; baseL[F.tid] = n ? __hip_atomic_fetch_add(cnt + F.tid, n, RLX_AGENT) : 0u; }
        __syncthreads();
        if (dispatch) { const int tk = F.tid >> 3, i = F.tid & 7; const unsigned e = ee[F.tid]; const unsigned pos = baseL[e] + pl[F.tid]; const int t = t0 + tk;
          list[(size_t)e * LISTCAP + pos] = t; tokslot[t * 8 + i] = (int)(e * LISTCAP + pos); tokw[t * 8 + i] = ww[F.tid]; }
        __syncthreads();
    }
}
__device__ __forceinline__ void combine_phase(const Frame& F, const bf16* X1B, const unsigned char* Y8, const bf16* YS, const int* tokslot, const float* tokw, const float* g, const float* bb, float* OUT, bf16* XBF, bool last) {
    const LAS unsigned* tb = (const LAS unsigned*)(F.lds + PLAN_TB);
    LAS int* rw = (LAS int*)(F.lds + RING_OFF) + F.wave * 32;
#define CB_LOAD(W, S, ROW) do { const int r_ = __builtin_amdgcn_readfirstlane(ROW); const v2u* yr_ = (const v2u*)(Y8 + (size_t)r_ * D) + F.lane; const bf16* ys_ = YS + (size_t)r_ * (D / 8) + F.lane; \
        _Pragma("unroll") for (int j = 0; j < 4; ++j) { W[j] = yr_[64 * j]; S[j] = ys_[64 * j]; } } while (0)
#define CB_ACC(W, S, WT) do { const float wt_ = __int_as_float(__builtin_amdgcn_readfirstlane(WT)); _Pragma("unroll") for (int j = 0; j < 4; ++j) { const float sc = bf2f(S[j]) * wt_, c0 = -128.f * sc; const unsigned x = W[j].x, y = W[j].y; \
        v[j][0] += sc * (float)(x & 255u) + c0; v[j][1] += sc * (float)((x >> 8) & 255u) + c0; v[j][2] += sc * (float)((x >> 16) & 255u) + c0; v[j][3] += sc * (float)(x >> 24) + c0; \
        v[j][4] += sc * (float)(y & 255u) + c0; v[j][5] += sc * (float)((y >> 8) & 255u) + c0; v[j][6] += sc * (float)((y >> 16) & 255u) + c0; v[j][7] += sc * (float)(y >> 24) + c0; } } while (0)
    const int cl = (F.lane >> 5) * 256 + (F.lane & 1) * 128 + ((F.lane >> 3) & 3) * 32 + ((F.lane >> 1) & 3) * 8;
    for (int t = F.gw; t < NTOK; t += F.NGW) {
        if (F.lane < 8) { const int sl = tokslot[t * 8 + F.lane]; rw[F.lane] = (int)tb[sl / LISTCAP] * 256 + (sl % LISTCAP); rw[16 + F.lane] = __float_as_int(tokw[t * 8 + F.lane]); }
        if (F.lane == 8) { rw[8] = (int)tb[NE] * 256 + t; rw[24] = __float_as_int(1.f); }
        LDS_WAIT(); asm volatile("" ::: "memory");
        float v[4][8]; float s = 0.f;
        v2u wa[4], wb[4], wc[4]; bf16 sa[4], sb2[4], sc2[4];
        CB_LOAD(wa, sa, rw[0]); CB_LOAD(wb, sb2, rw[1]); CB_LOAD(wc, sc2, rw[2]);
#pragma unroll
        for (int j = 0; j < 4; ++j) { const v4u xw = *(const v4u*)(X1B + (size_t)t * D + 512 * j + cl);
            v[j][0] = pg8::bf_lo(xw.x) * ALPHA; v[j][1] = pg8::bf_hi(xw.x) * ALPHA; v[j][2] = pg8::bf_lo(xw.y) * ALPHA; v[j][3] = pg8::bf_hi(xw.y) * ALPHA;
            v[j][4] = pg8::bf_lo(xw.z) * ALPHA; v[j][5] = pg8::bf_hi(xw.z) * ALPHA; v[j][6] = pg8::bf_lo(xw.w) * ALPHA; v[j][7] = pg8::bf_hi(xw.w) * ALPHA; }
#pragma unroll 1
        for (int i = 0; i < 9; i += 3) {
            CB_ACC(wa, sa, rw[16 + i]); if (i < 6) CB_LOAD(wa, sa, rw[i + 3]);
            CB_ACC(wb, sb2, rw[17 + i]); if (i < 6) CB_LOAD(wb, sb2, rw[i + 4]);
            CB_ACC(wc, sc2, rw[18 + i]); if (i < 6) CB_LOAD(wc, sc2, rw[i + 5]);
        }
        asm volatile("" ::: "memory");
#pragma unroll
        for (int j = 0; j < 4; ++j)
#pragma unroll
            for (int e = 0; e < 8; ++e) s += v[j][e];
        const float mean = wave_sum(s, F.lane) * (1.f / D); float s2 = 0.f;
#pragma unroll
        for (int j = 0; j < 4; ++j)
#pragma unroll
            for (int e = 0; e < 8; ++e) { v[j][e] -= mean; s2 += v[j][e] * v[j][e]; }
        const float rstd = 1.f / sqrtf(wave_sum(s2, F.lane) * (1.f / D) + LN_EPS);
#pragma unroll
        for (int j = 0; j < 4; ++j) { const int c0 = cl + 512 * j; const f32x4 g0 = *(const f32x4*)(g + c0), g1 = *(const f32x4*)(g + c0 + 4), b0 = *(const f32x4*)(bb + c0), b1 = *(const f32x4*)(bb + c0 + 4);
            f32x4 y0, y1;
#pragma unroll
            for (int e = 0; e < 4; ++e) { y0[e] = v[j][e] * rstd * g0[e] + b0[e]; y1[e] = v[j][4 + e] * rstd * g1[e] + b1[e]; }
            if (last) { *(f32x4*)(OUT + (size_t)t * D + c0) = y0; *(f32x4*)(OUT + (size_t)t * D + c0 + 4) = y1; }
            else { v4u w; w.x = pk2(y0[0], y0[1]); w.y = pk2(y0[2], y0[3]); w.z = pk2(y1[0], y1[1]); w.w = pk2(y1[2], y1[3]); *(v4u*)(XBF + (size_t)t * D + c0) = w; } }
    }
#undef CB_LOAD
#undef CB_ACC
}
constexpr size_t R2_UT = 0, R2_OI = 48 * MiB, R2_QP = 96 * MiB, R2_DEC = 120 * MiB;
constexpr int NHU = NB * HGH * (SEQ / 64);
typedef __attribute__((address_space(3))) bf16 lbf16;
__device__ __forceinline__ void unpack8(const v4u w, float (&f)[8]) {
    f[0] = pg8::bf_lo(w.x); f[1] = pg8::bf_hi(w.x); f[2] = pg8::bf_lo(w.y); f[3] = pg8::bf_hi(w.y); f[4] = pg8::bf_lo(w.z); f[5] = pg8::bf_hi(w.z); f[6] = pg8::bf_lo(w.w); f[7] = pg8::bf_hi(w.w); }
__device__ __forceinline__ float exp_c(float x) { return __expf(fminf(x, 80.f)); }

__device__ __forceinline__ void conv_part(const Frame& F, const bf16* proj, const float* cw, bf16* YA, bf16* YX) {
    for (int i = blockIdx.x * 512 + F.tid; i < NTOK * 32; i += F.G * 512) *(v4u*)(YX + (size_t)(i >> 5) * YXW + XAW + (i & 31) * 8) = (v4u){0u, 0u, 0u, 0u};
    for (int i = blockIdx.x * 512 + F.tid; i < NTOK * (CW / 8); i += F.G * 512) {
        const int t = i / (CW / 8), c = (i % (CW / 8)) * 8, pos = t & (SEQ - 1);
        const bf16* r = proj + (size_t)t * INC;
        float u0[8], c0[8], b0[8], u1[8], c1[8], u2[8], c2[8], w0[8], w1[8], w2[8];
        unpack8(*(const v4u*)(r + C_U + c), u0); unpack8(*(const v4u*)(r + C_C + c), c0); unpack8(*(const v4u*)(r + C_B + c), b0);
        const v4u z4 = {0u, 0u, 0u, 0u};
        unpack8(pos >= 1 ? *(const v4u*)(r - INC + C_U + c) : z4, u1); unpack8(pos >= 1 ? *(const v4u*)(r - INC + C_C + c) : z4, c1);
        unpack8(pos >= 2 ? *(const v4u*)(r - 2 * INC + C_U + c) : z4, u2); unpack8(pos >= 2 ? *(const v4u*)(r - 2 * INC + C_C + c) : z4, c2);
#pragma unroll
        for (int j = 0; j < 8; ++j) { w0[j] = cw[c + j]; w1[j] = cw[CW + c + j]; w2[j] = cw[2 * CW + c + j]; }
        float o[8];
#pragma unroll
        for (int j = 0; j < 8; ++j) o[j] = b0[j] * (w2[j] * c0[j] * u0[j] + w1[j] * c1[j] * u1[j] + w0[j] * c2[j] * u2[j]);
        v4u w; w.x = pk2(o[0], o[1]); w.y = pk2(o[2], o[3]); w.z = pk2(o[4], o[5]); w.w = pk2(o[6], o[7]);
        *(v4u*)(YA + (size_t)t * CW + c) = w;
    }
}

__device__ __forceinline__ void hgrn_local(const Frame& F, const bf16* proj, const float* lbl, int layer, unsigned char* r2) {
    lbf16* QS = (lbf16*)(F.lds);
    lbf16* KS = QS + 64 * 136;
    lbf16* KPT = KS + 64 * 136;
    lbf16* VT = KPT + 128 * 72;
    lbf16* PS = VT + 128 * 72;
    LAS float* SEG = (LAS float*)(PS + 64 * 72);
    bf16* UT = (bf16*)(r2 + R2_UT); bf16* OI = (bf16*)(r2 + R2_OI); bf16* QP = (bf16*)(r2 + R2_QP); float* DEC = (float*)(r2 + R2_DEC);
    const int lane = F.lane, wv = F.wave, r = lane & 15, kq = lane >> 4;
    bf16 rf[16], rq[16], rv[16];
#define HL_LOAD(U) do { const int b_ = (U) / (HGH * 64), h_ = ((U) / 64) % HGH, c_ = (U) % 64; const bf16* p_ = proj + (size_t)(b_ * SEQ + c_ * 64 + (F.tid >> 7) * 16) * INC + h_ * HGD + (F.tid & 127); \
        _Pragma("unroll") for (int i = 0; i < 16; ++i) { rf[i] = p_[(size_t)i * INC + C_F]; rq[i] = p_[(size_t)i * INC + C_Q]; rv[i] = p_[(size_t)i * INC + C_I]; } } while (0)
    if ((int)blockIdx.x < NHU) HL_LOAD((int)blockIdx.x);
    for (int unit = blockIdx.x; unit < NHU; unit += F.G) {
        const int b = unit / (HGH * 64), h = (unit / 64) % HGH, c = unit % 64, t0 = b * SEQ + c * 64;
        { const int col = F.tid & 127, seg = F.tid >> 7, ch = h * HGD + col;
          float lb = 0.f; if (layer == 1) lb = 1.f / (1.f + __expf(lbl[ch] - lbl[HGW + ch]));
          float a[16], kk[16], qv[16], vv[16]; float run = 0.f;
#pragma unroll
          for (int i = 0; i < 16; ++i) {
              const float z = bf2f(rf[i]); const float ez = __expf(-z); const float sg = 1.f / (1.f + ez);
              const float f = lb + (1.f - lb) * sg; kk[i] = (1.f - lb) * ez * sg; run += fmaxf(__logf(f), -60.f); a[i] = run;
              qv[i] = bf2f(rq[i]); vv[i] = bf2f(rv[i]); }
          if (unit + F.G < NHU) HL_LOAD(unit + F.G);
          SEG[seg * 128 + col] = run;
          __syncthreads();
          const float s0 = SEG[col], s1 = SEG[128 + col], s2 = SEG[256 + col], s3 = SEG[384 + col];
          const float base = seg == 0 ? 0.f : (seg == 1 ? s0 : (seg == 2 ? s0 + s1 : s0 + s1 + s2)), bm = s0 + s1, bl = (s0 + s1) + (s2 + s3);
          float kp[16];
#pragma unroll
          for (int i = 0; i < 16; ++i) { const float bb = base + a[i]; const int t = seg * 16 + i;
              QS[t * 136 + col] = f2bf(qv[i] * exp_c(bb - bm)); KS[t * 136 + col] = f2bf(kk[i] * exp_c(bm - bb)); kp[i] = kk[i] * exp_c(bl - bb);
              QP[(size_t)(t0 + t) * HGW + ch] = f2bf(qv[i] * exp_c(bb)); }
          v4u w0, w1; w0.x = pk2(kp[0], kp[1]); w0.y = pk2(kp[2], kp[3]); w0.z = pk2(kp[4], kp[5]); w0.w = pk2(kp[6], kp[7]); w1.x = pk2(kp[8], kp[9]); w1.y = pk2(kp[10], kp[11]); w1.z = pk2(kp[12], kp[13]); w1.w = pk2(kp[14], kp[15]);
          *(LAS v4u*)(KPT + col * 72 + seg * 16) = w0; *(LAS v4u*)(KPT + col * 72 + seg * 16 + 8) = w1;
          w0.x = pk2(vv[0], vv[1]); w0.y = pk2(vv[2], vv[3]); w0.z = pk2(vv[4], vv[5]); w0.w = pk2(vv[6], vv[7]); w1.x = pk2(vv[8], vv[9]); w1.y = pk2(vv[10], vv[11]); w1.z = pk2(vv[12], vv[13]); w1.w = pk2(vv[14], vv[15]);
          *(LAS v4u*)(VT + col * 72 + seg * 16) = w0; *(LAS v4u*)(VT + col * 72 + seg * 16 + 8) = w1;
          if (seg == 0) DEC[(size_t)unit * 128 + col] = exp_c(bl);
        }
        __syncthreads();
        { const int tm = wv >> 1, tn0 = (wv & 1) * 2;
          bf16x8 af[4];
#pragma unroll
          for (int ks = 0; ks < 4; ++ks) af[ks] = *(const LAS bf16x8*)(QS + (tm * 16 + r) * 136 + ks * 32 + kq * 8);
#pragma unroll
          for (int jn = 0; jn < 2; ++jn) { const int tn = tn0 + jn; f32x4 acc = {0.f, 0.f, 0.f, 0.f};
              if (tn <= tm) {
#pragma unroll
                  for (int ks = 0; ks < 4; ++ks) { const bf16x8 bf = *(const LAS bf16x8*)(KS + (tn * 16 + r) * 136 + ks * 32 + kq * 8); acc = __builtin_amdgcn_mfma_f32_16x16x32_bf16(af[ks], bf, acc, 0, 0, 0); } }
#pragma unroll
              for (int g = 0; g < 4; ++g) { const int t = tm * 16 + 4 * kq + g, s = tn * 16 + r; PS[t * 72 + s] = f2bf(s <= t ? acc[g] : 0.f); } } }
        { bf16x8 af[2];
#pragma unroll
          for (int ks = 0; ks < 2; ++ks) af[ks] = *(const LAS bf16x8*)(KPT + (wv * 16 + r) * 72 + ks * 32 + kq * 8);
#pragma unroll
          for (int tv = 0; tv < 8; ++tv) { f32x4 acc = {0.f, 0.f, 0.f, 0.f};
#pragma unroll
              for (int ks = 0; ks < 2; ++ks) { const bf16x8 bf = *(const LAS bf16x8*)(VT + (tv * 16 + r) * 72 + ks * 32 + kq * 8); acc = __builtin_amdgcn_mfma_f32_16x16x32_bf16(af[ks], bf, acc, 0, 0, 0); }
              v2u w; w.x = pk2(acc[0], acc[1]); w.y = pk2(acc[2], acc[3]);
              *(v2u*)(UT + (size_t)unit * 16384 + (tv * 16 + r) * 128 + wv * 16 + 4 * kq) = w; } }
        __syncthreads();
        { const int tm = wv & 3, tvg = wv >> 2;
          bf16x8 pf[2];
#pragma unroll
          for (int ks = 0; ks < 2; ++ks) pf[ks] = *(const LAS bf16x8*)(PS + (tm * 16 + r) * 72 + ks * 32 + kq * 8);
#pragma unroll
          for (int j = 0; j < 4; ++j) { const int tv = tvg * 4 + j; f32x4 acc = {0.f, 0.f, 0.f, 0.f};
#pragma unroll
              for (int ks = 0; ks < 2; ++ks) { const bf16x8 vf = *(const LAS bf16x8*)(VT + (tv * 16 + r) * 72 + ks * 32 + kq * 8); acc = __builtin_amdgcn_mfma_f32_16x16x32_bf16(vf, pf[ks], acc, 0, 0, 0); }
              v2u ow; ow.x = pk2(acc[0], acc[1]); ow.y = pk2(acc[2], acc[3]); *(v2u*)(OI + (size_t)(t0 + tm * 16 + r) * HGW + h * HGD + tv * 16 + 4 * kq) = ow; } }
        __syncthreads();
    }
#undef HL_LOAD
}
__device__ __forceinline__ void hgrn_scan(const Frame& F, const unsigned char* r2, v2u* __restrict__ SB64) {
    const v2u* __restrict__ UT64 = (const v2u*)(r2 + R2_UT); const f32x4* __restrict__ DEC4 = (const f32x4*)(r2 + R2_DEC);
    for (int it = blockIdx.x * 512 + F.tid; it < NB * HGH * 128 * 32; it += F.G * 512) {
        const int bh = it >> 12, v = (it >> 5) & 127, k4 = it & 31;
        f32x4 s = {0.f, 0.f, 0.f, 0.f};
#pragma unroll 8
        for (int c = 0; c < 64; ++c) { const size_t unit = (size_t)bh * 64 + c; const size_t idx = unit * 4096 + v * 32 + k4;
            const v2u w = UT64[idx]; const f32x4 d = DEC4[unit * 32 + k4];
            v2u o; o.x = pk2(s[0], s[1]); o.y = pk2(s[2], s[3]); SB64[idx] = o;
            s[0] = d[0] * s[0] + pg8::bf_lo(w.x); s[1] = d[1] * s[1] + pg8::bf_hi(w.x); s[2] = d[2] * s[2] + pg8::bf_lo(w.y); s[3] = d[3] * s[3] + pg8::bf_hi(w.y); }
    }
}
struct HoutOps { bf16x8 af[4]; bf16x8 bfr[4][4]; };
__device__ __forceinline__ void hout_load(HoutOps& O, int unit, const bf16* proj, const bf16* OI, const bf16* QP, const bf16* SB, int r, int kq, int tm, int tvg) {
    const int b = unit / (HGH * 64), h = (unit / 64) % HGH, c = unit % 64, t0 = b * SEQ + c * 64;
#pragma unroll
    for (int ks = 0; ks < 4; ++ks) O.af[ks] = *(const bf16x8*)(QP + (size_t)(t0 + tm * 16 + r) * HGW + h * HGD + ks * 32 + kq * 8);
#pragma unroll
    for (int j = 0; j < 4; ++j)
#pragma unroll
        for (int ks = 0; ks < 4; ++ks) O.bfr[j][ks] = *(const bf16x8*)(SB + (size_t)unit * 16384 + ((tvg * 4 + j) * 16 + r) * 128 + ks * 32 + kq * 8);
}
__device__ __forceinline__ void hout_compute(const HoutOps& O, int unit, const bf16* proj, const bf16* OI, LAS float* SSQ, const float* gain, bf16* YB, int lane, int r, int kq, int tm, int tvg) {
    const int b = unit / (HGH * 64), h = (unit / 64) % HGH, c = unit % 64, t0 = b * SEQ + c * 64;
    const size_t t = (size_t)(t0 + tm * 16 + r);
    f32x4 oi[4]; v2u gtw[4];
#pragma unroll
    for (int j = 0; j < 4; ++j) { const int ch = h * HGD + (tvg * 4 + j) * 16 + 4 * kq; { const v2u ow = *(const v2u*)(OI + t * HGW + ch); oi[j] = (f32x4){pg8::bf_lo(ow.x), pg8::bf_hi(ow.x), pg8::bf_lo(ow.y), pg8::bf_hi(ow.y)}; } gtw[j] = *(const v2u*)(proj + t * INC + C_G + ch); }
    f32x4 acc[4]; float q = 0.f;
#pragma unroll
    for (int j = 0; j < 4; ++j) { acc[j] = (f32x4){0.f, 0.f, 0.f, 0.f};
#pragma unroll
        for (int ks = 0; ks < 4; ++ks) acc[j] = __builtin_amdgcn_mfma_f32_16x16x32_bf16(O.bfr[j][ks], O.af[ks], acc[j], 0, 0, 0); }
#pragma unroll
    for (int j = 0; j < 4; ++j) { acc[j] += oi[j]; q += (acc[j][0] * acc[j][0] + acc[j][1] * acc[j][1]) + (acc[j][2] * acc[j][2] + acc[j][3] * acc[j][3]); }
    q += shx(q, 16, lane); q += shx(q, 32, lane);
    if (kq == 0) SSQ[tvg * 64 + tm * 16 + r] = q;
    __syncthreads();
    const float rs = rsqrtf((SSQ[tm * 16 + r] + SSQ[64 + tm * 16 + r]) * (1.f / 128.f) + RMS_EPS);
#pragma unroll
    for (int j = 0; j < 4; ++j) { const int ch = h * HGD + (tvg * 4 + j) * 16 + 4 * kq; const f32x4 gn = *(const f32x4*)(gain + ch);
        const float g0 = pg8::bf_lo(gtw[j].x), g1 = pg8::bf_hi(gtw[j].x), g2 = pg8::bf_lo(gtw[j].y), g3 = pg8::bf_hi(gtw[j].y);
        v2u w; w.x = pk2(acc[j][0] * rs * gn[0] * g0 * pg8::sigmoidf_(g0), acc[j][1] * rs * gn[1] * g1 * pg8::sigmoidf_(g1));
        w.y = pk2(acc[j][2] * rs * gn[2] * g2 * pg8::sigmoidf_(g2), acc[j][3] * rs * gn[3] * g3 * pg8::sigmoidf_(g3));
        *(v2u*)(YB + t * HGW + ch) = w; }
    __syncthreads();
}
__device__ __forceinline__ void hgrn_out(const Frame& F, const bf16* proj, const unsigned char* r2, const bf16* SB, const float* gain, bf16* YB) {
    LAS float* SSQ = (LAS float*)F.lds;
    const bf16* OI = (const bf16*)(r2 + R2_OI); const bf16* QP = (const bf16*)(r2 + R2_QP);
    const int lane = F.lane, wv = F.wave, r = lane & 15, kq = lane >> 4, tm = wv & 3, tvg = wv >> 2;
    HoutOps A, B;
    int unit = blockIdx.x;
    if (unit < NHU) hout_load(A, unit, proj, OI, QP, SB, r, kq, tm, tvg);
    for (; unit < NHU; unit += 2 * F.G) {
        const int u2 = unit + F.G, u3 = unit + 2 * F.G;
        if (u2 < NHU) hout_load(B, u2, proj, OI, QP, SB, r, kq, tm, tvg);
        hout_compute(A, unit, proj, OI, SSQ, gain, YB, lane, r, kq, tm, tvg);
        if (u2 < NHU) { if (u3 < NHU) hout_load(A, u3, proj, OI, QP, SB, r, kq, tm, tvg);
            hout_compute(B, u2, proj, OI, SSQ, gain, YB, lane, r, kq, tm, tvg); }
    }
}
__device__ __forceinline__ void memattn(const Frame& F, const bf16* proj, const bf16* KV, int layer, bf16* YX) {
    lbf16* Ks = (lbf16*)F.lds;
    lbf16* VTs = Ks + 256 * 136;
    const int lane = F.lane, wv = F.wave, r = lane & 15, kq = lane >> 4;
    for (int unit = blockIdx.x; unit < NB * XAH * (SEQ / 256); unit += F.G) {
        const int b = unit >> 6, hd = (unit >> 4) & 3, qt = unit & 15;
#pragma unroll
        for (int i = 0; i < 8; ++i) { const int p = F.tid + 512 * i, key = p >> 4, dc = (p & 15) * 8;
            const bf16* src = KV + (size_t)(b * NMEM + key) * 2048 + layer * 1024 + hd * XAD + dc;
            *(LAS v4u*)(Ks + key * 136 + dc) = *(const v4u*)src;
            const v4u w = *(const v4u*)(src + 512);
            const int k5 = key & 31, pos = (key & ~31) + 8 * ((k5 >> 2) & 3) + 4 * ((k5 >> 4) & 1) + (k5 & 3);
            lbf16* d = VTs + dc * 264 + pos;
            d[0] = (bf16)(w.x & 0xffffu); d[264] = (bf16)(w.x >> 16); d[2 * 264] = (bf16)(w.y & 0xffffu); d[3 * 264] = (bf16)(w.y >> 16);
            d[4 * 264] = (bf16)(w.z & 0xffffu); d[5 * 264] = (bf16)(w.z >> 16); d[6 * 264] = (bf16)(w.w & 0xffffu); d[7 * 264] = (bf16)(w.w >> 16); }
        __syncthreads();
#pragma unroll 1
        for (int g = 0; g < 2; ++g) {
            const int t = b * SEQ + qt * 256 + wv * 32 + g * 16 + r;
            bf16x8 qf[4];
#pragma unroll
            for (int ks = 0; ks < 4; ++ks) qf[ks] = *(const bf16x8*)(proj + (size_t)t * INC + C_QX + hd * XAD + ks * 32 + kq * 8);
            f32x4 s[16];
#pragma unroll
            for (int kt = 0; kt < 16; ++kt) { s[kt] = (f32x4){0.f, 0.f, 0.f, 0.f};
#pragma unroll
                for (int ks = 0; ks < 4; ++ks) { const bf16x8 a = *(const LAS bf16x8*)(Ks + (kt * 16 + r) * 136 + ks * 32 + kq * 8); s[kt] = __builtin_amdgcn_mfma_f32_16x16x32_bf16(a, qf[ks], s[kt], 0, 0, 0); }
                if (kt & 1) __builtin_amdgcn_sched_barrier(0); }
            float m = -1e30f;
#pragma unroll
            for (int kt = 0; kt < 16; ++kt) m = fmaxf(m, fmaxf(fmaxf(s[kt][0], s[kt][1]), fmaxf(s[kt][2], s[kt][3])));
            m = fmaxf(m, shx(m, 16, lane)); m = fmaxf(m, shx(m, 32, lane));
            const float cs = 0.08838834764831845f * 1.4426950408889634f; float l = 0.f;
#pragma unroll
            for (int kt = 0; kt < 16; ++kt)
#pragma unroll
                for (int e = 0; e < 4; ++e) { const float p = __builtin_amdgcn_exp2f((s[kt][e] - m) * cs); s[kt][e] = p; l += p; }
            l += shx(l, 16, lane); l += shx(l, 32, lane);
            f32x4 o[8];
#pragma unroll
            for (int dt = 0; dt < 8; ++dt) o[dt] = (f32x4){0.f, 0.f, 0.f, 0.f};
#pragma unroll
            for (int j = 0; j < 8; ++j) {
                v4u pw; pw.x = pk2(s[2 * j][0], s[2 * j][1]); pw.y = pk2(s[2 * j][2], s[2 * j][3]); pw.z = pk2(s[2 * j + 1][0], s[2 * j + 1][1]); pw.w = pk2(s[2 * j + 1][2], s[2 * j + 1][3]);
                const bf16x8 pf = __builtin_bit_cast(bf16x8, pw);
#pragma unroll
                for (int dt = 0; dt < 8; ++dt) { const bf16x8 a = *(const LAS bf16x8*)(VTs + (dt * 16 + r) * 264 + j * 32 + kq * 8); o[dt] = __builtin_amdgcn_mfma_f32_16x16x32_bf16(a, pf, o[dt], 0, 0, 0); }
                __builtin_amdgcn_sched_barrier(0); }
            const float inv = 1.f / l;
#pragma unroll
            for (int dt = 0; dt < 8; ++dt) { v2u w; w.x = pk2(o[dt][0] * inv, o[dt][1] * inv); w.y = pk2(o[dt][2] * inv, o[dt][3] * inv);
                *(v2u*)(YX + (size_t)t * YXW + hd * XAD + dt * 16 + 4 * kq) = w; }
        }
        __syncthreads();
    }
}
struct Args { const float* in[24]; float* out; unsigned char* ws; int ph_lo, ph_hi, mask, pad; };
typedef const __attribute__((address_space(4))) Args* KArgs;
__device__ __forceinline__ KArgs kargs() { KArgs p = (KArgs)__builtin_amdgcn_kernarg_segment_ptr(); asm volatile("" : "+s"(p)); return p; }
#define WSP(T, off) ((T*)(ws + (off)))
__global__ void __launch_bounds__(NWAVES * 64, 2) mk_fwd(Args args) {
    extern __shared__ __attribute__((aligned(16))) unsigned char lds_raw[];
    Frame F0; F0.lds = (LAS unsigned char*)lds_raw; F0.tid = threadIdx.x; F0.lane = F0.tid & 63; F0.wave = __builtin_amdgcn_readfirstlane(F0.tid >> 6);
    F0.G = gridDim.x; F0.gw = blockIdx.x * NWAVES + F0.wave; F0.NGW = F0.G * NWAVES;
    volatile LAS unsigned* MISC = (volatile LAS unsigned*)(F0.lds + MISC_OFF);
    for (int u = F0.tid; u < (LDS_BYTES - MISC_OFF) / 4; u += NWAVES * 64) ((LAS unsigned*)(F0.lds + MISC_OFF))[u] = 0u;
    __syncthreads();
    const int lo = args.ph_lo, hi = args.ph_hi;
    const bool multi = (hi - lo) > 1;
    XcdBarrier bar; bar.bar = (unsigned*)(args.ws + WS_CTL) + CW_BAR; bar.x = 0; bar.st = nullptr;
    if (multi) bar = xcd_barrier_post((unsigned*)(args.ws + WS_CTL) + CW_BAR, MISC + 8);
#define IN(k) (lo <= (k) && (k) < hi)
#define SEAM(k) do { if (IN((k) + 1)) xcd_barrier(bar); } while (0)
#define PH_BEGIN KArgs ka = kargs(); unsigned char* ws = ka->ws; (void)ws; Frame F = F0; F.lane = pg8::lane_id_opaque(); F.tid = F0.wave * 64 + F.lane
    if (IN(PH_CVT)) {
        { PH_BEGIN;
        unsigned gb = 0;
        for (int l = 0; l < 2; ++l) {
            xpose_matrix(F, ka->in[2] + (size_t)l * D * INC, D, INC, (bf16*)(ws + WS_WIN_T + l * WIN_T_L), D, 0, gb);
            xpose_matrix(F, ka->in[4] + (size_t)l * CW * D, CW, D, (bf16*)(ws + WS_WBR_T + l * WBR_T_L), CW, 0, gb);
            xpose_matrix(F, ka->in[7] + (size_t)l * HGW * D, HGW, D, (bf16*)(ws + WS_WBR_T + l * WBR_T_L + 3 * MiB), HGW, 0, gb);
            xpose_matrix(F, ka->in[10] + (size_t)l * XAW * D, XAW, D, (bf16*)(ws + WS_WBR_T + l * WBR_T_L + 6 * MiB), YXW, 0, gb);
            for (int i = blockIdx.x * 512 + F.tid; i < D * 32; i += F.G * 512) *(v4u*)((bf16*)(ws + WS_WBR_T + l * WBR_T_L + 6 * MiB) + (size_t)(i >> 5) * YXW + XAW + (i & 31) * 8) = (v4u){0u, 0u, 0u, 0u};
            xpose_matrix(F, ka->in[11] + (size_t)l * D * D, D, D, (bf16*)(ws + WS_WO_T + l * WO_T_L), D, 0, gb);
            xpose_matrix(F, ka->in[8] + (size_t)l * D * XAW, D, XAW, (bf16*)(ws + WS_WKV_T) + (size_t)(l * 1024) * D, D, 0, gb);
            xpose_matrix(F, ka->in[9] + (size_t)l * D * XAW, D, XAW, (bf16*)(ws + WS_WKV_T) + (size_t)(l * 1024 + 512) * D, D, 0, gb);
        }
        cvt_router(F, ka->in[14], ws);
        cvt_rows(F, ka->in[0], WSP(bf16, WS_XBF), (size_t)NTOK * D / 8);
        cvt_rows(F, ka->in[1], WSP(bf16, WS_MEMBF), (size_t)NB * NMEM * D / 8);
        }
        SEAM(PH_CVT);
    }
    for (int l = 0; l < 2; ++l) {
        const int pb = PH_L0 + l * PH_PER_LAYER;
        if (IN(pb + P_INPROJ)) {
            { PH_BEGIN;
            const bool split = F.G == 256;
            const int oa = (int)blockIdx.x >> 3, ox = (int)blockIdx.x & 7; const bool conv = split && (oa & 3) == 3;
            const int hrank = 8 * (oa >> 2) + ox, grank = 8 * (oa - ((oa + 1) >> 2)) + ox;
            static_assert((256 - NCV) * GM_UNITS + NCV * CV_UNITS == (NTOK / 256) * (INC / 256), "in-projection unit shares");
            if (conv) { Frame Fc = F; Fc.gw = hrank * NWAVES + F.wave; Fc.NGW = NCV * NWAVES; unsigned gb = 0;
                cvt_experts(Fc, ka->in[16] + (size_t)l * NE * D * EH, ka->in[17] + (size_t)l * NE * D * EH, ka->in[18] + (size_t)l * NE * EH * D, ka->in[19] + (size_t)l * D * EH, ka->in[20] + (size_t)l * D * EH, ka->in[21] + (size_t)l * EH * D, ws, gb);
                __syncthreads(); }
            if (!split) { unsigned gb = 0; cvt_experts(F, ka->in[16] + (size_t)l * NE * D * EH, ka->in[17] + (size_t)l * NE * D * EH, ka->in[18] + (size_t)l * NE * EH * D, ka->in[19] + (size_t)l * D * EH, ka->in[20] + (size_t)l * D * EH, ka->in[21] + (size_t)l * EH * D, ws, gb); __syncthreads(); }
            DenseSched S; S.init(ws + WS_XBF, ws + WS_WIN_T + l * WIN_T_L, NTOK, INC, D, split ? (conv ? NCV : 256 - NCV) : F.G, split ? (conv ? hrank : grank) : (int)blockIdx.x);
            if (split) { S.L0 = conv ? (256 - NCV) * GM_UNITS : 0; S.cnt = conv ? CV_UNITS : GM_UNITS; }
            EpiProj E{WSP(bf16, WS_R1), WSP(unsigned char, WS_GATE8)};
            pg8::gemm_phase<EpiProj, DenseSched, true>(F.lds + RING_OFF, F.wave, D, S, E);
            if (l == 0) {
                DenseSched S2; S2.init(ws + WS_MEMBF, ws + WS_WKV_T, NB * NMEM, 2048, D, split ? 32 : F.G, split ? ((conv && hrank < 32) ? hrank : -1) : (int)blockIdx.x);
                EpiBf16Plain E2{WSP(bf16, WS_KV), 2048};
                pg8::gemm_phase<EpiBf16Plain, DenseSched, true>(F.lds + RING_OFF, F.wave, D, S2, E2);
            }
            }
            SEAM(pb + P_INPROJ);
        }
        if (IN(pb + P_MIX)) {
            { PH_BEGIN;
            memattn(F, WSP(bf16, WS_R1), WSP(bf16, WS_KV), l, WSP(bf16, WS_YX));
            hgrn_local(F, WSP(bf16, WS_R1), ka->in[5], l, ws + WS_R2);
            conv_part(F, WSP(bf16, WS_R1), ka->in[3] + (size_t)l * 3 * CW, WSP(bf16, WS_YA), WSP(bf16, WS_YX));
            }
            SEAM(pb + P_MIX);
        }
        if (IN(pb + P_SCAN)) {
            { PH_BEGIN;
            hgrn_scan(F, ws + WS_R2, WSP(v2u, WS_ZF));
            }
            SEAM(pb + P_SCAN);
        }
        if (IN(pb + P_HOUT)) {
            { PH_BEGIN;
            hgrn_out(F, WSP(bf16, WS_R1), ws + WS_R2, WSP(bf16, WS_ZF), ka->in[6] + (size_t)l * HGW, WSP(bf16, WS_YB));
            }
            SEAM(pb + P_HOUT);
        }
        if (IN(pb + P_BRANCH)) {
            { PH_BEGIN;
            static_assert(WS_YX - WS_YB == WS_YB - WS_YA, "branch inputs equally spaced");
            BranchSched S; S.init(ws + WS_YA, ws + WS_WBR_T + l * WBR_T_L, F.G, (int)blockIdx.x); EpiGateRT E{WSP(unsigned char, WS_GATE8), WSP(bf16, WS_MERGED)};
            pg8::gemm_phase<EpiGateRT, BranchSched, true>(F.lds + RING_OFF, F.wave, CW, S, E);
            }
            SEAM(pb + P_BRANCH);
        }
        if (IN(pb + P_WO)) {
            { PH_BEGIN;
            DenseSched S; S.init(ws + WS_MERGED, ws + WS_WO_T + l * WO_T_L, NTOK, D, D, F.G, (int)blockIdx.x);
            EpiResid<true> E{(const void*)WSP(bf16, WS_XBF), WSP(bf16, WS_ZF)}; pg8::gemm_phase<EpiResid<true>, DenseSched, true>(F.lds + RING_OFF, F.wave, D, S, E);
            }
            SEAM(pb + P_WO);
        }
        if (IN(pb + P_ROUTE)) {
            { PH_BEGIN;
            route_phase(F, WSP(bf16, WS_ZF), ka->in[12] + (size_t)l * D, ka->in[13] + (size_t)l * D, WSP(bf16, WS_RW + l * RW_L), ka->in[15] + (size_t)l * NE, WSP(bf16, WS_X1F), WSP(bf16, WS_X1BF),
                        WSP(unsigned, WS_CTL) + CW_CNT + l * 64, WSP(int, WS_LIST), WSP(int, WS_TOKSLOT), WSP(float, WS_TOKW));
            }
            SEAM(pb + P_ROUTE);
        }
        if (IN(pb + P_GU)) {
            { PH_BEGIN;
            moe_plan(F, WSP(unsigned, WS_CTL) + CW_CNT + l * 64);
            MoeSched<true> S; S.init(F, ws + WS_X1BF, ws + WS_WGU, WSP(int, WS_LIST)); EpiSwiGLU E{WSP(bf16, WS_R2)};
            pg8::gemm_phase<EpiSwiGLU, MoeSched<true>, true>(F.lds + RING_OFF, F.wave, D, S, E);
            }
            SEAM(pb + P_GU);
        }
        if (IN(pb + P_DOWN)) {
            { PH_BEGIN;
            moe_plan(F, WSP(unsigned, WS_CTL) + CW_CNT + l * 64);
            MoeSched<false> S; S.init(F, ws + WS_R2, ws + WS_WDN, nullptr); EpiY8 E{WSP(unsigned char, WS_R1), WSP(bf16, WS_R1 + R1_YS)};
            pg8::gemm_phase<EpiY8, MoeSched<false>, true>(F.lds + RING_OFF, F.wave, EH, S, E);
            }
            SEAM(pb + P_DOWN);
        }
        if (IN(pb + P_COMB)) {
            { PH_BEGIN;
            moe_plan(F, WSP(unsigned, WS_CTL) + CW_CNT + l * 64);
            combine_phase(F, WSP(bf16, WS_X1BF), WSP(unsigned char, WS_R1), WSP(bf16, WS_R1 + R1_YS), WSP(int, WS_TOKSLOT), WSP(float, WS_TOKW), ka->in[22] + (size_t)l * D, ka->in[23] + (size_t)l * D, ka->out, WSP(bf16, WS_XBF), l == 1);
            }
            SEAM(pb + P_COMB);
        }
    }
#undef IN
#undef SEAM
}
static void launch_mk(Args a, int lo, int hi, int grid, hipStream_t stream) {
    a.ph_lo = lo; a.ph_hi = hi;
    hipLaunchKernelGGL(mk_fwd, dim3(grid), dim3(NWAVES * 64), LDS_BYTES, stream, a);
}
extern "C" void kernel_launch(void* const* d_in, const int* in_sizes, int n_in, void* d_out, int out_size, void* d_ws, size_t ws_size, hipStream_t stream) {
    static int grid = 0;
    if (grid == 0) {
        if (n_in != 24 || out_size != NTOK * D || ws_size < WS_END) { fprintf(stderr, "kernel_launch: unexpected sizes n_in %d out %d ws %zu\n", n_in, out_size, ws_size); grid = -1; return; }
        int dev = 0, cus = 0;
        if (hipGetDevice(&dev) != hipSuccess || hipDeviceGetAttribute(&cus, hipDeviceAttributeMultiprocessorCount, dev) != hipSuccess) { grid = -1; return; }
        if (hipFuncSetAttribute((const void*)mk_fwd, hipFuncAttributeMaxDynamicSharedMemorySize, LDS_BYTES) != hipSuccess) { fprintf(stderr, "kernel_launch: hipFuncSetAttribute failed\n"); grid = -1; return; }
        int per_cu = 0; (void)hipOccupancyMaxActiveBlocksPerMultiprocessor(&per_cu, (const void*)mk_fwd, NWAVES * 64, LDS_BYTES); (void)hipGetLastError();
        if (per_cu < 1) fprintf(stderr, "kernel_launch: occupancy query says %d\n", per_cu);
        grid = cus;
    }
    if (grid < 0) return;
    const float* x = (const float*)d_in[0];
    const float* conv_w = (const float*)d_in[3]; const float* lbl = (const float*)d_in[5];
    const float* hg_g = (const float*)d_in[6];
    const float* ln1_g = (const float*)d_in[12]; const float* ln1_b = (const float*)d_in[13]; const float* router_w = (const float*)d_in[14];
    const float* router_b = (const float*)d_in[15]; const float* exp_wg = (const float*)d_in[16]; const float* exp_wu = (const float*)d_in[17];
    const float* exp_wd = (const float*)d_in[18]; const float* sh_wg = (const float*)d_in[19]; const float* sh_wu = (const float*)d_in[20];
    const float* sh_wd = (const float*)d_in[21]; const float* ln2_g = (const float*)d_in[22]; const float* ln2_b = (const float*)d_in[23];
    unsigned char* ws = (unsigned char*)d_ws; float* out = (float*)d_out;
    unsigned* ctl = (unsigned*)(ws + WS_CTL);
    bf16* KV = (bf16*)(ws + WS_KV); bf16* XBF = (bf16*)(ws + WS_XBF); float* X1F = (float*)(ws + WS_X1F);
    bf16* X1BF = (bf16*)(ws + WS_X1BF); float* ZF = (float*)(ws + WS_ZF);
    bf16* YA = (bf16*)(ws + WS_YA); bf16* YB = (bf16*)(ws + WS_YB); bf16* YX = (bf16*)(ws + WS_YX);
    bf16* H = (bf16*)(ws + WS_R2); float* OH = (float*)(ws + WS_R2); bf16* PROJ = (bf16*)(ws + WS_R1); bf16* Y = (bf16*)(ws + WS_R1);
    int* LIST = (int*)(ws + WS_LIST); int* TOKSLOT = (int*)(ws + WS_TOKSLOT); float* TOKW = (float*)(ws + WS_TOKW);
    Args a{};
    for (int i = 0; i < 24; ++i) a.in[i] = (const float*)d_in[i];
    a.out = out; a.ws = ws;

    (void)hipMemsetAsync(ws + WS_CTL, 0, CTL_BYTES, stream);
    a.mask = 7;
    launch_mk(a, 0, N_PHASES, grid, stream);
}
```

```cpp
#include <hip/hip_runtime.h>
#include <stdint.h>
#include <stdio.h>

typedef unsigned short bf16;
__device__ __forceinline__ float bf2f(bf16 v) { return __uint_as_float(((unsigned)v) << 16); }
__device__ __forceinline__ bf16 f2bf(float f) { unsigned u = __float_as_uint(f); return (bf16)((u + 0x7fffu + ((u >> 16) & 1u)) >> 16); }

constexpr int NB = 4, SEQ = 4096, NTOK = NB * SEQ, D = 2048, NMEM = 256;
constexpr int CW = 768, HGW = 768, HGH = 6, HGD = 128, XAW = 512, XAH = 4, XAD = 128;
constexpr int INC = 12032, YXW = 768, GW8 = 3 * 2048, PN_GATE = 23;
constexpr int C_U = 0, C_B = 768, C_C = 1536, C_Q = 2304, C_F = 3072, C_I = 3840, C_G = 4608, C_QX = 5376, C_GA = 5888, C_GB = 7936, C_GX = 9984;
constexpr int NE = 64, TOPK = 8, EH = 512;
constexpr float ALPHA = 1.41421356237f, LN_EPS = 1e-5f, RMS_EPS = 1e-6f, RSCALE = 2.5f;
constexpr int LISTCAP = 16384;

constexpr size_t MiB = 1u << 20;
constexpr size_t WS_CTL = 0, CTL_BYTES = 1 * MiB;
constexpr size_t WS_RW = 1 * MiB, RW_L = 512 * 1024;
constexpr size_t WS_WIN_T = 2 * MiB, WIN_T_L = 47 * MiB;
constexpr size_t WS_WBR_T = 1932 * MiB, WBR_T_L = 9 * MiB;
constexpr size_t WS_WO_T = 112 * MiB, WO_T_L = 8 * MiB;
constexpr size_t WS_WKV_T = 128 * MiB;
constexpr size_t WS_MEMBF = 136 * MiB, WS_KV = 140 * MiB;
constexpr size_t WS_WGU = 144 * MiB, WGU_E = 4 * MiB;
constexpr size_t WS_WDN = 404 * MiB, WDN_E = 2 * MiB;
constexpr size_t WS_XBF = 534 * MiB, WS_X1F = 598 * MiB, WS_X1BF = 726 * MiB, WS_ZF = 790 * MiB, WS_MERGED = 918 * MiB;
constexpr size_t WS_YA = 1860 * MiB, WS_YB = 1884 * MiB, WS_YX = 1908 * MiB;
constexpr size_t WS_R2 = 1046 * MiB;
constexpr size_t WS_R1 = 1214 * MiB;
constexpr size_t R1_YS = 320 * MiB;
constexpr size_t WS_LIST = 1854 * MiB, WS_TOKSLOT = 1858 * MiB, WS_TOKW = 1859 * MiB, WS_GATE8 = 1950 * MiB, WS_END = 2046 * MiB;
constexpr int CW_CNT = 1024;
constexpr int CW_PLAN = 2048;
constexpr int CW_BAR = 4096;
#ifndef DBG_MASK
#define DBG_MASK 7
#endif
namespace pg8 {
#define PG8_LAS __attribute__((address_space(3)))
typedef unsigned short bf16_t;
typedef short bf16x8 __attribute__((ext_vector_type(8)));
typedef float f32x4 __attribute__((ext_vector_type(4)));
typedef unsigned u32x4 __attribute__((ext_vector_type(4)));
typedef unsigned u32x2 __attribute__((ext_vector_type(2)));
constexpr int PG8_NVO_OFF = 147456 + 1024;
constexpr int BM = 256, BK = 64, HALF = 128, HTB = HALF * BK * 2  , STAGE_BYTES = 8 * HTB, NXCD = 8, WGM = 8;

__host__ __device__ __forceinline__ int lds_byte(int r, int c) { const int st = (r >> 4) * 2 + (c >> 5), rr = r & 15, cc = c & 31, ob = rr * 64 + cc * 2; return st * 1024 + (ob ^ (((ob >> 9) & 1) << 5)); }
__host__ __device__ __forceinline__ void stage_rc(int b, int& R, int& C) { const int st = b / 1024, sb = b % 1024, swz = sb ^ (((sb >> 9) & 1) << 5); R = (st >> 1) * 16 + swz / 64; C = (st & 1) * 32 + (swz % 64) / 2; }
__host__ __device__ __forceinline__ int perm32(int rho) { const int n = rho >> 4, i = rho & 15; return 8 * (i >> 2) + 4 * n + (i & 3); }

struct Unit { const char* A; const char* B; int pm, pn; const int* list; int m0, cnt; };

typedef float f32x2_ __attribute__((ext_vector_type(2)));
typedef __bf16 bf16x2_ __attribute__((ext_vector_type(2)));
__device__ __forceinline__ unsigned cvt_pk_bf16(float lo, float hi) { const f32x2_ v = {lo, hi}; const bf16x2_ b = __builtin_convertvector(v, bf16x2_); return __builtin_bit_cast(unsigned, b); }
__device__ __forceinline__ int lane_id_opaque() { unsigned m = ~0u; asm volatile("" : "+s"(m)); return (int)__builtin_amdgcn_mbcnt_hi(m, __builtin_amdgcn_mbcnt_lo(m, 0u)); }
__device__ __forceinline__ float bf_lo(unsigned w) { return __uint_as_float(w << 16); }
__device__ __forceinline__ float bf_hi(unsigned w) { return __uint_as_float(w & 0xffff0000u); }
__device__ __forceinline__ float sigmoidf_(float x) { return __builtin_amdgcn_rcpf(1.f + __expf(-x)); }

typedef f32x4 Acc[2][2][4][2];

template <class Epi, class Sched, bool ALIGN_EPI>
__device__ __forceinline__ void gemm_phase(PG8_LAS unsigned char* lds, const int wave, const int K_in, const Sched& S, const Epi& E) {
    const int lane = lane_id_opaque(), wid = wave, tid = wid * 64 + lane, wr = wid >> 2, wc = wid & 3, fr = lane & 15, fq = lane >> 4;
    int K = K_in; asm volatile("" : "+s"(K));
    const int nt = K / BK;
    unsigned voffB[2];
#pragma unroll
    for (int i = 0; i < 2; ++i) { int R, C; stage_rc(tid * 16 + i * 8192, R, C); const int Rb = Epi::PERM ? ((R & ~31) + perm32(R & 31)) : R; voffB[i] = (unsigned)(Rb * K + C) * 2u; }
    const size_t kstep = (size_t)(BK * 2);
    const size_t hstep = (size_t)HALF * K * 2;
    const unsigned ldsw = (unsigned)wid * 1024u;
    const int aoff = lds_byte(wr * 64 + fr, fq * 8), boff = lds_byte(wc * 32 + fr, fq * 8);
#define PG8_SA(b, h) (((b) * 2 + (h)) * HTB)
#define PG8_SB(b, h) ((4 + (b) * 2 + (h)) * HTB)
#define PG8_STAGE2(bufoff, gbase, v0, v1) do { \
        __builtin_amdgcn_global_load_lds((const unsigned*)((const char*)(gbase) + (v0)), (PG8_LAS unsigned*)(lds + (bufoff) + ldsw), 16, 0, 0); \
        __builtin_amdgcn_global_load_lds((const unsigned*)((const char*)(gbase) + (v1)), (PG8_LAS unsigned*)(lds + (bufoff) + ldsw + 8192), 16, 0, 0); } while (0)
#define PG8_STAGEB(bufoff, gbase) PG8_STAGE2(bufoff, gbase, voffB[0], voffB[1])
#define PG8_LDA(dst, b, h) do { _Pragma("unroll") for (int m = 0; m < 4; ++m) _Pragma("unroll") for (int k = 0; k < 2; ++k) dst[m][k] = *(const PG8_LAS bf16x8*)(lds + PG8_SA(b, h) + aoff + m * 2048 + k * 1024); } while (0)
#define PG8_LDB(dst, b, h) do { _Pragma("unroll") for (int n = 0; n < 2; ++n) _Pragma("unroll") for (int k = 0; k < 2; ++k) dst[n][k] = *(const PG8_LAS bf16x8*)(lds + PG8_SB(b, h) + boff + n * 2048 + k * 1024); } while (0)
#define PG8_MMA(ai, bj, At, Bt) do { __builtin_amdgcn_s_setprio(1); _Pragma("unroll") for (int m = 0; m < 4; ++m) _Pragma("unroll") for (int n = 0; n < 2; ++n) _Pragma("unroll") for (int k = 0; k < 2; ++k) \
        acc[ai][bj][m][n] = __builtin_amdgcn_mfma_f32_16x16x32_bf16(Bt[n][k], At[m][k], acc[ai][bj][m][n], 0, 0, 0); __builtin_amdgcn_s_setprio(0); } while (0)
#define PG8_WAIT_V(n) asm volatile("s_waitcnt vmcnt(" #n ")" ::: "memory")
#define PG8_WAIT_L(n) asm volatile("s_waitcnt lgkmcnt(" #n ")" ::: "memory")
#define PG8_BAR __builtin_amdgcn_s_barrier()
#define PG8_SCHED __builtin_amdgcn_sched_barrier(0)
    Unit cur, nxt; int ui = 0;
    if (!S.next(0, cur)) return;
    Acc acc;
#pragma unroll
    for (int a = 0; a < 2; ++a)
#pragma unroll
        for (int b = 0; b < 2; ++b)
#pragma unroll
            for (int m = 0; m < 4; ++m)
#pragma unroll
                for (int n = 0; n < 2; ++n) acc[a][b][m][n] = (f32x4){0.f, 0.f, 0.f, 0.f};
    bf16x8 At[4][2], B0[2][2], B1[2][2];
    constexpr bool GA = Sched::GATHER;
    unsigned c00, c01, c10 = 0, c11 = 0;
    PG8_LAS unsigned* nvo = (PG8_LAS unsigned*)(lds + PG8_NVO_OFF) + tid * 4;
    { int R0, C0, R1, C1; stage_rc(tid * 16, R0, C0); stage_rc(tid * 16 + 8192, R1, C1);
      c00 = S.avoff(cur, 0, R0, C0, K); c01 = S.avoff(cur, 0, R1, C1, K); if constexpr (GA) { c10 = S.avoff(cur, 1, R0, C0, K); c11 = S.avoff(cur, 1, R1, C1, K); } }
    const size_t hA = GA ? (size_t)0 : hstep;
#define PG8_STAGEA0(bufoff, gbase) PG8_STAGE2(bufoff, gbase, c00, c01)
#define PG8_STAGEA1(bufoff, gbase) do { if constexpr (GA) PG8_STAGE2(bufoff, gbase, c10, c11); else PG8_STAGE2(bufoff, (gbase) + hA, c00, c01); } while (0)
    const char* cA = cur.A; const char* cB = cur.B;
    PG8_STAGEB(PG8_SB(0, 0), cB); PG8_STAGEB(PG8_SB(0, 1), cB + hstep); PG8_STAGEA0(PG8_SA(0, 0), cA); PG8_STAGEA1(PG8_SA(0, 1), cA);
    if (wr == 1) PG8_BAR;
    PG8_WAIT_V(2); PG8_BAR;
    PG8_STAGEB(PG8_SB(1, 0), cB + kstep); PG8_STAGEA0(PG8_SA(1, 0), cA + kstep); PG8_STAGEB(PG8_SB(1, 1), cB + hstep + kstep);
    PG8_WAIT_V(6); PG8_BAR;
    int pi0 = 0, pi1 = 0, pi2 = 0, pi3 = 0;
    if constexpr (GA) { Unit n1; if (S.next(1, n1)) { int R0, C0, R1, C1; stage_rc(tid * 16, R0, C0); stage_rc(tid * 16 + 8192, R1, C1);
        pi0 = S.avload(n1, 0, R0); pi1 = S.avload(n1, 0, R1); pi2 = S.avload(n1, 1, R0); pi3 = S.avload(n1, 1, R1); } }
    for (;;) {
        const bool has_next = S.next(ui + 1, nxt);
        const char* nA = has_next ? nxt.A : cA; const char* nB = has_next ? nxt.B : cB;
        if constexpr (GA) { if (has_next) {
            int R0, C0, R1, C1; stage_rc(tid * 16, R0, C0); stage_rc(tid * 16 + 8192, R1, C1);
            nvo[0] = S.avfin(nxt, 0, R0, C0, K, pi0); nvo[1] = S.avfin(nxt, 0, R1, C1, K, pi1); nvo[2] = S.avfin(nxt, 1, R0, C0, K, pi2); nvo[3] = S.avfin(nxt, 1, R1, C1, K, pi3); } }
        for (int t = 0; t < nt; t += 2) {
            const bool last = (t == nt - 2);
            const char* a1 = cA + (size_t)(t + 1) * kstep;
            const char* a2 = last ? nA : cA + (size_t)(t + 2) * kstep; const char* b2 = last ? nB : cB + (size_t)(t + 2) * kstep;
            const char* a3 = a2 + kstep; const char* b3 = b2 + kstep;
            const bool nx = GA && last && has_next;
#define PG8_STAGEA0N(bufoff, gbase) do { if (nx) { const unsigned q0 = nvo[0], q1 = nvo[1]; PG8_STAGE2(bufoff, gbase, q0, q1); } else PG8_STAGEA0(bufoff, gbase); } while (0)
#define PG8_STAGEA1N(bufoff, gbase) do { if (nx) { const unsigned q0 = nvo[2], q1 = nvo[3]; PG8_STAGE2(bufoff, gbase, q0, q1); } else PG8_STAGEA1(bufoff, gbase); } while (0)
            PG8_LDB(B0, 0, 0); PG8_LDB(B1, 0, 1); PG8_SCHED; PG8_LDA(At, 0, 0); PG8_STAGEA1(PG8_SA(1, 1), a1);
            PG8_WAIT_V(8); PG8_WAIT_L(0); PG8_BAR; PG8_MMA(0, 0, At, B0); PG8_MMA(0, 1, At, B1); PG8_BAR; PG8_SCHED;
            PG8_LDA(At, 0, 1); PG8_STAGEB(PG8_SB(0, 0), b2); PG8_STAGEB(PG8_SB(0, 1), b2 + hstep); PG8_STAGEA0N(PG8_SA(0, 0), a2);
            PG8_WAIT_V(8); PG8_WAIT_L(0); PG8_BAR; PG8_MMA(1, 0, At, B0); PG8_MMA(1, 1, At, B1); PG8_BAR; PG8_SCHED;
            PG8_LDB(B0, 1, 0); PG8_LDB(B1, 1, 1); PG8_SCHED; PG8_LDA(At, 1, 0); PG8_STAGEA1N(PG8_SA(0, 1), a2);
            PG8_WAIT_V(8); PG8_WAIT_L(0); PG8_BAR; PG8_MMA(0, 0, At, B0); PG8_MMA(0, 1, At, B1); PG8_BAR; PG8_SCHED;
            PG8_LDA(At, 1, 1); PG8_STAGEB(PG8_SB(1, 0), b3); PG8_STAGEB(PG8_SB(1, 1), b3 + hstep); PG8_STAGEA0N(PG8_SA(1, 0), a3);
            PG8_WAIT_V(8); PG8_WAIT_L(0); PG8_BAR; PG8_MMA(1, 0, At, B0); PG8_MMA(1, 1, At, B1); PG8_BAR; PG8_SCHED;
#undef PG8_STAGEA0N
#undef PG8_STAGEA1N
        }
        if constexpr (GA) { Unit n2; if (has_next && S.next(ui + 2, n2)) { int R0, C0, R1, C1; stage_rc(tid * 16, R0, C0); stage_rc(tid * 16 + 8192, R1, C1);
            pi0 = S.avload(n2, 0, R0); pi1 = S.avload(n2, 0, R1); pi2 = S.avload(n2, 1, R0); pi3 = S.avload(n2, 1, R1); } }
        if constexpr (ALIGN_EPI) { if (wr == 0) PG8_BAR; }
        bool keep = false;
        if constexpr (Epi::INPLACE) keep = E.inplace(acc, cur, wr, wc, fr, fq); else E(acc, cur, wr, wc, fr, fq);
        if (!has_next) break;
        if (!keep)
#pragma unroll
        for (int a = 0; a < 2; ++a)
#pragma unroll
            for (int b = 0; b < 2; ++b)
#pragma unroll
                for (int m = 0; m < 4; ++m)
#pragma unroll
                    for (int n = 0; n < 2; ++n) acc[a][b][m][n] = (f32x4){0.f, 0.f, 0.f, 0.f};
        cur = nxt; cA = nA; cB = nB; ++ui; if constexpr (GA) { c00 = nvo[0]; c01 = nvo[1]; c10 = nvo[2]; c11 = nvo[3]; }
        if constexpr (ALIGN_EPI) { if (wr == 1) PG8_BAR; }
    }
    PG8_WAIT_V(0);
    if constexpr (!ALIGN_EPI) { if (wr == 0) PG8_BAR; }
    PG8_BAR;
#undef PG8_SA
#undef PG8_SB
#undef PG8_STAGE2
#undef PG8_STAGEB
#undef PG8_STAGEA0
#undef PG8_STAGEA1
#undef PG8_LDA
#undef PG8_LDB
#undef PG8_MMA
#undef PG8_WAIT_V
#undef PG8_WAIT_L
#undef PG8_BAR
#undef PG8_SCHED
}
}
#define GAS __attribute__((address_space(1)))
#define LAS __attribute__((address_space(3)))
typedef unsigned v4u __attribute__((ext_vector_type(4)));
typedef unsigned v2u __attribute__((ext_vector_type(2)));
typedef float f32x4 __attribute__((ext_vector_type(4)));
typedef short bf16x8 __attribute__((ext_vector_type(8)));
typedef GAS unsigned gu32;
#define RLX_AGENT __ATOMIC_RELAXED, __HIP_MEMORY_SCOPE_AGENT
#define LDS_WAIT() asm volatile("s_waitcnt lgkmcnt(0)" ::: "memory")
#define VM_WAIT() asm volatile("s_waitcnt vmcnt(0)" ::: "memory")
__device__ __forceinline__ int opaque_v(int x) { asm volatile("" : "+v"(x)); return x; }
__device__ __forceinline__ float shx(float v, int o, int lane) { return __int_as_float(__builtin_amdgcn_ds_bpermute((lane ^ o) << 2, __float_as_int(v))); }
__device__ __forceinline__ unsigned pk2(float lo, float hi) { return pg8::cvt_pk_bf16(lo, hi); }

#define XB_TMO      128
#define XB_XCNT(j)  (256  + 64 * (j))
#define XB_XSUB(j)  (1280 + 64 * (j))
#define XB_XGEN(j)  (2304 + 64 * (j))
#define XB_TOP      3328
#define XB_TOPGEN   3392
#define XCD_BAR_WORDS 3456
#define XB_SPIN_CAP (1u << 18)
__device__ __forceinline__ unsigned xb_ld(unsigned* p)              { return __hip_atomic_load(p, __ATOMIC_RELAXED, __HIP_MEMORY_SCOPE_AGENT); }
__device__ __forceinline__ unsigned xb_add(unsigned* p, unsigned v) { return __hip_atomic_fetch_add(p, v, __ATOMIC_RELAXED, __HIP_MEMORY_SCOPE_AGENT); }
__device__ __forceinline__ unsigned xb_xcc_id() { return (unsigned)__builtin_amdgcn_s_getreg((3 << 11) | 20) & 0xFu; }
#define XB_SPIN(cond, bar) do { unsigned _sp = 0; while (cond) { __builtin_amdgcn_s_sleep(1); \
    if ((++_sp & 255u) == 0u) { if (xb_ld(&(bar)[XB_TMO])) break; if (_sp > XB_SPIN_CAP) { atomicAdd(&(bar)[XB_TMO], 1u); break; } } } } while (0)
struct XcdBarrier { unsigned* bar; unsigned x; volatile LAS unsigned* st; };
__device__ __forceinline__ XcdBarrier xcd_barrier_post(unsigned* bar, volatile LAS unsigned* st) {
    XcdBarrier b; b.bar = bar; b.x = xb_xcc_id(); b.st = st;
    if (threadIdx.x == 0) (void)xb_add(&bar[XB_XCNT(b.x)], 1u);
    return b;
}
__device__ __forceinline__ void xcd_barrier_complete(unsigned* bar, unsigned x, unsigned& nloc, unsigned& nx) {
    const unsigned G = gridDim.x * gridDim.y * gridDim.z;
    unsigned sum, cnt, mine, sp = 0u;
    for (;;) {
        sum = 0u; cnt = 0u; mine = 0u;
#pragma unroll
        for (unsigned j = 0; j < 16; ++j) { const unsigned c = xb_ld(&bar[XB_XCNT(j)]); sum += c; cnt += (c > 0u) ? 1u : 0u; mine = (j == x) ? c : mine; }
        if (sum == G) break;
        __builtin_amdgcn_s_sleep(1);
        if ((++sp & 255u) == 0u) { if (xb_ld(&bar[XB_TMO])) break; if (sp > XB_SPIN_CAP) { atomicAdd(&bar[XB_TMO], 1u); break; } }
    }
    nloc = mine > 0u ? mine : 1u; nx = cnt > 0u ? cnt : 1u;
}
__device__ __forceinline__ void xcd_barrier(const XcdBarrier& b_in) {
    asm volatile("s_waitcnt vmcnt(0)" ::: "memory");
    __syncthreads();
    if (threadIdx.x == 0) {
        XcdBarrier b = b_in; asm volatile("" : "+s"(b.x));
        unsigned* bar = b.bar; asm volatile("" : "+s"(bar));
        __builtin_amdgcn_s_waitcnt(0);
        unsigned nloc = b.st[0], nx = b.st[1];
        if (nloc == 0u) { xcd_barrier_complete(bar, b.x, nloc, nx); b.st[0] = nloc; b.st[1] = nx; }
        const unsigned old = xb_add(&bar[XB_XSUB(b.x)], 1u);
        const unsigned gen = old / nloc;
        if (old + 1u == (gen + 1u) * nloc) {
            __builtin_amdgcn_fence(__ATOMIC_RELEASE, "agent");
            asm volatile("s_waitcnt vmcnt(0)" ::: "memory");
            const unsigned og = xb_add(&bar[XB_TOP], 1u);
            const unsigned tg = og / nx;
            if (og + 1u == (tg + 1u) * nx) xb_add(&bar[XB_TOPGEN], 1u);
            else XB_SPIN(xb_ld(&bar[XB_TOPGEN]) == tg, bar);
            __builtin_amdgcn_fence(__ATOMIC_ACQUIRE, "agent");
            xb_add(&bar[XB_XGEN(b.x)], 1u);
            asm volatile("s_waitcnt vmcnt(0)" ::: "memory");
        } else {
            XB_SPIN(xb_ld(&bar[XB_XGEN(b.x)]) == gen, bar);
            __builtin_amdgcn_fence(__ATOMIC_ACQUIRE, "agent");
            asm volatile("s_waitcnt vmcnt(0)" ::: "memory");
        }
    }
    __syncthreads();
}
using pg8::Unit; using pg8::Acc;
struct DenseSched { static constexpr bool GATHER = false;
    const char* A; const char* B; int nM, nN, nwg, G, c, K; int L0 = 0, cnt = 1 << 30;
    __device__ __forceinline__ void init(const void* A_, const void* B_, int M, int N, int K_, int G_, int c_) { A = (const char*)A_; B = (const char*)B_; nM = M / 256; nN = N / 256; nwg = nM * nN; G = G_; c = c_; K = K_; }
    __device__ __forceinline__ bool next(int i, Unit& u) const {
        const long L = (long)L0 + (long)i * G + c; if (c < 0 || i >= cnt || L >= nwg) return false;
        int wgid = (int)L; { const int q = nwg / 8, r = nwg % 8, xcd = wgid % 8, off = wgid / 8; wgid = (xcd < r ? xcd * (q + 1) : r * (q + 1) + (xcd - r) * q) + off; }
        const int nig = 8 * nN, gid = wgid / nig, fm = gid * 8, gsz = (nM - fm) < 8 ? (nM - fm) : 8;
        u.pm = fm + ((wgid % nig) % gsz); u.pn = (wgid % nig) / gsz;
        u.A = A + (size_t)u.pm * 256 * K * 2; u.B = B + (size_t)u.pn * 256 * K * 2; u.list = nullptr; u.m0 = 0; u.cnt = 0; return true;
    }
    __device__ __forceinline__ int avload(const Unit&, int, int) const { return 0; }
    __device__ __forceinline__ unsigned avfin(const Unit&, int h, int R, int C, int K_, int) const { return (unsigned)(((h * 128 + R) * K_ + C) * 2); }
    __device__ __forceinline__ unsigned avoff(const Unit&, int h, int R, int C, int K_) const { return (unsigned)(((h * 128 + R) * K_ + C) * 2); }
};
struct EpiBf16Plain { static constexpr bool PERM = true, INPLACE = false; bf16* O; int ldc;
    __device__ __forceinline__ void operator()(const Acc& acc, const Unit& u, int wr, int wc, int fr, int fq) const {
        const int row0 = u.pm * 256 + wr * 64 + fr, col0 = u.pn * 256 + wc * 32 + 8 * fq;
#pragma unroll
        for (int ai = 0; ai < 2; ++ai)
#pragma unroll
            for (int m = 0; m < 4; ++m) { bf16* rowp = O + (size_t)(row0 + ai * 128 + m * 16) * ldc + col0;
#pragma unroll
                for (int bj = 0; bj < 2; ++bj) { const f32x4 v0 = acc[ai][bj][m][0], v1 = acc[ai][bj][m][1];
                    v4u w; w.x = pk2(v0[0], v0[1]); w.y = pk2(v0[2], v0[3]); w.z = pk2(v1[0], v1[1]); w.w = pk2(v1[2], v1[3]);
                    *(v4u*)(rowp + bj * 128) = w; } }
    }
};
struct EpiProj { static constexpr bool PERM = true, INPLACE = false; bf16* O; unsigned char* G8;
    __device__ __forceinline__ void operator()(const Acc& acc, const Unit& u, int wr, int wc, int fr, int fq) const {
        const int row0 = u.pm * 256 + wr * 64 + fr;
        if (u.pn < PN_GATE) { const int col0 = u.pn * 256 + wc * 32 + 8 * fq;
#pragma unroll
            for (int ai = 0; ai < 2; ++ai)
#pragma unroll
                for (int m = 0; m < 4; ++m) { bf16* rowp = O + (size_t)(row0 + ai * 128 + m * 16) * INC + col0;
#pragma unroll
                    for (int bj = 0; bj < 2; ++bj) { const f32x4 v0 = acc[ai][bj][m][0], v1 = acc[ai][bj][m][1];
                        v4u w; w.x = pk2(v0[0], v0[1]); w.y = pk2(v0[2], v0[3]); w.z = pk2(v1[0], v1[1]); w.w = pk2(v1[2], v1[3]);
                        *(v4u*)(rowp + bj * 128) = w; } }
        } else { const int pos0 = (u.pn - PN_GATE) * 256 + wc * 64 + fq * 16;
#pragma unroll
            for (int ai = 0; ai < 2; ++ai)
#pragma unroll
                for (int m = 0; m < 4; ++m) { unsigned char* rowp = G8 + (size_t)(row0 + ai * 128 + m * 16) * GW8 + pos0;
                    v4u w;
#pragma unroll
                    for (int bj = 0; bj < 2; ++bj) { const f32x4 v0 = acc[ai][bj][m][0], v1 = acc[ai][bj][m][1];
                        unsigned q[8];
#pragma unroll
                        for (int j = 0; j < 4; ++j) { q[j] = (unsigned)fmaxf(pg8::sigmoidf_(v0[j]) * 255.f + 0.5f, 1.f); q[4 + j] = (unsigned)fmaxf(pg8::sigmoidf_(v1[j]) * 255.f + 0.5f, 1.f); }
                        const unsigned lo = q[0] | (q[1] << 8) | (q[2] << 16) | (q[3] << 24), hi = q[4] | (q[5] << 8) | (q[6] << 16) | (q[7] << 24);
                        if (bj == 0) { w.x = lo; w.y = hi; } else { w.z = lo; w.w = hi; } }
                    *(v4u*)rowp = w; }
        }
    }
};
struct BranchSched { static constexpr bool GATHER = false;
    const char* A0; const char* B; int G, c;
    __device__ __forceinline__ void init(const void* ya, const void* w, int G_, int c_) { A0 = (const char*)ya; B = (const char*)w; G = G_; c = c_; }
    __device__ __forceinline__ bool next(int i, Unit& u) const {
        const int j = i / 3, seg = i - 3 * j; constexpr int nM = NTOK / 256, nN = D / 256, nwg = nM * nN;
        const int L = j * G + c; if (L >= nwg) return false;
        int wgid = L; { const int q = nwg / 8, xcd = wgid % 8, off = wgid / 8; wgid = xcd * q + off; }
        const int nig = 8 * nN; u.pm = (wgid / nig) * 8 + ((wgid % nig) % 8); u.pn = (wgid % nig) / 8;
        u.A = A0 + (size_t)seg * (WS_YB - WS_YA) + (size_t)u.pm * 256 * CW * 2; u.B = B + (size_t)seg * 3 * MiB + (size_t)u.pn * 256 * CW * 2; u.list = nullptr; u.m0 = seg; u.cnt = 0; return true; }
    __device__ __forceinline__ int avload(const Unit&, int, int) const { return 0; }
    __device__ __forceinline__ unsigned avfin(const Unit&, int h, int R, int C, int K_, int) const { return (unsigned)(((h * 128 + R) * K_ + C) * 2); }
    __device__ __forceinline__ unsigned avoff(const Unit&, int h, int R, int C, int K_) const { return (unsigned)(((h * 128 + R) * K_ + C) * 2); }
};
struct EpiGateRT { static constexpr bool PERM = true, INPLACE = true; const unsigned char* g8; bf16* merged;
    __device__ __forceinline__ bool inplace(Acc& acc, const Unit& u, int wr, int wc, int fr, int fq) const {
        const int row0 = u.pm * 256 + wr * 64 + fr, col0 = u.pn * 256 + wc * 32 + 8 * fq, pos0 = u.pn * 256 + wc * 64 + fq * 16; const int seg = u.m0;
#pragma unroll
        for (int ai = 0; ai < 2; ++ai) {
            v4u ga[4], gb[4];
#pragma unroll
            for (int m = 0; m < 4; ++m) { const size_t row = (size_t)(row0 + ai * 128 + m * 16);
                ga[m] = *(const v4u*)(g8 + row * GW8 + seg * D + pos0); gb[m] = ga[m]; if (seg < 2) gb[m] = *(const v4u*)(g8 + row * GW8 + (seg + 1) * D + pos0); }
            asm volatile("" ::: "memory");
#pragma unroll
            for (int m = 0; m < 4; ++m) { const size_t row = (size_t)(row0 + ai * 128 + m * 16);
#pragma unroll
                for (int bj = 0; bj < 2; ++bj) { const unsigned ax = bj ? ga[m].z : ga[m].x, ay = bj ? ga[m].w : ga[m].y, bx = bj ? gb[m].z : gb[m].x, by = bj ? gb[m].w : gb[m].y;
                    f32x4 v0 = acc[ai][bj][m][0], v1 = acc[ai][bj][m][1];
                    if (seg < 2) {
                        v0[0] *= (float)(ax & 255u) * __builtin_amdgcn_rcpf((float)(bx & 255u)); v0[1] *= (float)((ax >> 8) & 255u) * __builtin_amdgcn_rcpf((float)((bx >> 8) & 255u));
                        v0[2] *= (float)((ax >> 16) & 255u) * __builtin_amdgcn_rcpf((float)((bx >> 16) & 255u)); v0[3] *= (float)(ax >> 24) * __builtin_amdgcn_rcpf((float)(bx >> 24));
                        v1[0] *= (float)(ay & 255u) * __builtin_amdgcn_rcpf((float)(by & 255u)); v1[1] *= (float)((ay >> 8) & 255u) * __builtin_amdgcn_rcpf((float)((by >> 8) & 255u));
                        v1[2] *= (float)((ay >> 16) & 255u) * __builtin_amdgcn_rcpf((float)((by >> 16) & 255u)); v1[3] *= (float)(ay >> 24) * __builtin_amdgcn_rcpf((float)(by >> 24));
                        acc[ai][bj][m][0] = v0; acc[ai][bj][m][1] = v1;
                    } else { constexpr float s8 = 1.f / 255.f;
                        v0[0] *= (float)(ax & 255u) * s8; v0[1] *= (float)((ax >> 8) & 255u) * s8; v0[2] *= (float)((ax >> 16) & 255u) * s8; v0[3] *= (float)(ax >> 24) * s8;
                        v1[0] *= (float)(ay & 255u) * s8; v1[1] *= (float)((ay >> 8) & 255u) * s8; v1[2] *= (float)((ay >> 16) & 255u) * s8; v1[3] *= (float)(ay >> 24) * s8;
                        v4u w; w.x = pk2(v0[0], v0[1]); w.y = pk2(v0[2], v0[3]); w.z = pk2(v1[0], v1[1]); w.w = pk2(v1[2], v1[3]); *(v4u*)(merged + row * D + col0 + bj * 128) = w; } } }
            asm volatile("" ::: "memory");
        }
        return seg < 2;
    }
};
template <bool RB16> struct EpiResid { static constexpr bool PERM = true, INPLACE = false; const void* xres; bf16* z;
    __device__ __forceinline__ void operator()(const Acc& acc, const Unit& u, int wr, int wc, int fr, int fq) const {
        const int row0 = u.pm * 256 + wr * 64 + fr, col0 = u.pn * 256 + wc * 32 + 8 * fq;
#pragma unroll
        for (int ai = 0; ai < 2; ++ai) {
            f32x4 xr[4][2][2];
#pragma unroll
            for (int m = 0; m < 4; ++m) { const size_t off = (size_t)(row0 + ai * 128 + m * 16) * D + col0;
#pragma unroll
                for (int bj = 0; bj < 2; ++bj) {
                    if constexpr (RB16) { const v4u w = *(const v4u*)((const bf16*)xres + off + bj * 128);
                        xr[m][bj][0] = (f32x4){pg8::bf_lo(w.x), pg8::bf_hi(w.x), pg8::bf_lo(w.y), pg8::bf_hi(w.y)}; xr[m][bj][1] = (f32x4){pg8::bf_lo(w.z), pg8::bf_hi(w.z), pg8::bf_lo(w.w), pg8::bf_hi(w.w)}; }
                    else {
#pragma unroll
                        for (int n = 0; n < 2; ++n) xr[m][bj][n] = *(const f32x4*)((const float*)xres + off + bj * 128 + n * 4); } } }
            asm volatile("" ::: "memory");
#pragma unroll
            for (int m = 0; m < 4; ++m) { const size_t off = (size_t)(row0 + ai * 128 + m * 16) * D + col0;
#pragma unroll
                for (int bj = 0; bj < 2; ++bj) { const f32x4 v0 = xr[m][bj][0] * ALPHA + acc[ai][bj][m][0], v1 = xr[m][bj][1] * ALPHA + acc[ai][bj][m][1];
                    v4u w; w.x = pk2(v0[0], v0[1]); w.y = pk2(v0[2], v0[3]); w.z = pk2(v1[0], v1[1]); w.w = pk2(v1[2], v1[3]); *(v4u*)(z + off + bj * 128) = w; } }
            asm volatile("" ::: "memory");
        }
    }
};

constexpr int NWAVES = 8;
constexpr int RING_OFF = 0, RING_BYTES = 131072;
constexpr int SCR_BYTES = 147456;
constexpr int MISC_OFF = SCR_BYTES;
constexpr int LDS_BYTES = 163840;
constexpr int PH_CVT = 0, PH_L0 = 1, PH_PER_LAYER = 10;
constexpr int P_INPROJ = 0, P_MIX = 1, P_SCAN = 2, P_HOUT = 3, P_BRANCH = 4, P_WO = 5, P_ROUTE = 6, P_GU = 7, P_DOWN = 8, P_COMB = 9;
constexpr int N_PHASES = PH_L0 + 2 * PH_PER_LAYER;

constexpr int NCV = 64;
#define CV_UNITS 5
#define GM_UNITS 14
struct Frame { LAS unsigned char* lds; int tid, lane, wave, G, gw, NGW; };

__device__ __forceinline__ void xpose_item(const float* W, int N, int k0, int n0, bf16* WTrow0, int ldk, LAS float* scr, int lane) {
    const int kk = lane >> 3, nn = (lane & 7) * 4;
    f32x4 v[8];
#pragma unroll
    for (int i = 0; i < 8; ++i) v[i] = *(const f32x4*)(W + (size_t)(k0 + kk + 8 * i) * N + n0 + nn);
#pragma unroll
    for (int i = 0; i < 8; ++i) { LAS float* s = scr + (kk + 8 * i) * 33 + nn; s[0] = v[i][0]; s[1] = v[i][1]; s[2] = v[i][2]; s[3] = v[i][3]; }
    LDS_WAIT(); asm volatile("" ::: "memory");
    const int c = lane & 7;
#pragma unroll
    for (int j = 0; j < 4; ++j) { const int n = (lane >> 3) + 8 * j; const LAS float* s = scr + (8 * c) * 33 + n;
        v4u o; o.x = pk2(s[0 * 33], s[1 * 33]); o.y = pk2(s[2 * 33], s[3 * 33]); o.z = pk2(s[4 * 33], s[5 * 33]); o.w = pk2(s[6 * 33], s[7 * 33]);
        *(v4u*)(WTrow0 + (size_t)n * ldk + 8 * c) = o; }
    LDS_WAIT(); asm volatile("" ::: "memory");
}
__device__ __forceinline__ void xpose_matrix(const Frame& F, const float* W, int K, int N, bf16* WT, int ldk, int mode, unsigned& gbase) {
    const int nblk = N / 32, nitems = (K / 64) * nblk;
    LAS float* scr = (LAS float*)(F.lds + RING_OFF + F.wave * 8704);
    int it = (int)(((unsigned)F.gw + (unsigned)F.NGW - gbase % (unsigned)F.NGW) % (unsigned)F.NGW);
    for (; it < nitems; it += F.NGW) {
        const int kb = it / nblk, nb = it % nblk, n0 = nb * 32, k0 = kb * 64;
        const int drow = mode == 0 ? n0 : ((n0 >> 7) * 256 + (n0 & 127) + (mode == 2 ? 128 : 0));
        xpose_item(W, N, k0, n0, WT + (size_t)drow * ldk + k0, ldk, scr, F.lane);
    }
    gbase += (unsigned)nitems;
}
__device__ __forceinline__ void cvt_rows(const Frame& F, const float* in, bf16* out, size_t n8) {
    for (size_t i = (size_t)blockIdx.x * 512 + F.tid; i < n8; i += (size_t)F.G * 512) {
        const f32x4 a = *(const f32x4*)(in + i * 8), b = *(const f32x4*)(in + i * 8 + 4);
        v4u w; w.x = pk2(a[0], a[1]); w.y = pk2(a[2], a[3]); w.z = pk2(b[0], b[1]); w.w = pk2(b[2], b[3]);
        *(v4u*)(out + i * 8) = w; }
}
__device__ __forceinline__ void cvt_router(const Frame& F, const float* rw, unsigned char* ws) {
    for (int i = blockIdx.x * 512 + F.tid; i < 2 * D * NE; i += F.G * 512) { const int l = i / (D * NE), k = (i / NE) % D, e = i % NE;
        const float w = rw[i]; const bf16 h = f2bf(w); const bf16 lo = f2bf(w - bf2f(h));
        bf16* dst = (bf16*)(ws + WS_RW + l * RW_L); dst[(size_t)e * D + k] = h; dst[(size_t)(NE + e) * D + k] = lo; }
}
struct XItem { const float* src; bf16* dst; int N, ldk; };
__device__ __forceinline__ void xp_decode(int I, const float* wg, const float* wu, const float* wd, const float* sg, const float* su, const float* sd, unsigned char* ws, XItem& x) {
    const int e = I / 1536, rem = I % 1536, m = rem >> 9, it = rem & 511;
    if (m < 2) { const float* W = m == 0 ? (e < NE ? wg + (size_t)e * D * EH : sg) : (e < NE ? wu + (size_t)e * D * EH : su);
        const int kb = it >> 4, nb = it & 15, n0 = nb * 32, k0 = kb * 64; const int drow = (n0 >> 7) * 256 + (n0 & 127) + (m == 1 ? 128 : 0);
        x.src = W + (size_t)k0 * EH + n0; x.N = EH; x.ldk = D; x.dst = (bf16*)(ws + WS_WGU + (size_t)e * WGU_E) + (size_t)drow * D + k0; }
    else { const float* W = e < NE ? wd + (size_t)e * EH * D : sd; const int kb = it >> 6, nb = it & 63, n0 = nb * 32, k0 = kb * 64;
        x.src = W + (size_t)k0 * D + n0; x.N = D; x.ldk = EH; x.dst = (bf16*)(ws + WS_WDN + (size_t)e * WDN_E) + (size_t)n0 * EH + k0; }
}
__device__ __forceinline__ void xp_load(const XItem& x, int lane, f32x4 (&v)[8]) {
    const int kk = lane >> 3, nn = (lane & 7) * 4;
#pragma unroll
    for (int i = 0; i < 8; ++i) v[i] = __builtin_nontemporal_load((const f32x4*)(x.src + (size_t)(kk + 8 * i) * x.N + nn));
}
__device__ __forceinline__ void xp_store(const XItem& x, const f32x4 (&v)[8], LAS float* scr, int lane) {
    const int kk = lane >> 3, nn = (lane & 7) * 4;
#pragma unroll
    for (int i = 0; i < 8; ++i) { LAS float* s = scr + (kk + 8 * i) * 33 + nn; s[0] = v[i][0]; s[1] = v[i][1]; s[2] = v[i][2]; s[3] = v[i][3]; }
    LDS_WAIT(); asm volatile("" ::: "memory");
    const int c = lane & 7;
#pragma unroll
    for (int j = 0; j < 4; ++j) { const int n = (lane >> 3) + 8 * j; const LAS float* s = scr + (8 * c) * 33 + n;
        v4u o; o.x = pk2(s[0 * 33], s[1 * 33]); o.y = pk2(s[2 * 33], s[3 * 33]); o.z = pk2(s[4 * 33], s[5 * 33]); o.w = pk2(s[6 * 33], s[7 * 33]);
        __builtin_nontemporal_store(o, (v4u*)(x.dst + (size_t)n * x.ldk + 8 * c)); }
    LDS_WAIT(); asm volatile("" ::: "memory");
}
__device__ __forceinline__ void cvt_experts(const Frame& F, const float* wg, const float* wu, const float* wd, const float* sg, const float* su, const float* sd, unsigned char* ws, unsigned& gbase) {
    (void)gbase;
    LAS float* scr = (LAS float*)(F.lds + RING_OFF + F.wave * 8704);
    const int total = (NE + 1) * 1536;
    XItem A, B; f32x4 va[8], vb[8];
    int I = F.gw;
    if (I < total) { xp_decode(I, wg, wu, wd, sg, su, sd, ws, A); xp_load(A, F.lane, va); }
    for (; I < total; I += 2 * F.NGW) {
        const int I2 = I + F.NGW, I3 = I + 2 * F.NGW;
        if (I2 < total) { xp_decode(I2, wg, wu, wd, sg, su, sd, ws, B); xp_load(B, F.lane, vb); }
        xp_store(A, va, scr, F.lane);
        if (I2 < total) { if (I3 < total) { xp_decode(I3, wg, wu, wd, sg, su, sd, ws, A); xp_load(A, F.lane, va); }
            xp_store(B, vb, scr, F.lane); }
    }
}
constexpr int NVO_OFF = MISC_OFF + 1024;  static_assert(NVO_OFF == pg8::PG8_NVO_OFF, "nvo");
constexpr int PLAN_OFF = NVO_OFF + 8192;
constexpr int PLAN_TB = PLAN_OFF, PLAN_CN = PLAN_OFF + 66 * 4, PLAN_TE = PLAN_OFF + 132 * 4;
constexpr int MAXTILES = 640;
#ifndef ROUTE_PROBE
#define ROUTE_PROBE 0
#endif
static_assert(PLAN_TE + MAXTILES * 4 <= LDS_BYTES, "LDS map");

__device__ __forceinline__ float wave_sum(float v, int lane) {
#pragma unroll
    for (int o = 1; o < 64; o <<= 1) v += shx(v, o, lane);
    return v;
}
__device__ __forceinline__ void moe_plan(const Frame& F, const unsigned* cnt) {
    LAS unsigned* tb = (LAS unsigned*)(F.lds + PLAN_TB); LAS unsigned* cn = (LAS unsigned*)(F.lds + PLAN_CN); LAS unsigned* te = (LAS unsigned*)(F.lds + PLAN_TE);
    __syncthreads();
    if (F.tid <= NE) { unsigned run = 0; for (int e = 0; e < F.tid; ++e) run += (__hip_atomic_load(cnt + e, RLX_AGENT) + 255u) >> 8;
        tb[F.tid] = run; cn[F.tid] = F.tid < NE ? __hip_atomic_load(cnt + F.tid, RLX_AGENT) : (unsigned)NTOK; if (F.tid == NE) tb[NE + 1] = run + NTOK / 256; }
    __syncthreads();
    for (int t = F.tid; t < MAXTILES; t += NWAVES * 64) { unsigned e = 0; for (int q = 1; q <= NE; ++q) if (tb[q] <= (unsigned)t) e = q; te[t] = e; }
    __syncthreads();
}
template <bool GU> struct MoeSched { static constexpr bool GATHER = GU;
    const LAS unsigned* tb; const LAS unsigned* cn; const LAS unsigned* te; int nunits, nN, G, c; const char* Abase; const char* Bbase; const int* list;
    __device__ __forceinline__ void init(const Frame& F, const void* A_, const void* B_, const int* list_) {
        tb = (const LAS unsigned*)(F.lds + PLAN_TB); cn = (const LAS unsigned*)(F.lds + PLAN_CN); te = (const LAS unsigned*)(F.lds + PLAN_TE);
        nN = GU ? 4 : 8; nunits = (int)tb[NE + 1] * nN; G = F.G; const int bx = blockIdx.x; c = (G % 8 == 0) ? (bx % 8) * (G / 8) + bx / 8 : bx;
        Abase = (const char*)A_; Bbase = (const char*)B_; list = list_; }
    __device__ __forceinline__ bool next(int i, Unit& u) const {
        constexpr int RUN = GU ? 2 : 4; const int hs = c + G * (i / RUN), per = nN / RUN;
        const int tile = hs / per, pn = (hs % per) * RUN + (i % RUN); if (tile * nN >= nunits) return false;
        const int e = (int)te[tile];
        u.pm = tile; u.pn = pn;
        if (GU) { u.A = Abase; u.B = Bbase + (size_t)e * WGU_E + (size_t)pn * 256 * D * 2; u.list = e < NE ? list + (size_t)e * LISTCAP : nullptr; u.m0 = (tile - (int)tb[e]) * 256; u.cnt = (int)cn[e]; }
        else { u.A = Abase + (size_t)tile * 256 * EH * 2; u.B = Bbase + (size_t)e * WDN_E + (size_t)pn * 256 * EH * 2; u.list = nullptr; u.m0 = 0; u.cnt = 0; }
        return true; }
    __device__ __forceinline__ int avload(const Unit& u, int h, int R) const { const int pos = u.m0 + h * 128 + R; const int pc = pos < u.cnt ? pos : (u.cnt > 0 ? u.cnt - 1 : 0); const int* lp = u.list ? u.list : list; return lp[pc]; }
    __device__ __forceinline__ unsigned avfin(const Unit& u, int h, int R, int C, int K_, int v) const { const int pos = u.m0 + h * 128 + R; int row = u.list ? v : pos; row = pos < u.cnt ? row : 0; return (unsigned)((row * K_ + C) * 2); }
    __device__ __forceinline__ unsigned avoff(const Unit& u, int h, int R, int C, int K_) const {
        if (GU) return avfin(u, h, R, C, K_, avload(u, h, R));
        else return (unsigned)(((h * 128 + R) * K_ + C) * 2); }
};
struct EpiSwiGLU { static constexpr bool PERM = true, INPLACE = false; bf16* H;
    __device__ __forceinline__ void operator()(const Acc& acc, const Unit& u, int wr, int wc, int fr, int fq) const {
        const int row0 = u.pm * 256 + wr * 64 + fr, col0 = u.pn * 128 + wc * 32 + 8 * fq;
#pragma unroll
        for (int ai = 0; ai < 2; ++ai)
#pragma unroll
            for (int m = 0; m < 4; ++m) { bf16* rowp = H + (size_t)(row0 + ai * 128 + m * 16) * EH + col0;
                float hv[8];
#pragma unroll
                for (int n = 0; n < 2; ++n)
#pragma unroll
                    for (int j = 0; j < 4; ++j) { const float g = acc[ai][0][m][n][j], uu = acc[ai][1][m][n][j]; hv[n * 4 + j] = g * pg8::sigmoidf_(g) * uu; }
                v4u w; w.x = pk2(hv[0], hv[1]); w.y = pk2(hv[2], hv[3]); w.z = pk2(hv[4], hv[5]); w.w = pk2(hv[6], hv[7]);
                *(v4u*)rowp = w; }
    }
};

struct EpiY8 { static constexpr bool PERM = true, INPLACE = false; unsigned char* Y8; bf16* YS;
    __device__ __forceinline__ void operator()(const Acc& acc, const Unit& u, int wr, int wc, int fr, int fq) const {
        const int row0 = u.pm * 256 + wr * 64 + fr, pos0 = u.pn * 256 + wc * 64 + fq * 16;
#pragma unroll
        for (int ai = 0; ai < 2; ++ai)
#pragma unroll
            for (int m = 0; m < 4; ++m) { const size_t row = (size_t)(row0 + ai * 128 + m * 16);
                v4u w; unsigned sw = 0u;
#pragma unroll
                for (int bj = 0; bj < 2; ++bj) { const f32x4 v0 = acc[ai][bj][m][0], v1 = acc[ai][bj][m][1];
                    const float am = fmaxf(fmaxf(fmaxf(fabsf(v0[0]), fabsf(v0[1])), fmaxf(fabsf(v0[2]), fabsf(v0[3]))), fmaxf(fmaxf(fabsf(v1[0]), fabsf(v1[1])), fmaxf(fabsf(v1[2]), fabsf(v1[3]))));
                    const unsigned sb = f2bf(am * (1.f / 127.f)); const float sc = __uint_as_float(sb << 16); const float inv = sc > 0.f ? __builtin_amdgcn_rcpf(sc) : 0.f;
                    unsigned q[8];
#pragma unroll
                    for (int j = 0; j < 4; ++j) { q[j] = (unsigned)fminf(rintf(v0[j] * inv + 128.f), 255.f); q[4 + j] = (unsigned)fminf(rintf(v1[j] * inv + 128.f), 255.f); }
                    const unsigned lo = q[0] | (q[1] << 8) | (q[2] << 16) | (q[3] << 24), hi = q[4] | (q[5] << 8) | (q[6] << 16) | (q[7] << 24);
                    if (bj == 0) { w.x = lo; w.y = hi; sw = sb; } else { w.z = lo; w.w = hi; sw |= sb << 16; } }
                *(v4u*)(Y8 + row * D + pos0) = w; *(unsigned*)(YS + row * (D / 8) + (pos0 >> 3)) = sw; }
    }
};
__device__ __forceinline__ void route_phase(const Frame& F, const bf16* __restrict__ Z, const float* __restrict__ g, const float* __restrict__ bb, const bf16* __restrict__ rwh, const float* __restrict__ rb,
                                            bf16* __restrict__ X1L, bf16* __restrict__ X1BF, unsigned* cnt, int* list, int* tokslot, float* tokw, bool dispatch = true) {
    LAS float* part = (LAS float*)(F.lds + RING_OFF);
    LAS float* lg = part + 4 * 4096;
    LAS float* sl = lg + 64 * 65;
    LAS unsigned* cntL = (LAS unsigned*)(sl + 64 * 65);
    LAS unsigned* baseL = cntL + 64;
    LAS unsigned* ee = baseL + 64;
    LAS unsigned* pl = ee + 512;
    LAS float* ww = (LAS float*)(pl + 512);
    for (int grp = blockIdx.x; grp < NTOK / 64; grp += F.G) {
        const int t0 = grp * 64;
        if (F.tid < 64) cntL[F.tid] = 0u;
        for (int rp_ = 0; rp_ < (ROUTE_PROBE == 1 ? 2 : 1); ++rp_)
#pragma unroll 2
        for (int q = 0; q < 8; ++q) {
            const int t = t0 + F.wave * 8 + q;
            const v2u* zr = (const v2u*)(Z + (size_t)t * D) + F.lane;
            f32x4 v[8]; float s = 0.f;
#pragma unroll
            for (int j = 0; j < 8; ++j) { const v2u zw = zr[64 * j]; v[j] = (f32x4){pg8::bf_lo(zw.x), pg8::bf_hi(zw.x), pg8::bf_lo(zw.y), pg8::bf_hi(zw.y)}; s += (v[j][0] + v[j][1]) + (v[j][2] + v[j][3]); }
            const float mean = wave_sum(s, F.lane) * (1.f / D); float s2 = 0.f;
#pragma unroll
            for (int j = 0; j < 8; ++j) { v[j] = v[j] - mean; s2 += (v[j][0] * v[j][0] + v[j][1] * v[j][1]) + (v[j][2] * v[j][2] + v[j][3] * v[j][3]); }
            const float rstd = 1.f / sqrtf(wave_sum(s2, F.lane) * (1.f / D) + LN_EPS);
            v2u* xl = (v2u*)(X1L + (size_t)t * D) + F.lane; v2u* xb = (v2u*)(X1BF + (size_t)t * D) + F.lane;
#pragma unroll
            for (int j = 0; j < 8; ++j) { const f32x4 gg = ((const f32x4*)g)[F.lane + 64 * j], bv = ((const f32x4*)bb)[F.lane + 64 * j];
                const f32x4 y = v[j] * rstd * gg + bv; v2u w; w.x = pk2(y[0], y[1]); w.y = pk2(y[2], y[3]); xb[64 * j] = w;
                v2u lo; lo.x = pk2(y[0] - pg8::bf_lo(w.x), y[1] - pg8::bf_hi(w.x)); lo.y = pk2(y[2] - pg8::bf_lo(w.y), y[3] - pg8::bf_hi(w.y)); xl[64 * j] = lo; }
        }
        VM_WAIT(); __syncthreads();
        for (int rp_ = 0; rp_ < (ROUTE_PROBE == 2 ? 2 : 1); ++rp_)
        { const int r = F.lane & 15, kq = F.lane >> 4, kb = (F.wave & 3) * 512, th = F.wave >> 2;
          const bf16* xh = X1BF + (size_t)(t0 + th * 32 + r) * D + kb + 8 * kq;
          const bf16* xl = X1L + (size_t)(t0 + th * 32 + r) * D + kb + 8 * kq;
          const bf16* wh = rwh + (size_t)r * D + kb + 8 * kq;
          f32x4 acc[2][4];
#pragma unroll
          for (int tt = 0; tt < 2; ++tt)
#pragma unroll
              for (int nb = 0; nb < 4; ++nb) acc[tt][nb] = (f32x4){0.f, 0.f, 0.f, 0.f};
          bf16x8 xA[2][2], xB[2][2]; bf16x8 hA[4], lA[4], hB[4], lB[4];
#define RT_LOAD(X, H, L, ks) do { const int k_ = ((ks) < 16 ? (ks) : 15) * 32; _Pragma("unroll") for (int tt = 0; tt < 2; ++tt) { X[tt][0] = *(const bf16x8*)(xh + (size_t)tt * 16 * D + k_); X[tt][1] = *(const bf16x8*)(xl + (size_t)tt * 16 * D + k_); } \
              _Pragma("unroll") for (int nb = 0; nb < 4; ++nb) { H[nb] = *(const bf16x8*)(wh + (size_t)nb * 16 * D + k_); L[nb] = *(const bf16x8*)(wh + (size_t)(64 + nb * 16) * D + k_); } } while (0)
#define RT_MMA(X, H, L) do { \
              _Pragma("unroll") for (int tt = 0; tt < 2; ++tt) _Pragma("unroll") for (int nb = 0; nb < 4; ++nb) acc[tt][nb] = __builtin_amdgcn_mfma_f32_16x16x32_bf16(X[tt][1], H[nb], acc[tt][nb], 0, 0, 0); \
              _Pragma("unroll") for (int tt = 0; tt < 2; ++tt) _Pragma("unroll") for (int nb = 0; nb < 4; ++nb) acc[tt][nb] = __builtin_amdgcn_mfma_f32_16x16x32_bf16(X[tt][0], L[nb], acc[tt][nb], 0, 0, 0); \
              _Pragma("unroll") for (int tt = 0; tt < 2; ++tt) _Pragma("unroll") for (int nb = 0; nb < 4; ++nb) acc[tt][nb] = __builtin_amdgcn_mfma_f32_16x16x32_bf16(X[tt][0], H[nb], acc[tt][nb], 0, 0, 0); } while (0)
          RT_LOAD(xA, hA, lA, 0);
#pragma unroll 1
          for (int ks = 0; ks < 16; ks += 2) {
              RT_LOAD(xB, hB, lB, ks + 1); RT_MMA(xA, hA, lA);
              RT_LOAD(xA, hA, lA, ks + 2); RT_MMA(xB, hB, lB);
          }
#undef RT_LOAD
#undef RT_MMA
#pragma unroll
          for (int tt = 0; tt < 2; ++tt)
#pragma unroll
              for (int nb = 0; nb < 4; ++nb)
#pragma unroll
                  for (int reg = 0; reg < 4; ++reg) part[(F.wave & 3) * 4096 + (th * 32 + tt * 16 + 4 * kq + reg) * 64 + nb * 16 + r] = acc[tt][nb][reg];
        }
        __syncthreads();
        for (int i = F.tid; i < 64 * 64; i += NWAVES * 64) { const int tk = i >> 6, e = i & 63; const float lgt = (part[i] + part[4096 + i]) + (part[8192 + i] + part[12288 + i]);
            const float sc = 1.f / (1.f + __expf(-lgt)); lg[tk * 65 + e] = sc; sl[tk * 65 + e] = sc + rb[e]; }
        __syncthreads();
        for (int rp_ = 0; rp_ < (ROUTE_PROBE == 3 ? 2 : 1); ++rp_)
        { const bool lastrp = (rp_ == (ROUTE_PROBE == 3 ? 1 : 0));
          const int tk = F.wave * 8 + (F.lane >> 3), gq = F.lane & 7, lane = F.lane;
          float sv[8], cv[8];
#pragma unroll
          for (int j = 0; j < 8; ++j) { sv[j] = sl[tk * 65 + gq * 8 + j]; cv[j] = lg[tk * 65 + gq * 8 + j]; }
          float m1 = -INFINITY, m2 = -INFINITY;
#pragma unroll
          for (int j = 0; j < 8; ++j) { const float x = sv[j]; const bool g1 = x > m1; m2 = g1 ? m1 : fmaxf(m2, x); m1 = g1 ? x : m1; }
          const float gs = m1 + m2;
          int rank = 0;
#pragma unroll
          for (int o = 1; o < 8; ++o) { const float og = shx(gs, o, lane); const int oq = gq ^ o; rank += (og > gs || (og == gs && oq < gq)) ? 1 : 0; }
          const bool gsel = rank < 4;
          unsigned used = gsel ? 0u : 0xffu;
          float wsum = 0.f; float my_sc = 0.f; int my_e = 0;
#pragma unroll
          for (int i = 0; i < 8; ++i) {
              float bv = -INFINITY, bs = 0.f; int be = 64;
#pragma unroll
              for (int j = 0; j < 8; ++j) { const bool ok = !((used >> j) & 1u) && sv[j] > bv; bv = ok ? sv[j] : bv; bs = ok ? cv[j] : bs; be = ok ? gq * 8 + j : be; }
#pragma unroll
              for (int o = 1; o < 8; o <<= 1) { const float ov = shx(bv, o, lane), os = shx(bs, o, lane); const int oe = __float_as_int(shx(__int_as_float(be), o, lane));
                  const bool tk_o = ov > bv || (ov == bv && oe < be); bv = tk_o ? ov : bv; bs = tk_o ? os : bs; be = tk_o ? oe : be; }
              if ((be >> 3) == gq) used |= 1u << (be & 7);
              wsum += bs; if (gq == i) { my_sc = bs; my_e = be; }
          }
          const int slot = tk * 8 + gq;
          ee[slot] = (unsigned)my_e; ww[slot] = my_sc * (RSCALE / wsum);
          pl[slot] = __hip_atomic_fetch_add(cntL + my_e, (dispatch && lastrp) ? 1u : 0u, __ATOMIC_RELAXED, __HIP_MEMORY_SCOPE_WORKGROUP);
        }
        __syncthreads();
        if (F.tid < 64) { const unsigned n = cntL[F.tid]; baseL[F.tid] = n ? __hip_atomic_fetch_add(cnt + F.tid, n, RLX_AGENT) : 0u; }
        __syncthreads();
        if (dispatch) { const int tk = F.tid >> 3, i = F.tid & 7; const unsigned e = ee[F.tid]; const unsigned pos = baseL[e] + pl[F.tid]; const int t = t0 + tk;
          list[(size_t)e * LISTCAP + pos] = t; tokslot[t * 8 + i] = (int)(e * LISTCAP + pos); tokw[t * 8 + i] = ww[F.tid]; }
        __syncthreads();
    }
}
__device__ __forceinline__ void combine_phase(const Frame& F, const bf16* X1B, const unsigned char* Y8, const bf16* YS, const int* tokslot, const float* tokw, const float* g, const float* bb, float* OUT, bf16* XBF, bool last) {
    const LAS unsigned* tb = (const LAS unsigned*)(F.lds + PLAN_TB);
    LAS int* rw = (LAS int*)(F.lds + RING_OFF) + F.wave * 32;
#define CB_LOAD(W, S, ROW) do { const int r_ = __builtin_amdgcn_readfirstlane(ROW); const v2u* yr_ = (const v2u*)(Y8 + (size_t)r_ * D) + F.lane; const bf16* ys_ = YS + (size_t)r_ * (D / 8) + F.lane; \
        _Pragma("unroll") for (int j = 0; j < 4; ++j) { W[j] = yr_[64 * j]; S[j] = ys_[64 * j]; } } while (0)
#define CB_ACC(W, S, WT) do { const float wt_ = __int_as_float(__builtin_amdgcn_readfirstlane(WT)); _Pragma("unroll") for (int j = 0; j < 4; ++j) { const float sc = bf2f(S[j]) * wt_, c0 = -128.f * sc; const unsigned x = W[j].x, y = W[j].y; \
        v[j][0] += sc * (float)(x & 255u) + c0; v[j][1] += sc * (float)((x >> 8) & 255u) + c0; v[j][2] += sc * (float)((x >> 16) & 255u) + c0; v[j][3] += sc * (float)(x >> 24) + c0; \
        v[j][4] += sc * (float)(y & 255u) + c0; v[j][5] += sc * (float)((y >> 8) & 255u) + c0; v[j][6] += sc * (float)((y >> 16) & 255u) + c0; v[j][7] += sc * (float)(y >> 24) + c0; } } while (0)
    const int cl = (F.lane >> 5) * 256 + (F.lane & 1) * 128 + ((F.lane >> 3) & 3) * 32 + ((F.lane >> 1) & 3) * 8;
    for (int t = F.gw; t < NTOK; t += F.NGW) {
        if (F.lane < 8) { const int sl = tokslot[t * 8 + F.lane]; rw[F.lane] = (int)tb[sl / LISTCAP] * 256 + (sl % LISTCAP); rw[16 + F.lane] = __float_as_int(tokw[t * 8 + F.lane]); }
        if (F.lane == 8) { rw[8] = (int)tb[NE] * 256 + t; rw[24] = __float_as_int(1.f); }
        LDS_WAIT(); asm volatile("" ::: "memory");
        float v[4][8]; float s = 0.f;
        v2u wa[4], wb[4], wc[4]; bf16 sa[4], sb2[4], sc2[4];
        CB_LOAD(wa, sa, rw[0]); CB_LOAD(wb, sb2, rw[1]); CB_LOAD(wc, sc2, rw[2]);
#pragma unroll
        for (int j = 0; j < 4; ++j) { const v4u xw = *(const v4u*)(X1B + (size_t)t * D + 512 * j + cl);
            v[j][0] = pg8::bf_lo(xw.x) * ALPHA; v[j][1] = pg8::bf_hi(xw.x) * ALPHA; v[j][2] = pg8::bf_lo(xw.y) * ALPHA; v[j][3] = pg8::bf_hi(xw.y) * ALPHA;
            v[j][4] = pg8::bf_lo(xw.z) * ALPHA; v[j][5] = pg8::bf_hi(xw.z) * ALPHA; v[j][6] = pg8::bf_lo(xw.w) * ALPHA; v[j][7] = pg8::bf_hi(xw.w) * ALPHA; }
#pragma unroll 1
        for (int i = 0; i < 9; i += 3) {
            CB_ACC(wa, sa, rw[16 + i]); if (i < 6) CB_LOAD(wa, sa, rw[i + 3]);
            CB_ACC(wb, sb2, rw[17 + i]); if (i < 6) CB_LOAD(wb, sb2, rw[i + 4]);
            CB_ACC(wc, sc2, rw[18 + i]); if (i < 6) CB_LOAD(wc, sc2, rw[i + 5]);
        }
        asm volatile("" ::: "memory");
#pragma unroll
        for (int j = 0; j < 4; ++j)
#pragma unroll
            for (int e = 0; e < 8; ++e) s += v[j][e];
        const float mean = wave_sum(s, F.lane) * (1.f / D); float s2 = 0.f;
#pragma unroll
        for (int j = 0; j < 4; ++j)
#pragma unroll
            for (int e = 0; e < 8; ++e) { v[j][e] -= mean; s2 += v[j][e] * v[j][e]; }
        const float rstd = 1.f / sqrtf(wave_sum(s2, F.lane) * (1.f / D) + LN_EPS);
#pragma unroll
        for (int j = 0; j < 4; ++j) { const int c0 = cl + 512 * j; const f32x4 g0 = *(const f32x4*)(g + c0), g1 = *(const f32x4*)(g + c0 + 4), b0 = *(const f32x4*)(bb + c0), b1 = *(const f32x4*)(bb + c0 + 4);
            f32x4 y0, y1;
#pragma unroll
            for (int e = 0; e < 4; ++e) { y0[e] = v[j][e] * rstd * g0[e] + b0[e]; y1[e] = v[j][4 + e] * rstd * g1[e] + b1[e]; }
            if (last) { *(f32x4*)(OUT + (size_t)t * D + c0) = y0; *(f32x4*)(OUT + (size_t)t * D + c0 + 4) = y1; }
            else { v4u w; w.x = pk2(y0[0], y0[1]); w.y = pk2(y0[2], y0[3]); w.z = pk2(y1[0], y1[1]); w.w = pk2(y1[2], y1[3]); *(v4u*)(XBF + (size_t)t * D + c0) = w; } }
    }
#undef CB_LOAD
#undef CB_ACC
}
constexpr size_t R2_UT = 0, R2_OI = 48 * MiB, R2_QP = 96 * MiB, R2_DEC = 120 * MiB;
constexpr int NHU = NB * HGH * (SEQ / 64);
typedef __attribute__((address_space(3))) bf16 lbf16;
__device__ __forceinline__ void unpack8(const v4u w, float (&f)[8]) {
    f[0] = pg8::bf_lo(w.x); f[1] = pg8::bf_hi(w.x); f[2] = pg8::bf_lo(w.y); f[3] = pg8::bf_hi(w.y); f[4] = pg8::bf_lo(w.z); f[5] = pg8::bf_hi(w.z); f[6] = pg8::bf_lo(w.w); f[7] = pg8::bf_hi(w.w); }
__device__ __forceinline__ float exp_c(float x) { return __expf(fminf(x, 80.f)); }

__device__ __forceinline__ void conv_part(const Frame& F, const bf16* proj, const float* cw, bf16* YA, bf16* YX) {
    for (int i = blockIdx.x * 512 + F.tid; i < NTOK * 32; i += F.G * 512) *(v4u*)(YX + (size_t)(i >> 5) * YXW + XAW + (i & 31) * 8) = (v4u){0u, 0u, 0u, 0u};
    for (int i = blockIdx.x * 512 + F.tid; i < NTOK * (CW / 8); i += F.G * 512) {
        const int t = i / (CW / 8), c = (i % (CW / 8)) * 8, pos = t & (SEQ - 1);
        const bf16* r = proj + (size_t)t * INC;
        float u0[8], c0[8], b0[8], u1[8], c1[8], u2[8], c2[8], w0[8], w1[8], w2[8];
        unpack8(*(const v4u*)(r + C_U + c), u0); unpack8(*(const v4u*)(r + C_C + c), c0); unpack8(*(const v4u*)(r + C_B + c), b0);
        const v4u z4 = {0u, 0u, 0u, 0u};
        unpack8(pos >= 1 ? *(const v4u*)(r - INC + C_U + c) : z4, u1); unpack8(pos >= 1 ? *(const v4u*)(r - INC + C_C + c) : z4, c1);
        unpack8(pos >= 2 ? *(const v4u*)(r - 2 * INC + C_U + c) : z4, u2); unpack8(pos >= 2 ? *(const v4u*)(r - 2 * INC + C_C + c) : z4, c2);
#pragma unroll
        for (int j = 0; j < 8; ++j) { w0[j] = cw[c + j]; w1[j] = cw[CW + c + j]; w2[j] = cw[2 * CW + c + j]; }
        float o[8];
#pragma unroll
        for (int j = 0; j < 8; ++j) o[j] = b0[j] * (w2[j] * c0[j] * u0[j] + w1[j] * c1[j] * u1[j] + w0[j] * c2[j] * u2[j]);
        v4u w; w.x = pk2(o[0], o[1]); w.y = pk2(o[2], o[3]); w.z = pk2(o[4], o[5]); w.w = pk2(o[6], o[7]);
        *(v4u*)(YA + (size_t)t * CW + c) = w;
    }
}

__device__ __forceinline__ void hgrn_local(const Frame& F, const bf16* proj, const float* lbl, int layer, unsigned char* r2) {
    lbf16* QS = (lbf16*)(F.lds);
    lbf16* KS = QS + 64 * 136;
    lbf16* KPT = KS + 64 * 136;
    lbf16* VT = KPT + 128 * 72;
    lbf16* PS = VT + 128 * 72;
    LAS float* SEG = (LAS float*)(PS + 64 * 72);
    bf16* UT = (bf16*)(r2 + R2_UT); bf16* OI = (bf16*)(r2 + R2_OI); bf16* QP = (bf16*)(r2 + R2_QP); float* DEC = (float*)(r2 + R2_DEC);
    const int lane = F.lane, wv = F.wave, r = lane & 15, kq = lane >> 4;
    bf16 rf[16], rq[16], rv[16];
#define HL_LOAD(U) do { const int b_ = (U) / (HGH * 64), h_ = ((U) / 64) % HGH, c_ = (U) % 64; const bf16* p_ = proj + (size_t)(b_ * SEQ + c_ * 64 + (F.tid >> 7) * 16) * INC + h_ * HGD + (F.tid & 127); \
        _Pragma("unroll") for (int i = 0; i < 16; ++i) { rf[i] = p_[(size_t)i * INC + C_F]; rq[i] = p_[(size_t)i * INC + C_Q]; rv[i] = p_[(size_t)i * INC + C_I]; } } while (0)
    if ((int)blockIdx.x < NHU) HL_LOAD((int)blockIdx.x);
    for (int unit = blockIdx.x; unit < NHU; unit += F.G) {
        const int b = unit / (HGH * 64), h = (unit / 64) % HGH, c = unit % 64, t0 = b * SEQ + c * 64;
        { const int col = F.tid & 127, seg = F.tid >> 7, ch = h * HGD + col;
          float lb = 0.f; if (layer == 1) lb = 1.f / (1.f + __expf(lbl[ch] - lbl[HGW + ch]));
          float a[16], kk[16], qv[16], vv[16]; float run = 0.f;
#pragma unroll
          for (int i = 0; i < 16; ++i) {
              const float z = bf2f(rf[i]); const float ez = __expf(-z); const float sg = 1.f / (1.f + ez);
              const float f = lb + (1.f - lb) * sg; kk[i] = (1.f - lb) * ez * sg; run += fmaxf(__logf(f), -60.f); a[i] = run;
              qv[i] = bf2f(rq[i]); vv[i] = bf2f(rv[i]); }
          if (unit + F.G < NHU) HL_LOAD(unit + F.G);
          SEG[seg * 128 + col] = run;
          __syncthreads();
          const float s0 = SEG[col], s1 = SEG[128 + col], s2 = SEG[256 + col], s3 = SEG[384 + col];
          const float base = seg == 0 ? 0.f : (seg == 1 ? s0 : (seg == 2 ? s0 + s1 : s0 + s1 + s2)), bm = s0 + s1, bl = (s0 + s1) + (s2 + s3);
          float kp[16];
#pragma unroll
          for (int i = 0; i < 16; ++i) { const float bb = base + a[i]; const int t = seg * 16 + i;
              QS[t * 136 + col] = f2bf(qv[i] * exp_c(bb - bm)); KS[t * 136 + col] = f2bf(kk[i] * exp_c(bm - bb)); kp[i] = kk[i] * exp_c(bl - bb);
              QP[(size_t)(t0 + t) * HGW + ch] = f2bf(qv[i] * exp_c(bb)); }
          v4u w0, w1; w0.x = pk2(kp[0], kp[1]); w0.y = pk2(kp[2], kp[3]); w0.z = pk2(kp[4], kp[5]); w0.w = pk2(kp[6], kp[7]); w1.x = pk2(kp[8], kp[9]); w1.y = pk2(kp[10], kp[11]); w1.z = pk2(kp[12], kp[13]); w1.w = pk2(kp[14], kp[15]);
          *(LAS v4u*)(KPT + col * 72 + seg * 16) = w0; *(LAS v4u*)(KPT + col * 72 + seg * 16 + 8) = w1;
          w0.x = pk2(vv[0], vv[1]); w0.y = pk2(vv[2], vv[3]); w0.z = pk2(vv[4], vv[5]); w0.w = pk2(vv[6], vv[7]); w1.x = pk2(vv[8], vv[9]); w1.y = pk2(vv[10], vv[11]); w1.z = pk2(vv[12], vv[13]); w1.w = pk2(vv[14], vv[15]);
          *(LAS v4u*)(VT + col * 72 + seg * 16) = w0; *(LAS v4u*)(VT + col * 72 + seg * 16 + 8) = w1;
          if (seg == 0) DEC[(size_t)unit * 128 + col] = exp_c(bl);
        }
        __syncthreads();
        { const int tm = wv >> 1, tn0 = (wv & 1) * 2;
          bf16x8 af[4];
#pragma unroll
          for (int ks = 0; ks < 4; ++ks) af[ks] = *(const LAS bf16x8*)(QS + (tm * 16 + r) * 136 + ks * 32 + kq * 8);
#pragma unroll
          for (int jn = 0; jn < 2; ++jn) { const int tn = tn0 + jn; f32x4 acc = {0.f, 0.f, 0.f, 0.f};
              if (tn <= tm) {
#pragma unroll
                  for (int ks = 0; ks < 4; ++ks) { const bf16x8 bf = *(const LAS bf16x8*)(KS + (tn * 16 + r) * 136 + ks * 32 + kq * 8); acc = __builtin_amdgcn_mfma_f32_16x16x32_bf16(af[ks], bf, acc, 0, 0, 0); } }
#pragma unroll
              for (int g = 0; g < 4; ++g) { const int t = tm * 16 + 4 * kq + g, s = tn * 16 + r; PS[t * 72 + s] = f2bf(s <= t ? acc[g] : 0.f); } } }
        { bf16x8 af[2];
#pragma unroll
          for (int ks = 0; ks < 2; ++ks) af[ks] = *(const LAS bf16x8*)(KPT + (wv * 16 + r) * 72 + ks * 32 + kq * 8);
#pragma unroll
          for (int tv = 0; tv < 8; ++tv) { f32x4 acc = {0.f, 0.f, 0.f, 0.f};
#pragma unroll
              for (int ks = 0; ks < 2; ++ks) { const bf16x8 bf = *(const LAS bf16x8*)(VT + (tv * 16 + r) * 72 + ks * 32 + kq * 8); acc = __builtin_amdgcn_mfma_f32_16x16x32_bf16(af[ks], bf, acc, 0, 0, 0); }
              v2u w; w.x = pk2(acc[0], acc[1]); w.y = pk2(acc[2], acc[3]);
              *(v2u*)(UT + (size_t)unit * 16384 + (tv * 16 + r) * 128 + wv * 16 + 4 * kq) = w; } }
        __syncthreads();
        { const int tm = wv & 3, tvg = wv >> 2;
          bf16x8 pf[2];
#pragma unroll
          for (int ks = 0; ks < 2; ++ks) pf[ks] = *(const LAS bf16x8*)(PS + (tm * 16 + r) * 72 + ks * 32 + kq * 8);
#pragma unroll
          for (int j = 0; j < 4; ++j) { const int tv = tvg * 4 + j; f32x4 acc = {0.f, 0.f, 0.f, 0.f};
#pragma unroll
              for (int ks = 0; ks < 2; ++ks) { const bf16x8 vf = *(const LAS bf16x8*)(VT + (tv * 16 + r) * 72 + ks * 32 + kq * 8); acc = __builtin_amdgcn_mfma_f32_16x16x32_bf16(vf, pf[ks], acc, 0, 0, 0); }
              v2u ow; ow.x = pk2(acc[0], acc[1]); ow.y = pk2(acc[2], acc[3]); *(v2u*)(OI + (size_t)(t0 + tm * 16 + r) * HGW + h * HGD + tv * 16 + 4 * kq) = ow; } }
        __syncthreads();
    }
#undef HL_LOAD
}
__device__ __forceinline__ void hgrn_scan(const Frame& F, const unsigned char* r2, v2u* __restrict__ SB64) {
    const v2u* __restrict__ UT64 = (const v2u*)(r2 + R2_UT); const f32x4* __restrict__ DEC4 = (const f32x4*)(r2 + R2_DEC);
    for (int it = blockIdx.x * 512 + F.tid; it < NB * HGH * 128 * 32; it += F.G * 512) {
        const int bh = it >> 12, v = (it >> 5) & 127, k4 = it & 31;
        f32x4 s = {0.f, 0.f, 0.f, 0.f};
#pragma unroll 8
        for (int c = 0; c < 64; ++c) { const size_t unit = (size_t)bh * 64 + c; const size_t idx = unit * 4096 + v * 32 + k4;
            const v2u w = UT64[idx]; const f32x4 d = DEC4[unit * 32 + k4];
            v2u o; o.x = pk2(s[0], s[1]); o.y = pk2(s[2], s[3]); SB64[idx] = o;
            s[0] = d[0] * s[0] + pg8::bf_lo(w.x); s[1] = d[1] * s[1] + pg8::bf_hi(w.x); s[2] = d[2] * s[2] + pg8::bf_lo(w.y); s[3] = d[3] * s[3] + pg8::bf_hi(w.y); }
    }
}
struct HoutOps { bf16x8 af[4]; bf16x8 bfr[4][4]; };
__device__ __forceinline__ void hout_load(HoutOps& O, int unit, const bf16* proj, const bf16* OI, const bf16* QP, const bf16* SB, int r, int kq, int tm, int tvg) {
    const int b = unit / (HGH * 64), h = (unit / 64) % HGH, c = unit % 64, t0 = b * SEQ + c * 64;
#pragma unroll
    for (int ks = 0; ks < 4; ++ks) O.af[ks] = *(const bf16x8*)(QP + (size_t)(t0 + tm * 16 + r) * HGW + h * HGD + ks * 32 + kq * 8);
#pragma unroll
    for (int j = 0; j < 4; ++j)
#pragma unroll
        for (int ks = 0; ks < 4; ++ks) O.bfr[j][ks] = *(const bf16x8*)(SB + (size_t)unit * 16384 + ((tvg * 4 + j) * 16 + r) * 128 + ks * 32 + kq * 8);
}
__device__ __forceinline__ void hout_compute(const HoutOps& O, int unit, const bf16* proj, const bf16* OI, LAS float* SSQ, const float* gain, bf16* YB, int lane, int r, int kq, int tm, int tvg) {
    const int b = unit / (HGH * 64), h = (unit / 64) % HGH, c = unit % 64, t0 = b * SEQ + c * 64;
    const size_t t = (size_t)(t0 + tm * 16 + r);
    f32x4 oi[4]; v2u gtw[4];
#pragma unroll
    for (int j = 0; j < 4; ++j) { const int ch = h * HGD + (tvg * 4 + j) * 16 + 4 * kq; { const v2u ow = *(const v2u*)(OI + t * HGW + ch); oi[j] = (f32x4){pg8::bf_lo(ow.x), pg8::bf_hi(ow.x), pg8::bf_lo(ow.y), pg8::bf_hi(ow.y)}; } gtw[j] = *(const v2u*)(proj + t * INC + C_G + ch); }
    f32x4 acc[4]; float q = 0.f;
#pragma unroll
    for (int j = 0; j < 4; ++j) { acc[j] = (f32x4){0.f, 0.f, 0.f, 0.f};
#pragma unroll
        for (int ks = 0; ks < 4; ++ks) acc[j] = __builtin_amdgcn_mfma_f32_16x16x32_bf16(O.bfr[j][ks], O.af[ks], acc[j], 0, 0, 0); }
#pragma unroll
    for (int j = 0; j < 4; ++j) { acc[j] += oi[j]; q += (acc[j][0] * acc[j][0] + acc[j][1] * acc[j][1]) + (acc[j][2] * acc[j][2] + acc[j][3] * acc[j][3]); }
    q += shx(q, 16, lane); q += shx(q, 32, lane);
    if (kq == 0) SSQ[tvg * 64 + tm * 16 + r] = q;
    __syncthreads();
    const float rs = rsqrtf((SSQ[tm * 16 + r] + SSQ[64 + tm * 16 + r]) * (1.f / 128.f) + RMS_EPS);
#pragma unroll
    for (int j = 0; j < 4; ++j) { const int ch = h * HGD + (tvg * 4 + j) * 16 + 4 * kq; const f32x4 gn = *(const f32x4*)(gain + ch);
        const float g0 = pg8::bf_lo(gtw[j].x), g1 = pg8::bf_hi(gtw[j].x), g2 = pg8::bf_lo(gtw[j].y), g3 = pg8::bf_hi(gtw[j].y);
        v2u w; w.x = pk2(acc[j][0] * rs * gn[0] * g0 * pg8::sigmoidf_(g0), acc[j][1] * rs * gn[1] * g1 * pg8::sigmoidf_(g1));
        w.y = pk2(acc[j][2] * rs * gn[2] * g2 * pg8::sigmoidf_(g2), acc[j][3] * rs * gn[3] * g3 * pg8::sigmoidf_(g3));
        *(v2u*)(YB + t * HGW + ch) = w; }
    __syncthreads();
}
__device__ __forceinline__ void hgrn_out(const Frame& F, const bf16* proj, const unsigned char* r2, const bf16* SB, const float* gain, bf16* YB) {
    LAS float* SSQ = (LAS float*)F.lds;
    const bf16* OI = (const bf16*)(r2 + R2_OI); const bf16* QP = (const bf16*)(r2 + R2_QP);
    const int lane = F.lane, wv = F.wave, r = lane & 15, kq = lane >> 4, tm = wv & 3, tvg = wv >> 2;
    HoutOps A, B;
    int unit = blockIdx.x;
    if (unit < NHU) hout_load(A, unit, proj, OI, QP, SB, r, kq, tm, tvg);
    for (; unit < NHU; unit += 2 * F.G) {
        const int u2 = unit + F.G, u3 = unit + 2 * F.G;
        if (u2 < NHU) hout_load(B, u2, proj, OI, QP, SB, r, kq, tm, tvg);
        hout_compute(A, unit, proj, OI, SSQ, gain, YB, lane, r, kq, tm, tvg);
        if (u2 < NHU) { if (u3 < NHU) hout_load(A, u3, proj, OI, QP, SB, r, kq, tm, tvg);
            hout_compute(B, u2, proj, OI, SSQ, gain, YB, lane, r, kq, tm, tvg); }
    }
}
__device__ __forceinline__ void memattn(const Frame& F, const bf16* proj, const bf16* KV, int layer, bf16* YX) {
    lbf16* Ks = (lbf16*)F.lds;
    lbf16* VTs = Ks + 256 * 136;
    const int lane = F.lane, wv = F.wave, r = lane & 15, kq = lane >> 4;
    for (int unit = blockIdx.x; unit < NB * XAH * (SEQ / 256); unit += F.G) {
        const int b = unit >> 6, hd = (unit >> 4) & 3, qt = unit & 15;
#pragma unroll
        for (int i = 0; i < 8; ++i) { const int p = F.tid + 512 * i, key = p >> 4, dc = (p & 15) * 8;
            const bf16* src = KV + (size_t)(b * NMEM + key) * 2048 + layer * 1024 + hd * XAD + dc;
            *(LAS v4u*)(Ks + key * 136 + dc) = *(const v4u*)src;
            const v4u w = *(const v4u*)(src + 512);
            const int k5 = key & 31, pos = (key & ~31) + 8 * ((k5 >> 2) & 3) + 4 * ((k5 >> 4) & 1) + (k5 & 3);
            lbf16* d = VTs + dc * 264 + pos;
            d[0] = (bf16)(w.x & 0xffffu); d[264] = (bf16)(w.x >> 16); d[2 * 264] = (bf16)(w.y & 0xffffu); d[3 * 264] = (bf16)(w.y >> 16);
            d[4 * 264] = (bf16)(w.z & 0xffffu); d[5 * 264] = (bf16)(w.z >> 16); d[6 * 264] = (bf16)(w.w & 0xffffu); d[7 * 264] = (bf16)(w.w >> 16); }
        __syncthreads();
#pragma unroll 1
        for (int g = 0; g < 2; ++g) {
            const int t = b * SEQ + qt * 256 + wv * 32 + g * 16 + r;
            bf16x8 qf[4];
#pragma unroll
            for (int ks = 0; ks < 4; ++ks) qf[ks] = *(const bf16x8*)(proj + (size_t)t * INC + C_QX + hd * XAD + ks * 32 + kq * 8);
            f32x4 s[16];
#pragma unroll
            for (int kt = 0; kt < 16; ++kt) { s[kt] = (f32x4){0.f, 0.f, 0.f, 0.f};
#pragma unroll
                for (int ks = 0; ks < 4; ++ks) { const bf16x8 a = *(const LAS bf16x8*)(Ks + (kt * 16 + r) * 136 + ks * 32 + kq * 8); s[kt] = __builtin_amdgcn_mfma_f32_16x16x32_bf16(a, qf[ks], s[kt], 0, 0, 0); }
                if (kt & 1) __builtin_amdgcn_sched_barrier(0); }
            float m = -1e30f;
#pragma unroll
            for (int kt = 0; kt < 16; ++kt) m = fmaxf(m, fmaxf(fmaxf(s[kt][0], s[kt][1]), fmaxf(s[kt][2], s[kt][3])));
            m = fmaxf(m, shx(m, 16, lane)); m = fmaxf(m, shx(m, 32, lane));
            const float cs = 0.08838834764831845f * 1.4426950408889634f; float l = 0.f;
#pragma unroll
            for (int kt = 0; kt < 16; ++kt)
#pragma unroll
                for (int e = 0; e < 4; ++e) { const float p = __builtin_amdgcn_exp2f((s[kt][e] - m) * cs); s[kt][e] = p; l += p; }
            l += shx(l, 16, lane); l += shx(l, 32, lane);
            f32x4 o[8];
#pragma unroll
            for (int dt = 0; dt < 8; ++dt) o[dt] = (f32x4){0.f, 0.f, 0.f, 0.f};
#pragma unroll
            for (int j = 0; j < 8; ++j) {
                v4u pw; pw.x = pk2(s[2 * j][0], s[2 * j][1]); pw.y = pk2(s[2 * j][2], s[2 * j][3]); pw.z = pk2(s[2 * j + 1][0], s[2 * j + 1][1]); pw.w = pk2(s[2 * j + 1][2], s[2 * j + 1][3]);
                const bf16x8 pf = __builtin_bit_cast(bf16x8, pw);
#pragma unroll
                for (int dt = 0; dt < 8; ++dt) { const bf16x8 a = *(const LAS bf16x8*)(VTs + (dt * 16 + r) * 264 + j * 32 + kq * 8); o[dt] = __builtin_amdgcn_mfma_f32_16x16x32_bf16(a, pf, o[dt], 0, 0, 0); }
                __builtin_amdgcn_sched_barrier(0); }
            const float inv = 1.f / l;
#pragma unroll
            for (int dt = 0; dt < 8; ++dt) { v2u w; w.x = pk2(o[dt][0] * inv, o[dt][1] * inv); w.y = pk2(o[dt][2] * inv, o[dt][3] * inv);
                *(v2u*)(YX + (size_t)t * YXW + hd * XAD + dt * 16 + 4 * kq) = w; }
        }
        __syncthreads();
    }
}
struct Args { const float* in[24]; float* out; unsigned char* ws; int ph_lo, ph_hi, mask, pad; };
typedef const __attribute__((address_space(4))) Args* KArgs;
__device__ __forceinline__ KArgs kargs() { KArgs p = (KArgs)__builtin_amdgcn_kernarg_segment_ptr(); asm volatile("" : "+s"(p)); return p; }
#define WSP(T, off) ((T*)(ws + (off)))
__global__ void __launch_bounds__(NWAVES * 64, 2) mk_fwd(Args args) {
    extern __shared__ __attribute__((aligned(16))) unsigned char lds_raw[];
    Frame F0; F0.lds = (LAS unsigned char*)lds_raw; F0.tid = threadIdx.x; F0.lane = F0.tid & 63; F0.wave = __builtin_amdgcn_readfirstlane(F0.tid >> 6);
    F0.G = gridDim.x; F0.gw = blockIdx.x * NWAVES + F0.wave; F0.NGW = F0.G * NWAVES;
    volatile LAS unsigned* MISC = (volatile LAS unsigned*)(F0.lds + MISC_OFF);
    for (int u = F0.tid; u < (LDS_BYTES - MISC_OFF) / 4; u += NWAVES * 64) ((LAS unsigned*)(F0.lds + MISC_OFF))[u] = 0u;
    __syncthreads();
    const int lo = args.ph_lo, hi = args.ph_hi;
    const bool multi = (hi - lo) > 1;
    XcdBarrier bar; bar.bar = (unsigned*)(args.ws + WS_CTL) + CW_BAR; bar.x = 0; bar.st = nullptr;
    if (multi) bar = xcd_barrier_post((unsigned*)(args.ws + WS_CTL) + CW_BAR, MISC + 8);
#define IN(k) (lo <= (k) && (k) < hi)
#define SEAM(k) do { if (IN((k) + 1)) xcd_barrier(bar); } while (0)
#define PH_BEGIN KArgs ka = kargs(); unsigned char* ws = ka->ws; (void)ws; Frame F = F0; F.lane = pg8::lane_id_opaque(); F.tid = F0.wave * 64 + F.lane
    if (IN(PH_CVT)) {
        { PH_BEGIN;
        unsigned gb = 0;
        for (int l = 0; l < 2; ++l) {
            xpose_matrix(F, ka->in[2] + (size_t)l * D * INC, D, INC, (bf16*)(ws + WS_WIN_T + l * WIN_T_L), D, 0, gb);
            xpose_matrix(F, ka->in[4] + (size_t)l * CW * D, CW, D, (bf16*)(ws + WS_WBR_T + l * WBR_T_L), CW, 0, gb);
            xpose_matrix(F, ka->in[7] + (size_t)l * HGW * D, HGW, D, (bf16*)(ws + WS_WBR_T + l * WBR_T_L + 3 * MiB), HGW, 0, gb);
            xpose_matrix(F, ka->in[10] + (size_t)l * XAW * D, XAW, D, (bf16*)(ws + WS_WBR_T + l * WBR_T_L + 6 * MiB), YXW, 0, gb);
            for (int i = blockIdx.x * 512 + F.tid; i < D * 32; i += F.G * 512) *(v4u*)((bf16*)(ws + WS_WBR_T + l * WBR_T_L + 6 * MiB) + (size_t)(i >> 5) * YXW + XAW + (i & 31) * 8) = (v4u){0u, 0u, 0u, 0u};
            xpose_matrix(F, ka->in[11] + (size_t)l * D * D, D, D, (bf16*)(ws + WS_WO_T + l * WO_T_L), D, 0, gb);
            xpose_matrix(F, ka->in[8] + (size_t)l * D * XAW, D, XAW, (bf16*)(ws + WS_WKV_T) + (size_t)(l * 1024) * D, D, 0, gb);
            xpose_matrix(F, ka->in[9] + (size_t)l * D * XAW, D, XAW, (bf16*)(ws + WS_WKV_T) + (size_t)(l * 1024 + 512) * D, D, 0, gb);
        }
        cvt_router(F, ka->in[14], ws);
        cvt_rows(F, ka->in[0], WSP(bf16, WS_XBF), (size_t)NTOK * D / 8);
        cvt_rows(F, ka->in[1], WSP(bf16, WS_MEMBF), (size_t)NB * NMEM * D / 8);
        }
        SEAM(PH_CVT);
    }
    for (int l = 0; l < 2; ++l) {
        const int pb = PH_L0 + l * PH_PER_LAYER;
        if (IN(pb + P_INPROJ)) {
            { PH_BEGIN;
            const bool split = F.G == 256;
            const int oa = (int)blockIdx.x >> 3, ox = (int)blockIdx.x & 7; const bool conv = split && (oa & 3) == 3;
            const int hrank = 8 * (oa >> 2) + ox, grank = 8 * (oa - ((oa + 1) >> 2)) + ox;
            static_assert((256 - NCV) * GM_UNITS + NCV * CV_UNITS == (NTOK / 256) * (INC / 256), "in-projection unit shares");
            if (conv) { Frame Fc = F; Fc.gw = hrank * NWAVES + F.wave; Fc.NGW = NCV * NWAVES; unsigned gb = 0;
                cvt_experts(Fc, ka->in[16] + (size_t)l * NE * D * EH, ka->in[17] + (size_t)l * NE * D * EH, ka->in[18] + (size_t)l * NE * EH * D, ka->in[19] + (size_t)l * D * EH, ka->in[20] + (size_t)l * D * EH, ka->in[21] + (size_t)l * EH * D, ws, gb);
                __syncthreads(); }
            if (!split) { unsigned gb = 0; cvt_experts(F, ka->in[16] + (size_t)l * NE * D * EH, ka->in[17] + (size_t)l * NE * D * EH, ka->in[18] + (size_t)l * NE * EH * D, ka->in[19] + (size_t)l * D * EH, ka->in[20] + (size_t)l * D * EH, ka->in[21] + (size_t)l * EH * D, ws, gb); __syncthreads(); }
            DenseSched S; S.init(ws + WS_XBF, ws + WS_WIN_T + l * WIN_T_L, NTOK, INC, D, split ? (conv ? NCV : 256 - NCV) : F.G, split ? (conv ? hrank : grank) : (int)blockIdx.x);
            if (split) { S.L0 = conv ? (256 - NCV) * GM_UNITS : 0; S.cnt = conv ? CV_UNITS : GM_UNITS; }
            EpiProj E{WSP(bf16, WS_R1), WSP(unsigned char, WS_GATE8)};
            pg8::gemm_phase<EpiProj, DenseSched, true>(F.lds + RING_OFF, F.wave, D, S, E);
            if (l == 0) {
                DenseSched S2; S2.init(ws + WS_MEMBF, ws + WS_WKV_T, NB * NMEM, 2048, D, split ? 32 : F.G, split ? ((conv && hrank < 32) ? hrank : -1) : (int)blockIdx.x);
                EpiBf16Plain E2{WSP(bf16, WS_KV), 2048};
                pg8::gemm_phase<EpiBf16Plain, DenseSched, true>(F.lds + RING_OFF, F.wave, D, S2, E2);
            }
            }
            SEAM(pb + P_INPROJ);
        }
        if (IN(pb + P_MIX)) {
            { PH_BEGIN;
            memattn(F, WSP(bf16, WS_R1), WSP(bf16, WS_KV), l, WSP(bf16, WS_YX));
            hgrn_local(F, WSP(bf16, WS_R1), ka->in[5], l, ws + WS_R2);
            conv_part(F, WSP(bf16, WS_R1), ka->in[3] + (size_t)l * 3 * CW, WSP(bf16, WS_YA), WSP(bf16, WS_YX));
            }
            SEAM(pb + P_MIX);
        }
        if (IN(pb + P_SCAN)) {
            { PH_BEGIN;
            hgrn_scan(F, ws + WS_R2, WSP(v2u, WS_ZF));
            }
            SEAM(pb + P_SCAN);
        }
        if (IN(pb + P_HOUT)) {
            { PH_BEGIN;
            hgrn_out(F, WSP(bf16, WS_R1), ws + WS_R2, WSP(bf16, WS_ZF), ka->in[6] + (size_t)l * HGW, WSP(bf16, WS_YB));
            }
            SEAM(pb + P_HOUT);
        }
        if (IN(pb + P_BRANCH)) {
            { PH_BEGIN;
            static_assert(WS_YX - WS_YB == WS_YB - WS_YA, "branch inputs equally spaced");
            BranchSched S; S.init(ws + WS_YA, ws + WS_WBR_T + l * WBR_T_L, F.G, (int)blockIdx.x); EpiGateRT E{WSP(unsigned char, WS_GATE8), WSP(bf16, WS_MERGED)};
            pg8::gemm_phase<EpiGateRT, BranchSched, true>(F.lds + RING_OFF, F.wave, CW, S, E);
            }
            SEAM(pb + P_BRANCH);
        }
        if (IN(pb + P_WO)) {
            { PH_BEGIN;
            DenseSched S; S.init(ws + WS_MERGED, ws + WS_WO_T + l * WO_T_L, NTOK, D, D, F.G, (int)blockIdx.x);
            EpiResid<true> E{(const void*)WSP(bf16, WS_XBF), WSP(bf16, WS_ZF)}; pg8::gemm_phase<EpiResid<true>, DenseSched, true>(F.lds + RING_OFF, F.wave, D, S, E);
            }
            SEAM(pb + P_WO);
        }
        if (IN(pb + P_ROUTE)) {
            { PH_BEGIN;
            route_phase(F, WSP(bf16, WS_ZF), ka->in[12] + (size_t)l * D, ka->in[13] + (size_t)l * D, WSP(bf16, WS_RW + l * RW_L), ka->in[15] + (size_t)l * NE, WSP(bf16, WS_X1F), WSP(bf16, WS_X1BF),
                        WSP(unsigned, WS_CTL) + CW_CNT + l * 64, WSP(int, WS_LIST), WSP(int, WS_TOKSLOT), WSP(float, WS_TOKW));
            }
            SEAM(pb + P_ROUTE);
        }
        if (IN(pb + P_GU)) {
            { PH_BEGIN;
            moe_plan(F, WSP(unsigned, WS_CTL) + CW_CNT + l * 64);
            MoeSched<true> S; S.init(F, ws + WS_X1BF, ws + WS_WGU, WSP(int, WS_LIST)); EpiSwiGLU E{WSP(bf16, WS_R2)};
            pg8::gemm_phase<EpiSwiGLU, MoeSched<true>, true>(F.lds + RING_OFF, F.wave, D, S, E);
            }
            SEAM(pb + P_GU);
        }
        if (IN(pb + P_DOWN)) {
            { PH_BEGIN;
            moe_plan(F, WSP(unsigned, WS_CTL) + CW_CNT + l * 64);
            MoeSched<false> S; S.init(F, ws + WS_R2, ws + WS_WDN, nullptr); EpiY8 E{WSP(unsigned char, WS_R1), WSP(bf16, WS_R1 + R1_YS)};
            pg8::gemm_phase<EpiY8, MoeSched<false>, true>(F.lds + RING_OFF, F.wave, EH, S, E);
            }
            SEAM(pb + P_DOWN);
        }
        if (IN(pb + P_COMB)) {
            { PH_BEGIN;
            moe_plan(F, WSP(unsigned, WS_CTL) + CW_CNT + l * 64);
            combine_phase(F, WSP(bf16, WS_X1BF), WSP(unsigned char, WS_R1), WSP(bf16, WS_R1 + R1_YS), WSP(int, WS_TOKSLOT), WSP(float, WS_TOKW), ka->in[22] + (size_t)l * D, ka->in[23] + (size_t)l * D, ka->out, WSP(bf16, WS_XBF), l == 1);
            }
            SEAM(pb + P_COMB);
        }
    }
#undef IN
#undef SEAM
}
static void launch_mk(Args a, int lo, int hi, int grid, hipStream_t stream) {
    a.ph_lo = lo; a.ph_hi = hi;
    hipLaunchKernelGGL(mk_fwd, dim3(grid), dim3(NWAVES * 64), LDS_BYTES, stream, a);
}
extern "C" void kernel_launch(void* const* d_in, const int* in_sizes, int n_in, void* d_out, int out_size, void* d_ws, size_t ws_size, hipStream_t stream) {
    static int grid = 0;
    if (grid == 0) {
        if (n_in != 24 || out_size != NTOK * D || ws_size < WS_END) { fprintf(stderr, "kernel_launch: unexpected sizes n_in %d out %d ws %zu\n", n_in, out_size, ws_size); grid = -1; return; }
        int dev = 0, cus = 0;
        if (hipGetDevice(&dev) != hipSuccess || hipDeviceGetAttribute(&cus, hipDeviceAttributeMultiprocessorCount, dev) != hipSuccess) { grid = -1; return; }
        if (hipFuncSetAttribute((const void*)mk_fwd, hipFuncAttributeMaxDynamicSharedMemorySize, LDS_BYTES) != hipSuccess) { fprintf(stderr, "kernel_launch: hipFuncSetAttribute failed\n"); grid = -1; return; }
        int per_cu = 0; (void)hipOccupancyMaxActiveBlocksPerMultiprocessor(&per_cu, (const void*)mk_fwd, NWAVES * 64, LDS_BYTES); (void)hipGetLastError();
        if (per_cu < 1) fprintf(stderr, "kernel_launch: occupancy query says %d\n", per_cu);
        grid = cus;
    }
    if (grid < 0) return;
    const float* x = (const float*)d_in[0];
    const float* conv_w = (const float*)d_in[3]; const float* lbl = (const float*)d_in[5];
    const float* hg_g = (const float*)d_in[6];
    const float* ln1_g = (const float*)d_in[12]; const float* ln1_b = (const float*)d_in[13]; const float* router_w = (const float*)d_in[14];
    const float* router_b = (const float*)d_in[15]; const float* exp_wg = (const float*)d_in[16]; const float* exp_wu = (const float*)d_in[17];
    const float* exp_wd = (const float*)d_in[18]; const float* sh_wg = (const float*)d_in[19]; const float* sh_wu = (const float*)d_in[20];
    const float* sh_wd = (const float*)d_in[21]; const float* ln2_g = (const float*)d_in[22]; const float* ln2_b = (const float*)d_in[23];
    unsigned char* ws = (unsigned char*)d_ws; float* out = (float*)d_out;
    unsigned* ctl = (unsigned*)(ws + WS_CTL);
    bf16* KV = (bf16*)(ws + WS_KV); bf16* XBF = (bf16*)(ws + WS_XBF); float* X1F = (float*)(ws + WS_X1F);
    bf16* X1BF = (bf16*)(ws + WS_X1BF); float* ZF = (float*)(ws + WS_ZF);
    bf16* YA = (bf16*)(ws + WS_YA); bf16* YB = (bf16*)(ws + WS_YB); bf16* YX = (bf16*)(ws + WS_YX);
    bf16* H = (bf16*)(ws + WS_R2); float* OH = (float*)(ws + WS_R2); bf16* PROJ = (bf16*)(ws + WS_R1); bf16* Y = (bf16*)(ws + WS_R1);
    int* LIST = (int*)(ws + WS_LIST); int* TOKSLOT = (int*)(ws + WS_TOKSLOT); float* TOKW = (float*)(ws + WS_TOKW);
    Args a{};
    for (int i = 0; i < 24; ++i) a.in[i] = (const float*)d_in[i];
    a.out = out; a.ws = ws;

    (void)hipMemsetAsync(ws + WS_CTL, 0, CTL_BYTES, stream);
    a.mask = 7;
    launch_mk(a, 0, N_PHASES, grid, stream);
}
```

```cpp
#include <hip/hip_runtime.h>
#include <stdint.h>
#include <stdio.h>

typedef unsigned short bf16;
__device__ __forceinline__ float bf2f(bf16 v) { return __uint_as_float(((unsigned)v) << 16); }
__device__ __forceinline__ bf16 f2bf(float f) { unsigned u = __float_as_uint(f); return (bf16)((u + 0x7fffu + ((u >> 16) & 1u)) >> 16); }

constexpr int NB = 4, SEQ = 4096, NTOK = NB * SEQ, D = 2048, NMEM = 256;
constexpr int CW = 768, HGW = 768, HGH = 6, HGD = 128, XAW = 512, XAH = 4, XAD = 128;
constexpr int INC = 12032, YXW = 768, GW8 = 3 * 2048, PN_GATE = 23;
constexpr int C_U = 0, C_B = 768, C_C = 1536, C_Q = 2304, C_F = 3072, C_I = 3840, C_G = 4608, C_QX = 5376, C_GA = 5888, C_GB = 7936, C_GX = 9984;
constexpr int NE = 64, TOPK = 8, EH = 512;
constexpr float ALPHA = 1.41421356237f, LN_EPS = 1e-5f, RMS_EPS = 1e-6f, RSCALE = 2.5f;
constexpr int LISTCAP = 16384;

constexpr size_t MiB = 1u << 20;
constexpr size_t WS_CTL = 0, CTL_BYTES = 1 * MiB;
constexpr size_t WS_RW = 1 * MiB, RW_L = 512 * 1024;
constexpr size_t WS_WIN_T = 2 * MiB, WIN_T_L = 47 * MiB;
constexpr size_t WS_WBR_T = 1932 * MiB, WBR_T_L = 9 * MiB;
constexpr size_t WS_WO_T = 112 * MiB, WO_T_L = 8 * MiB;
constexpr size_t WS_WKV_T = 128 * MiB;
constexpr size_t WS_MEMBF = 136 * MiB, WS_KV = 140 * MiB;
constexpr size_t WS_WGU = 144 * MiB, WGU_E = 4 * MiB;
constexpr size_t WS_WDN = 404 * MiB, WDN_E = 2 * MiB;
constexpr size_t WS_XBF = 534 * MiB, WS_X1F = 598 * MiB, WS_X1BF = 726 * MiB, WS_ZF = 790 * MiB, WS_MERGED = 918 * MiB;
constexpr size_t WS_YA = 1860 * MiB, WS_YB = 1884 * MiB, WS_YX = 1908 * MiB;
constexpr size_t WS_R2 = 1046 * MiB;
constexpr size_t WS_R1 = 1214 * MiB;
constexpr size_t R1_YS = 320 * MiB;
constexpr size_t WS_LIST = 1854 * MiB, WS_TOKSLOT = 1858 * MiB, WS_TOKW = 1859 * MiB, WS_GATE8 = 1950 * MiB, WS_END = 2046 * MiB;
constexpr int CW_CNT = 1024;
constexpr int CW_PLAN = 2048;
constexpr int CW_BAR = 4096;
#ifndef DBG_MASK
#define DBG_MASK 7
#endif
namespace pg8 {
#define PG8_LAS __attribute__((address_space(3)))
typedef unsigned short bf16_t;
typedef short bf16x8 __attribute__((ext_vector_type(8)));
typedef float f32x4 __attribute__((ext_vector_type(4)));
typedef unsigned u32x4 __attribute__((ext_vector_type(4)));
typedef unsigned u32x2 __attribute__((ext_vector_type(2)));
constexpr int PG8_NVO_OFF = 147456 + 1024;
constexpr int BM = 256, BK = 64, HALF = 128, HTB = HALF * BK * 2  , STAGE_BYTES = 8 * HTB, NXCD = 8, WGM = 8;

__host__ __device__ __forceinline__ int lds_byte(int r, int c) { const int st = (r >> 4) * 2 + (c >> 5), rr = r & 15, cc = c & 31, ob = rr * 64 + cc * 2; return st * 1024 + (ob ^ (((ob >> 9) & 1) << 5)); }
__host__ __device__ __forceinline__ void stage_rc(int b, int& R, int& C) { const int st = b / 1024, sb = b % 1024, swz = sb ^ (((sb >> 9) & 1) << 5); R = (st >> 1) * 16 + swz / 64; C = (st & 1) * 32 + (swz % 64) / 2; }
__host__ __device__ __forceinline__ int perm32(int rho) { const int n = rho >> 4, i = rho & 15; return 8 * (i >> 2) + 4 * n + (i & 3); }

struct Unit { const char* A; const char* B; int pm, pn; const int* list; int m0, cnt; };

typedef float f32x2_ __attribute__((ext_vector_type(2)));
typedef __bf16 bf16x2_ __attribute__((ext_vector_type(2)));
__device__ __forceinline__ unsigned cvt_pk_bf16(float lo, float hi) { const f32x2_ v = {lo, hi}; const bf16x2_ b = __builtin_convertvector(v, bf16x2_); return __builtin_bit_cast(unsigned, b); }
__device__ __forceinline__ int lane_id_opaque() { unsigned m = ~0u; asm volatile("" : "+s"(m)); return (int)__builtin_amdgcn_mbcnt_hi(m, __builtin_amdgcn_mbcnt_lo(m, 0u)); }
__device__ __forceinline__ float bf_lo(unsigned w) { return __uint_as_float(w << 16); }
__device__ __forceinline__ float bf_hi(unsigned w) { return __uint_as_float(w & 0xffff0000u); }
__device__ __forceinline__ float sigmoidf_(float x) { return __builtin_amdgcn_rcpf(1.f + __expf(-x)); }

typedef f32x4 Acc[2][2][4][2];

template <class Epi, class Sched, bool ALIGN_EPI>
__device__ __forceinline__ void gemm_phase(PG8_LAS unsigned char* lds, const int wave, const int K_in, const Sched& S, const Epi& E) {
    const int lane = lane_id_opaque(), wid = wave, tid = wid * 64 + lane, wr = wid >> 2, wc = wid & 3, fr = lane & 15, fq = lane >> 4;
    int K = K_in; asm volatile("" : "+s"(K));
    const int nt = K / BK;
    unsigned voffB[2];
#pragma unroll
    for (int i = 0; i < 2; ++i) { int R, C; stage_rc(tid * 16 + i * 8192, R, C); const int Rb = Epi::PERM ? ((R & ~31) + perm32(R & 31)) : R; voffB[i] = (unsigned)(Rb * K + C) * 2u; }
    const size_t kstep = (size_t)(BK * 2);
    const size_t hstep = (size_t)HALF * K * 2;
    const unsigned ldsw = (unsigned)wid * 1024u;
    const int aoff = lds_byte(wr * 64 + fr, fq * 8), boff = lds_byte(wc * 32 + fr, fq * 8);
#define PG8_SA(b, h) (((b) * 2 + (h)) * HTB)
#define PG8_SB(b, h) ((4 + (b) * 2 + (h)) * HTB)
#define PG8_STAGE2(bufoff, gbase, v0, v1) do { \
        __builtin_amdgcn_global_load_lds((const unsigned*)((const char*)(gbase) + (v0)), (PG8_LAS unsigned*)(lds + (bufoff) + ldsw), 16, 0, 0); \
        __builtin_amdgcn_global_load_lds((const unsigned*)((const char*)(gbase) + (v1)), (PG8_LAS unsigned*)(lds + (bufoff) + ldsw + 8192), 16, 0, 0); } while (0)
#define PG8_STAGEB(bufoff, gbase) PG8_STAGE2(bufoff, gbase, voffB[0], voffB[1])
#define PG8_LDA(dst, b, h) do { _Pragma("unroll") for (int m = 0; m < 4; ++m) _Pragma("unroll") for (int k = 0; k < 2; ++k) dst[m][k] = *(const PG8_LAS bf16x8*)(lds + PG8_SA(b, h) + aoff + m * 2048 + k * 1024); } while (0)
#define PG8_LDB(dst, b, h) do { _Pragma("unroll") for (int n = 0; n < 2; ++n) _Pragma("unroll") for (int k = 0; k < 2; ++k) dst[n][k] = *(const PG8_LAS bf16x8*)(lds + PG8_SB(b, h) + boff + n * 2048 + k * 1024); } while (0)
#define PG8_MMA(ai, bj, At, Bt) do { __builtin_amdgcn_s_setprio(1); _Pragma("unroll") for (int m = 0; m < 4; ++m) _Pragma("unroll") for (int n = 0; n < 2; ++n) _Pragma("unroll") for (int k = 0; k < 2; ++k) \
        acc[ai][bj][m][n] = __builtin_amdgcn_mfma_f32_16x16x32_bf16(Bt[n][k], At[m][k], acc[ai][bj][m][n], 0, 0, 0); __builtin_amdgcn_s_setprio(0); } while (0)
#define PG8_WAIT_V(n) asm volatile("s_waitcnt vmcnt(" #n ")" ::: "memory")
#define PG8_WAIT_L(n) asm volatile("s_waitcnt lgkmcnt(" #n ")" ::: "memory")
#define PG8_BAR __builtin_amdgcn_s_barrier()
#define PG8_SCHED __builtin_amdgcn_sched_barrier(0)
    Unit cur, nxt; int ui = 0;
    if (!S.next(0, cur)) return;
    Acc acc;
#pragma unroll
    for (int a = 0; a < 2; ++a)
#pragma unroll
        for (int b = 0; b < 2; ++b)
#pragma unroll
            for (int m = 0; m < 4; ++m)
#pragma unroll
                for (int n = 0; n < 2; ++n) acc[a][b][m][n] = (f32x4){0.f, 0.f, 0.f, 0.f};
    bf16x8 At[4][2], B0[2][2], B1[2][2];
    constexpr bool GA = Sched::GATHER;
    unsigned c00, c01, c10 = 0, c11 = 0;
    PG8_LAS unsigned* nvo = (PG8_LAS unsigned*)(lds + PG8_NVO_OFF) + tid * 4;
    { int R0, C0, R1, C1; stage_rc(tid * 16, R0, C0); stage_rc(tid * 16 + 8192, R1, C1);
      c00 = S.avoff(cur, 0, R0, C0, K); c01 = S.avoff(cur, 0, R1, C1, K); if constexpr (GA) { c10 = S.avoff(cur, 1, R0, C0, K); c11 = S.avoff(cur, 1, R1, C1, K); } }
    const size_t hA = GA ? (size_t)0 : hstep;
#define PG8_STAGEA0(bufoff, gbase) PG8_STAGE2(bufoff, gbase, c00, c01)
#define PG8_STAGEA1(bufoff, gbase) do { if constexpr (GA) PG8_STAGE2(bufoff, gbase, c10, c11); else PG8_STAGE2(bufoff, (gbase) + hA, c00, c01); } while (0)
    const char* cA = cur.A; const char* cB = cur.B;
    PG8_STAGEB(PG8_SB(0, 0), cB); PG8_STAGEB(PG8_SB(0, 1), cB + hstep); PG8_STAGEA0(PG8_SA(0, 0), cA); PG8_STAGEA1(PG8_SA(0, 1), cA);
    if (wr == 1) PG8_BAR;
    PG8_WAIT_V(2); PG8_BAR;
    PG8_STAGEB(PG8_SB(1, 0), cB + kstep); PG8_STAGEA0(PG8_SA(1, 0), cA + kstep); PG8_STAGEB(PG8_SB(1, 1), cB + hstep + kstep);
    PG8_WAIT_V(6); PG8_BAR;
    int pi0 = 0, pi1 = 0, pi2 = 0, pi3 = 0;
    if constexpr (GA) { Unit n1; if (S.next(1, n1)) { int R0, C0, R1, C1; stage_rc(tid * 16, R0, C0); stage_rc(tid * 16 + 8192, R1, C1);
        pi0 = S.avload(n1, 0, R0); pi1 = S.avload(n1, 0, R1); pi2 = S.avload(n1, 1, R0); pi3 = S.avload(n1, 1, R1); } }
    for (;;) {
        const bool has_next = S.next(ui + 1, nxt);
        const char* nA = has_next ? nxt.A : cA; const char* nB = has_next ? nxt.B : cB;
        if constexpr (GA) { if (has_next) {
            int R0, C0, R1, C1; stage_rc(tid * 16, R0, C0); stage_rc(tid * 16 + 8192, R1, C1);
            nvo[0] = S.avfin(nxt, 0, R0, C0, K, pi0); nvo[1] = S.avfin(nxt, 0, R1, C1, K, pi1); nvo[2] = S.avfin(nxt, 1, R0, C0, K, pi2); nvo[3] = S.avfin(nxt, 1, R1, C1, K, pi3); } }
        for (int t = 0; t < nt; t += 2) {
            const bool last = (t == nt - 2);
            const char* a1 = cA + (size_t)(t + 1) * kstep;
            const char* a2 = last ? nA : cA + (size_t)(t + 2) * kstep; const char* b2 = last ? nB : cB + (size_t)(t + 2) * kstep;
            const char* a3 = a2 + kstep; const char* b3 = b2 + kstep;
            const bool nx = GA && last && has_next;
#define PG8_STAGEA0N(bufoff, gbase) do { if (nx) { const unsigned q0 = nvo[0], q1 = nvo[1]; PG8_STAGE2(bufoff, gbase, q0, q1); } else PG8_STAGEA0(bufoff, gbase); } while (0)
#define PG8_STAGEA1N(bufoff, gbase) do { if (nx) { const unsigned q0 = nvo[2], q1 = nvo[3]; PG8_STAGE2(bufoff, gbase, q0, q1); } else PG8_STAGEA1(bufoff, gbase); } while (0)
            PG8_LDB(B0, 0, 0); PG8_LDB(B1, 0, 1); PG8_SCHED; PG8_LDA(At, 0, 0); PG8_STAGEA1(PG8_SA(1, 1), a1);
            PG8_WAIT_V(8); PG8_WAIT_L(0); PG8_BAR; PG8_MMA(0, 0, At, B0); PG8_MMA(0, 1, At, B1); PG8_BAR; PG8_SCHED;
            PG8_LDA(At, 0, 1); PG8_STAGEB(PG8_SB(0, 0), b2); PG8_STAGEB(PG8_SB(0, 1), b2 + hstep); PG8_STAGEA0N(PG8_SA(0, 0), a2);
            PG8_WAIT_V(8); PG8_WAIT_L(0); PG8_BAR; PG8_MMA(1, 0, At, B0); PG8_MMA(1, 1, At, B1); PG8_BAR; PG8_SCHED;
            PG8_LDB(B0, 1, 0); PG8_LDB(B1, 1, 1); PG8_SCHED; PG8_LDA(At, 1, 0); PG8_STAGEA1N(PG8_SA(0, 1), a2);
            PG8_WAIT_V(8); PG8_WAIT_L(0); PG8_BAR; PG8_MMA(0, 0, At, B0); PG8_MMA(0, 1, At, B1); PG8_BAR; PG8_SCHED;
            PG8_LDA(At, 1, 1); PG8_STAGEB(PG8_SB(1, 0), b3); PG8_STAGEB(PG8_SB(1, 1), b3 + hstep); PG8_STAGEA0N(PG8_SA(1, 0), a3);
            PG8_WAIT_V(8); PG8_WAIT_L(0); PG8_BAR; PG8_MMA(1, 0, At, B0); PG8_MMA(1, 1, At, B1); PG8_BAR; PG8_SCHED;
#undef PG8_STAGEA0N
#undef PG8_STAGEA1N
        }
        if constexpr (GA) { Unit n2; if (has_next && S.next(ui + 2, n2)) { int R0, C0, R1, C1; stage_rc(tid * 16, R0, C0); stage_rc(tid * 16 + 8192, R1, C1);
            pi0 = S.avload(n2, 0, R0); pi1 = S.avload(n2, 0, R1); pi2 = S.avload(n2, 1, R0); pi3 = S.avload(n2, 1, R1); } }
        if constexpr (ALIGN_EPI) { if (wr == 0) PG8_BAR; }
        bool keep = false;
        if constexpr (Epi::INPLACE) keep = E.inplace(acc, cur, wr, wc, fr, fq); else E(acc, cur, wr, wc, fr, fq);
        if (!has_next) break;
        if (!keep)
#pragma unroll
        for (int a = 0; a < 2; ++a)
#pragma unroll
            for (int b = 0; b < 2; ++b)
#pragma unroll
                for (int m = 0; m < 4; ++m)
#pragma unroll
                    for (int n = 0; n < 2; ++n) acc[a][b][m][n] = (f32x4){0.f, 0.f, 0.f, 0.f};
        cur = nxt; cA = nA; cB = nB; ++ui; if constexpr (GA) { c00 = nvo[0]; c01 = nvo[1]; c10 = nvo[2]; c11 = nvo[3]; }
        if constexpr (ALIGN_EPI) { if (wr == 1) PG8_BAR; }
    }
    PG8_WAIT_V(0);
    if constexpr (!ALIGN_EPI) { if (wr == 0) PG8_BAR; }
    PG8_BAR;
#undef PG8_SA
#undef PG8_SB
#undef PG8_STAGE2
#undef PG8_STAGEB
#undef PG8_STAGEA0
#undef PG8_STAGEA1
#undef PG8_LDA
#undef PG8_LDB
#undef PG8_MMA
#undef PG8_WAIT_V
#undef PG8_WAIT_L
#undef PG8_BAR
#undef PG8_SCHED
}
}
#define GAS __attribute__((address_space(1)))
#define LAS __attribute__((address_space(3)))
typedef unsigned v4u __attribute__((ext_vector_type(4)));
typedef unsigned v2u __attribute__((ext_vector_type(2)));
typedef float f32x4 __attribute__((ext_vector_type(4)));
typedef short bf16x8 __attribute__((ext_vector_type(8)));
typedef GAS unsigned gu32;
#define RLX_AGENT __ATOMIC_RELAXED, __HIP_MEMORY_SCOPE_AGENT
#define LDS_WAIT() asm volatile("s_waitcnt lgkmcnt(0)" ::: "memory")
#define VM_WAIT() asm volatile("s_waitcnt vmcnt(0)" ::: "memory")
__device__ __forceinline__ int opaque_v(int x) { asm volatile("" : "+v"(x)); return x; }
__device__ __forceinline__ float shx(float v, int o, int lane) { return __int_as_float(__builtin_amdgcn_ds_bpermute((lane ^ o) << 2, __float_as_int(v))); }
__device__ __forceinline__ unsigned pk2(float lo, float hi) { return pg8::cvt_pk_bf16(lo, hi); }

#define XB_TMO      128
#define XB_XCNT(j)  (256  + 64 * (j))
#define XB_XSUB(j)  (1280 + 64 * (j))
#define XB_XGEN(j)  (2304 + 64 * (j))
#define XB_TOP      3328
#define XB_TOPGEN   3392
#define XCD_BAR_WORDS 3456
#define XB_SPIN_CAP (1u << 18)
__device__ __forceinline__ unsigned xb_ld(unsigned* p)              { return __hip_atomic_load(p, __ATOMIC_RELAXED, __HIP_MEMORY_SCOPE_AGENT); }
__device__ __forceinline__ unsigned xb_add(unsigned* p, unsigned v) { return __hip_atomic_fetch_add(p, v, __ATOMIC_RELAXED, __HIP_MEMORY_SCOPE_AGENT); }
__device__ __forceinline__ unsigned xb_xcc_id() { return (unsigned)__builtin_amdgcn_s_getreg((3 << 11) | 20) & 0xFu; }
#define XB_SPIN(cond, bar) do { unsigned _sp = 0; while (cond) { __builtin_amdgcn_s_sleep(1); \
    if ((++_sp & 255u) == 0u) { if (xb_ld(&(bar)[XB_TMO])) break; if (_sp > XB_SPIN_CAP) { atomicAdd(&(bar)[XB_TMO], 1u); break; } } } } while (0)
struct XcdBarrier { unsigned* bar; unsigned x; volatile LAS unsigned* st; };
__device__ __forceinline__ XcdBarrier xcd_barrier_post(unsigned* bar, volatile LAS unsigned* st) {
    XcdBarrier b; b.bar = bar; b.x = xb_xcc_id(); b.st = st;
    if (threadIdx.x == 0) (void)xb_add(&bar[XB_XCNT(b.x)], 1u);
    return b;
}
__device__ __forceinline__ void xcd_barrier_complete(unsigned* bar, unsigned x, unsigned& nloc, unsigned& nx) {
    const unsigned G = gridDim.x * gridDim.y * gridDim.z;
    unsigned sum, cnt, mine, sp = 0u;
    for (;;) {
        sum = 0u; cnt = 0u; mine = 0u;
#pragma unroll
        for (unsigned j = 0; j < 16; ++j) { const unsigned c = xb_ld(&bar[XB_XCNT(j)]); sum += c; cnt += (c > 0u) ? 1u : 0u; mine = (j == x) ? c : mine; }
        if (sum == G) break;
        __builtin_amdgcn_s_sleep(1);
        if ((++sp & 255u) == 0u) { if (xb_ld(&bar[XB_TMO])) break; if (sp > XB_SPIN_CAP) { atomicAdd(&bar[XB_TMO], 1u); break; } }
    }
    nloc = mine > 0u ? mine : 1u; nx = cnt > 0u ? cnt : 1u;
}
__device__ __forceinline__ void xcd_barrier(const XcdBarrier& b_in) {
    asm volatile("s_waitcnt vmcnt(0)" ::: "memory");
    __syncthreads();
    if (threadIdx.x == 0) {
        XcdBarrier b = b_in; asm volatile("" : "+s"(b.x));
        unsigned* bar = b.bar; asm volatile("" : "+s"(bar));
        __builtin_amdgcn_s_waitcnt(0);
        unsigned nloc = b.st[0], nx = b.st[1];
        if (nloc == 0u) { xcd_barrier_complete(bar, b.x, nloc, nx); b.st[0] = nloc; b.st[1] = nx; }
        const unsigned old = xb_add(&bar[XB_XSUB(b.x)], 1u);
        const unsigned gen = old / nloc;
        if (old + 1u == (gen + 1u) * nloc) {
            __builtin_amdgcn_fence(__ATOMIC_RELEASE, "agent");
            asm volatile("s_waitcnt vmcnt(0)" ::: "memory");
            const unsigned og = xb_add(&bar[XB_TOP], 1u);
            const unsigned tg = og / nx;
            if (og + 1u == (tg + 1u) * nx) xb_add(&bar[XB_TOPGEN], 1u);
            else XB_SPIN(xb_ld(&bar[XB_TOPGEN]) == tg, bar);
            __builtin_amdgcn_fence(__ATOMIC_ACQUIRE, "agent");
            xb_add(&bar[XB_XGEN(b.x)], 1u);
            asm volatile("s_waitcnt vmcnt(0)" ::: "memory");
        } else {
            XB_SPIN(xb_ld(&bar[XB_XGEN(b.x)]) == gen, bar);
            __builtin_amdgcn_fence(__ATOMIC_ACQUIRE, "agent");
            asm volatile("s_waitcnt vmcnt(0)" ::: "memory");
        }
    }
    __syncthreads();
}
using pg8::Unit; using pg8::Acc;
struct DenseSched { static constexpr bool GATHER = false;
    const char* A; const char* B; int nM, nN, nwg, G, c, K; int L0 = 0, cnt = 1 << 30;
    __device__ __forceinline__ void init(const void* A_, const void* B_, int M, int N, int K_, int G_, int c_) { A = (const char*)A_; B = (const char*)B_; nM = M / 256; nN = N / 256; nwg = nM * nN; G = G_; c = c_; K = K_; }
    __device__ __forceinline__ bool next(int i, Unit& u) const {
        const long L = (long)L0 + (long)i * G + c; if (c < 0 || i >= cnt || L >= nwg) return false;
        int wgid = (int)L; { const int q = nwg / 8, r = nwg % 8, xcd = wgid % 8, off = wgid / 8; wgid = (xcd < r ? xcd * (q + 1) : r * (q + 1) + (xcd - r) * q) + off; }
        const int nig = 8 * nN, gid = wgid / nig, fm = gid * 8, gsz = (nM - fm) < 8 ? (nM - fm) : 8;
        u.pm = fm + ((wgid % nig) % gsz); u.pn = (wgid % nig) / gsz;
        u.A = A + (size_t)u.pm * 256 * K * 2; u.B = B + (size_t)u.pn * 256 * K * 2; u.list = nullptr; u.m0 = 0; u.cnt = 0; return true;
    }
    __device__ __forceinline__ int avload(const Unit&, int, int) const { return 0; }
    __device__ __forceinline__ unsigned avfin(const Unit&, int h, int R, int C, int K_, int) const { return (unsigned)(((h * 128 + R) * K_ + C) * 2); }
    __device__ __forceinline__ unsigned avoff(const Unit&, int h, int R, int C, int K_) const { return (unsigned)(((h * 128 + R) * K_ + C) * 2); }
};
struct EpiBf16Plain { static constexpr bool PERM = true, INPLACE = false; bf16* O; int ldc;
    __device__ __forceinline__ void operator()(const Acc& acc, const Unit& u, int wr, int wc, int fr, int fq) const {
        const int row0 = u.pm * 256 + wr * 64 + fr, col0 = u.pn * 256 + wc * 32 + 8 * fq;
#pragma unroll
        for (int ai = 0; ai < 2; ++ai)
#pragma unroll
            for (int m = 0; m < 4; ++m) { bf16* rowp = O + (size_t)(row0 + ai * 128 + m * 16) * ldc + col0;
#pragma unroll
                for (int bj = 0; bj < 2; ++bj) { const f32x4 v0 = acc[ai][bj][m][0], v1 = acc[ai][bj][m][1];
                    v4u w; w.x = pk2(v0[0], v0[1]); w.y = pk2(v0[2], v0[3]); w.z = pk2(v1[0], v1[1]); w.w = pk2(v1[2], v1[3]);
                    *(v4u*)(rowp + bj * 128) = w; } }
    }
};
struct EpiProj { static constexpr bool PERM = true, INPLACE = false; bf16* O; unsigned char* G8;
    __device__ __forceinline__ void operator()(const Acc& acc, const Unit& u, int wr, int wc, int fr, int fq) const {
        const int row0 = u.pm * 256 + wr * 64 + fr;
        if (u.pn < PN_GATE) { const int col0 = u.pn * 256 + wc * 32 + 8 * fq;
#pragma unroll
            for (int ai = 0; ai < 2; ++ai)
#pragma unroll
                for (int m = 0; m < 4; ++m) { bf16* rowp = O + (size_t)(row0 + ai * 128 + m * 16) * INC + col0;
#pragma unroll
                    for (int bj = 0; bj < 2; ++bj) { const f32x4 v0 = acc[ai][bj][m][0], v1 = acc[ai][bj][m][1];
                        v4u w; w.x = pk2(v0[0], v0[1]); w.y = pk2(v0[2], v0[3]); w.z = pk2(v1[0], v1[1]); w.w = pk2(v1[2], v1[3]);
                        *(v4u*)(rowp + bj * 128) = w; } }
        } else { const int pos0 = (u.pn - PN_GATE) * 256 + wc * 64 + fq * 16;
#pragma unroll
            for (int ai = 0; ai < 2; ++ai)
#pragma unroll
                for (int m = 0; m < 4; ++m) { unsigned char* rowp = G8 + (size_t)(row0 + ai * 128 + m * 16) * GW8 + pos0;
                    v4u w;
#pragma unroll
                    for (int bj = 0; bj < 2; ++bj) { const f32x4 v0 = acc[ai][bj][m][0], v1 = acc[ai][bj][m][1];
                        unsigned q[8];
#pragma unroll
                        for (int j = 0; j < 4; ++j) { q[j] = (unsigned)fmaxf(pg8::sigmoidf_(v0[j]) * 255.f + 0.5f, 1.f); q[4 + j] = (unsigned)fmaxf(pg8::sigmoidf_(v1[j]) * 255.f + 0.5f, 1.f); }
                        const unsigned lo = q[0] | (q[1] << 8) | (q[2] << 16) | (q[3] << 24), hi = q[4] | (q[5] << 8) | (q[6] << 16) | (q[7] << 24);
                        if (bj == 0) { w.x = lo; w.y = hi; } else { w.z = lo; w.w = hi; } }
                    *(v4u*)rowp = w; }
        }
    }
};
struct BranchSched { static constexpr bool GATHER = false;
    const char* A0; const char* B; int G, c;
    __device__ __forceinline__ void init(const void* ya, const void* w, int G_, int c_) { A0 = (const char*)ya; B = (const char*)w; G = G_; c = c_; }
    __device__ __forceinline__ bool next(int i, Unit& u) const {
        const int j = i / 3, seg = i - 3 * j; constexpr int nM = NTOK / 256, nN = D / 256, nwg = nM * nN;
        const int L = j * G + c; if (L >= nwg) return false;
        int wgid = L; { const int q = nwg / 8, xcd = wgid % 8, off = wgid / 8; wgid = xcd * q + off; }
        const int nig = 8 * nN; u.pm = (wgid / nig) * 8 + ((wgid % nig) % 8); u.pn = (wgid % nig) / 8;
        u.A = A0 + (size_t)seg * (WS_YB - WS_YA) + (size_t)u.pm * 256 * CW * 2; u.B = B + (size_t)seg * 3 * MiB + (size_t)u.pn * 256 * CW * 2; u.list = nullptr; u.m0 = seg; u.cnt = 0; return true; }
    __device__ __forceinline__ int avload(const Unit&, int, int) const { return 0; }
    __device__ __forceinline__ unsigned avfin(const Unit&, int h, int R, int C, int K_, int) const { return (unsigned)(((h * 128 + R) * K_ + C) * 2); }
    __device__ __forceinline__ unsigned avoff(const Unit&, int h, int R, int C, int K_) const { return (unsigned)(((h * 128 + R) * K_ + C) * 2); }
};
struct EpiGateRT { static constexpr bool PERM = true, INPLACE = true; const unsigned char* g8; bf16* merged;
    __device__ __forceinline__ bool inplace(Acc& acc, const Unit& u, int wr, int wc, int fr, int fq) const {
        const int row0 = u.pm * 256 + wr * 64 + fr, col0 = u.pn * 256 + wc * 32 + 8 * fq, pos0 = u.pn * 256 + wc * 64 + fq * 16; const int seg = u.m0;
#pragma unroll
        for (int ai = 0; ai < 2; ++ai) {
            v4u ga[4], gb[4];
#pragma unroll
            for (int m = 0; m < 4; ++m) { const size_t row = (size_t)(row0 + ai * 128 + m * 16);
                ga[m] = *(const v4u*)(g8 + row * GW8 + seg * D + pos0); gb[m] = ga[m]; if (seg < 2) gb[m] = *(const v4u*)(g8 + row * GW8 + (seg + 1) * D + pos0); }
            asm volatile("" ::: "memory");
#pragma unroll
            for (int m = 0; m < 4; ++m) { const size_t row = (size_t)(row0 + ai * 128 + m * 16);
#pragma unroll
                for (int bj = 0; bj < 2; ++bj) { const unsigned ax = bj ? ga[m].z : ga[m].x, ay = bj ? ga[m].w : ga[m].y, bx = bj ? gb[m].z : gb[m].x, by = bj ? gb[m].w : gb[m].y;
                    f32x4 v0 = acc[ai][bj][m][0], v1 = acc[ai][bj][m][1];
                    if (seg < 2) {
                        v0[0] *= (float)(ax & 255u) * __builtin_amdgcn_rcpf((float)(bx & 255u)); v0[1] *= (float)((ax >> 8) & 255u) * __builtin_amdgcn_rcpf((float)((bx >> 8) & 255u));
                        v0[2] *= (float)((ax >> 16) & 255u) * __builtin_amdgcn_rcpf((float)((bx >> 16) & 255u)); v0[3] *= (float)(ax >> 24) * __builtin_amdgcn_rcpf((float)(bx >> 24));
                        v1[0] *= (float)(ay & 255u) * __builtin_amdgcn_rcpf((float)(by & 255u)); v1[1] *= (float)((ay >> 8) & 255u) * __builtin_amdgcn_rcpf((float)((by >> 8) & 255u));
                        v1[2] *= (float)((ay >> 16) & 255u) * __builtin_amdgcn_rcpf((float)((by >> 16) & 255u)); v1[3] *= (float)(ay >> 24) * __builtin_amdgcn_rcpf((float)(by >> 24));
                        acc[ai][bj][m][0] = v0; acc[ai][bj][m][1] = v1;
                    } else { constexpr float s8 = 1.f / 255.f;
                        v0[0] *= (float)(ax & 255u) * s8; v0[1] *= (float)((ax >> 8) & 255u) * s8; v0[2] *= (float)((ax >> 16) & 255u) * s8; v0[3] *= (float)(ax >> 24) * s8;
                        v1[0] *= (float)(ay & 255u) * s8; v1[1] *= (float)((ay >> 8) & 255u) * s8; v1[2] *= (float)((ay >> 16) & 255u) * s8; v1[3] *= (float)(ay >> 24) * s8;
                        v4u w; w.x = pk2(v0[0], v0[1]); w.y = pk2(v0[2], v0[3]); w.z = pk2(v1[0], v1[1]); w.w = pk2(v1[2], v1[3]); *(v4u*)(merged + row * D + col0 + bj * 128) = w; } } }
            asm volatile("" ::: "memory");
        }
        return seg < 2;
    }
};
template <bool RB16> struct EpiResid { static constexpr bool PERM = true, INPLACE = false; const void* xres; bf16* z;
    __device__ __forceinline__ void operator()(const Acc& acc, const Unit& u, int wr, int wc, int fr, int fq) const {
        const int row0 = u.pm * 256 + wr * 64 + fr, col0 = u.pn * 256 + wc * 32 + 8 * fq;
#pragma unroll
        for (int ai = 0; ai < 2; ++ai) {
            f32x4 xr[4][2][2];
#pragma unroll
            for (int m = 0; m < 4; ++m) { const size_t off = (size_t)(row0 + ai * 128 + m * 16) * D + col0;
#pragma unroll
                for (int bj = 0; bj < 2; ++bj) {
                    if constexpr (RB16) { const v4u w = *(const v4u*)((const bf16*)xres + off + bj * 128);
                        xr[m][bj][0] = (f32x4){pg8::bf_lo(w.x), pg8::bf_hi(w.x), pg8::bf_lo(w.y), pg8::bf_hi(w.y)}; xr[m][bj][1] = (f32x4){pg8::bf_lo(w.z), pg8::bf_hi(w.z), pg8::bf_lo(w.w), pg8::bf_hi(w.w)}; }
                    else {
#pragma unroll
                        for (int n = 0; n < 2; ++n) xr[m][bj][n] = *(const f32x4*)((const float*)xres + off + bj * 128 + n * 4); } } }
            asm volatile("" ::: "memory");
#pragma unroll
            for (int m = 0; m < 4; ++m) { const size_t off = (size_t)(row0 + ai * 128 + m * 16) * D + col0;
#pragma unroll
                for (int bj = 0; bj < 2; ++bj) { const f32x4 v0 = xr[m][bj][0] * ALPHA + acc[ai][bj][m][0], v1 = xr[m][bj][1] * ALPHA + acc[ai][bj][m][1];
                    v4u w; w.x = pk2(v0[0], v0[1]); w.y = pk2(v0[2], v0[3]); w.z = pk2(v1[0], v1[1]); w.w = pk2(v1[2], v1[3]); *(v4u*)(z + off + bj * 128) = w; } }
            asm volatile("" ::: "memory");
        }
    }
};

constexpr int NWAVES = 8;
constexpr int RING_OFF = 0, RING_BYTES = 131072;
constexpr int SCR_BYTES = 147456;
constexpr int MISC_OFF = SCR_BYTES;
constexpr int LDS_BYTES = 163840;
constexpr int PH_CVT = 0, PH_L0 = 1, PH_PER_LAYER = 10;
constexpr int P_INPROJ = 0, P_MIX = 1, P_SCAN = 2, P_HOUT = 3, P_BRANCH = 4, P_WO = 5, P_ROUTE = 6, P_GU = 7, P_DOWN = 8, P_COMB = 9;
constexpr int N_PHASES = PH_L0 + 2 * PH_PER_LAYER;

constexpr int NCV = 64;
#define CV_UNITS 5
#define GM_UNITS 14
struct Frame { LAS unsigned char* lds; int tid, lane, wave, G, gw, NGW; };

__device__ __forceinline__ void xpose_item(const float* W, int N, int k0, int n0, bf16* WTrow0, int ldk, LAS float* scr, int lane) {
    const int kk = lane >> 3, nn = (lane & 7) * 4;
    f32x4 v[8];
#pragma unroll
    for (int i = 0; i < 8; ++i) v[i] = *(const f32x4*)(W + (size_t)(k0 + kk + 8 * i) * N + n0 + nn);
#pragma unroll
    for (int i = 0; i < 8; ++i) { LAS float* s = scr + (kk + 8 * i) * 33 + nn; s[0] = v[i][0]; s[1] = v[i][1]; s[2] = v[i][2]; s[3] = v[i][3]; }
    LDS_WAIT(); asm volatile("" ::: "memory");
    const int c = lane & 7;
#pragma unroll
    for (int j = 0; j < 4; ++j) { const int n = (lane >> 3) + 8 * j; const LAS float* s = scr + (8 * c) * 33 + n;
        v4u o; o.x = pk2(s[0 * 33], s[1 * 33]); o.y = pk2(s[2 * 33], s[3 * 33]); o.z = pk2(s[4 * 33], s[5 * 33]); o.w = pk2(s[6 * 33], s[7 * 33]);
        *(v4u*)(WTrow0 + (size_t)n * ldk + 8 * c) = o; }
    LDS_WAIT(); asm volatile("" ::: "memory");
}
__device__ __forceinline__ void xpose_matrix(const Frame& F, const float* W, int K, int N, bf16* WT, int ldk, int mode, unsigned& gbase) {
    const int nblk = N / 32, nitems = (K / 64) * nblk;
    LAS float* scr = (LAS float*)(F.lds + RING_OFF + F.wave * 8704);
    int it = (int)(((unsigned)F.gw + (unsigned)F.NGW - gbase % (unsigned)F.NGW) % (unsigned)F.NGW);
    for (; it < nitems; it += F.NGW) {
        const int kb = it / nblk, nb = it % nblk, n0 = nb * 32, k0 = kb * 64;
        const int drow = mode == 0 ? n0 : ((n0 >> 7) * 256 + (n0 & 127) + (mode == 2 ? 128 : 0));
        xpose_item(W, N, k0, n0, WT + (size_t)drow * ldk + k0, ldk, scr, F.lane);
    }
    gbase += (unsigned)nitems;
}
__device__ __forceinline__ void cvt_rows(const Frame& F, const float* in, bf16* out, size_t n8) {
    for (size_t i = (size_t)blockIdx.x * 512 + F.tid; i < n8; i += (size_t)F.G * 512) {
        const f32x4 a = *(const f32x4*)(in + i * 8), b = *(const f32x4*)(in + i * 8 + 4);
        v4u w; w.x = pk2(a[0], a[1]); w.y = pk2(a[2], a[3]); w.z = pk2(b[0], b[1]); w.w = pk2(b[2], b[3]);
        *(v4u*)(out + i * 8) = w; }
}
__device__ __forceinline__ void cvt_router(const Frame& F, const float* rw, unsigned char* ws) {
    for (int i = blockIdx.x * 512 + F.tid; i < 2 * D * NE; i += F.G * 512) { const int l = i / (D * NE), k = (i / NE) % D, e = i % NE;
        const float w = rw[i]; const bf16 h = f2bf(w); const bf16 lo = f2bf(w - bf2f(h));
        bf16* dst = (bf16*)(ws + WS_RW + l * RW_L); dst[(size_t)e * D + k] = h; dst[(size_t)(NE + e) * D + k] = lo; }
}
struct XItem { const float* src; bf16* dst; int N, ldk; };
__device__ __forceinline__ void xp_decode(int I, const float* wg, const float* wu, const float* wd, const float* sg, const float* su, const float* sd, unsigned char* ws, XItem& x) {
    const int e = I / 1536, rem = I % 1536, m = rem >> 9, it = rem & 511;
    if (m < 2) { const float* W = m == 0 ? (e < NE ? wg + (size_t)e * D * EH : sg) : (e < NE ? wu + (size_t)e * D * EH : su);
        const int kb = it >> 4, nb = it & 15, n0 = nb * 32, k0 = kb * 64; const int drow = (n0 >> 7) * 256 + (n0 & 127) + (m == 1 ? 128 : 0);
        x.src = W + (size_t)k0 * EH + n0; x.N = EH; x.ldk = D; x.dst = (bf16*)(ws + WS_WGU + (size_t)e * WGU_E) + (size_t)drow * D + k0; }
    else { const float* W = e < NE ? wd + (size_t)e * EH * D : sd; const int kb = it >> 6, nb = it & 63, n0 = nb * 32, k0 = kb * 64;
        x.src = W + (size_t)k0 * D + n0; x.N = D; x.ldk = EH; x.dst = (bf16*)(ws + WS_WDN + (size_t)e * WDN_E) + (size_t)n0 * EH + k0; }
}
__device__ __forceinline__ void xp_load(const XItem& x, int lane, f32x4 (&v)[8]) {
    const int kk = lane >> 3, nn = (lane & 7) * 4;
#pragma unroll
    for (int i = 0; i < 8; ++i) v[i] = __builtin_nontemporal_load((const f32x4*)(x.src + (size_t)(kk + 8 * i) * x.N + nn));
}
__device__ __forceinline__ void xp_store(const XItem& x, const f32x4 (&v)[8], LAS float* scr, int lane) {
    const int kk = lane >> 3, nn = (lane & 7) * 4;
#pragma unroll
    for (int i = 0; i < 8; ++i) { LAS float* s = scr + (kk + 8 * i) * 33 + nn; s[0] = v[i][0]; s[1] = v[i][1]; s[2] = v[i][2]; s[3] = v[i][3]; }
    LDS_WAIT(); asm volatile("" ::: "memory");
    const int c = lane & 7;
#pragma unroll
    for (int j = 0; j < 4; ++j) { const int n = (lane >> 3) + 8 * j; const LAS float* s = scr + (8 * c) * 33 + n;
        v4u o; o.x = pk2(s[0 * 33], s[1 * 33]); o.y = pk2(s[2 * 33], s[3 * 33]); o.z = pk2(s[4 * 33], s[5 * 33]); o.w = pk2(s[6 * 33], s[7 * 33]);
        __builtin_nontemporal_store(o, (v4u*)(x.dst + (size_t)n * x.ldk + 8 * c)); }
    LDS_WAIT(); asm volatile("" ::: "memory");
}
__device__ __forceinline__ void cvt_experts(const Frame& F, const float* wg, const float* wu, const float* wd, const float* sg, const float* su, const float* sd, unsigned char* ws, unsigned& gbase) {
    (void)gbase;
    LAS float* scr = (LAS float*)(F.lds + RING_OFF + F.wave * 8704);
    const int total = (NE + 1) * 1536;
    XItem A, B; f32x4 va[8], vb[8];
    int I = F.gw;
    if (I < total) { xp_decode(I, wg, wu, wd, sg, su, sd, ws, A); xp_load(A, F.lane, va); }
    for (; I < total; I += 2 * F.NGW) {
        const int I2 = I + F.NGW, I3 = I + 2 * F.NGW;
        if (I2 < total) { xp_decode(I2, wg, wu, wd, sg, su, sd, ws, B); xp_load(B, F.lane, vb); }
        xp_store(A, va, scr, F.lane);
        if (I2 < total) { if (I3 < total) { xp_decode(I3, wg, wu, wd, sg, su, sd, ws, A); xp_load(A, F.lane, va); }
            xp_store(B, vb, scr, F.lane); }
    }
}
constexpr int NVO_OFF = MISC_OFF + 1024;  static_assert(NVO_OFF == pg8::PG8_NVO_OFF, "nvo");
constexpr int PLAN_OFF = NVO_OFF + 8192;
constexpr int PLAN_TB = PLAN_OFF, PLAN_CN = PLAN_OFF + 66 * 4, PLAN_TE = PLAN_OFF + 132 * 4;
constexpr int MAXTILES = 640;
#ifndef ROUTE_PROBE
#define ROUTE_PROBE 0
#endif
static_assert(PLAN_TE + MAXTILES * 4 <= LDS_BYTES, "LDS map");

__device__ __forceinline__ float wave_sum(float v, int lane) {
#pragma unroll
    for (int o = 1; o < 64; o <<= 1) v += shx(v, o, lane);
    return v;
}
__device__ __forceinline__ void moe_plan(const Frame& F, const unsigned* cnt) {
    LAS unsigned* tb = (LAS unsigned*)(F.lds + PLAN_TB); LAS unsigned* cn = (LAS unsigned*)(F.lds + PLAN_CN); LAS unsigned* te = (LAS unsigned*)(F.lds + PLAN_TE);
    __syncthreads();
    if (F.tid <= NE) { unsigned run = 0; for (int e = 0; e < F.tid; ++e) run += (__hip_atomic_load(cnt + e, RLX_AGENT) + 255u) >> 8;
        tb[F.tid] = run; cn[F.tid] = F.tid < NE ? __hip_atomic_load(cnt + F.tid, RLX_AGENT) : (unsigned)NTOK; if (F.tid == NE) tb[NE + 1] = run + NTOK / 256; }
    __syncthreads();
    for (int t = F.tid; t < MAXTILES; t += NWAVES * 64) { unsigned e = 0; for (int q = 1; q <= NE; ++q) if (tb[q] <= (unsigned)t) e = q; te[t] = e; }
    __syncthreads();
}
template <bool GU> struct MoeSched { static constexpr bool GATHER = GU;
    const LAS unsigned* tb; const LAS unsigned* cn; const LAS unsigned* te; int nunits, nN, G, c; const char* Abase; const char* Bbase; const int* list;
    __device__ __forceinline__ void init(const Frame& F, const void* A_, const void* B_, const int* list_) {
        tb = (const LAS unsigned*)(F.lds + PLAN_TB); cn = (const LAS unsigned*)(F.lds + PLAN_CN); te = (const LAS unsigned*)(F.lds + PLAN_TE);
        nN = GU ? 4 : 8; nunits = (int)tb[NE + 1] * nN; G = F.G; const int bx = blockIdx.x; c = (G % 8 == 0) ? (bx % 8) * (G / 8) + bx / 8 : bx;
        Abase = (const char*)A_; Bbase = (const char*)B_; list = list_; }
    __device__ __forceinline__ bool next(int i, Unit& u) const {
        constexpr int RUN = GU ? 2 : 1; const int hs = c + G * (i / RUN), per = nN / RUN;
        const int tile = hs / per, pn = (hs % per) * RUN + (i % RUN); if (tile * nN >= nunits) return false;
        const int e = (int)te[tile];
        u.pm = tile; u.pn = pn;
        if (GU) { u.A = Abase; u.B = Bbase + (size_t)e * WGU_E + (size_t)pn * 256 * D * 2; u.list = e < NE ? list + (size_t)e * LISTCAP : nullptr; u.m0 = (tile - (int)tb[e]) * 256; u.cnt = (int)cn[e]; }
        else { u.A = Abase + (size_t)tile * 256 * EH * 2; u.B = Bbase + (size_t)e * WDN_E + (size_t)pn * 256 * EH * 2; u.list = nullptr; u.m0 = 0; u.cnt = 0; }
        return true; }
    __device__ __forceinline__ int avload(const Unit& u, int h, int R) const { const int pos = u.m0 + h * 128 + R; const int pc = pos < u.cnt ? pos : (u.cnt > 0 ? u.cnt - 1 : 0); const int* lp = u.list ? u.list : list; return lp[pc]; }
    __device__ __forceinline__ unsigned avfin(const Unit& u, int h, int R, int C, int K_, int v) const { const int pos = u.m0 + h * 128 + R; int row = u.list ? v : pos; row = pos < u.cnt ? row : 0; return (unsigned)((row * K_ + C) * 2); }
    __device__ __forceinline__ unsigned avoff(const Unit& u, int h, int R, int C, int K_) const {
        if (GU) return avfin(u, h, R, C, K_, avload(u, h, R));
        else return (unsigned)(((h * 128 + R) * K_ + C) * 2); }
};
struct EpiSwiGLU { static constexpr bool PERM = true, INPLACE = false; bf16* H;
    __device__ __forceinline__ void operator()(const Acc& acc, const Unit& u, int wr, int wc, int fr, int fq) const {
        const int row0 = u.pm * 256 + wr * 64 + fr, col0 = u.pn * 128 + wc * 32 + 8 * fq;
#pragma unroll
        for (int ai = 0; ai < 2; ++ai)
#pragma unroll
            for (int m = 0; m < 4; ++m) { bf16* rowp = H + (size_t)(row0 + ai * 128 + m * 16) * EH + col0;
                float hv[8];
#pragma unroll
                for (int n = 0; n < 2; ++n)
#pragma unroll
                    for (int j = 0; j < 4; ++j) { const float g = acc[ai][0][m][n][j], uu = acc[ai][1][m][n][j]; hv[n * 4 + j] = g * pg8::sigmoidf_(g) * uu; }
                v4u w; w.x = pk2(hv[0], hv[1]); w.y = pk2(hv[2], hv[3]); w.z = pk2(hv[4], hv[5]); w.w = pk2(hv[6], hv[7]);
                *(v4u*)rowp = w; }
    }
};

struct EpiY8 { static constexpr bool PERM = true, INPLACE = false; unsigned char* Y8; bf16* YS;
    __device__ __forceinline__ void operator()(const Acc& acc, const Unit& u, int wr, int wc, int fr, int fq) const {
        const int row0 = u.pm * 256 + wr * 64 + fr, pos0 = u.pn * 256 + wc * 64 + fq * 16;
#pragma unroll
        for (int ai = 0; ai < 2; ++ai)
#pragma unroll
            for (int m = 0; m < 4; ++m) { const size_t row = (size_t)(row0 + ai * 128 + m * 16);
                v4u w; unsigned sw = 0u;
#pragma unroll
                for (int bj = 0; bj < 2; ++bj) { const f32x4 v0 = acc[ai][bj][m][0], v1 = acc[ai][bj][m][1];
                    const float am = fmaxf(fmaxf(fmaxf(fabsf(v0[0]), fabsf(v0[1])), fmaxf(fabsf(v0[2]), fabsf(v0[3]))), fmaxf(fmaxf(fabsf(v1[0]), fabsf(v1[1])), fmaxf(fabsf(v1[2]), fabsf(v1[3]))));
                    const unsigned sb = f2bf(am * (1.f / 127.f)); const float sc = __uint_as_float(sb << 16); const float inv = sc > 0.f ? __builtin_amdgcn_rcpf(sc) : 0.f;
                    unsigned q[8];
#pragma unroll
                    for (int j = 0; j < 4; ++j) { q[j] = (unsigned)fminf(rintf(v0[j] * inv + 128.f), 255.f); q[4 + j] = (unsigned)fminf(rintf(v1[j] * inv + 128.f), 255.f); }
                    const unsigned lo = q[0] | (q[1] << 8) | (q[2] << 16) | (q[3] << 24), hi = q[4] | (q[5] << 8) | (q[6] << 16) | (q[7] << 24);
                    if (bj == 0) { w.x = lo; w.y = hi; sw = sb; } else { w.z = lo; w.w = hi; sw |= sb << 16; } }
                *(v4u*)(Y8 + row * D + pos0) = w; *(unsigned*)(YS + row * (D / 8) + (pos0 >> 3)) = sw; }
    }
};
__device__ __forceinline__ void route_phase(const Frame& F, const bf16* __restrict__ Z, const float* __restrict__ g, const float* __restrict__ bb, const bf16* __restrict__ rwh, const float* __restrict__ rb,
                                            bf16* __restrict__ X1L, bf16* __restrict__ X1BF, unsigned* cnt, int* list, int* tokslot, float* tokw, bool dispatch = true) {
    LAS float* part = (LAS float*)(F.lds + RING_OFF);
    LAS float* lg = part + 4 * 4096;
    LAS float* sl = lg + 64 * 65;
    LAS unsigned* cntL = (LAS unsigned*)(sl + 64 * 65);
    LAS unsigned* baseL = cntL + 64;
    LAS unsigned* ee = baseL + 64;
    LAS unsigned* pl = ee + 512;
    LAS float* ww = (LAS float*)(pl + 512);
    for (int grp = blockIdx.x; grp < NTOK / 64; grp += F.G) {
        const int t0 = grp * 64;
        if (F.tid < 64) cntL[F.tid] = 0u;
        for (int rp_ = 0; rp_ < (ROUTE_PROBE == 1 ? 2 : 1); ++rp_)
#pragma unroll 2
        for (int q = 0; q < 8; ++q) {
            const int t = t0 + F.wave * 8 + q;
            const v2u* zr = (const v2u*)(Z + (size_t)t * D) + F.lane;
            f32x4 v[8]; float s = 0.f;
#pragma unroll
            for (int j = 0; j < 8; ++j) { const v2u zw = zr[64 * j]; v[j] = (f32x4){pg8::bf_lo(zw.x), pg8::bf_hi(zw.x), pg8::bf_lo(zw.y), pg8::bf_hi(zw.y)}; s += (v[j][0] + v[j][1]) + (v[j][2] + v[j][3]); }
            const float mean = wave_sum(s, F.lane) * (1.f / D); float s2 = 0.f;
#pragma unroll
            for (int j = 0; j < 8; ++j) { v[j] = v[j] - mean; s2 += (v[j][0] * v[j][0] + v[j][1] * v[j][1]) + (v[j][2] * v[j][2] + v[j][3] * v[j][3]); }
            const float rstd = 1.f / sqrtf(wave_sum(s2, F.lane) * (1.f / D) + LN_EPS);
            v2u* xl = (v2u*)(X1L + (size_t)t * D) + F.lane; v2u* xb = (v2u*)(X1BF + (size_t)t * D) + F.lane;
#pragma unroll
            for (int j = 0; j < 8; ++j) { const f32x4 gg = ((const f32x4*)g)[F.lane + 64 * j], bv = ((const f32x4*)bb)[F.lane + 64 * j];
                const f32x4 y = v[j] * rstd * gg + bv; v2u w; w.x = pk2(y[0], y[1]); w.y = pk2(y[2], y[3]); xb[64 * j] = w;
                v2u lo; lo.x = pk2(y[0] - pg8::bf_lo(w.x), y[1] - pg8::bf_hi(w.x)); lo.y = pk2(y[2] - pg8::bf_lo(w.y), y[3] - pg8::bf_hi(w.y)); xl[64 * j] = lo; }
        }
        VM_WAIT(); __syncthreads();
        for (int rp_ = 0; rp_ < (ROUTE_PROBE == 2 ? 2 : 1); ++rp_)
        { const int r = F.lane & 15, kq = F.lane >> 4, kb = (F.wave & 3) * 512, th = F.wave >> 2;
          const bf16* xh = X1BF + (size_t)(t0 + th * 32 + r) * D + kb + 8 * kq;
          const bf16* xl = X1L + (size_t)(t0 + th * 32 + r) * D + kb + 8 * kq;
          const bf16* wh = rwh + (size_t)r * D + kb + 8 * kq;
          f32x4 acc[2][4];
#pragma unroll
          for (int tt = 0; tt < 2; ++tt)
#pragma unroll
              for (int nb = 0; nb < 4; ++nb) acc[tt][nb] = (f32x4){0.f, 0.f, 0.f, 0.f};
          bf16x8 xA[2][2], xB[2][2]; bf16x8 hA[4], lA[4], hB[4], lB[4];
#define RT_LOAD(X, H, L, ks) do { const int k_ = ((ks) < 16 ? (ks) : 15) * 32; _Pragma("unroll") for (int tt = 0; tt < 2; ++tt) { X[tt][0] = *(const bf16x8*)(xh + (size_t)tt * 16 * D + k_); X[tt][1] = *(const bf16x8*)(xl + (size_t)tt * 16 * D + k_); } \
              _Pragma("unroll") for (int nb = 0; nb < 4; ++nb) { H[nb] = *(const bf16x8*)(wh + (size_t)nb * 16 * D + k_); L[nb] = *(const bf16x8*)(wh + (size_t)(64 + nb * 16) * D + k_); } } while (0)
#define RT_MMA(X, H, L) do { \
              _Pragma("unroll") for (int tt = 0; tt < 2; ++tt) _Pragma("unroll") for (int nb = 0; nb < 4; ++nb) acc[tt][nb] = __builtin_amdgcn_mfma_f32_16x16x32_bf16(X[tt][1], H[nb], acc[tt][nb], 0, 0, 0); \
              _Pragma("unroll") for (int tt = 0; tt < 2; ++tt) _Pragma("unroll") for (int nb = 0; nb < 4; ++nb) acc[tt][nb] = __builtin_amdgcn_mfma_f32_16x16x32_bf16(X[tt][0], L[nb], acc[tt][nb], 0, 0, 0); \
              _Pragma("unroll") for (int tt = 0; tt < 2; ++tt) _Pragma("unroll") for (int nb = 0; nb < 4; ++nb) acc[tt][nb] = __builtin_amdgcn_mfma_f32_16x16x32_bf16(X[tt][0], H[nb], acc[tt][nb], 0, 0, 0); } while (0)
          RT_LOAD(xA, hA, lA, 0);
#pragma unroll 1
          for (int ks = 0; ks < 16; ks += 2) {
              RT_LOAD(xB, hB, lB, ks + 1); RT_MMA(xA, hA, lA);
              RT_LOAD(xA, hA, lA, ks + 2); RT_MMA(xB, hB, lB);
          }
#undef RT_LOAD
#undef RT_MMA
#pragma unroll
          for (int tt = 0; tt < 2; ++tt)
#pragma unroll
              for (int nb = 0; nb < 4; ++nb)
#pragma unroll
                  for (int reg = 0; reg < 4; ++reg) part[(F.wave & 3) * 4096 + (th * 32 + tt * 16 + 4 * kq + reg) * 64 + nb * 16 + r] = acc[tt][nb][reg];
        }
        __syncthreads();
        for (int i = F.tid; i < 64 * 64; i += NWAVES * 64) { const int tk = i >> 6, e = i & 63; const float lgt = (part[i] + part[4096 + i]) + (part[8192 + i] + part[12288 + i]);
            const float sc = 1.f / (1.f + __expf(-lgt)); lg[tk * 65 + e] = sc; sl[tk * 65 + e] = sc + rb[e]; }
        __syncthreads();
        for (int rp_ = 0; rp_ < (ROUTE_PROBE == 3 ? 2 : 1); ++rp_)
        { const bool lastrp = (rp_ == (ROUTE_PROBE == 3 ? 1 : 0));
          const int tk = F.wave * 8 + (F.lane >> 3), gq = F.lane & 7, lane = F.lane;
          float sv[8], cv[8];
#pragma unroll
          for (int j = 0; j < 8; ++j) { sv[j] = sl[tk * 65 + gq * 8 + j]; cv[j] = lg[tk * 65 + gq * 8 + j]; }
          float m1 = -INFINITY, m2 = -INFINITY;
#pragma unroll
          for (int j = 0; j < 8; ++j) { const float x = sv[j]; const bool g1 = x > m1; m2 = g1 ? m1 : fmaxf(m2, x); m1 = g1 ? x : m1; }
          const float gs = m1 + m2;
          int rank = 0;
#pragma unroll
          for (int o = 1; o < 8; ++o) { const float og = shx(gs, o, lane); const int oq = gq ^ o; rank += (og > gs || (og == gs && oq < gq)) ? 1 : 0; }
          const bool gsel = rank < 4;
          unsigned used = gsel ? 0u : 0xffu;
          float wsum = 0.f; float my_sc = 0.f; int my_e = 0;
#pragma unroll
          for (int i = 0; i < 8; ++i) {
              float bv = -INFINITY, bs = 0.f; int be = 64;
#pragma unroll
              for (int j = 0; j < 8; ++j) { const bool ok = !((used >> j) & 1u) && sv[j] > bv; bv = ok ? sv[j] : bv; bs = ok ? cv[j] : bs; be = ok ? gq * 8 + j : be; }
#pragma unroll
              for (int o = 1; o < 8; o <<= 1) { const float ov = shx(bv, o, lane), os = shx(bs, o, lane); const int oe = __float_as_int(shx(__int_as_float(be), o, lane));
                  const bool tk_o = ov > bv || (ov == bv && oe < be); bv = tk_o ? ov : bv; bs = tk_o ? os : bs; be = tk_o ? oe : be; }
              if ((be >> 3) == gq) used |= 1u << (be & 7);
              wsum += bs; if (gq == i) { my_sc = bs; my_e = be; }
          }
          const int slot = tk * 8 + gq;
          ee[slot] = (unsigned)my_e; ww[slot] = my_sc * (RSCALE / wsum);
          pl[slot] = __hip_atomic_fetch_add(cntL + my_e, (dispatch && lastrp) ? 1u : 0u, __ATOMIC_RELAXED, __HIP_MEMORY_SCOPE_WORKGROUP);
        }
        __syncthreads();
        if (F.tid < 64) { const unsigned n = cntL[F.tid]; baseL[F.tid] = n ? __hip_atomic_fetch_add(cnt + F.tid, n, RLX_AGENT) : 0u; }
        __syncthreads();
        if (dispatch) { const int tk = F.tid >> 3, i = F.tid & 7; const unsigned e = ee[F.tid]; const unsigned pos = baseL[e] + pl[F.tid]; const int t = t0 + tk;
          list[(size_t)e * LISTCAP + pos] = t; tokslot[t * 8 + i] = (int)(e * LISTCAP + pos); tokw[t * 8 + i] = ww[F.tid]; }
        __syncthreads();
    }
}
__device__ __forceinline__ void combine_phase(const Frame& F, const bf16* X1B, const unsigned char* Y8, const bf16* YS, const int* tokslot, const float* tokw, const float* g, const float* bb, float* OUT, bf16* XBF, bool last) {
    const LAS unsigned* tb = (const LAS unsigned*)(F.lds + PLAN_TB);
    LAS int* rw = (LAS int*)(F.lds + RING_OFF) + F.wave * 32;
#define CB_LOAD(W, S, ROW) do { const int r_ = __builtin_amdgcn_readfirstlane(ROW); const v2u* yr_ = (const v2u*)(Y8 + (size_t)r_ * D) + F.lane; const bf16* ys_ = YS + (size_t)r_ * (D / 8) + F.lane; \
        _Pragma("unroll") for (int j = 0; j < 4; ++j) { W[j] = yr_[64 * j]; S[j] = ys_[64 * j]; } } while (0)
#define CB_ACC(W, S, WT) do { const float wt_ = __int_as_float(__builtin_amdgcn_readfirstlane(WT)); _Pragma("unroll") for (int j = 0; j < 4; ++j) { const float sc = bf2f(S[j]) * wt_, c0 = -128.f * sc; const unsigned x = W[j].x, y = W[j].y; \
        v[j][0] += sc * (float)(x & 255u) + c0; v[j][1] += sc * (float)((x >> 8) & 255u) + c0; v[j][2] += sc * (float)((x >> 16) & 255u) + c0; v[j][3] += sc * (float)(x >> 24) + c0; \
        v[j][4] += sc * (float)(y & 255u) + c0; v[j][5] += sc * (float)((y >> 8) & 255u) + c0; v[j][6] += sc * (float)((y >> 16) & 255u) + c0; v[j][7] += sc * (float)(y >> 24) + c0; } } while (0)
    const int cl = (F.lane >> 5) * 256 + (F.lane & 1) * 128 + ((F.lane >> 3) & 3) * 32 + ((F.lane >> 1) & 3) * 8;
    for (int t = F.gw; t < NTOK; t += F.NGW) {
        if (F.lane < 8) { const int sl = tokslot[t * 8 + F.lane]; rw[F.lane] = (int)tb[sl / LISTCAP] * 256 + (sl % LISTCAP); rw[16 + F.lane] = __float_as_int(tokw[t * 8 + F.lane]); }
        if (F.lane == 8) { rw[8] = (int)tb[NE] * 256 + t; rw[24] = __float_as_int(1.f); }
        LDS_WAIT(); asm volatile("" ::: "memory");
        float v[4][8]; float s = 0.f;
        v2u wa[4], wb[4], wc[4]; bf16 sa[4], sb2[4], sc2[4];
        CB_LOAD(wa, sa, rw[0]); CB_LOAD(wb, sb2, rw[1]); CB_LOAD(wc, sc2, rw[2]);
#pragma unroll
        for (int j = 0; j < 4; ++j) { const v4u xw = *(const v4u*)(X1B + (size_t)t * D + 512 * j + cl);
            v[j][0] = pg8::bf_lo(xw.x) * ALPHA; v[j][1] = pg8::bf_hi(xw.x) * ALPHA; v[j][2] = pg8::bf_lo(xw.y) * ALPHA; v[j][3] = pg8::bf_hi(xw.y) * ALPHA;
            v[j][4] = pg8::bf_lo(xw.z) * ALPHA; v[j][5] = pg8::bf_hi(xw.z) * ALPHA; v[j][6] = pg8::bf_lo(xw.w) * ALPHA; v[j][7] = pg8::bf_hi(xw.w) * ALPHA; }
#pragma unroll 1
        for (int i = 0; i < 9; i += 3) {
            CB_ACC(wa, sa, rw[16 + i]); if (i < 6) CB_LOAD(wa, sa, rw[i + 3]);
            CB_ACC(wb, sb2, rw[17 + i]); if (i < 6) CB_LOAD(wb, sb2, rw[i + 4]);
            CB_ACC(wc, sc2, rw[18 + i]); if (i < 6) CB_LOAD(wc, sc2, rw[i + 5]);
        }
        asm volatile("" ::: "memory");
#pragma unroll
        for (int j = 0; j < 4; ++j)
#pragma unroll
            for (int e = 0; e < 8; ++e) s += v[j][e];
        const float mean = wave_sum(s, F.lane) * (1.f / D); float s2 = 0.f;
#pragma unroll
        for (int j = 0; j < 4; ++j)
#pragma unroll
            for (int e = 0; e < 8; ++e) { v[j][e] -= mean; s2 += v[j][e] * v[j][e]; }
        const float rstd = 1.f / sqrtf(wave_sum(s2, F.lane) * (1.f / D) + LN_EPS);
#pragma unroll
        for (int j = 0; j < 4; ++j) { const int c0 = cl + 512 * j; const f32x4 g0 = *(const f32x4*)(g + c0), g1 = *(const f32x4*)(g + c0 + 4), b0 = *(const f32x4*)(bb + c0), b1 = *(const f32x4*)(bb + c0 + 4);
            f32x4 y0, y1;
#pragma unroll
            for (int e = 0; e < 4; ++e) { y0[e] = v[j][e] * rstd * g0[e] + b0[e]; y1[e] = v[j][4 + e] * rstd * g1[e] + b1[e]; }
            if (last) { *(f32x4*)(OUT + (size_t)t * D + c0) = y0; *(f32x4*)(OUT + (size_t)t * D + c0 + 4) = y1; }
            else { v4u w; w.x = pk2(y0[0], y0[1]); w.y = pk2(y0[2], y0[3]); w.z = pk2(y1[0], y1[1]); w.w = pk2(y1[2], y1[3]); *(v4u*)(XBF + (size_t)t * D + c0) = w; } }
    }
#undef CB_LOAD
#undef CB_ACC
}
constexpr size_t R2_UT = 0, R2_OI = 48 * MiB, R2_QP = 96 * MiB, R2_DEC = 120 * MiB;
constexpr int NHU = NB * HGH * (SEQ / 64);
typedef __attribute__((address_space(3))) bf16 lbf16;
__device__ __forceinline__ void unpack8(const v4u w, float (&f)[8]) {
    f[0] = pg8::bf_lo(w.x); f[1] = pg8::bf_hi(w.x); f[2] = pg8::bf_lo(w.y); f[3] = pg8::bf_hi(w.y); f[4] = pg8::bf_lo(w.z); f[5] = pg8::bf_hi(w.z); f[6] = pg8::bf_lo(w.w); f[7] = pg8::bf_hi(w.w); }
__device__ __forceinline__ float exp_c(float x) { return __expf(fminf(x, 80.f)); }

__device__ __forceinline__ void conv_part(const Frame& F, const bf16* proj, const float* cw, bf16* YA, bf16* YX) {
    for (int i = blockIdx.x * 512 + F.tid; i < NTOK * 32; i += F.G * 512) *(v4u*)(YX + (size_t)(i >> 5) * YXW + XAW + (i & 31) * 8) = (v4u){0u, 0u, 0u, 0u};
    for (int i = blockIdx.x * 512 + F.tid; i < NTOK * (CW / 8); i += F.G * 512) {
        const int t = i / (CW / 8), c = (i % (CW / 8)) * 8, pos = t & (SEQ - 1);
        const bf16* r = proj + (size_t)t * INC;
        float u0[8], c0[8], b0[8], u1[8], c1[8], u2[8], c2[8], w0[8], w1[8], w2[8];
        unpack8(*(const v4u*)(r + C_U + c), u0); unpack8(*(const v4u*)(r + C_C + c), c0); unpack8(*(const v4u*)(r + C_B + c), b0);
        const v4u z4 = {0u, 0u, 0u, 0u};
        unpack8(pos >= 1 ? *(const v4u*)(r - INC + C_U + c) : z4, u1); unpack8(pos >= 1 ? *(const v4u*)(r - INC + C_C + c) : z4, c1);
        unpack8(pos >= 2 ? *(const v4u*)(r - 2 * INC + C_U + c) : z4, u2); unpack8(pos >= 2 ? *(const v4u*)(r - 2 * INC + C_C + c) : z4, c2);
#pragma unroll
        for (int j = 0; j < 8; ++j) { w0[j] = cw[c + j]; w1[j] = cw[CW + c + j]; w2[j] = cw[2 * CW + c + j]; }
        float o[8];
#pragma unroll
        for (int j = 0; j < 8; ++j) o[j] = b0[j] * (w2[j] * c0[j] * u0[j] + w1[j] * c1[j] * u1[j] + w0[j] * c2[j] * u2[j]);
        v4u w; w.x = pk2(o[0], o[1]); w.y = pk2(o[2], o[3]); w.z = pk2(o[4], o[5]); w.w = pk2(o[6], o[7]);
        *(v4u*)(YA + (size_t)t * CW + c) = w;
    }
}

__device__ __forceinline__ void hgrn_local(const Frame& F, const bf16* proj, const float* lbl, int layer, unsigned char* r2) {
    lbf16* QS = (lbf16*)(F.lds);
    lbf16* KS = QS + 64 * 136;
    lbf16* KPT = KS + 64 * 136;
    lbf16* VT = KPT + 128 * 72;
    lbf16* PS = VT + 128 * 72;
    LAS float* SEG = (LAS float*)(PS + 64 * 72);
    bf16* UT = (bf16*)(r2 + R2_UT); bf16* OI = (bf16*)(r2 + R2_OI); bf16* QP = (bf16*)(r2 + R2_QP); float* DEC = (float*)(r2 + R2_DEC);
    const int lane = F.lane, wv = F.wave, r = lane & 15, kq = lane >> 4;
    bf16 rf[16], rq[16], rv[16];
#define HL_LOAD(U) do { const int b_ = (U) / (HGH * 64), h_ = ((U) / 64) % HGH, c_ = (U) % 64; const bf16* p_ = proj + (size_t)(b_ * SEQ + c_ * 64 + (F.tid >> 7) * 16) * INC + h_ * HGD + (F.tid & 127); \
        _Pragma("unroll") for (int i = 0; i < 16; ++i) { rf[i] = p_[(size_t)i * INC + C_F]; rq[i] = p_[(size_t)i * INC + C_Q]; rv[i] = p_[(size_t)i * INC + C_I]; } } while (0)
    if ((int)blockIdx.x < NHU) HL_LOAD((int)blockIdx.x);
    for (int unit = blockIdx.x; unit < NHU; unit += F.G) {
        const int b = unit / (HGH * 64), h = (unit / 64) % HGH, c = unit % 64, t0 = b * SEQ + c * 64;
        { const int col = F.tid & 127, seg = F.tid >> 7, ch = h * HGD + col;
          float lb = 0.f; if (layer == 1) lb = 1.f / (1.f + __expf(lbl[ch] - lbl[HGW + ch]));
          float a[16], kk[16], qv[16], vv[16]; float run = 0.f;
#pragma unroll
          for (int i = 0; i < 16; ++i) {
              const float z = bf2f(rf[i]); const float ez = __expf(-z); const float sg = 1.f / (1.f + ez);
              const float f = lb + (1.f - lb) * sg; kk[i] = (1.f - lb) * ez * sg; run += fmaxf(__logf(f), -60.f); a[i] = run;
              qv[i] = bf2f(rq[i]); vv[i] = bf2f(rv[i]); }
          if (unit + F.G < NHU) HL_LOAD(unit + F.G);
          SEG[seg * 128 + col] = run;
          __syncthreads();
          const float s0 = SEG[col], s1 = SEG[128 + col], s2 = SEG[256 + col], s3 = SEG[384 + col];
          const float base = seg == 0 ? 0.f : (seg == 1 ? s0 : (seg == 2 ? s0 + s1 : s0 + s1 + s2)), bm = s0 + s1, bl = (s0 + s1) + (s2 + s3);
          float kp[16];
#pragma unroll
          for (int i = 0; i < 16; ++i) { const float bb = base + a[i]; const int t = seg * 16 + i;
              QS[t * 136 + col] = f2bf(qv[i] * exp_c(bb - bm)); KS[t * 136 + col] = f2bf(kk[i] * exp_c(bm - bb)); kp[i] = kk[i] * exp_c(bl - bb);
              QP[(size_t)(t0 + t) * HGW + ch] = f2bf(qv[i] * exp_c(bb)); }
          v4u w0, w1; w0.x = pk2(kp[0], kp[1]); w0.y = pk2(kp[2], kp[3]); w0.z = pk2(kp[4], kp[5]); w0.w = pk2(kp[6], kp[7]); w1.x = pk2(kp[8], kp[9]); w1.y = pk2(kp[10], kp[11]); w1.z = pk2(kp[12], kp[13]); w1.w = pk2(kp[14], kp[15]);
          *(LAS v4u*)(KPT + col * 72 + seg * 16) = w0; *(LAS v4u*)(KPT + col * 72 + seg * 16 + 8) = w1;
          w0.x = pk2(vv[0], vv[1]); w0.y = pk2(vv[2], vv[3]); w0.z = pk2(vv[4], vv[5]); w0.w = pk2(vv[6], vv[7]); w1.x = pk2(vv[8], vv[9]); w1.y = pk2(vv[10], vv[11]); w1.z = pk2(vv[12], vv[13]); w1.w = pk2(vv[14], vv[15]);
          *(LAS v4u*)(VT + col * 72 + seg * 16) = w0; *(LAS v4u*)(VT + col * 72 + seg * 16 + 8) = w1;
          if (seg == 0) DEC[(size_t)unit * 128 + col] = exp_c(bl);
        }
        __syncthreads();
        { const int tm = wv >> 1, tn0 = (wv & 1) * 2;
          bf16x8 af[4];
#pragma unroll
          for (int ks = 0; ks < 4; ++ks) af[ks] = *(const LAS bf16x8*)(QS + (tm * 16 + r) * 136 + ks * 32 + kq * 8);
#pragma unroll
          for (int jn = 0; jn < 2; ++jn) { const int tn = tn0 + jn; f32x4 acc = {0.f, 0.f, 0.f, 0.f};
              if (tn <= tm) {
#pragma unroll
                  for (int ks = 0; ks < 4; ++ks) { const bf16x8 bf = *(const LAS bf16x8*)(KS + (tn * 16 + r) * 136 + ks * 32 + kq * 8); acc = __builtin_amdgcn_mfma_f32_16x16x32_bf16(af[ks], bf, acc, 0, 0, 0); } }
#pragma unroll
              for (int g = 0; g < 4; ++g) { const int t = tm * 16 + 4 * kq + g, s = tn * 16 + r; PS[t * 72 + s] = f2bf(s <= t ? acc[g] : 0.f); } } }
        { bf16x8 af[2];
#pragma unroll
          for (int ks = 0; ks < 2; ++ks) af[ks] = *(const LAS bf16x8*)(KPT + (wv * 16 + r) * 72 + ks * 32 + kq * 8);
#pragma unroll
          for (int tv = 0; tv < 8; ++tv) { f32x4 acc = {0.f, 0.f, 0.f, 0.f};
#pragma unroll
              for (int ks = 0; ks < 2; ++ks) { const bf16x8 bf = *(const LAS bf16x8*)(VT + (tv * 16 + r) * 72 + ks * 32 + kq * 8); acc = __builtin_amdgcn_mfma_f32_16x16x32_bf16(af[ks], bf, acc, 0, 0, 0); }
              v2u w; w.x = pk2(acc[0], acc[1]); w.y = pk2(acc[2], acc[3]);
              *(v2u*)(UT + (size_t)unit * 16384 + (tv * 16 + r) * 128 + wv * 16 + 4 * kq) = w; } }
        __syncthreads();
        { const int tm = wv & 3, tvg = wv >> 2;
          bf16x8 pf[2];
#pragma unroll
          for (int ks = 0; ks < 2; ++ks) pf[ks] = *(const LAS bf16x8*)(PS + (tm * 16 + r) * 72 + ks * 32 + kq * 8);
#pragma unroll
          for (int j = 0; j < 4; ++j) { const int tv = tvg * 4 + j; f32x4 acc = {0.f, 0.f, 0.f, 0.f};
#pragma unroll
              for (int ks = 0; ks < 2; ++ks) { const bf16x8 vf = *(const LAS bf16x8*)(VT + (tv * 16 + r) * 72 + ks * 32 + kq * 8); acc = __builtin_amdgcn_mfma_f32_16x16x32_bf16(vf, pf[ks], acc, 0, 0, 0); }
              v2u ow; ow.x = pk2(acc[0], acc[1]); ow.y = pk2(acc[2], acc[3]); *(v2u*)(OI + (size_t)(t0 + tm * 16 + r) * HGW + h * HGD + tv * 16 + 4 * kq) = ow; } }
        __syncthreads();
    }
#undef HL_LOAD
}
__device__ __forceinline__ void hgrn_scan(const Frame& F, const unsigned char* r2, v2u* __restrict__ SB64) {
    const v2u* __restrict__ UT64 = (const v2u*)(r2 + R2_UT); const f32x4* __restrict__ DEC4 = (const f32x4*)(r2 + R2_DEC);
    for (int it = blockIdx.x * 512 + F.tid; it < NB * HGH * 128 * 32; it += F.G * 512) {
        const int bh = it >> 12, v = (it >> 5) & 127, k4 = it & 31;
        f32x4 s = {0.f, 0.f, 0.f, 0.f};
#pragma unroll 8
        for (int c = 0; c < 64; ++c) { const size_t unit = (size_t)bh * 64 + c; const size_t idx = unit * 4096 + v * 32 + k4;
            const v2u w = UT64[idx]; const f32x4 d = DEC4[unit * 32 + k4];
            v2u o; o.x = pk2(s[0], s[1]); o.y = pk2(s[2], s[3]); SB64[idx] = o;
            s[0] = d[0] * s[0] + pg8::bf_lo(w.x); s[1] = d[1] * s[1] + pg8::bf_hi(w.x); s[2] = d[2] * s[2] + pg8::bf_lo(w.y); s[3] = d[3] * s[3] + pg8::bf_hi(w.y); }
    }
}
struct HoutOps { bf16x8 af[4]; bf16x8 bfr[4][4]; };
__device__ __forceinline__ void hout_load(HoutOps& O, int unit, const bf16* proj, const bf16* OI, const bf16* QP, const bf16* SB, int r, int kq, int tm, int tvg) {
    const int b = unit / (HGH * 64), h = (unit / 64) % HGH, c = unit % 64, t0 = b * SEQ + c * 64;
#pragma unroll
    for (int ks = 0; ks < 4; ++ks) O.af[ks] = *(const bf16x8*)(QP + (size_t)(t0 + tm * 16 + r) * HGW + h * HGD + ks * 32 + kq * 8);
#pragma unroll
    for (int j = 0; j < 4; ++j)
#pragma unroll
        for (int ks = 0; ks < 4; ++ks) O.bfr[j][ks] = *(const bf16x8*)(SB + (size_t)unit * 16384 + ((tvg * 4 + j) * 16 + r) * 128 + ks * 32 + kq * 8);
}
__device__ __forceinline__ void hout_compute(const HoutOps& O, int unit, const bf16* proj, const bf16* OI, LAS float* SSQ, const float* gain, bf16* YB, int lane, int r, int kq, int tm, int tvg) {
    const int b = unit / (HGH * 64), h = (unit / 64) % HGH, c = unit % 64, t0 = b * SEQ + c * 64;
    const size_t t = (size_t)(t0 + tm * 16 + r);
    f32x4 oi[4]; v2u gtw[4];
#pragma unroll
    for (int j = 0; j < 4; ++j) { const int ch = h * HGD + (tvg * 4 + j) * 16 + 4 * kq; { const v2u ow = *(const v2u*)(OI + t * HGW + ch); oi[j] = (f32x4){pg8::bf_lo(ow.x), pg8::bf_hi(ow.x), pg8::bf_lo(ow.y), pg8::bf_hi(ow.y)}; } gtw[j] = *(const v2u*)(proj + t * INC + C_G + ch); }
    f32x4 acc[4]; float q = 0.f;
#pragma unroll
    for (int j = 0; j < 4; ++j) { acc[j] = (f32x4){0.f, 0.f, 0.f, 0.f};
#pragma unroll
        for (int ks = 0; ks < 4; ++ks) acc[j] = __builtin_amdgcn_mfma_f32_16x16x32_bf16(O.bfr[j][ks], O.af[ks], acc[j], 0, 0, 0); }
#pragma unroll
    for (int j = 0; j < 4; ++j) { acc[j] += oi[j]; q += (acc[j][0] * acc[j][0] + acc[j][1] * acc[j][1]) + (acc[j][2] * acc[j][2] + acc[j][3] * acc[j][3]); }
    q += shx(q, 16, lane); q += shx(q, 32, lane);
    if (kq == 0) SSQ[tvg * 64 + tm * 16 + r] = q;
    __syncthreads();
    const float rs = rsqrtf((SSQ[tm * 16 + r] + SSQ[64 + tm * 16 + r]) * (1.f / 128.f) + RMS_EPS);
#pragma unroll
    for (int j = 0; j < 4; ++j) { const int ch = h * HGD + (tvg * 4 + j) * 16 + 4 * kq; const f32x4 gn = *(const f32x4*)(gain + ch);
        const float g0 = pg8::bf_lo(gtw[j].x), g1 = pg8::bf_hi(gtw[j].x), g2 = pg8::bf_lo(gtw[j].y), g3 = pg8::bf_hi(gtw[j].y);
        v2u w; w.x = pk2(acc[j][0] * rs * gn[0] * g0 * pg8::sigmoidf_(g0), acc[j][1] * rs * gn[1] * g1 * pg8::sigmoidf_(g1));
        w.y = pk2(acc[j][2] * rs * gn[2] * g2 * pg8::sigmoidf_(g2), acc[j][3] * rs * gn[3] * g3 * pg8::sigmoidf_(g3));
        *(v2u*)(YB + t * HGW + ch) = w; }
    __syncthreads();
}
__device__ __forceinline__ void hgrn_out(const Frame& F, const bf16* proj, const unsigned char* r2, const bf16* SB, const float* gain, bf16* YB) {
    LAS float* SSQ = (LAS float*)F.lds;
    const bf16* OI = (const bf16*)(r2 + R2_OI); const bf16* QP = (const bf16*)(r2 + R2_QP);
    const int lane = F.lane, wv = F.wave, r = lane & 15, kq = lane >> 4, tm = wv & 3, tvg = wv >> 2;
    HoutOps A, B;
    int unit = blockIdx.x;
    if (unit < NHU) hout_load(A, unit, proj, OI, QP, SB, r, kq, tm, tvg);
    for (; unit < NHU; unit += 2 * F.G) {
        const int u2 = unit + F.G, u3 = unit + 2 * F.G;
        if (u2 < NHU) hout_load(B, u2, proj, OI, QP, SB, r, kq, tm, tvg);
        hout_compute(A, unit, proj, OI, SSQ, gain, YB, lane, r, kq, tm, tvg);
        if (u2 < NHU) { if (u3 < NHU) hout_load(A, u3, proj, OI, QP, SB, r, kq, tm, tvg);
            hout_compute(B, u2, proj, OI, SSQ, gain, YB, lane, r, kq, tm, tvg); }
    }
}
__device__ __forceinline__ void memattn(const Frame& F, const bf16* proj, const bf16* KV, int layer, bf16* YX) {
    lbf16* Ks = (lbf16*)F.lds;
    lbf16* VTs = Ks + 256 * 136;
    const int lane = F.lane, wv = F.wave, r = lane & 15, kq = lane >> 4;
    for (int unit = blockIdx.x; unit < NB * XAH * (SEQ / 256); unit += F.G) {
        const int b = unit >> 6, hd = (unit >> 4) & 3, qt = unit & 15;
#pragma unroll
        for (int i = 0; i < 8; ++i) { const int p = F.tid + 512 * i, key = p >> 4, dc = (p & 15) * 8;
            const bf16* src = KV + (size_t)(b * NMEM + key) * 2048 + layer * 1024 + hd * XAD + dc;
            *(LAS v4u*)(Ks + key * 136 + dc) = *(const v4u*)src;
            const v4u w = *(const v4u*)(src + 512);
            const int k5 = key & 31, pos = (key & ~31) + 8 * ((k5 >> 2) & 3) + 4 * ((k5 >> 4) & 1) + (k5 & 3);
            lbf16* d = VTs + dc * 264 + pos;
            d[0] = (bf16)(w.x & 0xffffu); d[264] = (bf16)(w.x >> 16); d[2 * 264] = (bf16)(w.y & 0xffffu); d[3 * 264] = (bf16)(w.y >> 16);
            d[4 * 264] = (bf16)(w.z & 0xffffu); d[5 * 264] = (bf16)(w.z >> 16); d[6 * 264] = (bf16)(w.w & 0xffffu); d[7 * 264] = (bf16)(w.w >> 16); }
        __syncthreads();
#pragma unroll 1
        for (int g = 0; g < 2; ++g) {
            const int t = b * SEQ + qt * 256 + wv * 32 + g * 16 + r;
            bf16x8 qf[4];
#pragma unroll
            for (int ks = 0; ks < 4; ++ks) qf[ks] = *(const bf16x8*)(proj + (size_t)t * INC + C_QX + hd * XAD + ks * 32 + kq * 8);
            f32x4 s[16];
#pragma unroll
            for (int kt = 0; kt < 16; ++kt) { s[kt] = (f32x4){0.f, 0.f, 0.f, 0.f};
#pragma unroll
                for (int ks = 0; ks < 4; ++ks) { const bf16x8 a = *(const LAS bf16x8*)(Ks + (kt * 16 + r) * 136 + ks * 32 + kq * 8); s[kt] = __builtin_amdgcn_mfma_f32_16x16x32_bf16(a, qf[ks], s[kt], 0, 0, 0); }
                if (kt & 1) __builtin_amdgcn_sched_barrier(0); }
            float m = -1e30f;
#pragma unroll
            for (int kt = 0; kt < 16; ++kt) m = fmaxf(m, fmaxf(fmaxf(s[kt][0], s[kt][1]), fmaxf(s[kt][2], s[kt][3])));
            m = fmaxf(m, shx(m, 16, lane)); m = fmaxf(m, shx(m, 32, lane));
            const float cs = 0.08838834764831845f * 1.4426950408889634f; float l = 0.f;
#pragma unroll
            for (int kt = 0; kt < 16; ++kt)
#pragma unroll
                for (int e = 0; e < 4; ++e) { const float p = __builtin_amdgcn_exp2f((s[kt][e] - m) * cs); s[kt][e] = p; l += p; }
            l += shx(l, 16, lane); l += shx(l, 32, lane);
            f32x4 o[8];
#pragma unroll
            for (int dt = 0; dt < 8; ++dt) o[dt] = (f32x4){0.f, 0.f, 0.f, 0.f};
#pragma unroll
            for (int j = 0; j < 8; ++j) {
                v4u pw; pw.x = pk2(s[2 * j][0], s[2 * j][1]); pw.y = pk2(s[2 * j][2], s[2 * j][3]); pw.z = pk2(s[2 * j + 1][0], s[2 * j + 1][1]); pw.w = pk2(s[2 * j + 1][2], s[2 * j + 1][3]);
                const bf16x8 pf = __builtin_bit_cast(bf16x8, pw);
#pragma unroll
                for (int dt = 0; dt < 8; ++dt) { const bf16x8 a = *(const LAS bf16x8*)(VTs + (dt * 16 + r) * 264 + j * 32 + kq * 8); o[dt] = __builtin_amdgcn_mfma_f32_16x16x32_bf16(a, pf, o[dt], 0, 0, 0); }
                __builtin_amdgcn_sched_barrier(0); }
            const float inv = 1.f / l;
#pragma unroll
            for (int dt = 0; dt < 8; ++dt) { v2u w; w.x = pk2(o[dt][0] * inv, o[dt][1] * inv); w.y = pk2(o[dt][2] * inv, o[dt][3] * inv);
                *(v2u*)(YX + (size_t)t * YXW + hd * XAD + dt * 16 + 4 * kq) = w; }
        }
        __syncthreads();
    }
}
struct Args { const float* in[24]; float* out; unsigned char* ws; int ph_lo, ph_hi, mask, pad; };
typedef const __attribute__((address_space(4))) Args* KArgs;
__device__ __forceinline__ KArgs kargs() { KArgs p = (KArgs)__builtin_amdgcn_kernarg_segment_ptr(); asm volatile("" : "+s"(p)); return p; }
#define WSP(T, off) ((T*)(ws + (off)))
__global__ void __launch_bounds__(NWAVES * 64, 2) mk_fwd(Args args) {
    extern __shared__ __attribute__((aligned(16))) unsigned char lds_raw[];
    Frame F0; F0.lds = (LAS unsigned char*)lds_raw; F0.tid = threadIdx.x; F0.lane = F0.tid & 63; F0.wave = __builtin_amdgcn_readfirstlane(F0.tid >> 6);
    F0.G = gridDim.x; F0.gw = blockIdx.x * NWAVES + F0.wave; F0.NGW = F0.G * NWAVES;
    volatile LAS unsigned* MISC = (volatile LAS unsigned*)(F0.lds + MISC_OFF);
    for (int u = F0.tid; u < (LDS_BYTES - MISC_OFF) / 4; u += NWAVES * 64) ((LAS unsigned*)(F0.lds + MISC_OFF))[u] = 0u;
    __syncthreads();
    const int lo = args.ph_lo, hi = args.ph_hi;
    const bool multi = (hi - lo) > 1;
    XcdBarrier bar; bar.bar = (unsigned*)(args.ws + WS_CTL) + CW_BAR; bar.x = 0; bar.st = nullptr;
    if (multi) bar = xcd_barrier_post((unsigned*)(args.ws + WS_CTL) + CW_BAR, MISC + 8);
#define IN(k) (lo <= (k) && (k) < hi)
#define SEAM(k) do { if (IN((k) + 1)) xcd_barrier(bar); } while (0)
#define PH_BEGIN KArgs ka = kargs(); unsigned char* ws = ka->ws; (void)ws; Frame F = F0; F.lane = pg8::lane_id_opaque(); F.tid = F0.wave * 64 + F.lane
    if (IN(PH_CVT)) {
        { PH_BEGIN;
        unsigned gb = 0;
        for (int l = 0; l < 2; ++l) {
            xpose_matrix(F, ka->in[2] + (size_t)l * D * INC, D, INC, (bf16*)(ws + WS_WIN_T + l * WIN_T_L), D, 0, gb);
            xpose_matrix(F, ka->in[4] + (size_t)l * CW * D, CW, D, (bf16*)(ws + WS_WBR_T + l * WBR_T_L), CW, 0, gb);
            xpose_matrix(F, ka->in[7] + (size_t)l * HGW * D, HGW, D, (bf16*)(ws + WS_WBR_T + l * WBR_T_L + 3 * MiB), HGW, 0, gb);
            xpose_matrix(F, ka->in[10] + (size_t)l * XAW * D, XAW, D, (bf16*)(ws + WS_WBR_T + l * WBR_T_L + 6 * MiB), YXW, 0, gb);
            for (int i = blockIdx.x * 512 + F.tid; i < D * 32; i += F.G * 512) *(v4u*)((bf16*)(ws + WS_WBR_T + l * WBR_T_L + 6 * MiB) + (size_t)(i >> 5) * YXW + XAW + (i & 31) * 8) = (v4u){0u, 0u, 0u, 0u};
            xpose_matrix(F, ka->in[11] + (size_t)l * D * D, D, D, (bf16*)(ws + WS_WO_T + l * WO_T_L), D, 0, gb);
            xpose_matrix(F, ka->in[8] + (size_t)l * D * XAW, D, XAW, (bf16*)(ws + WS_WKV_T) + (size_t)(l * 1024) * D, D, 0, gb);
            xpose_matrix(F, ka->in[9] + (size_t)l * D * XAW, D, XAW, (bf16*)(ws + WS_WKV_T) + (size_t)(l * 1024 + 512) * D, D, 0, gb);
        }
        cvt_router(F, ka->in[14], ws);
        cvt_rows(F, ka->in[0], WSP(bf16, WS_XBF), (size_t)NTOK * D / 8);
        cvt_rows(F, ka->in[1], WSP(bf16, WS_MEMBF), (size_t)NB * NMEM * D / 8);
        }
        SEAM(PH_CVT);
    }
    for (int l = 0; l < 2; ++l) {
        const int pb = PH_L0 + l * PH_PER_LAYER;
        if (IN(pb + P_INPROJ)) {
            { PH_BEGIN;
            const bool split = F.G == 256;
            const int oa = (int)blockIdx.x >> 3, ox = (int)blockIdx.x & 7; const bool conv = split && (oa & 3) == 3;
            const int hrank = 8 * (oa >> 2) + ox, grank = 8 * (oa - ((oa + 1) >> 2)) + ox;
            static_assert((256 - NCV) * GM_UNITS + NCV * CV_UNITS == (NTOK / 256) * (INC / 256), "in-projection unit shares");
            if (conv) { Frame Fc = F; Fc.gw = hrank * NWAVES + F.wave; Fc.NGW = NCV * NWAVES; unsigned gb = 0;
                cvt_experts(Fc, ka->in[16] + (size_t)l * NE * D * EH, ka->in[17] + (size_t)l * NE * D * EH, ka->in[18] + (size_t)l * NE * EH * D, ka->in[19] + (size_t)l * D * EH, ka->in[20] + (size_t)l * D * EH, ka->in[21] + (size_t)l * EH * D, ws, gb);
                __syncthreads(); }
            if (!split) { unsigned gb = 0; cvt_experts(F, ka->in[16] + (size_t)l * NE * D * EH, ka->in[17] + (size_t)l * NE * D * EH, ka->in[18] + (size_t)l * NE * EH * D, ka->in[19] + (size_t)l * D * EH, ka->in[20] + (size_t)l * D * EH, ka->in[21] + (size_t)l * EH * D, ws, gb); __syncthreads(); }
            DenseSched S; S.init(ws + WS_XBF, ws + WS_WIN_T + l * WIN_T_L, NTOK, INC, D, split ? (conv ? NCV : 256 - NCV) : F.G, split ? (conv ? hrank : grank) : (int)blockIdx.x);
            if (split) { S.L0 = conv ? (256 - NCV) * GM_UNITS : 0; S.cnt = conv ? CV_UNITS : GM_UNITS; }
            EpiProj E{WSP(bf16, WS_R1), WSP(unsigned char, WS_GATE8)};
            pg8::gemm_phase<EpiProj, DenseSched, true>(F.lds + RING_OFF, F.wave, D, S, E);
            if (l == 0) {
                DenseSched S2; S2.init(ws + WS_MEMBF, ws + WS_WKV_T, NB * NMEM, 2048, D, split ? 32 : F.G, split ? ((conv && hrank < 32) ? hrank : -1) : (int)blockIdx.x);
                EpiBf16Plain E2{WSP(bf16, WS_KV), 2048};
                pg8::gemm_phase<EpiBf16Plain, DenseSched, true>(F.lds + RING_OFF, F.wave, D, S2, E2);
            }
            }
            SEAM(pb + P_INPROJ);
        }
        if (IN(pb + P_MIX)) {
            { PH_BEGIN;
            memattn(F, WSP(bf16, WS_R1), WSP(bf16, WS_KV), l, WSP(bf16, WS_YX));
            hgrn_local(F, WSP(bf16, WS_R1), ka->in[5], l, ws + WS_R2);
            conv_part(F, WSP(bf16, WS_R1), ka->in[3] + (size_t)l * 3 * CW, WSP(bf16, WS_YA), WSP(bf16, WS_YX));
            }
            SEAM(pb + P_MIX);
        }
        if (IN(pb + P_SCAN)) {
            { PH_BEGIN;
            hgrn_scan(F, ws + WS_R2, WSP(v2u, WS_ZF));
            }
            SEAM(pb + P_SCAN);
        }
        if (IN(pb + P_HOUT)) {
            { PH_BEGIN;
            hgrn_out(F, WSP(bf16, WS_R1), ws + WS_R2, WSP(bf16, WS_ZF), ka->in[6] + (size_t)l * HGW, WSP(bf16, WS_YB));
            }
            SEAM(pb + P_HOUT);
        }
        if (IN(pb + P_BRANCH)) {
            { PH_BEGIN;
            static_assert(WS_YX - WS_YB == WS_YB - WS_YA, "branch inputs equally spaced");
            BranchSched S; S.init(ws + WS_YA, ws + WS_WBR_T + l * WBR_T_L, F.G, (int)blockIdx.x); EpiGateRT E{WSP(unsigned char, WS_GATE8), WSP(bf16, WS_MERGED)};
            pg8::gemm_phase<EpiGateRT, BranchSched, true>(F.lds + RING_OFF, F.wave, CW, S, E);
            }
            SEAM(pb + P_BRANCH);
        }
        if (IN(pb + P_WO)) {
            { PH_BEGIN;
            DenseSched S; S.init(ws + WS_MERGED, ws + WS_WO_T + l * WO_T_L, NTOK, D, D, F.G, (int)blockIdx.x);
            EpiResid<true> E{(const void*)WSP(bf16, WS_XBF), WSP(bf16, WS_ZF)}; pg8::gemm_phase<EpiResid<true>, DenseSched, true>(F.lds + RING_OFF, F.wave, D, S, E);
            }
            SEAM(pb + P_WO);
        }
        if (IN(pb + P_ROUTE)) {
            { PH_BEGIN;
            route_phase(F, WSP(bf16, WS_ZF), ka->in[12] + (size_t)l * D, ka->in[13] + (size_t)l * D, WSP(bf16, WS_RW + l * RW_L), ka->in[15] + (size_t)l * NE, WSP(bf16, WS_X1F), WSP(bf16, WS_X1BF),
                        WSP(unsigned, WS_CTL) + CW_CNT + l * 64, WSP(int, WS_LIST), WSP(int, WS_TOKSLOT), WSP(float, WS_TOKW));
            }
            SEAM(pb + P_ROUTE);
        }
        if (IN(pb + P_GU)) {
            { PH_BEGIN;
            moe_plan(F, WSP(unsigned, WS_CTL) + CW_CNT + l * 64);
            MoeSched<true> S; S.init(F, ws + WS_X1BF, ws + WS_WGU, WSP(int, WS_LIST)); EpiSwiGLU E{WSP(bf16, WS_R2)};
            pg8::gemm_phase<EpiSwiGLU, MoeSched<true>, true>(F.lds + RING_OFF, F.wave, D, S, E);
            }
            SEAM(pb + P_GU);
        }
        if (IN(pb + P_DOWN)) {
            { PH_BEGIN;
            moe_plan(F, WSP(unsigned, WS_CTL) + CW_CNT + l * 64);
            MoeSched<false> S; S.init(F, ws + WS_R2, ws + WS_WDN, nullptr); EpiY8 E{WSP(unsigned char, WS_R1), WSP(bf16, WS_R1 + R1_YS)};
            pg8::gemm_phase<EpiY8, MoeSched<false>, true>(F.lds + RING_OFF, F.wave, EH, S, E);
            }
            SEAM(pb + P_DOWN);
        }
        if (IN(pb + P_COMB)) {
            { PH_BEGIN;
            moe_plan(F, WSP(unsigned, WS_CTL) + CW_CNT + l * 64);
            combine_phase(F, WSP(bf16, WS_X1BF), WSP(unsigned char, WS_R1), WSP(bf16, WS_R1 + R1_YS), WSP(int, WS_TOKSLOT), WSP(float, WS_TOKW), ka->in[22] + (size_t)l * D, ka->in[23] + (size_t)l * D, ka->out, WSP(bf16, WS_XBF), l == 1);
            }
            SEAM(pb + P_COMB);
        }
    }
#undef IN
#undef SEAM
}
static void launch_mk(Args a, int lo, int hi, int grid, hipStream_t stream) {
    a.ph_lo = lo; a.ph_hi = hi;
    hipLaunchKernelGGL(mk_fwd, dim3(grid), dim3(NWAVES * 64), LDS_BYTES, stream, a);
}
extern "C" void kernel_launch(void* const* d_in, const int* in_sizes, int n_in, void* d_out, int out_size, void* d_ws, size_t ws_size, hipStream_t stream) {
    static int grid = 0;
    if (grid == 0) {
        if (n_in != 24 || out_size != NTOK * D || ws_size < WS_END) { fprintf(stderr, "kernel_launch: unexpected sizes n_in %d out %d ws %zu\n", n_in, out_size, ws_size); grid = -1; return; }
        int dev = 0, cus = 0;
        if (hipGetDevice(&dev) != hipSuccess || hipDeviceGetAttribute(&cus, hipDeviceAttributeMultiprocessorCount, dev) != hipSuccess) { grid = -1; return; }
        if (hipFuncSetAttribute((const void*)mk_fwd, hipFuncAttributeMaxDynamicSharedMemorySize, LDS_BYTES) != hipSuccess) { fprintf(stderr, "kernel_launch: hipFuncSetAttribute failed\n"); grid = -1; return; }
        int per_cu = 0; (void)hipOccupancyMaxActiveBlocksPerMultiprocessor(&per_cu, (const void*)mk_fwd, NWAVES * 64, LDS_BYTES); (void)hipGetLastError();
        if (per_cu < 1) fprintf(stderr, "kernel_launch: occupancy query says %d\n", per_cu);
        grid = cus;
    }
    if (grid < 0) return;
    const float* x = (const float*)d_in[0];
    const float* conv_w = (const float*)d_in[3]; const float* lbl = (const float*)d_in[5];
    const float* hg_g = (const float*)d_in[6];
    const float* ln1_g = (const float*)d_in[12]; const float* ln1_b = (const float*)d_in[13]; const float* router_w = (const float*)d_in[14];
    const float* router_b = (const float*)d_in[15]; const float* exp_wg = (const float*)d_in[16]; const float* exp_wu = (const float*)d_in[17];
    const float* exp_wd = (const float*)d_in[18]; const float* sh_wg = (const float*)d_in[19]; const float* sh_wu = (const float*)d_in[20];
    const float* sh_wd = (const float*)d_in[21]; const float* ln2_g = (const float*)d_in[22]; const float* ln2_b = (const float*)d_in[23];
    unsigned char* ws = (unsigned char*)d_ws; float* out = (float*)d_out;
    unsigned* ctl = (unsigned*)(ws + WS_CTL);
    bf16* KV = (bf16*)(ws + WS_KV); bf16* XBF = (bf16*)(ws + WS_XBF); float* X1F = (float*)(ws + WS_X1F);
    bf16* X1BF = (bf16*)(ws + WS_X1BF); float* ZF = (float*)(ws + WS_ZF);
    bf16* YA = (bf16*)(ws + WS_YA); bf16* YB = (bf16*)(ws + WS_YB); bf16* YX = (bf16*)(ws + WS_YX);
    bf16* H = (bf16*)(ws + WS_R2); float* OH = (float*)(ws + WS_R2); bf16* PROJ = (bf16*)(ws + WS_R1); bf16* Y = (bf16*)(ws + WS_R1);
    int* LIST = (int*)(ws + WS_LIST); int* TOKSLOT = (int*)(ws + WS_TOKSLOT); float* TOKW = (float*)(ws + WS_TOKW);
    Args a{};
    for (int i = 0; i < 24; ++i) a.in[i] = (const float*)d_in[i];
    a.out = out; a.ws = ws;

    (void)hipMemsetAsync(ws + WS_CTL, 0, CTL_BYTES, stream);
    a.mask = 7;
    launch_mk(a, 0, N_PHASES, grid, stream);
}
```

```cpp
#include <hip/hip_runtime.h>
#include <stdint.h>
#include <stdio.h>

typedef unsigned short bf16;
__device__ __forceinline__ float bf2f(bf16 v) { return __uint_as_float(((unsigned)v) << 16); }
__device__ __forceinline__ bf16 f2bf(float f) { unsigned u = __float_as_uint(f); return (bf16)((u + 0x7fffu + ((u >> 16) & 1u)) >> 16); }

constexpr int NB = 4, SEQ = 4096, NTOK = NB * SEQ, D = 2048, NMEM = 256;
constexpr int CW = 768, HGW = 768, HGH = 6, HGD = 128, XAW = 512, XAH = 4, XAD = 128;
constexpr int INC = 12032, YXW = 768, GW8 = 3 * 2048, PN_GATE = 23;
constexpr int C_U = 0, C_B = 768, C_C = 1536, C_Q = 2304, C_F = 3072, C_I = 3840, C_G = 4608, C_QX = 5376, C_GA = 5888, C_GB = 7936, C_GX = 9984;
constexpr int NE = 64, TOPK = 8, EH = 512;
constexpr float ALPHA = 1.41421356237f, LN_EPS = 1e-5f, RMS_EPS = 1e-6f, RSCALE = 2.5f;
constexpr int LISTCAP = 16384;

constexpr size_t MiB = 1u << 20;
constexpr size_t WS_CTL = 0, CTL_BYTES = 1 * MiB;
constexpr size_t WS_RW = 1 * MiB, RW_L = 512 * 1024;
constexpr size_t WS_WIN_T = 2 * MiB, WIN_T_L = 47 * MiB;
constexpr size_t WS_WBR_T = 1932 * MiB, WBR_T_L = 9 * MiB;
constexpr size_t WS_WO_T = 112 * MiB, WO_T_L = 8 * MiB;
constexpr size_t WS_WKV_T = 128 * MiB;
constexpr size_t WS_MEMBF = 136 * MiB, WS_KV = 140 * MiB;
constexpr size_t WS_WGU = 144 * MiB, WGU_E = 4 * MiB;
constexpr size_t WS_WDN = 404 * MiB, WDN_E = 2 * MiB;
constexpr size_t WS_XBF = 534 * MiB, WS_X1F = 598 * MiB, WS_X1BF = 726 * MiB, WS_ZF = 790 * MiB, WS_MERGED = 918 * MiB;
constexpr size_t WS_YA = 1860 * MiB, WS_YB = 1884 * MiB, WS_YX = 1908 * MiB;
constexpr size_t WS_R2 = 1046 * MiB;
constexpr size_t WS_R1 = 1214 * MiB;
constexpr size_t R1_YS = 320 * MiB;
constexpr size_t WS_LIST = 1854 * MiB, WS_TOKSLOT = 1858 * MiB, WS_TOKW = 1859 * MiB, WS_GATE8 = 1950 * MiB, WS_END = 2046 * MiB;
constexpr int CW_CNT = 1024;
constexpr int CW_PLAN = 2048;
constexpr int CW_BAR = 4096;
#ifndef DBG_MASK
#define DBG_MASK 7
#endif
namespace pg8 {
#define PG8_LAS __attribute__((address_space(3)))
typedef unsigned short bf16_t;
typedef short bf16x8 __attribute__((ext_vector_type(8)));
typedef float f32x4 __attribute__((ext_vector_type(4)));
typedef unsigned u32x4 __attribute__((ext_vector_type(4)));
typedef unsigned u32x2 __attribute__((ext_vector_type(2)));
constexpr int PG8_NVO_OFF = 147456 + 1024;
constexpr int BM = 256, BK = 64, HALF = 128, HTB = HALF * BK * 2  , STAGE_BYTES = 8 * HTB, NXCD = 8, WGM = 8;

__host__ __device__ __forceinline__ int lds_byte(int r, int c) { const int st = (r >> 4) * 2 + (c >> 5), rr = r & 15, cc = c & 31, ob = rr * 64 + cc * 2; return st * 1024 + (ob ^ (((ob >> 9) & 1) << 5)); }
__host__ __device__ __forceinline__ void stage_rc(int b, int& R, int& C) { const int st = b / 1024, sb = b % 1024, swz = sb ^ (((sb >> 9) & 1) << 5); R = (st >> 1) * 16 + swz / 64; C = (st & 1) * 32 + (swz % 64) / 2; }
__host__ __device__ __forceinline__ int perm32(int rho) { const int n = rho >> 4, i = rho & 15; return 8 * (i >> 2) + 4 * n + (i & 3); }

struct Unit { const char* A; const char* B; int pm, pn; const int* list; int m0, cnt; };

typedef float f32x2_ __attribute__((ext_vector_type(2)));
typedef __bf16 bf16x2_ __attribute__((ext_vector_type(2)));
__device__ __forceinline__ unsigned cvt_pk_bf16(float lo, float hi) { const f32x2_ v = {lo, hi}; const bf16x2_ b = __builtin_convertvector(v, bf16x2_); return __builtin_bit_cast(unsigned, b); }
__device__ __forceinline__ int lane_id_opaque() { unsigned m = ~0u; asm volatile("" : "+s"(m)); return (int)__builtin_amdgcn_mbcnt_hi(m, __builtin_amdgcn_mbcnt_lo(m, 0u)); }
__device__ __forceinline__ float bf_lo(unsigned w) { return __uint_as_float(w << 16); }
__device__ __forceinline__ float bf_hi(unsigned w) { return __uint_as_float(w & 0xffff0000u); }
__device__ __forceinline__ float sigmoidf_(float x) { return __builtin_amdgcn_rcpf(1.f + __expf(-x)); }

typedef f32x4 Acc[2][2][4][2];

template <class Epi, class Sched, bool ALIGN_EPI>
__device__ __forceinline__ void gemm_phase(PG8_LAS unsigned char* lds, const int wave, const int K_in, const Sched& S, const Epi& E) {
    const int lane = lane_id_opaque(), wid = wave, tid = wid * 64 + lane, wr = wid >> 2, wc = wid & 3, fr = lane & 15, fq = lane >> 4;
    int K = K_in; asm volatile("" : "+s"(K));
    const int nt = K / BK;
    unsigned voffB[2];
#pragma unroll
    for (int i = 0; i < 2; ++i) { int R, C; stage_rc(tid * 16 + i * 8192, R, C); const int Rb = Epi::PERM ? ((R & ~31) + perm32(R & 31)) : R; voffB[i] = (unsigned)(Rb * K + C) * 2u; }
    const size_t kstep = (size_t)(BK * 2);
    const size_t hstep = (size_t)HALF * K * 2;
    const unsigned ldsw = (unsigned)wid * 1024u;
    const int aoff = lds_byte(wr * 64 + fr, fq * 8), boff = lds_byte(wc * 32 + fr, fq * 8);
#define PG8_SA(b, h) (((b) * 2 + (h)) * HTB)
#define PG8_SB(b, h) ((4 + (b) * 2 + (h)) * HTB)
#define PG8_STAGE2(bufoff, gbase, v0, v1) do { \
        __builtin_amdgcn_global_load_lds((const unsigned*)((const char*)(gbase) + (v0)), (PG8_LAS unsigned*)(lds + (bufoff) + ldsw), 16, 0, 0); \
        __builtin_amdgcn_global_load_lds((const unsigned*)((const char*)(gbase) + (v1)), (PG8_LAS unsigned*)(lds + (bufoff) + ldsw + 8192), 16, 0, 0); } while (0)
#define PG8_STAGEB(bufoff, gbase) PG8_STAGE2(bufoff, gbase, voffB[0], voffB[1])
#define PG8_LDA(dst, b, h) do { _Pragma("unroll") for (int m = 0; m < 4; ++m) _Pragma("unroll") for (int k = 0; k < 2; ++k) dst[m][k] = *(const PG8_LAS bf16x8*)(lds + PG8_SA(b, h) + aoff + m * 2048 + k * 1024); } while (0)
#define PG8_LDB(dst, b, h) do { _Pragma("unroll") for (int n = 0; n < 2; ++n) _Pragma("unroll") for (int k = 0; k < 2; ++k) dst[n][k] = *(const PG8_LAS bf16x8*)(lds + PG8_SB(b, h) + boff + n * 2048 + k * 1024); } while (0)
#define PG8_MMA(ai, bj, At, Bt) do { __builtin_amdgcn_s_setprio(1); _Pragma("unroll") for (int m = 0; m < 4; ++m) _Pragma("unroll") for (int n = 0; n < 2; ++n) _Pragma("unroll") for (int k = 0; k < 2; ++k) \
        acc[ai][bj][m][n] = __builtin_amdgcn_mfma_f32_16x16x32_bf16(Bt[n][k], At[m][k], acc[ai][bj][m][n], 0, 0, 0); __builtin_amdgcn_s_setprio(0); } while (0)
#define PG8_WAIT_V(n) asm volatile("s_waitcnt vmcnt(" #n ")" ::: "memory")
#define PG8_WAIT_L(n) asm volatile("s_waitcnt lgkmcnt(" #n ")" ::: "memory")
#define PG8_BAR __builtin_amdgcn_s_barrier()
#define PG8_SCHED __builtin_amdgcn_sched_barrier(0)
    Unit cur, nxt; int ui = 0;
    if (!S.next(0, cur)) return;
    Acc acc;
#pragma unroll
    for (int a = 0; a < 2; ++a)
#pragma unroll
        for (int b = 0; b < 2; ++b)
#pragma unroll
            for (int m = 0; m < 4; ++m)
#pragma unroll
                for (int n = 0; n < 2; ++n) acc[a][b][m][n] = (f32x4){0.f, 0.f, 0.f, 0.f};
    bf16x8 At[4][2], B0[2][2], B1[2][2];
    constexpr bool GA = Sched::GATHER;
    unsigned c00, c01, c10 = 0, c11 = 0;
    PG8_LAS unsigned* nvo = (PG8_LAS unsigned*)(lds + PG8_NVO_OFF) + tid * 4;
    { int R0, C0, R1, C1; stage_rc(tid * 16, R0, C0); stage_rc(tid * 16 + 8192, R1, C1);
      c00 = S.avoff(cur, 0, R0, C0, K); c01 = S.avoff(cur, 0, R1, C1, K); if constexpr (GA) { c10 = S.avoff(cur, 1, R0, C0, K); c11 = S.avoff(cur, 1, R1, C1, K); } }
    const size_t hA = GA ? (size_t)0 : hstep;
#define PG8_STAGEA0(bufoff, gbase) PG8_STAGE2(bufoff, gbase, c00, c01)
#define PG8_STAGEA1(bufoff, gbase) do { if constexpr (GA) PG8_STAGE2(bufoff, gbase, c10, c11); else PG8_STAGE2(bufoff, (gbase) + hA, c00, c01); } while (0)
    const char* cA = cur.A; const char* cB = cur.B;
    PG8_STAGEB(PG8_SB(0, 0), cB); PG8_STAGEB(PG8_SB(0, 1), cB + hstep); PG8_STAGEA0(PG8_SA(0, 0), cA); PG8_STAGEA1(PG8_SA(0, 1), cA);
    if (wr == 1) PG8_BAR;
    PG8_WAIT_V(2); PG8_BAR;
    PG8_STAGEB(PG8_SB(1, 0), cB + kstep); PG8_STAGEA0(PG8_SA(1, 0), cA + kstep); PG8_STAGEB(PG8_SB(1, 1), cB + hstep + kstep);
    PG8_WAIT_V(6); PG8_BAR;
    int pi0 = 0, pi1 = 0, pi2 = 0, pi3 = 0;
    if constexpr (GA) { Unit n1; if (S.next(1, n1)) { int R0, C0, R1, C1; stage_rc(tid * 16, R0, C0); stage_rc(tid * 16 + 8192, R1, C1);
        pi0 = S.avload(n1, 0, R0); pi1 = S.avload(n1, 0, R1); pi2 = S.avload(n1, 1, R0); pi3 = S.avload(n1, 1, R1); } }
    for (;;) {
        const bool has_next = S.next(ui + 1, nxt);
        const char* nA = has_next ? nxt.A : cA; const char* nB = has_next ? nxt.B : cB;
        if constexpr (GA) { if (has_next) {
            int R0, C0, R1, C1; stage_rc(tid * 16, R0, C0); stage_rc(tid * 16 + 8192, R1, C1);
            nvo[0] = S.avfin(nxt, 0, R0, C0, K, pi0); nvo[1] = S.avfin(nxt, 0, R1, C1, K, pi1); nvo[2] = S.avfin(nxt, 1, R0, C0, K, pi2); nvo[3] = S.avfin(nxt, 1, R1, C1, K, pi3); } }
        for (int t = 0; t < nt; t += 2) {
            const bool last = (t == nt - 2);
            const char* a1 = cA + (size_t)(t + 1) * kstep;
            const char* a2 = last ? nA : cA + (size_t)(t + 2) * kstep; const char* b2 = last ? nB : cB + (size_t)(t + 2) * kstep;
            const char* a3 = a2 + kstep; const char* b3 = b2 + kstep;
            const bool nx = GA && last && has_next;
#define PG8_STAGEA0N(bufoff, gbase) do { if (nx) { const unsigned q0 = nvo[0], q1 = nvo[1]; PG8_STAGE2(bufoff, gbase, q0, q1); } else PG8_STAGEA0(bufoff, gbase); } while (0)
#define PG8_STAGEA1N(bufoff, gbase) do { if (nx) { const unsigned q0 = nvo[2], q1 = nvo[3]; PG8_STAGE2(bufoff, gbase, q0, q1); } else PG8_STAGEA1(bufoff, gbase); } while (0)
            PG8_LDB(B0, 0, 0); PG8_LDB(B1, 0, 1); PG8_SCHED; PG8_LDA(At, 0, 0); PG8_STAGEA1(PG8_SA(1, 1), a1);
            PG8_WAIT_V(8); PG8_WAIT_L(0); PG8_BAR; PG8_MMA(0, 0, At, B0); PG8_MMA(0, 1, At, B1); PG8_BAR; PG8_SCHED;
            PG8_LDA(At, 0, 1); PG8_STAGEB(PG8_SB(0, 0), b2); PG8_STAGEB(PG8_SB(0, 1), b2 + hstep); PG8_STAGEA0N(PG8_SA(0, 0), a2);
            PG8_WAIT_V(8); PG8_WAIT_L(0); PG8_BAR; PG8_MMA(1, 0, At, B0); PG8_MMA(1, 1, At, B1); PG8_BAR; PG8_SCHED;
            PG8_LDB(B0, 1, 0); PG8_LDB(B1, 1, 1); PG8_SCHED; PG8_LDA(At, 1, 0); PG8_STAGEA1N(PG8_SA(0, 1), a2);
            PG8_WAIT_V(8); PG8_WAIT_L(0); PG8_BAR; PG8_MMA(0, 0, At, B0); PG8_MMA(0, 1, At, B1); PG8_BAR; PG8_SCHED;
            PG8_LDA(At, 1, 1); PG8_STAGEB(PG8_SB(1, 0), b3); PG8_STAGEB(PG8_SB(1, 1), b3 + hstep); PG8_STAGEA0N(PG8_SA(1, 0), a3);
            PG8_WAIT_V(8); PG8_WAIT_L(0); PG8_BAR; PG8_MMA(1, 0, At, B0); PG8_MMA(1, 1, At, B1); PG8_BAR; PG8_SCHED;
#undef PG8_STAGEA0N
#undef PG8_STAGEA1N
        }
        if constexpr (GA) { Unit n2; if (has_next && S.next(ui + 2, n2)) { int R0, C0, R1, C1; stage_rc(tid * 16, R0, C0); stage_rc(tid * 16 + 8192, R1, C1);
            pi0 = S.avload(n2, 0, R0); pi1 = S.avload(n2, 0, R1); pi2 = S.avload(n2, 1, R0); pi3 = S.avload(n2, 1, R1); } }
        if constexpr (ALIGN_EPI) { if (wr == 0) PG8_BAR; }
        bool keep = false;
        if constexpr (Epi::INPLACE) keep = E.inplace(acc, cur, wr, wc, fr, fq); else E(acc, cur, wr, wc, fr, fq);
        if (!has_next) break;
        if (!keep)
#pragma unroll
        for (int a = 0; a < 2; ++a)
#pragma unroll
            for (int b = 0; b < 2; ++b)
#pragma unroll
                for (int m = 0; m < 4; ++m)
#pragma unroll
                    for (int n = 0; n < 2; ++n) acc[a][b][m][n] = (f32x4){0.f, 0.f, 0.f, 0.f};
        cur = nxt; cA = nA; cB = nB; ++ui; if constexpr (GA) { c00 = nvo[0]; c01 = nvo[1]; c10 = nvo[2]; c11 = nvo[3]; }
        if constexpr (ALIGN_EPI) { if (wr == 1) PG8_BAR; }
    }
    PG8_WAIT_V(0);
    if constexpr (!ALIGN_EPI) { if (wr == 0) PG8_BAR; }
    PG8_BAR;
#undef PG8_SA
#undef PG8_SB
#undef PG8_STAGE2
#undef PG8_STAGEB
#undef PG8_STAGEA0
#undef PG8_STAGEA1
#undef PG8_LDA
#undef PG8_LDB
#undef PG8_MMA
#undef PG8_WAIT_V
#undef PG8_WAIT_L
#undef PG8_BAR
#undef PG8_SCHED
}
}
#define GAS __attribute__((address_space(1)))
#define LAS __attribute__((address_space(3)))
typedef unsigned v4u __attribute__((ext_vector_type(4)));
typedef unsigned v2u __attribute__((ext_vector_type(2)));
typedef float f32x4 __attribute__((ext_vector_type(4)));
typedef short bf16x8 __attribute__((ext_vector_type(8)));
typedef GAS unsigned gu32;
#define RLX_AGENT __ATOMIC_RELAXED, __HIP_MEMORY_SCOPE_AGENT
#define LDS_WAIT() asm volatile("s_waitcnt lgkmcnt(0)" ::: "memory")
#define VM_WAIT() asm volatile("s_waitcnt vmcnt(0)" ::: "memory")
__device__ __forceinline__ int opaque_v(int x) { asm volatile("" : "+v"(x)); return x; }
__device__ __forceinline__ float shx(float v, int o, int lane) { return __int_as_float(__builtin_amdgcn_ds_bpermute((lane ^ o) << 2, __float_as_int(v))); }
__device__ __forceinline__ unsigned pk2(float lo, float hi) { return pg8::cvt_pk_bf16(lo, hi); }

#define XB_TMO      128
#define XB_XCNT(j)  (256  + 64 * (j))
#define XB_XSUB(j)  (1280 + 64 * (j))
#define XB_XGEN(j)  (2304 + 64 * (j))
#define XB_TOP      3328
#define XB_TOPGEN   3392
#define XCD_BAR_WORDS 3456
#define XB_SPIN_CAP (1u << 18)
__device__ __forceinline__ unsigned xb_ld(unsigned* p)              { return __hip_atomic_load(p, __ATOMIC_RELAXED, __HIP_MEMORY_SCOPE_AGENT); }
__device__ __forceinline__ unsigned xb_add(unsigned* p, unsigned v) { return __hip_atomic_fetch_add(p, v, __ATOMIC_RELAXED, __HIP_MEMORY_SCOPE_AGENT); }
__device__ __forceinline__ unsigned xb_xcc_id() { return (unsigned)__builtin_amdgcn_s_getreg((3 << 11) | 20) & 0xFu; }
#define XB_SPIN(cond, bar) do { unsigned _sp = 0; while (cond) { __builtin_amdgcn_s_sleep(1); \
    if ((++_sp & 255u) == 0u) { if (xb_ld(&(bar)[XB_TMO])) break; if (_sp > XB_SPIN_CAP) { atomicAdd(&(bar)[XB_TMO], 1u); break; } } } } while (0)
struct XcdBarrier { unsigned* bar; unsigned x; volatile LAS unsigned* st; };
__device__ __forceinline__ XcdBarrier xcd_barrier_post(unsigned* bar, volatile LAS unsigned* st) {
    XcdBarrier b; b.bar = bar; b.x = xb_xcc_id(); b.st = st;
    if (threadIdx.x == 0) (void)xb_add(&bar[XB_XCNT(b.x)], 1u);
    return b;
}
__device__ __forceinline__ void xcd_barrier_complete(unsigned* bar, unsigned x, unsigned& nloc, unsigned& nx) {
    const unsigned G = gridDim.x * gridDim.y * gridDim.z;
    unsigned sum, cnt, mine, sp = 0u;
    for (;;) {
        sum = 0u; cnt = 0u; mine = 0u;
#pragma unroll
        for (unsigned j = 0; j < 16; ++j) { const unsigned c = xb_ld(&bar[XB_XCNT(j)]); sum += c; cnt += (c > 0u) ? 1u : 0u; mine = (j == x) ? c : mine; }
        if (sum == G) break;
        __builtin_amdgcn_s_sleep(1);
        if ((++sp & 255u) == 0u) { if (xb_ld(&bar[XB_TMO])) break; if (sp > XB_SPIN_CAP) { atomicAdd(&bar[XB_TMO], 1u); break; } }
    }
    nloc = mine > 0u ? mine : 1u; nx = cnt > 0u ? cnt : 1u;
}
__device__ __forceinline__ void xcd_barrier(const XcdBarrier& b_in) {
    asm volatile("s_waitcnt vmcnt(0)" ::: "memory");
    __syncthreads();
    if (threadIdx.x == 0) {
        XcdBarrier b = b_in; asm volatile("" : "+s"(b.x));
        unsigned* bar = b.bar; asm volatile("" : "+s"(bar));
        __builtin_amdgcn_s_waitcnt(0);
        unsigned nloc = b.st[0], nx = b.st[1];
        if (nloc == 0u) { xcd_barrier_complete(bar, b.x, nloc, nx); b.st[0] = nloc; b.st[1] = nx; }
        const unsigned old = xb_add(&bar[XB_XSUB(b.x)], 1u);
        const unsigned gen = old / nloc;
        if (old + 1u == (gen + 1u) * nloc) {
            __builtin_amdgcn_fence(__ATOMIC_RELEASE, "agent");
            asm volatile("s_waitcnt vmcnt(0)" ::: "memory");
            const unsigned og = xb_add(&bar[XB_TOP], 1u);
            const unsigned tg = og / nx;
            if (og + 1u == (tg + 1u) * nx) xb_add(&bar[XB_TOPGEN], 1u);
            else XB_SPIN(xb_ld(&bar[XB_TOPGEN]) == tg, bar);
            __builtin_amdgcn_fence(__ATOMIC_ACQUIRE, "agent");
            xb_add(&bar[XB_XGEN(b.x)], 1u);
            asm volatile("s_waitcnt vmcnt(0)" ::: "memory");
        } else {
            XB_SPIN(xb_ld(&bar[XB_XGEN(b.x)]) == gen, bar);
            __builtin_amdgcn_fence(__ATOMIC_ACQUIRE, "agent");
            asm volatile("s_waitcnt vmcnt(0)" ::: "memory");
        }
    }
    __syncthreads();
}
using pg8::Unit; using pg8::Acc;
struct DenseSched { static constexpr bool GATHER = false;
    const char* A; const char* B; int nM, nN, nwg, G, c, K; int L0 = 0, cnt = 1 << 30, lin = 0;
    __device__ __forceinline__ void init(const void* A_, const void* B_, int M, int N, int K_, int G_, int c_) { A = (const char*)A_; B = (const char*)B_; nM = M / 256; nN = N / 256; nwg = nM * nN; G = G_; c = c_; K = K_; }
    __device__ __forceinline__ bool next(int i, Unit& u) const {
        const long L = (long)L0 + (long)i * G + c; if (c < 0 || i >= cnt || L >= nwg) return false;
        int wgid = (int)L; if (!lin) { const int q = nwg / 8, r = nwg % 8, xcd = wgid % 8, off = wgid / 8; wgid = (xcd < r ? xcd * (q + 1) : r * (q + 1) + (xcd - r) * q) + off; }
        const int nig = 8 * nN, gid = wgid / nig, fm = gid * 8, gsz = (nM - fm) < 8 ? (nM - fm) : 8;
        u.pm = fm + ((wgid % nig) % gsz); u.pn = (wgid % nig) / gsz;
        u.A = A + (size_t)u.pm * 256 * K * 2; u.B = B + (size_t)u.pn * 256 * K * 2; u.list = nullptr; u.m0 = 0; u.cnt = 0; return true;
    }
    __device__ __forceinline__ int avload(const Unit&, int, int) const { return 0; }
    __device__ __forceinline__ unsigned avfin(const Unit&, int h, int R, int C, int K_, int) const { return (unsigned)(((h * 128 + R) * K_ + C) * 2); }
    __device__ __forceinline__ unsigned avoff(const Unit&, int h, int R, int C, int K_) const { return (unsigned)(((h * 128 + R) * K_ + C) * 2); }
};
struct EpiBf16Plain { static constexpr bool PERM = true, INPLACE = false; bf16* O; int ldc;
    __device__ __forceinline__ void operator()(const Acc& acc, const Unit& u, int wr, int wc, int fr, int fq) const {
        const int row0 = u.pm * 256 + wr * 64 + fr, col0 = u.pn * 256 + wc * 32 + 8 * fq;
#pragma unroll
        for (int ai = 0; ai < 2; ++ai)
#pragma unroll
            for (int m = 0; m < 4; ++m) { bf16* rowp = O + (size_t)(row0 + ai * 128 + m * 16) * ldc + col0;
#pragma unroll
                for (int bj = 0; bj < 2; ++bj) { const f32x4 v0 = acc[ai][bj][m][0], v1 = acc[ai][bj][m][1];
                    v4u w; w.x = pk2(v0[0], v0[1]); w.y = pk2(v0[2], v0[3]); w.z = pk2(v1[0], v1[1]); w.w = pk2(v1[2], v1[3]);
                    *(v4u*)(rowp + bj * 128) = w; } }
    }
};
struct EpiProj { static constexpr bool PERM = true, INPLACE = false; bf16* O; unsigned char* G8;
    __device__ __forceinline__ void operator()(const Acc& acc, const Unit& u, int wr, int wc, int fr, int fq) const {
        const int row0 = u.pm * 256 + wr * 64 + fr;
        if (u.pn < PN_GATE) { const int col0 = u.pn * 256 + wc * 32 + 8 * fq;
#pragma unroll
            for (int ai = 0; ai < 2; ++ai)
#pragma unroll
                for (int m = 0; m < 4; ++m) { bf16* rowp = O + (size_t)(row0 + ai * 128 + m * 16) * INC + col0;
#pragma unroll
                    for (int bj = 0; bj < 2; ++bj) { const f32x4 v0 = acc[ai][bj][m][0], v1 = acc[ai][bj][m][1];
                        v4u w; w.x = pk2(v0[0], v0[1]); w.y = pk2(v0[2], v0[3]); w.z = pk2(v1[0], v1[1]); w.w = pk2(v1[2], v1[3]);
                        *(v4u*)(rowp + bj * 128) = w; } }
        } else { const int pos0 = (u.pn - PN_GATE) * 256 + wc * 64 + fq * 16;
#pragma unroll
            for (int ai = 0; ai < 2; ++ai)
#pragma unroll
                for (int m = 0; m < 4; ++m) { unsigned char* rowp = G8 + (size_t)(row0 + ai * 128 + m * 16) * GW8 + pos0;
                    v4u w;
#pragma unroll
                    for (int bj = 0; bj < 2; ++bj) { const f32x4 v0 = acc[ai][bj][m][0], v1 = acc[ai][bj][m][1];
                        unsigned q[8];
#pragma unroll
                        for (int j = 0; j < 4; ++j) { q[j] = (unsigned)fmaxf(pg8::sigmoidf_(v0[j]) * 255.f + 0.5f, 1.f); q[4 + j] = (unsigned)fmaxf(pg8::sigmoidf_(v1[j]) * 255.f + 0.5f, 1.f); }
                        const unsigned lo = q[0] | (q[1] << 8) | (q[2] << 16) | (q[3] << 24), hi = q[4] | (q[5] << 8) | (q[6] << 16) | (q[7] << 24);
                        if (bj == 0) { w.x = lo; w.y = hi; } else { w.z = lo; w.w = hi; } }
                    *(v4u*)rowp = w; }
        }
    }
};
struct BranchSched { static constexpr bool GATHER = false;
    const char* A0; const char* B; int G, c;
    __device__ __forceinline__ void init(const void* ya, const void* w, int G_, int c_) { A0 = (const char*)ya; B = (const char*)w; G = G_; c = c_; }
    __device__ __forceinline__ bool next(int i, Unit& u) const {
        const int j = i / 3, seg = i - 3 * j; constexpr int nM = NTOK / 256, nN = D / 256, nwg = nM * nN;
        const int L = j * G + c; if (L >= nwg) return false;
        int wgid = L; { const int q = nwg / 8, xcd = wgid % 8, off = wgid / 8; wgid = xcd * q + off; }
        const int nig = 8 * nN; u.pm = (wgid / nig) * 8 + ((wgid % nig) % 8); u.pn = (wgid % nig) / 8;
        u.A = A0 + (size_t)seg * (WS_YB - WS_YA) + (size_t)u.pm * 256 * CW * 2; u.B = B + (size_t)seg * 3 * MiB + (size_t)u.pn * 256 * CW * 2; u.list = nullptr; u.m0 = seg; u.cnt = 0; return true; }
    __device__ __forceinline__ int avload(const Unit&, int, int) const { return 0; }
    __device__ __forceinline__ unsigned avfin(const Unit&, int h, int R, int C, int K_, int) const { return (unsigned)(((h * 128 + R) * K_ + C) * 2); }
    __device__ __forceinline__ unsigned avoff(const Unit&, int h, int R, int C, int K_) const { return (unsigned)(((h * 128 + R) * K_ + C) * 2); }
};
struct EpiGateRT { static constexpr bool PERM = true, INPLACE = true; const unsigned char* g8; bf16* merged;
    __device__ __forceinline__ bool inplace(Acc& acc, const Unit& u, int wr, int wc, int fr, int fq) const {
        const int row0 = u.pm * 256 + wr * 64 + fr, col0 = u.pn * 256 + wc * 32 + 8 * fq, pos0 = u.pn * 256 + wc * 64 + fq * 16; const int seg = u.m0;
#pragma unroll
        for (int ai = 0; ai < 2; ++ai) {
            v4u ga[4], gb[4];
#pragma unroll
            for (int m = 0; m < 4; ++m) { const size_t row = (size_t)(row0 + ai * 128 + m * 16);
                ga[m] = *(const v4u*)(g8 + row * GW8 + seg * D + pos0); gb[m] = ga[m]; if (seg < 2) gb[m] = *(const v4u*)(g8 + row * GW8 + (seg + 1) * D + pos0); }
            asm volatile("" ::: "memory");
#pragma unroll
            for (int m = 0; m < 4; ++m) { const size_t row = (size_t)(row0 + ai * 128 + m * 16);
#pragma unroll
                for (int bj = 0; bj < 2; ++bj) { const unsigned ax = bj ? ga[m].z : ga[m].x, ay = bj ? ga[m].w : ga[m].y, bx = bj ? gb[m].z : gb[m].x, by = bj ? gb[m].w : gb[m].y;
                    f32x4 v0 = acc[ai][bj][m][0], v1 = acc[ai][bj][m][1];
                    if (seg < 2) {
                        v0[0] *= (float)(ax & 255u) * __builtin_amdgcn_rcpf((float)(bx & 255u)); v0[1] *= (float)((ax >> 8) & 255u) * __builtin_amdgcn_rcpf((float)((bx >> 8) & 255u));
                        v0[2] *= (float)((ax >> 16) & 255u) * __builtin_amdgcn_rcpf((float)((bx >> 16) & 255u)); v0[3] *= (float)(ax >> 24) * __builtin_amdgcn_rcpf((float)(bx >> 24));
                        v1[0] *= (float)(ay & 255u) * __builtin_amdgcn_rcpf((float)(by & 255u)); v1[1] *= (float)((ay >> 8) & 255u) * __builtin_amdgcn_rcpf((float)((by >> 8) & 255u));
                        v1[2] *= (float)((ay >> 16) & 255u) * __builtin_amdgcn_rcpf((float)((by >> 16) & 255u)); v1[3] *= (float)(ay >> 24) * __builtin_amdgcn_rcpf((float)(by >> 24));
                        acc[ai][bj][m][0] = v0; acc[ai][bj][m][1] = v1;
                    } else { constexpr float s8 = 1.f / 255.f;
                        v0[0] *= (float)(ax & 255u) * s8; v0[1] *= (float)((ax >> 8) & 255u) * s8; v0[2] *= (float)((ax >> 16) & 255u) * s8; v0[3] *= (float)(ax >> 24) * s8;
                        v1[0] *= (float)(ay & 255u) * s8; v1[1] *= (float)((ay >> 8) & 255u) * s8; v1[2] *= (float)((ay >> 16) & 255u) * s8; v1[3] *= (float)(ay >> 24) * s8;
                        v4u w; w.x = pk2(v0[0], v0[1]); w.y = pk2(v0[2], v0[3]); w.z = pk2(v1[0], v1[1]); w.w = pk2(v1[2], v1[3]); *(v4u*)(merged + row * D + col0 + bj * 128) = w; } } }
            asm volatile("" ::: "memory");
        }
        return seg < 2;
    }
};
template <bool RB16> struct EpiResid { static constexpr bool PERM = true, INPLACE = false; const void* xres; bf16* z;
    __device__ __forceinline__ void operator()(const Acc& acc, const Unit& u, int wr, int wc, int fr, int fq) const {
        const int row0 = u.pm * 256 + wr * 64 + fr, col0 = u.pn * 256 + wc * 32 + 8 * fq;
#pragma unroll
        for (int ai = 0; ai < 2; ++ai) {
            f32x4 xr[4][2][2];
#pragma unroll
            for (int m = 0; m < 4; ++m) { const size_t off = (size_t)(row0 + ai * 128 + m * 16) * D + col0;
#pragma unroll
                for (int bj = 0; bj < 2; ++bj) {
                    if constexpr (RB16) { const v4u w = *(const v4u*)((const bf16*)xres + off + bj * 128);
                        xr[m][bj][0] = (f32x4){pg8::bf_lo(w.x), pg8::bf_hi(w.x), pg8::bf_lo(w.y), pg8::bf_hi(w.y)}; xr[m][bj][1] = (f32x4){pg8::bf_lo(w.z), pg8::bf_hi(w.z), pg8::bf_lo(w.w), pg8::bf_hi(w.w)}; }
                    else {
#pragma unroll
                        for (int n = 0; n < 2; ++n) xr[m][bj][n] = *(const f32x4*)((const float*)xres + off + bj * 128 + n * 4); } } }
            asm volatile("" ::: "memory");
#pragma unroll
            for (int m = 0; m < 4; ++m) { const size_t off = (size_t)(row0 + ai * 128 + m * 16) * D + col0;
#pragma unroll
                for (int bj = 0; bj < 2; ++bj) { const f32x4 v0 = xr[m][bj][0] * ALPHA + acc[ai][bj][m][0], v1 = xr[m][bj][1] * ALPHA + acc[ai][bj][m][1];
                    v4u w; w.x = pk2(v0[0], v0[1]); w.y = pk2(v0[2], v0[3]); w.z = pk2(v1[0], v1[1]); w.w = pk2(v1[2], v1[3]); *(v4u*)(z + off + bj * 128) = w; } }
            asm volatile("" ::: "memory");
        }
    }
};

constexpr int NWAVES = 8;
constexpr int RING_OFF = 0, RING_BYTES = 131072;
constexpr int SCR_BYTES = 147456;
constexpr int MISC_OFF = SCR_BYTES;
constexpr int LDS_BYTES = 163840;
constexpr int PH_CVT = 0, PH_L0 = 1, PH_PER_LAYER = 10;
constexpr int P_INPROJ = 0, P_MIX = 1, P_SCAN = 2, P_HOUT = 3, P_BRANCH = 4, P_WO = 5, P_ROUTE = 6, P_GU = 7, P_DOWN = 8, P_COMB = 9;
constexpr int N_PHASES = PH_L0 + 2 * PH_PER_LAYER;

constexpr int NCV = 64;
#define CV_UNITS 2
#define GM_UNITS 15
struct Frame { LAS unsigned char* lds; int tid, lane, wave, G, gw, NGW; };

__device__ __forceinline__ void xpose_item(const float* W, int N, int k0, int n0, bf16* WTrow0, int ldk, LAS float* scr, int lane) {
    const int kk = lane >> 3, nn = (lane & 7) * 4;
    f32x4 v[8];
#pragma unroll
    for (int i = 0; i < 8; ++i) v[i] = *(const f32x4*)(W + (size_t)(k0 + kk + 8 * i) * N + n0 + nn);
#pragma unroll
    for (int i = 0; i < 8; ++i) { LAS float* s = scr + (kk + 8 * i) * 33 + nn; s[0] = v[i][0]; s[1] = v[i][1]; s[2] = v[i][2]; s[3] = v[i][3]; }
    LDS_WAIT(); asm volatile("" ::: "memory");
    const int c = lane & 7;
#pragma unroll
    for (int j = 0; j < 4; ++j) { const int n = (lane >> 3) + 8 * j; const LAS float* s = scr + (8 * c) * 33 + n;
        v4u o; o.x = pk2(s[0 * 33], s[1 * 33]); o.y = pk2(s[2 * 33], s[3 * 33]); o.z = pk2(s[4 * 33], s[5 * 33]); o.w = pk2(s[6 * 33], s[7 * 33]);
        *(v4u*)(WTrow0 + (size_t)n * ldk + 8 * c) = o; }
    LDS_WAIT(); asm volatile("" ::: "memory");
}
__device__ __forceinline__ void xpose_matrix(const Frame& F, const float* W, int K, int N, bf16* WT, int ldk, int mode, unsigned& gbase) {
    const int nblk = N / 32, nitems = (K / 64) * nblk;
    LAS float* scr = (LAS float*)(F.lds + RING_OFF + F.wave * 8704);
    int it = (int)(((unsigned)F.gw + (unsigned)F.NGW - gbase % (unsigned)F.NGW) % (unsigned)F.NGW);
    for (; it < nitems; it += F.NGW) {
        const int kb = it / nblk, nb = it % nblk, n0 = nb * 32, k0 = kb * 64;
        const int drow = mode == 0 ? n0 : ((n0 >> 7) * 256 + (n0 & 127) + (mode == 2 ? 128 : 0));
        xpose_item(W, N, k0, n0, WT + (size_t)drow * ldk + k0, ldk, scr, F.lane);
    }
    gbase += (unsigned)nitems;
}
__device__ __forceinline__ void cvt_rows(const Frame& F, const float* in, bf16* out, size_t n8) {
    for (size_t i = (size_t)blockIdx.x * 512 + F.tid; i < n8; i += (size_t)F.G * 512) {
        const f32x4 a = *(const f32x4*)(in + i * 8), b = *(const f32x4*)(in + i * 8 + 4);
        v4u w; w.x = pk2(a[0], a[1]); w.y = pk2(a[2], a[3]); w.z = pk2(b[0], b[1]); w.w = pk2(b[2], b[3]);
        *(v4u*)(out + i * 8) = w; }
}
__device__ __forceinline__ void cvt_router(const Frame& F, const float* rw, unsigned char* ws) {
    for (int i = blockIdx.x * 512 + F.tid; i < 2 * D * NE; i += F.G * 512) { const int l = i / (D * NE), k = (i / NE) % D, e = i % NE;
        const float w = rw[i]; const bf16 h = f2bf(w); const bf16 lo = f2bf(w - bf2f(h));
        bf16* dst = (bf16*)(ws + WS_RW + l * RW_L); dst[(size_t)e * D + k] = h; dst[(size_t)(NE + e) * D + k] = lo; }
}
struct XItem { const float* src; bf16* dst; int N, ldk; };
__device__ __forceinline__ void xp_decode(int I, const float* wg, const float* wu, const float* wd, const float* sg, const float* su, const float* sd, unsigned char* ws, XItem& x) {
    const int e = I / 1536, rem = I % 1536, m = rem >> 9, it = rem & 511;
    if (m < 2) { const float* W = m == 0 ? (e < NE ? wg + (size_t)e * D * EH : sg) : (e < NE ? wu + (size_t)e * D * EH : su);
        const int kb = it >> 4, nb = it & 15, n0 = nb * 32, k0 = kb * 64; const int drow = (n0 >> 7) * 256 + (n0 & 127) + (m == 1 ? 128 : 0);
        x.src = W + (size_t)k0 * EH + n0; x.N = EH; x.ldk = D; x.dst = (bf16*)(ws + WS_WGU + (size_t)e * WGU_E) + (size_t)drow * D + k0; }
    else { const float* W = e < NE ? wd + (size_t)e * EH * D : sd; const int kb = it >> 6, nb = it & 63, n0 = nb * 32, k0 = kb * 64;
        x.src = W + (size_t)k0 * D + n0; x.N = D; x.ldk = EH; x.dst = (bf16*)(ws + WS_WDN + (size_t)e * WDN_E) + (size_t)n0 * EH + k0; }
}
__device__ __forceinline__ void xp_load(const XItem& x, int lane, f32x4 (&v)[8]) {
    const int kk = lane >> 3, nn = (lane & 7) * 4;
#pragma unroll
    for (int i = 0; i < 8; ++i) v[i] = __builtin_nontemporal_load((const f32x4*)(x.src + (size_t)(kk + 8 * i) * x.N + nn));
}
__device__ __forceinline__ void xp_store(const XItem& x, const f32x4 (&v)[8], LAS float* scr, int lane) {
    const int kk = lane >> 3, nn = (lane & 7) * 4;
#pragma unroll
    for (int i = 0; i < 8; ++i) { LAS float* s = scr + (kk + 8 * i) * 33 + nn; s[0] = v[i][0]; s[1] = v[i][1]; s[2] = v[i][2]; s[3] = v[i][3]; }
    LDS_WAIT(); asm volatile("" ::: "memory");
    const int c = lane & 7;
#pragma unroll
    for (int j = 0; j < 4; ++j) { const int n = (lane >> 3) + 8 * j; const LAS float* s = scr + (8 * c) * 33 + n;
        v4u o; o.x = pk2(s[0 * 33], s[1 * 33]); o.y = pk2(s[2 * 33], s[3 * 33]); o.z = pk2(s[4 * 33], s[5 * 33]); o.w = pk2(s[6 * 33], s[7 * 33]);
        __builtin_nontemporal_store(o, (v4u*)(x.dst + (size_t)n * x.ldk + 8 * c)); }
    LDS_WAIT(); asm volatile("" ::: "memory");
}
__device__ __forceinline__ void cvt_experts(const Frame& F, const float* wg, const float* wu, const float* wd, const float* sg, const float* su, const float* sd, unsigned char* ws, unsigned& gbase) {
    (void)gbase;
    LAS float* scr = (LAS float*)(F.lds + RING_OFF + F.wave * 8704);
    const int total = (NE + 1) * 1536;
    XItem A, B; f32x4 va[8], vb[8];
    int I = F.gw;
    if (I < total) { xp_decode(I, wg, wu, wd, sg, su, sd, ws, A); xp_load(A, F.lane, va); }
    for (; I < total; I += 2 * F.NGW) {
        const int I2 = I + F.NGW, I3 = I + 2 * F.NGW;
        if (I2 < total) { xp_decode(I2, wg, wu, wd, sg, su, sd, ws, B); xp_load(B, F.lane, vb); }
        xp_store(A, va, scr, F.lane);
        if (I2 < total) { if (I3 < total) { xp_decode(I3, wg, wu, wd, sg, su, sd, ws, A); xp_load(A, F.lane, va); }
            xp_store(B, vb, scr, F.lane); }
    }
}
constexpr int NVO_OFF = MISC_OFF + 1024;  static_assert(NVO_OFF == pg8::PG8_NVO_OFF, "nvo");
constexpr int PLAN_OFF = NVO_OFF + 8192;
constexpr int PLAN_TB = PLAN_OFF, PLAN_CN = PLAN_OFF + 66 * 4, PLAN_TE = PLAN_OFF + 132 * 4;
constexpr int MAXTILES = 640;
#ifndef ROUTE_PROBE
#define ROUTE_PROBE 0
#endif
static_assert(PLAN_TE + MAXTILES * 4 <= LDS_BYTES, "LDS map");

__device__ __forceinline__ float wave_sum(float v, int lane) {
#pragma unroll
    for (int o = 1; o < 64; o <<= 1) v += shx(v, o, lane);
    return v;
}
__device__ __forceinline__ void moe_plan(const Frame& F, const unsigned* cnt) {
    LAS unsigned* tb = (LAS unsigned*)(F.lds + PLAN_TB); LAS unsigned* cn = (LAS unsigned*)(F.lds + PLAN_CN); LAS unsigned* te = (LAS unsigned*)(F.lds + PLAN_TE);
    __syncthreads();
    if (F.tid <= NE) { unsigned run = 0; for (int e = 0; e < F.tid; ++e) run += (__hip_atomic_load(cnt + e, RLX_AGENT) + 255u) >> 8;
        tb[F.tid] = run; cn[F.tid] = F.tid < NE ? __hip_atomic_load(cnt + F.tid, RLX_AGENT) : (unsigned)NTOK; if (F.tid == NE) tb[NE + 1] = run + NTOK / 256; }
    __syncthreads();
    for (int t = F.tid; t < MAXTILES; t += NWAVES * 64) { unsigned e = 0; for (int q = 1; q <= NE; ++q) if (tb[q] <= (unsigned)t) e = q; te[t] = e; }
    __syncthreads();
}
template <bool GU> struct MoeSched { static constexpr bool GATHER = GU;
    const LAS unsigned* tb; const LAS unsigned* cn; const LAS unsigned* te; int nunits, nN, G, c; const char* Abase; const char* Bbase; const int* list;
    __device__ __forceinline__ void init(const Frame& F, const void* A_, const void* B_, const int* list_) {
        tb = (const LAS unsigned*)(F.lds + PLAN_TB); cn = (const LAS unsigned*)(F.lds + PLAN_CN); te = (const LAS unsigned*)(F.lds + PLAN_TE);
        nN = GU ? 4 : 8; nunits = (int)tb[NE + 1] * nN; G = F.G; const int bx = blockIdx.x; c = (G % 8 == 0) ? (bx % 8) * (G / 8) + bx / 8 : bx;
        Abase = (const char*)A_; Bbase = (const char*)B_; list = list_; }
    __device__ __forceinline__ bool next(int i, Unit& u) const {
        constexpr int RUN = GU ? 2 : 1; const int hs = c + G * (i / RUN), per = nN / RUN;
        const int tile = hs / per, pn = (hs % per) * RUN + (i % RUN); if (tile * nN >= nunits) return false;
        const int e = (int)te[tile];
        u.pm = tile; u.pn = pn;
        if (GU) { u.A = Abase; u.B = Bbase + (size_t)e * WGU_E + (size_t)pn * 256 * D * 2; u.list = e < NE ? list + (size_t)e * LISTCAP : nullptr; u.m0 = (tile - (int)tb[e]) * 256; u.cnt = (int)cn[e]; }
        else { u.A = Abase + (size_t)tile * 256 * EH * 2; u.B = Bbase + (size_t)e * WDN_E + (size_t)pn * 256 * EH * 2; u.list = nullptr; u.m0 = 0; u.cnt = 0; }
        return true; }
    __device__ __forceinline__ int avload(const Unit& u, int h, int R) const { const int pos = u.m0 + h * 128 + R; const int pc = pos < u.cnt ? pos : (u.cnt > 0 ? u.cnt - 1 : 0); const int* lp = u.list ? u.list : list; return lp[pc]; }
    __device__ __forceinline__ unsigned avfin(const Unit& u, int h, int R, int C, int K_, int v) const { const int pos = u.m0 + h * 128 + R; int row = u.list ? v : pos; row = pos < u.cnt ? row : 0; return (unsigned)((row * K_ + C) * 2); }
    __device__ __forceinline__ unsigned avoff(const Unit& u, int h, int R, int C, int K_) const {
        if (GU) return avfin(u, h, R, C, K_, avload(u, h, R));
        else return (unsigned)(((h * 128 + R) * K_ + C) * 2); }
};
struct EpiSwiGLU { static constexpr bool PERM = true, INPLACE = false; bf16* H;
    __device__ __forceinline__ void operator()(const Acc& acc, const Unit& u, int wr, int wc, int fr, int fq) const {
        const int row0 = u.pm * 256 + wr * 64 + fr, col0 = u.pn * 128 + wc * 32 + 8 * fq;
#pragma unroll
        for (int ai = 0; ai < 2; ++ai)
#pragma unroll
            for (int m = 0; m < 4; ++m) { bf16* rowp = H + (size_t)(row0 + ai * 128 + m * 16) * EH + col0;
                float hv[8];
#pragma unroll
                for (int n = 0; n < 2; ++n)
#pragma unroll
                    for (int j = 0; j < 4; ++j) { const float g = acc[ai][0][m][n][j], uu = acc[ai][1][m][n][j]; hv[n * 4 + j] = g * pg8::sigmoidf_(g) * uu; }
                v4u w; w.x = pk2(hv[0], hv[1]); w.y = pk2(hv[2], hv[3]); w.z = pk2(hv[4], hv[5]); w.w = pk2(hv[6], hv[7]);
                *(v4u*)rowp = w; }
    }
};

struct EpiY8 { static constexpr bool PERM = true, INPLACE = false; unsigned char* Y8; bf16* YS;
    __device__ __forceinline__ void operator()(const Acc& acc, const Unit& u, int wr, int wc, int fr, int fq) const {
        const int row0 = u.pm * 256 + wr * 64 + fr, pos0 = u.pn * 256 + wc * 64 + fq * 16;
#pragma unroll
        for (int ai = 0; ai < 2; ++ai)
#pragma unroll
            for (int m = 0; m < 4; ++m) { const size_t row = (size_t)(row0 + ai * 128 + m * 16);
                v4u w; unsigned sw = 0u;
#pragma unroll
                for (int bj = 0; bj < 2; ++bj) { const f32x4 v0 = acc[ai][bj][m][0], v1 = acc[ai][bj][m][1];
                    const float am = fmaxf(fmaxf(fmaxf(fabsf(v0[0]), fabsf(v0[1])), fmaxf(fabsf(v0[2]), fabsf(v0[3]))), fmaxf(fmaxf(fabsf(v1[0]), fabsf(v1[1])), fmaxf(fabsf(v1[2]), fabsf(v1[3]))));
                    const unsigned sb = f2bf(am * (1.f / 127.f)); const float sc = __uint_as_float(sb << 16); const float inv = sc > 0.f ? __builtin_amdgcn_rcpf(sc) : 0.f;
                    unsigned q[8];
#pragma unroll
                    for (int j = 0; j < 4; ++j) { q[j] = (unsigned)fminf(rintf(v0[j] * inv + 128.f), 255.f); q[4 + j] = (unsigned)fminf(rintf(v1[j] * inv + 128.f), 255.f); }
                    const unsigned lo = q[0] | (q[1] << 8) | (q[2] << 16) | (q[3] << 24), hi = q[4] | (q[5] << 8) | (q[6] << 16) | (q[7] << 24);
                    if (bj == 0) { w.x = lo; w.y = hi; sw = sb; } else { w.z = lo; w.w = hi; sw |= sb << 16; } }
                *(v4u*)(Y8 + row * D + pos0) = w; *(unsigned*)(YS + row * (D / 8) + (pos0 >> 3)) = sw; }
    }
};
__device__ __forceinline__ void route_phase(const Frame& F, const bf16* __restrict__ Z, const float* __restrict__ g, const float* __restrict__ bb, const bf16* __restrict__ rwh, const float* __restrict__ rb,
                                            bf16* __restrict__ X1L, bf16* __restrict__ X1BF, unsigned* cnt, int* list, int* tokslot, float* tokw, bool dispatch = true) {
    LAS float* part = (LAS float*)(F.lds + RING_OFF);
    LAS float* lg = part + 4 * 4096;
    LAS float* sl = lg + 64 * 65;
    LAS unsigned* cntL = (LAS unsigned*)(sl + 64 * 65);
    LAS unsigned* baseL = cntL + 64;
    LAS unsigned* ee = baseL + 64;
    LAS unsigned* pl = ee + 512;
    LAS float* ww = (LAS float*)(pl + 512);
    for (int grp = blockIdx.x; grp < NTOK / 64; grp += F.G) {
        const int t0 = grp * 64;
        if (F.tid < 64) cntL[F.tid] = 0u;
        for (int rp_ = 0; rp_ < (ROUTE_PROBE == 1 ? 2 : 1); ++rp_)
#pragma unroll 2
        for (int q = 0; q < 8; ++q) {
            const int t = t0 + F.wave * 8 + q;
            const v2u* zr = (const v2u*)(Z + (size_t)t * D) + F.lane;
            f32x4 v[8]; float s = 0.f;
#pragma unroll
            for (int j = 0; j < 8; ++j) { const v2u zw = zr[64 * j]; v[j] = (f32x4){pg8::bf_lo(zw.x), pg8::bf_hi(zw.x), pg8::bf_lo(zw.y), pg8::bf_hi(zw.y)}; s += (v[j][0] + v[j][1]) + (v[j][2] + v[j][3]); }
            const float mean = wave_sum(s, F.lane) * (1.f / D); float s2 = 0.f;
#pragma unroll
            for (int j = 0; j < 8; ++j) { v[j] = v[j] - mean; s2 += (v[j][0] * v[j][0] + v[j][1] * v[j][1]) + (v[j][2] * v[j][2] + v[j][3] * v[j][3]); }
            const float rstd = 1.f / sqrtf(wave_sum(s2, F.lane) * (1.f / D) + LN_EPS);
            v2u* xl = (v2u*)(X1L + (size_t)t * D) + F.lane; v2u* xb = (v2u*)(X1BF + (size_t)t * D) + F.lane;
#pragma unroll
            for (int j = 0; j < 8; ++j) { const f32x4 gg = ((const f32x4*)g)[F.lane + 64 * j], bv = ((const f32x4*)bb)[F.lane + 64 * j];
                const f32x4 y = v[j] * rstd * gg + bv; v2u w; w.x = pk2(y[0], y[1]); w.y = pk2(y[2], y[3]); xb[64 * j] = w;
                v2u lo; lo.x = pk2(y[0] - pg8::bf_lo(w.x), y[1] - pg8::bf_hi(w.x)); lo.y = pk2(y[2] - pg8::bf_lo(w.y), y[3] - pg8::bf_hi(w.y)); xl[64 * j] = lo; }
        }
        VM_WAIT(); __syncthreads();
        for (int rp_ = 0; rp_ < (ROUTE_PROBE == 2 ? 2 : 1); ++rp_)
        { const int r = F.lane & 15, kq = F.lane >> 4, kb = (F.wave & 3) * 512, th = F.wave >> 2;
          const bf16* xh = X1BF + (size_t)(t0 + th * 32 + r) * D + kb + 8 * kq;
          const bf16* xl = X1L + (size_t)(t0 + th * 32 + r) * D + kb + 8 * kq;
          const bf16* wh = rwh + (size_t)r * D + kb + 8 * kq;
          f32x4 acc[2][4];
#pragma unroll
          for (int tt = 0; tt < 2; ++tt)
#pragma unroll
              for (int nb = 0; nb < 4; ++nb) acc[tt][nb] = (f32x4){0.f, 0.f, 0.f, 0.f};
          bf16x8 xA[2][2], xB[2][2]; bf16x8 hA[4], lA[4], hB[4], lB[4];
#define RT_LOAD(X, H, L, ks) do { const int k_ = ((ks) < 16 ? (ks) : 15) * 32; _Pragma("unroll") for (int tt = 0; tt < 2; ++tt) { X[tt][0] = *(const bf16x8*)(xh + (size_t)tt * 16 * D + k_); X[tt][1] = *(const bf16x8*)(xl + (size_t)tt * 16 * D + k_); } \
              _Pragma("unroll") for (int nb = 0; nb < 4; ++nb) { H[nb] = *(const bf16x8*)(wh + (size_t)nb * 16 * D + k_); L[nb] = *(const bf16x8*)(wh + (size_t)(64 + nb * 16) * D + k_); } } while (0)
#define RT_MMA(X, H, L) do { \
              _Pragma("unroll") for (int tt = 0; tt < 2; ++tt) _Pragma("unroll") for (int nb = 0; nb < 4; ++nb) acc[tt][nb] = __builtin_amdgcn_mfma_f32_16x16x32_bf16(X[tt][1], H[nb], acc[tt][nb], 0, 0, 0); \
              _Pragma("unroll") for (int tt = 0; tt < 2; ++tt) _Pragma("unroll") for (int nb = 0; nb < 4; ++nb) acc[tt][nb] = __builtin_amdgcn_mfma_f32_16x16x32_bf16(X[tt][0], L[nb], acc[tt][nb], 0, 0, 0); \
              _Pragma("unroll") for (int tt = 0; tt < 2; ++tt) _Pragma("unroll") for (int nb = 0; nb < 4; ++nb) acc[tt][nb] = __builtin_amdgcn_mfma_f32_16x16x32_bf16(X[tt][0], H[nb], acc[tt][nb], 0, 0, 0); } while (0)
          RT_LOAD(xA, hA, lA, 0);
#pragma unroll 1
          for (int ks = 0; ks < 16; ks += 2) {
              RT_LOAD(xB, hB, lB, ks + 1); RT_MMA(xA, hA, lA);
              RT_LOAD(xA, hA, lA, ks + 2); RT_MMA(xB, hB, lB);
          }
#undef RT_LOAD
#undef RT_MMA
#pragma unroll
          for (int tt = 0; tt < 2; ++tt)
#pragma unroll
              for (int nb = 0; nb < 4; ++nb)
#pragma unroll
                  for (int reg = 0; reg < 4; ++reg) part[(F.wave & 3) * 4096 + (th * 32 + tt * 16 + 4 * kq + reg) * 64 + nb * 16 + r] = acc[tt][nb][reg];
        }
        __syncthreads();
        for (int i = F.tid; i < 64 * 64; i += NWAVES * 64) { const int tk = i >> 6, e = i & 63; const float lgt = (part[i] + part[4096 + i]) + (part[8192 + i] + part[12288 + i]);
            const float sc = 1.f / (1.f + __expf(-lgt)); lg[tk * 65 + e] = sc; sl[tk * 65 + e] = sc + rb[e]; }
        __syncthreads();
        for (int rp_ = 0; rp_ < (ROUTE_PROBE == 3 ? 2 : 1); ++rp_)
        { const bool lastrp = (rp_ == (ROUTE_PROBE == 3 ? 1 : 0));
          const int tk = F.wave * 8 + (F.lane >> 3), gq = F.lane & 7, lane = F.lane;
          float sv[8], cv[8];
#pragma unroll
          for (int j = 0; j < 8; ++j) { sv[j] = sl[tk * 65 + gq * 8 + j]; cv[j] = lg[tk * 65 + gq * 8 + j]; }
          float m1 = -INFINITY, m2 = -INFINITY;
#pragma unroll
          for (int j = 0; j < 8; ++j) { const float x = sv[j]; const bool g1 = x > m1; m2 = g1 ? m1 : fmaxf(m2, x); m1 = g1 ? x : m1; }
          const float gs = m1 + m2;
          int rank = 0;
#pragma unroll
          for (int o = 1; o < 8; ++o) { const float og = shx(gs, o, lane); const int oq = gq ^ o; rank += (og > gs || (og == gs && oq < gq)) ? 1 : 0; }
          const bool gsel = rank < 4;
          unsigned used = gsel ? 0u : 0xffu;
          float wsum = 0.f; float my_sc = 0.f; int my_e = 0;
#pragma unroll
          for (int i = 0; i < 8; ++i) {
              float bv = -INFINITY, bs = 0.f; int be = 64;
#pragma unroll
              for (int j = 0; j < 8; ++j) { const bool ok = !((used >> j) & 1u) && sv[j] > bv; bv = ok ? sv[j] : bv; bs = ok ? cv[j] : bs; be = ok ? gq * 8 + j : be; }
#pragma unroll
              for (int o = 1; o < 8; o <<= 1) { const float ov = shx(bv, o, lane), os = shx(bs, o, lane); const int oe = __float_as_int(shx(__int_as_float(be), o, lane));
                  const bool tk_o = ov > bv || (ov == bv && oe < be); bv = tk_o ? ov : bv; bs = tk_o ? os : bs; be = tk_o ? oe : be; }
              if ((be >> 3) == gq) used |= 1u << (be & 7);
              wsum += bs; if (gq == i) { my_sc = bs; my_e = be; }
          }
          const int slot = tk * 8 + gq;
          ee[slot] = (unsigned)my_e; ww[slot] = my_sc * (RSCALE / wsum);
          pl[slot] = __hip_atomic_fetch_add(cntL + my_e, (dispatch && lastrp) ? 1u : 0u, __ATOMIC_RELAXED, __HIP_MEMORY_SCOPE_WORKGROUP);
        }
        __syncthreads();
        if (F.tid < 64) { const unsigned n = cntL[F.tid]; baseL[F.tid] = n ? __hip_atomic_fetch_add(cnt + F.tid, n, RLX_AGENT) : 0u; }
        __syncthreads();
        if (dispatch) { const int tk = F.tid >> 3, i = F.tid & 7; const unsigned e = ee[F.tid]; const unsigned pos = baseL[e] + pl[F.tid]; const int t = t0 + tk;
          list[(size_t)e * LISTCAP + pos] = t; tokslot[t * 8 + i] = (int)(e * LISTCAP + pos); tokw[t * 8 + i] = ww[F.tid]; }
        __syncthreads();
    }
}
__device__ __forceinline__ void combine_phase(const Frame& F, const bf16* X1B, const unsigned char* Y8, const bf16* YS, const int* tokslot, const float* tokw, const float* g, const float* bb, float* OUT, bf16* XBF, bool last) {
    const LAS unsigned* tb = (const LAS unsigned*)(F.lds + PLAN_TB);
    LAS int* rw = (LAS int*)(F.lds + RING_OFF) + F.wave * 32;
#define CB_LOAD(W, S, ROW) do { const int r_ = __builtin_amdgcn_readfirstlane(ROW); const v2u* yr_ = (const v2u*)(Y8 + (size_t)r_ * D) + F.lane; const bf16* ys_ = YS + (size_t)r_ * (D / 8) + F.lane; \
        _Pragma("unroll") for (int j = 0; j < 4; ++j) { W[j] = yr_[64 * j]; S[j] = ys_[64 * j]; } } while (0)
#define CB_ACC(W, S, WT) do { const float wt_ = __int_as_float(__builtin_amdgcn_readfirstlane(WT)); _Pragma("unroll") for (int j = 0; j < 4; ++j) { const float sc = bf2f(S[j]) * wt_, c0 = -128.f * sc; const unsigned x = W[j].x, y = W[j].y; \
        v[j][0] += sc * (float)(x & 255u) + c0; v[j][1] += sc * (float)((x >> 8) & 255u) + c0; v[j][2] += sc * (float)((x >> 16) & 255u) + c0; v[j][3] += sc * (float)(x >> 24) + c0; \
        v[j][4] += sc * (float)(y & 255u) + c0; v[j][5] += sc * (float)((y >> 8) & 255u) + c0; v[j][6] += sc * (float)((y >> 16) & 255u) + c0; v[j][7] += sc * (float)(y >> 24) + c0; } } while (0)
    const int cl = (F.lane >> 5) * 256 + (F.lane & 1) * 128 + ((F.lane >> 3) & 3) * 32 + ((F.lane >> 1) & 3) * 8;
    for (int t = F.gw; t < NTOK; t += F.NGW) {
        if (F.lane < 8) { const int sl = tokslot[t * 8 + F.lane]; rw[F.lane] = (int)tb[sl / LISTCAP] * 256 + (sl % LISTCAP); rw[16 + F.lane] = __float_as_int(tokw[t * 8 + F.lane]); }
        if (F.lane == 8) { rw[8] = (int)tb[NE] * 256 + t; rw[24] = __float_as_int(1.f); }
        LDS_WAIT(); asm volatile("" ::: "memory");
        float v[4][8]; float s = 0.f;
        v2u wa[4], wb[4], wc[4]; bf16 sa[4], sb2[4], sc2[4];
        CB_LOAD(wa, sa, rw[0]); CB_LOAD(wb, sb2, rw[1]); CB_LOAD(wc, sc2, rw[2]);
#pragma unroll
        for (int j = 0; j < 4; ++j) { const v4u xw = *(const v4u*)(X1B + (size_t)t * D + 512 * j + cl);
            v[j][0] = pg8::bf_lo(xw.x) * ALPHA; v[j][1] = pg8::bf_hi(xw.x) * ALPHA; v[j][2] = pg8::bf_lo(xw.y) * ALPHA; v[j][3] = pg8::bf_hi(xw.y) * ALPHA;
            v[j][4] = pg8::bf_lo(xw.z) * ALPHA; v[j][5] = pg8::bf_hi(xw.z) * ALPHA; v[j][6] = pg8::bf_lo(xw.w) * ALPHA; v[j][7] = pg8::bf_hi(xw.w) * ALPHA; }
#pragma unroll 1
        for (int i = 0; i < 9; i += 3) {
            CB_ACC(wa, sa, rw[16 + i]); if (i < 6) CB_LOAD(wa, sa, rw[i + 3]);
            CB_ACC(wb, sb2, rw[17 + i]); if (i < 6) CB_LOAD(wb, sb2, rw[i + 4]);
            CB_ACC(wc, sc2, rw[18 + i]); if (i < 6) CB_LOAD(wc, sc2, rw[i + 5]);
        }
        asm volatile("" ::: "memory");
#pragma unroll
        for (int j = 0; j < 4; ++j)
#pragma unroll
            for (int e = 0; e < 8; ++e) s += v[j][e];
        const float mean = wave_sum(s, F.lane) * (1.f / D); float s2 = 0.f;
#pragma unroll
        for (int j = 0; j < 4; ++j)
#pragma unroll
            for (int e = 0; e < 8; ++e) { v[j][e] -= mean; s2 += v[j][e] * v[j][e]; }
        const float rstd = 1.f / sqrtf(wave_sum(s2, F.lane) * (1.f / D) + LN_EPS);
#pragma unroll
        for (int j = 0; j < 4; ++j) { const int c0 = cl + 512 * j; const f32x4 g0 = *(const f32x4*)(g + c0), g1 = *(const f32x4*)(g + c0 + 4), b0 = *(const f32x4*)(bb + c0), b1 = *(const f32x4*)(bb + c0 + 4);
            f32x4 y0, y1;
#pragma unroll
            for (int e = 0; e < 4; ++e) { y0[e] = v[j][e] * rstd * g0[e] + b0[e]; y1[e] = v[j][4 + e] * rstd * g1[e] + b1[e]; }
            if (last) { *(f32x4*)(OUT + (size_t)t * D + c0) = y0; *(f32x4*)(OUT + (size_t)t * D + c0 + 4) = y1; }
            else { v4u w; w.x = pk2(y0[0], y0[1]); w.y = pk2(y0[2], y0[3]); w.z = pk2(y1[0], y1[1]); w.w = pk2(y1[2], y1[3]); *(v4u*)(XBF + (size_t)t * D + c0) = w; } }
    }
#undef CB_LOAD
#undef CB_ACC
}
constexpr size_t R2_UT = 0, R2_OI = 48 * MiB, R2_QP = 96 * MiB, R2_DEC = 120 * MiB;
constexpr int NHU = NB * HGH * (SEQ / 64);
typedef __attribute__((address_space(3))) bf16 lbf16;
__device__ __forceinline__ void unpack8(const v4u w, float (&f)[8]) {
    f[0] = pg8::bf_lo(w.x); f[1] = pg8::bf_hi(w.x); f[2] = pg8::bf_lo(w.y); f[3] = pg8::bf_hi(w.y); f[4] = pg8::bf_lo(w.z); f[5] = pg8::bf_hi(w.z); f[6] = pg8::bf_lo(w.w); f[7] = pg8::bf_hi(w.w); }
__device__ __forceinline__ float exp_c(float x) { return __expf(fminf(x, 80.f)); }

__device__ __forceinline__ void conv_part(const Frame& F, const bf16* proj, const float* cw, bf16* YA, bf16* YX) {
    for (int i = blockIdx.x * 512 + F.tid; i < NTOK * 32; i += F.G * 512) *(v4u*)(YX + (size_t)(i >> 5) * YXW + XAW + (i & 31) * 8) = (v4u){0u, 0u, 0u, 0u};
    for (int i = blockIdx.x * 512 + F.tid; i < NTOK * (CW / 8); i += F.G * 512) {
        const int t = i / (CW / 8), c = (i % (CW / 8)) * 8, pos = t & (SEQ - 1);
        const bf16* r = proj + (size_t)t * INC;
        float u0[8], c0[8], b0[8], u1[8], c1[8], u2[8], c2[8], w0[8], w1[8], w2[8];
        unpack8(*(const v4u*)(r + C_U + c), u0); unpack8(*(const v4u*)(r + C_C + c), c0); unpack8(*(const v4u*)(r + C_B + c), b0);
        const v4u z4 = {0u, 0u, 0u, 0u};
        unpack8(pos >= 1 ? *(const v4u*)(r - INC + C_U + c) : z4, u1); unpack8(pos >= 1 ? *(const v4u*)(r - INC + C_C + c) : z4, c1);
        unpack8(pos >= 2 ? *(const v4u*)(r - 2 * INC + C_U + c) : z4, u2); unpack8(pos >= 2 ? *(const v4u*)(r - 2 * INC + C_C + c) : z4, c2);
#pragma unroll
        for (int j = 0; j < 8; ++j) { w0[j] = cw[c + j]; w1[j] = cw[CW + c + j]; w2[j] = cw[2 * CW + c + j]; }
        float o[8];
#pragma unroll
        for (int j = 0; j < 8; ++j) o[j] = b0[j] * (w2[j] * c0[j] * u0[j] + w1[j] * c1[j] * u1[j] + w0[j] * c2[j] * u2[j]);
        v4u w; w.x = pk2(o[0], o[1]); w.y = pk2(o[2], o[3]); w.z = pk2(o[4], o[5]); w.w = pk2(o[6], o[7]);
        *(v4u*)(YA + (size_t)t * CW + c) = w;
    }
}

__device__ __forceinline__ void hgrn_local(const Frame& F, const bf16* proj, const float* lbl, int layer, unsigned char* r2) {
    lbf16* QS = (lbf16*)(F.lds);
    lbf16* KS = QS + 64 * 136;
    lbf16* KPT = KS + 64 * 136;
    lbf16* VT = KPT + 128 * 72;
    lbf16* PS = VT + 128 * 72;
    LAS float* SEG = (LAS float*)(PS + 64 * 72);
    bf16* UT = (bf16*)(r2 + R2_UT); bf16* OI = (bf16*)(r2 + R2_OI); bf16* QP = (bf16*)(r2 + R2_QP); float* DEC = (float*)(r2 + R2_DEC);
    const int lane = F.lane, wv = F.wave, r = lane & 15, kq = lane >> 4;
    bf16 rf[16], rq[16], rv[16];
#define HL_LOAD(U) do { const int b_ = (U) / (HGH * 64), h_ = ((U) / 64) % HGH, c_ = (U) % 64; const bf16* p_ = proj + (size_t)(b_ * SEQ + c_ * 64 + (F.tid >> 7) * 16) * INC + h_ * HGD + (F.tid & 127); \
        _Pragma("unroll") for (int i = 0; i < 16; ++i) { rf[i] = p_[(size_t)i * INC + C_F]; rq[i] = p_[(size_t)i * INC + C_Q]; rv[i] = p_[(size_t)i * INC + C_I]; } } while (0)
    if ((int)blockIdx.x < NHU) HL_LOAD((int)blockIdx.x);
    for (int unit = blockIdx.x; unit < NHU; unit += F.G) {
        const int b = unit / (HGH * 64), h = (unit / 64) % HGH, c = unit % 64, t0 = b * SEQ + c * 64;
        { const int col = F.tid & 127, seg = F.tid >> 7, ch = h * HGD + col;
          float lb = 0.f; if (layer == 1) lb = 1.f / (1.f + __expf(lbl[ch] - lbl[HGW + ch]));
          float a[16], kk[16], qv[16], vv[16]; float run = 0.f;
#pragma unroll
          for (int i = 0; i < 16; ++i) {
              const float z = bf2f(rf[i]); const float ez = __expf(-z); const float sg = 1.f / (1.f + ez);
              const float f = lb + (1.f - lb) * sg; kk[i] = (1.f - lb) * ez * sg; run += fmaxf(__logf(f), -60.f); a[i] = run;
              qv[i] = bf2f(rq[i]); vv[i] = bf2f(rv[i]); }
          if (unit + F.G < NHU) HL_LOAD(unit + F.G);
          SEG[seg * 128 + col] = run;
          __syncthreads();
          const float s0 = SEG[col], s1 = SEG[128 + col], s2 = SEG[256 + col], s3 = SEG[384 + col];
          const float base = seg == 0 ? 0.f : (seg == 1 ? s0 : (seg == 2 ? s0 + s1 : s0 + s1 + s2)), bm = s0 + s1, bl = (s0 + s1) + (s2 + s3);
          float kp[16];
#pragma unroll
          for (int i = 0; i < 16; ++i) { const float bb = base + a[i]; const int t = seg * 16 + i;
              QS[t * 136 + col] = f2bf(qv[i] * exp_c(bb - bm)); KS[t * 136 + col] = f2bf(kk[i] * exp_c(bm - bb)); kp[i] = kk[i] * exp_c(bl - bb);
              QP[(size_t)(t0 + t) * HGW + ch] = f2bf(qv[i] * exp_c(bb)); }
          v4u w0, w1; w0.x = pk2(kp[0], kp[1]); w0.y = pk2(kp[2], kp[3]); w0.z = pk2(kp[4], kp[5]); w0.w = pk2(kp[6], kp[7]); w1.x = pk2(kp[8], kp[9]); w1.y = pk2(kp[10], kp[11]); w1.z = pk2(kp[12], kp[13]); w1.w = pk2(kp[14], kp[15]);
          *(LAS v4u*)(KPT + col * 72 + seg * 16) = w0; *(LAS v4u*)(KPT + col * 72 + seg * 16 + 8) = w1;
          w0.x = pk2(vv[0], vv[1]); w0.y = pk2(vv[2], vv[3]); w0.z = pk2(vv[4], vv[5]); w0.w = pk2(vv[6], vv[7]); w1.x = pk2(vv[8], vv[9]); w1.y = pk2(vv[10], vv[11]); w1.z = pk2(vv[12], vv[13]); w1.w = pk2(vv[14], vv[15]);
          *(LAS v4u*)(VT + col * 72 + seg * 16) = w0; *(LAS v4u*)(VT + col * 72 + seg * 16 + 8) = w1;
          if (seg == 0) DEC[(size_t)unit * 128 + col] = exp_c(bl);
        }
        __syncthreads();
        { const int tm = wv >> 1, tn0 = (wv & 1) * 2;
          bf16x8 af[4];
#pragma unroll
          for (int ks = 0; ks < 4; ++ks) af[ks] = *(const LAS bf16x8*)(QS + (tm * 16 + r) * 136 + ks * 32 + kq * 8);
#pragma unroll
          for (int jn = 0; jn < 2; ++jn) { const int tn = tn0 + jn; f32x4 acc = {0.f, 0.f, 0.f, 0.f};
              if (tn <= tm) {
#pragma unroll
                  for (int ks = 0; ks < 4; ++ks) { const bf16x8 bf = *(const LAS bf16x8*)(KS + (tn * 16 + r) * 136 + ks * 32 + kq * 8); acc = __builtin_amdgcn_mfma_f32_16x16x32_bf16(af[ks], bf, acc, 0, 0, 0); } }
#pragma unroll
              for (int g = 0; g < 4; ++g) { const int t = tm * 16 + 4 * kq + g, s = tn * 16 + r; PS[t * 72 + s] = f2bf(s <= t ? acc[g] : 0.f); } } }
        { bf16x8 af[2];
#pragma unroll
          for (int ks = 0; ks < 2; ++ks) af[ks] = *(const LAS bf16x8*)(KPT + (wv * 16 + r) * 72 + ks * 32 + kq * 8);
#pragma unroll
          for (int tv = 0; tv < 8; ++tv) { f32x4 acc = {0.f, 0.f, 0.f, 0.f};
#pragma unroll
              for (int ks = 0; ks < 2; ++ks) { const bf16x8 bf = *(const LAS bf16x8*)(VT + (tv * 16 + r) * 72 + ks * 32 + kq * 8); acc = __builtin_amdgcn_mfma_f32_16x16x32_bf16(af[ks], bf, acc, 0, 0, 0); }
              v2u w; w.x = pk2(acc[0], acc[1]); w.y = pk2(acc[2], acc[3]);
              *(v2u*)(UT + (size_t)unit * 16384 + (tv * 16 + r) * 128 + wv * 16 + 4 * kq) = w; } }
        __syncthreads();
        { const int tm = wv & 3, tvg = wv >> 2;
          bf16x8 pf[2];
#pragma unroll
          for (int ks = 0; ks < 2; ++ks) pf[ks] = *(const LAS bf16x8*)(PS + (tm * 16 + r) * 72 + ks * 32 + kq * 8);
#pragma unroll
          for (int j = 0; j < 4; ++j) { const int tv = tvg * 4 + j; f32x4 acc = {0.f, 0.f, 0.f, 0.f};
#pragma unroll
              for (int ks = 0; ks < 2; ++ks) { const bf16x8 vf = *(const LAS bf16x8*)(VT + (tv * 16 + r) * 72 + ks * 32 + kq * 8); acc = __builtin_amdgcn_mfma_f32_16x16x32_bf16(vf, pf[ks], acc, 0, 0, 0); }
              v2u ow; ow.x = pk2(acc[0], acc[1]); ow.y = pk2(acc[2], acc[3]); *(v2u*)(OI + (size_t)(t0 + tm * 16 + r) * HGW + h * HGD + tv * 16 + 4 * kq) = ow; } }
        __syncthreads();
    }
#undef HL_LOAD
}
__device__ __forceinline__ void hgrn_scan(const Frame& F, const unsigned char* r2, v2u* __restrict__ SB64) {
    const v2u* __restrict__ UT64 = (const v2u*)(r2 + R2_UT); const f32x4* __restrict__ DEC4 = (const f32x4*)(r2 + R2_DEC);
    for (int it = blockIdx.x * 512 + F.tid; it < NB * HGH * 128 * 32; it += F.G * 512) {
        const int bh = it >> 12, v = (it >> 5) & 127, k4 = it & 31;
        f32x4 s = {0.f, 0.f, 0.f, 0.f};
#pragma unroll 8
        for (int c = 0; c < 64; ++c) { const size_t unit = (size_t)bh * 64 + c; const size_t idx = unit * 4096 + v * 32 + k4;
            const v2u w = UT64[idx]; const f32x4 d = DEC4[unit * 32 + k4];
            v2u o; o.x = pk2(s[0], s[1]); o.y = pk2(s[2], s[3]); SB64[idx] = o;
            s[0] = d[0] * s[0] + pg8::bf_lo(w.x); s[1] = d[1] * s[1] + pg8::bf_hi(w.x); s[2] = d[2] * s[2] + pg8::bf_lo(w.y); s[3] = d[3] * s[3] + pg8::bf_hi(w.y); }
    }
}
struct HoutOps { bf16x8 af[4]; bf16x8 bfr[4][4]; };
__device__ __forceinline__ void hout_load(HoutOps& O, int unit, const bf16* proj, const bf16* OI, const bf16* QP, const bf16* SB, int r, int kq, int tm, int tvg) {
    const int b = unit / (HGH * 64), h = (unit / 64) % HGH, c = unit % 64, t0 = b * SEQ + c * 64;
#pragma unroll
    for (int ks = 0; ks < 4; ++ks) O.af[ks] = *(const bf16x8*)(QP + (size_t)(t0 + tm * 16 + r) * HGW + h * HGD + ks * 32 + kq * 8);
#pragma unroll
    for (int j = 0; j < 4; ++j)
#pragma unroll
        for (int ks = 0; ks < 4; ++ks) O.bfr[j][ks] = *(const bf16x8*)(SB + (size_t)unit * 16384 + ((tvg * 4 + j) * 16 + r) * 128 + ks * 32 + kq * 8);
}
__device__ __forceinline__ void hout_compute(const HoutOps& O, int unit, const bf16* proj, const bf16* OI, LAS float* SSQ, const float* gain, bf16* YB, int lane, int r, int kq, int tm, int tvg) {
    const int b = unit / (HGH * 64), h = (unit / 64) % HGH, c = unit % 64, t0 = b * SEQ + c * 64;
    const size_t t = (size_t)(t0 + tm * 16 + r);
    f32x4 oi[4]; v2u gtw[4];
#pragma unroll
    for (int j = 0; j < 4; ++j) { const int ch = h * HGD + (tvg * 4 + j) * 16 + 4 * kq; { const v2u ow = *(const v2u*)(OI + t * HGW + ch); oi[j] = (f32x4){pg8::bf_lo(ow.x), pg8::bf_hi(ow.x), pg8::bf_lo(ow.y), pg8::bf_hi(ow.y)}; } gtw[j] = *(const v2u*)(proj + t * INC + C_G + ch); }
    f32x4 acc[4]; float q = 0.f;
#pragma unroll
    for (int j = 0; j < 4; ++j) { acc[j] = (f32x4){0.f, 0.f, 0.f, 0.f};
#pragma unroll
        for (int ks = 0; ks < 4; ++ks) acc[j] = __builtin_amdgcn_mfma_f32_16x16x32_bf16(O.bfr[j][ks], O.af[ks], acc[j], 0, 0, 0); }
#pragma unroll
    for (int j = 0; j < 4; ++j) { acc[j] += oi[j]; q += (acc[j][0] * acc[j][0] + acc[j][1] * acc[j][1]) + (acc[j][2] * acc[j][2] + acc[j][3] * acc[j][3]); }
    q += shx(q, 16, lane); q += shx(q, 32, lane);
    if (kq == 0) SSQ[tvg * 64 + tm * 16 + r] = q;
    __syncthreads();
    const float rs = rsqrtf((SSQ[tm * 16 + r] + SSQ[64 + tm * 16 + r]) * (1.f / 128.f) + RMS_EPS);
#pragma unroll
    for (int j = 0; j < 4; ++j) { const int ch = h * HGD + (tvg * 4 + j) * 16 + 4 * kq; const f32x4 gn = *(const f32x4*)(gain + ch);
        const float g0 = pg8::bf_lo(gtw[j].x), g1 = pg8::bf_hi(gtw[j].x), g2 = pg8::bf_lo(gtw[j].y), g3 = pg8::bf_hi(gtw[j].y);
        v2u w; w.x = pk2(acc[j][0] * rs * gn[0] * g0 * pg8::sigmoidf_(g0), acc[j][1] * rs * gn[1] * g1 * pg8::sigmoidf_(g1));
        w.y = pk2(acc[j][2] * rs * gn[2] * g2 * pg8::sigmoidf_(g2), acc[j][3] * rs * gn[3] * g3 * pg8::sigmoidf_(g3));
        *(v2u*)(YB + t * HGW + ch) = w; }
    __syncthreads();
}
__device__ __forceinline__ void hgrn_out(const Frame& F, const bf16* proj, const unsigned char* r2, const bf16* SB, const float* gain, bf16* YB) {
    LAS float* SSQ = (LAS float*)F.lds;
    const bf16* OI = (const bf16*)(r2 + R2_OI); const bf16* QP = (const bf16*)(r2 + R2_QP);
    const int lane = F.lane, wv = F.wave, r = lane & 15, kq = lane >> 4, tm = wv & 3, tvg = wv >> 2;
    HoutOps A, B;
    int unit = blockIdx.x;
    if (unit < NHU) hout_load(A, unit, proj, OI, QP, SB, r, kq, tm, tvg);
    for (; unit < NHU; unit += 2 * F.G) {
        const int u2 = unit + F.G, u3 = unit + 2 * F.G;
        if (u2 < NHU) hout_load(B, u2, proj, OI, QP, SB, r, kq, tm, tvg);
        hout_compute(A, unit, proj, OI, SSQ, gain, YB, lane, r, kq, tm, tvg);
        if (u2 < NHU) { if (u3 < NHU) hout_load(A, u3, proj, OI, QP, SB, r, kq, tm, tvg);
            hout_compute(B, u2, proj, OI, SSQ, gain, YB, lane, r, kq, tm, tvg); }
    }
}
__device__ __forceinline__ void memattn(const Frame& F, const bf16* proj, const bf16* KV, int layer, bf16* YX) {
    lbf16* Ks = (lbf16*)F.lds;
    lbf16* VTs = Ks + 256 * 136;
    const int lane = F.lane, wv = F.wave, r = lane & 15, kq = lane >> 4;
    for (int unit = blockIdx.x; unit < NB * XAH * (SEQ / 256); unit += F.G) {
        const int b = unit >> 6, hd = (unit >> 4) & 3, qt = unit & 15;
#pragma unroll
        for (int i = 0; i < 8; ++i) { const int p = F.tid + 512 * i, key = p >> 4, dc = (p & 15) * 8;
            const bf16* src = KV + (size_t)(b * NMEM + key) * 2048 + layer * 1024 + hd * XAD + dc;
            *(LAS v4u*)(Ks + key * 136 + dc) = *(const v4u*)src;
            const v4u w = *(const v4u*)(src + 512);
            const int k5 = key & 31, pos = (key & ~31) + 8 * ((k5 >> 2) & 3) + 4 * ((k5 >> 4) & 1) + (k5 & 3);
            lbf16* d = VTs + dc * 264 + pos;
            d[0] = (bf16)(w.x & 0xffffu); d[264] = (bf16)(w.x >> 16); d[2 * 264] = (bf16)(w.y & 0xffffu); d[3 * 264] = (bf16)(w.y >> 16);
            d[4 * 264] = (bf16)(w.z & 0xffffu); d[5 * 264] = (bf16)(w.z >> 16); d[6 * 264] = (bf16)(w.w & 0xffffu); d[7 * 264] = (bf16)(w.w >> 16); }
        __syncthreads();
#pragma unroll 1
        for (int g = 0; g < 2; ++g) {
            const int t = b * SEQ + qt * 256 + wv * 32 + g * 16 + r;
            bf16x8 qf[4];
#pragma unroll
            for (int ks = 0; ks < 4; ++ks) qf[ks] = *(const bf16x8*)(proj + (size_t)t * INC + C_QX + hd * XAD + ks * 32 + kq * 8);
            f32x4 s[16];
#pragma unroll
            for (int kt = 0; kt < 16; ++kt) { s[kt] = (f32x4){0.f, 0.f, 0.f, 0.f};
#pragma unroll
                for (int ks = 0; ks < 4; ++ks) { const bf16x8 a = *(const LAS bf16x8*)(Ks + (kt * 16 + r) * 136 + ks * 32 + kq * 8); s[kt] = __builtin_amdgcn_mfma_f32_16x16x32_bf16(a, qf[ks], s[kt], 0, 0, 0); }
                if (kt & 1) __builtin_amdgcn_sched_barrier(0); }
            float m = -1e30f;
#pragma unroll
            for (int kt = 0; kt < 16; ++kt) m = fmaxf(m, fmaxf(fmaxf(s[kt][0], s[kt][1]), fmaxf(s[kt][2], s[kt][3])));
            m = fmaxf(m, shx(m, 16, lane)); m = fmaxf(m, shx(m, 32, lane));
            const float cs = 0.08838834764831845f * 1.4426950408889634f; float l = 0.f;
#pragma unroll
            for (int kt = 0; kt < 16; ++kt)
#pragma unroll
                for (int e = 0; e < 4; ++e) { const float p = __builtin_amdgcn_exp2f((s[kt][e] - m) * cs); s[kt][e] = p; l += p; }
            l += shx(l, 16, lane); l += shx(l, 32, lane);
            f32x4 o[8];
#pragma unroll
            for (int dt = 0; dt < 8; ++dt) o[dt] = (f32x4){0.f, 0.f, 0.f, 0.f};
#pragma unroll
            for (int j = 0; j < 8; ++j) {
                v4u pw; pw.x = pk2(s[2 * j][0], s[2 * j][1]); pw.y = pk2(s[2 * j][2], s[2 * j][3]); pw.z = pk2(s[2 * j + 1][0], s[2 * j + 1][1]); pw.w = pk2(s[2 * j + 1][2], s[2 * j + 1][3]);
                const bf16x8 pf = __builtin_bit_cast(bf16x8, pw);
#pragma unroll
                for (int dt = 0; dt < 8; ++dt) { const bf16x8 a = *(const LAS bf16x8*)(VTs + (dt * 16 + r) * 264 + j * 32 + kq * 8); o[dt] = __builtin_amdgcn_mfma_f32_16x16x32_bf16(a, pf, o[dt], 0, 0, 0); }
                __builtin_amdgcn_sched_barrier(0); }
            const float inv = 1.f / l;
#pragma unroll
            for (int dt = 0; dt < 8; ++dt) { v2u w; w.x = pk2(o[dt][0] * inv, o[dt][1] * inv); w.y = pk2(o[dt][2] * inv, o[dt][3] * inv);
                *(v2u*)(YX + (size_t)t * YXW + hd * XAD + dt * 16 + 4 * kq) = w; }
        }
        __syncthreads();
    }
}
struct Args { const float* in[24]; float* out; unsigned char* ws; int ph_lo, ph_hi, mask, pad; };
typedef const __attribute__((address_space(4))) Args* KArgs;
__device__ __forceinline__ KArgs kargs() { KArgs p = (KArgs)__builtin_amdgcn_kernarg_segment_ptr(); asm volatile("" : "+s"(p)); return p; }
#define WSP(T, off) ((T*)(ws + (off)))
__global__ void __launch_bounds__(NWAVES * 64, 2) mk_fwd(Args args) {
    extern __shared__ __attribute__((aligned(16))) unsigned char lds_raw[];
    Frame F0; F0.lds = (LAS unsigned char*)lds_raw; F0.tid = threadIdx.x; F0.lane = F0.tid & 63; F0.wave = __builtin_amdgcn_readfirstlane(F0.tid >> 6);
    F0.G = gridDim.x; F0.gw = blockIdx.x * NWAVES + F0.wave; F0.NGW = F0.G * NWAVES;
    volatile LAS unsigned* MISC = (volatile LAS unsigned*)(F0.lds + MISC_OFF);
    for (int u = F0.tid; u < (LDS_BYTES - MISC_OFF) / 4; u += NWAVES * 64) ((LAS unsigned*)(F0.lds + MISC_OFF))[u] = 0u;
    __syncthreads();
    const int lo = args.ph_lo, hi = args.ph_hi;
    const bool multi = (hi - lo) > 1;
    XcdBarrier bar; bar.bar = (unsigned*)(args.ws + WS_CTL) + CW_BAR; bar.x = 0; bar.st = nullptr;
    if (multi) bar = xcd_barrier_post((unsigned*)(args.ws + WS_CTL) + CW_BAR, MISC + 8);
#define IN(k) (lo <= (k) && (k) < hi)
#define SEAM(k) do { if (IN((k) + 1)) xcd_barrier(bar); } while (0)
#define PH_BEGIN KArgs ka = kargs(); unsigned char* ws = ka->ws; (void)ws; Frame F = F0; F.lane = pg8::lane_id_opaque(); F.tid = F0.wave * 64 + F.lane
    if (IN(PH_CVT)) {
        { PH_BEGIN;
        unsigned gb = 0;
        for (int l = 0; l < 2; ++l) {
            xpose_matrix(F, ka->in[2] + (size_t)l * D * INC, D, INC, (bf16*)(ws + WS_WIN_T + l * WIN_T_L), D, 0, gb);
            xpose_matrix(F, ka->in[4] + (size_t)l * CW * D, CW, D, (bf16*)(ws + WS_WBR_T + l * WBR_T_L), CW, 0, gb);
            xpose_matrix(F, ka->in[7] + (size_t)l * HGW * D, HGW, D, (bf16*)(ws + WS_WBR_T + l * WBR_T_L + 3 * MiB), HGW, 0, gb);
            xpose_matrix(F, ka->in[10] + (size_t)l * XAW * D, XAW, D, (bf16*)(ws + WS_WBR_T + l * WBR_T_L + 6 * MiB), YXW, 0, gb);
            for (int i = blockIdx.x * 512 + F.tid; i < D * 32; i += F.G * 512) *(v4u*)((bf16*)(ws + WS_WBR_T + l * WBR_T_L + 6 * MiB) + (size_t)(i >> 5) * YXW + XAW + (i & 31) * 8) = (v4u){0u, 0u, 0u, 0u};
            xpose_matrix(F, ka->in[11] + (size_t)l * D * D, D, D, (bf16*)(ws + WS_WO_T + l * WO_T_L), D, 0, gb);
            xpose_matrix(F, ka->in[8] + (size_t)l * D * XAW, D, XAW, (bf16*)(ws + WS_WKV_T) + (size_t)(l * 1024) * D, D, 0, gb);
            xpose_matrix(F, ka->in[9] + (size_t)l * D * XAW, D, XAW, (bf16*)(ws + WS_WKV_T) + (size_t)(l * 1024 + 512) * D, D, 0, gb);
        }
        cvt_router(F, ka->in[14], ws);
        cvt_rows(F, ka->in[0], WSP(bf16, WS_XBF), (size_t)NTOK * D / 8);
        cvt_rows(F, ka->in[1], WSP(bf16, WS_MEMBF), (size_t)NB * NMEM * D / 8);
        }
        SEAM(PH_CVT);
    }
    for (int l = 0; l < 2; ++l) {
        const int pb = PH_L0 + l * PH_PER_LAYER;
        if (IN(pb + P_INPROJ)) {
            { PH_BEGIN;
            const bool split = F.G == 256;
            const int oa = (int)blockIdx.x >> 3, ox = (int)blockIdx.x & 7; const bool conv = split && ox < 2;
            const int hrank = 2 * oa + ox, grank = oa;
            static_assert((256 - NCV) * GM_UNITS + NCV * CV_UNITS == (NTOK / 256) * (INC / 256), "in-projection unit shares");
            if (conv) { Frame Fc = F; Fc.gw = hrank * NWAVES + F.wave; Fc.NGW = NCV * NWAVES; unsigned gb = 0;
                cvt_experts(Fc, ka->in[16] + (size_t)l * NE * D * EH, ka->in[17] + (size_t)l * NE * D * EH, ka->in[18] + (size_t)l * NE * EH * D, ka->in[19] + (size_t)l * D * EH, ka->in[20] + (size_t)l * D * EH, ka->in[21] + (size_t)l * EH * D, ws, gb);
                __syncthreads(); }
            if (!split) { unsigned gb = 0; cvt_experts(F, ka->in[16] + (size_t)l * NE * D * EH, ka->in[17] + (size_t)l * NE * D * EH, ka->in[18] + (size_t)l * NE * EH * D, ka->in[19] + (size_t)l * D * EH, ka->in[20] + (size_t)l * D * EH, ka->in[21] + (size_t)l * EH * D, ws, gb); __syncthreads(); }
            DenseSched S; S.init(ws + WS_XBF, ws + WS_WIN_T + l * WIN_T_L, NTOK, INC, D, F.G, (int)blockIdx.x);
            if (split) { S.lin = 1; S.cnt = conv ? CV_UNITS : GM_UNITS;
                if (conv) { S.L0 = (256 - NCV) * GM_UNITS; S.G = NCV; S.c = hrank; } else { S.L0 = (ox - 2) * 32 * GM_UNITS; S.G = 32; S.c = grank; } }
            EpiProj E{WSP(bf16, WS_R1), WSP(unsigned char, WS_GATE8)};
            pg8::gemm_phase<EpiProj, DenseSched, true>(F.lds + RING_OFF, F.wave, D, S, E);
            if (l == 0) {
                DenseSched S2; S2.init(ws + WS_MEMBF, ws + WS_WKV_T, NB * NMEM, 2048, D, split ? 32 : F.G, split ? ((conv && hrank < 32) ? hrank : -1) : (int)blockIdx.x);
                EpiBf16Plain E2{WSP(bf16, WS_KV), 2048};
                pg8::gemm_phase<EpiBf16Plain, DenseSched, true>(F.lds + RING_OFF, F.wave, D, S2, E2);
            }
            }
            SEAM(pb + P_INPROJ);
        }
        if (IN(pb + P_MIX)) {
            { PH_BEGIN;
            memattn(F, WSP(bf16, WS_R1), WSP(bf16, WS_KV), l, WSP(bf16, WS_YX));
            hgrn_local(F, WSP(bf16, WS_R1), ka->in[5], l, ws + WS_R2);
            conv_part(F, WSP(bf16, WS_R1), ka->in[3] + (size_t)l * 3 * CW, WSP(bf16, WS_YA), WSP(bf16, WS_YX));
            }
            SEAM(pb + P_MIX);
        }
        if (IN(pb + P_SCAN)) {
            { PH_BEGIN;
            hgrn_scan(F, ws + WS_R2, WSP(v2u, WS_ZF));
            }
            SEAM(pb + P_SCAN);
        }
        if (IN(pb + P_HOUT)) {
            { PH_BEGIN;
            hgrn_out(F, WSP(bf16, WS_R1), ws + WS_R2, WSP(bf16, WS_ZF), ka->in[6] + (size_t)l * HGW, WSP(bf16, WS_YB));
            }
            SEAM(pb + P_HOUT);
        }
        if (IN(pb + P_BRANCH)) {
            { PH_BEGIN;
            static_assert(WS_YX - WS_YB == WS_YB - WS_YA, "branch inputs equally spaced");
            BranchSched S; S.init(ws + WS_YA, ws + WS_WBR_T + l * WBR_T_L, F.G, (int)blockIdx.x); EpiGateRT E{WSP(unsigned char, WS_GATE8), WSP(bf16, WS_MERGED)};
            pg8::gemm_phase<EpiGateRT, BranchSched, true>(F.lds + RING_OFF, F.wave, CW, S, E);
            }
            SEAM(pb + P_BRANCH);
        }
        if (IN(pb + P_WO)) {
            { PH_BEGIN;
            DenseSched S; S.init(ws + WS_MERGED, ws + WS_WO_T + l * WO_T_L, NTOK, D, D, F.G, (int)blockIdx.x);
            EpiResid<true> E{(const void*)WSP(bf16, WS_XBF), WSP(bf16, WS_ZF)}; pg8::gemm_phase<EpiResid<true>, DenseSched, true>(F.lds + RING_OFF, F.wave, D, S, E);
            }
            SEAM(pb + P_WO);
        }
        if (IN(pb + P_ROUTE)) {
            { PH_BEGIN;
            route_phase(F, WSP(bf16, WS_ZF), ka->in[12] + (size_t)l * D, ka->in[13] + (size_t)l * D, WSP(bf16, WS_RW + l * RW_L), ka->in[15] + (size_t)l * NE, WSP(bf16, WS_X1F), WSP(bf16, WS_X1BF),
                        WSP(unsigned, WS_CTL) + CW_CNT + l * 64, WSP(int, WS_LIST), WSP(int, WS_TOKSLOT), WSP(float, WS_TOKW));
            }
            SEAM(pb + P_ROUTE);
        }
        if (IN(pb + P_GU)) {
            { PH_BEGIN;
            moe_plan(F, WSP(unsigned, WS_CTL) + CW_CNT + l * 64);
            MoeSched<true> S; S.init(F, ws + WS_X1BF, ws + WS_WGU, WSP(int, WS_LIST)); EpiSwiGLU E{WSP(bf16, WS_R2)};
            pg8::gemm_phase<EpiSwiGLU, MoeSched<true>, true>(F.lds + RING_OFF, F.wave, D, S, E);
            }
            SEAM(pb + P_GU);
        }
        if (IN(pb + P_DOWN)) {
            { PH_BEGIN;
            moe_plan(F, WSP(unsigned, WS_CTL) + CW_CNT + l * 64);
            MoeSched<false> S; S.init(F, ws + WS_R2, ws + WS_WDN, nullptr); EpiY8 E{WSP(unsigned char, WS_R1), WSP(bf16, WS_R1 + R1_YS)};
            pg8::gemm_phase<EpiY8, MoeSched<false>, true>(F.lds + RING_OFF, F.wave, EH, S, E);
            }
            SEAM(pb + P_DOWN);
        }
        if (IN(pb + P_COMB)) {
            { PH_BEGIN;
            moe_plan(F, WSP(unsigned, WS_CTL) + CW_CNT + l * 64);
            combine_phase(F, WSP(bf16, WS_X1BF), WSP(unsigned char, WS_R1), WSP(bf16, WS_R1 + R1_YS), WSP(int, WS_TOKSLOT), WSP(float, WS_TOKW), ka->in[22] + (size_t)l * D, ka->in[23] + (size_t)l * D, ka->out, WSP(bf16, WS_XBF), l == 1);
            }
            SEAM(pb + P_COMB);
        }
    }
#undef IN
#undef SEAM
}
static void launch_mk(Args a, int lo, int hi, int grid, hipStream_t stream) {
    a.ph_lo = lo; a.ph_hi = hi;
    hipLaunchKernelGGL(mk_fwd, dim3(grid), dim3(NWAVES * 64), LDS_BYTES, stream, a);
}
extern "C" void kernel_launch(void* const* d_in, const int* in_sizes, int n_in, void* d_out, int out_size, void* d_ws, size_t ws_size, hipStream_t stream) {
    static int grid = 0;
    if (grid == 0) {
        if (n_in != 24 || out_size != NTOK * D || ws_size < WS_END) { fprintf(stderr, "kernel_launch: unexpected sizes n_in %d out %d ws %zu\n", n_in, out_size, ws_size); grid = -1; return; }
        int dev = 0, cus = 0;
        if (hipGetDevice(&dev) != hipSuccess || hipDeviceGetAttribute(&cus, hipDeviceAttributeMultiprocessorCount, dev) != hipSuccess) { grid = -1; return; }
        if (hipFuncSetAttribute((const void*)mk_fwd, hipFuncAttributeMaxDynamicSharedMemorySize, LDS_BYTES) != hipSuccess) { fprintf(stderr, "kernel_launch: hipFuncSetAttribute failed\n"); grid = -1; return; }
        int per_cu = 0; (void)hipOccupancyMaxActiveBlocksPerMultiprocessor(&per_cu, (const void*)mk_fwd, NWAVES * 64, LDS_BYTES); (void)hipGetLastError();
        if (per_cu < 1) fprintf(stderr, "kernel_launch: occupancy query says %d\n", per_cu);
        grid = cus;
    }
    if (grid < 0) return;
    const float* x = (const float*)d_in[0];
    const float* conv_w = (const float*)d_in[3]; const float* lbl = (const float*)d_in[5];
    const float* hg_g = (const float*)d_in[6];
    const float* ln1_g = (const float*)d_in[12]; const float* ln1_b = (const float*)d_in[13]; const float* router_w = (const float*)d_in[14];
    const float* router_b = (const float*)d_in[15]; const float* exp_wg = (const float*)d_in[16]; const float* exp_wu = (const float*)d_in[17];
    const float* exp_wd = (const float*)d_in[18]; const float* sh_wg = (const float*)d_in[19]; const float* sh_wu = (const float*)d_in[20];
    const float* sh_wd = (const float*)d_in[21]; const float* ln2_g = (const float*)d_in[22]; const float* ln2_b = (const float*)d_in[23];
    unsigned char* ws = (unsigned char*)d_ws; float* out = (float*)d_out;
    unsigned* ctl = (unsigned*)(ws + WS_CTL);
    bf16* KV = (bf16*)(ws + WS_KV); bf16* XBF = (bf16*)(ws + WS_XBF); float* X1F = (float*)(ws + WS_X1F);
    bf16* X1BF = (bf16*)(ws + WS_X1BF); float* ZF = (float*)(ws + WS_ZF);
    bf16* YA = (bf16*)(ws + WS_YA); bf16* YB = (bf16*)(ws + WS_YB); bf16* YX = (bf16*)(ws + WS_YX);
    bf16* H = (bf16*)(ws + WS_R2); float* OH = (float*)(ws + WS_R2); bf16* PROJ = (bf16*)(ws + WS_R1); bf16* Y = (bf16*)(ws + WS_R1);
    int* LIST = (int*)(ws + WS_LIST); int* TOKSLOT = (int*)(ws + WS_TOKSLOT); float* TOKW = (float*)(ws + WS_TOKW);
    Args a{};
    for (int i = 0; i < 24; ++i) a.in[i] = (const float*)d_in[i];
    a.out = out; a.ws = ws;

    (void)hipMemsetAsync(ws + WS_CTL, 0, CTL_BYTES, stream);
    a.mask = 7;
    launch_mk(a, 0, N_PHASES, grid, stream);
}
```

```cpp
#include <hip/hip_runtime.h>
#include <stdint.h>
#include <stdio.h>

typedef unsigned short bf16;
__device__ __forceinline__ float bf2f(bf16 v) { return __uint_as_float(((unsigned)v) << 16); }
__device__ __forceinline__ bf16 f2bf(float f) { unsigned u = __float_as_uint(f); return (bf16)((u + 0x7fffu + ((u >> 16) & 1u)) >> 16); }

constexpr int NB = 4, SEQ = 4096, NTOK = NB * SEQ, D = 2048, NMEM = 256;
constexpr int CW = 768, HGW = 768, HGH = 6, HGD = 128, XAW = 512, XAH = 4, XAD = 128;
constexpr int INC = 12032, YXW = 768, GW8 = 3 * 2048, PN_GATE = 23;
constexpr int C_U = 0, C_B = 768, C_C = 1536, C_Q = 2304, C_F = 3072, C_I = 3840, C_G = 4608, C_QX = 5376, C_GA = 5888, C_GB = 7936, C_GX = 9984;
constexpr int NE = 64, TOPK = 8, EH = 512;
constexpr float ALPHA = 1.41421356237f, LN_EPS = 1e-5f, RMS_EPS = 1e-6f, RSCALE = 2.5f;
constexpr int LISTCAP = 16384;

constexpr size_t MiB = 1u << 20;
constexpr size_t WS_CTL = 0, CTL_BYTES = 1 * MiB;
constexpr size_t WS_RW = 1 * MiB, RW_L = 512 * 1024;
constexpr size_t WS_WIN_T = 2 * MiB, WIN_T_L = 47 * MiB;
constexpr size_t WS_WBR_T = 1932 * MiB, WBR_T_L = 9 * MiB;
constexpr size_t WS_WO_T = 112 * MiB, WO_T_L = 8 * MiB;
constexpr size_t WS_WKV_T = 128 * MiB;
constexpr size_t WS_MEMBF = 136 * MiB, WS_KV = 140 * MiB;
constexpr size_t WS_WGU = 144 * MiB, WGU_E = 4 * MiB;
constexpr size_t WS_WDN = 404 * MiB, WDN_E = 2 * MiB;
constexpr size_t WS_XBF = 534 * MiB, WS_X1F = 598 * MiB, WS_X1BF = 726 * MiB, WS_ZF = 790 * MiB, WS_MERGED = 918 * MiB;
constexpr size_t WS_YA = 1860 * MiB, WS_YB = 1884 * MiB, WS_YX = 1908 * MiB;
constexpr size_t WS_R2 = 1046 * MiB;
constexpr size_t WS_R1 = 1214 * MiB;
constexpr size_t R1_YS = 320 * MiB;
constexpr size_t WS_LIST = 1854 * MiB, WS_TOKSLOT = 1858 * MiB, WS_TOKW = 1859 * MiB, WS_GATE8 = 1950 * MiB, WS_END = 2046 * MiB;
constexpr int CW_CNT = 1024;
constexpr int CW_PLAN = 2048;
constexpr int CW_BAR = 4096;
#ifndef DBG_MASK
#define DBG_MASK 7
#endif
namespace pg8 {
#define PG8_LAS __attribute__((address_space(3)))
typedef unsigned short bf16_t;
typedef short bf16x8 __attribute__((ext_vector_type(8)));
typedef float f32x4 __attribute__((ext_vector_type(4)));
typedef unsigned u32x4 __attribute__((ext_vector_type(4)));
typedef unsigned u32x2 __attribute__((ext_vector_type(2)));
constexpr int PG8_NVO_OFF = 147456 + 1024;
constexpr int BM = 256, BK = 64, HALF = 128, HTB = HALF * BK * 2  , STAGE_BYTES = 8 * HTB, NXCD = 8, WGM = 8;

__host__ __device__ __forceinline__ int lds_byte(int r, int c) { const int st = (r >> 4) * 2 + (c >> 5), rr = r & 15, cc = c & 31, ob = rr * 64 + cc * 2; return st * 1024 + (ob ^ (((ob >> 9) & 1) << 5)); }
__host__ __device__ __forceinline__ void stage_rc(int b, int& R, int& C) { const int st = b / 1024, sb = b % 1024, swz = sb ^ (((sb >> 9) & 1) << 5); R = (st >> 1) * 16 + swz / 64; C = (st & 1) * 32 + (swz % 64) / 2; }
__host__ __device__ __forceinline__ int perm32(int rho) { const int n = rho >> 4, i = rho & 15; return 8 * (i >> 2) + 4 * n + (i & 3); }

struct Unit { const char* A; const char* B; int pm, pn; const int* list; int m0, cnt; };

typedef float f32x2_ __attribute__((ext_vector_type(2)));
typedef __bf16 bf16x2_ __attribute__((ext_vector_type(2)));
__device__ __forceinline__ unsigned cvt_pk_bf16(float lo, float hi) { const f32x2_ v = {lo, hi}; const bf16x2_ b = __builtin_convertvector(v, bf16x2_); return __builtin_bit_cast(unsigned, b); }
__device__ __forceinline__ int lane_id_opaque() { unsigned m = ~0u; asm volatile("" : "+s"(m)); return (int)__builtin_amdgcn_mbcnt_hi(m, __builtin_amdgcn_mbcnt_lo(m, 0u)); }
__device__ __forceinline__ float bf_lo(unsigned w) { return __uint_as_float(w << 16); }
__device__ __forceinline__ float bf_hi(unsigned w) { return __uint_as_float(w & 0xffff0000u); }
__device__ __forceinline__ float sigmoidf_(float x) { return __builtin_amdgcn_rcpf(1.f + __expf(-x)); }

typedef f32x4 Acc[2][2][4][2];

template <class Epi, class Sched, bool ALIGN_EPI>
__device__ __forceinline__ void gemm_phase(PG8_LAS unsigned char* lds, const int wave, const int K_in, const Sched& S, const Epi& E) {
    const int lane = lane_id_opaque(), wid = wave, tid = wid * 64 + lane, wr = wid >> 2, wc = wid & 3, fr = lane & 15, fq = lane >> 4;
    int K = K_in; asm volatile("" : "+s"(K));
    const int nt = K / BK;
    unsigned voffB[2];
#pragma unroll
    for (int i = 0; i < 2; ++i) { int R, C; stage_rc(tid * 16 + i * 8192, R, C); const int Rb = Epi::PERM ? ((R & ~31) + perm32(R & 31)) : R; voffB[i] = (unsigned)(Rb * K + C) * 2u; }
    const size_t kstep = (size_t)(BK * 2);
    const size_t hstep = (size_t)HALF * K * 2;
    const unsigned ldsw = (unsigned)wid * 1024u;
    const int aoff = lds_byte(wr * 64 + fr, fq * 8), boff = lds_byte(wc * 32 + fr, fq * 8);
#define PG8_SA(b, h) (((b) * 2 + (h)) * HTB)
#define PG8_SB(b, h) ((4 + (b) * 2 + (h)) * HTB)
#define PG8_STAGE2(bufoff, gbase, v0, v1) do { \
        __builtin_amdgcn_global_load_lds((const unsigned*)((const char*)(gbase) + (v0)), (PG8_LAS unsigned*)(lds + (bufoff) + ldsw), 16, 0, 0); \
        __builtin_amdgcn_global_load_lds((const unsigned*)((const char*)(gbase) + (v1)), (PG8_LAS unsigned*)(lds + (bufoff) + ldsw + 8192), 16, 0, 0); } while (0)
#define PG8_STAGEB(bufoff, gbase) PG8_STAGE2(bufoff, gbase, voffB[0], voffB[1])
#define PG8_LDA(dst, b, h) do { _Pragma("unroll") for (int m = 0; m < 4; ++m) _Pragma("unroll") for (int k = 0; k < 2; ++k) dst[m][k] = *(const PG8_LAS bf16x8*)(lds + PG8_SA(b, h) + aoff + m * 2048 + k * 1024); } while (0)
#define PG8_LDB(dst, b, h) do { _Pragma("unroll") for (int n = 0; n < 2; ++n) _Pragma("unroll") for (int k = 0; k < 2; ++k) dst[n][k] = *(const PG8_LAS bf16x8*)(lds + PG8_SB(b, h) + boff + n * 2048 + k * 1024); } while (0)
#define PG8_MMA(ai, bj, At, Bt) do { __builtin_amdgcn_s_setprio(1); _Pragma("unroll") for (int m = 0; m < 4; ++m) _Pragma("unroll") for (int n = 0; n < 2; ++n) _Pragma("unroll") for (int k = 0; k < 2; ++k) \
        acc[ai][bj][m][n] = __builtin_amdgcn_mfma_f32_16x16x32_bf16(Bt[n][k], At[m][k], acc[ai][bj][m][n], 0, 0, 0); __builtin_amdgcn_s_setprio(0); } while (0)
#define PG8_WAIT_V(n) asm volatile("s_waitcnt vmcnt(" #n ")" ::: "memory")
#define PG8_WAIT_L(n) asm volatile("s_waitcnt lgkmcnt(" #n ")" ::: "memory")
#define PG8_BAR __builtin_amdgcn_s_barrier()
#define PG8_SCHED __builtin_amdgcn_sched_barrier(0)
    Unit cur, nxt; int ui = 0;
    if (!S.next(0, cur)) return;
    Acc acc;
#pragma unroll
    for (int a = 0; a < 2; ++a)
#pragma unroll
        for (int b = 0; b < 2; ++b)
#pragma unroll
            for (int m = 0; m < 4; ++m)
#pragma unroll
                for (int n = 0; n < 2; ++n) acc[a][b][m][n] = (f32x4){0.f, 0.f, 0.f, 0.f};
    bf16x8 At[4][2], B0[2][2], B1[2][2];
    constexpr bool GA = Sched::GATHER;
    unsigned c00, c01, c10 = 0, c11 = 0;
    PG8_LAS unsigned* nvo = (PG8_LAS unsigned*)(lds + PG8_NVO_OFF) + tid * 4;
    { int R0, C0, R1, C1; stage_rc(tid * 16, R0, C0); stage_rc(tid * 16 + 8192, R1, C1);
      c00 = S.avoff(cur, 0, R0, C0, K); c01 = S.avoff(cur, 0, R1, C1, K); if constexpr (GA) { c10 = S.avoff(cur, 1, R0, C0, K); c11 = S.avoff(cur, 1, R1, C1, K); } }
    const size_t hA = GA ? (size_t)0 : hstep;
#define PG8_STAGEA0(bufoff, gbase) PG8_STAGE2(bufoff, gbase, c00, c01)
#define PG8_STAGEA1(bufoff, gbase) do { if constexpr (GA) PG8_STAGE2(bufoff, gbase, c10, c11); else PG8_STAGE2(bufoff, (gbase) + hA, c00, c01); } while (0)
    const char* cA = cur.A; const char* cB = cur.B;
    PG8_STAGEB(PG8_SB(0, 0), cB); PG8_STAGEB(PG8_SB(0, 1), cB + hstep); PG8_STAGEA0(PG8_SA(0, 0), cA); PG8_STAGEA1(PG8_SA(0, 1), cA);
    if (wr == 1) PG8_BAR;
    PG8_WAIT_V(2); PG8_BAR;
    PG8_STAGEB(PG8_SB(1, 0), cB + kstep); PG8_STAGEA0(PG8_SA(1, 0), cA + kstep); PG8_STAGEB(PG8_SB(1, 1), cB + hstep + kstep);
    PG8_WAIT_V(6); PG8_BAR;
    int pi0 = 0, pi1 = 0, pi2 = 0, pi3 = 0;
    if constexpr (GA) { Unit n1; if (S.next(1, n1)) { int R0, C0, R1, C1; stage_rc(tid * 16, R0, C0); stage_rc(tid * 16 + 8192, R1, C1);
        pi0 = S.avload(n1, 0, R0); pi1 = S.avload(n1, 0, R1); pi2 = S.avload(n1, 1, R0); pi3 = S.avload(n1, 1, R1); } }
    for (;;) {
        const bool has_next = S.next(ui + 1, nxt);
        const char* nA = has_next ? nxt.A : cA; const char* nB = has_next ? nxt.B : cB;
        if constexpr (GA) { if (has_next) {
            int R0, C0, R1, C1; stage_rc(tid * 16, R0, C0); stage_rc(tid * 16 + 8192, R1, C1);
            nvo[0] = S.avfin(nxt, 0, R0, C0, K, pi0); nvo[1] = S.avfin(nxt, 0, R1, C1, K, pi1); nvo[2] = S.avfin(nxt, 1, R0, C0, K, pi2); nvo[3] = S.avfin(nxt, 1, R1, C1, K, pi3); } }
        for (int t = 0; t < nt; t += 2) {
            const bool last = (t == nt - 2);
            const char* a1 = cA + (size_t)(t + 1) * kstep;
            const char* a2 = last ? nA : cA + (size_t)(t + 2) * kstep; const char* b2 = last ? nB : cB + (size_t)(t + 2) * kstep;
            const char* a3 = a2 + kstep; const char* b3 = b2 + kstep;
            const bool nx = GA && last && has_next;
#define PG8_STAGEA0N(bufoff, gbase) do { if (nx) { const unsigned q0 = nvo[0], q1 = nvo[1]; PG8_STAGE2(bufoff, gbase, q0, q1); } else PG8_STAGEA0(bufoff, gbase); } while (0)
#define PG8_STAGEA1N(bufoff, gbase) do { if (nx) { const unsigned q0 = nvo[2], q1 = nvo[3]; PG8_STAGE2(bufoff, gbase, q0, q1); } else PG8_STAGEA1(bufoff, gbase); } while (0)
            PG8_LDB(B0, 0, 0); PG8_LDB(B1, 0, 1); PG8_SCHED; PG8_LDA(At, 0, 0); PG8_STAGEA1(PG8_SA(1, 1), a1);
            PG8_WAIT_V(8); PG8_WAIT_L(0); PG8_BAR; PG8_MMA(0, 0, At, B0); PG8_MMA(0, 1, At, B1); PG8_BAR; PG8_SCHED;
            PG8_LDA(At, 0, 1); PG8_STAGEB(PG8_SB(0, 0), b2); PG8_STAGEB(PG8_SB(0, 1), b2 + hstep); PG8_STAGEA0N(PG8_SA(0, 0), a2);
            PG8_WAIT_V(8); PG8_WAIT_L(0); PG8_BAR; PG8_MMA(1, 0, At, B0); PG8_MMA(1, 1, At, B1); PG8_BAR; PG8_SCHED;
            PG8_LDB(B0, 1, 0); PG8_LDB(B1, 1, 1); PG8_SCHED; PG8_LDA(At, 1, 0); PG8_STAGEA1N(PG8_SA(0, 1), a2);
            PG8_WAIT_V(8); PG8_WAIT_L(0); PG8_BAR; PG8_MMA(0, 0, At, B0); PG8_MMA(0, 1, At, B1); PG8_BAR; PG8_SCHED;
            PG8_LDA(At, 1, 1); PG8_STAGEB(PG8_SB(1, 0), b3); PG8_STAGEB(PG8_SB(1, 1), b3 + hstep); PG8_STAGEA0N(PG8_SA(1, 0), a3);
            PG8_WAIT_V(8); PG8_WAIT_L(0); PG8_BAR; PG8_MMA(1, 0, At, B0); PG8_MMA(1, 1, At, B1); PG8_BAR; PG8_SCHED;
#undef PG8_STAGEA0N
#undef PG8_STAGEA1N
        }
        if constexpr (GA) { Unit n2; if (has_next && S.next(ui + 2, n2)) { int R0, C0, R1, C1; stage_rc(tid * 16, R0, C0); stage_rc(tid * 16 + 8192, R1, C1);
            pi0 = S.avload(n2, 0, R0); pi1 = S.avload(n2, 0, R1); pi2 = S.avload(n2, 1, R0); pi3 = S.avload(n2, 1, R1); } }
        if constexpr (ALIGN_EPI) { if (wr == 0) PG8_BAR; }
        bool keep = false;
        if constexpr (Epi::INPLACE) keep = E.inplace(acc, cur, wr, wc, fr, fq); else E(acc, cur, wr, wc, fr, fq);
        if (!has_next) break;
        if (!keep)
#pragma unroll
        for (int a = 0; a < 2; ++a)
#pragma unroll
            for (int b = 0; b < 2; ++b)
#pragma unroll
                for (int m = 0; m < 4; ++m)
#pragma unroll
                    for (int n = 0; n < 2; ++n) acc[a][b][m][n] = (f32x4){0.f, 0.f, 0.f, 0.f};
        cur = nxt; cA = nA; cB = nB; ++ui; if constexpr (GA) { c00 = nvo[0]; c01 = nvo[1]; c10 = nvo[2]; c11 = nvo[3]; }
        if constexpr (ALIGN_EPI) { if (wr == 1) PG8_BAR; }
    }
    PG8_WAIT_V(0);
    if constexpr (!ALIGN_EPI) { if (wr == 0) PG8_BAR; }
    PG8_BAR;
#undef PG8_SA
#undef PG8_SB
#undef PG8_STAGE2
#undef PG8_STAGEB
#undef PG8_STAGEA0
#undef PG8_STAGEA1
#undef PG8_LDA
#undef PG8_LDB
#undef PG8_MMA
#undef PG8_WAIT_V
#undef PG8_WAIT_L
#undef PG8_BAR
#undef PG8_SCHED
}
}
#define GAS __attribute__((address_space(1)))
#define LAS __attribute__((address_space(3)))
typedef unsigned v4u __attribute__((ext_vector_type(4)));
typedef unsigned v2u __attribute__((ext_vector_type(2)));
typedef float f32x4 __attribute__((ext_vector_type(4)));
typedef short bf16x8 __attribute__((ext_vector_type(8)));
typedef GAS unsigned gu32;
#define RLX_AGENT __ATOMIC_RELAXED, __HIP_MEMORY_SCOPE_AGENT
#define LDS_WAIT() asm volatile("s_waitcnt lgkmcnt(0)" ::: "memory")
#define VM_WAIT() asm volatile("s_waitcnt vmcnt(0)" ::: "memory")
__device__ __forceinline__ int opaque_v(int x) { asm volatile("" : "+v"(x)); return x; }
__device__ __forceinline__ float shx(float v, int o, int lane) { return __int_as_float(__builtin_amdgcn_ds_bpermute((lane ^ o) << 2, __float_as_int(v))); }
__device__ __forceinline__ unsigned pk2(float lo, float hi) { return pg8::cvt_pk_bf16(lo, hi); }

#define XB_TMO      128
#define XB_XCNT(j)  (256  + 64 * (j))
#define XB_XSUB(j)  (1280 + 64 * (j))
#define XB_XGEN(j)  (2304 + 64 * (j))
#define XB_TOP      3328
#define XB_TOPGEN   3392
#define XCD_BAR_WORDS 3456
#define XB_SPIN_CAP (1u << 18)
__device__ __forceinline__ unsigned xb_ld(unsigned* p)              { return __hip_atomic_load(p, __ATOMIC_RELAXED, __HIP_MEMORY_SCOPE_AGENT); }
__device__ __forceinline__ unsigned xb_add(unsigned* p, unsigned v) { return __hip_atomic_fetch_add(p, v, __ATOMIC_RELAXED, __HIP_MEMORY_SCOPE_AGENT); }
__device__ __forceinline__ unsigned xb_xcc_id() { return (unsigned)__builtin_amdgcn_s_getreg((3 << 11) | 20) & 0xFu; }
#define XB_SPIN(cond, bar) do { unsigned _sp = 0; while (cond) { __builtin_amdgcn_s_sleep(1); \
    if ((++_sp & 255u) == 0u) { if (xb_ld(&(bar)[XB_TMO])) break; if (_sp > XB_SPIN_CAP) { atomicAdd(&(bar)[XB_TMO], 1u); break; } } } } while (0)
struct XcdBarrier { unsigned* bar; unsigned x; volatile LAS unsigned* st; };
__device__ __forceinline__ XcdBarrier xcd_barrier_post(unsigned* bar, volatile LAS unsigned* st) {
    XcdBarrier b; b.bar = bar; b.x = xb_xcc_id(); b.st = st;
    if (threadIdx.x == 0) (void)xb_add(&bar[XB_XCNT(b.x)], 1u);
    return b;
}
__device__ __forceinline__ void xcd_barrier_complete(unsigned* bar, unsigned x, unsigned& nloc, unsigned& nx) {
    const unsigned G = gridDim.x * gridDim.y * gridDim.z;
    unsigned sum, cnt, mine, sp = 0u;
    for (;;) {
        sum = 0u; cnt = 0u; mine = 0u;
#pragma unroll
        for (unsigned j = 0; j < 16; ++j) { const unsigned c = xb_ld(&bar[XB_XCNT(j)]); sum += c; cnt += (c > 0u) ? 1u : 0u; mine = (j == x) ? c : mine; }
        if (sum == G) break;
        __builtin_amdgcn_s_sleep(1);
        if ((++sp & 255u) == 0u) { if (xb_ld(&bar[XB_TMO])) break; if (sp > XB_SPIN_CAP) { atomicAdd(&bar[XB_TMO], 1u); break; } }
    }
    nloc = mine > 0u ? mine : 1u; nx = cnt > 0u ? cnt : 1u;
}
__device__ __forceinline__ void xcd_barrier(const XcdBarrier& b_in) {
    asm volatile("s_waitcnt vmcnt(0)" ::: "memory");
    __syncthreads();
    if (threadIdx.x == 0) {
        XcdBarrier b = b_in; asm volatile("" : "+s"(b.x));
        unsigned* bar = b.bar; asm volatile("" : "+s"(bar));
        __builtin_amdgcn_s_waitcnt(0);
        unsigned nloc = b.st[0], nx = b.st[1];
        if (nloc == 0u) { xcd_barrier_complete(bar, b.x, nloc, nx); b.st[0] = nloc; b.st[1] = nx; }
        const unsigned old = xb_add(&bar[XB_XSUB(b.x)], 1u);
        const unsigned gen = old / nloc;
        if (old + 1u == (gen + 1u) * nloc) {
            __builtin_amdgcn_fence(__ATOMIC_RELEASE, "agent");
            asm volatile("s_waitcnt vmcnt(0)" ::: "memory");
            const unsigned og = xb_add(&bar[XB_TOP], 1u);
            const unsigned tg = og / nx;
            if (og + 1u == (tg + 1u) * nx) xb_add(&bar[XB_TOPGEN], 1u);
            else XB_SPIN(xb_ld(&bar[XB_TOPGEN]) == tg, bar);
            __builtin_amdgcn_fence(__ATOMIC_ACQUIRE, "agent");
            xb_add(&bar[XB_XGEN(b.x)], 1u);
            asm volatile("s_waitcnt vmcnt(0)" ::: "memory");
        } else {
            XB_SPIN(xb_ld(&bar[XB_XGEN(b.x)]) == gen, bar);
            __builtin_amdgcn_fence(__ATOMIC_ACQUIRE, "agent");
            asm volatile("s_waitcnt vmcnt(0)" ::: "memory");
        }
    }
    __syncthreads();
}
using pg8::Unit; using pg8::Acc;
struct DenseSched { static constexpr bool GATHER = false;
    const char* A; const char* B; int nM, nN, nwg, G, c, K; int L0 = 0, cnt = 1 << 30, lin = 0;
    __device__ __forceinline__ void init(const void* A_, const void* B_, int M, int N, int K_, int G_, int c_) { A = (const char*)A_; B = (const char*)B_; nM = M / 256; nN = N / 256; nwg = nM * nN; G = G_; c = c_; K = K_; }
    __device__ __forceinline__ bool next(int i, Unit& u) const {
        const long L = (long)L0 + (long)i * G + c; if (c < 0 || i >= cnt || L >= nwg) return false;
        int wgid = (int)L; if (!lin) { const int q = nwg / 8, r = nwg % 8, xcd = wgid % 8, off = wgid / 8; wgid = (xcd < r ? xcd * (q + 1) : r * (q + 1) + (xcd - r) * q) + off; }
        const int nig = 8 * nN, gid = wgid / nig, fm = gid * 8, gsz = (nM - fm) < 8 ? (nM - fm) : 8;
        u.pm = fm + ((wgid % nig) % gsz); u.pn = (wgid % nig) / gsz;
        u.A = A + (size_t)u.pm * 256 * K * 2; u.B = B + (size_t)u.pn * 256 * K * 2; u.list = nullptr; u.m0 = 0; u.cnt = 0; return true;
    }
    __device__ __forceinline__ int avload(const Unit&, int, int) const { return 0; }
    __device__ __forceinline__ unsigned avfin(const Unit&, int h, int R, int C, int K_, int) const { return (unsigned)(((h * 128 + R) * K_ + C) * 2); }
    __device__ __forceinline__ unsigned avoff(const Unit&, int h, int R, int C, int K_) const { return (unsigned)(((h * 128 + R) * K_ + C) * 2); }
};
struct EpiBf16Plain { static constexpr bool PERM = true, INPLACE = false; bf16* O; int ldc;
    __device__ __forceinline__ void operator()(const Acc& acc, const Unit& u, int wr, int wc, int fr, int fq) const {
        const int row0 = u.pm * 256 + wr * 64 + fr, col0 = u.pn * 256 + wc * 32 + 8 * fq;
#pragma unroll
        for (int ai = 0; ai < 2; ++ai)
#pragma unroll
            for (int m = 0; m < 4; ++m) { bf16* rowp = O + (size_t)(row0 + ai * 128 + m * 16) * ldc + col0;
#pragma unroll
                for (int bj = 0; bj < 2; ++bj) { const f32x4 v0 = acc[ai][bj][m][0], v1 = acc[ai][bj][m][1];
                    v4u w; w.x = pk2(v0[0], v0[1]); w.y = pk2(v0[2], v0[3]); w.z = pk2(v1[0], v1[1]); w.w = pk2(v1[2], v1[3]);
                    *(v4u*)(rowp + bj * 128) = w; } }
    }
};
struct EpiProj { static constexpr bool PERM = true, INPLACE = false; bf16* O; unsigned char* G8;
    __device__ __forceinline__ void operator()(const Acc& acc, const Unit& u, int wr, int wc, int fr, int fq) const {
        const int row0 = u.pm * 256 + wr * 64 + fr;
        if (u.pn < PN_GATE) { const int col0 = u.pn * 256 + wc * 32 + 8 * fq;
#pragma unroll
            for (int ai = 0; ai < 2; ++ai)
#pragma unroll
                for (int m = 0; m < 4; ++m) { bf16* rowp = O + (size_t)(row0 + ai * 128 + m * 16) * INC + col0;
#pragma unroll
                    for (int bj = 0; bj < 2; ++bj) { const f32x4 v0 = acc[ai][bj][m][0], v1 = acc[ai][bj][m][1];
                        v4u w; w.x = pk2(v0[0], v0[1]); w.y = pk2(v0[2], v0[3]); w.z = pk2(v1[0], v1[1]); w.w = pk2(v1[2], v1[3]);
                        *(v4u*)(rowp + bj * 128) = w; } }
        } else { const int pos0 = (u.pn - PN_GATE) * 256 + wc * 64 + fq * 16;
#pragma unroll
            for (int ai = 0; ai < 2; ++ai)
#pragma unroll
                for (int m = 0; m < 4; ++m) { unsigned char* rowp = G8 + (size_t)(row0 + ai * 128 + m * 16) * GW8 + pos0;
                    v4u w;
#pragma unroll
                    for (int bj = 0; bj < 2; ++bj) { const f32x4 v0 = acc[ai][bj][m][0], v1 = acc[ai][bj][m][1];
                        unsigned q[8];
#pragma unroll
                        for (int j = 0; j < 4; ++j) { q[j] = (unsigned)fmaxf(pg8::sigmoidf_(v0[j]) * 255.f + 0.5f, 1.f); q[4 + j] = (unsigned)fmaxf(pg8::sigmoidf_(v1[j]) * 255.f + 0.5f, 1.f); }
                        const unsigned lo = q[0] | (q[1] << 8) | (q[2] << 16) | (q[3] << 24), hi = q[4] | (q[5] << 8) | (q[6] << 16) | (q[7] << 24);
                        if (bj == 0) { w.x = lo; w.y = hi; } else { w.z = lo; w.w = hi; } }
                    *(v4u*)rowp = w; }
        }
    }
};
struct BranchSched { static constexpr bool GATHER = false;
    const char* A0; const char* B; int G, c;
    __device__ __forceinline__ void init(const void* ya, const void* w, int G_, int c_) { A0 = (const char*)ya; B = (const char*)w; G = G_; c = c_; }
    __device__ __forceinline__ bool next(int i, Unit& u) const {
        const int j = i / 3, seg = i - 3 * j; constexpr int nM = NTOK / 256, nN = D / 256, nwg = nM * nN;
        const int L = j * G + c; if (L >= nwg) return false;
        int wgid = L; { const int q = nwg / 8, xcd = wgid % 8, off = wgid / 8; wgid = xcd * q + off; }
        const int nig = 8 * nN; u.pm = (wgid / nig) * 8 + ((wgid % nig) % 8); u.pn = (wgid % nig) / 8;
        u.A = A0 + (size_t)seg * (WS_YB - WS_YA) + (size_t)u.pm * 256 * CW * 2; u.B = B + (size_t)seg * 3 * MiB + (size_t)u.pn * 256 * CW * 2; u.list = nullptr; u.m0 = seg; u.cnt = 0; return true; }
    __device__ __forceinline__ int avload(const Unit&, int, int) const { return 0; }
    __device__ __forceinline__ unsigned avfin(const Unit&, int h, int R, int C, int K_, int) const { return (unsigned)(((h * 128 + R) * K_ + C) * 2); }
    __device__ __forceinline__ unsigned avoff(const Unit&, int h, int R, int C, int K_) const { return (unsigned)(((h * 128 + R) * K_ + C) * 2); }
};
struct EpiGateRT { static constexpr bool PERM = true, INPLACE = true; const unsigned char* g8; bf16* merged;
    __device__ __forceinline__ bool inplace(Acc& acc, const Unit& u, int wr, int wc, int fr, int fq) const {
        const int row0 = u.pm * 256 + wr * 64 + fr, col0 = u.pn * 256 + wc * 32 + 8 * fq, pos0 = u.pn * 256 + wc * 64 + fq * 16; const int seg = u.m0;
#pragma unroll
        for (int ai = 0; ai < 2; ++ai) {
            v4u ga[4], gb[4];
#pragma unroll
            for (int m = 0; m < 4; ++m) { const size_t row = (size_t)(row0 + ai * 128 + m * 16);
                ga[m] = *(const v4u*)(g8 + row * GW8 + seg * D + pos0); gb[m] = ga[m]; if (seg < 2) gb[m] = *(const v4u*)(g8 + row * GW8 + (seg + 1) * D + pos0); }
            asm volatile("" ::: "memory");
#pragma unroll
            for (int m = 0; m < 4; ++m) { const size_t row = (size_t)(row0 + ai * 128 + m * 16);
#pragma unroll
                for (int bj = 0; bj < 2; ++bj) { const unsigned ax = bj ? ga[m].z : ga[m].x, ay = bj ? ga[m].w : ga[m].y, bx = bj ? gb[m].z : gb[m].x, by = bj ? gb[m].w : gb[m].y;
                    f32x4 v0 = acc[ai][bj][m][0], v1 = acc[ai][bj][m][1];
                    if (seg < 2) {
                        v0[0] *= (float)(ax & 255u) * __builtin_amdgcn_rcpf((float)(bx & 255u)); v0[1] *= (float)((ax >> 8) & 255u) * __builtin_amdgcn_rcpf((float)((bx >> 8) & 255u));
                        v0[2] *= (float)((ax >> 16) & 255u) * __builtin_amdgcn_rcpf((float)((bx >> 16) & 255u)); v0[3] *= (float)(ax >> 24) * __builtin_amdgcn_rcpf((float)(bx >> 24));
                        v1[0] *= (float)(ay & 255u) * __builtin_amdgcn_rcpf((float)(by & 255u)); v1[1] *= (float)((ay >> 8) & 255u) * __builtin_amdgcn_rcpf((float)((by >> 8) & 255u));
                        v1[2] *= (float)((ay >> 16) & 255u) * __builtin_amdgcn_rcpf((float)((by >> 16) & 255u)); v1[3] *= (float)(ay >> 24) * __builtin_amdgcn_rcpf((float)(by >> 24));
                        acc[ai][bj][m][0] = v0; acc[ai][bj][m][1] = v1;
                    } else { constexpr float s8 = 1.f / 255.f;
                        v0[0] *= (float)(ax & 255u) * s8; v0[1] *= (float)((ax >> 8) & 255u) * s8; v0[2] *= (float)((ax >> 16) & 255u) * s8; v0[3] *= (float)(ax >> 24) * s8;
                        v1[0] *= (float)(ay & 255u) * s8; v1[1] *= (float)((ay >> 8) & 255u) * s8; v1[2] *= (float)((ay >> 16) & 255u) * s8; v1[3] *= (float)(ay >> 24) * s8;
                        v4u w; w.x = pk2(v0[0], v0[1]); w.y = pk2(v0[2], v0[3]); w.z = pk2(v1[0], v1[1]); w.w = pk2(v1[2], v1[3]); *(v4u*)(merged + row * D + col0 + bj * 128) = w; } } }
            asm volatile("" ::: "memory");
        }
        return seg < 2;
    }
};
template <bool RB16> struct EpiResid { static constexpr bool PERM = true, INPLACE = false; const void* xres; bf16* z;
    __device__ __forceinline__ void operator()(const Acc& acc, const Unit& u, int wr, int wc, int fr, int fq) const {
        const int row0 = u.pm * 256 + wr * 64 + fr, col0 = u.pn * 256 + wc * 32 + 8 * fq;
#pragma unroll
        for (int ai = 0; ai < 2; ++ai) {
            f32x4 xr[4][2][2];
#pragma unroll
            for (int m = 0; m < 4; ++m) { const size_t off = (size_t)(row0 + ai * 128 + m * 16) * D + col0;
#pragma unroll
                for (int bj = 0; bj < 2; ++bj) {
                    if constexpr (RB16) { const v4u w = *(const v4u*)((const bf16*)xres + off + bj * 128);
                        xr[m][bj][0] = (f32x4){pg8::bf_lo(w.x), pg8::bf_hi(w.x), pg8::bf_lo(w.y), pg8::bf_hi(w.y)}; xr[m][bj][1] = (f32x4){pg8::bf_lo(w.z), pg8::bf_hi(w.z), pg8::bf_lo(w.w), pg8::bf_hi(w.w)}; }
                    else {
#pragma unroll
                        for (int n = 0; n < 2; ++n) xr[m][bj][n] = *(const f32x4*)((const float*)xres + off + bj * 128 + n * 4); } } }
            asm volatile("" ::: "memory");
#pragma unroll
            for (int m = 0; m < 4; ++m) { const size_t off = (size_t)(row0 + ai * 128 + m * 16) * D + col0;
#pragma unroll
                for (int bj = 0; bj < 2; ++bj) { const f32x4 v0 = xr[m][bj][0] * ALPHA + acc[ai][bj][m][0], v1 = xr[m][bj][1] * ALPHA + acc[ai][bj][m][1];
                    v4u w; w.x = pk2(v0[0], v0[1]); w.y = pk2(v0[2], v0[3]); w.z = pk2(v1[0], v1[1]); w.w = pk2(v1[2], v1[3]); *(v4u*)(z + off + bj * 128) = w; } }
            asm volatile("" ::: "memory");
        }
    }
};

constexpr int NWAVES = 8;
constexpr int RING_OFF = 0, RING_BYTES = 131072;
constexpr int SCR_BYTES = 147456;
constexpr int MISC_OFF = SCR_BYTES;
constexpr int LDS_BYTES = 163840;
constexpr int PH_CVT = 0, PH_L0 = 1, PH_PER_LAYER = 10;
constexpr int P_INPROJ = 0, P_MIX = 1, P_SCAN = 2, P_HOUT = 3, P_BRANCH = 4, P_WO = 5, P_ROUTE = 6, P_GU = 7, P_DOWN = 8, P_COMB = 9;
constexpr int N_PHASES = PH_L0 + 2 * PH_PER_LAYER;

constexpr int NCV = 64;
#define CV_UNITS 2
#define GM_UNITS 15
struct Frame { LAS unsigned char* lds; int tid, lane, wave, G, gw, NGW; };

__device__ __forceinline__ void xpose_item(const float* W, int N, int k0, int n0, bf16* WTrow0, int ldk, LAS float* scr, int lane) {
    const int kk = lane >> 3, nn = (lane & 7) * 4;
    f32x4 v[8];
#pragma unroll
    for (int i = 0; i < 8; ++i) v[i] = *(const f32x4*)(W + (size_t)(k0 + kk + 8 * i) * N + n0 + nn);
#pragma unroll
    for (int i = 0; i < 8; ++i) { LAS float* s = scr + (kk + 8 * i) * 33 + nn; s[0] = v[i][0]; s[1] = v[i][1]; s[2] = v[i][2]; s[3] = v[i][3]; }
    LDS_WAIT(); asm volatile("" ::: "memory");
    const int c = lane & 7;
#pragma unroll
    for (int j = 0; j < 4; ++j) { const int n = (lane >> 3) + 8 * j; const LAS float* s = scr + (8 * c) * 33 + n;
        v4u o; o.x = pk2(s[0 * 33], s[1 * 33]); o.y = pk2(s[2 * 33], s[3 * 33]); o.z = pk2(s[4 * 33], s[5 * 33]); o.w = pk2(s[6 * 33], s[7 * 33]);
        *(v4u*)(WTrow0 + (size_t)n * ldk + 8 * c) = o; }
    LDS_WAIT(); asm volatile("" ::: "memory");
}
__device__ __forceinline__ void xpose_matrix(const Frame& F, const float* W, int K, int N, bf16* WT, int ldk, int mode, unsigned& gbase) {
    const int nblk = N / 32, nitems = (K / 64) * nblk;
    LAS float* scr = (LAS float*)(F.lds + RING_OFF + F.wave * 8704);
    int it = (int)(((unsigned)F.gw + (unsigned)F.NGW - gbase % (unsigned)F.NGW) % (unsigned)F.NGW);
    for (; it < nitems; it += F.NGW) {
        const int kb = it / nblk, nb = it % nblk, n0 = nb * 32, k0 = kb * 64;
        const int drow = mode == 0 ? n0 : ((n0 >> 7) * 256 + (n0 & 127) + (mode == 2 ? 128 : 0));
        xpose_item(W, N, k0, n0, WT + (size_t)drow * ldk + k0, ldk, scr, F.lane);
    }
    gbase += (unsigned)nitems;
}
__device__ __forceinline__ void cvt_rows(const Frame& F, const float* in, bf16* out, size_t n8) {
    for (size_t i = (size_t)blockIdx.x * 512 + F.tid; i < n8; i += (size_t)F.G * 512) {
        const f32x4 a = *(const f32x4*)(in + i * 8), b = *(const f32x4*)(in + i * 8 + 4);
        v4u w; w.x = pk2(a[0], a[1]); w.y = pk2(a[2], a[3]); w.z = pk2(b[0], b[1]); w.w = pk2(b[2], b[3]);
        *(v4u*)(out + i * 8) = w; }
}
__device__ __forceinline__ void cvt_router(const Frame& F, const float* rw, unsigned char* ws) {
    for (int i = blockIdx.x * 512 + F.tid; i < 2 * D * NE; i += F.G * 512) { const int l = i / (D * NE), k = (i / NE) % D, e = i % NE;
        const float w = rw[i]; const bf16 h = f2bf(w); const bf16 lo = f2bf(w - bf2f(h));
        bf16* dst = (bf16*)(ws + WS_RW + l * RW_L); dst[(size_t)e * D + k] = h; dst[(size_t)(NE + e) * D + k] = lo; }
}
struct XItem { const float* src; bf16* dst; int N, ldk; };
__device__ __forceinline__ void xp_decode(int I, const float* wg, const float* wu, const float* wd, const float* sg, const float* su, const float* sd, unsigned char* ws, XItem& x) {
    const int e = I / 1536, rem = I % 1536, m = rem >> 9, it = rem & 511;
    if (m < 2) { const float* W = m == 0 ? (e < NE ? wg + (size_t)e * D * EH : sg) : (e < NE ? wu + (size_t)e * D * EH : su);
        const int kb = it >> 4, nb = it & 15, n0 = nb * 32, k0 = kb * 64; const int drow = (n0 >> 7) * 256 + (n0 & 127) + (m == 1 ? 128 : 0);
        x.src = W + (size_t)k0 * EH + n0; x.N = EH; x.ldk = D; x.dst = (bf16*)(ws + WS_WGU + (size_t)e * WGU_E) + (size_t)drow * D + k0; }
    else { const float* W = e < NE ? wd + (size_t)e * EH * D : sd; const int kb = it >> 6, nb = it & 63, n0 = nb * 32, k0 = kb * 64;
        x.src = W + (size_t)k0 * D + n0; x.N = D; x.ldk = EH; x.dst = (bf16*)(ws + WS_WDN + (size_t)e * WDN_E) + (size_t)n0 * EH + k0; }
}
__device__ __forceinline__ void xp_load(const XItem& x, int lane, f32x4 (&v)[8]) {
    const int kk = lane >> 3, nn = (lane & 7) * 4;
#pragma unroll
    for (int i = 0; i < 8; ++i) v[i] = __builtin_nontemporal_load((const f32x4*)(x.src + (size_t)(kk + 8 * i) * x.N + nn));
}
__device__ __forceinline__ void xp_store(const XItem& x, const f32x4 (&v)[8], LAS float* scr, int lane) {
    const int kk = lane >> 3, nn = (lane & 7) * 4;
#pragma unroll
    for (int i = 0; i < 8; ++i) { LAS float* s = scr + (kk + 8 * i) * 33 + nn; s[0] = v[i][0]; s[1] = v[i][1]; s[2] = v[i][2]; s[3] = v[i][3]; }
    LDS_WAIT(); asm volatile("" ::: "memory");
    const int c = lane & 7;
#pragma unroll
    for (int j = 0; j < 4; ++j) { const int n = (lane >> 3) + 8 * j; const LAS float* s = scr + (8 * c) * 33 + n;
        v4u o; o.x = pk2(s[0 * 33], s[1 * 33]); o.y = pk2(s[2 * 33], s[3 * 33]); o.z = pk2(s[4 * 33], s[5 * 33]); o.w = pk2(s[6 * 33], s[7 * 33]);
        __builtin_nontemporal_store(o, (v4u*)(x.dst + (size_t)n * x.ldk + 8 * c)); }
    LDS_WAIT(); asm volatile("" ::: "memory");
}
__device__ __forceinline__ void cvt_experts(const Frame& F, const float* wg, const float* wu, const float* wd, const float* sg, const float* su, const float* sd, unsigned char* ws, unsigned& gbase) {
    (void)gbase;
    LAS float* scr = (LAS float*)(F.lds + RING_OFF + F.wave * 8704);
    const int total = (NE + 1) * 1536;
    XItem A, B; f32x4 va[8], vb[8];
    int I = F.gw;
    if (I < total) { xp_decode(I, wg, wu, wd, sg, su, sd, ws, A); xp_load(A, F.lane, va); }
    for (; I < total; I += 2 * F.NGW) {
        const int I2 = I + F.NGW, I3 = I + 2 * F.NGW;
        if (I2 < total) { xp_decode(I2, wg, wu, wd, sg, su, sd, ws, B); xp_load(B, F.lane, vb); }
        xp_store(A, va, scr, F.lane);
        if (I2 < total) { if (I3 < total) { xp_decode(I3, wg, wu, wd, sg, su, sd, ws, A); xp_load(A, F.lane, va); }
            xp_store(B, vb, scr, F.lane); }
    }
}
constexpr int NVO_OFF = MISC_OFF + 1024;  static_assert(NVO_OFF == pg8::PG8_NVO_OFF, "nvo");
constexpr int PLAN_OFF = NVO_OFF + 8192;
constexpr int PLAN_TB = PLAN_OFF, PLAN_CN = PLAN_OFF + 66 * 4, PLAN_TE = PLAN_OFF + 132 * 4;
constexpr int MAXTILES = 640;
#ifndef ROUTE_PROBE
#define ROUTE_PROBE 0
#endif
static_assert(PLAN_TE + MAXTILES * 4 <= LDS_BYTES, "LDS map");

__device__ __forceinline__ float wave_sum(float v, int lane) {
#pragma unroll
    for (int o = 1; o < 64; o <<= 1) v += shx(v, o, lane);
    return v;
}
__device__ __forceinline__ void moe_plan(const Frame& F, const unsigned* cnt) {
    LAS unsigned* tb = (LAS unsigned*)(F.lds + PLAN_TB); LAS unsigned* cn = (LAS unsigned*)(F.lds + PLAN_CN); LAS unsigned* te = (LAS unsigned*)(F.lds + PLAN_TE);
    __syncthreads();
    if (F.tid <= NE) { unsigned run = 0; for (int e = 0; e < F.tid; ++e) run += (__hip_atomic_load(cnt + e, RLX_AGENT) + 255u) >> 8;
        tb[F.tid] = run; cn[F.tid] = F.tid < NE ? __hip_atomic_load(cnt + F.tid, RLX_AGENT) : (unsigned)NTOK; if (F.tid == NE) tb[NE + 1] = run + NTOK / 256; }
    __syncthreads();
    for (int t = F.tid; t < MAXTILES; t += NWAVES * 64) { unsigned e = 0; for (int q = 1; q <= NE; ++q) if (tb[q] <= (unsigned)t) e = q; te[t] = e; }
    __syncthreads();
}
template <bool GU> struct MoeSched { static constexpr bool GATHER = GU;
    const LAS unsigned* tb; const LAS unsigned* cn; const LAS unsigned* te; int nunits, nN, G, c; const char* Abase; const char* Bbase; const int* list;
    __device__ __forceinline__ void init(const Frame& F, const void* A_, const void* B_, const int* list_) {
        tb = (const LAS unsigned*)(F.lds + PLAN_TB); cn = (const LAS unsigned*)(F.lds + PLAN_CN); te = (const LAS unsigned*)(F.lds + PLAN_TE);
        nN = GU ? 4 : 8; nunits = (int)tb[NE + 1] * nN; G = F.G; const int bx = blockIdx.x; c = (G % 8 == 0) ? (bx % 8) * (G / 8) + bx / 8 : bx;
        Abase = (const char*)A_; Bbase = (const char*)B_; list = list_; }
    __device__ __forceinline__ bool next(int i, Unit& u) const {
        constexpr int RUN = GU ? 2 : 1; const int hs = c + G * (i / RUN), per = nN / RUN;
        const int tile = hs / per, pn = (hs % per) * RUN + (i % RUN); if (tile * nN >= nunits) return false;
        const int e = (int)te[tile];
        u.pm = tile; u.pn = pn;
        if (GU) { u.A = Abase; u.B = Bbase + (size_t)e * WGU_E + (size_t)pn * 256 * D * 2; u.list = e < NE ? list + (size_t)e * LISTCAP : nullptr; u.m0 = (tile - (int)tb[e]) * 256; u.cnt = (int)cn[e]; }
        else { u.A = Abase + (size_t)tile * 256 * EH * 2; u.B = Bbase + (size_t)e * WDN_E + (size_t)pn * 256 * EH * 2; u.list = nullptr; u.m0 = 0; u.cnt = 0; }
        return true; }
    __device__ __forceinline__ int avload(const Unit& u, int h, int R) const { const int pos = u.m0 + h * 128 + R; const int pc = pos < u.cnt ? pos : (u.cnt > 0 ? u.cnt - 1 : 0); const int* lp = u.list ? u.list : list; return lp[pc]; }
    __device__ __forceinline__ unsigned avfin(const Unit& u, int h, int R, int C, int K_, int v) const { const int pos = u.m0 + h * 128 + R; int row = u.list ? v : pos; row = pos < u.cnt ? row : 0; return (unsigned)((row * K_ + C) * 2); }
    __device__ __forceinline__ unsigned avoff(const Unit& u, int h, int R, int C, int K_) const {
        if (GU) return avfin(u, h, R, C, K_, avload(u, h, R));
        else return (unsigned)(((h * 128 + R) * K_ + C) * 2); }
};
struct EpiSwiGLU { static constexpr bool PERM = true, INPLACE = false; bf16* H;
    __device__ __forceinline__ void operator()(const Acc& acc, const Unit& u, int wr, int wc, int fr, int fq) const {
        const int row0 = u.pm * 256 + wr * 64 + fr, col0 = u.pn * 128 + wc * 32 + 8 * fq;
#pragma unroll
        for (int ai = 0; ai < 2; ++ai)
#pragma unroll
            for (int m = 0; m < 4; ++m) { bf16* rowp = H + (size_t)(row0 + ai * 128 + m * 16) * EH + col0;
                float hv[8];
#pragma unroll
                for (int n = 0; n < 2; ++n)
#pragma unroll
                    for (int j = 0; j < 4; ++j) { const float g = acc[ai][0][m][n][j], uu = acc[ai][1][m][n][j]; hv[n * 4 + j] = g * pg8::sigmoidf_(g) * uu; }
                v4u w; w.x = pk2(hv[0], hv[1]); w.y = pk2(hv[2], hv[3]); w.z = pk2(hv[4], hv[5]); w.w = pk2(hv[6], hv[7]);
                *(v4u*)rowp = w; }
    }
};

struct EpiY8 { static constexpr bool PERM = true, INPLACE = false; unsigned char* Y8; bf16* YS;
    __device__ __forceinline__ void operator()(const Acc& acc, const Unit& u, int wr, int wc, int fr, int fq) const {
        const int row0 = u.pm * 256 + wr * 64 + fr, pos0 = u.pn * 256 + wc * 64 + fq * 16;
#pragma unroll
        for (int ai = 0; ai < 2; ++ai)
#pragma unroll
            for (int m = 0; m < 4; ++m) { const size_t row = (size_t)(row0 + ai * 128 + m * 16);
                v4u w; unsigned sw = 0u;
#pragma unroll
                for (int bj = 0; bj < 2; ++bj) { const f32x4 v0 = acc[ai][bj][m][0], v1 = acc[ai][bj][m][1];
                    const float am = fmaxf(fmaxf(fmaxf(fabsf(v0[0]), fabsf(v0[1])), fmaxf(fabsf(v0[2]), fabsf(v0[3]))), fmaxf(fmaxf(fabsf(v1[0]), fabsf(v1[1])), fmaxf(fabsf(v1[2]), fabsf(v1[3]))));
                    const unsigned sb = f2bf(am * (1.f / 127.f)); const float sc = __uint_as_float(sb << 16); const float inv = sc > 0.f ? __builtin_amdgcn_rcpf(sc) : 0.f;
                    unsigned q[8];
#pragma unroll
                    for (int j = 0; j < 4; ++j) { q[j] = (unsigned)fminf(rintf(v0[j] * inv + 128.f), 255.f); q[4 + j] = (unsigned)fminf(rintf(v1[j] * inv + 128.f), 255.f); }
                    const unsigned lo = q[0] | (q[1] << 8) | (q[2] << 16) | (q[3] << 24), hi = q[4] | (q[5] << 8) | (q[6] << 16) | (q[7] << 24);
                    if (bj == 0) { w.x = lo; w.y = hi; sw = sb; } else { w.z = lo; w.w = hi; sw |= sb << 16; } }
                *(v4u*)(Y8 + row * D + pos0) = w; *(unsigned*)(YS + row * (D / 8) + (pos0 >> 3)) = sw; }
    }
};
__device__ __forceinline__ void route_phase(const Frame& F, const bf16* __restrict__ Z, const float* __restrict__ g, const float* __restrict__ bb, const bf16* __restrict__ rwh, const float* __restrict__ rb,
                                            bf16* __restrict__ X1L, bf16* __restrict__ X1BF, unsigned* cnt, int* list, int* tokslot, float* tokw, bool dispatch = true) {
    LAS float* part = (LAS float*)(F.lds + RING_OFF);
    LAS float* lg = part + 4 * 4096;
    LAS float* sl = lg + 64 * 65;
    LAS unsigned* cntL = (LAS unsigned*)(sl + 64 * 65);
    LAS unsigned* baseL = cntL + 64;
    LAS unsigned* ee = baseL + 64;
    LAS unsigned* pl = ee + 512;
    LAS float* ww = (LAS float*)(pl + 512);
    for (int grp = blockIdx.x; grp < NTOK / 64; grp += F.G) {
        const int t0 = grp * 64;
        if (F.tid < 64) cntL[F.tid] = 0u;
        for (int rp_ = 0; rp_ < (ROUTE_PROBE == 1 ? 2 : 1); ++rp_)
#pragma unroll 2
        for (int q = 0; q < 8; ++q) {
            const int t = t0 + F.wave * 8 + q;
            const v2u* zr = (const v2u*)(Z + (size_t)t * D) + F.lane;
            f32x4 v[8]; float s = 0.f;
#pragma unroll
            for (int j = 0; j < 8; ++j) { const v2u zw = zr[64 * j]; v[j] = (f32x4){pg8::bf_lo(zw.x), pg8::bf_hi(zw.x), pg8::bf_lo(zw.y), pg8::bf_hi(zw.y)}; s += (v[j][0] + v[j][1]) + (v[j][2] + v[j][3]); }
            const float mean = wave_sum(s, F.lane) * (1.f / D); float s2 = 0.f;
#pragma unroll
            for (int j = 0; j < 8; ++j) { v[j] = v[j] - mean; s2 += (v[j][0] * v[j][0] + v[j][1] * v[j][1]) + (v[j][2] * v[j][2] + v[j][3] * v[j][3]); }
            const float rstd = 1.f / sqrtf(wave_sum(s2, F.lane) * (1.f / D) + LN_EPS);
            v2u* xl = (v2u*)(X1L + (size_t)t * D) + F.lane; v2u* xb = (v2u*)(X1BF + (size_t)t * D) + F.lane;
#pragma unroll
            for (int j = 0; j < 8; ++j) { const f32x4 gg = ((const f32x4*)g)[F.lane + 64 * j], bv = ((const f32x4*)bb)[F.lane + 64 * j];
                const f32x4 y = v[j] * rstd * gg + bv; v2u w; w.x = pk2(y[0], y[1]); w.y = pk2(y[2], y[3]); xb[64 * j] = w;
                v2u lo; lo.x = pk2(y[0] - pg8::bf_lo(w.x), y[1] - pg8::bf_hi(w.x)); lo.y = pk2(y[2] - pg8::bf_lo(w.y), y[3] - pg8::bf_hi(w.y)); xl[64 * j] = lo; }
        }
        VM_WAIT(); __syncthreads();
        for (int rp_ = 0; rp_ < (ROUTE_PROBE == 2 ? 2 : 1); ++rp_)
        { const int r = F.lane & 15, kq = F.lane >> 4, kb = (F.wave & 3) * 512, th = F.wave >> 2;
          const bf16* xh = X1BF + (size_t)(t0 + th * 32 + r) * D + kb + 8 * kq;
          const bf16* xl = X1L + (size_t)(t0 + th * 32 + r) * D + kb + 8 * kq;
          const bf16* wh = rwh + (size_t)r * D + kb + 8 * kq;
          f32x4 acc[2][4];
#pragma unroll
          for (int tt = 0; tt < 2; ++tt)
#pragma unroll
              for (int nb = 0; nb < 4; ++nb) acc[tt][nb] = (f32x4){0.f, 0.f, 0.f, 0.f};
          bf16x8 xA[2][2], xB[2][2]; bf16x8 hA[4], lA[4], hB[4], lB[4];
#define RT_LOAD(X, H, L, ks) do { const int k_ = ((ks) < 16 ? (ks) : 15) * 32; _Pragma("unroll") for (int tt = 0; tt < 2; ++tt) { X[tt][0] = *(const bf16x8*)(xh + (size_t)tt * 16 * D + k_); X[tt][1] = *(const bf16x8*)(xl + (size_t)tt * 16 * D + k_); } \
              _Pragma("unroll") for (int nb = 0; nb < 4; ++nb) { H[nb] = *(const bf16x8*)(wh + (size_t)nb * 16 * D + k_); L[nb] = *(const bf16x8*)(wh + (size_t)(64 + nb * 16) * D + k_); } } while (0)
#define RT_MMA(X, H, L) do { \
              _Pragma("unroll") for (int tt = 0; tt < 2; ++tt) _Pragma("unroll") for (int nb = 0; nb < 4; ++nb) acc[tt][nb] = __builtin_amdgcn_mfma_f32_16x16x32_bf16(X[tt][1], H[nb], acc[tt][nb], 0, 0, 0); \
              _Pragma("unroll") for (int tt = 0; tt < 2; ++tt) _Pragma("unroll") for (int nb = 0; nb < 4; ++nb) acc[tt][nb] = __builtin_amdgcn_mfma_f32_16x16x32_bf16(X[tt][0], L[nb], acc[tt][nb], 0, 0, 0); \
              _Pragma("unroll") for (int tt = 0; tt < 2; ++tt) _Pragma("unroll") for (int nb = 0; nb < 4; ++nb) acc[tt][nb] = __builtin_amdgcn_mfma_f32_16x16x32_bf16(X[tt][0], H[nb], acc[tt][nb], 0, 0, 0); } while (0)
          RT_LOAD(xA, hA, lA, 0);
#pragma unroll 1
          for (int ks = 0; ks < 16; ks += 2) {
              RT_LOAD(xB, hB, lB, ks + 1); RT_MMA(xA, hA, lA);
              RT_LOAD(xA, hA, lA, ks + 2); RT_MMA(xB, hB, lB);
          }
#undef RT_LOAD
#undef RT_MMA
#pragma unroll
          for (int tt = 0; tt < 2; ++tt)
#pragma unroll
              for (int nb = 0; nb < 4; ++nb)
#pragma unroll
                  for (int reg = 0; reg < 4; ++reg) part[(F.wave & 3) * 4096 + (th * 32 + tt * 16 + 4 * kq + reg) * 64 + nb * 16 + r] = acc[tt][nb][reg];
        }
        __syncthreads();
        for (int i = F.tid; i < 64 * 64; i += NWAVES * 64) { const int tk = i >> 6, e = i & 63; const float lgt = (part[i] + part[4096 + i]) + (part[8192 + i] + part[12288 + i]);
            const float sc = 1.f / (1.f + __expf(-lgt)); lg[tk * 65 + e] = sc; sl[tk * 65 + e] = sc + rb[e]; }
        __syncthreads();
        for (int rp_ = 0; rp_ < (ROUTE_PROBE == 3 ? 2 : 1); ++rp_)
        { const bool lastrp = (rp_ == (ROUTE_PROBE == 3 ? 1 : 0));
          const int tk = F.wave * 8 + (F.lane >> 3), gq = F.lane & 7, lane = F.lane;
          float sv[8], cv[8];
#pragma unroll
          for (int j = 0; j < 8; ++j) { sv[j] = sl[tk * 65 + gq * 8 + j]; cv[j] = lg[tk * 65 + gq * 8 + j]; }
          float m1 = -INFINITY, m2 = -INFINITY;
#pragma unroll
          for (int j = 0; j < 8; ++j) { const float x = sv[j]; const bool g1 = x > m1; m2 = g1 ? m1 : fmaxf(m2, x); m1 = g1 ? x : m1; }
          const float gs = m1 + m2;
          int rank = 0;
#pragma unroll
          for (int o = 1; o < 8; ++o) { const float og = shx(gs, o, lane); const int oq = gq ^ o; rank += (og > gs || (og == gs && oq < gq)) ? 1 : 0; }
          const bool gsel = rank < 4;
          unsigned used = gsel ? 0u : 0xffu;
          float wsum = 0.f; float my_sc = 0.f; int my_e = 0;
#pragma unroll
          for (int i = 0; i < 8; ++i) {
              float bv = -INFINITY, bs = 0.f; int be = 64;
#pragma unroll
              for (int j = 0; j < 8; ++j) { const bool ok = !((used >> j) & 1u) && sv[j] > bv; bv = ok ? sv[j] : bv; bs = ok ? cv[j] : bs; be = ok ? gq * 8 + j : be; }
#pragma unroll
              for (int o = 1; o < 8; o <<= 1) { const float ov = shx(bv, o, lane), os = shx(bs, o, lane); const int oe = __float_as_int(shx(__int_as_float(be), o, lane));
                  const bool tk_o = ov > bv || (ov == bv && oe < be); bv = tk_o ? ov : bv; bs = tk_o ? os : bs; be = tk_o ? oe : be; }
              if ((be >> 3) == gq) used |= 1u << (be & 7);
              wsum += bs; if (gq == i) { my_sc = bs; my_e = be; }
          }
          const int slot = tk * 8 + gq;
          ee[slot] = (unsigned)my_e; ww[slot] = my_sc * (RSCALE / wsum);
          pl[slot] = __hip_atomic_fetch_add(cntL + my_e, (dispatch && lastrp) ? 1u : 0u, __ATOMIC_RELAXED, __HIP_MEMORY_SCOPE_WORKGROUP);
        }
        __syncthreads();
        if (F.tid < 64) { const unsigned n = cntL[F.tid]; baseL[F.tid] = n ? __hip_atomic_fetch_add(cnt + F.tid, n, RLX_AGENT) : 0u; }
        __syncthreads();
        if (dispatch) { const int tk = F.tid >> 3, i = F.tid & 7; const unsigned e = ee[F.tid]; const unsigned pos = baseL[e] + pl[F.tid]; const int t = t0 + tk;
          list[(size_t)e * LISTCAP + pos] = t; tokslot[t * 8 + i] = (int)(e * LISTCAP + pos); tokw[t * 8 + i] = ww[F.tid]; }
        __syncthreads();
    }
}
__device__ __forceinline__ void combine_phase(const Frame& F, const bf16* X1B, const unsigned char* Y8, const bf16* YS, const int* tokslot, const float* tokw, const float* g, const float* bb, float* OUT, bf16* XBF, bool last) {
    const LAS unsigned* tb = (const LAS unsigned*)(F.lds + PLAN_TB);
    LAS int* rw = (LAS int*)(F.lds + RING_OFF) + F.wave * 32;
#define CB_LOAD(W, S, ROW) do { const int r_ = __builtin_amdgcn_readfirstlane(ROW); const v2u* yr_ = (const v2u*)(Y8 + (size_t)r_ * D) + F.lane; const bf16* ys_ = YS + (size_t)r_ * (D / 8) + F.lane; \
        _Pragma("unroll") for (int j = 0; j < 4; ++j) { W[j] = yr_[64 * j]; S[j] = ys_[64 * j]; } } while (0)
#define CB_ACC(W, S, WT) do { const float wt_ = __int_as_float(__builtin_amdgcn_readfirstlane(WT)); _Pragma("unroll") for (int j = 0; j < 4; ++j) { const float sc = bf2f(S[j]) * wt_, c0 = -128.f * sc; const unsigned x = W[j].x, y = W[j].y; \
        v[j][0] += sc * (float)(x & 255u) + c0; v[j][1] += sc * (float)((x >> 8) & 255u) + c0; v[j][2] += sc * (float)((x >> 16) & 255u) + c0; v[j][3] += sc * (float)(x >> 24) + c0; \
        v[j][4] += sc * (float)(y & 255u) + c0; v[j][5] += sc * (float)((y >> 8) & 255u) + c0; v[j][6] += sc * (float)((y >> 16) & 255u) + c0; v[j][7] += sc * (float)(y >> 24) + c0; } } while (0)
    const int cl = (F.lane >> 5) * 256 + (F.lane & 1) * 128 + ((F.lane >> 3) & 3) * 32 + ((F.lane >> 1) & 3) * 8;
    for (int t = F.gw; t < NTOK; t += F.NGW) {
        if (F.lane < 8) { const int sl = tokslot[t * 8 + F.lane]; rw[F.lane] = (int)tb[sl / LISTCAP] * 256 + (sl % LISTCAP); rw[16 + F.lane] = __float_as_int(tokw[t * 8 + F.lane]); }
        if (F.lane == 8) { rw[8] = (int)tb[NE] * 256 + t; rw[24] = __float_as_int(1.f); }
        LDS_WAIT(); asm volatile("" ::: "memory");
        float v[4][8]; float s = 0.f;
        v2u wa[4], wb[4], wc[4]; bf16 sa[4], sb2[4], sc2[4];
        CB_LOAD(wa, sa, rw[0]); CB_LOAD(wb, sb2, rw[1]); CB_LOAD(wc, sc2, rw[2]);
#pragma unroll
        for (int j = 0; j < 4; ++j) { const v4u xw = *(const v4u*)(X1B + (size_t)t * D + 512 * j + cl);
            v[j][0] = pg8::bf_lo(xw.x) * ALPHA; v[j][1] = pg8::bf_hi(xw.x) * ALPHA; v[j][2] = pg8::bf_lo(xw.y) * ALPHA; v[j][3] = pg8::bf_hi(xw.y) * ALPHA;
            v[j][4] = pg8::bf_lo(xw.z) * ALPHA; v[j][5] = pg8::bf_hi(xw.z) * ALPHA; v[j][6] = pg8::bf_lo(xw.w) * ALPHA; v[j][7] = pg8::bf_hi(xw.w) * ALPHA; }
#pragma unroll 1
        for (int i = 0; i < 9; i += 3) {
            CB_ACC(wa, sa, rw[16 + i]); if (i < 6) CB_LOAD(wa, sa, rw[i + 3]);
            CB_ACC(wb, sb2, rw[17 + i]); if (i < 6) CB_LOAD(wb, sb2, rw[i + 4]);
            CB_ACC(wc, sc2, rw[18 + i]); if (i < 6) CB_LOAD(wc, sc2, rw[i + 5]);
        }
        asm volatile("" ::: "memory");
#pragma unroll
        for (int j = 0; j < 4; ++j)
#pragma unroll
            for (int e = 0; e < 8; ++e) s += v[j][e];
        const float mean = wave_sum(s, F.lane) * (1.f / D); float s2 = 0.f;
#pragma unroll
        for (int j = 0; j < 4; ++j)
#pragma unroll
            for (int e = 0; e < 8; ++e) { v[j][e] -= mean; s2 += v[j][e] * v[j][e]; }
        const float rstd = 1.f / sqrtf(wave_sum(s2, F.lane) * (1.f / D) + LN_EPS);
#pragma unroll
        for (int j = 0; j < 4; ++j) { const int c0 = cl + 512 * j; const f32x4 g0 = *(const f32x4*)(g + c0), g1 = *(const f32x4*)(g + c0 + 4), b0 = *(const f32x4*)(bb + c0), b1 = *(const f32x4*)(bb + c0 + 4);
            f32x4 y0, y1;
#pragma unroll
            for (int e = 0; e < 4; ++e) { y0[e] = v[j][e] * rstd * g0[e] + b0[e]; y1[e] = v[j][4 + e] * rstd * g1[e] + b1[e]; }
            if (last) { *(f32x4*)(OUT + (size_t)t * D + c0) = y0; *(f32x4*)(OUT + (size_t)t * D + c0 + 4) = y1; }
            else { v4u w; w.x = pk2(y0[0], y0[1]); w.y = pk2(y0[2], y0[3]); w.z = pk2(y1[0], y1[1]); w.w = pk2(y1[2], y1[3]); *(v4u*)(XBF + (size_t)t * D + c0) = w; } }
    }
#undef CB_LOAD
#undef CB_ACC
}
constexpr size_t R2_UT = 0, R2_OI = 48 * MiB, R2_QP = 96 * MiB, R2_DEC = 120 * MiB;
constexpr int NHU = NB * HGH * (SEQ / 64);
typedef __attribute__((address_space(3))) bf16 lbf16;
__device__ __forceinline__ void unpack8(const v4u w, float (&f)[8]) {
    f[0] = pg8::bf_lo(w.x); f[1] = pg8::bf_hi(w.x); f[2] = pg8::bf_lo(w.y); f[3] = pg8::bf_hi(w.y); f[4] = pg8::bf_lo(w.z); f[5] = pg8::bf_hi(w.z); f[6] = pg8::bf_lo(w.w); f[7] = pg8::bf_hi(w.w); }
__device__ __forceinline__ float exp_c(float x) { return __expf(fminf(x, 80.f)); }

__device__ __forceinline__ void conv_part(const Frame& F, const bf16* proj, const float* cw, bf16* YA, bf16* YX) {
    for (int i = blockIdx.x * 512 + F.tid; i < NTOK * 32; i += F.G * 512) *(v4u*)(YX + (size_t)(i >> 5) * YXW + XAW + (i & 31) * 8) = (v4u){0u, 0u, 0u, 0u};
    for (int i = blockIdx.x * 512 + F.tid; i < NTOK * (CW / 8); i += F.G * 512) {
        const int t = i / (CW / 8), c = (i % (CW / 8)) * 8, pos = t & (SEQ - 1);
        const bf16* r = proj + (size_t)t * INC;
        float u0[8], c0[8], b0[8], u1[8], c1[8], u2[8], c2[8], w0[8], w1[8], w2[8];
        unpack8(*(const v4u*)(r + C_U + c), u0); unpack8(*(const v4u*)(r + C_C + c), c0); unpack8(*(const v4u*)(r + C_B + c), b0);
        const v4u z4 = {0u, 0u, 0u, 0u};
        unpack8(pos >= 1 ? *(const v4u*)(r - INC + C_U + c) : z4, u1); unpack8(pos >= 1 ? *(const v4u*)(r - INC + C_C + c) : z4, c1);
        unpack8(pos >= 2 ? *(const v4u*)(r - 2 * INC + C_U + c) : z4, u2); unpack8(pos >= 2 ? *(const v4u*)(r - 2 * INC + C_C + c) : z4, c2);
#pragma unroll
        for (int j = 0; j < 8; ++j) { w0[j] = cw[c + j]; w1[j] = cw[CW + c + j]; w2[j] = cw[2 * CW + c + j]; }
        float o[8];
#pragma unroll
        for (int j = 0; j < 8; ++j) o[j] = b0[j] * (w2[j] * c0[j] * u0[j] + w1[j] * c1[j] * u1[j] + w0[j] * c2[j] * u2[j]);
        v4u w; w.x = pk2(o[0], o[1]); w.y = pk2(o[2], o[3]); w.z = pk2(o[4], o[5]); w.w = pk2(o[6], o[7]);
        *(v4u*)(YA + (size_t)t * CW + c) = w;
    }
}

__device__ __forceinline__ void hgrn_local(const Frame& F, const bf16* proj, const float* lbl, int layer, unsigned char* r2) {
    lbf16* QS = (lbf16*)(F.lds);
    lbf16* KS = QS + 64 * 136;
    lbf16* KPT = KS + 64 * 136;
    lbf16* VT = KPT + 128 * 72;
    lbf16* PS = VT + 128 * 72;
    LAS float* SEG = (LAS float*)(PS + 64 * 72);
    bf16* UT = (bf16*)(r2 + R2_UT); bf16* OI = (bf16*)(r2 + R2_OI); bf16* QP = (bf16*)(r2 + R2_QP); float* DEC = (float*)(r2 + R2_DEC);
    const int lane = F.lane, wv = F.wave, r = lane & 15, kq = lane >> 4;
    bf16 rf[16], rq[16], rv[16];
#define HL_LOAD(U) do { const int b_ = (U) / (HGH * 64), h_ = ((U) / 64) % HGH, c_ = (U) % 64; const bf16* p_ = proj + (size_t)(b_ * SEQ + c_ * 64 + (F.tid >> 7) * 16) * INC + h_ * HGD + (F.tid & 127); \
        _Pragma("unroll") for (int i = 0; i < 16; ++i) { rf[i] = p_[(size_t)i * INC + C_F]; rq[i] = p_[(size_t)i * INC + C_Q]; rv[i] = p_[(size_t)i * INC + C_I]; } } while (0)
    if ((int)blockIdx.x < NHU) HL_LOAD((int)blockIdx.x);
    for (int unit = blockIdx.x; unit < NHU; unit += F.G) {
        const int b = unit / (HGH * 64), h = (unit / 64) % HGH, c = unit % 64, t0 = b * SEQ + c * 64;
        { const int col = F.tid & 127, seg = F.tid >> 7, ch = h * HGD + col;
          float lb = 0.f; if (layer == 1) lb = 1.f / (1.f + __expf(lbl[ch] - lbl[HGW + ch]));
          float a[16], kk[16], qv[16], vv[16]; float run = 0.f;
#pragma unroll
          for (int i = 0; i < 16; ++i) {
              const float z = bf2f(rf[i]); const float ez = __expf(-z); const float sg = 1.f / (1.f + ez);
              const float f = lb + (1.f - lb) * sg; kk[i] = (1.f - lb) * ez * sg; run += fmaxf(__logf(f), -60.f); a[i] = run;
              qv[i] = bf2f(rq[i]); vv[i] = bf2f(rv[i]); }
          if (unit + F.G < NHU) HL_LOAD(unit + F.G);
          SEG[seg * 128 + col] = run;
          __syncthreads();
          const float s0 = SEG[col], s1 = SEG[128 + col], s2 = SEG[256 + col], s3 = SEG[384 + col];
          const float base = seg == 0 ? 0.f : (seg == 1 ? s0 : (seg == 2 ? s0 + s1 : s0 + s1 + s2)), bm = s0 + s1, bl = (s0 + s1) + (s2 + s3);
          float kp[16];
#pragma unroll
          for (int i = 0; i < 16; ++i) { const float bb = base + a[i]; const int t = seg * 16 + i;
              QS[t * 136 + col] = f2bf(qv[i] * exp_c(bb - bm)); KS[t * 136 + col] = f2bf(kk[i] * exp_c(bm - bb)); kp[i] = kk[i] * exp_c(bl - bb);
              QP[(size_t)(t0 + t) * HGW + ch] = f2bf(qv[i] * exp_c(bb)); }
          v4u w0, w1; w0.x = pk2(kp[0], kp[1]); w0.y = pk2(kp[2], kp[3]); w0.z = pk2(kp[4], kp[5]); w0.w = pk2(kp[6], kp[7]); w1.x = pk2(kp[8], kp[9]); w1.y = pk2(kp[10], kp[11]); w1.z = pk2(kp[12], kp[13]); w1.w = pk2(kp[14], kp[15]);
          *(LAS v4u*)(KPT + col * 72 + seg * 16) = w0; *(LAS v4u*)(KPT + col * 72 + seg * 16 + 8) = w1;
          w0.x = pk2(vv[0], vv[1]); w0.y = pk2(vv[2], vv[3]); w0.z = pk2(vv[4], vv[5]); w0.w = pk2(vv[6], vv[7]); w1.x = pk2(vv[8], vv[9]); w1.y = pk2(vv[10], vv[11]); w1.z = pk2(vv[12], vv[13]); w1.w = pk2(vv[14], vv[15]);
          *(LAS v4u*)(VT + col * 72 + seg * 16) = w0; *(LAS v4u*)(VT + col * 72 + seg * 16 + 8) = w1;
          if (seg == 0) DEC[(size_t)unit * 128 + col] = exp_c(bl);
        }
        __syncthreads();
        { const int tm = wv >> 1, tn0 = (wv & 1) * 2;
          bf16x8 af[4];
#pragma unroll
          for (int ks = 0; ks < 4; ++ks) af[ks] = *(const LAS bf16x8*)(QS + (tm * 16 + r) * 136 + ks * 32 + kq * 8);
#pragma unroll
          for (int jn = 0; jn < 2; ++jn) { const int tn = tn0 + jn; f32x4 acc = {0.f, 0.f, 0.f, 0.f};
              if (tn <= tm) {
#pragma unroll
                  for (int ks = 0; ks < 4; ++ks) { const bf16x8 bf = *(const LAS bf16x8*)(KS + (tn * 16 + r) * 136 + ks * 32 + kq * 8); acc = __builtin_amdgcn_mfma_f32_16x16x32_bf16(af[ks], bf, acc, 0, 0, 0); } }
#pragma unroll
              for (int g = 0; g < 4; ++g) { const int t = tm * 16 + 4 * kq + g, s = tn * 16 + r; PS[t * 72 + s] = f2bf(s <= t ? acc[g] : 0.f); } } }
        { bf16x8 af[2];
#pragma unroll
          for (int ks = 0; ks < 2; ++ks) af[ks] = *(const LAS bf16x8*)(KPT + (wv * 16 + r) * 72 + ks * 32 + kq * 8);
#pragma unroll
          for (int tv = 0; tv < 8; ++tv) { f32x4 acc = {0.f, 0.f, 0.f, 0.f};
#pragma unroll
              for (int ks = 0; ks < 2; ++ks) { const bf16x8 bf = *(const LAS bf16x8*)(VT + (tv * 16 + r) * 72 + ks * 32 + kq * 8); acc = __builtin_amdgcn_mfma_f32_16x16x32_bf16(af[ks], bf, acc, 0, 0, 0); }
              v2u w; w.x = pk2(acc[0], acc[1]); w.y = pk2(acc[2], acc[3]);
              *(v2u*)(UT + (size_t)unit * 16384 + (tv * 16 + r) * 128 + wv * 16 + 4 * kq) = w; } }
        __syncthreads();
        { const int tm = wv & 3, tvg = wv >> 2;
          bf16x8 pf[2];
#pragma unroll
          for (int ks = 0; ks < 2; ++ks) pf[ks] = *(const LAS bf16x8*)(PS + (tm * 16 + r) * 72 + ks * 32 + kq * 8);
#pragma unroll
          for (int j = 0; j < 4; ++j) { const int tv = tvg * 4 + j; f32x4 acc = {0.f, 0.f, 0.f, 0.f};
#pragma unroll
              for (int ks = 0; ks < 2; ++ks) { const bf16x8 vf = *(const LAS bf16x8*)(VT + (tv * 16 + r) * 72 + ks * 32 + kq * 8); acc = __builtin_amdgcn_mfma_f32_16x16x32_bf16(vf, pf[ks], acc, 0, 0, 0); }
              v2u ow; ow.x = pk2(acc[0], acc[1]); ow.y = pk2(acc[2], acc[3]); *(v2u*)(OI + (size_t)(t0 + tm * 16 + r) * HGW + h * HGD + tv * 16 + 4 * kq) = ow; } }
        __syncthreads();
    }
#undef HL_LOAD
}
__device__ __forceinline__ void hgrn_scan(const Frame& F, const unsigned char* r2, v2u* __restrict__ SB64) {
    const v2u* __restrict__ UT64 = (const v2u*)(r2 + R2_UT); const f32x4* __restrict__ DEC4 = (const f32x4*)(r2 + R2_DEC);
    for (int it = blockIdx.x * 512 + F.tid; it < NB * HGH * 128 * 32; it += F.G * 512) {
        const int bh = it >> 12, v = (it >> 5) & 127, k4 = it & 31;
        f32x4 s = {0.f, 0.f, 0.f, 0.f};
#pragma unroll 8
        for (int c = 0; c < 64; ++c) { const size_t unit = (size_t)bh * 64 + c; const size_t idx = unit * 4096 + v * 32 + k4;
            const v2u w = UT64[idx]; const f32x4 d = DEC4[unit * 32 + k4];
            v2u o; o.x = pk2(s[0], s[1]); o.y = pk2(s[2], s[3]); SB64[idx] = o;
            s[0] = d[0] * s[0] + pg8::bf_lo(w.x); s[1] = d[1] * s[1] + pg8::bf_hi(w.x); s[2] = d[2] * s[2] + pg8::bf_lo(w.y); s[3] = d[3] * s[3] + pg8::bf_hi(w.y); }
    }
}
struct HoutOps { bf16x8 af[4]; bf16x8 bfr[4][4]; };
__device__ __forceinline__ void hout_load(HoutOps& O, int unit, const bf16* proj, const bf16* OI, const bf16* QP, const bf16* SB, int r, int kq, int tm, int tvg) {
    const int b = unit / (HGH * 64), h = (unit / 64) % HGH, c = unit % 64, t0 = b * SEQ + c * 64;
#pragma unroll
    for (int ks = 0; ks < 4; ++ks) O.af[ks] = *(const bf16x8*)(QP + (size_t)(t0 + tm * 16 + r) * HGW + h * HGD + ks * 32 + kq * 8);
#pragma unroll
    for (int j = 0; j < 4; ++j)
#pragma unroll
        for (int ks = 0; ks < 4; ++ks) O.bfr[j][ks] = *(const bf16x8*)(SB + (size_t)unit * 16384 + ((tvg * 4 + j) * 16 + r) * 128 + ks * 32 + kq * 8);
}
__device__ __forceinline__ void hout_compute(const HoutOps& O, int unit, const bf16* proj, const bf16* OI, LAS float* SSQ, const float* gain, bf16* YB, int lane, int r, int kq, int tm, int tvg) {
    const int b = unit / (HGH * 64), h = (unit / 64) % HGH, c = unit % 64, t0 = b * SEQ + c * 64;
    const size_t t = (size_t)(t0 + tm * 16 + r);
    f32x4 oi[4]; v2u gtw[4];
#pragma unroll
    for (int j = 0; j < 4; ++j) { const int ch = h * HGD + (tvg * 4 + j) * 16 + 4 * kq; { const v2u ow = *(const v2u*)(OI + t * HGW + ch); oi[j] = (f32x4){pg8::bf_lo(ow.x), pg8::bf_hi(ow.x), pg8::bf_lo(ow.y), pg8::bf_hi(ow.y)}; } gtw[j] = *(const v2u*)(proj + t * INC + C_G + ch); }
    f32x4 acc[4]; float q = 0.f;
#pragma unroll
    for (int j = 0; j < 4; ++j) { acc[j] = (f32x4){0.f, 0.f, 0.f, 0.f};
#pragma unroll
        for (int ks = 0; ks < 4; ++ks) acc[j] = __builtin_amdgcn_mfma_f32_16x16x32_bf16(O.bfr[j][ks], O.af[ks], acc[j], 0, 0, 0); }
#pragma unroll
    for (int j = 0; j < 4; ++j) { acc[j] += oi[j]; q += (acc[j][0] * acc[j][0] + acc[j][1] * acc[j][1]) + (acc[j][2] * acc[j][2] + acc[j][3] * acc[j][3]); }
    q += shx(q, 16, lane); q += shx(q, 32, lane);
    if (kq == 0) SSQ[tvg * 64 + tm * 16 + r] = q;
    __syncthreads();
    const float rs = rsqrtf((SSQ[tm * 16 + r] + SSQ[64 + tm * 16 + r]) * (1.f / 128.f) + RMS_EPS);
#pragma unroll
    for (int j = 0; j < 4; ++j) { const int ch = h * HGD + (tvg * 4 + j) * 16 + 4 * kq; const f32x4 gn = *(const f32x4*)(gain + ch);
        const float g0 = pg8::bf_lo(gtw[j].x), g1 = pg8::bf_hi(gtw[j].x), g2 = pg8::bf_lo(gtw[j].y), g3 = pg8::bf_hi(gtw[j].y);
        v2u w; w.x = pk2(acc[j][0] * rs * gn[0] * g0 * pg8::sigmoidf_(g0), acc[j][1] * rs * gn[1] * g1 * pg8::sigmoidf_(g1));
        w.y = pk2(acc[j][2] * rs * gn[2] * g2 * pg8::sigmoidf_(g2), acc[j][3] * rs * gn[3] * g3 * pg8::sigmoidf_(g3));
        *(v2u*)(YB + t * HGW + ch) = w; }
    __syncthreads();
}
__device__ __forceinline__ void hgrn_out(const Frame& F, const bf16* proj, const unsigned char* r2, const bf16* SB, const float* gain, bf16* YB) {
    LAS float* SSQ = (LAS float*)F.lds;
    const bf16* OI = (const bf16*)(r2 + R2_OI); const bf16* QP = (const bf16*)(r2 + R2_QP);
    const int lane = F.lane, wv = F.wave, r = lane & 15, kq = lane >> 4, tm = wv & 3, tvg = wv >> 2;
    HoutOps A, B;
    int unit = blockIdx.x;
    if (unit < NHU) hout_load(A, unit, proj, OI, QP, SB, r, kq, tm, tvg);
    for (; unit < NHU; unit += 2 * F.G) {
        const int u2 = unit + F.G, u3 = unit + 2 * F.G;
        if (u2 < NHU) hout_load(B, u2, proj, OI, QP, SB, r, kq, tm, tvg);
        hout_compute(A, unit, proj, OI, SSQ, gain, YB, lane, r, kq, tm, tvg);
        if (u2 < NHU) { if (u3 < NHU) hout_load(A, u3, proj, OI, QP, SB, r, kq, tm, tvg);
            hout_compute(B, u2, proj, OI, SSQ, gain, YB, lane, r, kq, tm, tvg); }
    }
}
__device__ __forceinline__ void memattn(const Frame& F, const bf16* proj, const bf16* KV, int layer, bf16* YX) {
    lbf16* Ks = (lbf16*)F.lds;
    lbf16* VTs = Ks + 256 * 136;
    const int lane = F.lane, wv = F.wave, r = lane & 15, kq = lane >> 4;
    for (int unit = blockIdx.x; unit < NB * XAH * (SEQ / 256); unit += F.G) {
        const int b = unit >> 6, hd = (unit >> 4) & 3, qt = unit & 15;
#pragma unroll
        for (int i = 0; i < 8; ++i) { const int p = F.tid + 512 * i, key = p >> 4, dc = (p & 15) * 8;
            const bf16* src = KV + (size_t)(b * NMEM + key) * 2048 + layer * 1024 + hd * XAD + dc;
            *(LAS v4u*)(Ks + key * 136 + dc) = *(const v4u*)src;
            const v4u w = *(const v4u*)(src + 512);
            const int k5 = key & 31, pos = (key & ~31) + 8 * ((k5 >> 2) & 3) + 4 * ((k5 >> 4) & 1) + (k5 & 3);
            lbf16* d = VTs + dc * 264 + pos;
            d[0] = (bf16)(w.x & 0xffffu); d[264] = (bf16)(w.x >> 16); d[2 * 264] = (bf16)(w.y & 0xffffu); d[3 * 264] = (bf16)(w.y >> 16);
            d[4 * 264] = (bf16)(w.z & 0xffffu); d[5 * 264] = (bf16)(w.z >> 16); d[6 * 264] = (bf16)(w.w & 0xffffu); d[7 * 264] = (bf16)(w.w >> 16); }
        __syncthreads();
#pragma unroll 1
        for (int g = 0; g < 2; ++g) {
            const int t = b * SEQ + qt * 256 + wv * 32 + g * 16 + r;
            bf16x8 qf[4];
#pragma unroll
            for (int ks = 0; ks < 4; ++ks) qf[ks] = *(const bf16x8*)(proj + (size_t)t * INC + C_QX + hd * XAD + ks * 32 + kq * 8);
            f32x4 s[16];
#pragma unroll
            for (int kt = 0; kt < 16; ++kt) { s[kt] = (f32x4){0.f, 0.f, 0.f, 0.f};
#pragma unroll
                for (int ks = 0; ks < 4; ++ks) { const bf16x8 a = *(const LAS bf16x8*)(Ks + (kt * 16 + r) * 136 + ks * 32 + kq * 8); s[kt] = __builtin_amdgcn_mfma_f32_16x16x32_bf16(a, qf[ks], s[kt], 0, 0, 0); }
                if (kt & 1) __builtin_amdgcn_sched_barrier(0); }
            float m = -1e30f;
#pragma unroll
            for (int kt = 0; kt < 16; ++kt) m = fmaxf(m, fmaxf(fmaxf(s[kt][0], s[kt][1]), fmaxf(s[kt][2], s[kt][3])));
            m = fmaxf(m, shx(m, 16, lane)); m = fmaxf(m, shx(m, 32, lane));
            const float cs = 0.08838834764831845f * 1.4426950408889634f; float l = 0.f;
#pragma unroll
            for (int kt = 0; kt < 16; ++kt)
#pragma unroll
                for (int e = 0; e < 4; ++e) { const float p = __builtin_amdgcn_exp2f((s[kt][e] - m) * cs); s[kt][e] = p; l += p; }
            l += shx(l, 16, lane); l += shx(l, 32, lane);
            f32x4 o[8];
#pragma unroll
            for (int dt = 0; dt < 8; ++dt) o[dt] = (f32x4){0.f, 0.f, 0.f, 0.f};
#pragma unroll
            for (int j = 0; j < 8; ++j) {
                v4u pw; pw.x = pk2(s[2 * j][0], s[2 * j][1]); pw.y = pk2(s[2 * j][2], s[2 * j][3]); pw.z = pk2(s[2 * j + 1][0], s[2 * j + 1][1]); pw.w = pk2(s[2 * j + 1][2], s[2 * j + 1][3]);
                const bf16x8 pf = __builtin_bit_cast(bf16x8, pw);
#pragma unroll
                for (int dt = 0; dt < 8; ++dt) { const bf16x8 a = *(const LAS bf16x8*)(VTs + (dt * 16 + r) * 264 + j * 32 + kq * 8); o[dt] = __builtin_amdgcn_mfma_f32_16x16x32_bf16(a, pf, o[dt], 0, 0, 0); }
                __builtin_amdgcn_sched_barrier(0); }
            const float inv = 1.f / l;
#pragma unroll
            for (int dt = 0; dt < 8; ++dt) { v2u w; w.x = pk2(o[dt][0] * inv, o[dt][1] * inv); w.y = pk2(o[dt][2] * inv, o[dt][3] * inv);
                *(v2u*)(YX + (size_t)t * YXW + hd * XAD + dt * 16 + 4 * kq) = w; }
        }
        __syncthreads();
    }
}
struct Args { const float* in[24]; float* out; unsigned char* ws; int ph_lo, ph_hi, mask, pad; };
typedef const __attribute__((address_space(4))) Args* KArgs;
__device__ __forceinline__ KArgs kargs() { KArgs p = (KArgs)__builtin_amdgcn_kernarg_segment_ptr(); asm volatile("" : "+s"(p)); return p; }
#define WSP(T, off) ((T*)(ws + (off)))
__global__ void __launch_bounds__(NWAVES * 64, 2) mk_fwd(Args args) {
    extern __shared__ __attribute__((aligned(16))) unsigned char lds_raw[];
    Frame F0; F0.lds = (LAS unsigned char*)lds_raw; F0.tid = threadIdx.x; F0.lane = F0.tid & 63; F0.wave = __builtin_amdgcn_readfirstlane(F0.tid >> 6);
    F0.G = gridDim.x; F0.gw = blockIdx.x * NWAVES + F0.wave; F0.NGW = F0.G * NWAVES;
    volatile LAS unsigned* MISC = (volatile LAS unsigned*)(F0.lds + MISC_OFF);
    for (int u = F0.tid; u < (LDS_BYTES - MISC_OFF) / 4; u += NWAVES * 64) ((LAS unsigned*)(F0.lds + MISC_OFF))[u] = 0u;
    __syncthreads();
    const int lo = args.ph_lo, hi = args.ph_hi;
    const bool multi = (hi - lo) > 1;
    XcdBarrier bar; bar.bar = (unsigned*)(args.ws + WS_CTL) + CW_BAR; bar.x = 0; bar.st = nullptr;
    if (multi) bar = xcd_barrier_post((unsigned*)(args.ws + WS_CTL) + CW_BAR, MISC + 8);
#define IN(k) (kargs()->ph_lo <= (k) && (k) < kargs()->ph_hi)
#define SEAM(k) do { if (IN((k) + 1)) xcd_barrier(bar); } while (0)
#define PH_BEGIN KArgs ka = kargs(); unsigned char* ws = ka->ws; (void)ws; Frame F = F0; { int w_ = F0.wave; asm volatile("" : "+s"(w_)); F.wave = w_; F.gw = (int)blockIdx.x * NWAVES + w_; } F.lane = pg8::lane_id_opaque(); F.tid = F.wave * 64 + F.lane
    if (IN(PH_CVT)) {
        { PH_BEGIN;
        unsigned gb = 0;
        for (int l = 0; l < 2; ++l) {
            xpose_matrix(F, ka->in[2] + (size_t)l * D * INC, D, INC, (bf16*)(ws + WS_WIN_T + l * WIN_T_L), D, 0, gb);
            xpose_matrix(F, ka->in[4] + (size_t)l * CW * D, CW, D, (bf16*)(ws + WS_WBR_T + l * WBR_T_L), CW, 0, gb);
            xpose_matrix(F, ka->in[7] + (size_t)l * HGW * D, HGW, D, (bf16*)(ws + WS_WBR_T + l * WBR_T_L + 3 * MiB), HGW, 0, gb);
            xpose_matrix(F, ka->in[10] + (size_t)l * XAW * D, XAW, D, (bf16*)(ws + WS_WBR_T + l * WBR_T_L + 6 * MiB), YXW, 0, gb);
            for (int i = blockIdx.x * 512 + F.tid; i < D * 32; i += F.G * 512) *(v4u*)((bf16*)(ws + WS_WBR_T + l * WBR_T_L + 6 * MiB) + (size_t)(i >> 5) * YXW + XAW + (i & 31) * 8) = (v4u){0u, 0u, 0u, 0u};
            xpose_matrix(F, ka->in[11] + (size_t)l * D * D, D, D, (bf16*)(ws + WS_WO_T + l * WO_T_L), D, 0, gb);
            xpose_matrix(F, ka->in[8] + (size_t)l * D * XAW, D, XAW, (bf16*)(ws + WS_WKV_T) + (size_t)(l * 1024) * D, D, 0, gb);
            xpose_matrix(F, ka->in[9] + (size_t)l * D * XAW, D, XAW, (bf16*)(ws + WS_WKV_T) + (size_t)(l * 1024 + 512) * D, D, 0, gb);
        }
        cvt_router(F, ka->in[14], ws);
        cvt_rows(F, ka->in[0], WSP(bf16, WS_XBF), (size_t)NTOK * D / 8);
        cvt_rows(F, ka->in[1], WSP(bf16, WS_MEMBF), (size_t)NB * NMEM * D / 8);
        }
        SEAM(PH_CVT);
    }
    for (int l = 0; l < 2; ++l) {
        const int pb = PH_L0 + l * PH_PER_LAYER;
        if (IN(pb + P_INPROJ)) {
            { PH_BEGIN;
            const bool split = F.G == 256;
            const int oa = (int)blockIdx.x >> 3, ox = (int)blockIdx.x & 7; const bool conv = split && ox < 2;
            const int hrank = 2 * oa + ox, grank = oa;
            static_assert((256 - NCV) * GM_UNITS + NCV * CV_UNITS == (NTOK / 256) * (INC / 256), "in-projection unit shares");
            if (conv) { Frame Fc = F; Fc.gw = hrank * NWAVES + F.wave; Fc.NGW = NCV * NWAVES; unsigned gb = 0;
                cvt_experts(Fc, ka->in[16] + (size_t)l * NE * D * EH, ka->in[17] + (size_t)l * NE * D * EH, ka->in[18] + (size_t)l * NE * EH * D, ka->in[19] + (size_t)l * D * EH, ka->in[20] + (size_t)l * D * EH, ka->in[21] + (size_t)l * EH * D, ws, gb);
                __syncthreads(); }
            if (!split) { unsigned gb = 0; cvt_experts(F, ka->in[16] + (size_t)l * NE * D * EH, ka->in[17] + (size_t)l * NE * D * EH, ka->in[18] + (size_t)l * NE * EH * D, ka->in[19] + (size_t)l * D * EH, ka->in[20] + (size_t)l * D * EH, ka->in[21] + (size_t)l * EH * D, ws, gb); __syncthreads(); }
            DenseSched S; S.init(ws + WS_XBF, ws + WS_WIN_T + l * WIN_T_L, NTOK, INC, D, F.G, (int)blockIdx.x);
            if (split) { S.lin = 1; S.cnt = conv ? CV_UNITS : GM_UNITS;
                if (conv) { S.L0 = (256 - NCV) * GM_UNITS; S.G = NCV; S.c = hrank; } else { S.L0 = (ox - 2) * 32 * GM_UNITS; S.G = 32; S.c = grank; } }
            EpiProj E{WSP(bf16, WS_R1), WSP(unsigned char, WS_GATE8)};
            pg8::gemm_phase<EpiProj, DenseSched, true>(F.lds + RING_OFF, F.wave, D, S, E);
            if (l == 0) {
                DenseSched S2; S2.init(ws + WS_MEMBF, ws + WS_WKV_T, NB * NMEM, 2048, D, split ? 32 : F.G, split ? ((conv && hrank < 32) ? hrank : -1) : (int)blockIdx.x);
                EpiBf16Plain E2{WSP(bf16, WS_KV), 2048};
                pg8::gemm_phase<EpiBf16Plain, DenseSched, true>(F.lds + RING_OFF, F.wave, D, S2, E2);
            }
            }
            SEAM(pb + P_INPROJ);
        }
        if (IN(pb + P_MIX)) {
            { PH_BEGIN;
            memattn(F, WSP(bf16, WS_R1), WSP(bf16, WS_KV), l, WSP(bf16, WS_YX));
            hgrn_local(F, WSP(bf16, WS_R1), ka->in[5], l, ws + WS_R2);
            conv_part(F, WSP(bf16, WS_R1), ka->in[3] + (size_t)l * 3 * CW, WSP(bf16, WS_YA), WSP(bf16, WS_YX));
            }
            SEAM(pb + P_MIX);
        }
        if (IN(pb + P_SCAN)) {
            { PH_BEGIN;
            hgrn_scan(F, ws + WS_R2, WSP(v2u, WS_ZF));
            }
            SEAM(pb + P_SCAN);
        }
        if (IN(pb + P_HOUT)) {
            { PH_BEGIN;
            hgrn_out(F, WSP(bf16, WS_R1), ws + WS_R2, WSP(bf16, WS_ZF), ka->in[6] + (size_t)l * HGW, WSP(bf16, WS_YB));
            }
            SEAM(pb + P_HOUT);
        }
        if (IN(pb + P_BRANCH)) {
            { PH_BEGIN;
            static_assert(WS_YX - WS_YB == WS_YB - WS_YA, "branch inputs equally spaced");
            BranchSched S; S.init(ws + WS_YA, ws + WS_WBR_T + l * WBR_T_L, F.G, (int)blockIdx.x); EpiGateRT E{WSP(unsigned char, WS_GATE8), WSP(bf16, WS_MERGED)};
            pg8::gemm_phase<EpiGateRT, BranchSched, true>(F.lds + RING_OFF, F.wave, CW, S, E);
            }
            SEAM(pb + P_BRANCH);
        }
        if (IN(pb + P_WO)) {
            { PH_BEGIN;
            DenseSched S; S.init(ws + WS_MERGED, ws + WS_WO_T + l * WO_T_L, NTOK, D, D, F.G, (int)blockIdx.x);
            EpiResid<true> E{(const void*)WSP(bf16, WS_XBF), WSP(bf16, WS_ZF)}; pg8::gemm_phase<EpiResid<true>, DenseSched, true>(F.lds + RING_OFF, F.wave, D, S, E);
            }
            SEAM(pb + P_WO);
        }
        if (IN(pb + P_ROUTE)) {
            { PH_BEGIN;
            route_phase(F, WSP(bf16, WS_ZF), ka->in[12] + (size_t)l * D, ka->in[13] + (size_t)l * D, WSP(bf16, WS_RW + l * RW_L), ka->in[15] + (size_t)l * NE, WSP(bf16, WS_X1F), WSP(bf16, WS_X1BF),
                        WSP(unsigned, WS_CTL) + CW_CNT + l * 64, WSP(int, WS_LIST), WSP(int, WS_TOKSLOT), WSP(float, WS_TOKW));
            }
            SEAM(pb + P_ROUTE);
        }
        if (IN(pb + P_GU)) {
            { PH_BEGIN;
            moe_plan(F, WSP(unsigned, WS_CTL) + CW_CNT + l * 64);
            MoeSched<true> S; S.init(F, ws + WS_X1BF, ws + WS_WGU, WSP(int, WS_LIST)); EpiSwiGLU E{WSP(bf16, WS_R2)};
            pg8::gemm_phase<EpiSwiGLU, MoeSched<true>, true>(F.lds + RING_OFF, F.wave, D, S, E);
            }
            SEAM(pb + P_GU);
        }
        if (IN(pb + P_DOWN)) {
            { PH_BEGIN;
            moe_plan(F, WSP(unsigned, WS_CTL) + CW_CNT + l * 64);
            MoeSched<false> S; S.init(F, ws + WS_R2, ws + WS_WDN, nullptr); EpiY8 E{WSP(unsigned char, WS_R1), WSP(bf16, WS_R1 + R1_YS)};
            pg8::gemm_phase<EpiY8, MoeSched<false>, true>(F.lds + RING_OFF, F.wave, EH, S, E);
            }
            SEAM(pb + P_DOWN);
        }
        if (IN(pb + P_COMB)) {
            { PH_BEGIN;
            moe_plan(F, WSP(unsigned, WS_CTL) + CW_CNT + l * 64);
            combine_phase(F, WSP(bf16, WS_X1BF), WSP(unsigned char, WS_R1), WSP(bf16, WS_R1 + R1_YS), WSP(int, WS_TOKSLOT), WSP(float, WS_TOKW), ka->in[22] + (size_t)l * D, ka->in[23] + (size_t)l * D, ka->out, WSP(bf16, WS_XBF), l == 1);
            }
            SEAM(pb + P_COMB);
        }
    }
#undef IN
#undef SEAM
}
static void launch_mk(Args a, int lo, int hi, int grid, hipStream_t stream) {
    a.ph_lo = lo; a.ph_hi = hi;
    hipLaunchKernelGGL(mk_fwd, dim3(grid), dim3(NWAVES * 64), LDS_BYTES, stream, a);
}
extern "C" void kernel_launch(void* const* d_in, const int* in_sizes, int n_in, void* d_out, int out_size, void* d_ws, size_t ws_size, hipStream_t stream) {
    static int grid = 0;
    if (grid == 0) {
        if (n_in != 24 || out_size != NTOK * D || ws_size < WS_END) { fprintf(stderr, "kernel_launch: unexpected sizes n_in %d out %d ws %zu\n", n_in, out_size, ws_size); grid = -1; return; }
        int dev = 0, cus = 0;
        if (hipGetDevice(&dev) != hipSuccess || hipDeviceGetAttribute(&cus, hipDeviceAttributeMultiprocessorCount, dev) != hipSuccess) { grid = -1; return; }
        if (hipFuncSetAttribute((const void*)mk_fwd, hipFuncAttributeMaxDynamicSharedMemorySize, LDS_BYTES) != hipSuccess) { fprintf(stderr, "kernel_launch: hipFuncSetAttribute failed\n"); grid = -1; return; }
        int per_cu = 0; (void)hipOccupancyMaxActiveBlocksPerMultiprocessor(&per_cu, (const void*)mk_fwd, NWAVES * 64, LDS_BYTES); (void)hipGetLastError();
        if (per_cu < 1) fprintf(stderr, "kernel_launch: occupancy query says %d\n", per_cu);
        grid = cus;
    }
    if (grid < 0) return;
    const float* x = (const float*)d_in[0];
    const float* conv_w = (const float*)d_in[3]; const float* lbl = (const float*)d_in[5];
    const float* hg_g = (const float*)d_in[6];
    const float* ln1_g = (const float*)d_in[12]; const float* ln1_b = (const float*)d_in[13]; const float* router_w = (const float*)d_in[14];
    const float* router_b = (const float*)d_in[15]; const float* exp_wg = (const float*)d_in[16]; const float* exp_wu = (const float*)d_in[17];
    const float* exp_wd = (const float*)d_in[18]; const float* sh_wg = (const float*)d_in[19]; const float* sh_wu = (const float*)d_in[20];
    const float* sh_wd = (const float*)d_in[21]; const float* ln2_g = (const float*)d_in[22]; const float* ln2_b = (const float*)d_in[23];
    unsigned char* ws = (unsigned char*)d_ws; float* out = (float*)d_out;
    unsigned* ctl = (unsigned*)(ws + WS_CTL);
    bf16* KV = (bf16*)(ws + WS_KV); bf16* XBF = (bf16*)(ws + WS_XBF); float* X1F = (float*)(ws + WS_X1F);
    bf16* X1BF = (bf16*)(ws + WS_X1BF); float* ZF = (float*)(ws + WS_ZF);
    bf16* YA = (bf16*)(ws + WS_YA); bf16* YB = (bf16*)(ws + WS_YB); bf16* YX = (bf16*)(ws + WS_YX);
    bf16* H = (bf16*)(ws + WS_R2); float* OH = (float*)(ws + WS_R2); bf16* PROJ = (bf16*)(ws + WS_R1); bf16* Y = (bf16*)(ws + WS_R1);
    int* LIST = (int*)(ws + WS_LIST); int* TOKSLOT = (int*)(ws + WS_TOKSLOT); float* TOKW = (float*)(ws + WS_TOKW);
    Args a{};
    for (int i = 0; i < 24; ++i) a.in[i] = (const float*)d_in[i];
    a.out = out; a.ws = ws;

    (void)hipMemsetAsync(ws + WS_CTL, 0, CTL_BYTES, stream);
    a.mask = 7;
    launch_mk(a, 0, N_PHASES, grid, stream);
}
```

```cpp
#include <hip/hip_runtime.h>
#include <stdint.h>
#include <stdio.h>

typedef unsigned short bf16;
__device__ __forceinline__ float bf2f(bf16 v) { return __uint_as_float(((unsigned)v) << 16); }
__device__ __forceinline__ bf16 f2bf(float f) { unsigned u = __float_as_uint(f); return (bf16)((u + 0x7fffu + ((u >> 16) & 1u)) >> 16); }

constexpr int NB = 4, SEQ = 4096, NTOK = NB * SEQ, D = 2048, NMEM = 256;
constexpr int CW = 768, HGW = 768, HGH = 6, HGD = 128, XAW = 512, XAH = 4, XAD = 128;
constexpr int INC = 12032, YXW = 768, GW8 = 3 * 2048, PN_GATE = 23;
constexpr int C_U = 0, C_B = 768, C_C = 1536, C_Q = 2304, C_F = 3072, C_I = 3840, C_G = 4608, C_QX = 5376, C_GA = 5888, C_GB = 7936, C_GX = 9984;
constexpr int NE = 64, TOPK = 8, EH = 512;
constexpr float ALPHA = 1.41421356237f, LN_EPS = 1e-5f, RMS_EPS = 1e-6f, RSCALE = 2.5f;
constexpr int LISTCAP = 16384;

constexpr size_t MiB = 1u << 20;
constexpr size_t WS_CTL = 0, CTL_BYTES = 1 * MiB;
constexpr size_t WS_RW = 1 * MiB, RW_L = 512 * 1024;
constexpr size_t WS_WIN_T = 2 * MiB, WIN_T_L = 47 * MiB;
constexpr size_t WS_WBR_T = 1932 * MiB, WBR_T_L = 9 * MiB;
constexpr size_t WS_WO_T = 112 * MiB, WO_T_L = 8 * MiB;
constexpr size_t WS_WKV_T = 128 * MiB;
constexpr size_t WS_MEMBF = 136 * MiB, WS_KV = 140 * MiB;
constexpr size_t WS_WGU = 144 * MiB, WGU_E = 4 * MiB;
constexpr size_t WS_WDN = 404 * MiB, WDN_E = 2 * MiB;
constexpr size_t WS_XBF = 534 * MiB, WS_X1F = 598 * MiB, WS_X1BF = 726 * MiB, WS_ZF = 790 * MiB, WS_MERGED = 918 * MiB;
constexpr size_t WS_YA = 1860 * MiB, WS_YB = 1884 * MiB, WS_YX = 1908 * MiB;
constexpr size_t WS_R2 = 1046 * MiB;
constexpr size_t WS_R1 = 1214 * MiB;
constexpr size_t R1_YS = 320 * MiB;
constexpr size_t WS_LIST = 1854 * MiB, WS_TOKSLOT = 1858 * MiB, WS_TOKW = 1859 * MiB, WS_GATE8 = 1950 * MiB, WS_END = 2046 * MiB;
constexpr int CW_CNT = 1024;
constexpr int CW_PLAN = 2048;
constexpr int CW_BAR = 4096;
#ifndef DBG_MASK
#define DBG_MASK 7
#endif
namespace pg8 {
#define PG8_LAS __attribute__((address_space(3)))
typedef unsigned short bf16_t;
typedef short bf16x8 __attribute__((ext_vector_type(8)));
typedef float f32x4 __attribute__((ext_vector_type(4)));
typedef unsigned u32x4 __attribute__((ext_vector_type(4)));
typedef unsigned u32x2 __attribute__((ext_vector_type(2)));
constexpr int PG8_NVO_OFF = 147456 + 1024;
constexpr int BM = 256, BK = 64, HALF = 128, HTB = HALF * BK * 2  , STAGE_BYTES = 8 * HTB, NXCD = 8, WGM = 8;

__host__ __device__ __forceinline__ int lds_byte(int r, int c) { const int st = (r >> 4) * 2 + (c >> 5), rr = r & 15, cc = c & 31, ob = rr * 64 + cc * 2; return st * 1024 + (ob ^ (((ob >> 9) & 1) << 5)); }
__host__ __device__ __forceinline__ void stage_rc(int b, int& R, int& C) { const int st = b / 1024, sb = b % 1024, swz = sb ^ (((sb >> 9) & 1) << 5); R = (st >> 1) * 16 + swz / 64; C = (st & 1) * 32 + (swz % 64) / 2; }
__host__ __device__ __forceinline__ int perm32(int rho) { const int n = rho >> 4, i = rho & 15; return 8 * (i >> 2) + 4 * n + (i & 3); }

struct Unit { const char* A; const char* B; int pm, pn; const int* list; int m0, cnt; };

typedef float f32x2_ __attribute__((ext_vector_type(2)));
typedef __bf16 bf16x2_ __attribute__((ext_vector_type(2)));
__device__ __forceinline__ unsigned cvt_pk_bf16(float lo, float hi) { const f32x2_ v = {lo, hi}; const bf16x2_ b = __builtin_convertvector(v, bf16x2_); return __builtin_bit_cast(unsigned, b); }
__device__ __forceinline__ int lane_id_opaque() { unsigned m = ~0u; asm volatile("" : "+s"(m)); return (int)__builtin_amdgcn_mbcnt_hi(m, __builtin_amdgcn_mbcnt_lo(m, 0u)); }
__device__ __forceinline__ float bf_lo(unsigned w) { return __uint_as_float(w << 16); }
__device__ __forceinline__ float bf_hi(unsigned w) { return __uint_as_float(w & 0xffff0000u); }
__device__ __forceinline__ float sigmoidf_(float x) { return __builtin_amdgcn_rcpf(1.f + __expf(-x)); }

typedef f32x4 Acc[2][2][4][2];

template <class Epi, class Sched, bool ALIGN_EPI>
__device__ __forceinline__ void gemm_phase(PG8_LAS unsigned char* lds, const int wave, const int K_in, const Sched& S, const Epi& E) {
    const int lane = lane_id_opaque(), wid = wave, tid = wid * 64 + lane, wr = wid >> 2, wc = wid & 3, fr = lane & 15, fq = lane >> 4;
    int K = K_in; asm volatile("" : "+s"(K));
    const int nt = K / BK;
    unsigned voffB[2];
#pragma unroll
    for (int i = 0; i < 2; ++i) { int R, C; stage_rc(tid * 16 + i * 8192, R, C); const int Rb = Epi::PERM ? ((R & ~31) + perm32(R & 31)) : R; voffB[i] = (unsigned)(Rb * K + C) * 2u; }
    const size_t kstep = (size_t)(BK * 2);
    const size_t hstep = (size_t)HALF * K * 2;
    const unsigned ldsw = (unsigned)wid * 1024u;
    const int aoff = lds_byte(wr * 64 + fr, fq * 8), boff = lds_byte(wc * 32 + fr, fq * 8);
#define PG8_SA(b, h) (((b) * 2 + (h)) * HTB)
#define PG8_SB(b, h) ((4 + (b) * 2 + (h)) * HTB)
#define PG8_STAGE2(bufoff, gbase, v0, v1) do { \
        __builtin_amdgcn_global_load_lds((const unsigned*)((const char*)(gbase) + (v0)), (PG8_LAS unsigned*)(lds + (bufoff) + ldsw), 16, 0, 0); \
        __builtin_amdgcn_global_load_lds((const unsigned*)((const char*)(gbase) + (v1)), (PG8_LAS unsigned*)(lds + (bufoff) + ldsw + 8192), 16, 0, 0); } while (0)
#define PG8_STAGEB(bufoff, gbase) PG8_STAGE2(bufoff, gbase, voffB[0], voffB[1])
#define PG8_LDA(dst, b, h) do { _Pragma("unroll") for (int m = 0; m < 4; ++m) _Pragma("unroll") for (int k = 0; k < 2; ++k) dst[m][k] = *(const PG8_LAS bf16x8*)(lds + PG8_SA(b, h) + aoff + m * 2048 + k * 1024); } while (0)
#define PG8_LDB(dst, b, h) do { _Pragma("unroll") for (int n = 0; n < 2; ++n) _Pragma("unroll") for (int k = 0; k < 2; ++k) dst[n][k] = *(const PG8_LAS bf16x8*)(lds + PG8_SB(b, h) + boff + n * 2048 + k * 1024); } while (0)
#define PG8_MMA(ai, bj, At, Bt) do { __builtin_amdgcn_s_setprio(1); _Pragma("unroll") for (int m = 0; m < 4; ++m) _Pragma("unroll") for (int n = 0; n < 2; ++n) _Pragma("unroll") for (int k = 0; k < 2; ++k) \
        acc[ai][bj][m][n] = __builtin_amdgcn_mfma_f32_16x16x32_bf16(Bt[n][k], At[m][k], acc[ai][bj][m][n], 0, 0, 0); __builtin_amdgcn_s_setprio(0); } while (0)
#define PG8_WAIT_V(n) asm volatile("s_waitcnt vmcnt(" #n ")" ::: "memory")
#define PG8_WAIT_L(n) asm volatile("s_waitcnt lgkmcnt(" #n ")" ::: "memory")
#define PG8_BAR __builtin_amdgcn_s_barrier()
#define PG8_SCHED __builtin_amdgcn_sched_barrier(0)
    Unit cur, nxt; int ui = 0;
    if (!S.next(0, cur)) return;
    Acc acc;
#pragma unroll
    for (int a = 0; a < 2; ++a)
#pragma unroll
        for (int b = 0; b < 2; ++b)
#pragma unroll
            for (int m = 0; m < 4; ++m)
#pragma unroll
                for (int n = 0; n < 2; ++n) acc[a][b][m][n] = (f32x4){0.f, 0.f, 0.f, 0.f};
    bf16x8 At[4][2], B0[2][2], B1[2][2];
    constexpr bool GA = Sched::GATHER;
    unsigned c00, c01, c10 = 0, c11 = 0;
    PG8_LAS unsigned* nvo = (PG8_LAS unsigned*)(lds + PG8_NVO_OFF) + tid * 4;
    { int R0, C0, R1, C1; stage_rc(tid * 16, R0, C0); stage_rc(tid * 16 + 8192, R1, C1);
      c00 = S.avoff(cur, 0, R0, C0, K); c01 = S.avoff(cur, 0, R1, C1, K); if constexpr (GA) { c10 = S.avoff(cur, 1, R0, C0, K); c11 = S.avoff(cur, 1, R1, C1, K); } }
    const size_t hA = GA ? (size_t)0 : hstep;
#define PG8_STAGEA0(bufoff, gbase) PG8_STAGE2(bufoff, gbase, c00, c01)
#define PG8_STAGEA1(bufoff, gbase) do { if constexpr (GA) PG8_STAGE2(bufoff, gbase, c10, c11); else PG8_STAGE2(bufoff, (gbase) + hA, c00, c01); } while (0)
    const char* cA = cur.A; const char* cB = cur.B;
    PG8_STAGEB(PG8_SB(0, 0), cB); PG8_STAGEB(PG8_SB(0, 1), cB + hstep); PG8_STAGEA0(PG8_SA(0, 0), cA); PG8_STAGEA1(PG8_SA(0, 1), cA);
    if (wr == 1) PG8_BAR;
    PG8_WAIT_V(2); PG8_BAR;
    PG8_STAGEB(PG8_SB(1, 0), cB + kstep); PG8_STAGEA0(PG8_SA(1, 0), cA + kstep); PG8_STAGEB(PG8_SB(1, 1), cB + hstep + kstep);
    PG8_WAIT_V(6); PG8_BAR;
    int pi0 = 0, pi1 = 0, pi2 = 0, pi3 = 0;
    if constexpr (GA) { Unit n1; if (S.next(1, n1)) { int R0, C0, R1, C1; stage_rc(tid * 16, R0, C0); stage_rc(tid * 16 + 8192, R1, C1);
        pi0 = S.avload(n1, 0, R0); pi1 = S.avload(n1, 0, R1); pi2 = S.avload(n1, 1, R0); pi3 = S.avload(n1, 1, R1); } }
    for (;;) {
        const bool has_next = S.next(ui + 1, nxt);
        const char* nA = has_next ? nxt.A : cA; const char* nB = has_next ? nxt.B : cB;
        if constexpr (GA) { if (has_next) {
            int R0, C0, R1, C1; stage_rc(tid * 16, R0, C0); stage_rc(tid * 16 + 8192, R1, C1);
            nvo[0] = S.avfin(nxt, 0, R0, C0, K, pi0); nvo[1] = S.avfin(nxt, 0, R1, C1, K, pi1); nvo[2] = S.avfin(nxt, 1, R0, C0, K, pi2); nvo[3] = S.avfin(nxt, 1, R1, C1, K, pi3); } }
        for (int t = 0; t < nt; t += 2) {
            const bool last = (t == nt - 2);
            const char* a1 = cA + (size_t)(t + 1) * kstep;
            const char* a2 = last ? nA : cA + (size_t)(t + 2) * kstep; const char* b2 = last ? nB : cB + (size_t)(t + 2) * kstep;
            const char* a3 = a2 + kstep; const char* b3 = b2 + kstep;
            const bool nx = GA && last && has_next;
#define PG8_STAGEA0N(bufoff, gbase) do { if (nx) { const unsigned q0 = nvo[0], q1 = nvo[1]; PG8_STAGE2(bufoff, gbase, q0, q1); } else PG8_STAGEA0(bufoff, gbase); } while (0)
#define PG8_STAGEA1N(bufoff, gbase) do { if (nx) { const unsigned q0 = nvo[2], q1 = nvo[3]; PG8_STAGE2(bufoff, gbase, q0, q1); } else PG8_STAGEA1(bufoff, gbase); } while (0)
            PG8_LDB(B0, 0, 0); PG8_LDB(B1, 0, 1); PG8_SCHED; PG8_LDA(At, 0, 0); PG8_STAGEA1(PG8_SA(1, 1), a1);
            PG8_WAIT_V(8); PG8_WAIT_L(0); PG8_BAR; PG8_MMA(0, 0, At, B0); PG8_MMA(0, 1, At, B1); PG8_BAR; PG8_SCHED;
            PG8_LDA(At, 0, 1); PG8_STAGEB(PG8_SB(0, 0), b2); PG8_STAGEB(PG8_SB(0, 1), b2 + hstep); PG8_STAGEA0N(PG8_SA(0, 0), a2);
            PG8_WAIT_V(8); PG8_WAIT_L(0); PG8_BAR; PG8_MMA(1, 0, At, B0); PG8_MMA(1, 1, At, B1); PG8_BAR; PG8_SCHED;
            PG8_LDB(B0, 1, 0); PG8_LDB(B1, 1, 1); PG8_SCHED; PG8_LDA(At, 1, 0); PG8_STAGEA1N(PG8_SA(0, 1), a2);
            PG8_WAIT_V(8); PG8_WAIT_L(0); PG8_BAR; PG8_MMA(0, 0, At, B0); PG8_MMA(0, 1, At, B1); PG8_BAR; PG8_SCHED;
            PG8_LDA(At, 1, 1); PG8_STAGEB(PG8_SB(1, 0), b3); PG8_STAGEB(PG8_SB(1, 1), b3 + hstep); PG8_STAGEA0N(PG8_SA(1, 0), a3);
            PG8_WAIT_V(8); PG8_WAIT_L(0); PG8_BAR; PG8_MMA(1, 0, At, B0); PG8_MMA(1, 1, At, B1); PG8_BAR; PG8_SCHED;
#undef PG8_STAGEA0N
#undef PG8_STAGEA1N
        }
        if constexpr (GA) { Unit n2; if (has_next && S.next(ui + 2, n2)) { int R0, C0, R1, C1; stage_rc(tid * 16, R0, C0); stage_rc(tid * 16 + 8192, R1, C1);
            pi0 = S.avload(n2, 0, R0); pi1 = S.avload(n2, 0, R1); pi2 = S.avload(n2, 1, R0); pi3 = S.avload(n2, 1, R1); } }
        if constexpr (ALIGN_EPI) { if (wr == 0) PG8_BAR; }
        bool keep = false;
        if constexpr (Epi::INPLACE) keep = E.inplace(acc, cur, wr, wc, fr, fq); else E(acc, cur, wr, wc, fr, fq);
        if (!has_next) break;
        if (!keep)
#pragma unroll
        for (int a = 0; a < 2; ++a)
#pragma unroll
            for (int b = 0; b < 2; ++b)
#pragma unroll
                for (int m = 0; m < 4; ++m)
#pragma unroll
                    for (int n = 0; n < 2; ++n) acc[a][b][m][n] = (f32x4){0.f, 0.f, 0.f, 0.f};
        cur = nxt; cA = nA; cB = nB; ++ui; if constexpr (GA) { c00 = nvo[0]; c01 = nvo[1]; c10 = nvo[2]; c11 = nvo[3]; }
        if constexpr (ALIGN_EPI) { if (wr == 1) PG8_BAR; }
    }
    PG8_WAIT_V(0);
    if constexpr (!ALIGN_EPI) { if (wr == 0) PG8_BAR; }
    PG8_BAR;
#undef PG8_SA
#undef PG8_SB
#undef PG8_STAGE2
#undef PG8_STAGEB
#undef PG8_STAGEA0
#undef PG8_STAGEA1
#undef PG8_LDA
#undef PG8_LDB
#undef PG8_MMA
#undef PG8_WAIT_V
#undef PG8_WAIT_L
#undef PG8_BAR
#undef PG8_SCHED
}
}
#define GAS __attribute__((address_space(1)))
#define LAS __attribute__((address_space(3)))
typedef unsigned v4u __attribute__((ext_vector_type(4)));
typedef unsigned v2u __attribute__((ext_vector_type(2)));
typedef float f32x4 __attribute__((ext_vector_type(4)));
typedef short bf16x8 __attribute__((ext_vector_type(8)));
typedef GAS unsigned gu32;
#define RLX_AGENT __ATOMIC_RELAXED, __HIP_MEMORY_SCOPE_AGENT
#define LDS_WAIT() asm volatile("s_waitcnt lgkmcnt(0)" ::: "memory")
#define VM_WAIT() asm volatile("s_waitcnt vmcnt(0)" ::: "memory")
__device__ __forceinline__ int opaque_v(int x) { asm volatile("" : "+v"(x)); return x; }
__device__ __forceinline__ float shx(float v, int o, int lane) { return __int_as_float(__builtin_amdgcn_ds_bpermute((lane ^ o) << 2, __float_as_int(v))); }
__device__ __forceinline__ unsigned pk2(float lo, float hi) { return pg8::cvt_pk_bf16(lo, hi); }

#define XB_TMO      128
#define XB_XCNT(j)  (256  + 64 * (j))
#define XB_XSUB(j)  (1280 + 64 * (j))
#define XB_XGEN(j)  (2304 + 64 * (j))
#define XB_TOP      3328
#define XB_TOPGEN   3392
#define XCD_BAR_WORDS 3456
#define XB_SPIN_CAP (1u << 18)
__device__ __forceinline__ unsigned xb_ld(unsigned* p)              { return __hip_atomic_load(p, __ATOMIC_RELAXED, __HIP_MEMORY_SCOPE_AGENT); }
__device__ __forceinline__ unsigned xb_add(unsigned* p, unsigned v) { return __hip_atomic_fetch_add(p, v, __ATOMIC_RELAXED, __HIP_MEMORY_SCOPE_AGENT); }
__device__ __forceinline__ unsigned xb_xcc_id() { return (unsigned)__builtin_amdgcn_s_getreg((3 << 11) | 20) & 0xFu; }
#define XB_SPIN(cond, bar) do { unsigned _sp = 0; while (cond) { __builtin_amdgcn_s_sleep(1); \
    if ((++_sp & 255u) == 0u) { if (xb_ld(&(bar)[XB_TMO])) break; if (_sp > XB_SPIN_CAP) { atomicAdd(&(bar)[XB_TMO], 1u); break; } } } } while (0)
struct XcdBarrier { unsigned* bar; unsigned x; volatile LAS unsigned* st; };
__device__ __forceinline__ XcdBarrier xcd_barrier_post(unsigned* bar, volatile LAS unsigned* st) {
    XcdBarrier b; b.bar = bar; b.x = xb_xcc_id(); b.st = st;
    if (threadIdx.x == 0) (void)xb_add(&bar[XB_XCNT(b.x)], 1u);
    return b;
}
__device__ __forceinline__ void xcd_barrier_complete(unsigned* bar, unsigned x, unsigned& nloc, unsigned& nx) {
    const unsigned G = gridDim.x * gridDim.y * gridDim.z;
    unsigned sum, cnt, mine, sp = 0u;
    for (;;) {
        sum = 0u; cnt = 0u; mine = 0u;
#pragma unroll
        for (unsigned j = 0; j < 16; ++j) { const unsigned c = xb_ld(&bar[XB_XCNT(j)]); sum += c; cnt += (c > 0u) ? 1u : 0u; mine = (j == x) ? c : mine; }
        if (sum == G) break;
        __builtin_amdgcn_s_sleep(1);
        if ((++sp & 255u) == 0u) { if (xb_ld(&bar[XB_TMO])) break; if (sp > XB_SPIN_CAP) { atomicAdd(&bar[XB_TMO], 1u); break; } }
    }
    nloc = mine > 0u ? mine : 1u; nx = cnt > 0u ? cnt : 1u;
}
__device__ __forceinline__ void xcd_barrier(const XcdBarrier& b_in) {
    asm volatile("s_waitcnt vmcnt(0)" ::: "memory");
    __syncthreads();
    if (threadIdx.x == 0) {
        XcdBarrier b = b_in; asm volatile("" : "+s"(b.x));
        unsigned* bar = b.bar; asm volatile("" : "+s"(bar));
        __builtin_amdgcn_s_waitcnt(0);
        unsigned nloc = b.st[0], nx = b.st[1];
        if (nloc == 0u) { xcd_barrier_complete(bar, b.x, nloc, nx); b.st[0] = nloc; b.st[1] = nx; }
        const unsigned old = xb_add(&bar[XB_XSUB(b.x)], 1u);
        const unsigned gen = old / nloc;
        if (old + 1u == (gen + 1u) * nloc) {
            __builtin_amdgcn_fence(__ATOMIC_RELEASE, "agent");
            asm volatile("s_waitcnt vmcnt(0)" ::: "memory");
            const unsigned og = xb_add(&bar[XB_TOP], 1u);
            const unsigned tg = og / nx;
            if (og + 1u == (tg + 1u) * nx) xb_add(&bar[XB_TOPGEN], 1u);
            else XB_SPIN(xb_ld(&bar[XB_TOPGEN]) == tg, bar);
            __builtin_amdgcn_fence(__ATOMIC_ACQUIRE, "agent");
            xb_add(&bar[XB_XGEN(b.x)], 1u);
            asm volatile("s_waitcnt vmcnt(0)" ::: "memory");
        } else {
            XB_SPIN(xb_ld(&bar[XB_XGEN(b.x)]) == gen, bar);
            __builtin_amdgcn_fence(__ATOMIC_ACQUIRE, "agent");
            asm volatile("s_waitcnt vmcnt(0)" ::: "memory");
        }
    }
    __syncthreads();
}
using pg8::Unit; using pg8::Acc;
struct DenseSched { static constexpr bool GATHER = false;
    const char* A; const char* B; int nM, nN, nwg, G, c, K; int L0 = 0, cnt = 1 << 30, lin = 0;
    __device__ __forceinline__ void init(const void* A_, const void* B_, int M, int N, int K_, int G_, int c_) { A = (const char*)A_; B = (const char*)B_; nM = M / 256; nN = N / 256; nwg = nM * nN; G = G_; c = c_; K = K_; }
    __device__ __forceinline__ bool next(int i, Unit& u) const {
        const long L = (long)L0 + (long)i * G + c; if (c < 0 || i >= cnt || L >= nwg) return false;
        int wgid = (int)L; if (!lin) { const int q = nwg / 8, r = nwg % 8, xcd = wgid % 8, off = wgid / 8; wgid = (xcd < r ? xcd * (q + 1) : r * (q + 1) + (xcd - r) * q) + off; }
        const int nig = 8 * nN, gid = wgid / nig, fm = gid * 8, gsz = (nM - fm) < 8 ? (nM - fm) : 8;
        u.pm = fm + ((wgid % nig) % gsz); u.pn = (wgid % nig) / gsz;
        u.A = A + (size_t)u.pm * 256 * K * 2; u.B = B + (size_t)u.pn * 256 * K * 2; u.list = nullptr; u.m0 = 0; u.cnt = 0; return true;
    }
    __device__ __forceinline__ int avload(const Unit&, int, int) const { return 0; }
    __device__ __forceinline__ unsigned avfin(const Unit&, int h, int R, int C, int K_, int) const { return (unsigned)(((h * 128 + R) * K_ + C) * 2); }
    __device__ __forceinline__ unsigned avoff(const Unit&, int h, int R, int C, int K_) const { return (unsigned)(((h * 128 + R) * K_ + C) * 2); }
};
struct EpiBf16Plain { static constexpr bool PERM = true, INPLACE = false; bf16* O; int ldc;
    __device__ __forceinline__ void operator()(const Acc& acc, const Unit& u, int wr, int wc, int fr, int fq) const {
        const int row0 = u.pm * 256 + wr * 64 + fr, col0 = u.pn * 256 + wc * 32 + 8 * fq;
#pragma unroll
        for (int ai = 0; ai < 2; ++ai)
#pragma unroll
            for (int m = 0; m < 4; ++m) { bf16* rowp = O + (size_t)(row0 + ai * 128 + m * 16) * ldc + col0;
#pragma unroll
                for (int bj = 0; bj < 2; ++bj) { const f32x4 v0 = acc[ai][bj][m][0], v1 = acc[ai][bj][m][1];
                    v4u w; w.x = pk2(v0[0], v0[1]); w.y = pk2(v0[2], v0[3]); w.z = pk2(v1[0], v1[1]); w.w = pk2(v1[2], v1[3]);
                    *(v4u*)(rowp + bj * 128) = w; } }
    }
};
struct EpiProj { static constexpr bool PERM = true, INPLACE = false; bf16* O; unsigned char* G8;
    __device__ __forceinline__ void operator()(const Acc& acc, const Unit& u, int wr, int wc, int fr, int fq) const {
        const int row0 = u.pm * 256 + wr * 64 + fr;
        if (u.pn < PN_GATE) { const int col0 = u.pn * 256 + wc * 32 + 8 * fq;
#pragma unroll
            for (int ai = 0; ai < 2; ++ai)
#pragma unroll
                for (int m = 0; m < 4; ++m) { bf16* rowp = O + (size_t)(row0 + ai * 128 + m * 16) * INC + col0;
#pragma unroll
                    for (int bj = 0; bj < 2; ++bj) { const f32x4 v0 = acc[ai][bj][m][0], v1 = acc[ai][bj][m][1];
                        v4u w; w.x = pk2(v0[0], v0[1]); w.y = pk2(v0[2], v0[3]); w.z = pk2(v1[0], v1[1]); w.w = pk2(v1[2], v1[3]);
                        *(v4u*)(rowp + bj * 128) = w; } }
        } else { const int pos0 = (u.pn - PN_GATE) * 256 + wc * 64 + fq * 16;
#pragma unroll
            for (int ai = 0; ai < 2; ++ai)
#pragma unroll
                for (int m = 0; m < 4; ++m) { unsigned char* rowp = G8 + (size_t)(row0 + ai * 128 + m * 16) * GW8 + pos0;
                    v4u w;
#pragma unroll
                    for (int bj = 0; bj < 2; ++bj) { const f32x4 v0 = acc[ai][bj][m][0], v1 = acc[ai][bj][m][1];
                        unsigned q[8];
#pragma unroll
                        for (int j = 0; j < 4; ++j) { q[j] = (unsigned)fmaxf(pg8::sigmoidf_(v0[j]) * 255.f + 0.5f, 1.f); q[4 + j] = (unsigned)fmaxf(pg8::sigmoidf_(v1[j]) * 255.f + 0.5f, 1.f); }
                        const unsigned lo = q[0] | (q[1] << 8) | (q[2] << 16) | (q[3] << 24), hi = q[4] | (q[5] << 8) | (q[6] << 16) | (q[7] << 24);
                        if (bj == 0) { w.x = lo; w.y = hi; } else { w.z = lo; w.w = hi; } }
                    *(v4u*)rowp = w; }
        }
    }
};
struct BranchSched { static constexpr bool GATHER = false;
    const char* A0; const char* B; int G, c;
    __device__ __forceinline__ void init(const void* ya, const void* w, int G_, int c_) { A0 = (const char*)ya; B = (const char*)w; G = G_; c = c_; }
    __device__ __forceinline__ bool next(int i, Unit& u) const {
        const int j = i / 3, seg = i - 3 * j; constexpr int nM = NTOK / 256, nN = D / 256, nwg = nM * nN;
        const int L = j * G + c; if (L >= nwg) return false;
        int wgid = L; { const int q = nwg / 8, xcd = wgid % 8, off = wgid / 8; wgid = xcd * q + off; }
        const int nig = 8 * nN; u.pm = (wgid / nig) * 8 + ((wgid % nig) % 8); u.pn = (wgid % nig) / 8;
        u.A = A0 + (size_t)seg * (WS_YB - WS_YA) + (size_t)u.pm * 256 * CW * 2; u.B = B + (size_t)seg * 3 * MiB + (size_t)u.pn * 256 * CW * 2; u.list = nullptr; u.m0 = seg; u.cnt = 0; return true; }
    __device__ __forceinline__ int avload(const Unit&, int, int) const { return 0; }
    __device__ __forceinline__ unsigned avfin(const Unit&, int h, int R, int C, int K_, int) const { return (unsigned)(((h * 128 + R) * K_ + C) * 2); }
    __device__ __forceinline__ unsigned avoff(const Unit&, int h, int R, int C, int K_) const { return (unsigned)(((h * 128 + R) * K_ + C) * 2); }
};
struct EpiGateRT { static constexpr bool PERM = true, INPLACE = true; const unsigned char* g8; bf16* merged;
    __device__ __forceinline__ bool inplace(Acc& acc, const Unit& u, int wr, int wc, int fr, int fq) const {
        const int row0 = u.pm * 256 + wr * 64 + fr, col0 = u.pn * 256 + wc * 32 + 8 * fq, pos0 = u.pn * 256 + wc * 64 + fq * 16; const int seg = u.m0;
#pragma unroll
        for (int ai = 0; ai < 2; ++ai) {
            v4u ga[4], gb[4];
#pragma unroll
            for (int m = 0; m < 4; ++m) { const size_t row = (size_t)(row0 + ai * 128 + m * 16);
                ga[m] = *(const v4u*)(g8 + row * GW8 + seg * D + pos0); gb[m] = ga[m]; if (seg < 2) gb[m] = *(const v4u*)(g8 + row * GW8 + (seg + 1) * D + pos0); }
            asm volatile("" ::: "memory");
#pragma unroll
            for (int m = 0; m < 4; ++m) { const size_t row = (size_t)(row0 + ai * 128 + m * 16);
#pragma unroll
                for (int bj = 0; bj < 2; ++bj) { const unsigned ax = bj ? ga[m].z : ga[m].x, ay = bj ? ga[m].w : ga[m].y, bx = bj ? gb[m].z : gb[m].x, by = bj ? gb[m].w : gb[m].y;
                    f32x4 v0 = acc[ai][bj][m][0], v1 = acc[ai][bj][m][1];
                    if (seg < 2) {
                        v0[0] *= (float)(ax & 255u) * __builtin_amdgcn_rcpf((float)(bx & 255u)); v0[1] *= (float)((ax >> 8) & 255u) * __builtin_amdgcn_rcpf((float)((bx >> 8) & 255u));
                        v0[2] *= (float)((ax >> 16) & 255u) * __builtin_amdgcn_rcpf((float)((bx >> 16) & 255u)); v0[3] *= (float)(ax >> 24) * __builtin_amdgcn_rcpf((float)(bx >> 24));
                        v1[0] *= (float)(ay & 255u) * __builtin_amdgcn_rcpf((float)(by & 255u)); v1[1] *= (float)((ay >> 8) & 255u) * __builtin_amdgcn_rcpf((float)((by >> 8) & 255u));
                        v1[2] *= (float)((ay >> 16) & 255u) * __builtin_amdgcn_rcpf((float)((by >> 16) & 255u)); v1[3] *= (float)(ay >> 24) * __builtin_amdgcn_rcpf((float)(by >> 24));
                        acc[ai][bj][m][0] = v0; acc[ai][bj][m][1] = v1;
                    } else { constexpr float s8 = 1.f / 255.f;
                        v0[0] *= (float)(ax & 255u) * s8; v0[1] *= (float)((ax >> 8) & 255u) * s8; v0[2] *= (float)((ax >> 16) & 255u) * s8; v0[3] *= (float)(ax >> 24) * s8;
                        v1[0] *= (float)(ay & 255u) * s8; v1[1] *= (float)((ay >> 8) & 255u) * s8; v1[2] *= (float)((ay >> 16) & 255u) * s8; v1[3] *= (float)(ay >> 24) * s8;
                        v4u w; w.x = pk2(v0[0], v0[1]); w.y = pk2(v0[2], v0[3]); w.z = pk2(v1[0], v1[1]); w.w = pk2(v1[2], v1[3]); *(v4u*)(merged + row * D + col0 + bj * 128) = w; } } }
            asm volatile("" ::: "memory");
        }
        return seg < 2;
    }
};
template <bool RB16> struct EpiResid { static constexpr bool PERM = true, INPLACE = false; const void* xres; bf16* z;
    __device__ __forceinline__ void operator()(const Acc& acc, const Unit& u, int wr, int wc, int fr, int fq) const {
        const int row0 = u.pm * 256 + wr * 64 + fr, col0 = u.pn * 256 + wc * 32 + 8 * fq;
#pragma unroll
        for (int ai = 0; ai < 2; ++ai) {
            f32x4 xr[4][2][2];
#pragma unroll
            for (int m = 0; m < 4; ++m) { const size_t off = (size_t)(row0 + ai * 128 + m * 16) * D + col0;
#pragma unroll
                for (int bj = 0; bj < 2; ++bj) {
                    if constexpr (RB16) { const v4u w = *(const v4u*)((const bf16*)xres + off + bj * 128);
                        xr[m][bj][0] = (f32x4){pg8::bf_lo(w.x), pg8::bf_hi(w.x), pg8::bf_lo(w.y), pg8::bf_hi(w.y)}; xr[m][bj][1] = (f32x4){pg8::bf_lo(w.z), pg8::bf_hi(w.z), pg8::bf_lo(w.w), pg8::bf_hi(w.w)}; }
                    else {
#pragma unroll
                        for (int n = 0; n < 2; ++n) xr[m][bj][n] = *(const f32x4*)((const float*)xres + off + bj * 128 + n * 4); } } }
            asm volatile("" ::: "memory");
#pragma unroll
            for (int m = 0; m < 4; ++m) { const size_t off = (size_t)(row0 + ai * 128 + m * 16) * D + col0;
#pragma unroll
                for (int bj = 0; bj < 2; ++bj) { const f32x4 v0 = xr[m][bj][0] * ALPHA + acc[ai][bj][m][0], v1 = xr[m][bj][1] * ALPHA + acc[ai][bj][m][1];
                    v4u w; w.x = pk2(v0[0], v0[1]); w.y = pk2(v0[2], v0[3]); w.z = pk2(v1[0], v1[1]); w.w = pk2(v1[2], v1[3]); *(v4u*)(z + off + bj * 128) = w; } }
            asm volatile("" ::: "memory");
        }
    }
};

constexpr int NWAVES = 8;
constexpr int RING_OFF = 0, RING_BYTES = 131072;
constexpr int SCR_BYTES = 147456;
constexpr int MISC_OFF = SCR_BYTES;
constexpr int LDS_BYTES = 163840;
constexpr int PH_CVT = 0, PH_L0 = 1, PH_PER_LAYER = 10;
constexpr int P_INPROJ = 0, P_MIX = 1, P_SCAN = 2, P_HOUT = 3, P_BRANCH = 4, P_WO = 5, P_ROUTE = 6, P_GU = 7, P_DOWN = 8, P_COMB = 9;
constexpr int N_PHASES = PH_L0 + 2 * PH_PER_LAYER;

constexpr int NCV = 64;
#define CV_UNITS 2
#define GM_UNITS 15
struct Frame { LAS unsigned char* lds; int tid, lane, wave, G, gw, NGW; };

__device__ __forceinline__ void xpose_item(const float* W, int N, int k0, int n0, bf16* WTrow0, int ldk, LAS float* scr, int lane) {
    const int kk = lane >> 3, nn = (lane & 7) * 4;
    f32x4 v[8];
#pragma unroll
    for (int i = 0; i < 8; ++i) v[i] = *(const f32x4*)(W + (size_t)(k0 + kk + 8 * i) * N + n0 + nn);
#pragma unroll
    for (int i = 0; i < 8; ++i) { LAS float* s = scr + (kk + 8 * i) * 33 + nn; s[0] = v[i][0]; s[1] = v[i][1]; s[2] = v[i][2]; s[3] = v[i][3]; }
    LDS_WAIT(); asm volatile("" ::: "memory");
    const int c = lane & 7;
#pragma unroll
    for (int j = 0; j < 4; ++j) { const int n = (lane >> 3) + 8 * j; const LAS float* s = scr + (8 * c) * 33 + n;
        v4u o; o.x = pk2(s[0 * 33], s[1 * 33]); o.y = pk2(s[2 * 33], s[3 * 33]); o.z = pk2(s[4 * 33], s[5 * 33]); o.w = pk2(s[6 * 33], s[7 * 33]);
        *(v4u*)(WTrow0 + (size_t)n * ldk + 8 * c) = o; }
    LDS_WAIT(); asm volatile("" ::: "memory");
}
__device__ __forceinline__ void xpose_matrix(const Frame& F, const float* W, int K, int N, bf16* WT, int ldk, int mode, unsigned& gbase) {
    const int nblk = N / 32, nitems = (K / 64) * nblk;
    LAS float* scr = (LAS float*)(F.lds + RING_OFF + F.wave * 8704);
    int it = (int)(((unsigned)F.gw + (unsigned)F.NGW - gbase % (unsigned)F.NGW) % (unsigned)F.NGW);
    for (; it < nitems; it += F.NGW) {
        const int kb = it / nblk, nb = it % nblk, n0 = nb * 32, k0 = kb * 64;
        const int drow = mode == 0 ? n0 : ((n0 >> 7) * 256 + (n0 & 127) + (mode == 2 ? 128 : 0));
        xpose_item(W, N, k0, n0, WT + (size_t)drow * ldk + k0, ldk, scr, F.lane);
    }
    gbase += (unsigned)nitems;
}
__device__ __forceinline__ void cvt_rows(const Frame& F, const float* in, bf16* out, size_t n8) {
    for (size_t i = (size_t)blockIdx.x * 512 + F.tid; i < n8; i += (size_t)F.G * 512) {
        const f32x4 a = *(const f32x4*)(in + i * 8), b = *(const f32x4*)(in + i * 8 + 4);
        v4u w; w.x = pk2(a[0], a[1]); w.y = pk2(a[2], a[3]); w.z = pk2(b[0], b[1]); w.w = pk2(b[2], b[3]);
        *(v4u*)(out + i * 8) = w; }
}
__device__ __forceinline__ void cvt_router(const Frame& F, const float* rw, unsigned char* ws) {
    for (int i = blockIdx.x * 512 + F.tid; i < 2 * D * NE; i += F.G * 512) { const int l = i / (D * NE), k = (i / NE) % D, e = i % NE;
        const float w = rw[i]; const bf16 h = f2bf(w); const bf16 lo = f2bf(w - bf2f(h));
        bf16* dst = (bf16*)(ws + WS_RW + l * RW_L); dst[(size_t)e * D + k] = h; dst[(size_t)(NE + e) * D + k] = lo; }
}
struct XItem { const float* src; bf16* dst; int N, ldk; };
__device__ __forceinline__ void xp_decode(int I, const float* wg, const float* wu, const float* wd, const float* sg, const float* su, const float* sd, unsigned char* ws, XItem& x) {
    const int e = I / 1536, rem = I % 1536, m = rem >> 9, it = rem & 511;
    if (m < 2) { const float* W = m == 0 ? (e < NE ? wg + (size_t)e * D * EH : sg) : (e < NE ? wu + (size_t)e * D * EH : su);
        const int kb = it >> 4, nb = it & 15, n0 = nb * 32, k0 = kb * 64; const int drow = (n0 >> 7) * 256 + (n0 & 127) + (m == 1 ? 128 : 0);
        x.src = W + (size_t)k0 * EH + n0; x.N = EH; x.ldk = D; x.dst = (bf16*)(ws + WS_WGU + (size_t)e * WGU_E) + (size_t)drow * D + k0; }
    else { const float* W = e < NE ? wd + (size_t)e * EH * D : sd; const int kb = it >> 6, nb = it & 63, n0 = nb * 32, k0 = kb * 64;
        x.src = W + (size_t)k0 * D + n0; x.N = D; x.ldk = EH; x.dst = (bf16*)(ws + WS_WDN + (size_t)e * WDN_E) + (size_t)n0 * EH + k0; }
}
__device__ __forceinline__ void xp_load(const XItem& x, int lane, f32x4 (&v)[8]) {
    const int kk = lane >> 3, nn = (lane & 7) * 4;
#pragma unroll
    for (int i = 0; i < 8; ++i) v[i] = __builtin_nontemporal_load((const f32x4*)(x.src + (size_t)(kk + 8 * i) * x.N + nn));
}
__device__ __forceinline__ void xp_store(const XItem& x, const f32x4 (&v)[8], LAS float* scr, int lane) {
    const int kk = lane >> 3, nn = (lane & 7) * 4;
#pragma unroll
    for (int i = 0; i < 8; ++i) { LAS float* s = scr + (kk + 8 * i) * 33 + nn; s[0] = v[i][0]; s[1] = v[i][1]; s[2] = v[i][2]; s[3] = v[i][3]; }
    LDS_WAIT(); asm volatile("" ::: "memory");
    const int c = lane & 7;
#pragma unroll
    for (int j = 0; j < 4; ++j) { const int n = (lane >> 3) + 8 * j; const LAS float* s = scr + (8 * c) * 33 + n;
        v4u o; o.x = pk2(s[0 * 33], s[1 * 33]); o.y = pk2(s[2 * 33], s[3 * 33]); o.z = pk2(s[4 * 33], s[5 * 33]); o.w = pk2(s[6 * 33], s[7 * 33]);
        __builtin_nontemporal_store(o, (v4u*)(x.dst + (size_t)n * x.ldk + 8 * c)); }
    LDS_WAIT(); asm volatile("" ::: "memory");
}
__device__ __forceinline__ void cvt_experts(const Frame& F, const float* wg, const float* wu, const float* wd, const float* sg, const float* su, const float* sd, unsigned char* ws, unsigned& gbase) {
    (void)gbase;
    LAS float* scr = (LAS float*)(F.lds + RING_OFF + F.wave * 8704);
    const int total = (NE + 1) * 1536;
    XItem A, B; f32x4 va[8], vb[8];
    int I = F.gw;
    if (I < total) { xp_decode(I, wg, wu, wd, sg, su, sd, ws, A); xp_load(A, F.lane, va); }
    for (; I < total; I += 2 * F.NGW) {
        const int I2 = I + F.NGW, I3 = I + 2 * F.NGW;
        if (I2 < total) { xp_decode(I2, wg, wu, wd, sg, su, sd, ws, B); xp_load(B, F.lane, vb); }
        xp_store(A, va, scr, F.lane);
        if (I2 < total) { if (I3 < total) { xp_decode(I3, wg, wu, wd, sg, su, sd, ws, A); xp_load(A, F.lane, va); }
            xp_store(B, vb, scr, F.lane); }
    }
}
constexpr int NVO_OFF = MISC_OFF + 1024;  static_assert(NVO_OFF == pg8::PG8_NVO_OFF, "nvo");
constexpr int PLAN_OFF = NVO_OFF + 8192;
constexpr int PLAN_TB = PLAN_OFF, PLAN_CN = PLAN_OFF + 66 * 4, PLAN_TE = PLAN_OFF + 132 * 4;
constexpr int MAXTILES = 640;
#ifndef ROUTE_PROBE
#define ROUTE_PROBE 0
#endif
static_assert(PLAN_TE + MAXTILES * 4 <= LDS_BYTES, "LDS map");

__device__ __forceinline__ float wave_sum(float v, int lane) {
#pragma unroll
    for (int o = 1; o < 64; o <<= 1) v += shx(v, o, lane);
    return v;
}
__device__ __forceinline__ void moe_plan(const Frame& F, const unsigned* cnt) {
    LAS unsigned* tb = (LAS unsigned*)(F.lds + PLAN_TB); LAS unsigned* cn = (LAS unsigned*)(F.lds + PLAN_CN); LAS unsigned* te = (LAS unsigned*)(F.lds + PLAN_TE);
    __syncthreads();
    if (F.wave == 0) {
        const unsigned c = __hip_atomic_load(cnt + F.lane, RLX_AGENT); const unsigned t = (c + 255u) >> 8; unsigned inc = t;
#pragma unroll
        for (int o = 1; o < 64; o <<= 1) { const unsigned v = (unsigned)__builtin_amdgcn_ds_bpermute((F.lane - o) << 2, (int)inc); if (F.lane >= o) inc += v; }
        tb[F.lane] = inc - t; cn[F.lane] = c;
        if (F.lane == 63) { tb[NE] = inc; cn[NE] = (unsigned)NTOK; tb[NE + 1] = inc + NTOK / 256; } }
    __syncthreads();
    for (int t = F.tid; t < MAXTILES; t += NWAVES * 64) { unsigned e = 0; for (int q = 1; q <= NE; ++q) if (tb[q] <= (unsigned)t) e = q; te[t] = e; }
    __syncthreads();
}
template <bool GU> struct MoeSched { static constexpr bool GATHER = GU;
    const LAS unsigned* tb; const LAS unsigned* cn; const LAS unsigned* te; int nunits, nN, G, c; const char* Abase; const char* Bbase; const int* list;
    __device__ __forceinline__ void init(const Frame& F, const void* A_, const void* B_, const int* list_) {
        tb = (const LAS unsigned*)(F.lds + PLAN_TB); cn = (const LAS unsigned*)(F.lds + PLAN_CN); te = (const LAS unsigned*)(F.lds + PLAN_TE);
        nN = GU ? 4 : 8; nunits = (int)tb[NE + 1] * nN; G = F.G; const int bx = blockIdx.x; c = (G % 8 == 0) ? (bx % 8) * (G / 8) + bx / 8 : bx;
        Abase = (const char*)A_; Bbase = (const char*)B_; list = list_; }
    __device__ __forceinline__ bool next(int i, Unit& u) const {
        constexpr int RUN = GU ? 2 : 1; const int hs = c + G * (i / RUN), per = nN / RUN;
        const int tile = hs / per, pn = (hs % per) * RUN + (i % RUN); if (tile * nN >= nunits) return false;
        const int e = (int)te[tile];
        u.pm = tile; u.pn = pn;
        if (GU) { u.A = Abase; u.B = Bbase + (size_t)e * WGU_E + (size_t)pn * 256 * D * 2; u.list = e < NE ? list + (size_t)e * LISTCAP : nullptr; u.m0 = (tile - (int)tb[e]) * 256; u.cnt = (int)cn[e]; }
        else { u.A = Abase + (size_t)tile * 256 * EH * 2; u.B = Bbase + (size_t)e * WDN_E + (size_t)pn * 256 * EH * 2; u.list = nullptr; u.m0 = 0; u.cnt = 0; }
        return true; }
    __device__ __forceinline__ int avload(const Unit& u, int h, int R) const { const int pos = u.m0 + h * 128 + R; const int pc = pos < u.cnt ? pos : (u.cnt > 0 ? u.cnt - 1 : 0); const int* lp = u.list ? u.list : list; return lp[pc]; }
    __device__ __forceinline__ unsigned avfin(const Unit& u, int h, int R, int C, int K_, int v) const { const int pos = u.m0 + h * 128 + R; int row = u.list ? v : pos; row = pos < u.cnt ? row : 0; return (unsigned)((row * K_ + C) * 2); }
    __device__ __forceinline__ unsigned avoff(const Unit& u, int h, int R, int C, int K_) const {
        if (GU) return avfin(u, h, R, C, K_, avload(u, h, R));
        else return (unsigned)(((h * 128 + R) * K_ + C) * 2); }
};
struct EpiSwiGLU { static constexpr bool PERM = true, INPLACE = false; bf16* H;
    __device__ __forceinline__ void operator()(const Acc& acc, const Unit& u, int wr, int wc, int fr, int fq) const {
        const int row0 = u.pm * 256 + wr * 64 + fr, col0 = u.pn * 128 + wc * 32 + 8 * fq;
#pragma unroll
        for (int ai = 0; ai < 2; ++ai)
#pragma unroll
            for (int m = 0; m < 4; ++m) { bf16* rowp = H + (size_t)(row0 + ai * 128 + m * 16) * EH + col0;
                float hv[8];
#pragma unroll
                for (int n = 0; n < 2; ++n)
#pragma unroll
                    for (int j = 0; j < 4; ++j) { const float g = acc[ai][0][m][n][j], uu = acc[ai][1][m][n][j]; hv[n * 4 + j] = g * pg8::sigmoidf_(g) * uu; }
                v4u w; w.x = pk2(hv[0], hv[1]); w.y = pk2(hv[2], hv[3]); w.z = pk2(hv[4], hv[5]); w.w = pk2(hv[6], hv[7]);
                *(v4u*)rowp = w; }
    }
};

struct EpiY8 { static constexpr bool PERM = true, INPLACE = false; unsigned char* Y8; bf16* YS;
    __device__ __forceinline__ void operator()(const Acc& acc, const Unit& u, int wr, int wc, int fr, int fq) const {
        const int row0 = u.pm * 256 + wr * 64 + fr, pos0 = u.pn * 256 + wc * 64 + fq * 16;
#pragma unroll
        for (int ai = 0; ai < 2; ++ai)
#pragma unroll
            for (int m = 0; m < 4; ++m) { const size_t row = (size_t)(row0 + ai * 128 + m * 16);
                v4u w; unsigned sw = 0u;
#pragma unroll
                for (int bj = 0; bj < 2; ++bj) { const f32x4 v0 = acc[ai][bj][m][0], v1 = acc[ai][bj][m][1];
                    const float am = fmaxf(fmaxf(fmaxf(fabsf(v0[0]), fabsf(v0[1])), fmaxf(fabsf(v0[2]), fabsf(v0[3]))), fmaxf(fmaxf(fabsf(v1[0]), fabsf(v1[1])), fmaxf(fabsf(v1[2]), fabsf(v1[3]))));
                    const unsigned sb = f2bf(am * (1.f / 127.f)); const float sc = __uint_as_float(sb << 16); const float inv = sc > 0.f ? __builtin_amdgcn_rcpf(sc) : 0.f;
                    unsigned q[8];
#pragma unroll
                    for (int j = 0; j < 4; ++j) { q[j] = (unsigned)fminf(rintf(v0[j] * inv + 128.f), 255.f); q[4 + j] = (unsigned)fminf(rintf(v1[j] * inv + 128.f), 255.f); }
                    const unsigned lo = q[0] | (q[1] << 8) | (q[2] << 16) | (q[3] << 24), hi = q[4] | (q[5] << 8) | (q[6] << 16) | (q[7] << 24);
                    if (bj == 0) { w.x = lo; w.y = hi; sw = sb; } else { w.z = lo; w.w = hi; sw |= sb << 16; } }
                *(v4u*)(Y8 + row * D + pos0) = w; *(unsigned*)(YS + row * (D / 8) + (pos0 >> 3)) = sw; }
    }
};
__device__ __forceinline__ void route_phase(const Frame& F, const bf16* __restrict__ Z, const float* __restrict__ g, const float* __restrict__ bb, const bf16* __restrict__ rwh, const float* __restrict__ rb,
                                            bf16* __restrict__ X1L, bf16* __restrict__ X1BF, unsigned* cnt, int* list, int* tokslot, float* tokw, bool dispatch = true) {
    LAS float* part = (LAS float*)(F.lds + RING_OFF);
    LAS float* lg = part + 4 * 4096;
    LAS float* sl = lg + 64 * 65;
    LAS unsigned* cntL = (LAS unsigned*)(sl + 64 * 65);
    LAS unsigned* baseL = cntL + 64;
    LAS unsigned* ee = baseL + 64;
    LAS unsigned* pl = ee + 512;
    LAS float* ww = (LAS float*)(pl + 512);
    for (int grp = blockIdx.x; grp < NTOK / 64; grp += F.G) {
        const int t0 = grp * 64;
        if (F.tid < 64) cntL[F.tid] = 0u;
        for (int rp_ = 0; rp_ < (ROUTE_PROBE == 1 ? 2 : 1); ++rp_)
#pragma unroll 2
        for (int q = 0; q < 8; ++q) {
            const int t = t0 + F.wave * 8 + q;
            const v2u* zr = (const v2u*)(Z + (size_t)t * D) + F.lane;
            f32x4 v[8]; float s = 0.f;
#pragma unroll
            for (int j = 0; j < 8; ++j) { const v2u zw = zr[64 * j]; v[j] = (f32x4){pg8::bf_lo(zw.x), pg8::bf_hi(zw.x), pg8::bf_lo(zw.y), pg8::bf_hi(zw.y)}; s += (v[j][0] + v[j][1]) + (v[j][2] + v[j][3]); }
            const float mean = wave_sum(s, F.lane) * (1.f / D); float s2 = 0.f;
#pragma unroll
            for (int j = 0; j < 8; ++j) { v[j] = v[j] - mean; s2 += (v[j][0] * v[j][0] + v[j][1] * v[j][1]) + (v[j][2] * v[j][2] + v[j][3] * v[j][3]); }
            const float rstd = 1.f / sqrtf(wave_sum(s2, F.lane) * (1.f / D) + LN_EPS);
            v2u* xl = (v2u*)(X1L + (size_t)t * D) + F.lane; v2u* xb = (v2u*)(X1BF + (size_t)t * D) + F.lane;
#pragma unroll
            for (int j = 0; j < 8; ++j) { const f32x4 gg = ((const f32x4*)g)[F.lane + 64 * j], bv = ((const f32x4*)bb)[F.lane + 64 * j];
                const f32x4 y = v[j] * rstd * gg + bv; v2u w; w.x = pk2(y[0], y[1]); w.y = pk2(y[2], y[3]); xb[64 * j] = w;
                v2u lo; lo.x = pk2(y[0] - pg8::bf_lo(w.x), y[1] - pg8::bf_hi(w.x)); lo.y = pk2(y[2] - pg8::bf_lo(w.y), y[3] - pg8::bf_hi(w.y)); xl[64 * j] = lo; }
        }
        VM_WAIT(); __syncthreads();
        for (int rp_ = 0; rp_ < (ROUTE_PROBE == 2 ? 2 : 1); ++rp_)
        { const int r = F.lane & 15, kq = F.lane >> 4, kb = (F.wave & 3) * 512, th = F.wave >> 2;
          const bf16* xh = X1BF + (size_t)(t0 + th * 32 + r) * D + kb + 8 * kq;
          const bf16* xl = X1L + (size_t)(t0 + th * 32 + r) * D + kb + 8 * kq;
          const bf16* wh = rwh + (size_t)r * D + kb + 8 * kq;
          f32x4 acc[2][4];
#pragma unroll
          for (int tt = 0; tt < 2; ++tt)
#pragma unroll
              for (int nb = 0; nb < 4; ++nb) acc[tt][nb] = (f32x4){0.f, 0.f, 0.f, 0.f};
          bf16x8 xA[2][2], xB[2][2]; bf16x8 hA[4], lA[4], hB[4], lB[4];
#define RT_LOAD(X, H, L, ks) do { const int k_ = ((ks) < 16 ? (ks) : 15) * 32; _Pragma("unroll") for (int tt = 0; tt < 2; ++tt) { X[tt][0] = *(const bf16x8*)(xh + (size_t)tt * 16 * D + k_); X[tt][1] = *(const bf16x8*)(xl + (size_t)tt * 16 * D + k_); } \
              _Pragma("unroll") for (int nb = 0; nb < 4; ++nb) { H[nb] = *(const bf16x8*)(wh + (size_t)nb * 16 * D + k_); L[nb] = *(const bf16x8*)(wh + (size_t)(64 + nb * 16) * D + k_); } } while (0)
#define RT_MMA(X, H, L) do { \
              _Pragma("unroll") for (int tt = 0; tt < 2; ++tt) _Pragma("unroll") for (int nb = 0; nb < 4; ++nb) acc[tt][nb] = __builtin_amdgcn_mfma_f32_16x16x32_bf16(X[tt][1], H[nb], acc[tt][nb], 0, 0, 0); \
              _Pragma("unroll") for (int tt = 0; tt < 2; ++tt) _Pragma("unroll") for (int nb = 0; nb < 4; ++nb) acc[tt][nb] = __builtin_amdgcn_mfma_f32_16x16x32_bf16(X[tt][0], L[nb], acc[tt][nb], 0, 0, 0); \
              _Pragma("unroll") for (int tt = 0; tt < 2; ++tt) _Pragma("unroll") for (int nb = 0; nb < 4; ++nb) acc[tt][nb] = __builtin_amdgcn_mfma_f32_16x16x32_bf16(X[tt][0], H[nb], acc[tt][nb], 0, 0, 0); } while (0)
          RT_LOAD(xA, hA, lA, 0);
#pragma unroll 1
          for (int ks = 0; ks < 16; ks += 2) {
              RT_LOAD(xB, hB, lB, ks + 1); RT_MMA(xA, hA, lA);
              RT_LOAD(xA, hA, lA, ks + 2); RT_MMA(xB, hB, lB);
          }
#undef RT_LOAD
#undef RT_MMA
#pragma unroll
          for (int tt = 0; tt < 2; ++tt)
#pragma unroll
              for (int nb = 0; nb < 4; ++nb)
#pragma unroll
                  for (int reg = 0; reg < 4; ++reg) part[(F.wave & 3) * 4096 + (th * 32 + tt * 16 + 4 * kq + reg) * 64 + nb * 16 + r] = acc[tt][nb][reg];
        }
        __syncthreads();
        for (int i = F.tid; i < 64 * 64; i += NWAVES * 64) { const int tk = i >> 6, e = i & 63; const float lgt = (part[i] + part[4096 + i]) + (part[8192 + i] + part[12288 + i]);
            const float sc = 1.f / (1.f + __expf(-lgt)); lg[tk * 65 + e] = sc; sl[tk * 65 + e] = sc + rb[e]; }
        __syncthreads();
        for (int rp_ = 0; rp_ < (ROUTE_PROBE == 3 ? 2 : 1); ++rp_)
        { const bool lastrp = (rp_ == (ROUTE_PROBE == 3 ? 1 : 0));
          const int tk = F.wave * 8 + (F.lane >> 3), gq = F.lane & 7, lane = F.lane;
          float sv[8], cv[8];
#pragma unroll
          for (int j = 0; j < 8; ++j) { sv[j] = sl[tk * 65 + gq * 8 + j]; cv[j] = lg[tk * 65 + gq * 8 + j]; }
          float m1 = -INFINITY, m2 = -INFINITY;
#pragma unroll
          for (int j = 0; j < 8; ++j) { const float x = sv[j]; const bool g1 = x > m1; m2 = g1 ? m1 : fmaxf(m2, x); m1 = g1 ? x : m1; }
          const float gs = m1 + m2;
          int rank = 0;
#pragma unroll
          for (int o = 1; o < 8; ++o) { const float og = shx(gs, o, lane); const int oq = gq ^ o; rank += (og > gs || (og == gs && oq < gq)) ? 1 : 0; }
          const bool gsel = rank < 4;
          unsigned used = gsel ? 0u : 0xffu;
          float wsum = 0.f; float my_sc = 0.f; int my_e = 0;
#pragma unroll
          for (int i = 0; i < 8; ++i) {
              float bv = -INFINITY, bs = 0.f; int be = 64;
#pragma unroll
              for (int j = 0; j < 8; ++j) { const bool ok = !((used >> j) & 1u) && sv[j] > bv; bv = ok ? sv[j] : bv; bs = ok ? cv[j] : bs; be = ok ? gq * 8 + j : be; }
#pragma unroll
              for (int o = 1; o < 8; o <<= 1) { const float ov = shx(bv, o, lane), os = shx(bs, o, lane); const int oe = __float_as_int(shx(__int_as_float(be), o, lane));
                  const bool tk_o = ov > bv || (ov == bv && oe < be); bv = tk_o ? ov : bv; bs = tk_o ? os : bs; be = tk_o ? oe : be; }
              if ((be >> 3) == gq) used |= 1u << (be & 7);
              wsum += bs; if (gq == i) { my_sc = bs; my_e = be; }
          }
          const int slot = tk * 8 + gq;
          ee[slot] = (unsigned)my_e; ww[slot] = my_sc * (RSCALE / wsum);
          pl[slot] = __hip_atomic_fetch_add(cntL + my_e, (dispatch && lastrp) ? 1u : 0u, __ATOMIC_RELAXED, __HIP_MEMORY_SCOPE_WORKGROUP);
        }
        __syncthreads();
        if (F.tid < 64) { const unsigned n = cntL[F.tid]; baseL[F.tid] = n ? __hip_atomic_fetch_add(cnt + F.tid, n, RLX_AGENT) : 0u; }
        __syncthreads();
        if (dispatch) { const int tk = F.tid >> 3, i = F.tid & 7; const unsigned e = ee[F.tid]; const unsigned pos = baseL[e] + pl[F.tid]; const int t = t0 + tk;
          list[(size_t)e * LISTCAP + pos] = t; tokslot[t * 8 + i] = (int)(e * LISTCAP + pos); tokw[t * 8 + i] = ww[F.tid]; }
        __syncthreads();
    }
}
__device__ __forceinline__ void combine_phase(const Frame& F, const bf16* X1B, const unsigned char* Y8, const bf16* YS, const int* tokslot, const float* tokw, const float* g, const float* bb, float* OUT, bf16* XBF, bool last) {
    const LAS unsigned* tb = (const LAS unsigned*)(F.lds + PLAN_TB);
    LAS int* rw = (LAS int*)(F.lds + RING_OFF) + F.wave * 32;
#define CB_LOAD(W, S, ROW) do { const int r_ = __builtin_amdgcn_readfirstlane(ROW); const v2u* yr_ = (const v2u*)(Y8 + (size_t)r_ * D) + F.lane; const bf16* ys_ = YS + (size_t)r_ * (D / 8) + F.lane; \
        _Pragma("unroll") for (int j = 0; j < 4; ++j) { W[j] = yr_[64 * j]; S[j] = ys_[64 * j]; } } while (0)
#define CB_ACC(W, S, WT) do { const float wt_ = __int_as_float(__builtin_amdgcn_readfirstlane(WT)); _Pragma("unroll") for (int j = 0; j < 4; ++j) { const float sc = bf2f(S[j]) * wt_, c0 = -128.f * sc; const unsigned x = W[j].x, y = W[j].y; \
        v[j][0] += sc * (float)(x & 255u) + c0; v[j][1] += sc * (float)((x >> 8) & 255u) + c0; v[j][2] += sc * (float)((x >> 16) & 255u) + c0; v[j][3] += sc * (float)(x >> 24) + c0; \
        v[j][4] += sc * (float)(y & 255u) + c0; v[j][5] += sc * (float)((y >> 8) & 255u) + c0; v[j][6] += sc * (float)((y >> 16) & 255u) + c0; v[j][7] += sc * (float)(y >> 24) + c0; } } while (0)
    const int cl = (F.lane >> 5) * 256 + (F.lane & 1) * 128 + ((F.lane >> 3) & 3) * 32 + ((F.lane >> 1) & 3) * 8;
    for (int t = F.gw; t < NTOK; t += F.NGW) {
        if (F.lane < 8) { const int sl = tokslot[t * 8 + F.lane]; rw[F.lane] = (int)tb[sl / LISTCAP] * 256 + (sl % LISTCAP); rw[16 + F.lane] = __float_as_int(tokw[t * 8 + F.lane]); }
        if (F.lane == 8) { rw[8] = (int)tb[NE] * 256 + t; rw[24] = __float_as_int(1.f); }
        LDS_WAIT(); asm volatile("" ::: "memory");
        float v[4][8]; float s = 0.f;
        v2u wa[4], wb[4], wc[4]; bf16 sa[4], sb2[4], sc2[4];
        CB_LOAD(wa, sa, rw[0]); CB_LOAD(wb, sb2, rw[1]); CB_LOAD(wc, sc2, rw[2]);
#pragma unroll
        for (int j = 0; j < 4; ++j) { const v4u xw = *(const v4u*)(X1B + (size_t)t * D + 512 * j + cl);
            v[j][0] = pg8::bf_lo(xw.x) * ALPHA; v[j][1] = pg8::bf_hi(xw.x) * ALPHA; v[j][2] = pg8::bf_lo(xw.y) * ALPHA; v[j][3] = pg8::bf_hi(xw.y) * ALPHA;
            v[j][4] = pg8::bf_lo(xw.z) * ALPHA; v[j][5] = pg8::bf_hi(xw.z) * ALPHA; v[j][6] = pg8::bf_lo(xw.w) * ALPHA; v[j][7] = pg8::bf_hi(xw.w) * ALPHA; }
#pragma unroll 1
        for (int i = 0; i < 9; i += 3) {
            CB_ACC(wa, sa, rw[16 + i]); if (i < 6) CB_LOAD(wa, sa, rw[i + 3]);
            CB_ACC(wb, sb2, rw[17 + i]); if (i < 6) CB_LOAD(wb, sb2, rw[i + 4]);
            CB_ACC(wc, sc2, rw[18 + i]); if (i < 6) CB_LOAD(wc, sc2, rw[i + 5]);
        }
        asm volatile("" ::: "memory");
#pragma unroll
        for (int j = 0; j < 4; ++j)
#pragma unroll
            for (int e = 0; e < 8; ++e) s += v[j][e];
        const float mean = wave_sum(s, F.lane) * (1.f / D); float s2 = 0.f;
#pragma unroll
        for (int j = 0; j < 4; ++j)
#pragma unroll
            for (int e = 0; e < 8; ++e) { v[j][e] -= mean; s2 += v[j][e] * v[j][e]; }
        const float rstd = 1.f / sqrtf(wave_sum(s2, F.lane) * (1.f / D) + LN_EPS);
#pragma unroll
        for (int j = 0; j < 4; ++j) { const int c0 = cl + 512 * j; const f32x4 g0 = *(const f32x4*)(g + c0), g1 = *(const f32x4*)(g + c0 + 4), b0 = *(const f32x4*)(bb + c0), b1 = *(const f32x4*)(bb + c0 + 4);
            f32x4 y0, y1;
#pragma unroll
            for (int e = 0; e < 4; ++e) { y0[e] = v[j][e] * rstd * g0[e] + b0[e]; y1[e] = v[j][4 + e] * rstd * g1[e] + b1[e]; }
            if (last) { *(f32x4*)(OUT + (size_t)t * D + c0) = y0; *(f32x4*)(OUT + (size_t)t * D + c0 + 4) = y1; }
            else { v4u w; w.x = pk2(y0[0], y0[1]); w.y = pk2(y0[2], y0[3]); w.z = pk2(y1[0], y1[1]); w.w = pk2(y1[2], y1[3]); *(v4u*)(XBF + (size_t)t * D + c0) = w; } }
    }
#undef CB_LOAD
#undef CB_ACC
}
constexpr size_t R2_UT = 0, R2_OI = 48 * MiB, R2_QP = 96 * MiB, R2_DEC = 120 * MiB;
constexpr int NHU = NB * HGH * (SEQ / 64);
typedef __attribute__((address_space(3))) bf16 lbf16;
__device__ __forceinline__ void unpack8(const v4u w, float (&f)[8]) {
    f[0] = pg8::bf_lo(w.x); f[1] = pg8::bf_hi(w.x); f[2] = pg8::bf_lo(w.y); f[3] = pg8::bf_hi(w.y); f[4] = pg8::bf_lo(w.z); f[5] = pg8::bf_hi(w.z); f[6] = pg8::bf_lo(w.w); f[7] = pg8::bf_hi(w.w); }
__device__ __forceinline__ float exp_c(float x) { return __expf(fminf(x, 80.f)); }

__device__ __forceinline__ void conv_part(const Frame& F, const bf16* proj, const float* cw, bf16* YA, bf16* YX) {
    for (int i = blockIdx.x * 512 + F.tid; i < NTOK * 32; i += F.G * 512) *(v4u*)(YX + (size_t)(i >> 5) * YXW + XAW + (i & 31) * 8) = (v4u){0u, 0u, 0u, 0u};
    for (int i = blockIdx.x * 512 + F.tid; i < NTOK * (CW / 8); i += F.G * 512) {
        const int t = i / (CW / 8), c = (i % (CW / 8)) * 8, pos = t & (SEQ - 1);
        const bf16* r = proj + (size_t)t * INC;
        float u0[8], c0[8], b0[8], u1[8], c1[8], u2[8], c2[8], w0[8], w1[8], w2[8];
        unpack8(*(const v4u*)(r + C_U + c), u0); unpack8(*(const v4u*)(r + C_C + c), c0); unpack8(*(const v4u*)(r + C_B + c), b0);
        const v4u z4 = {0u, 0u, 0u, 0u};
        unpack8(pos >= 1 ? *(const v4u*)(r - INC + C_U + c) : z4, u1); unpack8(pos >= 1 ? *(const v4u*)(r - INC + C_C + c) : z4, c1);
        unpack8(pos >= 2 ? *(const v4u*)(r - 2 * INC + C_U + c) : z4, u2); unpack8(pos >= 2 ? *(const v4u*)(r - 2 * INC + C_C + c) : z4, c2);
#pragma unroll
        for (int j = 0; j < 8; ++j) { w0[j] = cw[c + j]; w1[j] = cw[CW + c + j]; w2[j] = cw[2 * CW + c + j]; }
        float o[8];
#pragma unroll
        for (int j = 0; j < 8; ++j) o[j] = b0[j] * (w2[j] * c0[j] * u0[j] + w1[j] * c1[j] * u1[j] + w0[j] * c2[j] * u2[j]);
        v4u w; w.x = pk2(o[0], o[1]); w.y = pk2(o[2], o[3]); w.z = pk2(o[4], o[5]); w.w = pk2(o[6], o[7]);
        *(v4u*)(YA + (size_t)t * CW + c) = w;
    }
}

__device__ __forceinline__ void hgrn_local(const Frame& F, const bf16* proj, const float* lbl, int layer, unsigned char* r2) {
    lbf16* QS = (lbf16*)(F.lds);
    lbf16* KS = QS + 64 * 136;
    lbf16* KPT = KS + 64 * 136;
    lbf16* VT = KPT + 128 * 72;
    lbf16* PS = VT + 128 * 72;
    LAS float* SEG = (LAS float*)(PS + 64 * 72);
    bf16* UT = (bf16*)(r2 + R2_UT); bf16* OI = (bf16*)(r2 + R2_OI); bf16* QP = (bf16*)(r2 + R2_QP); float* DEC = (float*)(r2 + R2_DEC);
    const int lane = F.lane, wv = F.wave, r = lane & 15, kq = lane >> 4;
    bf16 rf[16], rq[16], rv[16];
#define HL_LOAD(U) do { const int b_ = (U) / (HGH * 64), h_ = ((U) / 64) % HGH, c_ = (U) % 64; const bf16* p_ = proj + (size_t)(b_ * SEQ + c_ * 64 + (F.tid >> 7) * 16) * INC + h_ * HGD + (F.tid & 127); \
        _Pragma("unroll") for (int i = 0; i < 16; ++i) { rf[i] = p_[(size_t)i * INC + C_F]; rq[i] = p_[(size_t)i * INC + C_Q]; rv[i] = p_[(size_t)i * INC + C_I]; } } while (0)
    if ((int)blockIdx.x < NHU) HL_LOAD((int)blockIdx.x);
    for (int unit = blockIdx.x; unit < NHU; unit += F.G) {
        const int b = unit / (HGH * 64), h = (unit / 64) % HGH, c = unit % 64, t0 = b * SEQ + c * 64;
        { const int col = F.tid & 127, seg = F.tid >> 7, ch = h * HGD + col;
          float lb = 0.f; if (layer == 1) lb = 1.f / (1.f + __expf(lbl[ch] - lbl[HGW + ch]));
          float a[16], kk[16], qv[16], vv[16]; float run = 0.f;
#pragma unroll
          for (int i = 0; i < 16; ++i) {
              const float z = bf2f(rf[i]); const float ez = __expf(-z); const float sg = 1.f / (1.f + ez);
              const float f = lb + (1.f - lb) * sg; kk[i] = (1.f - lb) * ez * sg; run += fmaxf(__logf(f), -60.f); a[i] = run;
              qv[i] = bf2f(rq[i]); vv[i] = bf2f(rv[i]); }
          if (unit + F.G < NHU) HL_LOAD(unit + F.G);
          SEG[seg * 128 + col] = run;
          __syncthreads();
          const float s0 = SEG[col], s1 = SEG[128 + col], s2 = SEG[256 + col], s3 = SEG[384 + col];
          const float base = seg == 0 ? 0.f : (seg == 1 ? s0 : (seg == 2 ? s0 + s1 : s0 + s1 + s2)), bm = s0 + s1, bl = (s0 + s1) + (s2 + s3);
          float kp[16];
#pragma unroll
          for (int i = 0; i < 16; ++i) { const float bb = base + a[i]; const int t = seg * 16 + i;
              QS[t * 136 + col] = f2bf(qv[i] * exp_c(bb - bm)); KS[t * 136 + col] = f2bf(kk[i] * exp_c(bm - bb)); kp[i] = kk[i] * exp_c(bl - bb);
              QP[(size_t)(t0 + t) * HGW + ch] = f2bf(qv[i] * exp_c(bb)); }
          v4u w0, w1; w0.x = pk2(kp[0], kp[1]); w0.y = pk2(kp[2], kp[3]); w0.z = pk2(kp[4], kp[5]); w0.w = pk2(kp[6], kp[7]); w1.x = pk2(kp[8], kp[9]); w1.y = pk2(kp[10], kp[11]); w1.z = pk2(kp[12], kp[13]); w1.w = pk2(kp[14], kp[15]);
          *(LAS v4u*)(KPT + col * 72 + seg * 16) = w0; *(LAS v4u*)(KPT + col * 72 + seg * 16 + 8) = w1;
          w0.x = pk2(vv[0], vv[1]); w0.y = pk2(vv[2], vv[3]); w0.z = pk2(vv[4], vv[5]); w0.w = pk2(vv[6], vv[7]); w1.x = pk2(vv[8], vv[9]); w1.y = pk2(vv[10], vv[11]); w1.z = pk2(vv[12], vv[13]); w1.w = pk2(vv[14], vv[15]);
          *(LAS v4u*)(VT + col * 72 + seg * 16) = w0; *(LAS v4u*)(VT + col * 72 + seg * 16 + 8) = w1;
          if (seg == 0) DEC[(size_t)unit * 128 + col] = exp_c(bl);
        }
        __syncthreads();
        { const int tm = wv >> 1, tn0 = (wv & 1) * 2;
          bf16x8 af[4];
#pragma unroll
          for (int ks = 0; ks < 4; ++ks) af[ks] = *(const LAS bf16x8*)(QS + (tm * 16 + r) * 136 + ks * 32 + kq * 8);
#pragma unroll
          for (int jn = 0; jn < 2; ++jn) { const int tn = tn0 + jn; f32x4 acc = {0.f, 0.f, 0.f, 0.f};
              if (tn <= tm) {
#pragma unroll
                  for (int ks = 0; ks < 4; ++ks) { const bf16x8 bf = *(const LAS bf16x8*)(KS + (tn * 16 + r) * 136 + ks * 32 + kq * 8); acc = __builtin_amdgcn_mfma_f32_16x16x32_bf16(af[ks], bf, acc, 0, 0, 0); } }
#pragma unroll
              for (int g = 0; g < 4; ++g) { const int t = tm * 16 + 4 * kq + g, s = tn * 16 + r; PS[t * 72 + s] = f2bf(s <= t ? acc[g] : 0.f); } } }
        { bf16x8 af[2];
#pragma unroll
          for (int ks = 0; ks < 2; ++ks) af[ks] = *(const LAS bf16x8*)(KPT + (wv * 16 + r) * 72 + ks * 32 + kq * 8);
#pragma unroll
          for (int tv = 0; tv < 8; ++tv) { f32x4 acc = {0.f, 0.f, 0.f, 0.f};
#pragma unroll
              for (int ks = 0; ks < 2; ++ks) { const bf16x8 bf = *(const LAS bf16x8*)(VT + (tv * 16 + r) * 72 + ks * 32 + kq * 8); acc = __builtin_amdgcn_mfma_f32_16x16x32_bf16(af[ks], bf, acc, 0, 0, 0); }
              v2u w; w.x = pk2(acc[0], acc[1]); w.y = pk2(acc[2], acc[3]);
              *(v2u*)(UT + (size_t)unit * 16384 + (tv * 16 + r) * 128 + wv * 16 + 4 * kq) = w; } }
        __syncthreads();
        { const int tm = wv & 3, tvg = wv >> 2;
          bf16x8 pf[2];
#pragma unroll
          for (int ks = 0; ks < 2; ++ks) pf[ks] = *(const LAS bf16x8*)(PS + (tm * 16 + r) * 72 + ks * 32 + kq * 8);
#pragma unroll
          for (int j = 0; j < 4; ++j) { const int tv = tvg * 4 + j; f32x4 acc = {0.f, 0.f, 0.f, 0.f};
#pragma unroll
              for (int ks = 0; ks < 2; ++ks) { const bf16x8 vf = *(const LAS bf16x8*)(VT + (tv * 16 + r) * 72 + ks * 32 + kq * 8); acc = __builtin_amdgcn_mfma_f32_16x16x32_bf16(vf, pf[ks], acc, 0, 0, 0); }
              v2u ow; ow.x = pk2(acc[0], acc[1]); ow.y = pk2(acc[2], acc[3]); *(v2u*)(OI + (size_t)(t0 + tm * 16 + r) * HGW + h * HGD + tv * 16 + 4 * kq) = ow; } }
        __syncthreads();
    }
#undef HL_LOAD
}
__device__ __forceinline__ void hgrn_scan(const Frame& F, const unsigned char* r2, v2u* __restrict__ SB64) {
    const v2u* __restrict__ UT64 = (const v2u*)(r2 + R2_UT); const f32x4* __restrict__ DEC4 = (const f32x4*)(r2 + R2_DEC);
    for (int it = blockIdx.x * 512 + F.tid; it < NB * HGH * 128 * 32; it += F.G * 512) {
        const int bh = it >> 12, v = (it >> 5) & 127, k4 = it & 31;
        f32x4 s = {0.f, 0.f, 0.f, 0.f};
#pragma unroll 8
        for (int c = 0; c < 64; ++c) { const size_t unit = (size_t)bh * 64 + c; const size_t idx = unit * 4096 + v * 32 + k4;
            const v2u w = UT64[idx]; const f32x4 d = DEC4[unit * 32 + k4];
            v2u o; o.x = pk2(s[0], s[1]); o.y = pk2(s[2], s[3]); SB64[idx] = o;
            s[0] = d[0] * s[0] + pg8::bf_lo(w.x); s[1] = d[1] * s[1] + pg8::bf_hi(w.x); s[2] = d[2] * s[2] + pg8::bf_lo(w.y); s[3] = d[3] * s[3] + pg8::bf_hi(w.y); }
    }
}
struct HoutOps { bf16x8 af[4]; bf16x8 bfr[4][4]; };
__device__ __forceinline__ void hout_load(HoutOps& O, int unit, const bf16* proj, const bf16* OI, const bf16* QP, const bf16* SB, int r, int kq, int tm, int tvg) {
    const int b = unit / (HGH * 64), h = (unit / 64) % HGH, c = unit % 64, t0 = b * SEQ + c * 64;
#pragma unroll
    for (int ks = 0; ks < 4; ++ks) O.af[ks] = *(const bf16x8*)(QP + (size_t)(t0 + tm * 16 + r) * HGW + h * HGD + ks * 32 + kq * 8);
#pragma unroll
    for (int j = 0; j < 4; ++j)
#pragma unroll
        for (int ks = 0; ks < 4; ++ks) O.bfr[j][ks] = *(const bf16x8*)(SB + (size_t)unit * 16384 + ((tvg * 4 + j) * 16 + r) * 128 + ks * 32 + kq * 8);
}
__device__ __forceinline__ void hout_compute(const HoutOps& O, int unit, const bf16* proj, const bf16* OI, LAS float* SSQ, const float* gain, bf16* YB, int lane, int r, int kq, int tm, int tvg) {
    const int b = unit / (HGH * 64), h = (unit / 64) % HGH, c = unit % 64, t0 = b * SEQ + c * 64;
    const size_t t = (size_t)(t0 + tm * 16 + r);
    f32x4 oi[4]; v2u gtw[4];
#pragma unroll
    for (int j = 0; j < 4; ++j) { const int ch = h * HGD + (tvg * 4 + j) * 16 + 4 * kq; { const v2u ow = *(const v2u*)(OI + t * HGW + ch); oi[j] = (f32x4){pg8::bf_lo(ow.x), pg8::bf_hi(ow.x), pg8::bf_lo(ow.y), pg8::bf_hi(ow.y)}; } gtw[j] = *(const v2u*)(proj + t * INC + C_G + ch); }
    f32x4 acc[4]; float q = 0.f;
#pragma unroll
    for (int j = 0; j < 4; ++j) { acc[j] = (f32x4){0.f, 0.f, 0.f, 0.f};
#pragma unroll
        for (int ks = 0; ks < 4; ++ks) acc[j] = __builtin_amdgcn_mfma_f32_16x16x32_bf16(O.bfr[j][ks], O.af[ks], acc[j], 0, 0, 0); }
#pragma unroll
    for (int j = 0; j < 4; ++j) { acc[j] += oi[j]; q += (acc[j][0] * acc[j][0] + acc[j][1] * acc[j][1]) + (acc[j][2] * acc[j][2] + acc[j][3] * acc[j][3]); }
    q += shx(q, 16, lane); q += shx(q, 32, lane);
    if (kq == 0) SSQ[tvg * 64 + tm * 16 + r] = q;
    __syncthreads();
    const float rs = rsqrtf((SSQ[tm * 16 + r] + SSQ[64 + tm * 16 + r]) * (1.f / 128.f) + RMS_EPS);
#pragma unroll
    for (int j = 0; j < 4; ++j) { const int ch = h * HGD + (tvg * 4 + j) * 16 + 4 * kq; const f32x4 gn = *(const f32x4*)(gain + ch);
        const float g0 = pg8::bf_lo(gtw[j].x), g1 = pg8::bf_hi(gtw[j].x), g2 = pg8::bf_lo(gtw[j].y), g3 = pg8::bf_hi(gtw[j].y);
        v2u w; w.x = pk2(acc[j][0] * rs * gn[0] * g0 * pg8::sigmoidf_(g0), acc[j][1] * rs * gn[1] * g1 * pg8::sigmoidf_(g1));
        w.y = pk2(acc[j][2] * rs * gn[2] * g2 * pg8::sigmoidf_(g2), acc[j][3] * rs * gn[3] * g3 * pg8::sigmoidf_(g3));
        *(v2u*)(YB + t * HGW + ch) = w; }
    __syncthreads();
}
__device__ __forceinline__ void hgrn_out(const Frame& F, const bf16* proj, const unsigned char* r2, const bf16* SB, const float* gain, bf16* YB) {
    LAS float* SSQ = (LAS float*)F.lds;
    const bf16* OI = (const bf16*)(r2 + R2_OI); const bf16* QP = (const bf16*)(r2 + R2_QP);
    const int lane = F.lane, wv = F.wave, r = lane & 15, kq = lane >> 4, tm = wv & 3, tvg = wv >> 2;
    HoutOps A, B;
    int unit = blockIdx.x;
    if (unit < NHU) hout_load(A, unit, proj, OI, QP, SB, r, kq, tm, tvg);
    for (; unit < NHU; unit += 2 * F.G) {
        const int u2 = unit + F.G, u3 = unit + 2 * F.G;
        if (u2 < NHU) hout_load(B, u2, proj, OI, QP, SB, r, kq, tm, tvg);
        hout_compute(A, unit, proj, OI, SSQ, gain, YB, lane, r, kq, tm, tvg);
        if (u2 < NHU) { if (u3 < NHU) hout_load(A, u3, proj, OI, QP, SB, r, kq, tm, tvg);
            hout_compute(B, u2, proj, OI, SSQ, gain, YB, lane, r, kq, tm, tvg); }
    }
}
__device__ __forceinline__ void memattn(const Frame& F, const bf16* proj, const bf16* KV, int layer, bf16* YX) {
    lbf16* Ks = (lbf16*)F.lds;
    lbf16* VTs = Ks + 256 * 136;
    const int lane = F.lane, wv = F.wave, r = lane & 15, kq = lane >> 4;
    for (int unit = blockIdx.x; unit < NB * XAH * (SEQ / 256); unit += F.G) {
        const int b = unit >> 6, hd = (unit >> 4) & 3, qt = unit & 15;
#pragma unroll
        for (int i = 0; i < 8; ++i) { const int p = F.tid + 512 * i, key = p >> 4, dc = (p & 15) * 8;
            const bf16* src = KV + (size_t)(b * NMEM + key) * 2048 + layer * 1024 + hd * XAD + dc;
            *(LAS v4u*)(Ks + key * 136 + dc) = *(const v4u*)src;
            const v4u w = *(const v4u*)(src + 512);
            const int k5 = key & 31, pos = (key & ~31) + 8 * ((k5 >> 2) & 3) + 4 * ((k5 >> 4) & 1) + (k5 & 3);
            lbf16* d = VTs + dc * 264 + pos;
            d[0] = (bf16)(w.x & 0xffffu); d[264] = (bf16)(w.x >> 16); d[2 * 264] = (bf16)(w.y & 0xffffu); d[3 * 264] = (bf16)(w.y >> 16);
            d[4 * 264] = (bf16)(w.z & 0xffffu); d[5 * 264] = (bf16)(w.z >> 16); d[6 * 264] = (bf16)(w.w & 0xffffu); d[7 * 264] = (bf16)(w.w >> 16); }
        __syncthreads();
#pragma unroll 1
        for (int g = 0; g < 2; ++g) {
            const int t = b * SEQ + qt * 256 + wv * 32 + g * 16 + r;
            bf16x8 qf[4];
#pragma unroll
            for (int ks = 0; ks < 4; ++ks) qf[ks] = *(const bf16x8*)(proj + (size_t)t * INC + C_QX + hd * XAD + ks * 32 + kq * 8);
            f32x4 s[16];
#pragma unroll
            for (int kt = 0; kt < 16; ++kt) { s[kt] = (f32x4){0.f, 0.f, 0.f, 0.f};
#pragma unroll
                for (int ks = 0; ks < 4; ++ks) { const bf16x8 a = *(const LAS bf16x8*)(Ks + (kt * 16 + r) * 136 + ks * 32 + kq * 8); s[kt] = __builtin_amdgcn_mfma_f32_16x16x32_bf16(a, qf[ks], s[kt], 0, 0, 0); }
                if (kt & 1) __builtin_amdgcn_sched_barrier(0); }
            float m = -1e30f;
#pragma unroll
            for (int kt = 0; kt < 16; ++kt) m = fmaxf(m, fmaxf(fmaxf(s[kt][0], s[kt][1]), fmaxf(s[kt][2], s[kt][3])));
            m = fmaxf(m, shx(m, 16, lane)); m = fmaxf(m, shx(m, 32, lane));
            const float cs = 0.08838834764831845f * 1.4426950408889634f; float l = 0.f;
#pragma unroll
            for (int kt = 0; kt < 16; ++kt)
#pragma unroll
                for (int e = 0; e < 4; ++e) { const float p = __builtin_amdgcn_exp2f((s[kt][e] - m) * cs); s[kt][e] = p; l += p; }
            l += shx(l, 16, lane); l += shx(l, 32, lane);
            f32x4 o[8];
#pragma unroll
            for (int dt = 0; dt < 8; ++dt) o[dt] = (f32x4){0.f, 0.f, 0.f, 0.f};
#pragma unroll
            for (int j = 0; j < 8; ++j) {
                v4u pw; pw.x = pk2(s[2 * j][0], s[2 * j][1]); pw.y = pk2(s[2 * j][2], s[2 * j][3]); pw.z = pk2(s[2 * j + 1][0], s[2 * j + 1][1]); pw.w = pk2(s[2 * j + 1][2], s[2 * j + 1][3]);
                const bf16x8 pf = __builtin_bit_cast(bf16x8, pw);
#pragma unroll
                for (int dt = 0; dt < 8; ++dt) { const bf16x8 a = *(const LAS bf16x8*)(VTs + (dt * 16 + r) * 264 + j * 32 + kq * 8); o[dt] = __builtin_amdgcn_mfma_f32_16x16x32_bf16(a, pf, o[dt], 0, 0, 0); }
                __builtin_amdgcn_sched_barrier(0); }
            const float inv = 1.f / l;
#pragma unroll
            for (int dt = 0; dt < 8; ++dt) { v2u w; w.x = pk2(o[dt][0] * inv, o[dt][1] * inv); w.y = pk2(o[dt][2] * inv, o[dt][3] * inv);
                *(v2u*)(YX + (size_t)t * YXW + hd * XAD + dt * 16 + 4 * kq) = w; }
        }
        __syncthreads();
    }
}
struct Args { const float* in[24]; float* out; unsigned char* ws; int ph_lo, ph_hi, mask, pad; };
typedef const __attribute__((address_space(4))) Args* KArgs;
__device__ __forceinline__ KArgs kargs() { KArgs p = (KArgs)__builtin_amdgcn_kernarg_segment_ptr(); asm volatile("" : "+s"(p)); return p; }
#define WSP(T, off) ((T*)(ws + (off)))
__global__ void __launch_bounds__(NWAVES * 64, 2) mk_fwd(Args args) {
    extern __shared__ __attribute__((aligned(16))) unsigned char lds_raw[];
    Frame F0; F0.lds = (LAS unsigned char*)lds_raw; F0.tid = threadIdx.x; F0.lane = F0.tid & 63; F0.wave = __builtin_amdgcn_readfirstlane(F0.tid >> 6);
    F0.G = gridDim.x; F0.gw = blockIdx.x * NWAVES + F0.wave; F0.NGW = F0.G * NWAVES;
    volatile LAS unsigned* MISC = (volatile LAS unsigned*)(F0.lds + MISC_OFF);
    for (int u = F0.tid; u < (LDS_BYTES - MISC_OFF) / 4; u += NWAVES * 64) ((LAS unsigned*)(F0.lds + MISC_OFF))[u] = 0u;
    __syncthreads();
    const int lo = args.ph_lo, hi = args.ph_hi;
    const bool multi = (hi - lo) > 1;
    XcdBarrier bar; bar.bar = (unsigned*)(args.ws + WS_CTL) + CW_BAR; bar.x = 0; bar.st = nullptr;
    if (multi) bar = xcd_barrier_post((unsigned*)(args.ws + WS_CTL) + CW_BAR, MISC + 8);
#define IN(k) (kargs()->ph_lo <= (k) && (k) < kargs()->ph_hi)
#define SEAM(k) do { if (IN((k) + 1)) xcd_barrier(bar); } while (0)
#define PH_BEGIN KArgs ka = kargs(); unsigned char* ws = ka->ws; (void)ws; Frame F = F0; { int w_ = F0.wave; asm volatile("" : "+s"(w_)); F.wave = w_; F.gw = (int)blockIdx.x * NWAVES + w_; } F.lane = pg8::lane_id_opaque(); F.tid = F.wave * 64 + F.lane
    if (IN(PH_CVT)) {
        { PH_BEGIN;
        unsigned gb = 0;
        for (int l = 0; l < 2; ++l) {
            xpose_matrix(F, ka->in[2] + (size_t)l * D * INC, D, INC, (bf16*)(ws + WS_WIN_T + l * WIN_T_L), D, 0, gb);
            xpose_matrix(F, ka->in[4] + (size_t)l * CW * D, CW, D, (bf16*)(ws + WS_WBR_T + l * WBR_T_L), CW, 0, gb);
            xpose_matrix(F, ka->in[7] + (size_t)l * HGW * D, HGW, D, (bf16*)(ws + WS_WBR_T + l * WBR_T_L + 3 * MiB), HGW, 0, gb);
            xpose_matrix(F, ka->in[10] + (size_t)l * XAW * D, XAW, D, (bf16*)(ws + WS_WBR_T + l * WBR_T_L + 6 * MiB), YXW, 0, gb);
            for (int i = blockIdx.x * 512 + F.tid; i < D * 32; i += F.G * 512) *(v4u*)((bf16*)(ws + WS_WBR_T + l * WBR_T_L + 6 * MiB) + (size_t)(i >> 5) * YXW + XAW + (i & 31) * 8) = (v4u){0u, 0u, 0u, 0u};
            xpose_matrix(F, ka->in[11] + (size_t)l * D * D, D, D, (bf16*)(ws + WS_WO_T + l * WO_T_L), D, 0, gb);
            xpose_matrix(F, ka->in[8] + (size_t)l * D * XAW, D, XAW, (bf16*)(ws + WS_WKV_T) + (size_t)(l * 1024) * D, D, 0, gb);
            xpose_matrix(F, ka->in[9] + (size_t)l * D * XAW, D, XAW, (bf16*)(ws + WS_WKV_T) + (size_t)(l * 1024 + 512) * D, D, 0, gb);
        }
        cvt_router(F, ka->in[14], ws);
        cvt_rows(F, ka->in[0], WSP(bf16, WS_XBF), (size_t)NTOK * D / 8);
        cvt_rows(F, ka->in[1], WSP(bf16, WS_MEMBF), (size_t)NB * NMEM * D / 8);
        }
        SEAM(PH_CVT);
    }
    for (int l = 0; l < 2; ++l) {
        const int pb = PH_L0 + l * PH_PER_LAYER;
        if (IN(pb + P_INPROJ)) {
            { PH_BEGIN;
            const bool split = F.G == 256;
            const int oa = (int)blockIdx.x >> 3, ox = (int)blockIdx.x & 7; const bool conv = split && ox < 2;
            const int hrank = 2 * oa + ox, grank = oa;
            static_assert((256 - NCV) * GM_UNITS + NCV * CV_UNITS == (NTOK / 256) * (INC / 256), "in-projection unit shares");
            if (conv) { Frame Fc = F; Fc.gw = hrank * NWAVES + F.wave; Fc.NGW = NCV * NWAVES; unsigned gb = 0;
                cvt_experts(Fc, ka->in[16] + (size_t)l * NE * D * EH, ka->in[17] + (size_t)l * NE * D * EH, ka->in[18] + (size_t)l * NE * EH * D, ka->in[19] + (size_t)l * D * EH, ka->in[20] + (size_t)l * D * EH, ka->in[21] + (size_t)l * EH * D, ws, gb);
                __syncthreads(); }
            if (!split) { unsigned gb = 0; cvt_experts(F, ka->in[16] + (size_t)l * NE * D * EH, ka->in[17] + (size_t)l * NE * D * EH, ka->in[18] + (size_t)l * NE * EH * D, ka->in[19] + (size_t)l * D * EH, ka->in[20] + (size_t)l * D * EH, ka->in[21] + (size_t)l * EH * D, ws, gb); __syncthreads(); }
            DenseSched S; S.init(ws + WS_XBF, ws + WS_WIN_T + l * WIN_T_L, NTOK, INC, D, F.G, (int)blockIdx.x);
            if (split) { S.lin = 1; S.cnt = conv ? CV_UNITS : GM_UNITS;
                if (conv) { S.L0 = (256 - NCV) * GM_UNITS; S.G = NCV; S.c = hrank; } else { S.L0 = (ox - 2) * 32 * GM_UNITS; S.G = 32; S.c = grank; } }
            EpiProj E{WSP(bf16, WS_R1), WSP(unsigned char, WS_GATE8)};
            pg8::gemm_phase<EpiProj, DenseSched, true>(F.lds + RING_OFF, F.wave, D, S, E);
            if (l == 0) {
                DenseSched S2; S2.init(ws + WS_MEMBF, ws + WS_WKV_T, NB * NMEM, 2048, D, split ? 32 : F.G, split ? ((conv && hrank < 32) ? hrank : -1) : (int)blockIdx.x);
                EpiBf16Plain E2{WSP(bf16, WS_KV), 2048};
                pg8::gemm_phase<EpiBf16Plain, DenseSched, true>(F.lds + RING_OFF, F.wave, D, S2, E2);
            }
            }
            SEAM(pb + P_INPROJ);
        }
        if (IN(pb + P_MIX)) {
            { PH_BEGIN;
            memattn(F, WSP(bf16, WS_R1), WSP(bf16, WS_KV), l, WSP(bf16, WS_YX));
            hgrn_local(F, WSP(bf16, WS_R1), ka->in[5], l, ws + WS_R2);
            conv_part(F, WSP(bf16, WS_R1), ka->in[3] + (size_t)l * 3 * CW, WSP(bf16, WS_YA), WSP(bf16, WS_YX));
            }
            SEAM(pb + P_MIX);
        }
        if (IN(pb + P_SCAN)) {
            { PH_BEGIN;
            hgrn_scan(F, ws + WS_R2, WSP(v2u, WS_ZF));
            }
            SEAM(pb + P_SCAN);
        }
        if (IN(pb + P_HOUT)) {
            { PH_BEGIN;
            hgrn_out(F, WSP(bf16, WS_R1), ws + WS_R2, WSP(bf16, WS_ZF), ka->in[6] + (size_t)l * HGW, WSP(bf16, WS_YB));
            }
            SEAM(pb + P_HOUT);
        }
        if (IN(pb + P_BRANCH)) {
            { PH_BEGIN;
            static_assert(WS_YX - WS_YB == WS_YB - WS_YA, "branch inputs equally spaced");
            BranchSched S; S.init(ws + WS_YA, ws + WS_WBR_T + l * WBR_T_L, F.G, (int)blockIdx.x); EpiGateRT E{WSP(unsigned char, WS_GATE8), WSP(bf16, WS_MERGED)};
            pg8::gemm_phase<EpiGateRT, BranchSched, true>(F.lds + RING_OFF, F.wave, CW, S, E);
            }
            SEAM(pb + P_BRANCH);
        }
        if (IN(pb + P_WO)) {
            { PH_BEGIN;
            DenseSched S; S.init(ws + WS_MERGED, ws + WS_WO_T + l * WO_T_L, NTOK, D, D, F.G, (int)blockIdx.x);
            EpiResid<true> E{(const void*)WSP(bf16, WS_XBF), WSP(bf16, WS_ZF)}; pg8::gemm_phase<EpiResid<true>, DenseSched, true>(F.lds + RING_OFF, F.wave, D, S, E);
            }
            SEAM(pb + P_WO);
        }
        if (IN(pb + P_ROUTE)) {
            { PH_BEGIN;
            route_phase(F, WSP(bf16, WS_ZF), ka->in[12] + (size_t)l * D, ka->in[13] + (size_t)l * D, WSP(bf16, WS_RW + l * RW_L), ka->in[15] + (size_t)l * NE, WSP(bf16, WS_X1F), WSP(bf16, WS_X1BF),
                        WSP(unsigned, WS_CTL) + CW_CNT + l * 64, WSP(int, WS_LIST), WSP(int, WS_TOKSLOT), WSP(float, WS_TOKW));
            }
            SEAM(pb + P_ROUTE);
        }
        if (IN(pb + P_GU)) {
            { PH_BEGIN;
            moe_plan(F, WSP(unsigned, WS_CTL) + CW_CNT + l * 64);
            MoeSched<true> S; S.init(F, ws + WS_X1BF, ws + WS_WGU, WSP(int, WS_LIST)); EpiSwiGLU E{WSP(bf16, WS_R2)};
            pg8::gemm_phase<EpiSwiGLU, MoeSched<true>, true>(F.lds + RING_OFF, F.wave, D, S, E);
            }
            SEAM(pb + P_GU);
        }
        if (IN(pb + P_DOWN)) {
            { PH_BEGIN;
            if (kargs()->ph_lo > pb + P_GU) moe_plan(F, WSP(unsigned, WS_CTL) + CW_CNT + l * 64);
            MoeSched<false> S; S.init(F, ws + WS_R2, ws + WS_WDN, nullptr); EpiY8 E{WSP(unsigned char, WS_R1), WSP(bf16, WS_R1 + R1_YS)};
            pg8::gemm_phase<EpiY8, MoeSched<false>, true>(F.lds + RING_OFF, F.wave, EH, S, E);
            }
            SEAM(pb + P_DOWN);
        }
        if (IN(pb + P_COMB)) {
            { PH_BEGIN;
            if (kargs()->ph_lo > pb + P_GU) moe_plan(F, WSP(unsigned, WS_CTL) + CW_CNT + l * 64);
            combine_phase(F, WSP(bf16, WS_X1BF), WSP(unsigned char, WS_R1), WSP(bf16, WS_R1 + R1_YS), WSP(int, WS_TOKSLOT), WSP(float, WS_TOKW), ka->in[22] + (size_t)l * D, ka->in[23] + (size_t)l * D, ka->out, WSP(bf16, WS_XBF), l == 1);
            }
            SEAM(pb + P_COMB);
        }
    }
#undef IN
#undef SEAM
}
static void launch_mk(Args a, int lo, int hi, int grid, hipStream_t stream) {
    a.ph_lo = lo; a.ph_hi = hi;
    hipLaunchKernelGGL(mk_fwd, dim3(grid), dim3(NWAVES * 64), LDS_BYTES, stream, a);
}
extern "C" void kernel_launch(void* const* d_in, const int* in_sizes, int n_in, void* d_out, int out_size, void* d_ws, size_t ws_size, hipStream_t stream) {
    static int grid = 0;
    if (grid == 0) {
        if (n_in != 24 || out_size != NTOK * D || ws_size < WS_END) { fprintf(stderr, "kernel_launch: unexpected sizes n_in %d out %d ws %zu\n", n_in, out_size, ws_size); grid = -1; return; }
        int dev = 0, cus = 0;
        if (hipGetDevice(&dev) != hipSuccess || hipDeviceGetAttribute(&cus, hipDeviceAttributeMultiprocessorCount, dev) != hipSuccess) { grid = -1; return; }
        if (hipFuncSetAttribute((const void*)mk_fwd, hipFuncAttributeMaxDynamicSharedMemorySize, LDS_BYTES) != hipSuccess) { fprintf(stderr, "kernel_launch: hipFuncSetAttribute failed\n"); grid = -1; return; }
        int per_cu = 0; (void)hipOccupancyMaxActiveBlocksPerMultiprocessor(&per_cu, (const void*)mk_fwd, NWAVES * 64, LDS_BYTES); (void)hipGetLastError();
        if (per_cu < 1) fprintf(stderr, "kernel_launch: occupancy query says %d\n", per_cu);
        grid = cus;
    }
    if (grid < 0) return;
    const float* x = (const float*)d_in[0];
    const float* conv_w = (const float*)d_in[3]; const float* lbl = (const float*)d_in[5];
    const float* hg_g = (const float*)d_in[6];
    const float* ln1_g = (const float*)d_in[12]; const float* ln1_b = (const float*)d_in[13]; const float* router_w = (const float*)d_in[14];
    const float* router_b = (const float*)d_in[15]; const float* exp_wg = (const float*)d_in[16]; const float* exp_wu = (const float*)d_in[17];
    const float* exp_wd = (const float*)d_in[18]; const float* sh_wg = (const float*)d_in[19]; const float* sh_wu = (const float*)d_in[20];
    const float* sh_wd = (const float*)d_in[21]; const float* ln2_g = (const float*)d_in[22]; const float* ln2_b = (const float*)d_in[23];
    unsigned char* ws = (unsigned char*)d_ws; float* out = (float*)d_out;
    unsigned* ctl = (unsigned*)(ws + WS_CTL);
    bf16* KV = (bf16*)(ws + WS_KV); bf16* XBF = (bf16*)(ws + WS_XBF); float* X1F = (float*)(ws + WS_X1F);
    bf16* X1BF = (bf16*)(ws + WS_X1BF); float* ZF = (float*)(ws + WS_ZF);
    bf16* YA = (bf16*)(ws + WS_YA); bf16* YB = (bf16*)(ws + WS_YB); bf16* YX = (bf16*)(ws + WS_YX);
    bf16* H = (bf16*)(ws + WS_R2); float* OH = (float*)(ws + WS_R2); bf16* PROJ = (bf16*)(ws + WS_R1); bf16* Y = (bf16*)(ws + WS_R1);
    int* LIST = (int*)(ws + WS_LIST); int* TOKSLOT = (int*)(ws + WS_TOKSLOT); float* TOKW = (float*)(ws + WS_TOKW);
    Args a{};
    for (int i = 0; i < 24; ++i) a.in[i] = (const float*)d_in[i];
    a.out = out; a.ws = ws;

    (void)hipMemsetAsync(ws + WS_CTL, 0, CTL_BYTES, stream);
    a.mask = 7;
    launch_mk(a, 0, N_PHASES, grid, stream);
}
```

```cpp
#include <hip/hip_runtime.h>
#include <stdint.h>
#include <stdio.h>

typedef unsigned short bf16;
__device__ __forceinline__ float bf2f(bf16 v) { return __uint_as_float(((unsigned)v) << 16); }
__device__ __forceinline__ bf16 f2bf(float f) { unsigned u = __float_as_uint(f); return (bf16)((u + 0x7fffu + ((u >> 16) & 1u)) >> 16); }

constexpr int NB = 4, SEQ = 4096, NTOK = NB * SEQ, D = 2048, NMEM = 256;
constexpr int CW = 768, HGW = 768, HGH = 6, HGD = 128, XAW = 512, XAH = 4, XAD = 128;
constexpr int INC = 12032, YXW = 768, GW8 = 3 * 2048, PN_GATE = 23;
constexpr int C_U = 0, C_B = 768, C_C = 1536, C_Q = 2304, C_F = 3072, C_I = 3840, C_G = 4608, C_QX = 5376, C_GA = 5888, C_GB = 7936, C_GX = 9984;
constexpr int NE = 64, TOPK = 8, EH = 512;
constexpr float ALPHA = 1.41421356237f, LN_EPS = 1e-5f, RMS_EPS = 1e-6f, RSCALE = 2.5f;
constexpr int LISTCAP = 16384;

constexpr size_t MiB = 1u << 20;
constexpr size_t WS_CTL = 0, CTL_BYTES = 1 * MiB;
constexpr size_t WS_RW = 1 * MiB, RW_L = 512 * 1024;
constexpr size_t WS_WIN_T = 2 * MiB, WIN_T_L = 47 * MiB;
constexpr size_t WS_WBR_T = 1932 * MiB, WBR_T_L = 9 * MiB;
constexpr size_t WS_WO_T = 112 * MiB, WO_T_L = 8 * MiB;
constexpr size_t WS_WKV_T = 128 * MiB;
constexpr size_t WS_MEMBF = 136 * MiB, WS_KV = 140 * MiB;
constexpr size_t WS_WGU = 144 * MiB, WGU_E = 4 * MiB;
constexpr size_t WS_WDN = 404 * MiB, WDN_E = 2 * MiB;
constexpr size_t WS_XBF = 534 * MiB, WS_X1F = 598 * MiB, WS_X1BF = 726 * MiB, WS_ZF = 790 * MiB, WS_MERGED = 918 * MiB;
constexpr size_t WS_YA = 1860 * MiB, WS_YB = 1884 * MiB, WS_YX = 1908 * MiB;
constexpr size_t WS_R2 = 1046 * MiB;
constexpr size_t WS_R1 = 1214 * MiB;
constexpr size_t R1_YS = 320 * MiB;
constexpr size_t WS_LIST = 1854 * MiB, WS_TOKSLOT = 1858 * MiB, WS_TOKW = 1859 * MiB, WS_GATE8 = 1950 * MiB, WS_END = 2046 * MiB;
constexpr int CW_CNT = 1024;
constexpr int CW_PLAN = 2048;
constexpr int CW_BAR = 4096;
#ifndef DBG_MASK
#define DBG_MASK 7
#endif
namespace pg8 {
#define PG8_LAS __attribute__((address_space(3)))
typedef unsigned short bf16_t;
typedef short bf16x8 __attribute__((ext_vector_type(8)));
typedef float f32x4 __attribute__((ext_vector_type(4)));
typedef unsigned u32x4 __attribute__((ext_vector_type(4)));
typedef unsigned u32x2 __attribute__((ext_vector_type(2)));
constexpr int PG8_NVO_OFF = 147456 + 1024;
constexpr int BM = 256, BK = 64, HALF = 128, HTB = HALF * BK * 2  , STAGE_BYTES = 8 * HTB, NXCD = 8, WGM = 8;

__host__ __device__ __forceinline__ int lds_byte(int r, int c) { const int st = (r >> 4) * 2 + (c >> 5), rr = r & 15, cc = c & 31, ob = rr * 64 + cc * 2; return st * 1024 + (ob ^ (((ob >> 9) & 1) << 5)); }
__host__ __device__ __forceinline__ void stage_rc(int b, int& R, int& C) { const int st = b / 1024, sb = b % 1024, swz = sb ^ (((sb >> 9) & 1) << 5); R = (st >> 1) * 16 + swz / 64; C = (st & 1) * 32 + (swz % 64) / 2; }
__host__ __device__ __forceinline__ int perm32(int rho) { const int n = rho >> 4, i = rho & 15; return 8 * (i >> 2) + 4 * n + (i & 3); }

struct Unit { const char* A; const char* B; int pm, pn; const int* list; int m0, cnt; };

typedef float f32x2_ __attribute__((ext_vector_type(2)));
typedef __bf16 bf16x2_ __attribute__((ext_vector_type(2)));
__device__ __forceinline__ unsigned cvt_pk_bf16(float lo, float hi) { const f32x2_ v = {lo, hi}; const bf16x2_ b = __builtin_convertvector(v, bf16x2_); return __builtin_bit_cast(unsigned, b); }
__device__ __forceinline__ int lane_id_opaque() { unsigned m = ~0u; asm volatile("" : "+s"(m)); return (int)__builtin_amdgcn_mbcnt_hi(m, __builtin_amdgcn_mbcnt_lo(m, 0u)); }
__device__ __forceinline__ float bf_lo(unsigned w) { return __uint_as_float(w << 16); }
__device__ __forceinline__ float bf_hi(unsigned w) { return __uint_as_float(w & 0xffff0000u); }
__device__ __forceinline__ float sigmoidf_(float x) { return __builtin_amdgcn_rcpf(1.f + __expf(-x)); }

typedef f32x4 Acc[2][2][4][2];

template <class Epi, class Sched, bool ALIGN_EPI>
__device__ __forceinline__ void gemm_phase(PG8_LAS unsigned char* lds, const int wave, const int K_in, const Sched& S, const Epi& E) {
    const int lane = lane_id_opaque(), wid = wave, tid = wid * 64 + lane, wr = wid >> 2, wc = wid & 3, fr = lane & 15, fq = lane >> 4;
    int K = K_in; asm volatile("" : "+s"(K));
    const int nt = K / BK;
    unsigned voffB[2];
#pragma unroll
    for (int i = 0; i < 2; ++i) { int R, C; stage_rc(tid * 16 + i * 8192, R, C); const int Rb = Epi::PERM ? ((R & ~31) + perm32(R & 31)) : R; voffB[i] = (unsigned)(Rb * K + C) * 2u; }
    const size_t kstep = (size_t)(BK * 2);
    const size_t hstep = (size_t)HALF * K * 2;
    const unsigned ldsw = (unsigned)wid * 1024u;
    const int aoff = lds_byte(wr * 64 + fr, fq * 8), boff = lds_byte(wc * 32 + fr, fq * 8);
#define PG8_SA(b, h) (((b) * 2 + (h)) * HTB)
#define PG8_SB(b, h) ((4 + (b) * 2 + (h)) * HTB)
#define PG8_STAGE2(bufoff, gbase, v0, v1) do { \
        __builtin_amdgcn_global_load_lds((const unsigned*)((const char*)(gbase) + (v0)), (PG8_LAS unsigned*)(lds + (bufoff) + ldsw), 16, 0, 0); \
        __builtin_amdgcn_global_load_lds((const unsigned*)((const char*)(gbase) + (v1)), (PG8_LAS unsigned*)(lds + (bufoff) + ldsw + 8192), 16, 0, 0); } while (0)
#define PG8_STAGEB(bufoff, gbase) PG8_STAGE2(bufoff, gbase, voffB[0], voffB[1])
#define PG8_LDA(dst, b, h) do { _Pragma("unroll") for (int m = 0; m < 4; ++m) _Pragma("unroll") for (int k = 0; k < 2; ++k) dst[m][k] = *(const PG8_LAS bf16x8*)(lds + PG8_SA(b, h) + aoff + m * 2048 + k * 1024); } while (0)
#define PG8_LDB(dst, b, h) do { _Pragma("unroll") for (int n = 0; n < 2; ++n) _Pragma("unroll") for (int k = 0; k < 2; ++k) dst[n][k] = *(const PG8_LAS bf16x8*)(lds + PG8_SB(b, h) + boff + n * 2048 + k * 1024); } while (0)
#define PG8_MMA(ai, bj, At, Bt) do { __builtin_amdgcn_s_setprio(1); _Pragma("unroll") for (int m = 0; m < 4; ++m) _Pragma("unroll") for (int n = 0; n < 2; ++n) _Pragma("unroll") for (int k = 0; k < 2; ++k) \
        acc[ai][bj][m][n] = __builtin_amdgcn_mfma_f32_16x16x32_bf16(Bt[n][k], At[m][k], acc[ai][bj][m][n], 0, 0, 0); __builtin_amdgcn_s_setprio(0); } while (0)
#define PG8_WAIT_V(n) asm volatile("s_waitcnt vmcnt(" #n ")" ::: "memory")
#define PG8_WAIT_L(n) asm volatile("s_waitcnt lgkmcnt(" #n ")" ::: "memory")
#define PG8_BAR __builtin_amdgcn_s_barrier()
#define PG8_SCHED __builtin_amdgcn_sched_barrier(0)
    Unit cur, nxt; int ui = 0;
    if (!S.next(0, cur)) return;
    Acc acc;
#pragma unroll
    for (int a = 0; a < 2; ++a)
#pragma unroll
        for (int b = 0; b < 2; ++b)
#pragma unroll
            for (int m = 0; m < 4; ++m)
#pragma unroll
                for (int n = 0; n < 2; ++n) acc[a][b][m][n] = (f32x4){0.f, 0.f, 0.f, 0.f};
    bf16x8 At[4][2], B0[2][2], B1[2][2];
    constexpr bool GA = Sched::GATHER;
    unsigned c00, c01, c10 = 0, c11 = 0;
    PG8_LAS unsigned* nvo = (PG8_LAS unsigned*)(lds + PG8_NVO_OFF) + tid * 4;
    { int R0, C0, R1, C1; stage_rc(tid * 16, R0, C0); stage_rc(tid * 16 + 8192, R1, C1);
      c00 = S.avoff(cur, 0, R0, C0, K); c01 = S.avoff(cur, 0, R1, C1, K); if constexpr (GA) { c10 = S.avoff(cur, 1, R0, C0, K); c11 = S.avoff(cur, 1, R1, C1, K); } }
    const size_t hA = GA ? (size_t)0 : hstep;
#define PG8_STAGEA0(bufoff, gbase) PG8_STAGE2(bufoff, gbase, c00, c01)
#define PG8_STAGEA1(bufoff, gbase) do { if constexpr (GA) PG8_STAGE2(bufoff, gbase, c10, c11); else PG8_STAGE2(bufoff, (gbase) + hA, c00, c01); } while (0)
    const char* cA = cur.A; const char* cB = cur.B;
    PG8_STAGEB(PG8_SB(0, 0), cB); PG8_STAGEB(PG8_SB(0, 1), cB + hstep); PG8_STAGEA0(PG8_SA(0, 0), cA); PG8_STAGEA1(PG8_SA(0, 1), cA);
    if (wr == 1) PG8_BAR;
    PG8_WAIT_V(2); PG8_BAR;
    PG8_STAGEB(PG8_SB(1, 0), cB + kstep); PG8_STAGEA0(PG8_SA(1, 0), cA + kstep); PG8_STAGEB(PG8_SB(1, 1), cB + hstep + kstep);
    PG8_WAIT_V(6); PG8_BAR;
    int pi0 = 0, pi1 = 0, pi2 = 0, pi3 = 0;
    if constexpr (GA) { Unit n1; if (S.next(1, n1)) { int R0, C0, R1, C1; stage_rc(tid * 16, R0, C0); stage_rc(tid * 16 + 8192, R1, C1);
        pi0 = S.avload(n1, 0, R0); pi1 = S.avload(n1, 0, R1); pi2 = S.avload(n1, 1, R0); pi3 = S.avload(n1, 1, R1); } }
    for (;;) {
        const bool has_next = S.next(ui + 1, nxt);
        const char* nA = has_next ? nxt.A : cA; const char* nB = has_next ? nxt.B : cB;
        if constexpr (GA) { if (has_next) {
            int R0, C0, R1, C1; stage_rc(tid * 16, R0, C0); stage_rc(tid * 16 + 8192, R1, C1);
            nvo[0] = S.avfin(nxt, 0, R0, C0, K, pi0); nvo[1] = S.avfin(nxt, 0, R1, C1, K, pi1); nvo[2] = S.avfin(nxt, 1, R0, C0, K, pi2); nvo[3] = S.avfin(nxt, 1, R1, C1, K, pi3); } }
        for (int t = 0; t < nt; t += 2) {
            const bool last = (t == nt - 2);
            const char* a1 = cA + (size_t)(t + 1) * kstep;
            const char* a2 = last ? nA : cA + (size_t)(t + 2) * kstep; const char* b2 = last ? nB : cB + (size_t)(t + 2) * kstep;
            const char* a3 = a2 + kstep; const char* b3 = b2 + kstep;
            const bool nx = GA && last && has_next;
#define PG8_STAGEA0N(bufoff, gbase) do { if (nx) { const unsigned q0 = nvo[0], q1 = nvo[1]; PG8_STAGE2(bufoff, gbase, q0, q1); } else PG8_STAGEA0(bufoff, gbase); } while (0)
#define PG8_STAGEA1N(bufoff, gbase) do { if (nx) { const unsigned q0 = nvo[2], q1 = nvo[3]; PG8_STAGE2(bufoff, gbase, q0, q1); } else PG8_STAGEA1(bufoff, gbase); } while (0)
            PG8_LDB(B0, 0, 0); PG8_LDB(B1, 0, 1); PG8_SCHED; PG8_LDA(At, 0, 0); PG8_STAGEA1(PG8_SA(1, 1), a1);
            PG8_WAIT_V(8); PG8_WAIT_L(0); PG8_BAR; PG8_MMA(0, 0, At, B0); PG8_MMA(0, 1, At, B1); PG8_BAR; PG8_SCHED;
            PG8_LDA(At, 0, 1); PG8_STAGEB(PG8_SB(0, 0), b2); PG8_STAGEB(PG8_SB(0, 1), b2 + hstep); PG8_STAGEA0N(PG8_SA(0, 0), a2);
            PG8_WAIT_V(8); PG8_WAIT_L(0); PG8_BAR; PG8_MMA(1, 0, At, B0); PG8_MMA(1, 1, At, B1); PG8_BAR; PG8_SCHED;
            PG8_LDB(B0, 1, 0); PG8_LDB(B1, 1, 1); PG8_SCHED; PG8_LDA(At, 1, 0); PG8_STAGEA1N(PG8_SA(0, 1), a2);
            PG8_WAIT_V(8); PG8_WAIT_L(0); PG8_BAR; PG8_MMA(0, 0, At, B0); PG8_MMA(0, 1, At, B1); PG8_BAR; PG8_SCHED;
            PG8_LDA(At, 1, 1); PG8_STAGEB(PG8_SB(1, 0), b3); PG8_STAGEB(PG8_SB(1, 1), b3 + hstep); PG8_STAGEA0N(PG8_SA(1, 0), a3);
            PG8_WAIT_V(8); PG8_WAIT_L(0); PG8_BAR; PG8_MMA(1, 0, At, B0); PG8_MMA(1, 1, At, B1); PG8_BAR; PG8_SCHED;
#undef PG8_STAGEA0N
#undef PG8_STAGEA1N
        }
        if constexpr (GA) { Unit n2; if (has_next && S.next(ui + 2, n2)) { int R0, C0, R1, C1; stage_rc(tid * 16, R0, C0); stage_rc(tid * 16 + 8192, R1, C1);
            pi0 = S.avload(n2, 0, R0); pi1 = S.avload(n2, 0, R1); pi2 = S.avload(n2, 1, R0); pi3 = S.avload(n2, 1, R1); } }
        if constexpr (ALIGN_EPI) { if (wr == 0) PG8_BAR; }
        bool keep = false;
        if constexpr (Epi::INPLACE) keep = E.inplace(acc, cur, wr, wc, fr, fq); else E(acc, cur, wr, wc, fr, fq);
        if (!has_next) break;
        if (!keep)
#pragma unroll
        for (int a = 0; a < 2; ++a)
#pragma unroll
            for (int b = 0; b < 2; ++b)
#pragma unroll
                for (int m = 0; m < 4; ++m)
#pragma unroll
                    for (int n = 0; n < 2; ++n) acc[a][b][m][n] = (f32x4){0.f, 0.f, 0.f, 0.f};
        cur = nxt; cA = nA; cB = nB; ++ui; if constexpr (GA) { c00 = nvo[0]; c01 = nvo[1]; c10 = nvo[2]; c11 = nvo[3]; }
        if constexpr (ALIGN_EPI) { if (wr == 1) PG8_BAR; }
    }
    PG8_WAIT_V(0);
    if constexpr (!ALIGN_EPI) { if (wr == 0) PG8_BAR; }
    PG8_BAR;
#undef PG8_SA
#undef PG8_SB
#undef PG8_STAGE2
#undef PG8_STAGEB
#undef PG8_STAGEA0
#undef PG8_STAGEA1
#undef PG8_LDA
#undef PG8_LDB
#undef PG8_MMA
#undef PG8_WAIT_V
#undef PG8_WAIT_L
#undef PG8_BAR
#undef PG8_SCHED
}
}
#define GAS __attribute__((address_space(1)))
#define LAS __attribute__((address_space(3)))
typedef unsigned v4u __attribute__((ext_vector_type(4)));
typedef unsigned v2u __attribute__((ext_vector_type(2)));
typedef float f32x4 __attribute__((ext_vector_type(4)));
typedef short bf16x8 __attribute__((ext_vector_type(8)));
typedef GAS unsigned gu32;
#define RLX_AGENT __ATOMIC_RELAXED, __HIP_MEMORY_SCOPE_AGENT
#define LDS_WAIT() asm volatile("s_waitcnt lgkmcnt(0)" ::: "memory")
#define VM_WAIT() asm volatile("s_waitcnt vmcnt(0)" ::: "memory")
__device__ __forceinline__ int opaque_v(int x) { asm volatile("" : "+v"(x)); return x; }
__device__ __forceinline__ float shx(float v, int o, int lane) { return __int_as_float(__builtin_amdgcn_ds_bpermute((lane ^ o) << 2, __float_as_int(v))); }
__device__ __forceinline__ unsigned pk2(float lo, float hi) { return pg8::cvt_pk_bf16(lo, hi); }

#define XB_TMO      128
#define XB_XCNT(j)  (256  + 64 * (j))
#define XB_XSUB(j)  (1280 + 64 * (j))
#define XB_XGEN(j)  (2304 + 64 * (j))
#define XB_TOP      3328
#define XB_TOPGEN   3392
#define XCD_BAR_WORDS 3456
#define XB_SPIN_CAP (1u << 18)
__device__ __forceinline__ unsigned xb_ld(unsigned* p)              { return __hip_atomic_load(p, __ATOMIC_RELAXED, __HIP_MEMORY_SCOPE_AGENT); }
__device__ __forceinline__ unsigned xb_add(unsigned* p, unsigned v) { return __hip_atomic_fetch_add(p, v, __ATOMIC_RELAXED, __HIP_MEMORY_SCOPE_AGENT); }
__device__ __forceinline__ unsigned xb_xcc_id() { return (unsigned)__builtin_amdgcn_s_getreg((3 << 11) | 20) & 0xFu; }
#define XB_SPIN(cond, bar) do { unsigned _sp = 0; while (cond) { __builtin_amdgcn_s_sleep(1); \
    if ((++_sp & 255u) == 0u) { if (xb_ld(&(bar)[XB_TMO])) break; if (_sp > XB_SPIN_CAP) { atomicAdd(&(bar)[XB_TMO], 1u); break; } } } } while (0)
struct XcdBarrier { unsigned* bar; unsigned x; volatile LAS unsigned* st; };
__device__ __forceinline__ XcdBarrier xcd_barrier_post(unsigned* bar, volatile LAS unsigned* st) {
    XcdBarrier b; b.bar = bar; b.x = xb_xcc_id(); b.st = st;
    if (threadIdx.x == 0) (void)xb_add(&bar[XB_XCNT(b.x)], 1u);
    return b;
}
__device__ __forceinline__ void xcd_barrier_complete(unsigned* bar, unsigned x, unsigned& nloc, unsigned& nx) {
    const unsigned G = gridDim.x * gridDim.y * gridDim.z;
    unsigned sum, cnt, mine, sp = 0u;
    for (;;) {
        sum = 0u; cnt = 0u; mine = 0u;
#pragma unroll
        for (unsigned j = 0; j < 16; ++j) { const unsigned c = xb_ld(&bar[XB_XCNT(j)]); sum += c; cnt += (c > 0u) ? 1u : 0u; mine = (j == x) ? c : mine; }
        if (sum == G) break;
        __builtin_amdgcn_s_sleep(1);
        if ((++sp & 255u) == 0u) { if (xb_ld(&bar[XB_TMO])) break; if (sp > XB_SPIN_CAP) { atomicAdd(&bar[XB_TMO], 1u); break; } }
    }
    nloc = mine > 0u ? mine : 1u; nx = cnt > 0u ? cnt : 1u;
}
__device__ __forceinline__ void xcd_barrier(const XcdBarrier& b_in) {
    asm volatile("s_waitcnt vmcnt(0)" ::: "memory");
    __syncthreads();
    if (threadIdx.x == 0) {
        XcdBarrier b = b_in; asm volatile("" : "+s"(b.x));
        unsigned* bar = b.bar; asm volatile("" : "+s"(bar));
        __builtin_amdgcn_s_waitcnt(0);
        unsigned nloc = b.st[0], nx = b.st[1];
        if (nloc == 0u) { xcd_barrier_complete(bar, b.x, nloc, nx); b.st[0] = nloc; b.st[1] = nx; }
        const unsigned old = xb_add(&bar[XB_XSUB(b.x)], 1u);
        const unsigned gen = old / nloc;
        if (old + 1u == (gen + 1u) * nloc) {
            __builtin_amdgcn_fence(__ATOMIC_RELEASE, "agent");
            asm volatile("s_waitcnt vmcnt(0)" ::: "memory");
            const unsigned og = xb_add(&bar[XB_TOP], 1u);
            const unsigned tg = og / nx;
            if (og + 1u == (tg + 1u) * nx) xb_add(&bar[XB_TOPGEN], 1u);
            else XB_SPIN(xb_ld(&bar[XB_TOPGEN]) == tg, bar);
            __builtin_amdgcn_fence(__ATOMIC_ACQUIRE, "agent");
            xb_add(&bar[XB_XGEN(b.x)], 1u);
            asm volatile("s_waitcnt vmcnt(0)" ::: "memory");
        } else {
            XB_SPIN(xb_ld(&bar[XB_XGEN(b.x)]) == gen, bar);
            __builtin_amdgcn_fence(__ATOMIC_ACQUIRE, "agent");
            asm volatile("s_waitcnt vmcnt(0)" ::: "memory");
        }
    }
    __syncthreads();
}
using pg8::Unit; using pg8::Acc;
struct DenseSched { static constexpr bool GATHER = false;
    const char* A; const char* B; int nM, nN, nwg, G, c, K; int L0 = 0, cnt = 1 << 30, lin = 0;
    __device__ __forceinline__ void init(const void* A_, const void* B_, int M, int N, int K_, int G_, int c_) { A = (const char*)A_; B = (const char*)B_; nM = M / 256; nN = N / 256; nwg = nM * nN; G = G_; c = c_; K = K_; }
    __device__ __forceinline__ bool next(int i, Unit& u) const {
        const long L = (long)L0 + (long)i * G + c; if (c < 0 || i >= cnt || L >= nwg) return false;
        int wgid = (int)L; if (!lin) { const int q = nwg / 8, r = nwg % 8, xcd = wgid % 8, off = wgid / 8; wgid = (xcd < r ? xcd * (q + 1) : r * (q + 1) + (xcd - r) * q) + off; }
        const int nig = 8 * nN, gid = wgid / nig, fm = gid * 8, gsz = (nM - fm) < 8 ? (nM - fm) : 8;
        u.pm = fm + ((wgid % nig) % gsz); u.pn = (wgid % nig) / gsz;
        u.A = A + (size_t)u.pm * 256 * K * 2; u.B = B + (size_t)u.pn * 256 * K * 2; u.list = nullptr; u.m0 = 0; u.cnt = 0; return true;
    }
    __device__ __forceinline__ int avload(const Unit&, int, int) const { return 0; }
    __device__ __forceinline__ unsigned avfin(const Unit&, int h, int R, int C, int K_, int) const { return (unsigned)(((h * 128 + R) * K_ + C) * 2); }
    __device__ __forceinline__ unsigned avoff(const Unit&, int h, int R, int C, int K_) const { return (unsigned)(((h * 128 + R) * K_ + C) * 2); }
};
struct EpiBf16Plain { static constexpr bool PERM = true, INPLACE = false; bf16* O; int ldc;
    __device__ __forceinline__ void operator()(const Acc& acc, const Unit& u, int wr, int wc, int fr, int fq) const {
        const int row0 = u.pm * 256 + wr * 64 + fr, col0 = u.pn * 256 + wc * 32 + 8 * fq;
#pragma unroll
        for (int ai = 0; ai < 2; ++ai)
#pragma unroll
            for (int m = 0; m < 4; ++m) { bf16* rowp = O + (size_t)(row0 + ai * 128 + m * 16) * ldc + col0;
#pragma unroll
                for (int bj = 0; bj < 2; ++bj) { const f32x4 v0 = acc[ai][bj][m][0], v1 = acc[ai][bj][m][1];
                    v4u w; w.x = pk2(v0[0], v0[1]); w.y = pk2(v0[2], v0[3]); w.z = pk2(v1[0], v1[1]); w.w = pk2(v1[2], v1[3]);
                    *(v4u*)(rowp + bj * 128) = w; } }
    }
};
struct EpiProj { static constexpr bool PERM = true, INPLACE = false; bf16* O; unsigned char* G8;
    __device__ __forceinline__ void operator()(const Acc& acc, const Unit& u, int wr, int wc, int fr, int fq) const {
        const int row0 = u.pm * 256 + wr * 64 + fr;
        if (u.pn < PN_GATE) { const int col0 = u.pn * 256 + wc * 32 + 8 * fq;
#pragma unroll
            for (int ai = 0; ai < 2; ++ai)
#pragma unroll
                for (int m = 0; m < 4; ++m) { bf16* rowp = O + (size_t)(row0 + ai * 128 + m * 16) * INC + col0;
#pragma unroll
                    for (int bj = 0; bj < 2; ++bj) { const f32x4 v0 = acc[ai][bj][m][0], v1 = acc[ai][bj][m][1];
                        v4u w; w.x = pk2(v0[0], v0[1]); w.y = pk2(v0[2], v0[3]); w.z = pk2(v1[0], v1[1]); w.w = pk2(v1[2], v1[3]);
                        *(v4u*)(rowp + bj * 128) = w; } }
        } else { const int pos0 = (u.pn - PN_GATE) * 256 + wc * 64 + fq * 16;
#pragma unroll
            for (int ai = 0; ai < 2; ++ai)
#pragma unroll
                for (int m = 0; m < 4; ++m) { unsigned char* rowp = G8 + (size_t)(row0 + ai * 128 + m * 16) * GW8 + pos0;
                    v4u w;
#pragma unroll
                    for (int bj = 0; bj < 2; ++bj) { const f32x4 v0 = acc[ai][bj][m][0], v1 = acc[ai][bj][m][1];
                        unsigned q[8];
#pragma unroll
                        for (int j = 0; j < 4; ++j) { q[j] = (unsigned)fmaxf(pg8::sigmoidf_(v0[j]) * 255.f + 0.5f, 1.f); q[4 + j] = (unsigned)fmaxf(pg8::sigmoidf_(v1[j]) * 255.f + 0.5f, 1.f); }
                        const unsigned lo = q[0] | (q[1] << 8) | (q[2] << 16) | (q[3] << 24), hi = q[4] | (q[5] << 8) | (q[6] << 16) | (q[7] << 24);
                        if (bj == 0) { w.x = lo; w.y = hi; } else { w.z = lo; w.w = hi; } }
                    *(v4u*)rowp = w; }
        }
    }
};
struct BranchSched { static constexpr bool GATHER = false;
    const char* A0; const char* B; int G, c;
    __device__ __forceinline__ void init(const void* ya, const void* w, int G_, int c_) { A0 = (const char*)ya; B = (const char*)w; G = G_; c = c_; }
    __device__ __forceinline__ bool next(int i, Unit& u) const {
        const int j = i / 3, seg = i - 3 * j; constexpr int nM = NTOK / 256, nN = D / 256, nwg = nM * nN;
        const int L = j * G + c; if (L >= nwg) return false;
        int wgid = L; { const int q = nwg / 8, xcd = wgid % 8, off = wgid / 8; wgid = xcd * q + off; }
        const int nig = 8 * nN; u.pm = (wgid / nig) * 8 + ((wgid % nig) % 8); u.pn = (wgid % nig) / 8;
        u.A = A0 + (size_t)seg * (WS_YB - WS_YA) + (size_t)u.pm * 256 * CW * 2; u.B = B + (size_t)seg * 3 * MiB + (size_t)u.pn * 256 * CW * 2; u.list = nullptr; u.m0 = seg; u.cnt = 0; return true; }
    __device__ __forceinline__ int avload(const Unit&, int, int) const { return 0; }
    __device__ __forceinline__ unsigned avfin(const Unit&, int h, int R, int C, int K_, int) const { return (unsigned)(((h * 128 + R) * K_ + C) * 2); }
    __device__ __forceinline__ unsigned avoff(const Unit&, int h, int R, int C, int K_) const { return (unsigned)(((h * 128 + R) * K_ + C) * 2); }
};
struct EpiGateRT { static constexpr bool PERM = true, INPLACE = true; const unsigned char* g8; bf16* merged;
    __device__ __forceinline__ bool inplace(Acc& acc, const Unit& u, int wr, int wc, int fr, int fq) const {
        const int row0 = u.pm * 256 + wr * 64 + fr, col0 = u.pn * 256 + wc * 32 + 8 * fq, pos0 = u.pn * 256 + wc * 64 + fq * 16; const int seg = u.m0;
#pragma unroll
        for (int ai = 0; ai < 2; ++ai) {
            v4u ga[4], gb[4];
#pragma unroll
            for (int m = 0; m < 4; ++m) { const size_t row = (size_t)(row0 + ai * 128 + m * 16);
                ga[m] = *(const v4u*)(g8 + row * GW8 + seg * D + pos0); gb[m] = ga[m]; if (seg < 2) gb[m] = *(const v4u*)(g8 + row * GW8 + (seg + 1) * D + pos0); }
            asm volatile("" ::: "memory");
#pragma unroll
            for (int m = 0; m < 4; ++m) { const size_t row = (size_t)(row0 + ai * 128 + m * 16);
#pragma unroll
                for (int bj = 0; bj < 2; ++bj) { const unsigned ax = bj ? ga[m].z : ga[m].x, ay = bj ? ga[m].w : ga[m].y, bx = bj ? gb[m].z : gb[m].x, by = bj ? gb[m].w : gb[m].y;
                    f32x4 v0 = acc[ai][bj][m][0], v1 = acc[ai][bj][m][1];
                    if (seg < 2) {
                        v0[0] *= (float)(ax & 255u) * __builtin_amdgcn_rcpf((float)(bx & 255u)); v0[1] *= (float)((ax >> 8) & 255u) * __builtin_amdgcn_rcpf((float)((bx >> 8) & 255u));
                        v0[2] *= (float)((ax >> 16) & 255u) * __builtin_amdgcn_rcpf((float)((bx >> 16) & 255u)); v0[3] *= (float)(ax >> 24) * __builtin_amdgcn_rcpf((float)(bx >> 24));
                        v1[0] *= (float)(ay & 255u) * __builtin_amdgcn_rcpf((float)(by & 255u)); v1[1] *= (float)((ay >> 8) & 255u) * __builtin_amdgcn_rcpf((float)((by >> 8) & 255u));
                        v1[2] *= (float)((ay >> 16) & 255u) * __builtin_amdgcn_rcpf((float)((by >> 16) & 255u)); v1[3] *= (float)(ay >> 24) * __builtin_amdgcn_rcpf((float)(by >> 24));
                        acc[ai][bj][m][0] = v0; acc[ai][bj][m][1] = v1;
                    } else { constexpr float s8 = 1.f / 255.f;
                        v0[0] *= (float)(ax & 255u) * s8; v0[1] *= (float)((ax >> 8) & 255u) * s8; v0[2] *= (float)((ax >> 16) & 255u) * s8; v0[3] *= (float)(ax >> 24) * s8;
                        v1[0] *= (float)(ay & 255u) * s8; v1[1] *= (float)((ay >> 8) & 255u) * s8; v1[2] *= (float)((ay >> 16) & 255u) * s8; v1[3] *= (float)(ay >> 24) * s8;
                        v4u w; w.x = pk2(v0[0], v0[1]); w.y = pk2(v0[2], v0[3]); w.z = pk2(v1[0], v1[1]); w.w = pk2(v1[2], v1[3]); *(v4u*)(merged + row * D + col0 + bj * 128) = w; } } }
            asm volatile("" ::: "memory");
        }
        return seg < 2;
    }
};
template <bool RB16> struct EpiResid { static constexpr bool PERM = true, INPLACE = false; const void* xres; bf16* z;
    __device__ __forceinline__ void operator()(const Acc& acc, const Unit& u, int wr, int wc, int fr, int fq) const {
        const int row0 = u.pm * 256 + wr * 64 + fr, col0 = u.pn * 256 + wc * 32 + 8 * fq;
#pragma unroll
        for (int ai = 0; ai < 2; ++ai) {
            f32x4 xr[4][2][2];
#pragma unroll
            for (int m = 0; m < 4; ++m) { const size_t off = (size_t)(row0 + ai * 128 + m * 16) * D + col0;
#pragma unroll
                for (int bj = 0; bj < 2; ++bj) {
                    if constexpr (RB16) { const v4u w = *(const v4u*)((const bf16*)xres + off + bj * 128);
                        xr[m][bj][0] = (f32x4){pg8::bf_lo(w.x), pg8::bf_hi(w.x), pg8::bf_lo(w.y), pg8::bf_hi(w.y)}; xr[m][bj][1] = (f32x4){pg8::bf_lo(w.z), pg8::bf_hi(w.z), pg8::bf_lo(w.w), pg8::bf_hi(w.w)}; }
                    else {
#pragma unroll
                        for (int n = 0; n < 2; ++n) xr[m][bj][n] = *(const f32x4*)((const float*)xres + off + bj * 128 + n * 4); } } }
            asm volatile("" ::: "memory");
#pragma unroll
            for (int m = 0; m < 4; ++m) { const size_t off = (size_t)(row0 + ai * 128 + m * 16) * D + col0;
#pragma unroll
                for (int bj = 0; bj < 2; ++bj) { const f32x4 v0 = xr[m][bj][0] * ALPHA + acc[ai][bj][m][0], v1 = xr[m][bj][1] * ALPHA + acc[ai][bj][m][1];
                    v4u w; w.x = pk2(v0[0], v0[1]); w.y = pk2(v0[2], v0[3]); w.z = pk2(v1[0], v1[1]); w.w = pk2(v1[2], v1[3]); *(v4u*)(z + off + bj * 128) = w; } }
            asm volatile("" ::: "memory");
        }
    }
};

constexpr int NWAVES = 8;
constexpr int RING_OFF = 0, RING_BYTES = 131072;
constexpr int SCR_BYTES = 147456;
constexpr int MISC_OFF = SCR_BYTES;
constexpr int LDS_BYTES = 163840;
constexpr int PH_CVT = 0, PH_L0 = 1, PH_PER_LAYER = 10;
constexpr int P_INPROJ = 0, P_MIX = 1, P_SCAN = 2, P_HOUT = 3, P_BRANCH = 4, P_WO = 5, P_ROUTE = 6, P_GU = 7, P_DOWN = 8, P_COMB = 9;
constexpr int N_PHASES = PH_L0 + 2 * PH_PER_LAYER;

constexpr int NCV = 64;
#define CV_UNITS 2
#define GM_UNITS 15
struct Frame { LAS unsigned char* lds; int tid, lane, wave, G, gw, NGW; };

__device__ __forceinline__ void xpose_item(const float* W, int N, int k0, int n0, bf16* WTrow0, int ldk, LAS float* scr, int lane) {
    const int kk = lane >> 3, nn = (lane & 7) * 4;
    f32x4 v[8];
#pragma unroll
    for (int i = 0; i < 8; ++i) v[i] = *(const f32x4*)(W + (size_t)(k0 + kk + 8 * i) * N + n0 + nn);
#pragma unroll
    for (int i = 0; i < 8; ++i) { LAS float* s = scr + (kk + 8 * i) * 33 + nn; s[0] = v[i][0]; s[1] = v[i][1]; s[2] = v[i][2]; s[3] = v[i][3]; }
    LDS_WAIT(); asm volatile("" ::: "memory");
    const int c = lane & 7;
#pragma unroll
    for (int j = 0; j < 4; ++j) { const int n = (lane >> 3) + 8 * j; const LAS float* s = scr + (8 * c) * 33 + n;
        v4u o; o.x = pk2(s[0 * 33], s[1 * 33]); o.y = pk2(s[2 * 33], s[3 * 33]); o.z = pk2(s[4 * 33], s[5 * 33]); o.w = pk2(s[6 * 33], s[7 * 33]);
        *(v4u*)(WTrow0 + (size_t)n * ldk + 8 * c) = o; }
    LDS_WAIT(); asm volatile("" ::: "memory");
}
__device__ __forceinline__ void xpose_matrix(const Frame& F, const float* W, int K, int N, bf16* WT, int ldk, int mode, unsigned& gbase) {
    const int nblk = N / 32, nitems = (K / 64) * nblk;
    LAS float* scr = (LAS float*)(F.lds + RING_OFF + F.wave * 8704);
    int it = (int)(((unsigned)F.gw + (unsigned)F.NGW - gbase % (unsigned)F.NGW) % (unsigned)F.NGW);
    for (; it < nitems; it += F.NGW) {
        const int kb = it / nblk, nb = it % nblk, n0 = nb * 32, k0 = kb * 64;
        const int drow = mode == 0 ? n0 : ((n0 >> 7) * 256 + (n0 & 127) + (mode == 2 ? 128 : 0));
        xpose_item(W, N, k0, n0, WT + (size_t)drow * ldk + k0, ldk, scr, F.lane);
    }
    gbase += (unsigned)nitems;
}
__device__ __forceinline__ void cvt_rows(const Frame& F, const float* in, bf16* out, size_t n8) {
    for (size_t i = (size_t)blockIdx.x * 512 + F.tid; i < n8; i += (size_t)F.G * 512) {
        const f32x4 a = *(const f32x4*)(in + i * 8), b = *(const f32x4*)(in + i * 8 + 4);
        v4u w; w.x = pk2(a[0], a[1]); w.y = pk2(a[2], a[3]); w.z = pk2(b[0], b[1]); w.w = pk2(b[2], b[3]);
        *(v4u*)(out + i * 8) = w; }
}
__device__ __forceinline__ void cvt_router(const Frame& F, const float* rw, unsigned char* ws) {
    for (int i = blockIdx.x * 512 + F.tid; i < 2 * D * NE; i += F.G * 512) { const int l = i / (D * NE), k = (i / NE) % D, e = i % NE;
        const float w = rw[i]; const bf16 h = f2bf(w); const bf16 lo = f2bf(w - bf2f(h));
        bf16* dst = (bf16*)(ws + WS_RW + l * RW_L); dst[(size_t)e * D + k] = h; dst[(size_t)(NE + e) * D + k] = lo; }
}
struct XItem { const float* src; bf16* dst; int N, ldk; };
__device__ __forceinline__ void xp_decode(int I, const float* wg, const float* wu, const float* wd, const float* sg, const float* su, const float* sd, unsigned char* ws, XItem& x) {
    const int e = I / 1536, rem = I % 1536, m = rem >> 9, it = rem & 511;
    if (m < 2) { const float* W = m == 0 ? (e < NE ? wg + (size_t)e * D * EH : sg) : (e < NE ? wu + (size_t)e * D * EH : su);
        const int kb = it >> 4, nb = it & 15, n0 = nb * 32, k0 = kb * 64; const int drow = (n0 >> 7) * 256 + (n0 & 127) + (m == 1 ? 128 : 0);
        x.src = W + (size_t)k0 * EH + n0; x.N = EH; x.ldk = D; x.dst = (bf16*)(ws + WS_WGU + (size_t)e * WGU_E) + (size_t)drow * D + k0; }
    else { const float* W = e < NE ? wd + (size_t)e * EH * D : sd; const int kb = it >> 6, nb = it & 63, n0 = nb * 32, k0 = kb * 64;
        x.src = W + (size_t)k0 * D + n0; x.N = D; x.ldk = EH; x.dst = (bf16*)(ws + WS_WDN + (size_t)e * WDN_E) + (size_t)n0 * EH + k0; }
}
__device__ __forceinline__ void xp_load(const XItem& x, int lane, f32x4 (&v)[8]) {
    const int kk = lane >> 3, nn = (lane & 7) * 4;
#pragma unroll
    for (int i = 0; i < 8; ++i) v[i] = __builtin_nontemporal_load((const f32x4*)(x.src + (size_t)(kk + 8 * i) * x.N + nn));
}
__device__ __forceinline__ void xp_store(const XItem& x, const f32x4 (&v)[8], LAS float* scr, int lane) {
    const int kk = lane >> 3, nn = (lane & 7) * 4;
#pragma unroll
    for (int i = 0; i < 8; ++i) { LAS float* s = scr + (kk + 8 * i) * 33 + nn; s[0] = v[i][0]; s[1] = v[i][1]; s[2] = v[i][2]; s[3] = v[i][3]; }
    LDS_WAIT(); asm volatile("" ::: "memory");
    const int c = lane & 7;
#pragma unroll
    for (int j = 0; j < 4; ++j) { const int n = (lane >> 3) + 8 * j; const LAS float* s = scr + (8 * c) * 33 + n;
        v4u o; o.x = pk2(s[0 * 33], s[1 * 33]); o.y = pk2(s[2 * 33], s[3 * 33]); o.z = pk2(s[4 * 33], s[5 * 33]); o.w = pk2(s[6 * 33], s[7 * 33]);
        __builtin_nontemporal_store(o, (v4u*)(x.dst + (size_t)n * x.ldk + 8 * c)); }
    LDS_WAIT(); asm volatile("" ::: "memory");
}
__device__ __forceinline__ void cvt_experts(const Frame& F, const float* wg, const float* wu, const float* wd, const float* sg, const float* su, const float* sd, unsigned char* ws, unsigned& gbase) {
    (void)gbase;
    LAS float* scr = (LAS float*)(F.lds + RING_OFF + F.wave * 8704);
    const int total = (NE + 1) * 1536;
    XItem A, B; f32x4 va[8], vb[8];
    int I = F.gw;
    if (I < total) { xp_decode(I, wg, wu, wd, sg, su, sd, ws, A); xp_load(A, F.lane, va); }
    for (; I < total; I += 2 * F.NGW) {
        const int I2 = I + F.NGW, I3 = I + 2 * F.NGW;
        if (I2 < total) { xp_decode(I2, wg, wu, wd, sg, su, sd, ws, B); xp_load(B, F.lane, vb); }
        xp_store(A, va, scr, F.lane);
        if (I2 < total) { if (I3 < total) { xp_decode(I3, wg, wu, wd, sg, su, sd, ws, A); xp_load(A, F.lane, va); }
            xp_store(B, vb, scr, F.lane); }
    }
}
constexpr int NVO_OFF = MISC_OFF + 1024;  static_assert(NVO_OFF == pg8::PG8_NVO_OFF, "nvo");
constexpr int PLAN_OFF = NVO_OFF + 8192;
constexpr int PLAN_TB = PLAN_OFF, PLAN_CN = PLAN_OFF + 66 * 4, PLAN_TE = PLAN_OFF + 132 * 4;
constexpr int MAXTILES = 640;
#ifndef ROUTE_PROBE
#define ROUTE_PROBE 0
#endif
static_assert(PLAN_TE + MAXTILES * 4 <= LDS_BYTES, "LDS map");

__device__ __forceinline__ float wave_sum(float v, int lane) {
#pragma unroll
    for (int o = 1; o < 64; o <<= 1) v += shx(v, o, lane);
    return v;
}
__device__ __forceinline__ void moe_plan(const Frame& F, const unsigned* cnt) {
    LAS unsigned* tb = (LAS unsigned*)(F.lds + PLAN_TB); LAS unsigned* cn = (LAS unsigned*)(F.lds + PLAN_CN); LAS unsigned* te = (LAS unsigned*)(F.lds + PLAN_TE);
    __syncthreads();
    if (F.wave == 0) {
        const unsigned c = __hip_atomic_load(cnt + F.lane, RLX_AGENT); const unsigned t = (c + 255u) >> 8; unsigned inc = t;
#pragma unroll
        for (int o = 1; o < 64; o <<= 1) { const unsigned v = (unsigned)__builtin_amdgcn_ds_bpermute((F.lane - o) << 2, (int)inc); if (F.lane >= o) inc += v; }
        tb[F.lane] = inc - t; cn[F.lane] = c;
        if (F.lane == 63) { tb[NE] = inc; cn[NE] = (unsigned)NTOK; tb[NE + 1] = inc + NTOK / 256; } }
    __syncthreads();
    for (int t = F.tid; t < MAXTILES; t += NWAVES * 64) { unsigned e = 0; for (int q = 1; q <= NE; ++q) if (tb[q] <= (unsigned)t) e = q; te[t] = e; }
    __syncthreads();
}
template <bool GU> struct MoeSched { static constexpr bool GATHER = GU;
    const LAS unsigned* tb; const LAS unsigned* cn; const LAS unsigned* te; int nunits, nN, G, c; const char* Abase; const char* Bbase; const int* list;
    __device__ __forceinline__ void init(const Frame& F, const void* A_, const void* B_, const int* list_) {
        tb = (const LAS unsigned*)(F.lds + PLAN_TB); cn = (const LAS unsigned*)(F.lds + PLAN_CN); te = (const LAS unsigned*)(F.lds + PLAN_TE);
        nN = GU ? 4 : 8; nunits = (int)tb[NE + 1] * nN; G = F.G; const int bx = blockIdx.x; c = (G % 8 == 0) ? (bx % 8) * (G / 8) + bx / 8 : bx;
        Abase = (const char*)A_; Bbase = (const char*)B_; list = list_; }
    __device__ __forceinline__ bool next(int i, Unit& u) const {
        constexpr int RUN = GU ? 2 : 1; const int hs = c + G * (i / RUN), per = nN / RUN;
        const int tile = hs / per, pn = (hs % per) * RUN + (i % RUN); if (tile * nN >= nunits) return false;
        const int e = (int)te[tile];
        u.pm = tile; u.pn = pn;
        if (GU) { u.A = Abase; u.B = Bbase + (size_t)e * WGU_E + (size_t)pn * 256 * D * 2; u.list = e < NE ? list + (size_t)e * LISTCAP : nullptr; u.m0 = (tile - (int)tb[e]) * 256; u.cnt = (int)cn[e]; }
        else { u.A = Abase + (size_t)tile * 256 * EH * 2; u.B = Bbase + (size_t)e * WDN_E + (size_t)pn * 256 * EH * 2; u.list = nullptr; u.m0 = 0; u.cnt = 0; }
        return true; }
    __device__ __forceinline__ int avload(const Unit& u, int h, int R) const { const int pos = u.m0 + h * 128 + R; const int pc = pos < u.cnt ? pos : (u.cnt > 0 ? u.cnt - 1 : 0); const int* lp = u.list ? u.list : list; return lp[pc]; }
    __device__ __forceinline__ unsigned avfin(const Unit& u, int h, int R, int C, int K_, int v) const { const int pos = u.m0 + h * 128 + R; int row = u.list ? v : pos; row = pos < u.cnt ? row : 0; return (unsigned)((row * K_ + C) * 2); }
    __device__ __forceinline__ unsigned avoff(const Unit& u, int h, int R, int C, int K_) const {
        if (GU) return avfin(u, h, R, C, K_, avload(u, h, R));
        else return (unsigned)(((h * 128 + R) * K_ + C) * 2); }
};
struct EpiSwiGLU { static constexpr bool PERM = true, INPLACE = false; bf16* H;
    __device__ __forceinline__ void operator()(const Acc& acc, const Unit& u, int wr, int wc, int fr, int fq) const {
        const int row0 = u.pm * 256 + wr * 64 + fr, col0 = u.pn * 128 + wc * 32 + 8 * fq;
#pragma unroll
        for (int ai = 0; ai < 2; ++ai)
#pragma unroll
            for (int m = 0; m < 4; ++m) { bf16* rowp = H + (size_t)(row0 + ai * 128 + m * 16) * EH + col0;
                float hv[8];
#pragma unroll
                for (int n = 0; n < 2; ++n)
#pragma unroll
                    for (int j = 0; j < 4; ++j) { const float g = acc[ai][0][m][n][j], uu = acc[ai][1][m][n][j]; hv[n * 4 + j] = g * pg8::sigmoidf_(g) * uu; }
                v4u w; w.x = pk2(hv[0], hv[1]); w.y = pk2(hv[2], hv[3]); w.z = pk2(hv[4], hv[5]); w.w = pk2(hv[6], hv[7]);
                *(v4u*)rowp = w; }
    }
};

struct EpiY8 { static constexpr bool PERM = true, INPLACE = false; unsigned char* Y8; bf16* YS;
    __device__ __forceinline__ void operator()(const Acc& acc, const Unit& u, int wr, int wc, int fr, int fq) const {
        const int row0 = u.pm * 256 + wr * 64 + fr, pos0 = u.pn * 256 + wc * 64 + fq * 16;
#pragma unroll
        for (int ai = 0; ai < 2; ++ai)
#pragma unroll
            for (int m = 0; m < 4; ++m) { const size_t row = (size_t)(row0 + ai * 128 + m * 16);
                v4u w; unsigned sw = 0u;
#pragma unroll
                for (int bj = 0; bj < 2; ++bj) { const f32x4 v0 = acc[ai][bj][m][0], v1 = acc[ai][bj][m][1];
                    const float am = fmaxf(fmaxf(fmaxf(fabsf(v0[0]), fabsf(v0[1])), fmaxf(fabsf(v0[2]), fabsf(v0[3]))), fmaxf(fmaxf(fabsf(v1[0]), fabsf(v1[1])), fmaxf(fabsf(v1[2]), fabsf(v1[3]))));
                    const unsigned sb = f2bf(am * (1.f / 127.f)); const float sc = __uint_as_float(sb << 16); const float inv = sc > 0.f ? __builtin_amdgcn_rcpf(sc) : 0.f;
                    unsigned q[8];
#pragma unroll
                    for (int j = 0; j < 4; ++j) { q[j] = (unsigned)fminf(rintf(v0[j] * inv + 128.f), 255.f); q[4 + j] = (unsigned)fminf(rintf(v1[j] * inv + 128.f), 255.f); }
                    const unsigned lo = q[0] | (q[1] << 8) | (q[2] << 16) | (q[3] << 24), hi = q[4] | (q[5] << 8) | (q[6] << 16) | (q[7] << 24);
                    if (bj == 0) { w.x = lo; w.y = hi; sw = sb; } else { w.z = lo; w.w = hi; sw |= sb << 16; } }
                *(v4u*)(Y8 + row * D + pos0) = w; *(unsigned*)(YS + row * (D / 8) + (pos0 >> 3)) = sw; }
    }
};
__device__ __forceinline__ void route_phase(const Frame& F, const bf16* __restrict__ Z, const float* __restrict__ g, const float* __restrict__ bb, const bf16* __restrict__ rwh, const float* __restrict__ rb,
                                            bf16* __restrict__ X1L, bf16* __restrict__ X1BF, unsigned* cnt, int* list, int* tokslot, float* tokw, bool dispatch = true) {
    LAS float* part = (LAS float*)(F.lds + RING_OFF);
    LAS float* lg = part + 4 * 4096;
    LAS float* sl = lg + 64 * 65;
    LAS unsigned* cntL = (LAS unsigned*)(sl + 64 * 65);
    LAS unsigned* baseL = cntL + 64;
    LAS unsigned* ee = baseL + 64;
    LAS unsigned* pl = ee + 512;
    LAS float* ww = (LAS float*)(pl + 512);
    for (int grp = blockIdx.x; grp < NTOK / 64; grp += F.G) {
        const int t0 = grp * 64;
        if (F.tid < 64) cntL[F.tid] = 0u;
        for (int rp_ = 0; rp_ < (ROUTE_PROBE == 1 ? 2 : 1); ++rp_)
#pragma unroll 2
        for (int q = 0; q < 8; ++q) {
            const int t = t0 + F.wave * 8 + q;
            const v2u* zr = (const v2u*)(Z + (size_t)t * D) + F.lane;
            f32x4 v[8]; float s = 0.f;
#pragma unroll
            for (int j = 0; j < 8; ++j) { const v2u zw = zr[64 * j]; v[j] = (f32x4){pg8::bf_lo(zw.x), pg8::bf_hi(zw.x), pg8::bf_lo(zw.y), pg8::bf_hi(zw.y)}; s += (v[j][0] + v[j][1]) + (v[j][2] + v[j][3]); }
            const float mean = wave_sum(s, F.lane) * (1.f / D); float s2 = 0.f;
#pragma unroll
            for (int j = 0; j < 8; ++j) { v[j] = v[j] - mean; s2 += (v[j][0] * v[j][0] + v[j][1] * v[j][1]) + (v[j][2] * v[j][2] + v[j][3] * v[j][3]); }
            const float rstd = 1.f / sqrtf(wave_sum(s2, F.lane) * (1.f / D) + LN_EPS);
            v2u* xl = (v2u*)(X1L + (size_t)t * D) + F.lane; v2u* xb = (v2u*)(X1BF + (size_t)t * D) + F.lane;
#pragma unroll
            for (int j = 0; j < 8; ++j) { const f32x4 gg = ((const f32x4*)g)[F.lane + 64 * j], bv = ((const f32x4*)bb)[F.lane + 64 * j];
                const f32x4 y = v[j] * rstd * gg + bv; v2u w; w.x = pk2(y[0], y[1]); w.y = pk2(y[2], y[3]); xb[64 * j] = w;
                v2u lo; lo.x = pk2(y[0] - pg8::bf_lo(w.x), y[1] - pg8::bf_hi(w.x)); lo.y = pk2(y[2] - pg8::bf_lo(w.y), y[3] - pg8::bf_hi(w.y)); xl[64 * j] = lo; }
        }
        VM_WAIT(); __syncthreads();
        for (int rp_ = 0; rp_ < (ROUTE_PROBE == 2 ? 2 : 1); ++rp_)
        { const int r = F.lane & 15, kq = F.lane >> 4, kb = (F.wave & 3) * 512, th = F.wave >> 2;
          const bf16* xh = X1BF + (size_t)(t0 + th * 32 + r) * D + kb + 8 * kq;
          const bf16* xl = X1L + (size_t)(t0 + th * 32 + r) * D + kb + 8 * kq;
          const bf16* wh = rwh + (size_t)r * D + kb + 8 * kq;
          f32x4 acc[2][4];
#pragma unroll
          for (int tt = 0; tt < 2; ++tt)
#pragma unroll
              for (int nb = 0; nb < 4; ++nb) acc[tt][nb] = (f32x4){0.f, 0.f, 0.f, 0.f};
          bf16x8 xA[2][2], xB[2][2]; bf16x8 hA[4], lA[4], hB[4], lB[4];
#define RT_LOAD(X, H, L, ks) do { const int k_ = ((ks) < 16 ? (ks) : 15) * 32; _Pragma("unroll") for (int tt = 0; tt < 2; ++tt) { X[tt][0] = *(const bf16x8*)(xh + (size_t)tt * 16 * D + k_); X[tt][1] = *(const bf16x8*)(xl + (size_t)tt * 16 * D + k_); } \
              _Pragma("unroll") for (int nb = 0; nb < 4; ++nb) { H[nb] = *(const bf16x8*)(wh + (size_t)nb * 16 * D + k_); L[nb] = *(const bf16x8*)(wh + (size_t)(64 + nb * 16) * D + k_); } } while (0)
#define RT_MMA(X, H, L) do { \
              _Pragma("unroll") for (int tt = 0; tt < 2; ++tt) _Pragma("unroll") for (int nb = 0; nb < 4; ++nb) acc[tt][nb] = __builtin_amdgcn_mfma_f32_16x16x32_bf16(X[tt][1], H[nb], acc[tt][nb], 0, 0, 0); \
              _Pragma("unroll") for (int tt = 0; tt < 2; ++tt) _Pragma("unroll") for (int nb = 0; nb < 4; ++nb) acc[tt][nb] = __builtin_amdgcn_mfma_f32_16x16x32_bf16(X[tt][0], L[nb], acc[tt][nb], 0, 0, 0); \
              _Pragma("unroll") for (int tt = 0; tt < 2; ++tt) _Pragma("unroll") for (int nb = 0; nb < 4; ++nb) acc[tt][nb] = __builtin_amdgcn_mfma_f32_16x16x32_bf16(X[tt][0], H[nb], acc[tt][nb], 0, 0, 0); } while (0)
          RT_LOAD(xA, hA, lA, 0);
#pragma unroll 1
          for (int ks = 0; ks < 16; ks += 2) {
              RT_LOAD(xB, hB, lB, ks + 1); RT_MMA(xA, hA, lA);
              RT_LOAD(xA, hA, lA, ks + 2); RT_MMA(xB, hB, lB);
          }
#undef RT_LOAD
#undef RT_MMA
#pragma unroll
          for (int tt = 0; tt < 2; ++tt)
#pragma unroll
              for (int nb = 0; nb < 4; ++nb)
#pragma unroll
                  for (int reg = 0; reg < 4; ++reg) part[(F.wave & 3) * 4096 + (th * 32 + tt * 16 + 4 * kq + reg) * 64 + nb * 16 + r] = acc[tt][nb][reg];
        }
        __syncthreads();
        for (int i = F.tid; i < 64 * 64; i += NWAVES * 64) { const int tk = i >> 6, e = i & 63; const float lgt = (part[i] + part[4096 + i]) + (part[8192 + i] + part[12288 + i]);
            const float sc = 1.f / (1.f + __expf(-lgt)); lg[tk * 65 + e] = sc; sl[tk * 65 + e] = sc + rb[e]; }
        __syncthreads();
        for (int rp_ = 0; rp_ < (ROUTE_PROBE == 3 ? 2 : 1); ++rp_)
        { const bool lastrp = (rp_ == (ROUTE_PROBE == 3 ? 1 : 0));
          const int tk = F.wave * 8 + (F.lane >> 3), gq = F.lane & 7, lane = F.lane;
          float sv[8], cv[8];
#pragma unroll
          for (int j = 0; j < 8; ++j) { sv[j] = sl[tk * 65 + gq * 8 + j]; cv[j] = lg[tk * 65 + gq * 8 + j]; }
          float m1 = -INFINITY, m2 = -INFINITY;
#pragma unroll
          for (int j = 0; j < 8; ++j) { const float x = sv[j]; const bool g1 = x > m1; m2 = g1 ? m1 : fmaxf(m2, x); m1 = g1 ? x : m1; }
          const float gs = m1 + m2;
          int rank = 0;
#pragma unroll
          for (int o = 1; o < 8; ++o) { const float og = shx(gs, o, lane); const int oq = gq ^ o; rank += (og > gs || (og == gs && oq < gq)) ? 1 : 0; }
          const bool gsel = rank < 4;
          unsigned used = gsel ? 0u : 0xffu;
          float wsum = 0.f; float my_sc = 0.f; int my_e = 0;
#pragma unroll
          for (int i = 0; i < 8; ++i) {
              float bv = -INFINITY, bs = 0.f; int be = 64;
#pragma unroll
              for (int j = 0; j < 8; ++j) { const bool ok = !((used >> j) & 1u) && sv[j] > bv; bv = ok ? sv[j] : bv; bs = ok ? cv[j] : bs; be = ok ? gq * 8 + j : be; }
#pragma unroll
              for (int o = 1; o < 8; o <<= 1) { const float ov = shx(bv, o, lane), os = shx(bs, o, lane); const int oe = __float_as_int(shx(__int_as_float(be), o, lane));
                  const bool tk_o = ov > bv || (ov == bv && oe < be); bv = tk_o ? ov : bv; bs = tk_o ? os : bs; be = tk_o ? oe : be; }
              if ((be >> 3) == gq) used |= 1u << (be & 7);
              wsum += bs; if (gq == i) { my_sc = bs; my_e = be; }
          }
          const int slot = tk * 8 + gq;
          ee[slot] = (unsigned)my_e; ww[slot] = my_sc * (RSCALE / wsum);
          pl[slot] = __hip_atomic_fetch_add(cntL + my_e, (dispatch && lastrp) ? 1u : 0u, __ATOMIC_RELAXED, __HIP_MEMORY_SCOPE_WORKGROUP);
        }
        __syncthreads();
        if (F.tid < 64) { const unsigned n = cntL[F.tid]; baseL[F.tid] = n ? __hip_atomic_fetch_add(cnt + F.tid, n, RLX_AGENT) : 0u; }
        __syncthreads();
        if (dispatch) { const int tk = F.tid >> 3, i = F.tid & 7; const unsigned e = ee[F.tid]; const unsigned pos = baseL[e] + pl[F.tid]; const int t = t0 + tk;
          list[(size_t)e * LISTCAP + pos] = t; tokslot[t * 8 + i] = (int)(e * LISTCAP + pos); tokw[t * 8 + i] = ww[F.tid]; }
        __syncthreads();
    }
}
__device__ __forceinline__ void combine_phase(const Frame& F, const bf16* X1B, const unsigned char* Y8, const bf16* YS, const int* tokslot, const float* tokw, const float* g, const float* bb, float* OUT, bf16* XBF, bool last) {
    const LAS unsigned* tb = (const LAS unsigned*)(F.lds + PLAN_TB);
    LAS int* rw = (LAS int*)(F.lds + RING_OFF) + F.wave * 32;
#define CB_LOAD(W, S, ROW) do { const int r_ = __builtin_amdgcn_readfirstlane(ROW); const v2u* yr_ = (const v2u*)(Y8 + (size_t)r_ * D) + F.lane; const bf16* ys_ = YS + (size_t)r_ * (D / 8) + F.lane; \
        _Pragma("unroll") for (int j = 0; j < 4; ++j) { W[j] = yr_[64 * j]; S[j] = ys_[64 * j]; } } while (0)
#define CB_ACC(W, S, WT) do { const float wt_ = __int_as_float(__builtin_amdgcn_readfirstlane(WT)); _Pragma("unroll") for (int j = 0; j < 4; ++j) { const float sc = bf2f(S[j]) * wt_, c0 = -128.f * sc; const unsigned x = W[j].x, y = W[j].y; \
        v[j][0] += sc * (float)(x & 255u) + c0; v[j][1] += sc * (float)((x >> 8) & 255u) + c0; v[j][2] += sc * (float)((x >> 16) & 255u) + c0; v[j][3] += sc * (float)(x >> 24) + c0; \
        v[j][4] += sc * (float)(y & 255u) + c0; v[j][5] += sc * (float)((y >> 8) & 255u) + c0; v[j][6] += sc * (float)((y >> 16) & 255u) + c0; v[j][7] += sc * (float)(y >> 24) + c0; } } while (0)
    const int cl = (F.lane >> 5) * 256 + (F.lane & 1) * 128 + ((F.lane >> 3) & 3) * 32 + ((F.lane >> 1) & 3) * 8;
    for (int t = F.gw; t < NTOK; t += F.NGW) {
        if (F.lane < 8) { const int sl = tokslot[t * 8 + F.lane]; rw[F.lane] = (int)tb[sl / LISTCAP] * 256 + (sl % LISTCAP); rw[16 + F.lane] = __float_as_int(tokw[t * 8 + F.lane]); }
        if (F.lane == 8) { rw[8] = (int)tb[NE] * 256 + t; rw[24] = __float_as_int(1.f); }
        LDS_WAIT(); asm volatile("" ::: "memory");
        float v[4][8]; float s = 0.f;
        v2u wa[4], wb[4], wc[4]; bf16 sa[4], sb2[4], sc2[4];
        CB_LOAD(wa, sa, rw[0]); CB_LOAD(wb, sb2, rw[1]); CB_LOAD(wc, sc2, rw[2]);
#pragma unroll
        for (int j = 0; j < 4; ++j) { const v4u xw = *(const v4u*)(X1B + (size_t)t * D + 512 * j + cl);
            v[j][0] = pg8::bf_lo(xw.x) * ALPHA; v[j][1] = pg8::bf_hi(xw.x) * ALPHA; v[j][2] = pg8::bf_lo(xw.y) * ALPHA; v[j][3] = pg8::bf_hi(xw.y) * ALPHA;
            v[j][4] = pg8::bf_lo(xw.z) * ALPHA; v[j][5] = pg8::bf_hi(xw.z) * ALPHA; v[j][6] = pg8::bf_lo(xw.w) * ALPHA; v[j][7] = pg8::bf_hi(xw.w) * ALPHA; }
#pragma unroll 1
        for (int i = 0; i < 9; i += 3) {
            CB_ACC(wa, sa, rw[16 + i]); if (i < 6) CB_LOAD(wa, sa, rw[i + 3]);
            CB_ACC(wb, sb2, rw[17 + i]); if (i < 6) CB_LOAD(wb, sb2, rw[i + 4]);
            CB_ACC(wc, sc2, rw[18 + i]); if (i < 6) CB_LOAD(wc, sc2, rw[i + 5]);
        }
        asm volatile("" ::: "memory");
#pragma unroll
        for (int j = 0; j < 4; ++j)
#pragma unroll
            for (int e = 0; e < 8; ++e) s += v[j][e];
        const float mean = wave_sum(s, F.lane) * (1.f / D); float s2 = 0.f;
#pragma unroll
        for (int j = 0; j < 4; ++j)
#pragma unroll
            for (int e = 0; e < 8; ++e) { v[j][e] -= mean; s2 += v[j][e] * v[j][e]; }
        const float rstd = 1.f / sqrtf(wave_sum(s2, F.lane) * (1.f / D) + LN_EPS);
#pragma unroll
        for (int j = 0; j < 4; ++j) { const int c0 = cl + 512 * j; const f32x4 g0 = *(const f32x4*)(g + c0), g1 = *(const f32x4*)(g + c0 + 4), b0 = *(const f32x4*)(bb + c0), b1 = *(const f32x4*)(bb + c0 + 4);
            f32x4 y0, y1;
#pragma unroll
            for (int e = 0; e < 4; ++e) { y0[e] = v[j][e] * rstd * g0[e] + b0[e]; y1[e] = v[j][4 + e] * rstd * g1[e] + b1[e]; }
            if (last) { *(f32x4*)(OUT + (size_t)t * D + c0) = y0; *(f32x4*)(OUT + (size_t)t * D + c0 + 4) = y1; }
            else { v4u w; w.x = pk2(y0[0], y0[1]); w.y = pk2(y0[2], y0[3]); w.z = pk2(y1[0], y1[1]); w.w = pk2(y1[2], y1[3]); *(v4u*)(XBF + (size_t)t * D + c0) = w; } }
    }
#undef CB_LOAD
#undef CB_ACC
}
constexpr size_t R2_UT = 0, R2_OI = 48 * MiB, R2_QP = 96 * MiB, R2_DEC = 120 * MiB;
constexpr int NHU = NB * HGH * (SEQ / 64);
typedef __attribute__((address_space(3))) bf16 lbf16;
__device__ __forceinline__ void unpack8(const v4u w, float (&f)[8]) {
    f[0] = pg8::bf_lo(w.x); f[1] = pg8::bf_hi(w.x); f[2] = pg8::bf_lo(w.y); f[3] = pg8::bf_hi(w.y); f[4] = pg8::bf_lo(w.z); f[5] = pg8::bf_hi(w.z); f[6] = pg8::bf_lo(w.w); f[7] = pg8::bf_hi(w.w); }
__device__ __forceinline__ float exp_c(float x) { return __expf(fminf(x, 80.f)); }

__device__ __forceinline__ void conv_part(const Frame& F, const bf16* proj, const float* cw, bf16* YA, bf16* YX) {
    for (int i = blockIdx.x * 512 + F.tid; i < NTOK * 32; i += F.G * 512) *(v4u*)(YX + (size_t)(i >> 5) * YXW + XAW + (i & 31) * 8) = (v4u){0u, 0u, 0u, 0u};
    for (int i = blockIdx.x * 512 + F.tid; i < NTOK * (CW / 8); i += F.G * 512) {
        const int t = i / (CW / 8), c = (i % (CW / 8)) * 8, pos = t & (SEQ - 1);
        const bf16* r = proj + (size_t)t * INC;
        float u0[8], c0[8], b0[8], u1[8], c1[8], u2[8], c2[8], w0[8], w1[8], w2[8];
        unpack8(*(const v4u*)(r + C_U + c), u0); unpack8(*(const v4u*)(r + C_C + c), c0); unpack8(*(const v4u*)(r + C_B + c), b0);
        const v4u z4 = {0u, 0u, 0u, 0u};
        unpack8(pos >= 1 ? *(const v4u*)(r - INC + C_U + c) : z4, u1); unpack8(pos >= 1 ? *(const v4u*)(r - INC + C_C + c) : z4, c1);
        unpack8(pos >= 2 ? *(const v4u*)(r - 2 * INC + C_U + c) : z4, u2); unpack8(pos >= 2 ? *(const v4u*)(r - 2 * INC + C_C + c) : z4, c2);
#pragma unroll
        for (int j = 0; j < 8; ++j) { w0[j] = cw[c + j]; w1[j] = cw[CW + c + j]; w2[j] = cw[2 * CW + c + j]; }
        float o[8];
#pragma unroll
        for (int j = 0; j < 8; ++j) o[j] = b0[j] * (w2[j] * c0[j] * u0[j] + w1[j] * c1[j] * u1[j] + w0[j] * c2[j] * u2[j]);
        v4u w; w.x = pk2(o[0], o[1]); w.y = pk2(o[2], o[3]); w.z = pk2(o[4], o[5]); w.w = pk2(o[6], o[7]);
        *(v4u*)(YA + (size_t)t * CW + c) = w;
    }
}

__device__ __forceinline__ void hgrn_local(const Frame& F, const bf16* proj, const float* lbl, int layer, unsigned char* r2) {
    lbf16* QS = (lbf16*)(F.lds);
    lbf16* KS = QS + 64 * 136;
    lbf16* KPT = KS + 64 * 136;
    lbf16* VT = KPT + 128 * 72;
    lbf16* PS = VT + 128 * 72;
    LAS float* SEG = (LAS float*)(PS + 64 * 72);
    bf16* UT = (bf16*)(r2 + R2_UT); bf16* OI = (bf16*)(r2 + R2_OI); bf16* QP = (bf16*)(r2 + R2_QP); float* DEC = (float*)(r2 + R2_DEC);
    const int lane = F.lane, wv = F.wave, r = lane & 15, kq = lane >> 4;
    bf16 rf[16], rq[16], rv[16];
#define HL_LOAD(U) do { const int b_ = (U) / (HGH * 64), h_ = ((U) / 64) % HGH, c_ = (U) % 64; const bf16* p_ = proj + (size_t)(b_ * SEQ + c_ * 64 + (F.tid >> 7) * 16) * INC + h_ * HGD + (F.tid & 127); \
        _Pragma("unroll") for (int i = 0; i < 16; ++i) { rf[i] = p_[(size_t)i * INC + C_F]; rq[i] = p_[(size_t)i * INC + C_Q]; rv[i] = p_[(size_t)i * INC + C_I]; } } while (0)
    if ((int)blockIdx.x < NHU) HL_LOAD((int)blockIdx.x);
    for (int unit = blockIdx.x; unit < NHU; unit += F.G) {
        const int b = unit / (HGH * 64), h = (unit / 64) % HGH, c = unit % 64, t0 = b * SEQ + c * 64;
        { const int col = F.tid & 127, seg = F.tid >> 7, ch = h * HGD + col;
          float lb = 0.f; if (layer == 1) lb = 1.f / (1.f + __expf(lbl[ch] - lbl[HGW + ch]));
          float a[16], kk[16], qv[16], vv[16]; float run = 0.f;
#pragma unroll
          for (int i = 0; i < 16; ++i) {
              const float z = bf2f(rf[i]); const float ez = __expf(-z); const float sg = 1.f / (1.f + ez);
              const float f = lb + (1.f - lb) * sg; kk[i] = (1.f - lb) * ez * sg; run += fmaxf(__logf(f), -60.f); a[i] = run;
              qv[i] = bf2f(rq[i]); vv[i] = bf2f(rv[i]); }
          if (unit + F.G < NHU) HL_LOAD(unit + F.G);
          SEG[seg * 128 + col] = run;
          __syncthreads();
          const float s0 = SEG[col], s1 = SEG[128 + col], s2 = SEG[256 + col], s3 = SEG[384 + col];
          const float base = seg == 0 ? 0.f : (seg == 1 ? s0 : (seg == 2 ? s0 + s1 : s0 + s1 + s2)), bm = s0 + s1, bl = (s0 + s1) + (s2 + s3);
          float kp[16];
#pragma unroll
          for (int i = 0; i < 16; ++i) { const float bb = base + a[i]; const int t = seg * 16 + i;
              QS[t * 136 + col] = f2bf(qv[i] * exp_c(bb - bm)); KS[t * 136 + col] = f2bf(kk[i] * exp_c(bm - bb)); kp[i] = kk[i] * exp_c(bl - bb);
              QP[(size_t)(t0 + t) * HGW + ch] = f2bf(qv[i] * exp_c(bb)); }
          v4u w0, w1; w0.x = pk2(kp[0], kp[1]); w0.y = pk2(kp[2], kp[3]); w0.z = pk2(kp[4], kp[5]); w0.w = pk2(kp[6], kp[7]); w1.x = pk2(kp[8], kp[9]); w1.y = pk2(kp[10], kp[11]); w1.z = pk2(kp[12], kp[13]); w1.w = pk2(kp[14], kp[15]);
          *(LAS v4u*)(KPT + col * 72 + seg * 16) = w0; *(LAS v4u*)(KPT + col * 72 + seg * 16 + 8) = w1;
          w0.x = pk2(vv[0], vv[1]); w0.y = pk2(vv[2], vv[3]); w0.z = pk2(vv[4], vv[5]); w0.w = pk2(vv[6], vv[7]); w1.x = pk2(vv[8], vv[9]); w1.y = pk2(vv[10], vv[11]); w1.z = pk2(vv[12], vv[13]); w1.w = pk2(vv[14], vv[15]);
          *(LAS v4u*)(VT + col * 72 + seg * 16) = w0; *(LAS v4u*)(VT + col * 72 + seg * 16 + 8) = w1;
          if (seg == 0) DEC[(size_t)unit * 128 + col] = exp_c(bl);
        }
        __syncthreads();
        { const int tm = wv >> 1, tn0 = (wv & 1) * 2;
          bf16x8 af[4];
#pragma unroll
          for (int ks = 0; ks < 4; ++ks) af[ks] = *(const LAS bf16x8*)(QS + (tm * 16 + r) * 136 + ks * 32 + kq * 8);
#pragma unroll
          for (int jn = 0; jn < 2; ++jn) { const int tn = tn0 + jn; f32x4 acc = {0.f, 0.f, 0.f, 0.f};
              if (tn <= tm) {
#pragma unroll
                  for (int ks = 0; ks < 4; ++ks) { const bf16x8 bf = *(const LAS bf16x8*)(KS + (tn * 16 + r) * 136 + ks * 32 + kq * 8); acc = __builtin_amdgcn_mfma_f32_16x16x32_bf16(af[ks], bf, acc, 0, 0, 0); } }
#pragma unroll
              for (int g = 0; g < 4; ++g) { const int t = tm * 16 + 4 * kq + g, s = tn * 16 + r; PS[t * 72 + s] = f2bf(s <= t ? acc[g] : 0.f); } } }
        { bf16x8 af[2];
#pragma unroll
          for (int ks = 0; ks < 2; ++ks) af[ks] = *(const LAS bf16x8*)(KPT + (wv * 16 + r) * 72 + ks * 32 + kq * 8);
#pragma unroll
          for (int tv = 0; tv < 8; ++tv) { f32x4 acc = {0.f, 0.f, 0.f, 0.f};
#pragma unroll
              for (int ks = 0; ks < 2; ++ks) { const bf16x8 bf = *(const LAS bf16x8*)(VT + (tv * 16 + r) * 72 + ks * 32 + kq * 8); acc = __builtin_amdgcn_mfma_f32_16x16x32_bf16(af[ks], bf, acc, 0, 0, 0); }
              v2u w; w.x = pk2(acc[0], acc[1]); w.y = pk2(acc[2], acc[3]);
              *(v2u*)(UT + (size_t)unit * 16384 + (tv * 16 + r) * 128 + wv * 16 + 4 * kq) = w; } }
        __syncthreads();
        { const int tm = wv & 3, tvg = wv >> 2;
          bf16x8 pf[2];
#pragma unroll
          for (int ks = 0; ks < 2; ++ks) pf[ks] = *(const LAS bf16x8*)(PS + (tm * 16 + r) * 72 + ks * 32 + kq * 8);
#pragma unroll
          for (int j = 0; j < 4; ++j) { const int tv = tvg * 4 + j; f32x4 acc = {0.f, 0.f, 0.f, 0.f};
#pragma unroll
              for (int ks = 0; ks < 2; ++ks) { const bf16x8 vf = *(const LAS bf16x8*)(VT + (tv * 16 + r) * 72 + ks * 32 + kq * 8); acc = __builtin_amdgcn_mfma_f32_16x16x32_bf16(vf, pf[ks], acc, 0, 0, 0); }
              v2u ow; ow.x = pk2(acc[0], acc[1]); ow.y = pk2(acc[2], acc[3]); *(v2u*)(OI + (size_t)(t0 + tm * 16 + r) * HGW + h * HGD + tv * 16 + 4 * kq) = ow; } }
        __syncthreads();
    }
#undef HL_LOAD
}
__device__ __forceinline__ void hgrn_scan(const Frame& F, const unsigned char* r2, v2u* __restrict__ SB64) {
    const v2u* __restrict__ UT64 = (const v2u*)(r2 + R2_UT); const f32x4* __restrict__ DEC4 = (const f32x4*)(r2 + R2_DEC);
    for (int it = blockIdx.x * 512 + F.tid; it < NB * HGH * 128 * 32; it += F.G * 512) {
        const int bh = it >> 12, v = (it >> 5) & 127, k4 = it & 31;
        f32x4 s = {0.f, 0.f, 0.f, 0.f};
#pragma unroll 16
        for (int c = 0; c < 64; ++c) { const size_t unit = (size_t)bh * 64 + c; const size_t idx = unit * 4096 + v * 32 + k4;
            const v2u w = UT64[idx]; const f32x4 d = DEC4[unit * 32 + k4];
            v2u o; o.x = pk2(s[0], s[1]); o.y = pk2(s[2], s[3]); SB64[idx] = o;
            s[0] = d[0] * s[0] + pg8::bf_lo(w.x); s[1] = d[1] * s[1] + pg8::bf_hi(w.x); s[2] = d[2] * s[2] + pg8::bf_lo(w.y); s[3] = d[3] * s[3] + pg8::bf_hi(w.y); }
    }
}
struct HoutOps { bf16x8 af[4]; bf16x8 bfr[4][4]; };
__device__ __forceinline__ void hout_load(HoutOps& O, int unit, const bf16* proj, const bf16* OI, const bf16* QP, const bf16* SB, int r, int kq, int tm, int tvg) {
    const int b = unit / (HGH * 64), h = (unit / 64) % HGH, c = unit % 64, t0 = b * SEQ + c * 64;
#pragma unroll
    for (int ks = 0; ks < 4; ++ks) O.af[ks] = *(const bf16x8*)(QP + (size_t)(t0 + tm * 16 + r) * HGW + h * HGD + ks * 32 + kq * 8);
#pragma unroll
    for (int j = 0; j < 4; ++j)
#pragma unroll
        for (int ks = 0; ks < 4; ++ks) O.bfr[j][ks] = *(const bf16x8*)(SB + (size_t)unit * 16384 + ((tvg * 4 + j) * 16 + r) * 128 + ks * 32 + kq * 8);
}
__device__ __forceinline__ void hout_compute(const HoutOps& O, int unit, const bf16* proj, const bf16* OI, LAS float* SSQ, const float* gain, bf16* YB, int lane, int r, int kq, int tm, int tvg) {
    const int b = unit / (HGH * 64), h = (unit / 64) % HGH, c = unit % 64, t0 = b * SEQ + c * 64;
    const size_t t = (size_t)(t0 + tm * 16 + r);
    f32x4 oi[4]; v2u gtw[4];
#pragma unroll
    for (int j = 0; j < 4; ++j) { const int ch = h * HGD + (tvg * 4 + j) * 16 + 4 * kq; { const v2u ow = *(const v2u*)(OI + t * HGW + ch); oi[j] = (f32x4){pg8::bf_lo(ow.x), pg8::bf_hi(ow.x), pg8::bf_lo(ow.y), pg8::bf_hi(ow.y)}; } gtw[j] = *(const v2u*)(proj + t * INC + C_G + ch); }
    f32x4 acc[4]; float q = 0.f;
#pragma unroll
    for (int j = 0; j < 4; ++j) { acc[j] = (f32x4){0.f, 0.f, 0.f, 0.f};
#pragma unroll
        for (int ks = 0; ks < 4; ++ks) acc[j] = __builtin_amdgcn_mfma_f32_16x16x32_bf16(O.bfr[j][ks], O.af[ks], acc[j], 0, 0, 0); }
#pragma unroll
    for (int j = 0; j < 4; ++j) { acc[j] += oi[j]; q += (acc[j][0] * acc[j][0] + acc[j][1] * acc[j][1]) + (acc[j][2] * acc[j][2] + acc[j][3] * acc[j][3]); }
    q += shx(q, 16, lane); q += shx(q, 32, lane);
    if (kq == 0) SSQ[tvg * 64 + tm * 16 + r] = q;
    __syncthreads();
    const float rs = rsqrtf((SSQ[tm * 16 + r] + SSQ[64 + tm * 16 + r]) * (1.f / 128.f) + RMS_EPS);
#pragma unroll
    for (int j = 0; j < 4; ++j) { const int ch = h * HGD + (tvg * 4 + j) * 16 + 4 * kq; const f32x4 gn = *(const f32x4*)(gain + ch);
        const float g0 = pg8::bf_lo(gtw[j].x), g1 = pg8::bf_hi(gtw[j].x), g2 = pg8::bf_lo(gtw[j].y), g3 = pg8::bf_hi(gtw[j].y);
        v2u w; w.x = pk2(acc[j][0] * rs * gn[0] * g0 * pg8::sigmoidf_(g0), acc[j][1] * rs * gn[1] * g1 * pg8::sigmoidf_(g1));
        w.y = pk2(acc[j][2] * rs * gn[2] * g2 * pg8::sigmoidf_(g2), acc[j][3] * rs * gn[3] * g3 * pg8::sigmoidf_(g3));
        *(v2u*)(YB + t * HGW + ch) = w; }
    __syncthreads();
}
__device__ __forceinline__ void hgrn_out(const Frame& F, const bf16* proj, const unsigned char* r2, const bf16* SB, const float* gain, bf16* YB) {
    LAS float* SSQ = (LAS float*)F.lds;
    const bf16* OI = (const bf16*)(r2 + R2_OI); const bf16* QP = (const bf16*)(r2 + R2_QP);
    const int lane = F.lane, wv = F.wave, r = lane & 15, kq = lane >> 4, tm = wv & 3, tvg = wv >> 2;
    HoutOps A, B;
    int unit = blockIdx.x;
    if (unit < NHU) hout_load(A, unit, proj, OI, QP, SB, r, kq, tm, tvg);
    for (; unit < NHU; unit += 2 * F.G) {
        const int u2 = unit + F.G, u3 = unit + 2 * F.G;
        if (u2 < NHU) hout_load(B, u2, proj, OI, QP, SB, r, kq, tm, tvg);
        hout_compute(A, unit, proj, OI, SSQ, gain, YB, lane, r, kq, tm, tvg);
        if (u2 < NHU) { if (u3 < NHU) hout_load(A, u3, proj, OI, QP, SB, r, kq, tm, tvg);
            hout_compute(B, u2, proj, OI, SSQ, gain, YB, lane, r, kq, tm, tvg); }
    }
}
__device__ __forceinline__ void memattn(const Frame& F, const bf16* proj, const bf16* KV, int layer, bf16* YX) {
    lbf16* Ks = (lbf16*)F.lds;
    lbf16* VTs = Ks + 256 * 136;
    const int lane = F.lane, wv = F.wave, r = lane & 15, kq = lane >> 4;
    for (int unit = blockIdx.x; unit < NB * XAH * (SEQ / 256); unit += F.G) {
        const int b = unit >> 6, hd = (unit >> 4) & 3, qt = unit & 15;
#pragma unroll
        for (int i = 0; i < 8; ++i) { const int p = F.tid + 512 * i, key = p >> 4, dc = (p & 15) * 8;
            const bf16* src = KV + (size_t)(b * NMEM + key) * 2048 + layer * 1024 + hd * XAD + dc;
            *(LAS v4u*)(Ks + key * 136 + dc) = *(const v4u*)src;
            const v4u w = *(const v4u*)(src + 512);
            const int k5 = key & 31, pos = (key & ~31) + 8 * ((k5 >> 2) & 3) + 4 * ((k5 >> 4) & 1) + (k5 & 3);
            lbf16* d = VTs + dc * 264 + pos;
            d[0] = (bf16)(w.x & 0xffffu); d[264] = (bf16)(w.x >> 16); d[2 * 264] = (bf16)(w.y & 0xffffu); d[3 * 264] = (bf16)(w.y >> 16);
            d[4 * 264] = (bf16)(w.z & 0xffffu); d[5 * 264] = (bf16)(w.z >> 16); d[6 * 264] = (bf16)(w.w & 0xffffu); d[7 * 264] = (bf16)(w.w >> 16); }
        __syncthreads();
#pragma unroll 1
        for (int g = 0; g < 2; ++g) {
            const int t = b * SEQ + qt * 256 + wv * 32 + g * 16 + r;
            bf16x8 qf[4];
#pragma unroll
            for (int ks = 0; ks < 4; ++ks) qf[ks] = *(const bf16x8*)(proj + (size_t)t * INC + C_QX + hd * XAD + ks * 32 + kq * 8);
            f32x4 s[16];
#pragma unroll
            for (int kt = 0; kt < 16; ++kt) { s[kt] = (f32x4){0.f, 0.f, 0.f, 0.f};
#pragma unroll
                for (int ks = 0; ks < 4; ++ks) { const bf16x8 a = *(const LAS bf16x8*)(Ks + (kt * 16 + r) * 136 + ks * 32 + kq * 8); s[kt] = __builtin_amdgcn_mfma_f32_16x16x32_bf16(a, qf[ks], s[kt], 0, 0, 0); }
                if (kt & 1) __builtin_amdgcn_sched_barrier(0); }
            float m = -1e30f;
#pragma unroll
            for (int kt = 0; kt < 16; ++kt) m = fmaxf(m, fmaxf(fmaxf(s[kt][0], s[kt][1]), fmaxf(s[kt][2], s[kt][3])));
            m = fmaxf(m, shx(m, 16, lane)); m = fmaxf(m, shx(m, 32, lane));
            const float cs = 0.08838834764831845f * 1.4426950408889634f; float l = 0.f;
#pragma unroll
            for (int kt = 0; kt < 16; ++kt)
#pragma unroll
                for (int e = 0; e < 4; ++e) { const float p = __builtin_amdgcn_exp2f((s[kt][e] - m) * cs); s[kt][e] = p; l += p; }
            l += shx(l, 16, lane); l += shx(l, 32, lane);
            f32x4 o[8];
#pragma unroll
            for (int dt = 0; dt < 8; ++dt) o[dt] = (f32x4){0.f, 0.f, 0.f, 0.f};
#pragma unroll
            for (int j = 0; j < 8; ++j) {
                v4u pw; pw.x = pk2(s[2 * j][0], s[2 * j][1]); pw.y = pk2(s[2 * j][2], s[2 * j][3]); pw.z = pk2(s[2 * j + 1][0], s[2 * j + 1][1]); pw.w = pk2(s[2 * j + 1][2], s[2 * j + 1][3]);
                const bf16x8 pf = __builtin_bit_cast(bf16x8, pw);
#pragma unroll
                for (int dt = 0; dt < 8; ++dt) { const bf16x8 a = *(const LAS bf16x8*)(VTs + (dt * 16 + r) * 264 + j * 32 + kq * 8); o[dt] = __builtin_amdgcn_mfma_f32_16x16x32_bf16(a, pf, o[dt], 0, 0, 0); }
                __builtin_amdgcn_sched_barrier(0); }
            const float inv = 1.f / l;
#pragma unroll
            for (int dt = 0; dt < 8; ++dt) { v2u w; w.x = pk2(o[dt][0] * inv, o[dt][1] * inv); w.y = pk2(o[dt][2] * inv, o[dt][3] * inv);
                *(v2u*)(YX + (size_t)t * YXW + hd * XAD + dt * 16 + 4 * kq) = w; }
        }
        __syncthreads();
    }
}
struct Args { const float* in[24]; float* out; unsigned char* ws; int ph_lo, ph_hi, mask, pad; };
typedef const __attribute__((address_space(4))) Args* KArgs;
__device__ __forceinline__ KArgs kargs() { KArgs p = (KArgs)__builtin_amdgcn_kernarg_segment_ptr(); asm volatile("" : "+s"(p)); return p; }
#define WSP(T, off) ((T*)(ws + (off)))
__global__ void __launch_bounds__(NWAVES * 64, 2) mk_fwd(Args args) {
    extern __shared__ __attribute__((aligned(16))) unsigned char lds_raw[];
    Frame F0; F0.lds = (LAS unsigned char*)lds_raw; F0.tid = threadIdx.x; F0.lane = F0.tid & 63; F0.wave = __builtin_amdgcn_readfirstlane(F0.tid >> 6);
    F0.G = gridDim.x; F0.gw = blockIdx.x * NWAVES + F0.wave; F0.NGW = F0.G * NWAVES;
    volatile LAS unsigned* MISC = (volatile LAS unsigned*)(F0.lds + MISC_OFF);
    for (int u = F0.tid; u < (LDS_BYTES - MISC_OFF) / 4; u += NWAVES * 64) ((LAS unsigned*)(F0.lds + MISC_OFF))[u] = 0u;
    __syncthreads();
    const int lo = args.ph_lo, hi = args.ph_hi;
    const bool multi = (hi - lo) > 1;
    XcdBarrier bar; bar.bar = (unsigned*)(args.ws + WS_CTL) + CW_BAR; bar.x = 0; bar.st = nullptr;
    if (multi) bar = xcd_barrier_post((unsigned*)(args.ws + WS_CTL) + CW_BAR, MISC + 8);
#define IN(k) (kargs()->ph_lo <= (k) && (k) < kargs()->ph_hi)
#define SEAM(k) do { if (IN((k) + 1)) xcd_barrier(bar); } while (0)
#define PH_BEGIN KArgs ka = kargs(); unsigned char* ws = ka->ws; (void)ws; Frame F = F0; { int w_ = F0.wave; asm volatile("" : "+s"(w_)); F.wave = w_; F.gw = (int)blockIdx.x * NWAVES + w_; } F.lane = pg8::lane_id_opaque(); F.tid = F.wave * 64 + F.lane
    if (IN(PH_CVT)) {
        { PH_BEGIN;
        unsigned gb = 0;
        for (int l = 0; l < 2; ++l) {
            xpose_matrix(F, ka->in[2] + (size_t)l * D * INC, D, INC, (bf16*)(ws + WS_WIN_T + l * WIN_T_L), D, 0, gb);
            xpose_matrix(F, ka->in[4] + (size_t)l * CW * D, CW, D, (bf16*)(ws + WS_WBR_T + l * WBR_T_L), CW, 0, gb);
            xpose_matrix(F, ka->in[7] + (size_t)l * HGW * D, HGW, D, (bf16*)(ws + WS_WBR_T + l * WBR_T_L + 3 * MiB), HGW, 0, gb);
            xpose_matrix(F, ka->in[10] + (size_t)l * XAW * D, XAW, D, (bf16*)(ws + WS_WBR_T + l * WBR_T_L + 6 * MiB), YXW, 0, gb);
            for (int i = blockIdx.x * 512 + F.tid; i < D * 32; i += F.G * 512) *(v4u*)((bf16*)(ws + WS_WBR_T + l * WBR_T_L + 6 * MiB) + (size_t)(i >> 5) * YXW + XAW + (i & 31) * 8) = (v4u){0u, 0u, 0u, 0u};
            xpose_matrix(F, ka->in[11] + (size_t)l * D * D, D, D, (bf16*)(ws + WS_WO_T + l * WO_T_L), D, 0, gb);
            xpose_matrix(F, ka->in[8] + (size_t)l * D * XAW, D, XAW, (bf16*)(ws + WS_WKV_T) + (size_t)(l * 1024) * D, D, 0, gb);
            xpose_matrix(F, ka->in[9] + (size_t)l * D * XAW, D, XAW, (bf16*)(ws + WS_WKV_T) + (size_t)(l * 1024 + 512) * D, D, 0, gb);
        }
        cvt_router(F, ka->in[14], ws);
        cvt_rows(F, ka->in[0], WSP(bf16, WS_XBF), (size_t)NTOK * D / 8);
        cvt_rows(F, ka->in[1], WSP(bf16, WS_MEMBF), (size_t)NB * NMEM * D / 8);
        }
        SEAM(PH_CVT);
    }
    for (int l = 0; l < 2; ++l) {
        const int pb = PH_L0 + l * PH_PER_LAYER;
        if (IN(pb + P_INPROJ)) {
            { PH_BEGIN;
            const bool split = F.G == 256;
            const int oa = (int)blockIdx.x >> 3, ox = (int)blockIdx.x & 7; const bool conv = split && ox < 2;
            const int hrank = 2 * oa + ox, grank = oa;
            static_assert((256 - NCV) * GM_UNITS + NCV * CV_UNITS == (NTOK / 256) * (INC / 256), "in-projection unit shares");
            if (conv) { Frame Fc = F; Fc.gw = hrank * NWAVES + F.wave; Fc.NGW = NCV * NWAVES; unsigned gb = 0;
                cvt_experts(Fc, ka->in[16] + (size_t)l * NE * D * EH, ka->in[17] + (size_t)l * NE * D * EH, ka->in[18] + (size_t)l * NE * EH * D, ka->in[19] + (size_t)l * D * EH, ka->in[20] + (size_t)l * D * EH, ka->in[21] + (size_t)l * EH * D, ws, gb);
                __syncthreads(); }
            if (!split) { unsigned gb = 0; cvt_experts(F, ka->in[16] + (size_t)l * NE * D * EH, ka->in[17] + (size_t)l * NE * D * EH, ka->in[18] + (size_t)l * NE * EH * D, ka->in[19] + (size_t)l * D * EH, ka->in[20] + (size_t)l * D * EH, ka->in[21] + (size_t)l * EH * D, ws, gb); __syncthreads(); }
            DenseSched S; S.init(ws + WS_XBF, ws + WS_WIN_T + l * WIN_T_L, NTOK, INC, D, F.G, (int)blockIdx.x);
            if (split) { S.lin = 1; S.cnt = conv ? CV_UNITS : GM_UNITS;
                if (conv) { S.L0 = (256 - NCV) * GM_UNITS; S.G = NCV; S.c = hrank; } else { S.L0 = (ox - 2) * 32 * GM_UNITS; S.G = 32; S.c = grank; } }
            EpiProj E{WSP(bf16, WS_R1), WSP(unsigned char, WS_GATE8)};
            pg8::gemm_phase<EpiProj, DenseSched, true>(F.lds + RING_OFF, F.wave, D, S, E);
            if (l == 0) {
                DenseSched S2; S2.init(ws + WS_MEMBF, ws + WS_WKV_T, NB * NMEM, 2048, D, split ? 32 : F.G, split ? ((conv && hrank < 32) ? hrank : -1) : (int)blockIdx.x);
                EpiBf16Plain E2{WSP(bf16, WS_KV), 2048};
                pg8::gemm_phase<EpiBf16Plain, DenseSched, true>(F.lds + RING_OFF, F.wave, D, S2, E2);
            }
            }
            SEAM(pb + P_INPROJ);
        }
        if (IN(pb + P_MIX)) {
            { PH_BEGIN;
            memattn(F, WSP(bf16, WS_R1), WSP(bf16, WS_KV), l, WSP(bf16, WS_YX));
            hgrn_local(F, WSP(bf16, WS_R1), ka->in[5], l, ws + WS_R2);
            conv_part(F, WSP(bf16, WS_R1), ka->in[3] + (size_t)l * 3 * CW, WSP(bf16, WS_YA), WSP(bf16, WS_YX));
            }
            SEAM(pb + P_MIX);
        }
        if (IN(pb + P_SCAN)) {
            { PH_BEGIN;
            hgrn_scan(F, ws + WS_R2, WSP(v2u, WS_ZF));
            }
            SEAM(pb + P_SCAN);
        }
        if (IN(pb + P_HOUT)) {
            { PH_BEGIN;
            hgrn_out(F, WSP(bf16, WS_R1), ws + WS_R2, WSP(bf16, WS_ZF), ka->in[6] + (size_t)l * HGW, WSP(bf16, WS_YB));
            }
            SEAM(pb + P_HOUT);
        }
        if (IN(pb + P_BRANCH)) {
            { PH_BEGIN;
            static_assert(WS_YX - WS_YB == WS_YB - WS_YA, "branch inputs equally spaced");
            BranchSched S; S.init(ws + WS_YA, ws + WS_WBR_T + l * WBR_T_L, F.G, (int)blockIdx.x); EpiGateRT E{WSP(unsigned char, WS_GATE8), WSP(bf16, WS_MERGED)};
            pg8::gemm_phase<EpiGateRT, BranchSched, true>(F.lds + RING_OFF, F.wave, CW, S, E);
            }
            SEAM(pb + P_BRANCH);
        }
        if (IN(pb + P_WO)) {
            { PH_BEGIN;
            DenseSched S; S.init(ws + WS_MERGED, ws + WS_WO_T + l * WO_T_L, NTOK, D, D, F.G, (int)blockIdx.x);
            EpiResid<true> E{(const void*)WSP(bf16, WS_XBF), WSP(bf16, WS_ZF)}; pg8::gemm_phase<EpiResid<true>, DenseSched, true>(F.lds + RING_OFF, F.wave, D, S, E);
            }
            SEAM(pb + P_WO);
        }
        if (IN(pb + P_ROUTE)) {
            { PH_BEGIN;
            route_phase(F, WSP(bf16, WS_ZF), ka->in[12] + (size_t)l * D, ka->in[13] + (size_t)l * D, WSP(bf16, WS_RW + l * RW_L), ka->in[15] + (size_t)l * NE, WSP(bf16, WS_X1F), WSP(bf16, WS_X1BF),
                        WSP(unsigned, WS_CTL) + CW_CNT + l * 64, WSP(int, WS_LIST), WSP(int, WS_TOKSLOT), WSP(float, WS_TOKW));
            }
            SEAM(pb + P_ROUTE);
        }
        if (IN(pb + P_GU)) {
            { PH_BEGIN;
            moe_plan(F, WSP(unsigned, WS_CTL) + CW_CNT + l * 64);
            MoeSched<true> S; S.init(F, ws + WS_X1BF, ws + WS_WGU, WSP(int, WS_LIST)); EpiSwiGLU E{WSP(bf16, WS_R2)};
            pg8::gemm_phase<EpiSwiGLU, MoeSched<true>, true>(F.lds + RING_OFF, F.wave, D, S, E);
            }
            SEAM(pb + P_GU);
        }
        if (IN(pb + P_DOWN)) {
            { PH_BEGIN;
            if (kargs()->ph_lo > pb + P_GU) moe_plan(F, WSP(unsigned, WS_CTL) + CW_CNT + l * 64);
            MoeSched<false> S; S.init(F, ws + WS_R2, ws + WS_WDN, nullptr); EpiY8 E{WSP(unsigned char, WS_R1), WSP(bf16, WS_R1 + R1_YS)};
            pg8::gemm_phase<EpiY8, MoeSched<false>, true>(F.lds + RING_OFF, F.wave, EH, S, E);
            }
            SEAM(pb + P_DOWN);
        }
        if (IN(pb + P_COMB)) {
            { PH_BEGIN;
            if (kargs()->ph_lo > pb + P_GU) moe_plan(F, WSP(unsigned, WS_CTL) + CW_CNT + l * 64);
            combine_phase(F, WSP(bf16, WS_X1BF), WSP(unsigned char, WS_R1), WSP(bf16, WS_R1 + R1_YS), WSP(int, WS_TOKSLOT), WSP(float, WS_TOKW), ka->in[22] + (size_t)l * D, ka->in[23] + (size_t)l * D, ka->out, WSP(bf16, WS_XBF), l == 1);
            }
            SEAM(pb + P_COMB);
        }
    }
#undef IN
#undef SEAM
}
static void launch_mk(Args a, int lo, int hi, int grid, hipStream_t stream) {
    a.ph_lo = lo; a.ph_hi = hi;
    hipLaunchKernelGGL(mk_fwd, dim3(grid), dim3(NWAVES * 64), LDS_BYTES, stream, a);
}
extern "C" void kernel_launch(void* const* d_in, const int* in_sizes, int n_in, void* d_out, int out_size, void* d_ws, size_t ws_size, hipStream_t stream) {
    static int grid = 0;
    if (grid == 0) {
        if (n_in != 24 || out_size != NTOK * D || ws_size < WS_END) { fprintf(stderr, "kernel_launch: unexpected sizes n_in %d out %d ws %zu\n", n_in, out_size, ws_size); grid = -1; return; }
        int dev = 0, cus = 0;
        if (hipGetDevice(&dev) != hipSuccess || hipDeviceGetAttribute(&cus, hipDeviceAttributeMultiprocessorCount, dev) != hipSuccess) { grid = -1; return; }
        if (hipFuncSetAttribute((const void*)mk_fwd, hipFuncAttributeMaxDynamicSharedMemorySize, LDS_BYTES) != hipSuccess) { fprintf(stderr, "kernel_launch: hipFuncSetAttribute failed\n"); grid = -1; return; }
        int per_cu = 0; (void)hipOccupancyMaxActiveBlocksPerMultiprocessor(&per_cu, (const void*)mk_fwd, NWAVES * 64, LDS_BYTES); (void)hipGetLastError();
        if (per_cu < 1) fprintf(stderr, "kernel_launch: occupancy query says %d\n", per_cu);
        grid = cus;
    }
    if (grid < 0) return;
    const float* x = (const float*)d_in[0];
    const float* conv_w = (const float*)d_in[3]; const float* lbl = (const float*)d_in[5];
    const float* hg_g = (const float*)d_in[6];
    const float* ln1_g = (const float*)d_in[12]; const float* ln1_b = (const float*)d_in[13]; const float* router_w = (const float*)d_in[14];
    const float* router_b = (const float*)d_in[15]; const float* exp_wg = (const float*)d_in[16]; const float* exp_wu = (const float*)d_in[17];
    const float* exp_wd = (const float*)d_in[18]; const float* sh_wg = (const float*)d_in[19]; const float* sh_wu = (const float*)d_in[20];
    const float* sh_wd = (const float*)d_in[21]; const float* ln2_g = (const float*)d_in[22]; const float* ln2_b = (const float*)d_in[23];
    unsigned char* ws = (unsigned char*)d_ws; float* out = (float*)d_out;
    unsigned* ctl = (unsigned*)(ws + WS_CTL);
    bf16* KV = (bf16*)(ws + WS_KV); bf16* XBF = (bf16*)(ws + WS_XBF); float* X1F = (float*)(ws + WS_X1F);
    bf16* X1BF = (bf16*)(ws + WS_X1BF); float* ZF = (float*)(ws + WS_ZF);
    bf16* YA = (bf16*)(ws + WS_YA); bf16* YB = (bf16*)(ws + WS_YB); bf16* YX = (bf16*)(ws + WS_YX);
    bf16* H = (bf16*)(ws + WS_R2); float* OH = (float*)(ws + WS_R2); bf16* PROJ = (bf16*)(ws + WS_R1); bf16* Y = (bf16*)(ws + WS_R1);
    int* LIST = (int*)(ws + WS_LIST); int* TOKSLOT = (int*)(ws + WS_TOKSLOT); float* TOKW = (float*)(ws + WS_TOKW);
    Args a{};
    for (int i = 0; i < 24; ++i) a.in[i] = (const float*)d_in[i];
    a.out = out; a.ws = ws;

    (void)hipMemsetAsync(ws + WS_CTL, 0, (size_t)(CW_BAR + XCD_BAR_WORDS) * 4, stream);
    a.mask = 7;
    launch_mk(a, 0, N_PHASES, grid, stream);
}
```

```cpp
#include <hip/hip_runtime.h>
#include <stdint.h>
#include <stdio.h>

typedef unsigned short bf16;
__device__ __forceinline__ float bf2f(bf16 v) { return __uint_as_float(((unsigned)v) << 16); }
__device__ __forceinline__ bf16 f2bf(float f) { unsigned u = __float_as_uint(f); return (bf16)((u + 0x7fffu + ((u >> 16) & 1u)) >> 16); }

constexpr int NB = 4, SEQ = 4096, NTOK = NB * SEQ, D = 2048, NMEM = 256;
constexpr int CW = 768, HGW = 768, HGH = 6, HGD = 128, XAW = 512, XAH = 4, XAD = 128;
constexpr int INC = 12032, YXW = 768, GW8 = 3 * 2048, PN_GATE = 23;
constexpr int C_U = 0, C_B = 768, C_C = 1536, C_Q = 2304, C_F = 3072, C_I = 3840, C_G = 4608, C_QX = 5376, C_GA = 5888, C_GB = 7936, C_GX = 9984;
constexpr int NE = 64, TOPK = 8, EH = 512;
constexpr float ALPHA = 1.41421356237f, LN_EPS = 1e-5f, RMS_EPS = 1e-6f, RSCALE = 2.5f;
constexpr int LISTCAP = 16384;

constexpr size_t MiB = 1u << 20;
constexpr size_t WS_CTL = 0, CTL_BYTES = 1 * MiB;
constexpr size_t WS_RW = 1 * MiB, RW_L = 512 * 1024;
constexpr size_t WS_WIN_T = 2 * MiB, WIN_T_L = 47 * MiB;
constexpr size_t WS_WBR_T = 1932 * MiB, WBR_T_L = 9 * MiB;
constexpr size_t WS_WO_T = 112 * MiB, WO_T_L = 8 * MiB;
constexpr size_t WS_WKV_T = 128 * MiB;
constexpr size_t WS_MEMBF = 136 * MiB, WS_KV = 140 * MiB;
constexpr size_t WS_WGU = 144 * MiB, WGU_E = 4 * MiB;
constexpr size_t WS_WDN = 404 * MiB, WDN_E = 2 * MiB;
constexpr size_t WS_XBF = 534 * MiB, WS_X1F = 598 * MiB, WS_X1BF = 726 * MiB, WS_ZF = 790 * MiB, WS_MERGED = 918 * MiB;
constexpr size_t WS_YA = 1860 * MiB, WS_YB = 1884 * MiB, WS_YX = 1908 * MiB;
constexpr size_t WS_R2 = 1046 * MiB;
constexpr size_t WS_R1 = 1214 * MiB;
constexpr size_t R1_YS = 320 * MiB;
constexpr size_t WS_LIST = 1854 * MiB, WS_TOKSLOT = 1858 * MiB, WS_TOKW = 1859 * MiB, WS_GATE8 = 1950 * MiB, WS_END = 2046 * MiB;
constexpr int CW_CNT = 1024;
constexpr int CW_PLAN = 2048;
constexpr int CW_BAR = 4096;
#ifndef DBG_MASK
#define DBG_MASK 7
#endif
namespace pg8 {
#define PG8_LAS __attribute__((address_space(3)))
typedef unsigned short bf16_t;
typedef short bf16x8 __attribute__((ext_vector_type(8)));
typedef float f32x4 __attribute__((ext_vector_type(4)));
typedef unsigned u32x4 __attribute__((ext_vector_type(4)));
typedef unsigned u32x2 __attribute__((ext_vector_type(2)));
constexpr int PG8_NVO_OFF = 147456 + 1024;
constexpr int BM = 256, BK = 64, HALF = 128, HTB = HALF * BK * 2  , STAGE_BYTES = 8 * HTB, NXCD = 8, WGM = 8;

__host__ __device__ __forceinline__ int lds_byte(int r, int c) { const int st = (r >> 4) * 2 + (c >> 5), rr = r & 15, cc = c & 31, ob = rr * 64 + cc * 2; return st * 1024 + (ob ^ (((ob >> 9) & 1) << 5)); }
__host__ __device__ __forceinline__ void stage_rc(int b, int& R, int& C) { const int st = b / 1024, sb = b % 1024, swz = sb ^ (((sb >> 9) & 1) << 5); R = (st >> 1) * 16 + swz / 64; C = (st & 1) * 32 + (swz % 64) / 2; }
__host__ __device__ __forceinline__ int perm32(int rho) { const int n = rho >> 4, i = rho & 15; return 8 * (i >> 2) + 4 * n + (i & 3); }

struct Unit { const char* A; const char* B; int pm, pn; const int* list; int m0, cnt; };

typedef float f32x2_ __attribute__((ext_vector_type(2)));
typedef __bf16 bf16x2_ __attribute__((ext_vector_type(2)));
__device__ __forceinline__ unsigned cvt_pk_bf16(float lo, float hi) { const f32x2_ v = {lo, hi}; const bf16x2_ b = __builtin_convertvector(v, bf16x2_); return __builtin_bit_cast(unsigned, b); }
__device__ __forceinline__ int lane_id_opaque() { unsigned m = ~0u; asm volatile("" : "+s"(m)); return (int)__builtin_amdgcn_mbcnt_hi(m, __builtin_amdgcn_mbcnt_lo(m, 0u)); }
__device__ __forceinline__ float bf_lo(unsigned w) { return __uint_as_float(w << 16); }
__device__ __forceinline__ float bf_hi(unsigned w) { return __uint_as_float(w & 0xffff0000u); }
__device__ __forceinline__ float sigmoidf_(float x) { return __builtin_amdgcn_rcpf(1.f + __expf(-x)); }

typedef f32x4 Acc[2][2][4][2];

template <class Epi, class Sched, bool ALIGN_EPI>
__device__ __forceinline__ void gemm_phase(PG8_LAS unsigned char* lds, const int wave, const int K_in, const Sched& S, const Epi& E) {
    const int lane = lane_id_opaque(), wid = wave, tid = wid * 64 + lane, wr = wid >> 2, wc = wid & 3, fr = lane & 15, fq = lane >> 4;
    int K = K_in; asm volatile("" : "+s"(K));
    const int nt = K / BK;
    unsigned voffB[2];
#pragma unroll
    for (int i = 0; i < 2; ++i) { int R, C; stage_rc(tid * 16 + i * 8192, R, C); const int Rb = Epi::PERM ? ((R & ~31) + perm32(R & 31)) : R; voffB[i] = (unsigned)(Rb * K + C) * 2u; }
    const size_t kstep = (size_t)(BK * 2);
    const size_t hstep = (size_t)HALF * K * 2;
    const unsigned ldsw = (unsigned)wid * 1024u;
    const int aoff = lds_byte(wr * 64 + fr, fq * 8), boff = lds_byte(wc * 32 + fr, fq * 8);
#define PG8_SA(b, h) (((b) * 2 + (h)) * HTB)
#define PG8_SB(b, h) ((4 + (b) * 2 + (h)) * HTB)
#define PG8_STAGE2(bufoff, gbase, v0, v1) do { \
        __builtin_amdgcn_global_load_lds((const unsigned*)((const char*)(gbase) + (v0)), (PG8_LAS unsigned*)(lds + (bufoff) + ldsw), 16, 0, 0); \
        __builtin_amdgcn_global_load_lds((const unsigned*)((const char*)(gbase) + (v1)), (PG8_LAS unsigned*)(lds + (bufoff) + ldsw + 8192), 16, 0, 0); } while (0)
#define PG8_STAGEB(bufoff, gbase) PG8_STAGE2(bufoff, gbase, voffB[0], voffB[1])
#define PG8_LDA(dst, b, h) do { _Pragma("unroll") for (int m = 0; m < 4; ++m) _Pragma("unroll") for (int k = 0; k < 2; ++k) dst[m][k] = *(const PG8_LAS bf16x8*)(lds + PG8_SA(b, h) + aoff + m * 2048 + k * 1024); } while (0)
#define PG8_LDB(dst, b, h) do { _Pragma("unroll") for (int n = 0; n < 2; ++n) _Pragma("unroll") for (int k = 0; k < 2; ++k) dst[n][k] = *(const PG8_LAS bf16x8*)(lds + PG8_SB(b, h) + boff + n * 2048 + k * 1024); } while (0)
#define PG8_MMA(ai, bj, At, Bt) do { __builtin_amdgcn_s_setprio(1); _Pragma("unroll") for (int m = 0; m < 4; ++m) _Pragma("unroll") for (int n = 0; n < 2; ++n) _Pragma("unroll") for (int k = 0; k < 2; ++k) \
        acc[ai][bj][m][n] = __builtin_amdgcn_mfma_f32_16x16x32_bf16(Bt[n][k], At[m][k], acc[ai][bj][m][n], 0, 0, 0); __builtin_amdgcn_s_setprio(0); } while (0)
#define PG8_WAIT_V(n) asm volatile("s_waitcnt vmcnt(" #n ")" ::: "memory")
#define PG8_WAIT_L(n) asm volatile("s_waitcnt lgkmcnt(" #n ")" ::: "memory")
#define PG8_BAR __builtin_amdgcn_s_barrier()
#define PG8_SCHED __builtin_amdgcn_sched_barrier(0)
    Unit cur, nxt; int ui = 0;
    if (!S.next(0, cur)) return;
    Acc acc;
#pragma unroll
    for (int a = 0; a < 2; ++a)
#pragma unroll
        for (int b = 0; b < 2; ++b)
#pragma unroll
            for (int m = 0; m < 4; ++m)
#pragma unroll
                for (int n = 0; n < 2; ++n) acc[a][b][m][n] = (f32x4){0.f, 0.f, 0.f, 0.f};
    bf16x8 At[4][2], B0[2][2], B1[2][2];
    constexpr bool GA = Sched::GATHER;
    unsigned c00, c01, c10 = 0, c11 = 0;
    PG8_LAS unsigned* nvo = (PG8_LAS unsigned*)(lds + PG8_NVO_OFF) + tid * 4;
    { int R0, C0, R1, C1; stage_rc(tid * 16, R0, C0); stage_rc(tid * 16 + 8192, R1, C1);
      c00 = S.avoff(cur, 0, R0, C0, K); c01 = S.avoff(cur, 0, R1, C1, K); if constexpr (GA) { c10 = S.avoff(cur, 1, R0, C0, K); c11 = S.avoff(cur, 1, R1, C1, K); } }
    const size_t hA = GA ? (size_t)0 : hstep;
#define PG8_STAGEA0(bufoff, gbase) PG8_STAGE2(bufoff, gbase, c00, c01)
#define PG8_STAGEA1(bufoff, gbase) do { if constexpr (GA) PG8_STAGE2(bufoff, gbase, c10, c11); else PG8_STAGE2(bufoff, (gbase) + hA, c00, c01); } while (0)
    const char* cA = cur.A; const char* cB = cur.B;
    PG8_STAGEB(PG8_SB(0, 0), cB); PG8_STAGEB(PG8_SB(0, 1), cB + hstep); PG8_STAGEA0(PG8_SA(0, 0), cA); PG8_STAGEA1(PG8_SA(0, 1), cA);
    if (wr == 1) PG8_BAR;
    PG8_WAIT_V(2); PG8_BAR;
    PG8_STAGEB(PG8_SB(1, 0), cB + kstep); PG8_STAGEA0(PG8_SA(1, 0), cA + kstep); PG8_STAGEB(PG8_SB(1, 1), cB + hstep + kstep);
    PG8_WAIT_V(6); PG8_BAR;
    int pi0 = 0, pi1 = 0, pi2 = 0, pi3 = 0;
    if constexpr (GA) { Unit n1; if (S.next(1, n1)) { int R0, C0, R1, C1; stage_rc(tid * 16, R0, C0); stage_rc(tid * 16 + 8192, R1, C1);
        pi0 = S.avload(n1, 0, R0); pi1 = S.avload(n1, 0, R1); pi2 = S.avload(n1, 1, R0); pi3 = S.avload(n1, 1, R1); } }
    for (;;) {
        const bool has_next = S.next(ui + 1, nxt);
        const char* nA = has_next ? nxt.A : cA; const char* nB = has_next ? nxt.B : cB;
        if constexpr (GA) { if (has_next) {
            int R0, C0, R1, C1; stage_rc(tid * 16, R0, C0); stage_rc(tid * 16 + 8192, R1, C1);
            nvo[0] = S.avfin(nxt, 0, R0, C0, K, pi0); nvo[1] = S.avfin(nxt, 0, R1, C1, K, pi1); nvo[2] = S.avfin(nxt, 1, R0, C0, K, pi2); nvo[3] = S.avfin(nxt, 1, R1, C1, K, pi3); } }
        for (int t = 0; t < nt; t += 2) {
            const bool last = (t == nt - 2);
            const char* a1 = cA + (size_t)(t + 1) * kstep;
            const char* a2 = last ? nA : cA + (size_t)(t + 2) * kstep; const char* b2 = last ? nB : cB + (size_t)(t + 2) * kstep;
            const char* a3 = a2 + kstep; const char* b3 = b2 + kstep;
            const bool nx = GA && last && has_next;
#define PG8_STAGEA0N(bufoff, gbase) do { if (nx) { const unsigned q0 = nvo[0], q1 = nvo[1]; PG8_STAGE2(bufoff, gbase, q0, q1); } else PG8_STAGEA0(bufoff, gbase); } while (0)
#define PG8_STAGEA1N(bufoff, gbase) do { if (nx) { const unsigned q0 = nvo[2], q1 = nvo[3]; PG8_STAGE2(bufoff, gbase, q0, q1); } else PG8_STAGEA1(bufoff, gbase); } while (0)
            PG8_LDB(B0, 0, 0); PG8_LDB(B1, 0, 1); PG8_SCHED; PG8_LDA(At, 0, 0); PG8_STAGEA1(PG8_SA(1, 1), a1);
            PG8_WAIT_V(8); PG8_WAIT_L(0); PG8_BAR; PG8_MMA(0, 0, At, B0); PG8_MMA(0, 1, At, B1); PG8_BAR; PG8_SCHED;
            PG8_LDA(At, 0, 1); PG8_STAGEB(PG8_SB(0, 0), b2); PG8_STAGEB(PG8_SB(0, 1), b2 + hstep); PG8_STAGEA0N(PG8_SA(0, 0), a2);
            PG8_WAIT_V(8); PG8_WAIT_L(0); PG8_BAR; PG8_MMA(1, 0, At, B0); PG8_MMA(1, 1, At, B1); PG8_BAR; PG8_SCHED;
            PG8_LDB(B0, 1, 0); PG8_LDB(B1, 1, 1); PG8_SCHED; PG8_LDA(At, 1, 0); PG8_STAGEA1N(PG8_SA(0, 1), a2);
            PG8_WAIT_V(8); PG8_WAIT_L(0); PG8_BAR; PG8_MMA(0, 0, At, B0); PG8_MMA(0, 1, At, B1); PG8_BAR; PG8_SCHED;
            PG8_LDA(At, 1, 1); PG8_STAGEB(PG8_SB(1, 0), b3); PG8_STAGEB(PG8_SB(1, 1), b3 + hstep); PG8_STAGEA0N(PG8_SA(1, 0), a3);
            PG8_WAIT_V(8); PG8_WAIT_L(0); PG8_BAR; PG8_MMA(1, 0, At, B0); PG8_MMA(1, 1, At, B1); PG8_BAR; PG8_SCHED;
#undef PG8_STAGEA0N
#undef PG8_STAGEA1N
        }
        if constexpr (GA) { Unit n2; if (has_next && S.next(ui + 2, n2)) { int R0, C0, R1, C1; stage_rc(tid * 16, R0, C0); stage_rc(tid * 16 + 8192, R1, C1);
            pi0 = S.avload(n2, 0, R0); pi1 = S.avload(n2, 0, R1); pi2 = S.avload(n2, 1, R0); pi3 = S.avload(n2, 1, R1); } }
        if constexpr (ALIGN_EPI) { if (wr == 0) PG8_BAR; }
        bool keep = false;
        if constexpr (Epi::INPLACE) keep = E.inplace(acc, cur, wr, wc, fr, fq); else E(acc, cur, wr, wc, fr, fq);
        if (!has_next) break;
        if (!keep)
#pragma unroll
        for (int a = 0; a < 2; ++a)
#pragma unroll
            for (int b = 0; b < 2; ++b)
#pragma unroll
                for (int m = 0; m < 4; ++m)
#pragma unroll
                    for (int n = 0; n < 2; ++n) acc[a][b][m][n] = (f32x4){0.f, 0.f, 0.f, 0.f};
        cur = nxt; cA = nA; cB = nB; ++ui; if constexpr (GA) { c00 = nvo[0]; c01 = nvo[1]; c10 = nvo[2]; c11 = nvo[3]; }
        if constexpr (ALIGN_EPI) { if (wr == 1) PG8_BAR; }
    }
    PG8_WAIT_V(0);
    if constexpr (!ALIGN_EPI) { if (wr == 0) PG8_BAR; }
    PG8_BAR;
#undef PG8_SA
#undef PG8_SB
#undef PG8_STAGE2
#undef PG8_STAGEB
#undef PG8_STAGEA0
#undef PG8_STAGEA1
#undef PG8_LDA
#undef PG8_LDB
#undef PG8_MMA
#undef PG8_WAIT_V
#undef PG8_WAIT_L
#undef PG8_BAR
#undef PG8_SCHED
}
}
#define GAS __attribute__((address_space(1)))
#define LAS __attribute__((address_space(3)))
typedef unsigned v4u __attribute__((ext_vector_type(4)));
typedef unsigned v2u __attribute__((ext_vector_type(2)));
typedef float f32x4 __attribute__((ext_vector_type(4)));
typedef short bf16x8 __attribute__((ext_vector_type(8)));
typedef GAS unsigned gu32;
#define RLX_AGENT __ATOMIC_RELAXED, __HIP_MEMORY_SCOPE_AGENT
#define LDS_WAIT() asm volatile("s_waitcnt lgkmcnt(0)" ::: "memory")
#define VM_WAIT() asm volatile("s_waitcnt vmcnt(0)" ::: "memory")
__device__ __forceinline__ int opaque_v(int x) { asm volatile("" : "+v"(x)); return x; }
__device__ __forceinline__ float shx(float v, int o, int lane) { return __int_as_float(__builtin_amdgcn_ds_bpermute((lane ^ o) << 2, __float_as_int(v))); }
__device__ __forceinline__ unsigned pk2(float lo, float hi) { return pg8::cvt_pk_bf16(lo, hi); }

#define XB_TMO      128
#define XB_XCNT(j)  (256  + 64 * (j))
#define XB_XSUB(j)  (1280 + 64 * (j))
#define XB_XGEN(j)  (2304 + 64 * (j))
#define XB_TOP      3328
#define XB_TOPGEN   3392
#define XCD_BAR_WORDS 3456
#define XB_SPIN_CAP (1u << 18)
__device__ __forceinline__ unsigned xb_ld(unsigned* p)              { return __hip_atomic_load(p, __ATOMIC_RELAXED, __HIP_MEMORY_SCOPE_AGENT); }
__device__ __forceinline__ unsigned xb_add(unsigned* p, unsigned v) { return __hip_atomic_fetch_add(p, v, __ATOMIC_RELAXED, __HIP_MEMORY_SCOPE_AGENT); }
__device__ __forceinline__ unsigned xb_xcc_id() { return (unsigned)__builtin_amdgcn_s_getreg((3 << 11) | 20) & 0xFu; }
#define XB_SPIN(cond, bar) do { unsigned _sp = 0; while (cond) { __builtin_amdgcn_s_sleep(1); \
    if ((++_sp & 255u) == 0u) { if (xb_ld(&(bar)[XB_TMO])) break; if (_sp > XB_SPIN_CAP) { atomicAdd(&(bar)[XB_TMO], 1u); break; } } } } while (0)
struct XcdBarrier { unsigned* bar; unsigned x; volatile LAS unsigned* st; };
__device__ __forceinline__ XcdBarrier xcd_barrier_post(unsigned* bar, volatile LAS unsigned* st) {
    XcdBarrier b; b.bar = bar; b.x = xb_xcc_id(); b.st = st;
    if (threadIdx.x == 0) (void)xb_add(&bar[XB_XCNT(b.x)], 1u);
    return b;
}
__device__ __forceinline__ void xcd_barrier_complete(unsigned* bar, unsigned x, unsigned& nloc, unsigned& nx) {
    const unsigned G = gridDim.x * gridDim.y * gridDim.z;
    unsigned sum, cnt, mine, sp = 0u;
    for (;;) {
        sum = 0u; cnt = 0u; mine = 0u;
#pragma unroll
        for (unsigned j = 0; j < 16; ++j) { const unsigned c = xb_ld(&bar[XB_XCNT(j)]); sum += c; cnt += (c > 0u) ? 1u : 0u; mine = (j == x) ? c : mine; }
        if (sum == G) break;
        __builtin_amdgcn_s_sleep(1);
        if ((++sp & 255u) == 0u) { if (xb_ld(&bar[XB_TMO])) break; if (sp > XB_SPIN_CAP) { atomicAdd(&bar[XB_TMO], 1u); break; } }
    }
    nloc = mine > 0u ? mine : 1u; nx = cnt > 0u ? cnt : 1u;
}
__device__ __forceinline__ void xcd_barrier(const XcdBarrier& b_in) {
    asm volatile("s_waitcnt vmcnt(0)" ::: "memory");
    __syncthreads();
    if (threadIdx.x == 0) {
        XcdBarrier b = b_in; asm volatile("" : "+s"(b.x));
        unsigned* bar = b.bar; asm volatile("" : "+s"(bar));
        __builtin_amdgcn_s_waitcnt(0);
        unsigned nloc = b.st[0], nx = b.st[1];
        if (nloc == 0u) { xcd_barrier_complete(bar, b.x, nloc, nx); b.st[0] = nloc; b.st[1] = nx; }
        const unsigned old = xb_add(&bar[XB_XSUB(b.x)], 1u);
        const unsigned gen = old / nloc;
        if (old + 1u == (gen + 1u) * nloc) {
            __builtin_amdgcn_fence(__ATOMIC_RELEASE, "agent");
            asm volatile("s_waitcnt vmcnt(0)" ::: "memory");
            const unsigned og = xb_add(&bar[XB_TOP], 1u);
            const unsigned tg = og / nx;
            if (og + 1u == (tg + 1u) * nx) xb_add(&bar[XB_TOPGEN], 1u);
            else XB_SPIN(xb_ld(&bar[XB_TOPGEN]) == tg, bar);
            __builtin_amdgcn_fence(__ATOMIC_ACQUIRE, "agent");
            xb_add(&bar[XB_XGEN(b.x)], 1u);
            asm volatile("s_waitcnt vmcnt(0)" ::: "memory");
        } else {
            XB_SPIN(xb_ld(&bar[XB_XGEN(b.x)]) == gen, bar);
            __builtin_amdgcn_fence(__ATOMIC_ACQUIRE, "agent");
            asm volatile("s_waitcnt vmcnt(0)" ::: "memory");
        }
    }
    __syncthreads();
}
using pg8::Unit; using pg8::Acc;
struct DenseSched { static constexpr bool GATHER = false;
    const char* A; const char* B; int nM, nN, nwg, G, c, K; int L0 = 0, cnt = 1 << 30, lin = 0;
    __device__ __forceinline__ void init(const void* A_, const void* B_, int M, int N, int K_, int G_, int c_) { A = (const char*)A_; B = (const char*)B_; nM = M / 256; nN = N / 256; nwg = nM * nN; G = G_; c = c_; K = K_; }
    __device__ __forceinline__ bool next(int i, Unit& u) const {
        const long L = (long)L0 + (long)i * G + c; if (c < 0 || i >= cnt || L >= nwg) return false;
        int wgid = (int)L; if (!lin) { const int q = nwg / 8, r = nwg % 8, xcd = wgid % 8, off = wgid / 8; wgid = (xcd < r ? xcd * (q + 1) : r * (q + 1) + (xcd - r) * q) + off; }
        const int nig = 8 * nN, gid = wgid / nig, fm = gid * 8, gsz = (nM - fm) < 8 ? (nM - fm) : 8;
        u.pm = fm + ((wgid % nig) % gsz); u.pn = (wgid % nig) / gsz;
        u.A = A + (size_t)u.pm * 256 * K * 2; u.B = B + (size_t)u.pn * 256 * K * 2; u.list = nullptr; u.m0 = 0; u.cnt = 0; return true;
    }
    __device__ __forceinline__ int avload(const Unit&, int, int) const { return 0; }
    __device__ __forceinline__ unsigned avfin(const Unit&, int h, int R, int C, int K_, int) const { return (unsigned)(((h * 128 + R) * K_ + C) * 2); }
    __device__ __forceinline__ unsigned avoff(const Unit&, int h, int R, int C, int K_) const { return (unsigned)(((h * 128 + R) * K_ + C) * 2); }
};
struct EpiBf16Plain { static constexpr bool PERM = true, INPLACE = false; bf16* O; int ldc;
    __device__ __forceinline__ void operator()(const Acc& acc, const Unit& u, int wr, int wc, int fr, int fq) const {
        const int row0 = u.pm * 256 + wr * 64 + fr, col0 = u.pn * 256 + wc * 32 + 8 * fq;
#pragma unroll
        for (int ai = 0; ai < 2; ++ai)
#pragma unroll
            for (int m = 0; m < 4; ++m) { bf16* rowp = O + (size_t)(row0 + ai * 128 + m * 16) * ldc + col0;
#pragma unroll
                for (int bj = 0; bj < 2; ++bj) { const f32x4 v0 = acc[ai][bj][m][0], v1 = acc[ai][bj][m][1];
                    v4u w; w.x = pk2(v0[0], v0[1]); w.y = pk2(v0[2], v0[3]); w.z = pk2(v1[0], v1[1]); w.w = pk2(v1[2], v1[3]);
                    *(v4u*)(rowp + bj * 128) = w; } }
    }
};
struct EpiProj { static constexpr bool PERM = true, INPLACE = false; bf16* O; unsigned char* G8;
    __device__ __forceinline__ void operator()(const Acc& acc, const Unit& u, int wr, int wc, int fr, int fq) const {
        const int row0 = u.pm * 256 + wr * 64 + fr;
        if (u.pn < PN_GATE) { const int col0 = u.pn * 256 + wc * 32 + 8 * fq;
#pragma unroll
            for (int ai = 0; ai < 2; ++ai)
#pragma unroll
                for (int m = 0; m < 4; ++m) { bf16* rowp = O + (size_t)(row0 + ai * 128 + m * 16) * INC + col0;
#pragma unroll
                    for (int bj = 0; bj < 2; ++bj) { const f32x4 v0 = acc[ai][bj][m][0], v1 = acc[ai][bj][m][1];
                        v4u w; w.x = pk2(v0[0], v0[1]); w.y = pk2(v0[2], v0[3]); w.z = pk2(v1[0], v1[1]); w.w = pk2(v1[2], v1[3]);
                        *(v4u*)(rowp + bj * 128) = w; } }
        } else { const int pos0 = (u.pn - PN_GATE) * 256 + wc * 64 + fq * 16;
#pragma unroll
            for (int ai = 0; ai < 2; ++ai)
#pragma unroll
                for (int m = 0; m < 4; ++m) { unsigned char* rowp = G8 + (size_t)(row0 + ai * 128 + m * 16) * GW8 + pos0;
                    v4u w;
#pragma unroll
                    for (int bj = 0; bj < 2; ++bj) { const f32x4 v0 = acc[ai][bj][m][0], v1 = acc[ai][bj][m][1];
                        unsigned q[8];
#pragma unroll
                        for (int j = 0; j < 4; ++j) { q[j] = (unsigned)fmaxf(pg8::sigmoidf_(v0[j]) * 255.f + 0.5f, 1.f); q[4 + j] = (unsigned)fmaxf(pg8::sigmoidf_(v1[j]) * 255.f + 0.5f, 1.f); }
                        const unsigned lo = q[0] | (q[1] << 8) | (q[2] << 16) | (q[3] << 24), hi = q[4] | (q[5] << 8) | (q[6] << 16) | (q[7] << 24);
                        if (bj == 0) { w.x = lo; w.y = hi; } else { w.z = lo; w.w = hi; } }
                    *(v4u*)rowp = w; }
        }
    }
};
struct BranchSched { static constexpr bool GATHER = false;
    const char* A0; const char* B; int G, c;
    __device__ __forceinline__ void init(const void* ya, const void* w, int G_, int c_) { A0 = (const char*)ya; B = (const char*)w; G = G_; c = c_; }
    __device__ __forceinline__ bool next(int i, Unit& u) const {
        const int j = i / 3, seg = i - 3 * j; constexpr int nM = NTOK / 256, nN = D / 256, nwg = nM * nN;
        const int L = j * G + c; if (L >= nwg) return false;
        int wgid = L; { const int q = nwg / 8, xcd = wgid % 8, off = wgid / 8; wgid = xcd * q + off; }
        const int nig = 8 * nN; u.pm = (wgid / nig) * 8 + ((wgid % nig) % 8); u.pn = (wgid % nig) / 8;
        u.A = A0 + (size_t)seg * (WS_YB - WS_YA) + (size_t)u.pm * 256 * CW * 2; u.B = B + (size_t)seg * 3 * MiB + (size_t)u.pn * 256 * CW * 2; u.list = nullptr; u.m0 = seg; u.cnt = 0; return true; }
    __device__ __forceinline__ int avload(const Unit&, int, int) const { return 0; }
    __device__ __forceinline__ unsigned avfin(const Unit&, int h, int R, int C, int K_, int) const { return (unsigned)(((h * 128 + R) * K_ + C) * 2); }
    __device__ __forceinline__ unsigned avoff(const Unit&, int h, int R, int C, int K_) const { return (unsigned)(((h * 128 + R) * K_ + C) * 2); }
};
struct EpiGateRT { static constexpr bool PERM = true, INPLACE = true; const unsigned char* g8; bf16* merged;
    __device__ __forceinline__ bool inplace(Acc& acc, const Unit& u, int wr, int wc, int fr, int fq) const {
        const int row0 = u.pm * 256 + wr * 64 + fr, col0 = u.pn * 256 + wc * 32 + 8 * fq, pos0 = u.pn * 256 + wc * 64 + fq * 16; const int seg = u.m0;
#pragma unroll
        for (int ai = 0; ai < 2; ++ai) {
            v4u ga[4], gb[4];
#pragma unroll
            for (int m = 0; m < 4; ++m) { const size_t row = (size_t)(row0 + ai * 128 + m * 16);
                ga[m] = *(const v4u*)(g8 + row * GW8 + seg * D + pos0); gb[m] = ga[m]; if (seg < 2) gb[m] = *(const v4u*)(g8 + row * GW8 + (seg + 1) * D + pos0); }
            asm volatile("" ::: "memory");
#pragma unroll
            for (int m = 0; m < 4; ++m) { const size_t row = (size_t)(row0 + ai * 128 + m * 16);
#pragma unroll
                for (int bj = 0; bj < 2; ++bj) { const unsigned ax = bj ? ga[m].z : ga[m].x, ay = bj ? ga[m].w : ga[m].y, bx = bj ? gb[m].z : gb[m].x, by = bj ? gb[m].w : gb[m].y;
                    f32x4 v0 = acc[ai][bj][m][0], v1 = acc[ai][bj][m][1];
                    if (seg < 2) {
                        v0[0] *= (float)(ax & 255u) * __builtin_amdgcn_rcpf((float)(bx & 255u)); v0[1] *= (float)((ax >> 8) & 255u) * __builtin_amdgcn_rcpf((float)((bx >> 8) & 255u));
                        v0[2] *= (float)((ax >> 16) & 255u) * __builtin_amdgcn_rcpf((float)((bx >> 16) & 255u)); v0[3] *= (float)(ax >> 24) * __builtin_amdgcn_rcpf((float)(bx >> 24));
                        v1[0] *= (float)(ay & 255u) * __builtin_amdgcn_rcpf((float)(by & 255u)); v1[1] *= (float)((ay >> 8) & 255u) * __builtin_amdgcn_rcpf((float)((by >> 8) & 255u));
                        v1[2] *= (float)((ay >> 16) & 255u) * __builtin_amdgcn_rcpf((float)((by >> 16) & 255u)); v1[3] *= (float)(ay >> 24) * __builtin_amdgcn_rcpf((float)(by >> 24));
                        acc[ai][bj][m][0] = v0; acc[ai][bj][m][1] = v1;
                    } else { constexpr float s8 = 1.f / 255.f;
                        v0[0] *= (float)(ax & 255u) * s8; v0[1] *= (float)((ax >> 8) & 255u) * s8; v0[2] *= (float)((ax >> 16) & 255u) * s8; v0[3] *= (float)(ax >> 24) * s8;
                        v1[0] *= (float)(ay & 255u) * s8; v1[1] *= (float)((ay >> 8) & 255u) * s8; v1[2] *= (float)((ay >> 16) & 255u) * s8; v1[3] *= (float)(ay >> 24) * s8;
                        v4u w; w.x = pk2(v0[0], v0[1]); w.y = pk2(v0[2], v0[3]); w.z = pk2(v1[0], v1[1]); w.w = pk2(v1[2], v1[3]); *(v4u*)(merged + row * D + col0 + bj * 128) = w; } } }
            asm volatile("" ::: "memory");
        }
        return seg < 2;
    }
};
template <bool RB16> struct EpiResid { static constexpr bool PERM = true, INPLACE = false; const void* xres; bf16* z;
    __device__ __forceinline__ void operator()(const Acc& acc, const Unit& u, int wr, int wc, int fr, int fq) const {
        const int row0 = u.pm * 256 + wr * 64 + fr, col0 = u.pn * 256 + wc * 32 + 8 * fq;
#pragma unroll
        for (int ai = 0; ai < 2; ++ai) {
            f32x4 xr[4][2][2];
#pragma unroll
            for (int m = 0; m < 4; ++m) { const size_t off = (size_t)(row0 + ai * 128 + m * 16) * D + col0;
#pragma unroll
                for (int bj = 0; bj < 2; ++bj) {
                    if constexpr (RB16) { const v4u w = *(const v4u*)((const bf16*)xres + off + bj * 128);
                        xr[m][bj][0] = (f32x4){pg8::bf_lo(w.x), pg8::bf_hi(w.x), pg8::bf_lo(w.y), pg8::bf_hi(w.y)}; xr[m][bj][1] = (f32x4){pg8::bf_lo(w.z), pg8::bf_hi(w.z), pg8::bf_lo(w.w), pg8::bf_hi(w.w)}; }
                    else {
#pragma unroll
                        for (int n = 0; n < 2; ++n) xr[m][bj][n] = *(const f32x4*)((const float*)xres + off + bj * 128 + n * 4); } } }
            asm volatile("" ::: "memory");
#pragma unroll
            for (int m = 0; m < 4; ++m) { const size_t off = (size_t)(row0 + ai * 128 + m * 16) * D + col0;
#pragma unroll
                for (int bj = 0; bj < 2; ++bj) { const f32x4 v0 = xr[m][bj][0] * ALPHA + acc[ai][bj][m][0], v1 = xr[m][bj][1] * ALPHA + acc[ai][bj][m][1];
                    v4u w; w.x = pk2(v0[0], v0[1]); w.y = pk2(v0[2], v0[3]); w.z = pk2(v1[0], v1[1]); w.w = pk2(v1[2], v1[3]); *(v4u*)(z + off + bj * 128) = w; } }
            asm volatile("" ::: "memory");
        }
    }
};

constexpr int NWAVES = 8;
constexpr int RING_OFF = 0, RING_BYTES = 131072;
constexpr int SCR_BYTES = 147456;
constexpr int MISC_OFF = SCR_BYTES;
constexpr int LDS_BYTES = 163840;
constexpr int PH_CVT = 0, PH_L0 = 1, PH_PER_LAYER = 10;
constexpr int P_INPROJ = 0, P_MIX = 1, P_SCAN = 2, P_HOUT = 3, P_BRANCH = 4, P_WO = 5, P_ROUTE = 6, P_GU = 7, P_DOWN = 8, P_COMB = 9;
constexpr int N_PHASES = PH_L0 + 2 * PH_PER_LAYER;

constexpr int NCV = 64;
#define CV_UNITS 2
#define GM_UNITS 15
struct Frame { LAS unsigned char* lds; int tid, lane, wave, G, gw, NGW; };

__device__ __forceinline__ void xpose_item(const float* W, int N, int k0, int n0, bf16* WTrow0, int ldk, LAS float* scr, int lane) {
    const int kk = lane >> 3, nn = (lane & 7) * 4;
    f32x4 v[8];
#pragma unroll
    for (int i = 0; i < 8; ++i) v[i] = *(const f32x4*)(W + (size_t)(k0 + kk + 8 * i) * N + n0 + nn);
#pragma unroll
    for (int i = 0; i < 8; ++i) { LAS float* s = scr + (kk + 8 * i) * 33 + nn; s[0] = v[i][0]; s[1] = v[i][1]; s[2] = v[i][2]; s[3] = v[i][3]; }
    LDS_WAIT(); asm volatile("" ::: "memory");
    const int c = lane & 7;
#pragma unroll
    for (int j = 0; j < 4; ++j) { const int n = (lane >> 3) + 8 * j; const LAS float* s = scr + (8 * c) * 33 + n;
        v4u o; o.x = pk2(s[0 * 33], s[1 * 33]); o.y = pk2(s[2 * 33], s[3 * 33]); o.z = pk2(s[4 * 33], s[5 * 33]); o.w = pk2(s[6 * 33], s[7 * 33]);
        *(v4u*)(WTrow0 + (size_t)n * ldk + 8 * c) = o; }
    LDS_WAIT(); asm volatile("" ::: "memory");
}
__device__ __forceinline__ void xpose_matrix(const Frame& F, const float* W, int K, int N, bf16* WT, int ldk, int mode, unsigned& gbase) {
    const int nblk = N / 32, nitems = (K / 64) * nblk;
    LAS float* scr = (LAS float*)(F.lds + RING_OFF + F.wave * 8704);
    int it = (int)(((unsigned)F.gw + (unsigned)F.NGW - gbase % (unsigned)F.NGW) % (unsigned)F.NGW);
    for (; it < nitems; it += F.NGW) {
        const int kb = it / nblk, nb = it % nblk, n0 = nb * 32, k0 = kb * 64;
        const int drow = mode == 0 ? n0 : ((n0 >> 7) * 256 + (n0 & 127) + (mode == 2 ? 128 : 0));
        xpose_item(W, N, k0, n0, WT + (size_t)drow * ldk + k0, ldk, scr, F.lane);
    }
    gbase += (unsigned)nitems;
}
__device__ __forceinline__ void cvt_rows(const Frame& F, const float* in, bf16* out, size_t n8) {
    for (size_t i = (size_t)blockIdx.x * 512 + F.tid; i < n8; i += (size_t)F.G * 512) {
        const f32x4 a = *(const f32x4*)(in + i * 8), b = *(const f32x4*)(in + i * 8 + 4);
        v4u w; w.x = pk2(a[0], a[1]); w.y = pk2(a[2], a[3]); w.z = pk2(b[0], b[1]); w.w = pk2(b[2], b[3]);
        *(v4u*)(out + i * 8) = w; }
}
__device__ __forceinline__ void cvt_router(const Frame& F, const float* rw, unsigned char* ws) {
    for (int i = blockIdx.x * 512 + F.tid; i < 2 * D * NE; i += F.G * 512) { const int l = i / (D * NE), k = (i / NE) % D, e = i % NE;
        const float w = rw[i]; const bf16 h = f2bf(w); const bf16 lo = f2bf(w - bf2f(h));
        bf16* dst = (bf16*)(ws + WS_RW + l * RW_L); dst[(size_t)e * D + k] = h; dst[(size_t)(NE + e) * D + k] = lo; }
}
struct XItem { const float* src; bf16* dst; int N, ldk; };
__device__ __forceinline__ void xp_decode(int I, const float* wg, const float* wu, const float* wd, const float* sg, const float* su, const float* sd, unsigned char* ws, XItem& x) {
    const int e = I / 1536, rem = I % 1536, m = rem >> 9, it = rem & 511;
    if (m < 2) { const float* W = m == 0 ? (e < NE ? wg + (size_t)e * D * EH : sg) : (e < NE ? wu + (size_t)e * D * EH : su);
        const int kb = it >> 4, nb = it & 15, n0 = nb * 32, k0 = kb * 64; const int drow = (n0 >> 7) * 256 + (n0 & 127) + (m == 1 ? 128 : 0);
        x.src = W + (size_t)k0 * EH + n0; x.N = EH; x.ldk = D; x.dst = (bf16*)(ws + WS_WGU + (size_t)e * WGU_E) + (size_t)drow * D + k0; }
    else { const float* W = e < NE ? wd + (size_t)e * EH * D : sd; const int kb = it >> 6, nb = it & 63, n0 = nb * 32, k0 = kb * 64;
        x.src = W + (size_t)k0 * D + n0; x.N = D; x.ldk = EH; x.dst = (bf16*)(ws + WS_WDN + (size_t)e * WDN_E) + (size_t)n0 * EH + k0; }
}
__device__ __forceinline__ void xp_load(const XItem& x, int lane, f32x4 (&v)[8]) {
    const int kk = lane >> 3, nn = (lane & 7) * 4;
#pragma unroll
    for (int i = 0; i < 8; ++i) v[i] = __builtin_nontemporal_load((const f32x4*)(x.src + (size_t)(kk + 8 * i) * x.N + nn));
}
__device__ __forceinline__ void xp_store(const XItem& x, const f32x4 (&v)[8], LAS float* scr, int lane) {
    const int kk = lane >> 3, nn = (lane & 7) * 4;
#pragma unroll
    for (int i = 0; i < 8; ++i) { LAS float* s = scr + (kk + 8 * i) * 33 + nn; s[0] = v[i][0]; s[1] = v[i][1]; s[2] = v[i][2]; s[3] = v[i][3]; }
    LDS_WAIT(); asm volatile("" ::: "memory");
    const int c = lane & 7;
#pragma unroll
    for (int j = 0; j < 4; ++j) { const int n = (lane >> 3) + 8 * j; const LAS float* s = scr + (8 * c) * 33 + n;
        v4u o; o.x = pk2(s[0 * 33], s[1 * 33]); o.y = pk2(s[2 * 33], s[3 * 33]); o.z = pk2(s[4 * 33], s[5 * 33]); o.w = pk2(s[6 * 33], s[7 * 33]);
        __builtin_nontemporal_store(o, (v4u*)(x.dst + (size_t)n * x.ldk + 8 * c)); }
    LDS_WAIT(); asm volatile("" ::: "memory");
}
__device__ __forceinline__ void cvt_experts(const Frame& F, const float* wg, const float* wu, const float* wd, const float* sg, const float* su, const float* sd, unsigned char* ws, unsigned& gbase) {
    (void)gbase;
    LAS float* scr = (LAS float*)(F.lds + RING_OFF + F.wave * 8704);
    const int total = (NE + 1) * 1536;
    XItem A, B; f32x4 va[8], vb[8];
    int I = F.gw;
    if (I < total) { xp_decode(I, wg, wu, wd, sg, su, sd, ws, A); xp_load(A, F.lane, va); }
    for (; I < total; I += 2 * F.NGW) {
        const int I2 = I + F.NGW, I3 = I + 2 * F.NGW;
        if (I2 < total) { xp_decode(I2, wg, wu, wd, sg, su, sd, ws, B); xp_load(B, F.lane, vb); }
        xp_store(A, va, scr, F.lane);
        if (I2 < total) { if (I3 < total) { xp_decode(I3, wg, wu, wd, sg, su, sd, ws, A); xp_load(A, F.lane, va); }
            xp_store(B, vb, scr, F.lane); }
    }
}
constexpr int NVO_OFF = MISC_OFF + 1024;  static_assert(NVO_OFF == pg8::PG8_NVO_OFF, "nvo");
constexpr int PLAN_OFF = NVO_OFF + 8192;
constexpr int PLAN_TB = PLAN_OFF, PLAN_CN = PLAN_OFF + 66 * 4, PLAN_TE = PLAN_OFF + 132 * 4;
constexpr int MAXTILES = 640;
#ifndef ROUTE_PROBE
#define ROUTE_PROBE 0
#endif
static_assert(PLAN_TE + MAXTILES * 4 <= LDS_BYTES, "LDS map");

__device__ __forceinline__ float wave_sum(float v, int lane) {
#pragma unroll
    for (int o = 1; o < 64; o <<= 1) v += shx(v, o, lane);
    return v;
}
__device__ __forceinline__ void moe_plan(const Frame& F, const unsigned* cnt) {
    LAS unsigned* tb = (LAS unsigned*)(F.lds + PLAN_TB); LAS unsigned* cn = (LAS unsigned*)(F.lds + PLAN_CN); LAS unsigned* te = (LAS unsigned*)(F.lds + PLAN_TE);
    __syncthreads();
    if (F.wave == 0) {
        const unsigned c = __hip_atomic_load(cnt + F.lane, RLX_AGENT); const unsigned t = (c + 255u) >> 8; unsigned inc = t;
#pragma unroll
        for (int o = 1; o < 64; o <<= 1) { const unsigned v = (unsigned)__builtin_amdgcn_ds_bpermute((F.lane - o) << 2, (int)inc); if (F.lane >= o) inc += v; }
        tb[F.lane] = inc - t; cn[F.lane] = c;
        if (F.lane == 63) { tb[NE] = inc; cn[NE] = (unsigned)NTOK; tb[NE + 1] = inc + NTOK / 256; } }
    __syncthreads();
    for (int t = F.tid; t < MAXTILES; t += NWAVES * 64) { unsigned e = 0; for (int q = 1; q <= NE; ++q) if (tb[q] <= (unsigned)t) e = q; te[t] = e; }
    __syncthreads();
}
template <bool GU> struct MoeSched { static constexpr bool GATHER = GU;
    const LAS unsigned* tb; const LAS unsigned* cn; const LAS unsigned* te; int nunits, nN, G, c; const char* Abase; const char* Bbase; const int* list;
    __device__ __forceinline__ void init(const Frame& F, const void* A_, const void* B_, const int* list_) {
        tb = (const LAS unsigned*)(F.lds + PLAN_TB); cn = (const LAS unsigned*)(F.lds + PLAN_CN); te = (const LAS unsigned*)(F.lds + PLAN_TE);
        nN = GU ? 4 : 8; nunits = (int)tb[NE + 1] * nN; G = F.G; const int bx = blockIdx.x; c = (G % 8 == 0) ? (bx % 8) * (G / 8) + bx / 8 : bx;
        Abase = (const char*)A_; Bbase = (const char*)B_; list = list_; }
    __device__ __forceinline__ bool next(int i, Unit& u) const {
        constexpr int RUN = GU ? 2 : 1; const int hs = c + G * (i / RUN), per = nN / RUN;
        const int tile = hs / per, pn = (hs % per) * RUN + (i % RUN); if (tile * nN >= nunits) return false;
        const int e = (int)te[tile];
        u.pm = tile; u.pn = pn;
        if (GU) { u.A = Abase; u.B = Bbase + (size_t)e * WGU_E + (size_t)pn * 256 * D * 2; u.list = e < NE ? list + (size_t)e * LISTCAP : nullptr; u.m0 = (tile - (int)tb[e]) * 256; u.cnt = (int)cn[e]; }
        else { u.A = Abase + (size_t)tile * 256 * EH * 2; u.B = Bbase + (size_t)e * WDN_E + (size_t)pn * 256 * EH * 2; u.list = nullptr; u.m0 = 0; u.cnt = 0; }
        return true; }
    __device__ __forceinline__ int avload(const Unit& u, int h, int R) const { const int pos = u.m0 + h * 128 + R; const int pc = pos < u.cnt ? pos : (u.cnt > 0 ? u.cnt - 1 : 0); const int* lp = u.list ? u.list : list; return lp[pc]; }
    __device__ __forceinline__ unsigned avfin(const Unit& u, int h, int R, int C, int K_, int v) const { const int pos = u.m0 + h * 128 + R; int row = u.list ? v : pos; row = pos < u.cnt ? row : 0; return (unsigned)((row * K_ + C) * 2); }
    __device__ __forceinline__ unsigned avoff(const Unit& u, int h, int R, int C, int K_) const {
        if (GU) return avfin(u, h, R, C, K_, avload(u, h, R));
        else return (unsigned)(((h * 128 + R) * K_ + C) * 2); }
};
struct EpiSwiGLU { static constexpr bool PERM = true, INPLACE = false; bf16* H;
    __device__ __forceinline__ void operator()(const Acc& acc, const Unit& u, int wr, int wc, int fr, int fq) const {
        const int row0 = u.pm * 256 + wr * 64 + fr, col0 = u.pn * 128 + wc * 32 + 8 * fq;
#pragma unroll
        for (int ai = 0; ai < 2; ++ai)
#pragma unroll
            for (int m = 0; m < 4; ++m) { bf16* rowp = H + (size_t)(row0 + ai * 128 + m * 16) * EH + col0;
                float hv[8];
#pragma unroll
                for (int n = 0; n < 2; ++n)
#pragma unroll
                    for (int j = 0; j < 4; ++j) { const float g = acc[ai][0][m][n][j], uu = acc[ai][1][m][n][j]; hv[n * 4 + j] = g * pg8::sigmoidf_(g) * uu; }
                v4u w; w.x = pk2(hv[0], hv[1]); w.y = pk2(hv[2], hv[3]); w.z = pk2(hv[4], hv[5]); w.w = pk2(hv[6], hv[7]);
                *(v4u*)rowp = w; }
    }
};

struct EpiY8 { static constexpr bool PERM = true, INPLACE = false; unsigned char* Y8; bf16* YS;
    __device__ __forceinline__ void operator()(const Acc& acc, const Unit& u, int wr, int wc, int fr, int fq) const {
        const int row0 = u.pm * 256 + wr * 64 + fr, pos0 = u.pn * 256 + wc * 64 + fq * 16;
#pragma unroll
        for (int ai = 0; ai < 2; ++ai)
#pragma unroll
            for (int m = 0; m < 4; ++m) { const size_t row = (size_t)(row0 + ai * 128 + m * 16);
                v4u w; unsigned sw = 0u;
#pragma unroll
                for (int bj = 0; bj < 2; ++bj) { const f32x4 v0 = acc[ai][bj][m][0], v1 = acc[ai][bj][m][1];
                    const float am = fmaxf(fmaxf(fmaxf(fabsf(v0[0]), fabsf(v0[1])), fmaxf(fabsf(v0[2]), fabsf(v0[3]))), fmaxf(fmaxf(fabsf(v1[0]), fabsf(v1[1])), fmaxf(fabsf(v1[2]), fabsf(v1[3]))));
                    const unsigned sb = f2bf(am * (1.f / 127.f)); const float sc = __uint_as_float(sb << 16); const float inv = sc > 0.f ? __builtin_amdgcn_rcpf(sc) : 0.f;
                    unsigned q[8];
#pragma unroll
                    for (int j = 0; j < 4; ++j) { q[j] = (unsigned)fminf(rintf(v0[j] * inv + 128.f), 255.f); q[4 + j] = (unsigned)fminf(rintf(v1[j] * inv + 128.f), 255.f); }
                    const unsigned lo = q[0] | (q[1] << 8) | (q[2] << 16) | (q[3] << 24), hi = q[4] | (q[5] << 8) | (q[6] << 16) | (q[7] << 24);
                    if (bj == 0) { w.x = lo; w.y = hi; sw = sb; } else { w.z = lo; w.w = hi; sw |= sb << 16; } }
                *(v4u*)(Y8 + row * D + pos0) = w; *(unsigned*)(YS + row * (D / 8) + (pos0 >> 3)) = sw; }
    }
};
__device__ __forceinline__ void route_phase(const Frame& F, const bf16* __restrict__ Z, const float* __restrict__ g, const float* __restrict__ bb, const bf16* __restrict__ rwh, const float* __restrict__ rb,
                                            bf16* __restrict__ X1L, bf16* __restrict__ X1BF, unsigned* cnt, int* list, int* tokslot, float* tokw, bool dispatch = true) {
    LAS float* part = (LAS float*)(F.lds + RING_OFF);
    LAS float* lg = part + 4 * 4096;
    LAS float* sl = lg + 64 * 65;
    LAS unsigned* cntL = (LAS unsigned*)(sl + 64 * 65);
    LAS unsigned* baseL = cntL + 64;
    LAS unsigned* ee = baseL + 64;
    LAS unsigned* pl = ee + 512;
    LAS float* ww = (LAS float*)(pl + 512);
    for (int grp = blockIdx.x; grp < NTOK / 64; grp += F.G) {
        const int t0 = grp * 64;
        if (F.tid < 64) cntL[F.tid] = 0u;
        for (int rp_ = 0; rp_ < (ROUTE_PROBE == 1 ? 2 : 1); ++rp_)
#pragma unroll 2
        for (int q = 0; q < 8; ++q) {
            const int t = t0 + F.wave * 8 + q;
            const v2u* zr = (const v2u*)(Z + (size_t)t * D) + F.lane;
            f32x4 v[8]; float s = 0.f;
#pragma unroll
            for (int j = 0; j < 8; ++j) { const v2u zw = zr[64 * j]; v[j] = (f32x4){pg8::bf_lo(zw.x), pg8::bf_hi(zw.x), pg8::bf_lo(zw.y), pg8::bf_hi(zw.y)}; s += (v[j][0] + v[j][1]) + (v[j][2] + v[j][3]); }
            const float mean = wave_sum(s, F.lane) * (1.f / D); float s2 = 0.f;
#pragma unroll
            for (int j = 0; j < 8; ++j) { v[j] = v[j] - mean; s2 += (v[j][0] * v[j][0] + v[j][1] * v[j][1]) + (v[j][2] * v[j][2] + v[j][3] * v[j][3]); }
            const float rstd = 1.f / sqrtf(wave_sum(s2, F.lane) * (1.f / D) + LN_EPS);
            v2u* xl = (v2u*)(X1L + (size_t)t * D) + F.lane; v2u* xb = (v2u*)(X1BF + (size_t)t * D) + F.lane;
#pragma unroll
            for (int j = 0; j < 8; ++j) { const f32x4 gg = ((const f32x4*)g)[F.lane + 64 * j], bv = ((const f32x4*)bb)[F.lane + 64 * j];
                const f32x4 y = v[j] * rstd * gg + bv; v2u w; w.x = pk2(y[0], y[1]); w.y = pk2(y[2], y[3]); xb[64 * j] = w;
                v2u lo; lo.x = pk2(y[0] - pg8::bf_lo(w.x), y[1] - pg8::bf_hi(w.x)); lo.y = pk2(y[2] - pg8::bf_lo(w.y), y[3] - pg8::bf_hi(w.y)); xl[64 * j] = lo; }
        }
        VM_WAIT(); __syncthreads();
        for (int rp_ = 0; rp_ < (ROUTE_PROBE == 2 ? 2 : 1); ++rp_)
        { const int r = F.lane & 15, kq = F.lane >> 4, kb = (F.wave & 3) * 512, th = F.wave >> 2;
          const bf16* xh = X1BF + (size_t)(t0 + th * 32 + r) * D + kb + 8 * kq;
          const bf16* xl = X1L + (size_t)(t0 + th * 32 + r) * D + kb + 8 * kq;
          const bf16* wh = rwh + (size_t)r * D + kb + 8 * kq;
          f32x4 acc[2][4];
#pragma unroll
          for (int tt = 0; tt < 2; ++tt)
#pragma unroll
              for (int nb = 0; nb < 4; ++nb) acc[tt][nb] = (f32x4){0.f, 0.f, 0.f, 0.f};
          bf16x8 xA[2][2], xB[2][2]; bf16x8 hA[4], lA[4], hB[4], lB[4];
#define RT_LOAD(X, H, L, ks) do { const int k_ = ((ks) < 16 ? (ks) : 15) * 32; _Pragma("unroll") for (int tt = 0; tt < 2; ++tt) { X[tt][0] = *(const bf16x8*)(xh + (size_t)tt * 16 * D + k_); X[tt][1] = *(const bf16x8*)(xl + (size_t)tt * 16 * D + k_); } \
              _Pragma("unroll") for (int nb = 0; nb < 4; ++nb) { H[nb] = *(const bf16x8*)(wh + (size_t)nb * 16 * D + k_); L[nb] = *(const bf16x8*)(wh + (size_t)(64 + nb * 16) * D + k_); } } while (0)
#define RT_MMA(X, H, L) do { \
              _Pragma("unroll") for (int tt = 0; tt < 2; ++tt) _Pragma("unroll") for (int nb = 0; nb < 4; ++nb) acc[tt][nb] = __builtin_amdgcn_mfma_f32_16x16x32_bf16(X[tt][1], H[nb], acc[tt][nb], 0, 0, 0); \
              _Pragma("unroll") for (int tt = 0; tt < 2; ++tt) _Pragma("unroll") for (int nb = 0; nb < 4; ++nb) acc[tt][nb] = __builtin_amdgcn_mfma_f32_16x16x32_bf16(X[tt][0], L[nb], acc[tt][nb], 0, 0, 0); \
              _Pragma("unroll") for (int tt = 0; tt < 2; ++tt) _Pragma("unroll") for (int nb = 0; nb < 4; ++nb) acc[tt][nb] = __builtin_amdgcn_mfma_f32_16x16x32_bf16(X[tt][0], H[nb], acc[tt][nb], 0, 0, 0); } while (0)
          RT_LOAD(xA, hA, lA, 0);
#pragma unroll 1
          for (int ks = 0; ks < 16; ks += 2) {
              RT_LOAD(xB, hB, lB, ks + 1); RT_MMA(xA, hA, lA);
              RT_LOAD(xA, hA, lA, ks + 2); RT_MMA(xB, hB, lB);
          }
#undef RT_LOAD
#undef RT_MMA
#pragma unroll
          for (int tt = 0; tt < 2; ++tt)
#pragma unroll
              for (int nb = 0; nb < 4; ++nb)
#pragma unroll
                  for (int reg = 0; reg < 4; ++reg) part[(F.wave & 3) * 4096 + (th * 32 + tt * 16 + 4 * kq + reg) * 64 + nb * 16 + r] = acc[tt][nb][reg];
        }
        __syncthreads();
        for (int i = F.tid; i < 64 * 64; i += NWAVES * 64) { const int tk = i >> 6, e = i & 63; const float lgt = (part[i] + part[4096 + i]) + (part[8192 + i] + part[12288 + i]);
            const float sc = 1.f / (1.f + __expf(-lgt)); lg[tk * 65 + e] = sc; sl[tk * 65 + e] = sc + rb[e]; }
        __syncthreads();
        for (int rp_ = 0; rp_ < (ROUTE_PROBE == 3 ? 2 : 1); ++rp_)
        { const bool lastrp = (rp_ == (ROUTE_PROBE == 3 ? 1 : 0));
          const int tk = F.wave * 8 + (F.lane >> 3), gq = F.lane & 7, lane = F.lane;
          float sv[8], cv[8];
#pragma unroll
          for (int j = 0; j < 8; ++j) { sv[j] = sl[tk * 65 + gq * 8 + j]; cv[j] = lg[tk * 65 + gq * 8 + j]; }
          float m1 = -INFINITY, m2 = -INFINITY;
#pragma unroll
          for (int j = 0; j < 8; ++j) { const float x = sv[j]; const bool g1 = x > m1; m2 = g1 ? m1 : fmaxf(m2, x); m1 = g1 ? x : m1; }
          const float gs = m1 + m2;
          int rank = 0;
#pragma unroll
          for (int o = 1; o < 8; ++o) { const float og = shx(gs, o, lane); const int oq = gq ^ o; rank += (og > gs || (og == gs && oq < gq)) ? 1 : 0; }
          const bool gsel = rank < 4;
          unsigned used = gsel ? 0u : 0xffu;
          float wsum = 0.f; float my_sc = 0.f; int my_e = 0;
#pragma unroll
          for (int i = 0; i < 8; ++i) {
              float bv = -INFINITY, bs = 0.f; int be = 64;
#pragma unroll
              for (int j = 0; j < 8; ++j) { const bool ok = !((used >> j) & 1u) && sv[j] > bv; bv = ok ? sv[j] : bv; bs = ok ? cv[j] : bs; be = ok ? gq * 8 + j : be; }
#pragma unroll
              for (int o = 1; o < 8; o <<= 1) { const float ov = shx(bv, o, lane), os = shx(bs, o, lane); const int oe = __float_as_int(shx(__int_as_float(be), o, lane));
                  const bool tk_o = ov > bv || (ov == bv && oe < be); bv = tk_o ? ov : bv; bs = tk_o ? os : bs; be = tk_o ? oe : be; }
              if ((be >> 3) == gq) used |= 1u << (be & 7);
              wsum += bs; if (gq == i) { my_sc = bs; my_e = be; }
          }
          const int slot = tk * 8 + gq;
          ee[slot] = (unsigned)my_e; ww[slot] = my_sc * (RSCALE / wsum);
          pl[slot] = __hip_atomic_fetch_add(cntL + my_e, (dispatch && lastrp) ? 1u : 0u, __ATOMIC_RELAXED, __HIP_MEMORY_SCOPE_WORKGROUP);
        }
        __syncthreads();
        if (F.tid < 64) { const unsigned n = cntL[F.tid]; baseL[F.tid] = n ? __hip_atomic_fetch_add(cnt + F.tid, n, RLX_AGENT) : 0u; }
        __syncthreads();
        if (dispatch) { const int tk = F.tid >> 3, i = F.tid & 7; const unsigned e = ee[F.tid]; const unsigned pos = baseL[e] + pl[F.tid]; const int t = t0 + tk;
          list[(size_t)e * LISTCAP + pos] = t; tokslot[t * 8 + i] = (int)(e * LISTCAP + pos); tokw[t * 8 + i] = ww[F.tid]; }
        __syncthreads();
    }
}
__device__ __forceinline__ void combine_phase(const Frame& F, const bf16* X1B, const unsigned char* Y8, const bf16* YS, const int* tokslot, const float* tokw, const float* g, const float* bb, float* OUT, bf16* XBF, bool last) {
    const LAS unsigned* tb = (const LAS unsigned*)(F.lds + PLAN_TB);
    LAS int* rw = (LAS int*)(F.lds + RING_OFF) + F.wave * 32;
#define CB_LOAD(W, S, ROW) do { const int r_ = __builtin_amdgcn_readfirstlane(ROW); const v2u* yr_ = (const v2u*)(Y8 + (size_t)r_ * D) + F.lane; const bf16* ys_ = YS + (size_t)r_ * (D / 8) + F.lane; \
        _Pragma("unroll") for (int j = 0; j < 4; ++j) { W[j] = yr_[64 * j]; S[j] = ys_[64 * j]; } } while (0)
#define CB_ACC(W, S, WT) do { const float wt_ = __int_as_float(__builtin_amdgcn_readfirstlane(WT)); _Pragma("unroll") for (int j = 0; j < 4; ++j) { const float sc = bf2f(S[j]) * wt_, c0 = -128.f * sc; const unsigned x = W[j].x, y = W[j].y; \
        v[j][0] += sc * (float)(x & 255u) + c0; v[j][1] += sc * (float)((x >> 8) & 255u) + c0; v[j][2] += sc * (float)((x >> 16) & 255u) + c0; v[j][3] += sc * (float)(x >> 24) + c0; \
        v[j][4] += sc * (float)(y & 255u) + c0; v[j][5] += sc * (float)((y >> 8) & 255u) + c0; v[j][6] += sc * (float)((y >> 16) & 255u) + c0; v[j][7] += sc * (float)(y >> 24) + c0; } } while (0)
    const int cl = (F.lane >> 5) * 256 + (F.lane & 1) * 128 + ((F.lane >> 3) & 3) * 32 + ((F.lane >> 1) & 3) * 8;
    f32x4 gq[4][2], bq[4][2];
#pragma unroll
    for (int j = 0; j < 4; ++j) { const int c0 = cl + 512 * j; gq[j][0] = *(const f32x4*)(g + c0); gq[j][1] = *(const f32x4*)(g + c0 + 4); bq[j][0] = *(const f32x4*)(bb + c0); bq[j][1] = *(const f32x4*)(bb + c0 + 4); }
    int nsl = 0; float nwt = 0.f;
    if (F.gw < NTOK && F.lane < 8) { nsl = tokslot[F.gw * 8 + F.lane]; nwt = tokw[F.gw * 8 + F.lane]; }
    for (int t = F.gw; t < NTOK; t += F.NGW) {
        v4u xw[4];
#pragma unroll
        for (int j = 0; j < 4; ++j) xw[j] = *(const v4u*)(X1B + (size_t)t * D + 512 * j + cl);
        if (F.lane < 8) { const int sl = nsl; rw[F.lane] = (int)tb[sl / LISTCAP] * 256 + (sl % LISTCAP); rw[16 + F.lane] = __float_as_int(nwt); }
        if (F.lane == 8) { rw[8] = (int)tb[NE] * 256 + t; rw[24] = __float_as_int(1.f); }
        LDS_WAIT(); asm volatile("" ::: "memory");
        float v[4][8]; float s = 0.f;
        v2u wa[4], wb[4], wc[4]; bf16 sa[4], sb2[4], sc2[4];
        CB_LOAD(wa, sa, rw[0]); CB_LOAD(wb, sb2, rw[1]); CB_LOAD(wc, sc2, rw[2]);
        { const int tn = t + F.NGW; if (tn < NTOK && F.lane < 8) { nsl = tokslot[tn * 8 + F.lane]; nwt = tokw[tn * 8 + F.lane]; } }
        __builtin_amdgcn_sched_barrier(0);
#pragma unroll
        for (int j = 0; j < 4; ++j) {
            v[j][0] = pg8::bf_lo(xw[j].x) * ALPHA; v[j][1] = pg8::bf_hi(xw[j].x) * ALPHA; v[j][2] = pg8::bf_lo(xw[j].y) * ALPHA; v[j][3] = pg8::bf_hi(xw[j].y) * ALPHA;
            v[j][4] = pg8::bf_lo(xw[j].z) * ALPHA; v[j][5] = pg8::bf_hi(xw[j].z) * ALPHA; v[j][6] = pg8::bf_lo(xw[j].w) * ALPHA; v[j][7] = pg8::bf_hi(xw[j].w) * ALPHA; }
#pragma unroll 1
        for (int i = 0; i < 9; i += 3) {
            CB_ACC(wa, sa, rw[16 + i]); if (i < 6) CB_LOAD(wa, sa, rw[i + 3]);
            CB_ACC(wb, sb2, rw[17 + i]); if (i < 6) CB_LOAD(wb, sb2, rw[i + 4]);
            CB_ACC(wc, sc2, rw[18 + i]); if (i < 6) CB_LOAD(wc, sc2, rw[i + 5]);
        }
        asm volatile("" ::: "memory");
#pragma unroll
        for (int j = 0; j < 4; ++j)
#pragma unroll
            for (int e = 0; e < 8; ++e) s += v[j][e];
        const float mean = wave_sum(s, F.lane) * (1.f / D); float s2 = 0.f;
#pragma unroll
        for (int j = 0; j < 4; ++j)
#pragma unroll
            for (int e = 0; e < 8; ++e) { v[j][e] -= mean; s2 += v[j][e] * v[j][e]; }
        const float rstd = 1.f / sqrtf(wave_sum(s2, F.lane) * (1.f / D) + LN_EPS);
#pragma unroll
        for (int j = 0; j < 4; ++j) { const int c0 = cl + 512 * j; const f32x4 g0 = gq[j][0], g1 = gq[j][1], b0 = bq[j][0], b1 = bq[j][1];
            f32x4 y0, y1;
#pragma unroll
            for (int e = 0; e < 4; ++e) { y0[e] = v[j][e] * rstd * g0[e] + b0[e]; y1[e] = v[j][4 + e] * rstd * g1[e] + b1[e]; }
            if (last) { *(f32x4*)(OUT + (size_t)t * D + c0) = y0; *(f32x4*)(OUT + (size_t)t * D + c0 + 4) = y1; }
            else { v4u w; w.x = pk2(y0[0], y0[1]); w.y = pk2(y0[2], y0[3]); w.z = pk2(y1[0], y1[1]); w.w = pk2(y1[2], y1[3]); *(v4u*)(XBF + (size_t)t * D + c0) = w; } }
    }
#undef CB_LOAD
#undef CB_ACC
}
constexpr size_t R2_UT = 0, R2_OI = 48 * MiB, R2_QP = 96 * MiB, R2_DEC = 120 * MiB;
constexpr int NHU = NB * HGH * (SEQ / 64);
typedef __attribute__((address_space(3))) bf16 lbf16;
__device__ __forceinline__ void unpack8(const v4u w, float (&f)[8]) {
    f[0] = pg8::bf_lo(w.x); f[1] = pg8::bf_hi(w.x); f[2] = pg8::bf_lo(w.y); f[3] = pg8::bf_hi(w.y); f[4] = pg8::bf_lo(w.z); f[5] = pg8::bf_hi(w.z); f[6] = pg8::bf_lo(w.w); f[7] = pg8::bf_hi(w.w); }
__device__ __forceinline__ float exp_c(float x) { return __expf(fminf(x, 80.f)); }

__device__ __forceinline__ void conv_part(const Frame& F, const bf16* proj, const float* cw, bf16* YA, bf16* YX) {
    for (int i = blockIdx.x * 512 + F.tid; i < NTOK * 32; i += F.G * 512) *(v4u*)(YX + (size_t)(i >> 5) * YXW + XAW + (i & 31) * 8) = (v4u){0u, 0u, 0u, 0u};
    for (int i = blockIdx.x * 512 + F.tid; i < NTOK * (CW / 8); i += F.G * 512) {
        const int t = i / (CW / 8), c = (i % (CW / 8)) * 8, pos = t & (SEQ - 1);
        const bf16* r = proj + (size_t)t * INC;
        float u0[8], c0[8], b0[8], u1[8], c1[8], u2[8], c2[8], w0[8], w1[8], w2[8];
        unpack8(*(const v4u*)(r + C_U + c), u0); unpack8(*(const v4u*)(r + C_C + c), c0); unpack8(*(const v4u*)(r + C_B + c), b0);
        const v4u z4 = {0u, 0u, 0u, 0u};
        unpack8(pos >= 1 ? *(const v4u*)(r - INC + C_U + c) : z4, u1); unpack8(pos >= 1 ? *(const v4u*)(r - INC + C_C + c) : z4, c1);
        unpack8(pos >= 2 ? *(const v4u*)(r - 2 * INC + C_U + c) : z4, u2); unpack8(pos >= 2 ? *(const v4u*)(r - 2 * INC + C_C + c) : z4, c2);
#pragma unroll
        for (int j = 0; j < 8; ++j) { w0[j] = cw[c + j]; w1[j] = cw[CW + c + j]; w2[j] = cw[2 * CW + c + j]; }
        float o[8];
#pragma unroll
        for (int j = 0; j < 8; ++j) o[j] = b0[j] * (w2[j] * c0[j] * u0[j] + w1[j] * c1[j] * u1[j] + w0[j] * c2[j] * u2[j]);
        v4u w; w.x = pk2(o[0], o[1]); w.y = pk2(o[2], o[3]); w.z = pk2(o[4], o[5]); w.w = pk2(o[6], o[7]);
        *(v4u*)(YA + (size_t)t * CW + c) = w;
    }
}

__device__ __forceinline__ void hgrn_local(const Frame& F, const bf16* proj, const float* lbl, int layer, unsigned char* r2) {
    lbf16* QS = (lbf16*)(F.lds);
    lbf16* KS = QS + 64 * 136;
    lbf16* KPT = KS + 64 * 136;
    lbf16* VT = KPT + 128 * 72;
    lbf16* PS = VT + 128 * 72;
    LAS float* SEG = (LAS float*)(PS + 64 * 72);
    bf16* UT = (bf16*)(r2 + R2_UT); bf16* OI = (bf16*)(r2 + R2_OI); bf16* QP = (bf16*)(r2 + R2_QP); float* DEC = (float*)(r2 + R2_DEC);
    const int lane = F.lane, wv = F.wave, r = lane & 15, kq = lane >> 4;
    bf16 rf[16], rq[16], rv[16];
#define HL_LOAD(U) do { const int b_ = (U) / (HGH * 64), h_ = ((U) / 64) % HGH, c_ = (U) % 64; const bf16* p_ = proj + (size_t)(b_ * SEQ + c_ * 64 + (F.tid >> 7) * 16) * INC + h_ * HGD + (F.tid & 127); \
        _Pragma("unroll") for (int i = 0; i < 16; ++i) { rf[i] = p_[(size_t)i * INC + C_F]; rq[i] = p_[(size_t)i * INC + C_Q]; rv[i] = p_[(size_t)i * INC + C_I]; } } while (0)
    if ((int)blockIdx.x < NHU) HL_LOAD((int)blockIdx.x);
    for (int unit = blockIdx.x; unit < NHU; unit += F.G) {
        const int b = unit / (HGH * 64), h = (unit / 64) % HGH, c = unit % 64, t0 = b * SEQ + c * 64;
        { const int col = F.tid & 127, seg = F.tid >> 7, ch = h * HGD + col;
          float lb = 0.f; if (layer == 1) lb = 1.f / (1.f + __expf(lbl[ch] - lbl[HGW + ch]));
          float a[16], kk[16], qv[16], vv[16]; float run = 0.f;
#pragma unroll
          for (int i = 0; i < 16; ++i) {
              const float z = bf2f(rf[i]); const float ez = __expf(-z); const float sg = 1.f / (1.f + ez);
              const float f = lb + (1.f - lb) * sg; kk[i] = (1.f - lb) * ez * sg; run += fmaxf(__logf(f), -60.f); a[i] = run;
              qv[i] = bf2f(rq[i]); vv[i] = bf2f(rv[i]); }
          if (unit + F.G < NHU) HL_LOAD(unit + F.G);
          SEG[seg * 128 + col] = run;
          __syncthreads();
          const float s0 = SEG[col], s1 = SEG[128 + col], s2 = SEG[256 + col], s3 = SEG[384 + col];
          const float base = seg == 0 ? 0.f : (seg == 1 ? s0 : (seg == 2 ? s0 + s1 : s0 + s1 + s2)), bm = s0 + s1, bl = (s0 + s1) + (s2 + s3);
          float kp[16];
#pragma unroll
          for (int i = 0; i < 16; ++i) { const float bb = base + a[i]; const int t = seg * 16 + i;
              QS[t * 136 + col] = f2bf(qv[i] * exp_c(bb - bm)); KS[t * 136 + col] = f2bf(kk[i] * exp_c(bm - bb)); kp[i] = kk[i] * exp_c(bl - bb);
              QP[(size_t)(t0 + t) * HGW + ch] = f2bf(qv[i] * exp_c(bb)); }
          v4u w0, w1; w0.x = pk2(kp[0], kp[1]); w0.y = pk2(kp[2], kp[3]); w0.z = pk2(kp[4], kp[5]); w0.w = pk2(kp[6], kp[7]); w1.x = pk2(kp[8], kp[9]); w1.y = pk2(kp[10], kp[11]); w1.z = pk2(kp[12], kp[13]); w1.w = pk2(kp[14], kp[15]);
          *(LAS v4u*)(KPT + col * 72 + seg * 16) = w0; *(LAS v4u*)(KPT + col * 72 + seg * 16 + 8) = w1;
          w0.x = pk2(vv[0], vv[1]); w0.y = pk2(vv[2], vv[3]); w0.z = pk2(vv[4], vv[5]); w0.w = pk2(vv[6], vv[7]); w1.x = pk2(vv[8], vv[9]); w1.y = pk2(vv[10], vv[11]); w1.z = pk2(vv[12], vv[13]); w1.w = pk2(vv[14], vv[15]);
          *(LAS v4u*)(VT + col * 72 + seg * 16) = w0; *(LAS v4u*)(VT + col * 72 + seg * 16 + 8) = w1;
          if (seg == 0) DEC[(size_t)unit * 128 + col] = exp_c(bl);
        }
        __syncthreads();
        { const int tm = wv >> 1, tn0 = (wv & 1) * 2;
          bf16x8 af[4];
#pragma unroll
          for (int ks = 0; ks < 4; ++ks) af[ks] = *(const LAS bf16x8*)(QS + (tm * 16 + r) * 136 + ks * 32 + kq * 8);
#pragma unroll
          for (int jn = 0; jn < 2; ++jn) { const int tn = tn0 + jn; f32x4 acc = {0.f, 0.f, 0.f, 0.f};
              if (tn <= tm) {
#pragma unroll
                  for (int ks = 0; ks < 4; ++ks) { const bf16x8 bf = *(const LAS bf16x8*)(KS + (tn * 16 + r) * 136 + ks * 32 + kq * 8); acc = __builtin_amdgcn_mfma_f32_16x16x32_bf16(af[ks], bf, acc, 0, 0, 0); } }
#pragma unroll
              for (int g = 0; g < 4; ++g) { const int t = tm * 16 + 4 * kq + g, s = tn * 16 + r; PS[t * 72 + s] = f2bf(s <= t ? acc[g] : 0.f); } } }
        { bf16x8 af[2];
#pragma unroll
          for (int ks = 0; ks < 2; ++ks) af[ks] = *(const LAS bf16x8*)(KPT + (wv * 16 + r) * 72 + ks * 32 + kq * 8);
#pragma unroll
          for (int tv = 0; tv < 8; ++tv) { f32x4 acc = {0.f, 0.f, 0.f, 0.f};
#pragma unroll
              for (int ks = 0; ks < 2; ++ks) { const bf16x8 bf = *(const LAS bf16x8*)(VT + (tv * 16 + r) * 72 + ks * 32 + kq * 8); acc = __builtin_amdgcn_mfma_f32_16x16x32_bf16(af[ks], bf, acc, 0, 0, 0); }
              v2u w; w.x = pk2(acc[0], acc[1]); w.y = pk2(acc[2], acc[3]);
              *(v2u*)(UT + (size_t)unit * 16384 + (tv * 16 + r) * 128 + wv * 16 + 4 * kq) = w; } }
        __syncthreads();
        { const int tm = wv & 3, tvg = wv >> 2;
          bf16x8 pf[2];
#pragma unroll
          for (int ks = 0; ks < 2; ++ks) pf[ks] = *(const LAS bf16x8*)(PS + (tm * 16 + r) * 72 + ks * 32 + kq * 8);
#pragma unroll
          for (int j = 0; j < 4; ++j) { const int tv = tvg * 4 + j; f32x4 acc = {0.f, 0.f, 0.f, 0.f};
#pragma unroll
              for (int ks = 0; ks < 2; ++ks) { const bf16x8 vf = *(const LAS bf16x8*)(VT + (tv * 16 + r) * 72 + ks * 32 + kq * 8); acc = __builtin_amdgcn_mfma_f32_16x16x32_bf16(vf, pf[ks], acc, 0, 0, 0); }
              v2u ow; ow.x = pk2(acc[0], acc[1]); ow.y = pk2(acc[2], acc[3]); *(v2u*)(OI + (size_t)(t0 + tm * 16 + r) * HGW + h * HGD + tv * 16 + 4 * kq) = ow; } }
        __syncthreads();
    }
#undef HL_LOAD
}
__device__ __forceinline__ void hgrn_scan(const Frame& F, const unsigned char* r2, v2u* __restrict__ SB64) {
    const v2u* __restrict__ UT64 = (const v2u*)(r2 + R2_UT); const f32x4* __restrict__ DEC4 = (const f32x4*)(r2 + R2_DEC);
    for (int it = blockIdx.x * 512 + F.tid; it < NB * HGH * 128 * 32; it += F.G * 512) {
        const int bh = it >> 12, v = (it >> 5) & 127, k4 = it & 31;
        f32x4 s = {0.f, 0.f, 0.f, 0.f};
#pragma unroll 16
        for (int c = 0; c < 64; ++c) { const size_t unit = (size_t)bh * 64 + c; const size_t idx = unit * 4096 + v * 32 + k4;
            const v2u w = UT64[idx]; const f32x4 d = DEC4[unit * 32 + k4];
            v2u o; o.x = pk2(s[0], s[1]); o.y = pk2(s[2], s[3]); SB64[idx] = o;
            s[0] = d[0] * s[0] + pg8::bf_lo(w.x); s[1] = d[1] * s[1] + pg8::bf_hi(w.x); s[2] = d[2] * s[2] + pg8::bf_lo(w.y); s[3] = d[3] * s[3] + pg8::bf_hi(w.y); }
    }
}
struct HoutOps { bf16x8 af[4]; bf16x8 bfr[4][4]; };
__device__ __forceinline__ void hout_load(HoutOps& O, int unit, const bf16* proj, const bf16* OI, const bf16* QP, const bf16* SB, int r, int kq, int tm, int tvg) {
    const int b = unit / (HGH * 64), h = (unit / 64) % HGH, c = unit % 64, t0 = b * SEQ + c * 64;
#pragma unroll
    for (int ks = 0; ks < 4; ++ks) O.af[ks] = *(const bf16x8*)(QP + (size_t)(t0 + tm * 16 + r) * HGW + h * HGD + ks * 32 + kq * 8);
#pragma unroll
    for (int j = 0; j < 4; ++j)
#pragma unroll
        for (int ks = 0; ks < 4; ++ks) O.bfr[j][ks] = *(const bf16x8*)(SB + (size_t)unit * 16384 + ((tvg * 4 + j) * 16 + r) * 128 + ks * 32 + kq * 8);
}
__device__ __forceinline__ void hout_compute(const HoutOps& O, int unit, const bf16* proj, const bf16* OI, LAS float* SSQ, const float* gain, bf16* YB, int lane, int r, int kq, int tm, int tvg) {
    const int b = unit / (HGH * 64), h = (unit / 64) % HGH, c = unit % 64, t0 = b * SEQ + c * 64;
    const size_t t = (size_t)(t0 + tm * 16 + r);
    f32x4 oi[4]; v2u gtw[4];
#pragma unroll
    for (int j = 0; j < 4; ++j) { const int ch = h * HGD + (tvg * 4 + j) * 16 + 4 * kq; { const v2u ow = *(const v2u*)(OI + t * HGW + ch); oi[j] = (f32x4){pg8::bf_lo(ow.x), pg8::bf_hi(ow.x), pg8::bf_lo(ow.y), pg8::bf_hi(ow.y)}; } gtw[j] = *(const v2u*)(proj + t * INC + C_G + ch); }
    f32x4 acc[4]; float q = 0.f;
#pragma unroll
    for (int j = 0; j < 4; ++j) { acc[j] = (f32x4){0.f, 0.f, 0.f, 0.f};
#pragma unroll
        for (int ks = 0; ks < 4; ++ks) acc[j] = __builtin_amdgcn_mfma_f32_16x16x32_bf16(O.bfr[j][ks], O.af[ks], acc[j], 0, 0, 0); }
#pragma unroll
    for (int j = 0; j < 4; ++j) { acc[j] += oi[j]; q += (acc[j][0] * acc[j][0] + acc[j][1] * acc[j][1]) + (acc[j][2] * acc[j][2] + acc[j][3] * acc[j][3]); }
    q += shx(q, 16, lane); q += shx(q, 32, lane);
    if (kq == 0) SSQ[tvg * 64 + tm * 16 + r] = q;
    __syncthreads();
    const float rs = rsqrtf((SSQ[tm * 16 + r] + SSQ[64 + tm * 16 + r]) * (1.f / 128.f) + RMS_EPS);
#pragma unroll
    for (int j = 0; j < 4; ++j) { const int ch = h * HGD + (tvg * 4 + j) * 16 + 4 * kq; const f32x4 gn = *(const f32x4*)(gain + ch);
        const float g0 = pg8::bf_lo(gtw[j].x), g1 = pg8::bf_hi(gtw[j].x), g2 = pg8::bf_lo(gtw[j].y), g3 = pg8::bf_hi(gtw[j].y);
        v2u w; w.x = pk2(acc[j][0] * rs * gn[0] * g0 * pg8::sigmoidf_(g0), acc[j][1] * rs * gn[1] * g1 * pg8::sigmoidf_(g1));
        w.y = pk2(acc[j][2] * rs * gn[2] * g2 * pg8::sigmoidf_(g2), acc[j][3] * rs * gn[3] * g3 * pg8::sigmoidf_(g3));
        *(v2u*)(YB + t * HGW + ch) = w; }
    __syncthreads();
}
__device__ __forceinline__ void hgrn_out(const Frame& F, const bf16* proj, const unsigned char* r2, const bf16* SB, const float* gain, bf16* YB) {
    LAS float* SSQ = (LAS float*)F.lds;
    const bf16* OI = (const bf16*)(r2 + R2_OI); const bf16* QP = (const bf16*)(r2 + R2_QP);
    const int lane = F.lane, wv = F.wave, r = lane & 15, kq = lane >> 4, tm = wv & 3, tvg = wv >> 2;
    HoutOps A, B;
    int unit = blockIdx.x;
    if (unit < NHU) hout_load(A, unit, proj, OI, QP, SB, r, kq, tm, tvg);
    for (; unit < NHU; unit += 2 * F.G) {
        const int u2 = unit + F.G, u3 = unit + 2 * F.G;
        if (u2 < NHU) hout_load(B, u2, proj, OI, QP, SB, r, kq, tm, tvg);
        hout_compute(A, unit, proj, OI, SSQ, gain, YB, lane, r, kq, tm, tvg);
        if (u2 < NHU) { if (u3 < NHU) hout_load(A, u3, proj, OI, QP, SB, r, kq, tm, tvg);
            hout_compute(B, u2, proj, OI, SSQ, gain, YB, lane, r, kq, tm, tvg); }
    }
}
__device__ __forceinline__ void memattn(const Frame& F, const bf16* proj, const bf16* KV, int layer, bf16* YX) {
    lbf16* Ks = (lbf16*)F.lds;
    lbf16* VTs = Ks + 256 * 136;
    const int lane = F.lane, wv = F.wave, r = lane & 15, kq = lane >> 4;
    for (int unit = blockIdx.x; unit < NB * XAH * (SEQ / 256); unit += F.G) {
        const int b = unit >> 6, hd = (unit >> 4) & 3, qt = unit & 15;
        {
            v4u kw[8], vw[8];
#pragma unroll
            for (int i = 0; i < 8; ++i) { const int p = F.tid + 512 * i, key = p >> 4, dc = (p & 15) * 8;
                const bf16* src = KV + (size_t)(b * NMEM + key) * 2048 + layer * 1024 + hd * XAD + dc;
                kw[i] = *(const v4u*)src; vw[i] = *(const v4u*)(src + 512); }
            __builtin_amdgcn_sched_barrier(0);
#pragma unroll
            for (int i = 0; i < 8; ++i) { const int p = F.tid + 512 * i, key = p >> 4, dc = (p & 15) * 8;
                *(LAS v4u*)(Ks + key * 136 + dc) = kw[i];
                const v4u w = vw[i];
                const int k5 = key & 31, pos = (key & ~31) + 8 * ((k5 >> 2) & 3) + 4 * ((k5 >> 4) & 1) + (k5 & 3);
                lbf16* d = VTs + dc * 264 + pos;
                d[0] = (bf16)(w.x & 0xffffu); d[264] = (bf16)(w.x >> 16); d[2 * 264] = (bf16)(w.y & 0xffffu); d[3 * 264] = (bf16)(w.y >> 16);
                d[4 * 264] = (bf16)(w.z & 0xffffu); d[5 * 264] = (bf16)(w.z >> 16); d[6 * 264] = (bf16)(w.w & 0xffffu); d[7 * 264] = (bf16)(w.w >> 16); }
        }
        __syncthreads();
#pragma unroll 1
        for (int g = 0; g < 2; ++g) {
            const int t = b * SEQ + qt * 256 + wv * 32 + g * 16 + r;
            bf16x8 qf[4];
#pragma unroll
            for (int ks = 0; ks < 4; ++ks) qf[ks] = *(const bf16x8*)(proj + (size_t)t * INC + C_QX + hd * XAD + ks * 32 + kq * 8);
            f32x4 s[16];
#pragma unroll
            for (int kt = 0; kt < 16; ++kt) { s[kt] = (f32x4){0.f, 0.f, 0.f, 0.f};
#pragma unroll
                for (int ks = 0; ks < 4; ++ks) { const bf16x8 a = *(const LAS bf16x8*)(Ks + (kt * 16 + r) * 136 + ks * 32 + kq * 8); s[kt] = __builtin_amdgcn_mfma_f32_16x16x32_bf16(a, qf[ks], s[kt], 0, 0, 0); }
                if (kt & 1) __builtin_amdgcn_sched_barrier(0); }
            float m = -1e30f;
#pragma unroll
            for (int kt = 0; kt < 16; ++kt) m = fmaxf(m, fmaxf(fmaxf(s[kt][0], s[kt][1]), fmaxf(s[kt][2], s[kt][3])));
            m = fmaxf(m, shx(m, 16, lane)); m = fmaxf(m, shx(m, 32, lane));
            const float cs = 0.08838834764831845f * 1.4426950408889634f; float l = 0.f;
#pragma unroll
            for (int kt = 0; kt < 16; ++kt)
#pragma unroll
                for (int e = 0; e < 4; ++e) { const float p = __builtin_amdgcn_exp2f((s[kt][e] - m) * cs); s[kt][e] = p; l += p; }
            l += shx(l, 16, lane); l += shx(l, 32, lane);
            f32x4 o[8];
#pragma unroll
            for (int dt = 0; dt < 8; ++dt) o[dt] = (f32x4){0.f, 0.f, 0.f, 0.f};
#pragma unroll
            for (int j = 0; j < 8; ++j) {
                v4u pw; pw.x = pk2(s[2 * j][0], s[2 * j][1]); pw.y = pk2(s[2 * j][2], s[2 * j][3]); pw.z = pk2(s[2 * j + 1][0], s[2 * j + 1][1]); pw.w = pk2(s[2 * j + 1][2], s[2 * j + 1][3]);
                const bf16x8 pf = __builtin_bit_cast(bf16x8, pw);
#pragma unroll
                for (int dt = 0; dt < 8; ++dt) { const bf16x8 a = *(const LAS bf16x8*)(VTs + (dt * 16 + r) * 264 + j * 32 + kq * 8); o[dt] = __builtin_amdgcn_mfma_f32_16x16x32_bf16(a, pf, o[dt], 0, 0, 0); }
                __builtin_amdgcn_sched_barrier(0); }
            const float inv = 1.f / l;
#pragma unroll
            for (int dt = 0; dt < 8; ++dt) { v2u w; w.x = pk2(o[dt][0] * inv, o[dt][1] * inv); w.y = pk2(o[dt][2] * inv, o[dt][3] * inv);
                *(v2u*)(YX + (size_t)t * YXW + hd * XAD + dt * 16 + 4 * kq) = w; }
        }
        __syncthreads();
    }
}
struct Args { const float* in[24]; float* out; unsigned char* ws; int ph_lo, ph_hi, mask, pad; };
typedef const __attribute__((address_space(4))) Args* KArgs;
__device__ __forceinline__ KArgs kargs() { KArgs p = (KArgs)__builtin_amdgcn_kernarg_segment_ptr(); asm volatile("" : "+s"(p)); return p; }
#define WSP(T, off) ((T*)(ws + (off)))
__global__ void __launch_bounds__(NWAVES * 64, 2) mk_fwd(Args args) {
    extern __shared__ __attribute__((aligned(16))) unsigned char lds_raw[];
    Frame F0; F0.lds = (LAS unsigned char*)lds_raw; F0.tid = threadIdx.x; F0.lane = F0.tid & 63; F0.wave = __builtin_amdgcn_readfirstlane(F0.tid >> 6);
    F0.G = gridDim.x; F0.gw = blockIdx.x * NWAVES + F0.wave; F0.NGW = F0.G * NWAVES;
    volatile LAS unsigned* MISC = (volatile LAS unsigned*)(F0.lds + MISC_OFF);
    for (int u = F0.tid; u < (LDS_BYTES - MISC_OFF) / 4; u += NWAVES * 64) ((LAS unsigned*)(F0.lds + MISC_OFF))[u] = 0u;
    __syncthreads();
    const int lo = args.ph_lo, hi = args.ph_hi;
    const bool multi = (hi - lo) > 1;
    XcdBarrier bar; bar.bar = (unsigned*)(args.ws + WS_CTL) + CW_BAR; bar.x = 0; bar.st = nullptr;
    if (multi) bar = xcd_barrier_post((unsigned*)(args.ws + WS_CTL) + CW_BAR, MISC + 8);
#define IN(k) (kargs()->ph_lo <= (k) && (k) < kargs()->ph_hi)
#define SEAM(k) do { if (IN((k) + 1)) xcd_barrier(bar); } while (0)
#define PH_BEGIN KArgs ka = kargs(); unsigned char* ws = ka->ws; (void)ws; Frame F = F0; { int w_ = F0.wave; asm volatile("" : "+s"(w_)); F.wave = w_; F.gw = (int)blockIdx.x * NWAVES + w_; } F.lane = pg8::lane_id_opaque(); F.tid = F.wave * 64 + F.lane
    if (IN(PH_CVT)) {
        { PH_BEGIN;
        unsigned gb = 0;
        for (int l = 0; l < 2; ++l) {
            xpose_matrix(F, ka->in[2] + (size_t)l * D * INC, D, INC, (bf16*)(ws + WS_WIN_T + l * WIN_T_L), D, 0, gb);
            xpose_matrix(F, ka->in[4] + (size_t)l * CW * D, CW, D, (bf16*)(ws + WS_WBR_T + l * WBR_T_L), CW, 0, gb);
            xpose_matrix(F, ka->in[7] + (size_t)l * HGW * D, HGW, D, (bf16*)(ws + WS_WBR_T + l * WBR_T_L + 3 * MiB), HGW, 0, gb);
            xpose_matrix(F, ka->in[10] + (size_t)l * XAW * D, XAW, D, (bf16*)(ws + WS_WBR_T + l * WBR_T_L + 6 * MiB), YXW, 0, gb);
            for (int i = blockIdx.x * 512 + F.tid; i < D * 32; i += F.G * 512) *(v4u*)((bf16*)(ws + WS_WBR_T + l * WBR_T_L + 6 * MiB) + (size_t)(i >> 5) * YXW + XAW + (i & 31) * 8) = (v4u){0u, 0u, 0u, 0u};
            xpose_matrix(F, ka->in[11] + (size_t)l * D * D, D, D, (bf16*)(ws + WS_WO_T + l * WO_T_L), D, 0, gb);
            xpose_matrix(F, ka->in[8] + (size_t)l * D * XAW, D, XAW, (bf16*)(ws + WS_WKV_T) + (size_t)(l * 1024) * D, D, 0, gb);
            xpose_matrix(F, ka->in[9] + (size_t)l * D * XAW, D, XAW, (bf16*)(ws + WS_WKV_T) + (size_t)(l * 1024 + 512) * D, D, 0, gb);
        }
        cvt_router(F, ka->in[14], ws);
        cvt_rows(F, ka->in[0], WSP(bf16, WS_XBF), (size_t)NTOK * D / 8);
        cvt_rows(F, ka->in[1], WSP(bf16, WS_MEMBF), (size_t)NB * NMEM * D / 8);
        }
        SEAM(PH_CVT);
    }
    for (int l = 0; l < 2; ++l) {
        const int pb = PH_L0 + l * PH_PER_LAYER;
        if (IN(pb + P_INPROJ)) {
            { PH_BEGIN;
            const bool split = F.G == 256;
            const int oa = (int)blockIdx.x >> 3, ox = (int)blockIdx.x & 7; const bool conv = split && ox < 2;
            const int hrank = 2 * oa + ox, grank = oa;
            static_assert((256 - NCV) * GM_UNITS + NCV * CV_UNITS == (NTOK / 256) * (INC / 256), "in-projection unit shares");
            if (conv) { Frame Fc = F; Fc.gw = hrank * NWAVES + F.wave; Fc.NGW = NCV * NWAVES; unsigned gb = 0;
                cvt_experts(Fc, ka->in[16] + (size_t)l * NE * D * EH, ka->in[17] + (size_t)l * NE * D * EH, ka->in[18] + (size_t)l * NE * EH * D, ka->in[19] + (size_t)l * D * EH, ka->in[20] + (size_t)l * D * EH, ka->in[21] + (size_t)l * EH * D, ws, gb);
                __syncthreads(); }
            if (!split) { unsigned gb = 0; cvt_experts(F, ka->in[16] + (size_t)l * NE * D * EH, ka->in[17] + (size_t)l * NE * D * EH, ka->in[18] + (size_t)l * NE * EH * D, ka->in[19] + (size_t)l * D * EH, ka->in[20] + (size_t)l * D * EH, ka->in[21] + (size_t)l * EH * D, ws, gb); __syncthreads(); }
            DenseSched S; S.init(ws + WS_XBF, ws + WS_WIN_T + l * WIN_T_L, NTOK, INC, D, F.G, (int)blockIdx.x);
            if (split) { S.lin = 1; S.cnt = conv ? CV_UNITS : GM_UNITS;
                if (conv) { S.L0 = (256 - NCV) * GM_UNITS; S.G = NCV; S.c = hrank; } else { S.L0 = (ox - 2) * 32 * GM_UNITS; S.G = 32; S.c = grank; } }
            EpiProj E{WSP(bf16, WS_R1), WSP(unsigned char, WS_GATE8)};
            pg8::gemm_phase<EpiProj, DenseSched, true>(F.lds + RING_OFF, F.wave, D, S, E);
            if (l == 0) {
                DenseSched S2; S2.init(ws + WS_MEMBF, ws + WS_WKV_T, NB * NMEM, 2048, D, split ? 32 : F.G, split ? ((conv && hrank < 32) ? hrank : -1) : (int)blockIdx.x);
                EpiBf16Plain E2{WSP(bf16, WS_KV), 2048};
                pg8::gemm_phase<EpiBf16Plain, DenseSched, true>(F.lds + RING_OFF, F.wave, D, S2, E2);
            }
            }
            SEAM(pb + P_INPROJ);
        }
        if (IN(pb + P_MIX)) {
            { PH_BEGIN;
            memattn(F, WSP(bf16, WS_R1), WSP(bf16, WS_KV), l, WSP(bf16, WS_YX));
            hgrn_local(F, WSP(bf16, WS_R1), ka->in[5], l, ws + WS_R2);
            conv_part(F, WSP(bf16, WS_R1), ka->in[3] + (size_t)l * 3 * CW, WSP(bf16, WS_YA), WSP(bf16, WS_YX));
            }
            SEAM(pb + P_MIX);
        }
        if (IN(pb + P_SCAN)) {
            { PH_BEGIN;
            hgrn_scan(F, ws + WS_R2, WSP(v2u, WS_ZF));
            }
            SEAM(pb + P_SCAN);
        }
        if (IN(pb + P_HOUT)) {
            { PH_BEGIN;
            hgrn_out(F, WSP(bf16, WS_R1), ws + WS_R2, WSP(bf16, WS_ZF), ka->in[6] + (size_t)l * HGW, WSP(bf16, WS_YB));
            }
            SEAM(pb + P_HOUT);
        }
        if (IN(pb + P_BRANCH)) {
            { PH_BEGIN;
            static_assert(WS_YX - WS_YB == WS_YB - WS_YA, "branch inputs equally spaced");
            BranchSched S; S.init(ws + WS_YA, ws + WS_WBR_T + l * WBR_T_L, F.G, (int)blockIdx.x); EpiGateRT E{WSP(unsigned char, WS_GATE8), WSP(bf16, WS_MERGED)};
            pg8::gemm_phase<EpiGateRT, BranchSched, true>(F.lds + RING_OFF, F.wave, CW, S, E);
            }
            SEAM(pb + P_BRANCH);
        }
        if (IN(pb + P_WO)) {
            { PH_BEGIN;
            DenseSched S; S.init(ws + WS_MERGED, ws + WS_WO_T + l * WO_T_L, NTOK, D, D, F.G, (int)blockIdx.x);
            EpiResid<true> E{(const void*)WSP(bf16, WS_XBF), WSP(bf16, WS_ZF)}; pg8::gemm_phase<EpiResid<true>, DenseSched, true>(F.lds + RING_OFF, F.wave, D, S, E);
            }
            SEAM(pb + P_WO);
        }
        if (IN(pb + P_ROUTE)) {
            { PH_BEGIN;
            route_phase(F, WSP(bf16, WS_ZF), ka->in[12] + (size_t)l * D, ka->in[13] + (size_t)l * D, WSP(bf16, WS_RW + l * RW_L), ka->in[15] + (size_t)l * NE, WSP(bf16, WS_X1F), WSP(bf16, WS_X1BF),
                        WSP(unsigned, WS_CTL) + CW_CNT + l * 64, WSP(int, WS_LIST), WSP(int, WS_TOKSLOT), WSP(float, WS_TOKW));
            }
            SEAM(pb + P_ROUTE);
        }
        if (IN(pb + P_GU)) {
            { PH_BEGIN;
            moe_plan(F, WSP(unsigned, WS_CTL) + CW_CNT + l * 64);
            MoeSched<true> S; S.init(F, ws + WS_X1BF, ws + WS_WGU, WSP(int, WS_LIST)); EpiSwiGLU E{WSP(bf16, WS_R2)};
            pg8::gemm_phase<EpiSwiGLU, MoeSched<true>, true>(F.lds + RING_OFF, F.wave, D, S, E);
            }
            SEAM(pb + P_GU);
        }
        if (IN(pb + P_DOWN)) {
            { PH_BEGIN;
            if (kargs()->ph_lo > pb + P_GU) moe_plan(F, WSP(unsigned, WS_CTL) + CW_CNT + l * 64);
            MoeSched<false> S; S.init(F, ws + WS_R2, ws + WS_WDN, nullptr); EpiY8 E{WSP(unsigned char, WS_R1), WSP(bf16, WS_R1 + R1_YS)};
            pg8::gemm_phase<EpiY8, MoeSched<false>, true>(F.lds + RING_OFF, F.wave, EH, S, E);
            }
            SEAM(pb + P_DOWN);
        }
        if (IN(pb + P_COMB)) {
            { PH_BEGIN;
            if (kargs()->ph_lo > pb + P_GU) moe_plan(F, WSP(unsigned, WS_CTL) + CW_CNT + l * 64);
            combine_phase(F, WSP(bf16, WS_X1BF), WSP(unsigned char, WS_R1), WSP(bf16, WS_R1 + R1_YS), WSP(int, WS_TOKSLOT), WSP(float, WS_TOKW), ka->in[22] + (size_t)l * D, ka->in[23] + (size_t)l * D, ka->out, WSP(bf16, WS_XBF), l == 1);
            }
            SEAM(pb + P_COMB);
        }
    }
#undef IN
#undef SEAM
}
static void launch_mk(Args a, int lo, int hi, int grid, hipStream_t stream) {
    a.ph_lo = lo; a.ph_hi = hi;
    hipLaunchKernelGGL(mk_fwd, dim3(grid), dim3(NWAVES * 64), LDS_BYTES, stream, a);
}
extern "C" void kernel_launch(void* const* d_in, const int* in_sizes, int n_in, void* d_out, int out_size, void* d_ws, size_t ws_size, hipStream_t stream) {
    static int grid = 0;
    if (grid == 0) {
        if (n_in != 24 || out_size != NTOK * D || ws_size < WS_END) { fprintf(stderr, "kernel_launch: unexpected sizes n_in %d out %d ws %zu\n", n_in, out_size, ws_size); grid = -1; return; }
        int dev = 0, cus = 0;
        if (hipGetDevice(&dev) != hipSuccess || hipDeviceGetAttribute(&cus, hipDeviceAttributeMultiprocessorCount, dev) != hipSuccess) { grid = -1; return; }
        if (hipFuncSetAttribute((const void*)mk_fwd, hipFuncAttributeMaxDynamicSharedMemorySize, LDS_BYTES) != hipSuccess) { fprintf(stderr, "kernel_launch: hipFuncSetAttribute failed\n"); grid = -1; return; }
        int per_cu = 0; (void)hipOccupancyMaxActiveBlocksPerMultiprocessor(&per_cu, (const void*)mk_fwd, NWAVES * 64, LDS_BYTES); (void)hipGetLastError();
        if (per_cu < 1) fprintf(stderr, "kernel_launch: occupancy query says %d\n", per_cu);
        grid = cus;
    }
    if (grid < 0) return;
    const float* x = (const float*)d_in[0];
    const float* conv_w = (const float*)d_in[3]; const float* lbl = (const float*)d_in[5];
    const float* hg_g = (const float*)d_in[6];
    const float* ln1_g = (const float*)d_in[12]; const float* ln1_b = (const float*)d_in[13]; const float* router_w = (const float*)d_in[14];
    const float* router_b = (const float*)d_in[15]; const float* exp_wg = (const float*)d_in[16]; const float* exp_wu = (const float*)d_in[17];
    const float* exp_wd = (const float*)d_in[18]; const float* sh_wg = (const float*)d_in[19]; const float* sh_wu = (const float*)d_in[20];
    const float* sh_wd = (const float*)d_in[21]; const float* ln2_g = (const float*)d_in[22]; const float* ln2_b = (const float*)d_in[23];
    unsigned char* ws = (unsigned char*)d_ws; float* out = (float*)d_out;
    unsigned* ctl = (unsigned*)(ws + WS_CTL);
    bf16* KV = (bf16*)(ws + WS_KV); bf16* XBF = (bf16*)(ws + WS_XBF); float* X1F = (float*)(ws + WS_X1F);
    bf16* X1BF = (bf16*)(ws + WS_X1BF); float* ZF = (float*)(ws + WS_ZF);
    bf16* YA = (bf16*)(ws + WS_YA); bf16* YB = (bf16*)(ws + WS_YB); bf16* YX = (bf16*)(ws + WS_YX);
    bf16* H = (bf16*)(ws + WS_R2); float* OH = (float*)(ws + WS_R2); bf16* PROJ = (bf16*)(ws + WS_R1); bf16* Y = (bf16*)(ws + WS_R1);
    int* LIST = (int*)(ws + WS_LIST); int* TOKSLOT = (int*)(ws + WS_TOKSLOT); float* TOKW = (float*)(ws + WS_TOKW);
    Args a{};
    for (int i = 0; i < 24; ++i) a.in[i] = (const float*)d_in[i];
    a.out = out; a.ws = ws;

    (void)hipMemsetAsync(ws + WS_CTL, 0, (size_t)(CW_BAR + XCD_BAR_WORDS) * 4, stream);
    a.mask = 7;
    launch_mk(a, 0, N_PHASES, grid, stream);
}
```

```cpp
#include <hip/hip_runtime.h>
#include <stdint.h>
#include <stdio.h>

typedef unsigned short bf16;
__device__ __forceinline__ float bf2f(bf16 v) { return __uint_as_float(((unsigned)v) << 16); }
__device__ __forceinline__ bf16 f2bf(float f) { unsigned u = __float_as_uint(f); return (bf16)((u + 0x7fffu + ((u >> 16) & 1u)) >> 16); }

constexpr int NB = 4, SEQ = 4096, NTOK = NB * SEQ, D = 2048, NMEM = 256;
constexpr int CW = 768, HGW = 768, HGH = 6, HGD = 128, XAW = 512, XAH = 4, XAD = 128;
constexpr int INC = 12032, YXW = 768, GW8 = 3 * 2048, PN_GATE = 23;
constexpr int C_U = 0, C_B = 768, C_C = 1536, C_Q = 2304, C_F = 3072, C_I = 3840, C_G = 4608, C_QX = 5376, C_GA = 5888, C_GB = 7936, C_GX = 9984;
constexpr int NE = 64, TOPK = 8, EH = 512;
constexpr float ALPHA = 1.41421356237f, LN_EPS = 1e-5f, RMS_EPS = 1e-6f, RSCALE = 2.5f;
constexpr int LISTCAP = 16384;

constexpr size_t MiB = 1u << 20;
constexpr size_t WS_CTL = 0, CTL_BYTES = 1 * MiB;
constexpr size_t WS_RW = 1 * MiB, RW_L = 512 * 1024;
constexpr size_t WS_WIN_T = 2 * MiB, WIN_T_L = 47 * MiB;
constexpr size_t WS_WBR_T = 1932 * MiB, WBR_T_L = 9 * MiB;
constexpr size_t WS_WO_T = 112 * MiB, WO_T_L = 8 * MiB;
constexpr size_t WS_WKV_T = 128 * MiB;
constexpr size_t WS_MEMBF = 136 * MiB, WS_KV = 140 * MiB;
constexpr size_t WS_WGU = 144 * MiB, WGU_E = 4 * MiB;
constexpr size_t WS_WDN = 404 * MiB, WDN_E = 2 * MiB;
constexpr size_t WS_XBF = 534 * MiB, WS_X1F = 598 * MiB, WS_X1BF = 726 * MiB, WS_ZF = 790 * MiB, WS_MERGED = 918 * MiB;
constexpr size_t WS_YA = 1860 * MiB, WS_YB = 1884 * MiB, WS_YX = 1908 * MiB;
constexpr size_t WS_R2 = 1046 * MiB;
constexpr size_t WS_R1 = 1214 * MiB;
constexpr size_t R1_YS = 320 * MiB;
constexpr size_t WS_LIST = 1854 * MiB, WS_TOKSLOT = 1858 * MiB, WS_TOKW = 1859 * MiB, WS_GATE8 = 1950 * MiB, WS_END = 2046 * MiB;
constexpr int CW_CNT = 1024;
constexpr int CW_PLAN = 2048;
constexpr int CW_BAR = 4096;
#ifndef DBG_MASK
#define DBG_MASK 7
#endif
namespace pg8 {
#define PG8_LAS __attribute__((address_space(3)))
typedef unsigned short bf16_t;
typedef short bf16x8 __attribute__((ext_vector_type(8)));
typedef float f32x4 __attribute__((ext_vector_type(4)));
typedef unsigned u32x4 __attribute__((ext_vector_type(4)));
typedef unsigned u32x2 __attribute__((ext_vector_type(2)));
constexpr int PG8_NVO_OFF = 147456 + 1024;
constexpr int BM = 256, BK = 64, HALF = 128, HTB = HALF * BK * 2  , STAGE_BYTES = 8 * HTB, NXCD = 8, WGM = 8;

__host__ __device__ __forceinline__ int lds_byte(int r, int c) { const int st = (r >> 4) * 2 + (c >> 5), rr = r & 15, cc = c & 31, ob = rr * 64 + cc * 2; return st * 1024 + (ob ^ (((ob >> 9) & 1) << 5)); }
__host__ __device__ __forceinline__ void stage_rc(int b, int& R, int& C) { const int st = b / 1024, sb = b % 1024, swz = sb ^ (((sb >> 9) & 1) << 5); R = (st >> 1) * 16 + swz / 64; C = (st & 1) * 32 + (swz % 64) / 2; }
__host__ __device__ __forceinline__ int perm32(int rho) { const int n = rho >> 4, i = rho & 15; return 8 * (i >> 2) + 4 * n + (i & 3); }

struct Unit { const char* A; const char* B; int pm, pn; const int* list; int m0, cnt; };

typedef float f32x2_ __attribute__((ext_vector_type(2)));
typedef __bf16 bf16x2_ __attribute__((ext_vector_type(2)));
__device__ __forceinline__ unsigned cvt_pk_bf16(float lo, float hi) { const f32x2_ v = {lo, hi}; const bf16x2_ b = __builtin_convertvector(v, bf16x2_); return __builtin_bit_cast(unsigned, b); }
__device__ __forceinline__ int lane_id_opaque() { unsigned m = ~0u; asm volatile("" : "+s"(m)); return (int)__builtin_amdgcn_mbcnt_hi(m, __builtin_amdgcn_mbcnt_lo(m, 0u)); }
__device__ __forceinline__ float bf_lo(unsigned w) { return __uint_as_float(w << 16); }
__device__ __forceinline__ float bf_hi(unsigned w) { return __uint_as_float(w & 0xffff0000u); }
__device__ __forceinline__ float sigmoidf_(float x) { return __builtin_amdgcn_rcpf(1.f + __expf(-x)); }

typedef f32x4 Acc[2][2][4][2];

template <class Epi, class Sched, bool ALIGN_EPI>
__device__ __forceinline__ void gemm_phase(PG8_LAS unsigned char* lds, const int wave, const int K_in, const Sched& S, const Epi& E) {
    const int lane = lane_id_opaque(), wid = wave, tid = wid * 64 + lane, wr = wid >> 2, wc = wid & 3, fr = lane & 15, fq = lane >> 4;
    int K = K_in; asm volatile("" : "+s"(K));
    const int nt = K / BK;
    unsigned voffB[2];
#pragma unroll
    for (int i = 0; i < 2; ++i) { int R, C; stage_rc(tid * 16 + i * 8192, R, C); const int Rb = Epi::PERM ? ((R & ~31) + perm32(R & 31)) : R; voffB[i] = (unsigned)(Rb * K + C) * 2u; }
    const size_t kstep = (size_t)(BK * 2);
    const size_t hstep = (size_t)HALF * K * 2;
    const unsigned ldsw = (unsigned)wid * 1024u;
    const int aoff = lds_byte(wr * 64 + fr, fq * 8), boff = lds_byte(wc * 32 + fr, fq * 8);
#define PG8_SA(b, h) (((b) * 2 + (h)) * HTB)
#define PG8_SB(b, h) ((4 + (b) * 2 + (h)) * HTB)
#define PG8_STAGE2(bufoff, gbase, v0, v1) do { \
        __builtin_amdgcn_global_load_lds((const unsigned*)((const char*)(gbase) + (v0)), (PG8_LAS unsigned*)(lds + (bufoff) + ldsw), 16, 0, 0); \
        __builtin_amdgcn_global_load_lds((const unsigned*)((const char*)(gbase) + (v1)), (PG8_LAS unsigned*)(lds + (bufoff) + ldsw + 8192), 16, 0, 0); } while (0)
#define PG8_STAGEB(bufoff, gbase) PG8_STAGE2(bufoff, gbase, voffB[0], voffB[1])
#define PG8_LDA(dst, b, h) do { _Pragma("unroll") for (int m = 0; m < 4; ++m) _Pragma("unroll") for (int k = 0; k < 2; ++k) dst[m][k] = *(const PG8_LAS bf16x8*)(lds + PG8_SA(b, h) + aoff + m * 2048 + k * 1024); } while (0)
#define PG8_LDB(dst, b, h) do { _Pragma("unroll") for (int n = 0; n < 2; ++n) _Pragma("unroll") for (int k = 0; k < 2; ++k) dst[n][k] = *(const PG8_LAS bf16x8*)(lds + PG8_SB(b, h) + boff + n * 2048 + k * 1024); } while (0)
#define PG8_MMA(ai, bj, At, Bt) do { __builtin_amdgcn_s_setprio(1); _Pragma("unroll") for (int m = 0; m < 4; ++m) _Pragma("unroll") for (int n = 0; n < 2; ++n) _Pragma("unroll") for (int k = 0; k < 2; ++k) \
        acc[ai][bj][m][n] = __builtin_amdgcn_mfma_f32_16x16x32_bf16(Bt[n][k], At[m][k], acc[ai][bj][m][n], 0, 0, 0); __builtin_amdgcn_s_setprio(0); } while (0)
#define PG8_WAIT_V(n) asm volatile("s_waitcnt vmcnt(" #n ")" ::: "memory")
#define PG8_WAIT_L(n) asm volatile("s_waitcnt lgkmcnt(" #n ")" ::: "memory")
#define PG8_BAR __builtin_amdgcn_s_barrier()
#define PG8_SCHED __builtin_amdgcn_sched_barrier(0)
    Unit cur, nxt; int ui = 0;
    if (!S.next(0, cur)) return;
    Acc acc;
#pragma unroll
    for (int a = 0; a < 2; ++a)
#pragma unroll
        for (int b = 0; b < 2; ++b)
#pragma unroll
            for (int m = 0; m < 4; ++m)
#pragma unroll
                for (int n = 0; n < 2; ++n) acc[a][b][m][n] = (f32x4){0.f, 0.f, 0.f, 0.f};
    bf16x8 At[4][2], B0[2][2], B1[2][2];
    constexpr bool GA = Sched::GATHER;
    unsigned c00, c01, c10 = 0, c11 = 0;
    PG8_LAS unsigned* nvo = (PG8_LAS unsigned*)(lds + PG8_NVO_OFF) + tid * 4;
    { int R0, C0, R1, C1; stage_rc(tid * 16, R0, C0); stage_rc(tid * 16 + 8192, R1, C1);
      c00 = S.avoff(cur, 0, R0, C0, K); c01 = S.avoff(cur, 0, R1, C1, K); if constexpr (GA) { c10 = S.avoff(cur, 1, R0, C0, K); c11 = S.avoff(cur, 1, R1, C1, K); } }
    const size_t hA = GA ? (size_t)0 : hstep;
#define PG8_STAGEA0(bufoff, gbase) PG8_STAGE2(bufoff, gbase, c00, c01)
#define PG8_STAGEA1(bufoff, gbase) do { if constexpr (GA) PG8_STAGE2(bufoff, gbase, c10, c11); else PG8_STAGE2(bufoff, (gbase) + hA, c00, c01); } while (0)
    const char* cA = cur.A; const char* cB = cur.B;
    PG8_STAGEB(PG8_SB(0, 0), cB); PG8_STAGEB(PG8_SB(0, 1), cB + hstep); PG8_STAGEA0(PG8_SA(0, 0), cA); PG8_STAGEA1(PG8_SA(0, 1), cA);
    if (wr == 1) PG8_BAR;
    PG8_WAIT_V(2); PG8_BAR;
    PG8_STAGEB(PG8_SB(1, 0), cB + kstep); PG8_STAGEA0(PG8_SA(1, 0), cA + kstep); PG8_STAGEB(PG8_SB(1, 1), cB + hstep + kstep);
    PG8_WAIT_V(6); PG8_BAR;
    int pi0 = 0, pi1 = 0, pi2 = 0, pi3 = 0;
    if constexpr (GA) { Unit n1; if (S.next(1, n1)) { int R0, C0, R1, C1; stage_rc(tid * 16, R0, C0); stage_rc(tid * 16 + 8192, R1, C1);
        pi0 = S.avload(n1, 0, R0); pi1 = S.avload(n1, 0, R1); pi2 = S.avload(n1, 1, R0); pi3 = S.avload(n1, 1, R1); } }
    for (;;) {
        const bool has_next = S.next(ui + 1, nxt);
        const char* nA = has_next ? nxt.A : cA; const char* nB = has_next ? nxt.B : cB;
        if constexpr (GA) { if (has_next) {
            int R0, C0, R1, C1; stage_rc(tid * 16, R0, C0); stage_rc(tid * 16 + 8192, R1, C1);
            nvo[0] = S.avfin(nxt, 0, R0, C0, K, pi0); nvo[1] = S.avfin(nxt, 0, R1, C1, K, pi1); nvo[2] = S.avfin(nxt, 1, R0, C0, K, pi2); nvo[3] = S.avfin(nxt, 1, R1, C1, K, pi3); } }
        for (int t = 0; t < nt; t += 2) {
            const bool last = (t == nt - 2);
            const char* a1 = cA + (size_t)(t + 1) * kstep;
            const char* a2 = last ? nA : cA + (size_t)(t + 2) * kstep; const char* b2 = last ? nB : cB + (size_t)(t + 2) * kstep;
            const char* a3 = a2 + kstep; const char* b3 = b2 + kstep;
            const bool nx = GA && last && has_next;
#define PG8_STAGEA0N(bufoff, gbase) do { if (nx) { const unsigned q0 = nvo[0], q1 = nvo[1]; PG8_STAGE2(bufoff, gbase, q0, q1); } else PG8_STAGEA0(bufoff, gbase); } while (0)
#define PG8_STAGEA1N(bufoff, gbase) do { if (nx) { const unsigned q0 = nvo[2], q1 = nvo[3]; PG8_STAGE2(bufoff, gbase, q0, q1); } else PG8_STAGEA1(bufoff, gbase); } while (0)
            PG8_LDB(B0, 0, 0); PG8_LDB(B1, 0, 1); PG8_SCHED; PG8_LDA(At, 0, 0); PG8_STAGEA1(PG8_SA(1, 1), a1);
            PG8_WAIT_V(8); PG8_WAIT_L(0); PG8_BAR; PG8_MMA(0, 0, At, B0); PG8_MMA(0, 1, At, B1); PG8_BAR; PG8_SCHED;
            PG8_LDA(At, 0, 1); PG8_STAGEB(PG8_SB(0, 0), b2); PG8_STAGEB(PG8_SB(0, 1), b2 + hstep); PG8_STAGEA0N(PG8_SA(0, 0), a2);
            PG8_WAIT_V(8); PG8_WAIT_L(0); PG8_BAR; PG8_MMA(1, 0, At, B0); PG8_MMA(1, 1, At, B1); PG8_BAR; PG8_SCHED;
            PG8_LDB(B0, 1, 0); PG8_LDB(B1, 1, 1); PG8_SCHED; PG8_LDA(At, 1, 0); PG8_STAGEA1N(PG8_SA(0, 1), a2);
            PG8_WAIT_V(8); PG8_WAIT_L(0); PG8_BAR; PG8_MMA(0, 0, At, B0); PG8_MMA(0, 1, At, B1); PG8_BAR; PG8_SCHED;
            PG8_LDA(At, 1, 1); PG8_STAGEB(PG8_SB(1, 0), b3); PG8_STAGEB(PG8_SB(1, 1), b3 + hstep); PG8_STAGEA0N(PG8_SA(1, 0), a3);
            PG8_WAIT_V(8); PG8_WAIT_L(0); PG8_BAR; PG8_MMA(1, 0, At, B0); PG8_MMA(1, 1, At, B1); PG8_BAR; PG8_SCHED;
#undef PG8_STAGEA0N
#undef PG8_STAGEA1N
        }
        if constexpr (GA) { Unit n2; if (has_next && S.next(ui + 2, n2)) { int R0, C0, R1, C1; stage_rc(tid * 16, R0, C0); stage_rc(tid * 16 + 8192, R1, C1);
            pi0 = S.avload(n2, 0, R0); pi1 = S.avload(n2, 0, R1); pi2 = S.avload(n2, 1, R0); pi3 = S.avload(n2, 1, R1); } }
        if constexpr (ALIGN_EPI) { if (wr == 0) PG8_BAR; }
        bool keep = false;
        if constexpr (Epi::INPLACE) keep = E.inplace(acc, cur, wr, wc, fr, fq); else E(acc, cur, wr, wc, fr, fq);
        if (!has_next) break;
        if (!keep)
#pragma unroll
        for (int a = 0; a < 2; ++a)
#pragma unroll
            for (int b = 0; b < 2; ++b)
#pragma unroll
                for (int m = 0; m < 4; ++m)
#pragma unroll
                    for (int n = 0; n < 2; ++n) acc[a][b][m][n] = (f32x4){0.f, 0.f, 0.f, 0.f};
        cur = nxt; cA = nA; cB = nB; ++ui; if constexpr (GA) { c00 = nvo[0]; c01 = nvo[1]; c10 = nvo[2]; c11 = nvo[3]; }
        if constexpr (ALIGN_EPI) { if (wr == 1) PG8_BAR; }
    }
    PG8_WAIT_V(0);
    if constexpr (!ALIGN_EPI) { if (wr == 0) PG8_BAR; }
    PG8_BAR;
#undef PG8_SA
#undef PG8_SB
#undef PG8_STAGE2
#undef PG8_STAGEB
#undef PG8_STAGEA0
#undef PG8_STAGEA1
#undef PG8_LDA
#undef PG8_LDB
#undef PG8_MMA
#undef PG8_WAIT_V
#undef PG8_WAIT_L
#undef PG8_BAR
#undef PG8_SCHED
}
}
#define GAS __attribute__((address_space(1)))
#define LAS __attribute__((address_space(3)))
typedef unsigned v4u __attribute__((ext_vector_type(4)));
typedef unsigned v2u __attribute__((ext_vector_type(2)));
typedef float f32x4 __attribute__((ext_vector_type(4)));
typedef short bf16x8 __attribute__((ext_vector_type(8)));
typedef GAS unsigned gu32;
#define RLX_AGENT __ATOMIC_RELAXED, __HIP_MEMORY_SCOPE_AGENT
#define LDS_WAIT() asm volatile("s_waitcnt lgkmcnt(0)" ::: "memory")
#define VM_WAIT() asm volatile("s_waitcnt vmcnt(0)" ::: "memory")
__device__ __forceinline__ int opaque_v(int x) { asm volatile("" : "+v"(x)); return x; }
__device__ __forceinline__ float shx(float v, int o, int lane) { return __int_as_float(__builtin_amdgcn_ds_bpermute((lane ^ o) << 2, __float_as_int(v))); }
__device__ __forceinline__ unsigned pk2(float lo, float hi) { return pg8::cvt_pk_bf16(lo, hi); }

#define XB_TMO      128
#define XB_XCNT(j)  (256  + 64 * (j))
#define XB_XSUB(j)  (1280 + 64 * (j))
#define XB_XGEN(j)  (2304 + 64 * (j))
#define XB_TOP      3328
#define XB_TOPGEN   3392
#define XCD_BAR_WORDS 3456
#define XB_SPIN_CAP (1u << 18)
__device__ __forceinline__ unsigned xb_ld(unsigned* p)              { return __hip_atomic_load(p, __ATOMIC_RELAXED, __HIP_MEMORY_SCOPE_AGENT); }
__device__ __forceinline__ unsigned xb_add(unsigned* p, unsigned v) { return __hip_atomic_fetch_add(p, v, __ATOMIC_RELAXED, __HIP_MEMORY_SCOPE_AGENT); }
__device__ __forceinline__ unsigned xb_xcc_id() { return (unsigned)__builtin_amdgcn_s_getreg((3 << 11) | 20) & 0xFu; }
#define XB_SPIN(cond, bar) do { unsigned _sp = 0; while (cond) { __builtin_amdgcn_s_sleep(1); \
    if ((++_sp & 255u) == 0u) { if (xb_ld(&(bar)[XB_TMO])) break; if (_sp > XB_SPIN_CAP) { atomicAdd(&(bar)[XB_TMO], 1u); break; } } } } while (0)
struct XcdBarrier { unsigned* bar; unsigned x; volatile LAS unsigned* st; };
__device__ __forceinline__ XcdBarrier xcd_barrier_post(unsigned* bar, volatile LAS unsigned* st) {
    XcdBarrier b; b.bar = bar; b.x = xb_xcc_id(); b.st = st;
    if (threadIdx.x == 0) (void)xb_add(&bar[XB_XCNT(b.x)], 1u);
    return b;
}
__device__ __forceinline__ void xcd_barrier_complete(unsigned* bar, unsigned x, unsigned& nloc, unsigned& nx) {
    const unsigned G = gridDim.x * gridDim.y * gridDim.z;
    unsigned sum, cnt, mine, sp = 0u;
    for (;;) {
        sum = 0u; cnt = 0u; mine = 0u;
#pragma unroll
        for (unsigned j = 0; j < 16; ++j) { const unsigned c = xb_ld(&bar[XB_XCNT(j)]); sum += c; cnt += (c > 0u) ? 1u : 0u; mine = (j == x) ? c : mine; }
        if (sum == G) break;
        __builtin_amdgcn_s_sleep(1);
        if ((++sp & 255u) == 0u) { if (xb_ld(&bar[XB_TMO])) break; if (sp > XB_SPIN_CAP) { atomicAdd(&bar[XB_TMO], 1u); break; } }
    }
    nloc = mine > 0u ? mine : 1u; nx = cnt > 0u ? cnt : 1u;
}
__device__ __forceinline__ void xcd_barrier(const XcdBarrier& b_in) {
    asm volatile("s_waitcnt vmcnt(0)" ::: "memory");
    __syncthreads();
    if (threadIdx.x == 0) {
        XcdBarrier b = b_in; asm volatile("" : "+s"(b.x));
        unsigned* bar = b.bar; asm volatile("" : "+s"(bar));
        __builtin_amdgcn_s_waitcnt(0);
        unsigned nloc = b.st[0], nx = b.st[1];
        if (nloc == 0u) { xcd_barrier_complete(bar, b.x, nloc, nx); b.st[0] = nloc; b.st[1] = nx; }
        const unsigned old = xb_add(&bar[XB_XSUB(b.x)], 1u);
        const unsigned gen = old / nloc;
        if (old + 1u == (gen + 1u) * nloc) {
            __builtin_amdgcn_fence(__ATOMIC_RELEASE, "agent");
            asm volatile("s_waitcnt vmcnt(0)" ::: "memory");
            const unsigned og = xb_add(&bar[XB_TOP], 1u);
            const unsigned tg = og / nx;
            if (og + 1u == (tg + 1u) * nx) xb_add(&bar[XB_TOPGEN], 1u);
            else XB_SPIN(xb_ld(&bar[XB_TOPGEN]) == tg, bar);
            __builtin_amdgcn_fence(__ATOMIC_ACQUIRE, "agent");
            xb_add(&bar[XB_XGEN(b.x)], 1u);
            asm volatile("s_waitcnt vmcnt(0)" ::: "memory");
        } else {
            XB_SPIN(xb_ld(&bar[XB_XGEN(b.x)]) == gen, bar);
            __builtin_amdgcn_fence(__ATOMIC_ACQUIRE, "agent");
            asm volatile("s_waitcnt vmcnt(0)" ::: "memory");
        }
    }
    __syncthreads();
}
using pg8::Unit; using pg8::Acc;
struct DenseSched { static constexpr bool GATHER = false;
    const char* A; const char* B; int nM, nN, nwg, G, c, K; int L0 = 0, cnt = 1 << 30, lin = 0;
    __device__ __forceinline__ void init(const void* A_, const void* B_, int M, int N, int K_, int G_, int c_) { A = (const char*)A_; B = (const char*)B_; nM = M / 256; nN = N / 256; nwg = nM * nN; G = G_; c = c_; K = K_; }
    __device__ __forceinline__ bool next(int i, Unit& u) const {
        const long L = (long)L0 + (long)i * G + c; if (c < 0 || i >= cnt || L >= nwg) return false;
        int wgid = (int)L; if (!lin) { const int q = nwg / 8, r = nwg % 8, xcd = wgid % 8, off = wgid / 8; wgid = (xcd < r ? xcd * (q + 1) : r * (q + 1) + (xcd - r) * q) + off; }
        const int nig = 8 * nN, gid = wgid / nig, fm = gid * 8, gsz = (nM - fm) < 8 ? (nM - fm) : 8;
        u.pm = fm + ((wgid % nig) % gsz); u.pn = (wgid % nig) / gsz;
        u.A = A + (size_t)u.pm * 256 * K * 2; u.B = B + (size_t)u.pn * 256 * K * 2; u.list = nullptr; u.m0 = 0; u.cnt = 0; return true;
    }
    __device__ __forceinline__ int avload(const Unit&, int, int) const { return 0; }
    __device__ __forceinline__ unsigned avfin(const Unit&, int h, int R, int C, int K_, int) const { return (unsigned)(((h * 128 + R) * K_ + C) * 2); }
    __device__ __forceinline__ unsigned avoff(const Unit&, int h, int R, int C, int K_) const { return (unsigned)(((h * 128 + R) * K_ + C) * 2); }
};
struct EpiBf16Plain { static constexpr bool PERM = true, INPLACE = false; bf16* O; int ldc;
    __device__ __forceinline__ void operator()(const Acc& acc, const Unit& u, int wr, int wc, int fr, int fq) const {
        const int row0 = u.pm * 256 + wr * 64 + fr, col0 = u.pn * 256 + wc * 32 + 8 * fq;
#pragma unroll
        for (int ai = 0; ai < 2; ++ai)
#pragma unroll
            for (int m = 0; m < 4; ++m) { bf16* rowp = O + (size_t)(row0 + ai * 128 + m * 16) * ldc + col0;
#pragma unroll
                for (int bj = 0; bj < 2; ++bj) { const f32x4 v0 = acc[ai][bj][m][0], v1 = acc[ai][bj][m][1];
                    v4u w; w.x = pk2(v0[0], v0[1]); w.y = pk2(v0[2], v0[3]); w.z = pk2(v1[0], v1[1]); w.w = pk2(v1[2], v1[3]);
                    *(v4u*)(rowp + bj * 128) = w; } }
    }
};
struct EpiProj { static constexpr bool PERM = true, INPLACE = false; bf16* O; unsigned char* G8;
    __device__ __forceinline__ void operator()(const Acc& acc, const Unit& u, int wr, int wc, int fr, int fq) const {
        const int row0 = u.pm * 256 + wr * 64 + fr;
        if (u.pn < PN_GATE) { const int col0 = u.pn * 256 + wc * 32 + 8 * fq;
#pragma unroll
            for (int ai = 0; ai < 2; ++ai)
#pragma unroll
                for (int m = 0; m < 4; ++m) { bf16* rowp = O + (size_t)(row0 + ai * 128 + m * 16) * INC + col0;
#pragma unroll
                    for (int bj = 0; bj < 2; ++bj) { const f32x4 v0 = acc[ai][bj][m][0], v1 = acc[ai][bj][m][1];
                        v4u w; w.x = pk2(v0[0], v0[1]); w.y = pk2(v0[2], v0[3]); w.z = pk2(v1[0], v1[1]); w.w = pk2(v1[2], v1[3]);
                        *(v4u*)(rowp + bj * 128) = w; } }
        } else { const int pos0 = (u.pn - PN_GATE) * 256 + wc * 64 + fq * 16;
#pragma unroll
            for (int ai = 0; ai < 2; ++ai)
#pragma unroll
                for (int m = 0; m < 4; ++m) { unsigned char* rowp = G8 + (size_t)(row0 + ai * 128 + m * 16) * GW8 + pos0;
                    v4u w;
#pragma unroll
                    for (int bj = 0; bj < 2; ++bj) { const f32x4 v0 = acc[ai][bj][m][0], v1 = acc[ai][bj][m][1];
                        unsigned q[8];
#pragma unroll
                        for (int j = 0; j < 4; ++j) { q[j] = (unsigned)fmaxf(pg8::sigmoidf_(v0[j]) * 255.f + 0.5f, 1.f); q[4 + j] = (unsigned)fmaxf(pg8::sigmoidf_(v1[j]) * 255.f + 0.5f, 1.f); }
                        const unsigned lo = q[0] | (q[1] << 8) | (q[2] << 16) | (q[3] << 24), hi = q[4] | (q[5] << 8) | (q[6] << 16) | (q[7] << 24);
                        if (bj == 0) { w.x = lo; w.y = hi; } else { w.z = lo; w.w = hi; } }
                    *(v4u*)rowp = w; }
        }
    }
};
struct BranchSched { static constexpr bool GATHER = false;
    const char* A0; const char* B; int G, c;
    __device__ __forceinline__ void init(const void* ya, const void* w, int G_, int c_) { A0 = (const char*)ya; B = (const char*)w; G = G_; c = c_; }
    __device__ __forceinline__ bool next(int i, Unit& u) const {
        const int j = i / 3, seg = i - 3 * j; constexpr int nM = NTOK / 256, nN = D / 256, nwg = nM * nN;
        const int L = j * G + c; if (L >= nwg) return false;
        int wgid = L; { const int q = nwg / 8, xcd = wgid % 8, off = wgid / 8; wgid = xcd * q + off; }
        const int nig = 8 * nN; u.pm = (wgid / nig) * 8 + ((wgid % nig) % 8); u.pn = (wgid % nig) / 8;
        u.A = A0 + (size_t)seg * (WS_YB - WS_YA) + (size_t)u.pm * 256 * CW * 2; u.B = B + (size_t)seg * 3 * MiB + (size_t)u.pn * 256 * CW * 2; u.list = nullptr; u.m0 = seg; u.cnt = 0; return true; }
    __device__ __forceinline__ int avload(const Unit&, int, int) const { return 0; }
    __device__ __forceinline__ unsigned avfin(const Unit&, int h, int R, int C, int K_, int) const { return (unsigned)(((h * 128 + R) * K_ + C) * 2); }
    __device__ __forceinline__ unsigned avoff(const Unit&, int h, int R, int C, int K_) const { return (unsigned)(((h * 128 + R) * K_ + C) * 2); }
};
struct EpiGateRT { static constexpr bool PERM = true, INPLACE = true; const unsigned char* g8; bf16* merged;
    __device__ __forceinline__ bool inplace(Acc& acc, const Unit& u, int wr, int wc, int fr, int fq) const {
        const int row0 = u.pm * 256 + wr * 64 + fr, col0 = u.pn * 256 + wc * 32 + 8 * fq, pos0 = u.pn * 256 + wc * 64 + fq * 16; const int seg = u.m0;
#pragma unroll
        for (int ai = 0; ai < 2; ++ai) {
            v4u ga[4], gb[4];
#pragma unroll
            for (int m = 0; m < 4; ++m) { const size_t row = (size_t)(row0 + ai * 128 + m * 16);
                ga[m] = *(const v4u*)(g8 + row * GW8 + seg * D + pos0); gb[m] = ga[m]; if (seg < 2) gb[m] = *(const v4u*)(g8 + row * GW8 + (seg + 1) * D + pos0); }
            asm volatile("" ::: "memory");
#pragma unroll
            for (int m = 0; m < 4; ++m) { const size_t row = (size_t)(row0 + ai * 128 + m * 16);
#pragma unroll
                for (int bj = 0; bj < 2; ++bj) { const unsigned ax = bj ? ga[m].z : ga[m].x, ay = bj ? ga[m].w : ga[m].y, bx = bj ? gb[m].z : gb[m].x, by = bj ? gb[m].w : gb[m].y;
                    f32x4 v0 = acc[ai][bj][m][0], v1 = acc[ai][bj][m][1];
                    if (seg < 2) {
                        v0[0] *= (float)(ax & 255u) * __builtin_amdgcn_rcpf((float)(bx & 255u)); v0[1] *= (float)((ax >> 8) & 255u) * __builtin_amdgcn_rcpf((float)((bx >> 8) & 255u));
                        v0[2] *= (float)((ax >> 16) & 255u) * __builtin_amdgcn_rcpf((float)((bx >> 16) & 255u)); v0[3] *= (float)(ax >> 24) * __builtin_amdgcn_rcpf((float)(bx >> 24));
                        v1[0] *= (float)(ay & 255u) * __builtin_amdgcn_rcpf((float)(by & 255u)); v1[1] *= (float)((ay >> 8) & 255u) * __builtin_amdgcn_rcpf((float)((by >> 8) & 255u));
                        v1[2] *= (float)((ay >> 16) & 255u) * __builtin_amdgcn_rcpf((float)((by >> 16) & 255u)); v1[3] *= (float)(ay >> 24) * __builtin_amdgcn_rcpf((float)(by >> 24));
                        acc[ai][bj][m][0] = v0; acc[ai][bj][m][1] = v1;
                    } else { constexpr float s8 = 1.f / 255.f;
                        v0[0] *= (float)(ax & 255u) * s8; v0[1] *= (float)((ax >> 8) & 255u) * s8; v0[2] *= (float)((ax >> 16) & 255u) * s8; v0[3] *= (float)(ax >> 24) * s8;
                        v1[0] *= (float)(ay & 255u) * s8; v1[1] *= (float)((ay >> 8) & 255u) * s8; v1[2] *= (float)((ay >> 16) & 255u) * s8; v1[3] *= (float)(ay >> 24) * s8;
                        v4u w; w.x = pk2(v0[0], v0[1]); w.y = pk2(v0[2], v0[3]); w.z = pk2(v1[0], v1[1]); w.w = pk2(v1[2], v1[3]); *(v4u*)(merged + row * D + col0 + bj * 128) = w; } } }
            asm volatile("" ::: "memory");
        }
        return seg < 2;
    }
};
template <bool RB16> struct EpiResid { static constexpr bool PERM = true, INPLACE = false; const void* xres; bf16* z;
    __device__ __forceinline__ void operator()(const Acc& acc, const Unit& u, int wr, int wc, int fr, int fq) const {
        const int row0 = u.pm * 256 + wr * 64 + fr, col0 = u.pn * 256 + wc * 32 + 8 * fq;
#pragma unroll
        for (int ai = 0; ai < 2; ++ai) {
            f32x4 xr[4][2][2];
#pragma unroll
            for (int m = 0; m < 4; ++m) { const size_t off = (size_t)(row0 + ai * 128 + m * 16) * D + col0;
#pragma unroll
                for (int bj = 0; bj < 2; ++bj) {
                    if constexpr (RB16) { const v4u w = *(const v4u*)((const bf16*)xres + off + bj * 128);
                        xr[m][bj][0] = (f32x4){pg8::bf_lo(w.x), pg8::bf_hi(w.x), pg8::bf_lo(w.y), pg8::bf_hi(w.y)}; xr[m][bj][1] = (f32x4){pg8::bf_lo(w.z), pg8::bf_hi(w.z), pg8::bf_lo(w.w), pg8::bf_hi(w.w)}; }
                    else {
#pragma unroll
                        for (int n = 0; n < 2; ++n) xr[m][bj][n] = *(const f32x4*)((const float*)xres + off + bj * 128 + n * 4); } } }
            asm volatile("" ::: "memory");
#pragma unroll
            for (int m = 0; m < 4; ++m) { const size_t off = (size_t)(row0 + ai * 128 + m * 16) * D + col0;
#pragma unroll
                for (int bj = 0; bj < 2; ++bj) { const f32x4 v0 = xr[m][bj][0] * ALPHA + acc[ai][bj][m][0], v1 = xr[m][bj][1] * ALPHA + acc[ai][bj][m][1];
                    v4u w; w.x = pk2(v0[0], v0[1]); w.y = pk2(v0[2], v0[3]); w.z = pk2(v1[0], v1[1]); w.w = pk2(v1[2], v1[3]); *(v4u*)(z + off + bj * 128) = w; } }
            asm volatile("" ::: "memory");
        }
    }
};

constexpr int NWAVES = 8;
constexpr int RING_OFF = 0, RING_BYTES = 131072;
constexpr int SCR_BYTES = 147456;
constexpr int MISC_OFF = SCR_BYTES;
constexpr int LDS_BYTES = 163840;
constexpr int PH_CVT = 0, PH_L0 = 1, PH_PER_LAYER = 10;
constexpr int P_INPROJ = 0, P_MIX = 1, P_SCAN = 2, P_HOUT = 3, P_BRANCH = 4, P_WO = 5, P_ROUTE = 6, P_GU = 7, P_DOWN = 8, P_COMB = 9;
constexpr int N_PHASES = PH_L0 + 2 * PH_PER_LAYER;

constexpr int NCV = 64;
#define CV_UNITS 2
#define GM_UNITS 15
struct Frame { LAS unsigned char* lds; int tid, lane, wave, G, gw, NGW; };

__device__ __forceinline__ void xpose_item(const float* W, int N, int k0, int n0, bf16* WTrow0, int ldk, LAS float* scr, int lane) {
    const int kk = lane >> 3, nn = (lane & 7) * 4;
    f32x4 v[8];
#pragma unroll
    for (int i = 0; i < 8; ++i) v[i] = *(const f32x4*)(W + (size_t)(k0 + kk + 8 * i) * N + n0 + nn);
#pragma unroll
    for (int i = 0; i < 8; ++i) { LAS float* s = scr + (kk + 8 * i) * 33 + nn; s[0] = v[i][0]; s[1] = v[i][1]; s[2] = v[i][2]; s[3] = v[i][3]; }
    LDS_WAIT(); asm volatile("" ::: "memory");
    const int c = lane & 7;
#pragma unroll
    for (int j = 0; j < 4; ++j) { const int n = (lane >> 3) + 8 * j; const LAS float* s = scr + (8 * c) * 33 + n;
        v4u o; o.x = pk2(s[0 * 33], s[1 * 33]); o.y = pk2(s[2 * 33], s[3 * 33]); o.z = pk2(s[4 * 33], s[5 * 33]); o.w = pk2(s[6 * 33], s[7 * 33]);
        *(v4u*)(WTrow0 + (size_t)n * ldk + 8 * c) = o; }
    LDS_WAIT(); asm volatile("" ::: "memory");
}
__device__ __forceinline__ void xpose_matrix(const Frame& F, const float* W, int K, int N, bf16* WT, int ldk, int mode, unsigned& gbase) {
    const int nblk = N / 32, nitems = (K / 64) * nblk;
    LAS float* scr = (LAS float*)(F.lds + RING_OFF + F.wave * 8704);
    int it = (int)(((unsigned)F.gw + (unsigned)F.NGW - gbase % (unsigned)F.NGW) % (unsigned)F.NGW);
    for (; it < nitems; it += F.NGW) {
        const int kb = it / nblk, nb = it % nblk, n0 = nb * 32, k0 = kb * 64;
        const int drow = mode == 0 ? n0 : ((n0 >> 7) * 256 + (n0 & 127) + (mode == 2 ? 128 : 0));
        xpose_item(W, N, k0, n0, WT + (size_t)drow * ldk + k0, ldk, scr, F.lane);
    }
    gbase += (unsigned)nitems;
}
__device__ __forceinline__ void cvt_rows(const Frame& F, const float* in, bf16* out, size_t n8) {
    for (size_t i = (size_t)blockIdx.x * 512 + F.tid; i < n8; i += (size_t)F.G * 512) {
        const f32x4 a = *(const f32x4*)(in + i * 8), b = *(const f32x4*)(in + i * 8 + 4);
        v4u w; w.x = pk2(a[0], a[1]); w.y = pk2(a[2], a[3]); w.z = pk2(b[0], b[1]); w.w = pk2(b[2], b[3]);
        *(v4u*)(out + i * 8) = w; }
}
__device__ __forceinline__ void cvt_router(const Frame& F, const float* rw, unsigned char* ws) {
    for (int i = blockIdx.x * 512 + F.tid; i < 2 * D * NE; i += F.G * 512) { const int l = i / (D * NE), k = (i / NE) % D, e = i % NE;
        const float w = rw[i]; const bf16 h = f2bf(w); const bf16 lo = f2bf(w - bf2f(h));
        bf16* dst = (bf16*)(ws + WS_RW + l * RW_L); dst[(size_t)e * D + k] = h; dst[(size_t)(NE + e) * D + k] = lo; }
}
struct XItem { const float* src; bf16* dst; int N, ldk; };
__device__ __forceinline__ void xp_decode(int I, const float* wg, const float* wu, const float* wd, const float* sg, const float* su, const float* sd, unsigned char* ws, XItem& x) {
    const int e = I / 1536, rem = I % 1536, m = rem >> 9, it = rem & 511;
    if (m < 2) { const float* W = m == 0 ? (e < NE ? wg + (size_t)e * D * EH : sg) : (e < NE ? wu + (size_t)e * D * EH : su);
        const int kb = it >> 4, nb = it & 15, n0 = nb * 32, k0 = kb * 64; const int drow = (n0 >> 7) * 256 + (n0 & 127) + (m == 1 ? 128 : 0);
        x.src = W + (size_t)k0 * EH + n0; x.N = EH; x.ldk = D; x.dst = (bf16*)(ws + WS_WGU + (size_t)e * WGU_E) + (size_t)drow * D + k0; }
    else { const float* W = e < NE ? wd + (size_t)e * EH * D : sd; const int kb = it >> 6, nb = it & 63, n0 = nb * 32, k0 = kb * 64;
        x.src = W + (size_t)k0 * D + n0; x.N = D; x.ldk = EH; x.dst = (bf16*)(ws + WS_WDN + (size_t)e * WDN_E) + (size_t)n0 * EH + k0; }
}
__device__ __forceinline__ void xp_load(const XItem& x, int lane, f32x4 (&v)[8]) {
    const int kk = lane >> 3, nn = (lane & 7) * 4;
#pragma unroll
    for (int i = 0; i < 8; ++i) v[i] = __builtin_nontemporal_load((const f32x4*)(x.src + (size_t)(kk + 8 * i) * x.N + nn));
}
__device__ __forceinline__ void xp_store(const XItem& x, const f32x4 (&v)[8], LAS float* scr, int lane) {
    const int kk = lane >> 3, nn = (lane & 7) * 4;
#pragma unroll
    for (int i = 0; i < 8; ++i) { LAS float* s = scr + (kk + 8 * i) * 33 + nn; s[0] = v[i][0]; s[1] = v[i][1]; s[2] = v[i][2]; s[3] = v[i][3]; }
    LDS_WAIT(); asm volatile("" ::: "memory");
    const int c = lane & 7;
#pragma unroll
    for (int j = 0; j < 4; ++j) { const int n = (lane >> 3) + 8 * j; const LAS float* s = scr + (8 * c) * 33 + n;
        v4u o; o.x = pk2(s[0 * 33], s[1 * 33]); o.y = pk2(s[2 * 33], s[3 * 33]); o.z = pk2(s[4 * 33], s[5 * 33]); o.w = pk2(s[6 * 33], s[7 * 33]);
        __builtin_nontemporal_store(o, (v4u*)(x.dst + (size_t)n * x.ldk + 8 * c)); }
    LDS_WAIT(); asm volatile("" ::: "memory");
}
__device__ __forceinline__ void cvt_experts(const Frame& F, const float* wg, const float* wu, const float* wd, const float* sg, const float* su, const float* sd, unsigned char* ws, unsigned& gbase) {
    (void)gbase;
    LAS float* scr = (LAS float*)(F.lds + RING_OFF + F.wave * 8704);
    const int total = (NE + 1) * 1536;
    XItem A, B; f32x4 va[8], vb[8];
    int I = F.gw;
    if (I < total) { xp_decode(I, wg, wu, wd, sg, su, sd, ws, A); xp_load(A, F.lane, va); }
    for (; I < total; I += 2 * F.NGW) {
        const int I2 = I + F.NGW, I3 = I + 2 * F.NGW;
        if (I2 < total) { xp_decode(I2, wg, wu, wd, sg, su, sd, ws, B); xp_load(B, F.lane, vb); }
        xp_store(A, va, scr, F.lane);
        if (I2 < total) { if (I3 < total) { xp_decode(I3, wg, wu, wd, sg, su, sd, ws, A); xp_load(A, F.lane, va); }
            xp_store(B, vb, scr, F.lane); }
    }
}
constexpr int NVO_OFF = MISC_OFF + 1024;  static_assert(NVO_OFF == pg8::PG8_NVO_OFF, "nvo");
constexpr int PLAN_OFF = NVO_OFF + 8192;
constexpr int PLAN_TB = PLAN_OFF, PLAN_CN = PLAN_OFF + 66 * 4, PLAN_TE = PLAN_OFF + 132 * 4;
constexpr int MAXTILES = 640;
#ifndef ROUTE_PROBE
#define ROUTE_PROBE 0
#endif
static_assert(PLAN_TE + MAXTILES * 4 <= LDS_BYTES, "LDS map");

__device__ __forceinline__ float wave_sum(float v, int lane) {
#pragma unroll
    for (int o = 1; o < 64; o <<= 1) v += shx(v, o, lane);
    return v;
}
__device__ __forceinline__ void moe_plan(const Frame& F, const unsigned* cnt) {
    LAS unsigned* tb = (LAS unsigned*)(F.lds + PLAN_TB); LAS unsigned* cn = (LAS unsigned*)(F.lds + PLAN_CN); LAS unsigned* te = (LAS unsigned*)(F.lds + PLAN_TE);
    __syncthreads();
    if (F.wave == 0) {
        const unsigned c = __hip_atomic_load(cnt + F.lane, RLX_AGENT); const unsigned t = (c + 255u) >> 8; unsigned inc = t;
#pragma unroll
        for (int o = 1; o < 64; o <<= 1) { const unsigned v = (unsigned)__builtin_amdgcn_ds_bpermute((F.lane - o) << 2, (int)inc); if (F.lane >= o) inc += v; }
        tb[F.lane] = inc - t; cn[F.lane] = c;
        if (F.lane == 63) { tb[NE] = inc; cn[NE] = (unsigned)NTOK; tb[NE + 1] = inc + NTOK / 256; } }
    __syncthreads();
    for (int t = F.tid; t < MAXTILES; t += NWAVES * 64) { unsigned e = 0; for (int q = 1; q <= NE; ++q) if (tb[q] <= (unsigned)t) e = q; te[t] = e; }
    __syncthreads();
}
template <bool GU> struct MoeSched { static constexpr bool GATHER = GU;
    const LAS unsigned* tb; const LAS unsigned* cn; const LAS unsigned* te; int nunits, nN, G, c; const char* Abase; const char* Bbase; const int* list;
    __device__ __forceinline__ void init(const Frame& F, const void* A_, const void* B_, const int* list_) {
        tb = (const LAS unsigned*)(F.lds + PLAN_TB); cn = (const LAS unsigned*)(F.lds + PLAN_CN); te = (const LAS unsigned*)(F.lds + PLAN_TE);
        nN = GU ? 4 : 8; nunits = (int)tb[NE + 1] * nN; G = F.G; const int bx = blockIdx.x; c = (G % 8 == 0) ? (bx % 8) * (G / 8) + bx / 8 : bx;
        Abase = (const char*)A_; Bbase = (const char*)B_; list = list_; }
    __device__ __forceinline__ bool next(int i, Unit& u) const {
        constexpr int RUN = GU ? 2 : 1; const int hs = c + G * (i / RUN), per = nN / RUN;
        const int tile = hs / per, pn = (hs % per) * RUN + (i % RUN); if (tile * nN >= nunits) return false;
        const int e = (int)te[tile];
        u.pm = tile; u.pn = pn;
        if (GU) { u.A = Abase; u.B = Bbase + (size_t)e * WGU_E + (size_t)pn * 256 * D * 2; u.list = e < NE ? list + (size_t)e * LISTCAP : nullptr; u.m0 = (tile - (int)tb[e]) * 256; u.cnt = (int)cn[e]; }
        else { u.A = Abase + (size_t)tile * 256 * EH * 2; u.B = Bbase + (size_t)e * WDN_E + (size_t)pn * 256 * EH * 2; u.list = nullptr; u.m0 = 0; u.cnt = 0; }
        return true; }
    __device__ __forceinline__ int avload(const Unit& u, int h, int R) const { const int pos = u.m0 + h * 128 + R; const int pc = pos < u.cnt ? pos : (u.cnt > 0 ? u.cnt - 1 : 0); const int* lp = u.list ? u.list : list; return lp[pc]; }
    __device__ __forceinline__ unsigned avfin(const Unit& u, int h, int R, int C, int K_, int v) const { const int pos = u.m0 + h * 128 + R; int row = u.list ? v : pos; row = pos < u.cnt ? row : 0; return (unsigned)((row * K_ + C) * 2); }
    __device__ __forceinline__ unsigned avoff(const Unit& u, int h, int R, int C, int K_) const {
        if (GU) return avfin(u, h, R, C, K_, avload(u, h, R));
        else return (unsigned)(((h * 128 + R) * K_ + C) * 2); }
};
struct EpiSwiGLU { static constexpr bool PERM = true, INPLACE = false; bf16* H;
    __device__ __forceinline__ void operator()(const Acc& acc, const Unit& u, int wr, int wc, int fr, int fq) const {
        const int row0 = u.pm * 256 + wr * 64 + fr, col0 = u.pn * 128 + wc * 32 + 8 * fq;
#pragma unroll
        for (int ai = 0; ai < 2; ++ai)
#pragma unroll
            for (int m = 0; m < 4; ++m) { bf16* rowp = H + (size_t)(row0 + ai * 128 + m * 16) * EH + col0;
                float hv[8];
#pragma unroll
                for (int n = 0; n < 2; ++n)
#pragma unroll
                    for (int j = 0; j < 4; ++j) { const float g = acc[ai][0][m][n][j], uu = acc[ai][1][m][n][j]; hv[n * 4 + j] = g * pg8::sigmoidf_(g) * uu; }
                v4u w; w.x = pk2(hv[0], hv[1]); w.y = pk2(hv[2], hv[3]); w.z = pk2(hv[4], hv[5]); w.w = pk2(hv[6], hv[7]);
                *(v4u*)rowp = w; }
    }
};

struct EpiY8 { static constexpr bool PERM = true, INPLACE = false; unsigned char* Y8; bf16* YS;
    __device__ __forceinline__ void operator()(const Acc& acc, const Unit& u, int wr, int wc, int fr, int fq) const {
        const int row0 = u.pm * 256 + wr * 64 + fr, pos0 = u.pn * 256 + wc * 64 + fq * 16;
#pragma unroll
        for (int ai = 0; ai < 2; ++ai)
#pragma unroll
            for (int m = 0; m < 4; ++m) { const size_t row = (size_t)(row0 + ai * 128 + m * 16);
                v4u w; unsigned sw = 0u;
#pragma unroll
                for (int bj = 0; bj < 2; ++bj) { const f32x4 v0 = acc[ai][bj][m][0], v1 = acc[ai][bj][m][1];
                    const float am = fmaxf(fmaxf(fmaxf(fabsf(v0[0]), fabsf(v0[1])), fmaxf(fabsf(v0[2]), fabsf(v0[3]))), fmaxf(fmaxf(fabsf(v1[0]), fabsf(v1[1])), fmaxf(fabsf(v1[2]), fabsf(v1[3]))));
                    const unsigned sb = f2bf(am * (1.f / 127.f)); const float sc = __uint_as_float(sb << 16); const float inv = sc > 0.f ? __builtin_amdgcn_rcpf(sc) : 0.f;
                    unsigned q[8];
#pragma unroll
                    for (int j = 0; j < 4; ++j) { q[j] = (unsigned)fminf(rintf(v0[j] * inv + 128.f), 255.f); q[4 + j] = (unsigned)fminf(rintf(v1[j] * inv + 128.f), 255.f); }
                    const unsigned lo = q[0] | (q[1] << 8) | (q[2] << 16) | (q[3] << 24), hi = q[4] | (q[5] << 8) | (q[6] << 16) | (q[7] << 24);
                    if (bj == 0) { w.x = lo; w.y = hi; sw = sb; } else { w.z = lo; w.w = hi; sw |= sb << 16; } }
                *(v4u*)(Y8 + row * D + pos0) = w; *(unsigned*)(YS + row * (D / 8) + (pos0 >> 3)) = sw; }
    }
};
__device__ __forceinline__ void route_phase(const Frame& F, const bf16* __restrict__ Z, const float* __restrict__ g, const float* __restrict__ bb, const bf16* __restrict__ rwh, const float* __restrict__ rb,
                                            bf16* __restrict__ X1L, bf16* __restrict__ X1BF, unsigned* cnt, int* list, int* tokslot, float* tokw, bool dispatch = true) {
    LAS float* part = (LAS float*)(F.lds + RING_OFF);
    LAS float* lg = part + 4 * 4096;
    LAS float* sl = lg + 64 * 65;
    LAS unsigned* cntL = (LAS unsigned*)(sl + 64 * 65);
    LAS unsigned* baseL = cntL + 64;
    LAS unsigned* ee = baseL + 64;
    LAS unsigned* pl = ee + 512;
    LAS float* ww = (LAS float*)(pl + 512);
    for (int grp = blockIdx.x; grp < NTOK / 64; grp += F.G) {
        const int t0 = grp * 64;
        if (F.tid < 64) cntL[F.tid] = 0u;
        {
#define RT_LN_LOAD(Z, q_) do { const v2u* zr_ = (const v2u*)(Z_ + (size_t)(t0 + F.wave * 8 + (q_)) * D) + F.lane; _Pragma("unroll") for (int j = 0; j < 8; ++j) Z[j] = zr_[64 * j]; } while (0)
#define RT_LN_DO(Z, q_) do { const int t = t0 + F.wave * 8 + (q_); f32x4 v[8]; float s = 0.f; \
            _Pragma("unroll") for (int j = 0; j < 8; ++j) { const v2u zw = Z[j]; v[j] = (f32x4){pg8::bf_lo(zw.x), pg8::bf_hi(zw.x), pg8::bf_lo(zw.y), pg8::bf_hi(zw.y)}; s += (v[j][0] + v[j][1]) + (v[j][2] + v[j][3]); } \
            const float mean = wave_sum(s, F.lane) * (1.f / D); float s2 = 0.f; \
            _Pragma("unroll") for (int j = 0; j < 8; ++j) { v[j] = v[j] - mean; s2 += (v[j][0] * v[j][0] + v[j][1] * v[j][1]) + (v[j][2] * v[j][2] + v[j][3] * v[j][3]); } \
            const float rstd = 1.f / sqrtf(wave_sum(s2, F.lane) * (1.f / D) + LN_EPS); \
            v2u* xl = (v2u*)(X1L + (size_t)t * D) + F.lane; v2u* xb = (v2u*)(X1BF + (size_t)t * D) + F.lane; \
            _Pragma("unroll") for (int j = 0; j < 8; ++j) { const f32x4 gg = ((const f32x4*)g)[F.lane + 64 * j], bv = ((const f32x4*)bb)[F.lane + 64 * j]; \
                const f32x4 y = v[j] * rstd * gg + bv; v2u w; w.x = pk2(y[0], y[1]); w.y = pk2(y[2], y[3]); xb[64 * j] = w; \
                v2u lo; lo.x = pk2(y[0] - pg8::bf_lo(w.x), y[1] - pg8::bf_hi(w.x)); lo.y = pk2(y[2] - pg8::bf_lo(w.y), y[3] - pg8::bf_hi(w.y)); xl[64 * j] = lo; } } while (0)
            const bf16* Z_ = Z; v2u zA[8], zB[8];
            RT_LN_LOAD(zA, 0);
#pragma unroll 1
            for (int q = 0; q < 8; q += 2) {
                RT_LN_LOAD(zB, q + 1); __builtin_amdgcn_sched_barrier(0);
                RT_LN_DO(zA, q); __builtin_amdgcn_sched_barrier(0);
                if (q + 2 < 8) RT_LN_LOAD(zA, q + 2);
                __builtin_amdgcn_sched_barrier(0);
                RT_LN_DO(zB, q + 1); __builtin_amdgcn_sched_barrier(0);
            }
#undef RT_LN_LOAD
#undef RT_LN_DO
        }
        VM_WAIT(); __syncthreads();
        for (int rp_ = 0; rp_ < (ROUTE_PROBE == 2 ? 2 : 1); ++rp_)
        { const int r = F.lane & 15, kq = F.lane >> 4, kb = (F.wave & 3) * 512, th = F.wave >> 2;
          const bf16* xh = X1BF + (size_t)(t0 + th * 32 + r) * D + kb + 8 * kq;
          const bf16* xl = X1L + (size_t)(t0 + th * 32 + r) * D + kb + 8 * kq;
          const bf16* wh = rwh + (size_t)r * D + kb + 8 * kq;
          f32x4 acc[2][4];
#pragma unroll
          for (int tt = 0; tt < 2; ++tt)
#pragma unroll
              for (int nb = 0; nb < 4; ++nb) acc[tt][nb] = (f32x4){0.f, 0.f, 0.f, 0.f};
          bf16x8 xA[2][2], xB[2][2]; bf16x8 hA[4], lA[4], hB[4], lB[4];
#define RT_LOAD(X, H, L, ks) do { const int k_ = ((ks) < 16 ? (ks) : 15) * 32; _Pragma("unroll") for (int tt = 0; tt < 2; ++tt) { X[tt][0] = *(const bf16x8*)(xh + (size_t)tt * 16 * D + k_); X[tt][1] = *(const bf16x8*)(xl + (size_t)tt * 16 * D + k_); } \
              _Pragma("unroll") for (int nb = 0; nb < 4; ++nb) { H[nb] = *(const bf16x8*)(wh + (size_t)nb * 16 * D + k_); L[nb] = *(const bf16x8*)(wh + (size_t)(64 + nb * 16) * D + k_); } } while (0)
#define RT_MMA(X, H, L) do { \
              _Pragma("unroll") for (int tt = 0; tt < 2; ++tt) _Pragma("unroll") for (int nb = 0; nb < 4; ++nb) acc[tt][nb] = __builtin_amdgcn_mfma_f32_16x16x32_bf16(X[tt][1], H[nb], acc[tt][nb], 0, 0, 0); \
              _Pragma("unroll") for (int tt = 0; tt < 2; ++tt) _Pragma("unroll") for (int nb = 0; nb < 4; ++nb) acc[tt][nb] = __builtin_amdgcn_mfma_f32_16x16x32_bf16(X[tt][0], L[nb], acc[tt][nb], 0, 0, 0); \
              _Pragma("unroll") for (int tt = 0; tt < 2; ++tt) _Pragma("unroll") for (int nb = 0; nb < 4; ++nb) acc[tt][nb] = __builtin_amdgcn_mfma_f32_16x16x32_bf16(X[tt][0], H[nb], acc[tt][nb], 0, 0, 0); } while (0)
          RT_LOAD(xA, hA, lA, 0);
#pragma unroll 1
          for (int ks = 0; ks < 16; ks += 2) {
              RT_LOAD(xB, hB, lB, ks + 1); RT_MMA(xA, hA, lA);
              RT_LOAD(xA, hA, lA, ks + 2); RT_MMA(xB, hB, lB);
          }
#undef RT_LOAD
#undef RT_MMA
#pragma unroll
          for (int tt = 0; tt < 2; ++tt)
#pragma unroll
              for (int nb = 0; nb < 4; ++nb)
#pragma unroll
                  for (int reg = 0; reg < 4; ++reg) part[(F.wave & 3) * 4096 + (th * 32 + tt * 16 + 4 * kq + reg) * 64 + nb * 16 + r] = acc[tt][nb][reg];
        }
        __syncthreads();
        for (int i = F.tid; i < 64 * 64; i += NWAVES * 64) { const int tk = i >> 6, e = i & 63; const float lgt = (part[i] + part[4096 + i]) + (part[8192 + i] + part[12288 + i]);
            const float sc = 1.f / (1.f + __expf(-lgt)); lg[tk * 65 + e] = sc; sl[tk * 65 + e] = sc + rb[e]; }
        __syncthreads();
        for (int rp_ = 0; rp_ < (ROUTE_PROBE == 3 ? 2 : 1); ++rp_)
        { const bool lastrp = (rp_ == (ROUTE_PROBE == 3 ? 1 : 0));
          const int tk = F.wave * 8 + (F.lane >> 3), gq = F.lane & 7, lane = F.lane;
          float sv[8], cv[8];
#pragma unroll
          for (int j = 0; j < 8; ++j) { sv[j] = sl[tk * 65 + gq * 8 + j]; cv[j] = lg[tk * 65 + gq * 8 + j]; }
          float m1 = -INFINITY, m2 = -INFINITY;
#pragma unroll
          for (int j = 0; j < 8; ++j) { const float x = sv[j]; const bool g1 = x > m1; m2 = g1 ? m1 : fmaxf(m2, x); m1 = g1 ? x : m1; }
          const float gs = m1 + m2;
          int rank = 0;
#pragma unroll
          for (int o = 1; o < 8; ++o) { const float og = shx(gs, o, lane); const int oq = gq ^ o; rank += (og > gs || (og == gs && oq < gq)) ? 1 : 0; }
          const bool gsel = rank < 4;
          unsigned used = gsel ? 0u : 0xffu;
          float wsum = 0.f; float my_sc = 0.f; int my_e = 0;
#pragma unroll
          for (int i = 0; i < 8; ++i) {
              float bv = -INFINITY, bs = 0.f; int be = 64;
#pragma unroll
              for (int j = 0; j < 8; ++j) { const bool ok = !((used >> j) & 1u) && sv[j] > bv; bv = ok ? sv[j] : bv; bs = ok ? cv[j] : bs; be = ok ? gq * 8 + j : be; }
#pragma unroll
              for (int o = 1; o < 8; o <<= 1) { const float ov = shx(bv, o, lane), os = shx(bs, o, lane); const int oe = __float_as_int(shx(__int_as_float(be), o, lane));
                  const bool tk_o = ov > bv || (ov == bv && oe < be); bv = tk_o ? ov : bv; bs = tk_o ? os : bs; be = tk_o ? oe : be; }
              if ((be >> 3) == gq) used |= 1u << (be & 7);
              wsum += bs; if (gq == i) { my_sc = bs; my_e = be; }
          }
          const int slot = tk * 8 + gq;
          ee[slot] = (unsigned)my_e; ww[slot] = my_sc * (RSCALE / wsum);
          pl[slot] = __hip_atomic_fetch_add(cntL + my_e, (dispatch && lastrp) ? 1u : 0u, __ATOMIC_RELAXED, __HIP_MEMORY_SCOPE_WORKGROUP);
        }
        __syncthreads();
        if (F.tid < 64) { const unsigned n = cntL[F.tid]; baseL[F.tid] = n ? __hip_atomic_fetch_add(cnt + F.tid, n, RLX_AGENT) : 0u; }
        __syncthreads();
        if (dispatch) { const int tk = F.tid >> 3, i = F.tid & 7; const unsigned e = ee[F.tid]; const unsigned pos = baseL[e] + pl[F.tid]; const int t = t0 + tk;
          list[(size_t)e * LISTCAP + pos] = t; tokslot[t * 8 + i] = (int)(e * LISTCAP + pos); tokw[t * 8 + i] = ww[F.tid]; }
        __syncthreads();
    }
}
__device__ __forceinline__ void combine_phase(const Frame& F, const bf16* X1B, const unsigned char* Y8, const bf16* YS, const int* tokslot, const float* tokw, const float* g, const float* bb, float* OUT, bf16* XBF, bool last) {
    const LAS unsigned* tb = (const LAS unsigned*)(F.lds + PLAN_TB);
    LAS int* rw = (LAS int*)(F.lds + RING_OFF) + F.wave * 32;
#define CB_LOAD(W, S, ROW) do { const int r_ = __builtin_amdgcn_readfirstlane(ROW); const v2u* yr_ = (const v2u*)(Y8 + (size_t)r_ * D) + F.lane; const bf16* ys_ = YS + (size_t)r_ * (D / 8) + F.lane; \
        _Pragma("unroll") for (int j = 0; j < 4; ++j) { W[j] = yr_[64 * j]; S[j] = ys_[64 * j]; } } while (0)
#define CB_ACC(W, S, WT) do { const float wt_ = __int_as_float(__builtin_amdgcn_readfirstlane(WT)); _Pragma("unroll") for (int j = 0; j < 4; ++j) { const float sc = bf2f(S[j]) * wt_, c0 = -128.f * sc; const unsigned x = W[j].x, y = W[j].y; \
        v[j][0] += sc * (float)(x & 255u) + c0; v[j][1] += sc * (float)((x >> 8) & 255u) + c0; v[j][2] += sc * (float)((x >> 16) & 255u) + c0; v[j][3] += sc * (float)(x >> 24) + c0; \
        v[j][4] += sc * (float)(y & 255u) + c0; v[j][5] += sc * (float)((y >> 8) & 255u) + c0; v[j][6] += sc * (float)((y >> 16) & 255u) + c0; v[j][7] += sc * (float)(y >> 24) + c0; } } while (0)
    const int cl = (F.lane >> 5) * 256 + (F.lane & 1) * 128 + ((F.lane >> 3) & 3) * 32 + ((F.lane >> 1) & 3) * 8;
    f32x4 gq[4][2], bq[4][2];
#pragma unroll
    for (int j = 0; j < 4; ++j) { const int c0 = cl + 512 * j; gq[j][0] = *(const f32x4*)(g + c0); gq[j][1] = *(const f32x4*)(g + c0 + 4); bq[j][0] = *(const f32x4*)(bb + c0); bq[j][1] = *(const f32x4*)(bb + c0 + 4); }
    int nsl = 0; float nwt = 0.f;
    if (F.gw < NTOK && F.lane < 8) { nsl = tokslot[F.gw * 8 + F.lane]; nwt = tokw[F.gw * 8 + F.lane]; }
    for (int t = F.gw; t < NTOK; t += F.NGW) {
        v4u xw[4];
#pragma unroll
        for (int j = 0; j < 4; ++j) xw[j] = *(const v4u*)(X1B + (size_t)t * D + 512 * j + cl);
        if (F.lane < 8) { const int sl = nsl; rw[F.lane] = (int)tb[sl / LISTCAP] * 256 + (sl % LISTCAP); rw[16 + F.lane] = __float_as_int(nwt); }
        if (F.lane == 8) { rw[8] = (int)tb[NE] * 256 + t; rw[24] = __float_as_int(1.f); }
        LDS_WAIT(); asm volatile("" ::: "memory");
        float v[4][8]; float s = 0.f;
        v2u wa[4], wb[4], wc[4]; bf16 sa[4], sb2[4], sc2[4];
        CB_LOAD(wa, sa, rw[0]); CB_LOAD(wb, sb2, rw[1]); CB_LOAD(wc, sc2, rw[2]);
        { const int tn = t + F.NGW; if (tn < NTOK && F.lane < 8) { nsl = tokslot[tn * 8 + F.lane]; nwt = tokw[tn * 8 + F.lane]; } }
        __builtin_amdgcn_sched_barrier(0);
#pragma unroll
        for (int j = 0; j < 4; ++j) {
            v[j][0] = pg8::bf_lo(xw[j].x) * ALPHA; v[j][1] = pg8::bf_hi(xw[j].x) * ALPHA; v[j][2] = pg8::bf_lo(xw[j].y) * ALPHA; v[j][3] = pg8::bf_hi(xw[j].y) * ALPHA;
            v[j][4] = pg8::bf_lo(xw[j].z) * ALPHA; v[j][5] = pg8::bf_hi(xw[j].z) * ALPHA; v[j][6] = pg8::bf_lo(xw[j].w) * ALPHA; v[j][7] = pg8::bf_hi(xw[j].w) * ALPHA; }
#pragma unroll 1
        for (int i = 0; i < 9; i += 3) {
            CB_ACC(wa, sa, rw[16 + i]); if (i < 6) CB_LOAD(wa, sa, rw[i + 3]);
            CB_ACC(wb, sb2, rw[17 + i]); if (i < 6) CB_LOAD(wb, sb2, rw[i + 4]);
            CB_ACC(wc, sc2, rw[18 + i]); if (i < 6) CB_LOAD(wc, sc2, rw[i + 5]);
        }
        asm volatile("" ::: "memory");
#pragma unroll
        for (int j = 0; j < 4; ++j)
#pragma unroll
            for (int e = 0; e < 8; ++e) s += v[j][e];
        const float mean = wave_sum(s, F.lane) * (1.f / D); float s2 = 0.f;
#pragma unroll
        for (int j = 0; j < 4; ++j)
#pragma unroll
            for (int e = 0; e < 8; ++e) { v[j][e] -= mean; s2 += v[j][e] * v[j][e]; }
        const float rstd = 1.f / sqrtf(wave_sum(s2, F.lane) * (1.f / D) + LN_EPS);
#pragma unroll
        for (int j = 0; j < 4; ++j) { const int c0 = cl + 512 * j; const f32x4 g0 = gq[j][0], g1 = gq[j][1], b0 = bq[j][0], b1 = bq[j][1];
            f32x4 y0, y1;
#pragma unroll
            for (int e = 0; e < 4; ++e) { y0[e] = v[j][e] * rstd * g0[e] + b0[e]; y1[e] = v[j][4 + e] * rstd * g1[e] + b1[e]; }
            if (last) { *(f32x4*)(OUT + (size_t)t * D + c0) = y0; *(f32x4*)(OUT + (size_t)t * D + c0 + 4) = y1; }
            else { v4u w; w.x = pk2(y0[0], y0[1]); w.y = pk2(y0[2], y0[3]); w.z = pk2(y1[0], y1[1]); w.w = pk2(y1[2], y1[3]); *(v4u*)(XBF + (size_t)t * D + c0) = w; } }
    }
#undef CB_LOAD
#undef CB_ACC
}
constexpr size_t R2_UT = 0, R2_OI = 48 * MiB, R2_QP = 96 * MiB, R2_DEC = 120 * MiB;
constexpr int NHU = NB * HGH * (SEQ / 64);
typedef __attribute__((address_space(3))) bf16 lbf16;
__device__ __forceinline__ void unpack8(const v4u w, float (&f)[8]) {
    f[0] = pg8::bf_lo(w.x); f[1] = pg8::bf_hi(w.x); f[2] = pg8::bf_lo(w.y); f[3] = pg8::bf_hi(w.y); f[4] = pg8::bf_lo(w.z); f[5] = pg8::bf_hi(w.z); f[6] = pg8::bf_lo(w.w); f[7] = pg8::bf_hi(w.w); }
__device__ __forceinline__ float exp_c(float x) { return __expf(fminf(x, 80.f)); }

__device__ __forceinline__ void conv_part(const Frame& F, const bf16* proj, const float* cw, bf16* YA, bf16* YX) {
    for (int i = blockIdx.x * 512 + F.tid; i < NTOK * 32; i += F.G * 512) *(v4u*)(YX + (size_t)(i >> 5) * YXW + XAW + (i & 31) * 8) = (v4u){0u, 0u, 0u, 0u};
    for (int i = blockIdx.x * 512 + F.tid; i < NTOK * (CW / 8); i += F.G * 512) {
        const int t = i / (CW / 8), c = (i % (CW / 8)) * 8, pos = t & (SEQ - 1);
        const bf16* r = proj + (size_t)t * INC;
        float u0[8], c0[8], b0[8], u1[8], c1[8], u2[8], c2[8], w0[8], w1[8], w2[8];
        unpack8(*(const v4u*)(r + C_U + c), u0); unpack8(*(const v4u*)(r + C_C + c), c0); unpack8(*(const v4u*)(r + C_B + c), b0);
        const v4u z4 = {0u, 0u, 0u, 0u};
        unpack8(pos >= 1 ? *(const v4u*)(r - INC + C_U + c) : z4, u1); unpack8(pos >= 1 ? *(const v4u*)(r - INC + C_C + c) : z4, c1);
        unpack8(pos >= 2 ? *(const v4u*)(r - 2 * INC + C_U + c) : z4, u2); unpack8(pos >= 2 ? *(const v4u*)(r - 2 * INC + C_C + c) : z4, c2);
#pragma unroll
        for (int j = 0; j < 8; ++j) { w0[j] = cw[c + j]; w1[j] = cw[CW + c + j]; w2[j] = cw[2 * CW + c + j]; }
        float o[8];
#pragma unroll
        for (int j = 0; j < 8; ++j) o[j] = b0[j] * (w2[j] * c0[j] * u0[j] + w1[j] * c1[j] * u1[j] + w0[j] * c2[j] * u2[j]);
        v4u w; w.x = pk2(o[0], o[1]); w.y = pk2(o[2], o[3]); w.z = pk2(o[4], o[5]); w.w = pk2(o[6], o[7]);
        *(v4u*)(YA + (size_t)t * CW + c) = w;
    }
}

__device__ __forceinline__ void hgrn_local(const Frame& F, const bf16* proj, const float* lbl, int layer, unsigned char* r2) {
    lbf16* QS = (lbf16*)(F.lds);
    lbf16* KS = QS + 64 * 136;
    lbf16* KPT = KS + 64 * 136;
    lbf16* VT = KPT + 128 * 72;
    lbf16* PS = VT + 128 * 72;
    LAS float* SEG = (LAS float*)(PS + 64 * 72);
    bf16* UT = (bf16*)(r2 + R2_UT); bf16* OI = (bf16*)(r2 + R2_OI); bf16* QP = (bf16*)(r2 + R2_QP); float* DEC = (float*)(r2 + R2_DEC);
    const int lane = F.lane, wv = F.wave, r = lane & 15, kq = lane >> 4;
    bf16 rf[16], rq[16], rv[16];
#define HL_LOAD(U) do { const int b_ = (U) / (HGH * 64), h_ = ((U) / 64) % HGH, c_ = (U) % 64; const bf16* p_ = proj + (size_t)(b_ * SEQ + c_ * 64 + (F.tid >> 7) * 16) * INC + h_ * HGD + (F.tid & 127); \
        _Pragma("unroll") for (int i = 0; i < 16; ++i) { rf[i] = p_[(size_t)i * INC + C_F]; rq[i] = p_[(size_t)i * INC + C_Q]; rv[i] = p_[(size_t)i * INC + C_I]; } } while (0)
    if ((int)blockIdx.x < NHU) HL_LOAD((int)blockIdx.x);
    for (int unit = blockIdx.x; unit < NHU; unit += F.G) {
        const int b = unit / (HGH * 64), h = (unit / 64) % HGH, c = unit % 64, t0 = b * SEQ + c * 64;
        { const int col = F.tid & 127, seg = F.tid >> 7, ch = h * HGD + col;
          float lb = 0.f; if (layer == 1) lb = 1.f / (1.f + __expf(lbl[ch] - lbl[HGW + ch]));
          float a[16], kk[16], qv[16], vv[16]; float run = 0.f;
#pragma unroll
          for (int i = 0; i < 16; ++i) {
              const float z = bf2f(rf[i]); const float ez = __expf(-z); const float sg = 1.f / (1.f + ez);
              const float f = lb + (1.f - lb) * sg; kk[i] = (1.f - lb) * ez * sg; run += fmaxf(__logf(f), -60.f); a[i] = run;
              qv[i] = bf2f(rq[i]); vv[i] = bf2f(rv[i]); }
          if (unit + F.G < NHU) HL_LOAD(unit + F.G);
          SEG[seg * 128 + col] = run;
          __syncthreads();
          const float s0 = SEG[col], s1 = SEG[128 + col], s2 = SEG[256 + col], s3 = SEG[384 + col];
          const float base = seg == 0 ? 0.f : (seg == 1 ? s0 : (seg == 2 ? s0 + s1 : s0 + s1 + s2)), bm = s0 + s1, bl = (s0 + s1) + (s2 + s3);
          float kp[16];
#pragma unroll
          for (int i = 0; i < 16; ++i) { const float bb = base + a[i]; const int t = seg * 16 + i;
              QS[t * 136 + col] = f2bf(qv[i] * exp_c(bb - bm)); KS[t * 136 + col] = f2bf(kk[i] * exp_c(bm - bb)); kp[i] = kk[i] * exp_c(bl - bb);
              QP[(size_t)(t0 + t) * HGW + ch] = f2bf(qv[i] * exp_c(bb)); }
          v4u w0, w1; w0.x = pk2(kp[0], kp[1]); w0.y = pk2(kp[2], kp[3]); w0.z = pk2(kp[4], kp[5]); w0.w = pk2(kp[6], kp[7]); w1.x = pk2(kp[8], kp[9]); w1.y = pk2(kp[10], kp[11]); w1.z = pk2(kp[12], kp[13]); w1.w = pk2(kp[14], kp[15]);
          *(LAS v4u*)(KPT + col * 72 + seg * 16) = w0; *(LAS v4u*)(KPT + col * 72 + seg * 16 + 8) = w1;
          w0.x = pk2(vv[0], vv[1]); w0.y = pk2(vv[2], vv[3]); w0.z = pk2(vv[4], vv[5]); w0.w = pk2(vv[6], vv[7]); w1.x = pk2(vv[8], vv[9]); w1.y = pk2(vv[10], vv[11]); w1.z = pk2(vv[12], vv[13]); w1.w = pk2(vv[14], vv[15]);
          *(LAS v4u*)(VT + col * 72 + seg * 16) = w0; *(LAS v4u*)(VT + col * 72 + seg * 16 + 8) = w1;
          if (seg == 0) DEC[(size_t)unit * 128 + col] = exp_c(bl);
        }
        __syncthreads();
        { const int tm = wv >> 1, tn0 = (wv & 1) * 2;
          bf16x8 af[4];
#pragma unroll
          for (int ks = 0; ks < 4; ++ks) af[ks] = *(const LAS bf16x8*)(QS + (tm * 16 + r) * 136 + ks * 32 + kq * 8);
#pragma unroll
          for (int jn = 0; jn < 2; ++jn) { const int tn = tn0 + jn; f32x4 acc = {0.f, 0.f, 0.f, 0.f};
              if (tn <= tm) {
#pragma unroll
                  for (int ks = 0; ks < 4; ++ks) { const bf16x8 bf = *(const LAS bf16x8*)(KS + (tn * 16 + r) * 136 + ks * 32 + kq * 8); acc = __builtin_amdgcn_mfma_f32_16x16x32_bf16(af[ks], bf, acc, 0, 0, 0); } }
#pragma unroll
              for (int g = 0; g < 4; ++g) { const int t = tm * 16 + 4 * kq + g, s = tn * 16 + r; PS[t * 72 + s] = f2bf(s <= t ? acc[g] : 0.f); } } }
        { bf16x8 af[2];
#pragma unroll
          for (int ks = 0; ks < 2; ++ks) af[ks] = *(const LAS bf16x8*)(KPT + (wv * 16 + r) * 72 + ks * 32 + kq * 8);
#pragma unroll
          for (int tv = 0; tv < 8; ++tv) { f32x4 acc = {0.f, 0.f, 0.f, 0.f};
#pragma unroll
              for (int ks = 0; ks < 2; ++ks) { const bf16x8 bf = *(const LAS bf16x8*)(VT + (tv * 16 + r) * 72 + ks * 32 + kq * 8); acc = __builtin_amdgcn_mfma_f32_16x16x32_bf16(af[ks], bf, acc, 0, 0, 0); }
              v2u w; w.x = pk2(acc[0], acc[1]); w.y = pk2(acc[2], acc[3]);
              *(v2u*)(UT + (size_t)unit * 16384 + (tv * 16 + r) * 128 + wv * 16 + 4 * kq) = w; } }
        __syncthreads();
        { const int tm = wv & 3, tvg = wv >> 2;
          bf16x8 pf[2];
#pragma unroll
          for (int ks = 0; ks < 2; ++ks) pf[ks] = *(const LAS bf16x8*)(PS + (tm * 16 + r) * 72 + ks * 32 + kq * 8);
#pragma unroll
          for (int j = 0; j < 4; ++j) { const int tv = tvg * 4 + j; f32x4 acc = {0.f, 0.f, 0.f, 0.f};
#pragma unroll
              for (int ks = 0; ks < 2; ++ks) { const bf16x8 vf = *(const LAS bf16x8*)(VT + (tv * 16 + r) * 72 + ks * 32 + kq * 8); acc = __builtin_amdgcn_mfma_f32_16x16x32_bf16(vf, pf[ks], acc, 0, 0, 0); }
              v2u ow; ow.x = pk2(acc[0], acc[1]); ow.y = pk2(acc[2], acc[3]); *(v2u*)(OI + (size_t)(t0 + tm * 16 + r) * HGW + h * HGD + tv * 16 + 4 * kq) = ow; } }
        __syncthreads();
    }
#undef HL_LOAD
}
__device__ __forceinline__ void hgrn_scan(const Frame& F, const unsigned char* r2, v2u* __restrict__ SB64) {
    const v2u* __restrict__ UT64 = (const v2u*)(r2 + R2_UT); const f32x4* __restrict__ DEC4 = (const f32x4*)(r2 + R2_DEC);
    for (int it = blockIdx.x * 512 + F.tid; it < NB * HGH * 128 * 32; it += F.G * 512) {
        const int bh = it >> 12, v = (it >> 5) & 127, k4 = it & 31;
        f32x4 s = {0.f, 0.f, 0.f, 0.f};
#pragma unroll 16
        for (int c = 0; c < 64; ++c) { const size_t unit = (size_t)bh * 64 + c; const size_t idx = unit * 4096 + v * 32 + k4;
            const v2u w = UT64[idx]; const f32x4 d = DEC4[unit * 32 + k4];
            v2u o; o.x = pk2(s[0], s[1]); o.y = pk2(s[2], s[3]); SB64[idx] = o;
            s[0] = d[0] * s[0] + pg8::bf_lo(w.x); s[1] = d[1] * s[1] + pg8::bf_hi(w.x); s[2] = d[2] * s[2] + pg8::bf_lo(w.y); s[3] = d[3] * s[3] + pg8::bf_hi(w.y); }
    }
}
struct HoutOps { bf16x8 af[4]; bf16x8 bfr[4][4]; };
__device__ __forceinline__ void hout_load(HoutOps& O, int unit, const bf16* proj, const bf16* OI, const bf16* QP, const bf16* SB, int r, int kq, int tm, int tvg) {
    const int b = unit / (HGH * 64), h = (unit / 64) % HGH, c = unit % 64, t0 = b * SEQ + c * 64;
#pragma unroll
    for (int ks = 0; ks < 4; ++ks) O.af[ks] = *(const bf16x8*)(QP + (size_t)(t0 + tm * 16 + r) * HGW + h * HGD + ks * 32 + kq * 8);
#pragma unroll
    for (int j = 0; j < 4; ++j)
#pragma unroll
        for (int ks = 0; ks < 4; ++ks) O.bfr[j][ks] = *(const bf16x8*)(SB + (size_t)unit * 16384 + ((tvg * 4 + j) * 16 + r) * 128 + ks * 32 + kq * 8);
}
__device__ __forceinline__ void hout_compute(const HoutOps& O, int unit, const bf16* proj, const bf16* OI, LAS float* SSQ, const float* gain, bf16* YB, int lane, int r, int kq, int tm, int tvg) {
    const int b = unit / (HGH * 64), h = (unit / 64) % HGH, c = unit % 64, t0 = b * SEQ + c * 64;
    const size_t t = (size_t)(t0 + tm * 16 + r);
    f32x4 oi[4]; v2u gtw[4];
#pragma unroll
    for (int j = 0; j < 4; ++j) { const int ch = h * HGD + (tvg * 4 + j) * 16 + 4 * kq; { const v2u ow = *(const v2u*)(OI + t * HGW + ch); oi[j] = (f32x4){pg8::bf_lo(ow.x), pg8::bf_hi(ow.x), pg8::bf_lo(ow.y), pg8::bf_hi(ow.y)}; } gtw[j] = *(const v2u*)(proj + t * INC + C_G + ch); }
    f32x4 acc[4]; float q = 0.f;
#pragma unroll
    for (int j = 0; j < 4; ++j) { acc[j] = (f32x4){0.f, 0.f, 0.f, 0.f};
#pragma unroll
        for (int ks = 0; ks < 4; ++ks) acc[j] = __builtin_amdgcn_mfma_f32_16x16x32_bf16(O.bfr[j][ks], O.af[ks], acc[j], 0, 0, 0); }
#pragma unroll
    for (int j = 0; j < 4; ++j) { acc[j] += oi[j]; q += (acc[j][0] * acc[j][0] + acc[j][1] * acc[j][1]) + (acc[j][2] * acc[j][2] + acc[j][3] * acc[j][3]); }
    q += shx(q, 16, lane); q += shx(q, 32, lane);
    if (kq == 0) SSQ[tvg * 64 + tm * 16 + r] = q;
    __syncthreads();
    const float rs = rsqrtf((SSQ[tm * 16 + r] + SSQ[64 + tm * 16 + r]) * (1.f / 128.f) + RMS_EPS);
#pragma unroll
    for (int j = 0; j < 4; ++j) { const int ch = h * HGD + (tvg * 4 + j) * 16 + 4 * kq; const f32x4 gn = *(const f32x4*)(gain + ch);
        const float g0 = pg8::bf_lo(gtw[j].x), g1 = pg8::bf_hi(gtw[j].x), g2 = pg8::bf_lo(gtw[j].y), g3 = pg8::bf_hi(gtw[j].y);
        v2u w; w.x = pk2(acc[j][0] * rs * gn[0] * g0 * pg8::sigmoidf_(g0), acc[j][1] * rs * gn[1] * g1 * pg8::sigmoidf_(g1));
        w.y = pk2(acc[j][2] * rs * gn[2] * g2 * pg8::sigmoidf_(g2), acc[j][3] * rs * gn[3] * g3 * pg8::sigmoidf_(g3));
        *(v2u*)(YB + t * HGW + ch) = w; }
    __syncthreads();
}
__device__ __forceinline__ void hgrn_out(const Frame& F, const bf16* proj, const unsigned char* r2, const bf16* SB, const float* gain, bf16* YB) {
    LAS float* SSQ = (LAS float*)F.lds;
    const bf16* OI = (const bf16*)(r2 + R2_OI); const bf16* QP = (const bf16*)(r2 + R2_QP);
    const int lane = F.lane, wv = F.wave, r = lane & 15, kq = lane >> 4, tm = wv & 3, tvg = wv >> 2;
    HoutOps A, B;
    int unit = blockIdx.x;
    if (unit < NHU) hout_load(A, unit, proj, OI, QP, SB, r, kq, tm, tvg);
    for (; unit < NHU; unit += 2 * F.G) {
        const int u2 = unit + F.G, u3 = unit + 2 * F.G;
        if (u2 < NHU) hout_load(B, u2, proj, OI, QP, SB, r, kq, tm, tvg);
        hout_compute(A, unit, proj, OI, SSQ, gain, YB, lane, r, kq, tm, tvg);
        if (u2 < NHU) { if (u3 < NHU) hout_load(A, u3, proj, OI, QP, SB, r, kq, tm, tvg);
            hout_compute(B, u2, proj, OI, SSQ, gain, YB, lane, r, kq, tm, tvg); }
    }
}
__device__ __forceinline__ void memattn(const Frame& F, const bf16* proj, const bf16* KV, int layer, bf16* YX) {
    lbf16* Ks = (lbf16*)F.lds;
    lbf16* VTs = Ks + 256 * 136;
    const int lane = F.lane, wv = F.wave, r = lane & 15, kq = lane >> 4;
    for (int unit = blockIdx.x; unit < NB * XAH * (SEQ / 256); unit += F.G) {
        const int b = unit >> 6, hd = (unit >> 4) & 3, qt = unit & 15;
        {
            v4u kw[8], vw[8];
#pragma unroll
            for (int i = 0; i < 8; ++i) { const int p = F.tid + 512 * i, key = p >> 4, dc = (p & 15) * 8;
                const bf16* src = KV + (size_t)(b * NMEM + key) * 2048 + layer * 1024 + hd * XAD + dc;
                kw[i] = *(const v4u*)src; vw[i] = *(const v4u*)(src + 512); }
            __builtin_amdgcn_sched_barrier(0);
#pragma unroll
            for (int i = 0; i < 8; ++i) { const int p = F.tid + 512 * i, key = p >> 4, dc = (p & 15) * 8;
                *(LAS v4u*)(Ks + key * 136 + dc) = kw[i];
                const v4u w = vw[i];
                const int k5 = key & 31, pos = (key & ~31) + 8 * ((k5 >> 2) & 3) + 4 * ((k5 >> 4) & 1) + (k5 & 3);
                lbf16* d = VTs + dc * 264 + pos;
                d[0] = (bf16)(w.x & 0xffffu); d[264] = (bf16)(w.x >> 16); d[2 * 264] = (bf16)(w.y & 0xffffu); d[3 * 264] = (bf16)(w.y >> 16);
                d[4 * 264] = (bf16)(w.z & 0xffffu); d[5 * 264] = (bf16)(w.z >> 16); d[6 * 264] = (bf16)(w.w & 0xffffu); d[7 * 264] = (bf16)(w.w >> 16); }
        }
        __syncthreads();
#pragma unroll 1
        for (int g = 0; g < 2; ++g) {
            const int t = b * SEQ + qt * 256 + wv * 32 + g * 16 + r;
            bf16x8 qf[4];
#pragma unroll
            for (int ks = 0; ks < 4; ++ks) qf[ks] = *(const bf16x8*)(proj + (size_t)t * INC + C_QX + hd * XAD + ks * 32 + kq * 8);
            f32x4 s[16];
#pragma unroll
            for (int kt = 0; kt < 16; ++kt) { s[kt] = (f32x4){0.f, 0.f, 0.f, 0.f};
#pragma unroll
                for (int ks = 0; ks < 4; ++ks) { const bf16x8 a = *(const LAS bf16x8*)(Ks + (kt * 16 + r) * 136 + ks * 32 + kq * 8); s[kt] = __builtin_amdgcn_mfma_f32_16x16x32_bf16(a, qf[ks], s[kt], 0, 0, 0); }
                if (kt & 1) __builtin_amdgcn_sched_barrier(0); }
            float m = -1e30f;
#pragma unroll
            for (int kt = 0; kt < 16; ++kt) m = fmaxf(m, fmaxf(fmaxf(s[kt][0], s[kt][1]), fmaxf(s[kt][2], s[kt][3])));
            m = fmaxf(m, shx(m, 16, lane)); m = fmaxf(m, shx(m, 32, lane));
            const float cs = 0.08838834764831845f * 1.4426950408889634f; float l = 0.f;
#pragma unroll
            for (int kt = 0; kt < 16; ++kt)
#pragma unroll
                for (int e = 0; e < 4; ++e) { const float p = __builtin_amdgcn_exp2f((s[kt][e] - m) * cs); s[kt][e] = p; l += p; }
            l += shx(l, 16, lane); l += shx(l, 32, lane);
            f32x4 o[8];
#pragma unroll
            for (int dt = 0; dt < 8; ++dt) o[dt] = (f32x4){0.f, 0.f, 0.f, 0.f};
#pragma unroll
            for (int j = 0; j < 8; ++j) {
                v4u pw; pw.x = pk2(s[2 * j][0], s[2 * j][1]); pw.y = pk2(s[2 * j][2], s[2 * j][3]); pw.z = pk2(s[2 * j + 1][0], s[2 * j + 1][1]); pw.w = pk2(s[2 * j + 1][2], s[2 * j + 1][3]);
                const bf16x8 pf = __builtin_bit_cast(bf16x8, pw);
#pragma unroll
                for (int dt = 0; dt < 8; ++dt) { const bf16x8 a = *(const LAS bf16x8*)(VTs + (dt * 16 + r) * 264 + j * 32 + kq * 8); o[dt] = __builtin_amdgcn_mfma_f32_16x16x32_bf16(a, pf, o[dt], 0, 0, 0); }
                __builtin_amdgcn_sched_barrier(0); }
            const float inv = 1.f / l;
#pragma unroll
            for (int dt = 0; dt < 8; ++dt) { v2u w; w.x = pk2(o[dt][0] * inv, o[dt][1] * inv); w.y = pk2(o[dt][2] * inv, o[dt][3] * inv);
                *(v2u*)(YX + (size_t)t * YXW + hd * XAD + dt * 16 + 4 * kq) = w; }
        }
        __syncthreads();
    }
}
struct Args { const float* in[24]; float* out; unsigned char* ws; int ph_lo, ph_hi, mask, pad; };
typedef const __attribute__((address_space(4))) Args* KArgs;
__device__ __forceinline__ KArgs kargs() { KArgs p = (KArgs)__builtin_amdgcn_kernarg_segment_ptr(); asm volatile("" : "+s"(p)); return p; }
#define WSP(T, off) ((T*)(ws + (off)))
__global__ void __launch_bounds__(NWAVES * 64, 2) mk_fwd(Args args) {
    extern __shared__ __attribute__((aligned(16))) unsigned char lds_raw[];
    Frame F0; F0.lds = (LAS unsigned char*)lds_raw; F0.tid = threadIdx.x; F0.lane = F0.tid & 63; F0.wave = __builtin_amdgcn_readfirstlane(F0.tid >> 6);
    F0.G = gridDim.x; F0.gw = blockIdx.x * NWAVES + F0.wave; F0.NGW = F0.G * NWAVES;
    volatile LAS unsigned* MISC = (volatile LAS unsigned*)(F0.lds + MISC_OFF);
    for (int u = F0.tid; u < (LDS_BYTES - MISC_OFF) / 4; u += NWAVES * 64) ((LAS unsigned*)(F0.lds + MISC_OFF))[u] = 0u;
    __syncthreads();
    const int lo = args.ph_lo, hi = args.ph_hi;
    const bool multi = (hi - lo) > 1;
    XcdBarrier bar; bar.bar = (unsigned*)(args.ws + WS_CTL) + CW_BAR; bar.x = 0; bar.st = nullptr;
    if (multi) bar = xcd_barrier_post((unsigned*)(args.ws + WS_CTL) + CW_BAR, MISC + 8);
#define IN(k) (kargs()->ph_lo <= (k) && (k) < kargs()->ph_hi)
#define SEAM(k) do { if (IN((k) + 1)) xcd_barrier(bar); } while (0)
#define PH_BEGIN KArgs ka = kargs(); unsigned char* ws = ka->ws; (void)ws; Frame F = F0; { int w_ = F0.wave; asm volatile("" : "+s"(w_)); F.wave = w_; F.gw = (int)blockIdx.x * NWAVES + w_; } F.lane = pg8::lane_id_opaque(); F.tid = F.wave * 64 + F.lane
    if (IN(PH_CVT)) {
        { PH_BEGIN;
        unsigned gb = 0;
        for (int l = 0; l < 2; ++l) {
            xpose_matrix(F, ka->in[2] + (size_t)l * D * INC, D, INC, (bf16*)(ws + WS_WIN_T + l * WIN_T_L), D, 0, gb);
            xpose_matrix(F, ka->in[4] + (size_t)l * CW * D, CW, D, (bf16*)(ws + WS_WBR_T + l * WBR_T_L), CW, 0, gb);
            xpose_matrix(F, ka->in[7] + (size_t)l * HGW * D, HGW, D, (bf16*)(ws + WS_WBR_T + l * WBR_T_L + 3 * MiB), HGW, 0, gb);
            xpose_matrix(F, ka->in[10] + (size_t)l * XAW * D, XAW, D, (bf16*)(ws + WS_WBR_T + l * WBR_T_L + 6 * MiB), YXW, 0, gb);
            for (int i = blockIdx.x * 512 + F.tid; i < D * 32; i += F.G * 512) *(v4u*)((bf16*)(ws + WS_WBR_T + l * WBR_T_L + 6 * MiB) + (size_t)(i >> 5) * YXW + XAW + (i & 31) * 8) = (v4u){0u, 0u, 0u, 0u};
            xpose_matrix(F, ka->in[11] + (size_t)l * D * D, D, D, (bf16*)(ws + WS_WO_T + l * WO_T_L), D, 0, gb);
            xpose_matrix(F, ka->in[8] + (size_t)l * D * XAW, D, XAW, (bf16*)(ws + WS_WKV_T) + (size_t)(l * 1024) * D, D, 0, gb);
            xpose_matrix(F, ka->in[9] + (size_t)l * D * XAW, D, XAW, (bf16*)(ws + WS_WKV_T) + (size_t)(l * 1024 + 512) * D, D, 0, gb);
        }
        cvt_router(F, ka->in[14], ws);
        cvt_rows(F, ka->in[0], WSP(bf16, WS_XBF), (size_t)NTOK * D / 8);
        cvt_rows(F, ka->in[1], WSP(bf16, WS_MEMBF), (size_t)NB * NMEM * D / 8);
        }
        SEAM(PH_CVT);
    }
    for (int l = 0; l < 2; ++l) {
        const int pb = PH_L0 + l * PH_PER_LAYER;
        if (IN(pb + P_INPROJ)) {
            { PH_BEGIN;
            const bool split = F.G == 256;
            const int oa = (int)blockIdx.x >> 3, ox = (int)blockIdx.x & 7; const bool conv = split && ox < 2;
            const int hrank = 2 * oa + ox, grank = oa;
            static_assert((256 - NCV) * GM_UNITS + NCV * CV_UNITS == (NTOK / 256) * (INC / 256), "in-projection unit shares");
            if (conv) { Frame Fc = F; Fc.gw = hrank * NWAVES + F.wave; Fc.NGW = NCV * NWAVES; unsigned gb = 0;
                cvt_experts(Fc, ka->in[16] + (size_t)l * NE * D * EH, ka->in[17] + (size_t)l * NE * D * EH, ka->in[18] + (size_t)l * NE * EH * D, ka->in[19] + (size_t)l * D * EH, ka->in[20] + (size_t)l * D * EH, ka->in[21] + (size_t)l * EH * D, ws, gb);
                __syncthreads(); }
            if (!split) { unsigned gb = 0; cvt_experts(F, ka->in[16] + (size_t)l * NE * D * EH, ka->in[17] + (size_t)l * NE * D * EH, ka->in[18] + (size_t)l * NE * EH * D, ka->in[19] + (size_t)l * D * EH, ka->in[20] + (size_t)l * D * EH, ka->in[21] + (size_t)l * EH * D, ws, gb); __syncthreads(); }
            DenseSched S; S.init(ws + WS_XBF, ws + WS_WIN_T + l * WIN_T_L, NTOK, INC, D, F.G, (int)blockIdx.x);
            if (split) { S.lin = 1; S.cnt = conv ? CV_UNITS : GM_UNITS;
                if (conv) { S.L0 = (256 - NCV) * GM_UNITS; S.G = NCV; S.c = hrank; } else { S.L0 = (ox - 2) * 32 * GM_UNITS; S.G = 32; S.c = grank; } }
            EpiProj E{WSP(bf16, WS_R1), WSP(unsigned char, WS_GATE8)};
            pg8::gemm_phase<EpiProj, DenseSched, true>(F.lds + RING_OFF, F.wave, D, S, E);
            if (l == 0) {
                DenseSched S2; S2.init(ws + WS_MEMBF, ws + WS_WKV_T, NB * NMEM, 2048, D, split ? 32 : F.G, split ? ((conv && hrank < 32) ? hrank : -1) : (int)blockIdx.x);
                EpiBf16Plain E2{WSP(bf16, WS_KV), 2048};
                pg8::gemm_phase<EpiBf16Plain, DenseSched, true>(F.lds + RING_OFF, F.wave, D, S2, E2);
            }
            }
            SEAM(pb + P_INPROJ);
        }
        if (IN(pb + P_MIX)) {
            { PH_BEGIN;
            memattn(F, WSP(bf16, WS_R1), WSP(bf16, WS_KV), l, WSP(bf16, WS_YX));
            hgrn_local(F, WSP(bf16, WS_R1), ka->in[5], l, ws + WS_R2);
            conv_part(F, WSP(bf16, WS_R1), ka->in[3] + (size_t)l * 3 * CW, WSP(bf16, WS_YA), WSP(bf16, WS_YX));
            }
            SEAM(pb + P_MIX);
        }
        if (IN(pb + P_SCAN)) {
            { PH_BEGIN;
            hgrn_scan(F, ws + WS_R2, WSP(v2u, WS_ZF));
            }
            SEAM(pb + P_SCAN);
        }
        if (IN(pb + P_HOUT)) {
            { PH_BEGIN;
            hgrn_out(F, WSP(bf16, WS_R1), ws + WS_R2, WSP(bf16, WS_ZF), ka->in[6] + (size_t)l * HGW, WSP(bf16, WS_YB));
            }
            SEAM(pb + P_HOUT);
        }
        if (IN(pb + P_BRANCH)) {
            { PH_BEGIN;
            static_assert(WS_YX - WS_YB == WS_YB - WS_YA, "branch inputs equally spaced");
            BranchSched S; S.init(ws + WS_YA, ws + WS_WBR_T + l * WBR_T_L, F.G, (int)blockIdx.x); EpiGateRT E{WSP(unsigned char, WS_GATE8), WSP(bf16, WS_MERGED)};
            pg8::gemm_phase<EpiGateRT, BranchSched, true>(F.lds + RING_OFF, F.wave, CW, S, E);
            }
            SEAM(pb + P_BRANCH);
        }
        if (IN(pb + P_WO)) {
            { PH_BEGIN;
            DenseSched S; S.init(ws + WS_MERGED, ws + WS_WO_T + l * WO_T_L, NTOK, D, D, F.G, (int)blockIdx.x);
            EpiResid<true> E{(const void*)WSP(bf16, WS_XBF), WSP(bf16, WS_ZF)}; pg8::gemm_phase<EpiResid<true>, DenseSched, true>(F.lds + RING_OFF, F.wave, D, S, E);
            }
            SEAM(pb + P_WO);
        }
        if (IN(pb + P_ROUTE)) {
            { PH_BEGIN;
            route_phase(F, WSP(bf16, WS_ZF), ka->in[12] + (size_t)l * D, ka->in[13] + (size_t)l * D, WSP(bf16, WS_RW + l * RW_L), ka->in[15] + (size_t)l * NE, WSP(bf16, WS_X1F), WSP(bf16, WS_X1BF),
                        WSP(unsigned, WS_CTL) + CW_CNT + l * 64, WSP(int, WS_LIST), WSP(int, WS_TOKSLOT), WSP(float, WS_TOKW));
            }
            SEAM(pb + P_ROUTE);
        }
        if (IN(pb + P_GU)) {
            { PH_BEGIN;
            moe_plan(F, WSP(unsigned, WS_CTL) + CW_CNT + l * 64);
            MoeSched<true> S; S.init(F, ws + WS_X1BF, ws + WS_WGU, WSP(int, WS_LIST)); EpiSwiGLU E{WSP(bf16, WS_R2)};
            pg8::gemm_phase<EpiSwiGLU, MoeSched<true>, true>(F.lds + RING_OFF, F.wave, D, S, E);
            }
            SEAM(pb + P_GU);
        }
        if (IN(pb + P_DOWN)) {
            { PH_BEGIN;
            if (kargs()->ph_lo > pb + P_GU) moe_plan(F, WSP(unsigned, WS_CTL) + CW_CNT + l * 64);
            MoeSched<false> S; S.init(F, ws + WS_R2, ws + WS_WDN, nullptr); EpiY8 E{WSP(unsigned char, WS_R1), WSP(bf16, WS_R1 + R1_YS)};
            pg8::gemm_phase<EpiY8, MoeSched<false>, true>(F.lds + RING_OFF, F.wave, EH, S, E);
            }
            SEAM(pb + P_DOWN);
        }
        if (IN(pb + P_COMB)) {
            { PH_BEGIN;
            if (kargs()->ph_lo > pb + P_GU) moe_plan(F, WSP(unsigned, WS_CTL) + CW_CNT + l * 64);
            combine_phase(F, WSP(bf16, WS_X1BF), WSP(unsigned char, WS_R1), WSP(bf16, WS_R1 + R1_YS), WSP(int, WS_TOKSLOT), WSP(float, WS_TOKW), ka->in[22] + (size_t)l * D, ka->in[23] + (size_t)l * D, ka->out, WSP(bf16, WS_XBF), l == 1);
            }
            SEAM(pb + P_COMB);
        }
    }
#undef IN
#undef SEAM
}
static void launch_mk(Args a, int lo, int hi, int grid, hipStream_t stream) {
    a.ph_lo = lo; a.ph_hi = hi;
    hipLaunchKernelGGL(mk_fwd, dim3(grid), dim3(NWAVES * 64), LDS_BYTES, stream, a);
}
extern "C" void kernel_launch(void* const* d_in, const int* in_sizes, int n_in, void* d_out, int out_size, void* d_ws, size_t ws_size, hipStream_t stream) {
    static int grid = 0;
    if (grid == 0) {
        if (n_in != 24 || out_size != NTOK * D || ws_size < WS_END) { fprintf(stderr, "kernel_launch: unexpected sizes n_in %d out %d ws %zu\n", n_in, out_size, ws_size); grid = -1; return; }
        int dev = 0, cus = 0;
        if (hipGetDevice(&dev) != hipSuccess || hipDeviceGetAttribute(&cus, hipDeviceAttributeMultiprocessorCount, dev) != hipSuccess) { grid = -1; return; }
        if (hipFuncSetAttribute((const void*)mk_fwd, hipFuncAttributeMaxDynamicSharedMemorySize, LDS_BYTES) != hipSuccess) { fprintf(stderr, "kernel_launch: hipFuncSetAttribute failed\n"); grid = -1; return; }
        int per_cu = 0; (void)hipOccupancyMaxActiveBlocksPerMultiprocessor(&per_cu, (const void*)mk_fwd, NWAVES * 64, LDS_BYTES); (void)hipGetLastError();
        if (per_cu < 1) fprintf(stderr, "kernel_launch: occupancy query says %d\n", per_cu);
        grid = cus;
    }
    if (grid < 0) return;
    const float* x = (const float*)d_in[0];
    const float* conv_w = (const float*)d_in[3]; const float* lbl = (const float*)d_in[5];
    const float* hg_g = (const float*)d_in[6];
    const float* ln1_g = (const float*)d_in[12]; const float* ln1_b = (const float*)d_in[13]; const float* router_w = (const float*)d_in[14];
    const float* router_b = (const float*)d_in[15]; const float* exp_wg = (const float*)d_in[16]; const float* exp_wu = (const float*)d_in[17];
    const float* exp_wd = (const float*)d_in[18]; const float* sh_wg = (const float*)d_in[19]; const float* sh_wu = (const float*)d_in[20];
    const float* sh_wd = (const float*)d_in[21]; const float* ln2_g = (const float*)d_in[22]; const float* ln2_b = (const float*)d_in[23];
    unsigned char* ws = (unsigned char*)d_ws; float* out = (float*)d_out;
    unsigned* ctl = (unsigned*)(ws + WS_CTL);
    bf16* KV = (bf16*)(ws + WS_KV); bf16* XBF = (bf16*)(ws + WS_XBF); float* X1F = (float*)(ws + WS_X1F);
    bf16* X1BF = (bf16*)(ws + WS_X1BF); float* ZF = (float*)(ws + WS_ZF);
    bf16* YA = (bf16*)(ws + WS_YA); bf16* YB = (bf16*)(ws + WS_YB); bf16* YX = (bf16*)(ws + WS_YX);
    bf16* H = (bf16*)(ws + WS_R2); float* OH = (float*)(ws + WS_R2); bf16* PROJ = (bf16*)(ws + WS_R1); bf16* Y = (bf16*)(ws + WS_R1);
    int* LIST = (int*)(ws + WS_LIST); int* TOKSLOT = (int*)(ws + WS_TOKSLOT); float* TOKW = (float*)(ws + WS_TOKW);
    Args a{};
    for (int i = 0; i < 24; ++i) a.in[i] = (const float*)d_in[i];
    a.out = out; a.ws = ws;

    (void)hipMemsetAsync(ws + WS_CTL, 0, (size_t)(CW_BAR + XCD_BAR_WORDS) * 4, stream);
    a.mask = 7;
    launch_mk(a, 0, N_PHASES, grid, stream);
}
```

```cpp
#include <hip/hip_runtime.h>
#include <stdint.h>
#include <stdio.h>

typedef unsigned short bf16;
__device__ __forceinline__ float bf2f(bf16 v) { return __uint_as_float(((unsigned)v) << 16); }
__device__ __forceinline__ bf16 f2bf(float f) { unsigned u = __float_as_uint(f); return (bf16)((u + 0x7fffu + ((u >> 16) & 1u)) >> 16); }

constexpr int NB = 4, SEQ = 4096, NTOK = NB * SEQ, D = 2048, NMEM = 256;
constexpr int CW = 768, HGW = 768, HGH = 6, HGD = 128, XAW = 512, XAH = 4, XAD = 128;
constexpr int INC = 12032, YXW = 768, GW8 = 3 * 2048, PN_GATE = 23;
constexpr int C_U = 0, C_B = 768, C_C = 1536, C_Q = 2304, C_F = 3072, C_I = 3840, C_G = 4608, C_QX = 5376, C_GA = 5888, C_GB = 7936, C_GX = 9984;
constexpr int NE = 64, TOPK = 8, EH = 512;
constexpr float ALPHA = 1.41421356237f, LN_EPS = 1e-5f, RMS_EPS = 1e-6f, RSCALE = 2.5f;
constexpr int LISTCAP = 16384;

constexpr size_t MiB = 1u << 20;
constexpr size_t WS_CTL = 0, CTL_BYTES = 1 * MiB;
constexpr size_t WS_RW = 1 * MiB, RW_L = 512 * 1024;
constexpr size_t WS_WIN_T = 2 * MiB, WIN_T_L = 47 * MiB;
constexpr size_t WS_WBR_T = 1932 * MiB, WBR_T_L = 9 * MiB;
constexpr size_t WS_WO_T = 112 * MiB, WO_T_L = 8 * MiB;
constexpr size_t WS_WKV_T = 128 * MiB;
constexpr size_t WS_MEMBF = 136 * MiB, WS_KV = 140 * MiB;
constexpr size_t WS_WGU = 144 * MiB, WGU_E = 4 * MiB;
constexpr size_t WS_WDN = 404 * MiB, WDN_E = 2 * MiB;
constexpr size_t WS_XBF = 534 * MiB, WS_X1F = 598 * MiB, WS_X1BF = 726 * MiB, WS_ZF = 790 * MiB, WS_MERGED = 918 * MiB;
constexpr size_t WS_YA = 1860 * MiB, WS_YB = 1884 * MiB, WS_YX = 1908 * MiB;
constexpr size_t WS_R2 = 1046 * MiB;
constexpr size_t WS_R1 = 1214 * MiB;
constexpr size_t R1_YS = 320 * MiB;
constexpr size_t WS_LIST = 1854 * MiB, WS_TOKSLOT = 1858 * MiB, WS_TOKW = 1859 * MiB, WS_GATE8 = 1950 * MiB, WS_END = 2046 * MiB;
constexpr int CW_CNT = 1024;
constexpr int CW_PLAN = 2048;
constexpr int CW_BAR = 4096;
#ifndef DBG_MASK
#define DBG_MASK 7
#endif
namespace pg8 {
#define PG8_LAS __attribute__((address_space(3)))
typedef unsigned short bf16_t;
typedef short bf16x8 __attribute__((ext_vector_type(8)));
typedef float f32x4 __attribute__((ext_vector_type(4)));
typedef unsigned u32x4 __attribute__((ext_vector_type(4)));
typedef unsigned u32x2 __attribute__((ext_vector_type(2)));
constexpr int PG8_NVO_OFF = 147456 + 1024;
constexpr int BM = 256, BK = 64, HALF = 128, HTB = HALF * BK * 2  , STAGE_BYTES = 8 * HTB, NXCD = 8, WGM = 8;

__host__ __device__ __forceinline__ int lds_byte(int r, int c) { const int st = (r >> 4) * 2 + (c >> 5), rr = r & 15, cc = c & 31, ob = rr * 64 + cc * 2; return st * 1024 + (ob ^ (((ob >> 9) & 1) << 5)); }
__host__ __device__ __forceinline__ void stage_rc(int b, int& R, int& C) { const int st = b / 1024, sb = b % 1024, swz = sb ^ (((sb >> 9) & 1) << 5); R = (st >> 1) * 16 + swz / 64; C = (st & 1) * 32 + (swz % 64) / 2; }
__host__ __device__ __forceinline__ int perm32(int rho) { const int n = rho >> 4, i = rho & 15; return 8 * (i >> 2) + 4 * n + (i & 3); }

struct Unit { const char* A; const char* B; int pm, pn; const int* list; int m0, cnt; };

typedef float f32x2_ __attribute__((ext_vector_type(2)));
typedef __bf16 bf16x2_ __attribute__((ext_vector_type(2)));
__device__ __forceinline__ unsigned cvt_pk_bf16(float lo, float hi) { const f32x2_ v = {lo, hi}; const bf16x2_ b = __builtin_convertvector(v, bf16x2_); return __builtin_bit_cast(unsigned, b); }
__device__ __forceinline__ int lane_id_opaque() { unsigned m = ~0u; asm volatile("" : "+s"(m)); return (int)__builtin_amdgcn_mbcnt_hi(m, __builtin_amdgcn_mbcnt_lo(m, 0u)); }
__device__ __forceinline__ float bf_lo(unsigned w) { return __uint_as_float(w << 16); }
__device__ __forceinline__ float bf_hi(unsigned w) { return __uint_as_float(w & 0xffff0000u); }
__device__ __forceinline__ float sigmoidf_(float x) { return __builtin_amdgcn_rcpf(1.f + __expf(-x)); }

typedef f32x4 Acc[2][2][4][2];

template <class Epi, class Sched, bool ALIGN_EPI>
__device__ __forceinline__ void gemm_phase(PG8_LAS unsigned char* lds, const int wave, const int K_in, const Sched& S, const Epi& E) {
    const int lane = lane_id_opaque(), wid = wave, tid = wid * 64 + lane, wr = wid >> 2, wc = wid & 3, fr = lane & 15, fq = lane >> 4;
    int K = K_in; asm volatile("" : "+s"(K));
    const int nt = K / BK;
    unsigned voffB[2];
#pragma unroll
    for (int i = 0; i < 2; ++i) { int R, C; stage_rc(tid * 16 + i * 8192, R, C); const int Rb = Epi::PERM ? ((R & ~31) + perm32(R & 31)) : R; voffB[i] = (unsigned)(Rb * K + C) * 2u; }
    const size_t kstep = (size_t)(BK * 2);
    const size_t hstep = (size_t)HALF * K * 2;
    const unsigned ldsw = (unsigned)wid * 1024u;
    const int aoff = lds_byte(wr * 64 + fr, fq * 8), boff = lds_byte(wc * 32 + fr, fq * 8);
#define PG8_SA(b, h) (((b) * 2 + (h)) * HTB)
#define PG8_SB(b, h) ((4 + (b) * 2 + (h)) * HTB)
#define PG8_STAGE2(bufoff, gbase, v0, v1) do { \
        __builtin_amdgcn_global_load_lds((const unsigned*)((const char*)(gbase) + (v0)), (PG8_LAS unsigned*)(lds + (bufoff) + ldsw), 16, 0, 0); \
        __builtin_amdgcn_global_load_lds((const unsigned*)((const char*)(gbase) + (v1)), (PG8_LAS unsigned*)(lds + (bufoff) + ldsw + 8192), 16, 0, 0); } while (0)
#define PG8_STAGEB(bufoff, gbase) PG8_STAGE2(bufoff, gbase, voffB[0], voffB[1])
#define PG8_LDA(dst, b, h) do { _Pragma("unroll") for (int m = 0; m < 4; ++m) _Pragma("unroll") for (int k = 0; k < 2; ++k) dst[m][k] = *(const PG8_LAS bf16x8*)(lds + PG8_SA(b, h) + aoff + m * 2048 + k * 1024); } while (0)
#define PG8_LDB(dst, b, h) do { _Pragma("unroll") for (int n = 0; n < 2; ++n) _Pragma("unroll") for (int k = 0; k < 2; ++k) dst[n][k] = *(const PG8_LAS bf16x8*)(lds + PG8_SB(b, h) + boff + n * 2048 + k * 1024); } while (0)
#define PG8_MMA(ai, bj, At, Bt) do { __builtin_amdgcn_s_setprio(1); _Pragma("unroll") for (int m = 0; m < 4; ++m) _Pragma("unroll") for (int n = 0; n < 2; ++n) _Pragma("unroll") for (int k = 0; k < 2; ++k) \
        acc[ai][bj][m][n] = __builtin_amdgcn_mfma_f32_16x16x32_bf16(Bt[n][k], At[m][k], acc[ai][bj][m][n], 0, 0, 0); __builtin_amdgcn_s_setprio(0); } while (0)
#define PG8_WAIT_V(n) asm volatile("s_waitcnt vmcnt(" #n ")" ::: "memory")
#define PG8_WAIT_L(n) asm volatile("s_waitcnt lgkmcnt(" #n ")" ::: "memory")
#define PG8_BAR __builtin_amdgcn_s_barrier()
#define PG8_SCHED __builtin_amdgcn_sched_barrier(0)
    Unit cur, nxt; int ui = 0;
    if (!S.next(0, cur)) return;
    Acc acc;
#pragma unroll
    for (int a = 0; a < 2; ++a)
#pragma unroll
        for (int b = 0; b < 2; ++b)
#pragma unroll
            for (int m = 0; m < 4; ++m)
#pragma unroll
                for (int n = 0; n < 2; ++n) acc[a][b][m][n] = (f32x4){0.f, 0.f, 0.f, 0.f};
    bf16x8 At[4][2], B0[2][2], B1[2][2];
    constexpr bool GA = Sched::GATHER;
    unsigned c00, c01, c10 = 0, c11 = 0;
    PG8_LAS unsigned* nvo = (PG8_LAS unsigned*)(lds + PG8_NVO_OFF) + tid * 4;
    { int R0, C0, R1, C1; stage_rc(tid * 16, R0, C0); stage_rc(tid * 16 + 8192, R1, C1);
      c00 = S.avoff(cur, 0, R0, C0, K); c01 = S.avoff(cur, 0, R1, C1, K); if constexpr (GA) { c10 = S.avoff(cur, 1, R0, C0, K); c11 = S.avoff(cur, 1, R1, C1, K); } }
    const size_t hA = GA ? (size_t)0 : hstep;
#define PG8_STAGEA0(bufoff, gbase) PG8_STAGE2(bufoff, gbase, c00, c01)
#define PG8_STAGEA1(bufoff, gbase) do { if constexpr (GA) PG8_STAGE2(bufoff, gbase, c10, c11); else PG8_STAGE2(bufoff, (gbase) + hA, c00, c01); } while (0)
    const char* cA = cur.A; const char* cB = cur.B;
    PG8_STAGEB(PG8_SB(0, 0), cB); PG8_STAGEB(PG8_SB(0, 1), cB + hstep); PG8_STAGEA0(PG8_SA(0, 0), cA); PG8_STAGEA1(PG8_SA(0, 1), cA);
    if (wr == 1) PG8_BAR;
    PG8_WAIT_V(2); PG8_BAR;
    PG8_STAGEB(PG8_SB(1, 0), cB + kstep); PG8_STAGEA0(PG8_SA(1, 0), cA + kstep); PG8_STAGEB(PG8_SB(1, 1), cB + hstep + kstep);
    PG8_WAIT_V(6); PG8_BAR;
    int pi0 = 0, pi1 = 0, pi2 = 0, pi3 = 0;
    if constexpr (GA) { Unit n1; if (S.next(1, n1)) { int R0, C0, R1, C1; stage_rc(tid * 16, R0, C0); stage_rc(tid * 16 + 8192, R1, C1);
        pi0 = S.avload(n1, 0, R0); pi1 = S.avload(n1, 0, R1); pi2 = S.avload(n1, 1, R0); pi3 = S.avload(n1, 1, R1); } }
    for (;;) {
        const bool has_next = S.next(ui + 1, nxt);
        const char* nA = has_next ? nxt.A : cA; const char* nB = has_next ? nxt.B : cB;
        if constexpr (GA) { if (has_next) {
            int R0, C0, R1, C1; stage_rc(tid * 16, R0, C0); stage_rc(tid * 16 + 8192, R1, C1);
            nvo[0] = S.avfin(nxt, 0, R0, C0, K, pi0); nvo[1] = S.avfin(nxt, 0, R1, C1, K, pi1); nvo[2] = S.avfin(nxt, 1, R0, C0, K, pi2); nvo[3] = S.avfin(nxt, 1, R1, C1, K, pi3); } }
        for (int t = 0; t < nt; t += 2) {
            const bool last = (t == nt - 2);
            const char* a1 = cA + (size_t)(t + 1) * kstep;
            const char* a2 = last ? nA : cA + (size_t)(t + 2) * kstep; const char* b2 = last ? nB : cB + (size_t)(t + 2) * kstep;
            const char* a3 = a2 + kstep; const char* b3 = b2 + kstep;
            const bool nx = GA && last && has_next;
#define PG8_STAGEA0N(bufoff, gbase) do { if (nx) { const unsigned q0 = nvo[0], q1 = nvo[1]; PG8_STAGE2(bufoff, gbase, q0, q1); } else PG8_STAGEA0(bufoff, gbase); } while (0)
#define PG8_STAGEA1N(bufoff, gbase) do { if (nx) { const unsigned q0 = nvo[2], q1 = nvo[3]; PG8_STAGE2(bufoff, gbase, q0, q1); } else PG8_STAGEA1(bufoff, gbase); } while (0)
            PG8_LDB(B0, 0, 0); PG8_LDB(B1, 0, 1); PG8_SCHED; PG8_LDA(At, 0, 0); PG8_STAGEA1(PG8_SA(1, 1), a1);
            PG8_WAIT_V(8); PG8_WAIT_L(0); PG8_BAR; PG8_MMA(0, 0, At, B0); PG8_MMA(0, 1, At, B1); PG8_BAR; PG8_SCHED;
            PG8_LDA(At, 0, 1); PG8_STAGEB(PG8_SB(0, 0), b2); PG8_STAGEB(PG8_SB(0, 1), b2 + hstep); PG8_STAGEA0N(PG8_SA(0, 0), a2);
            PG8_WAIT_V(8); PG8_WAIT_L(0); PG8_BAR; PG8_MMA(1, 0, At, B0); PG8_MMA(1, 1, At, B1); PG8_BAR; PG8_SCHED;
            PG8_LDB(B0, 1, 0); PG8_LDB(B1, 1, 1); PG8_SCHED; PG8_LDA(At, 1, 0); PG8_STAGEA1N(PG8_SA(0, 1), a2);
            PG8_WAIT_V(8); PG8_WAIT_L(0); PG8_BAR; PG8_MMA(0, 0, At, B0); PG8_MMA(0, 1, At, B1); PG8_BAR; PG8_SCHED;
            PG8_LDA(At, 1, 1); PG8_STAGEB(PG8_SB(1, 0), b3); PG8_STAGEB(PG8_SB(1, 1), b3 + hstep); PG8_STAGEA0N(PG8_SA(1, 0), a3);
            PG8_WAIT_V(8); PG8_WAIT_L(0); PG8_BAR; PG8_MMA(1, 0, At, B0); PG8_MMA(1, 1, At, B1); PG8_BAR; PG8_SCHED;
#undef PG8_STAGEA0N
#undef PG8_STAGEA1N
        }
        if constexpr (GA) { Unit n2; if (has_next && S.next(ui + 2, n2)) { int R0, C0, R1, C1; stage_rc(tid * 16, R0, C0); stage_rc(tid * 16 + 8192, R1, C1);
            pi0 = S.avload(n2, 0, R0); pi1 = S.avload(n2, 0, R1); pi2 = S.avload(n2, 1, R0); pi3 = S.avload(n2, 1, R1); } }
        if constexpr (ALIGN_EPI) { if (wr == 0) PG8_BAR; }
        bool keep = false;
        if constexpr (Epi::INPLACE) keep = E.inplace(acc, cur, wr, wc, fr, fq); else E(acc, cur, wr, wc, fr, fq);
        if (!has_next) break;
        if (!keep)
#pragma unroll
        for (int a = 0; a < 2; ++a)
#pragma unroll
            for (int b = 0; b < 2; ++b)
#pragma unroll
                for (int m = 0; m < 4; ++m)
#pragma unroll
                    for (int n = 0; n < 2; ++n) acc[a][b][m][n] = (f32x4){0.f, 0.f, 0.f, 0.f};
        cur = nxt; cA = nA; cB = nB; ++ui; if constexpr (GA) { c00 = nvo[0]; c01 = nvo[1]; c10 = nvo[2]; c11 = nvo[3]; }
        if constexpr (ALIGN_EPI) { if (wr == 1) PG8_BAR; }
    }
    PG8_WAIT_V(0);
    if constexpr (!ALIGN_EPI) { if (wr == 0) PG8_BAR; }
    PG8_BAR;
#undef PG8_SA
#undef PG8_SB
#undef PG8_STAGE2
#undef PG8_STAGEB
#undef PG8_STAGEA0
#undef PG8_STAGEA1
#undef PG8_LDA
#undef PG8_LDB
#undef PG8_MMA
#undef PG8_WAIT_V
#undef PG8_WAIT_L
#undef PG8_BAR
#undef PG8_SCHED
}
}
#define GAS __attribute__((address_space(1)))
#define LAS __attribute__((address_space(3)))
typedef unsigned v4u __attribute__((ext_vector_type(4)));
typedef unsigned v2u __attribute__((ext_vector_type(2)));
typedef float f32x4 __attribute__((ext_vector_type(4)));
typedef short bf16x8 __attribute__((ext_vector_type(8)));
typedef GAS unsigned gu32;
#define RLX_AGENT __ATOMIC_RELAXED, __HIP_MEMORY_SCOPE_AGENT
#define LDS_WAIT() asm volatile("s_waitcnt lgkmcnt(0)" ::: "memory")
#define VM_WAIT() asm volatile("s_waitcnt vmcnt(0)" ::: "memory")
__device__ __forceinline__ int opaque_v(int x) { asm volatile("" : "+v"(x)); return x; }
__device__ __forceinline__ float shx(float v, int o, int lane) { return __int_as_float(__builtin_amdgcn_ds_bpermute((lane ^ o) << 2, __float_as_int(v))); }
__device__ __forceinline__ unsigned pk2(float lo, float hi) { return pg8::cvt_pk_bf16(lo, hi); }

#define XB_TMO      128
#define XB_XCNT(j)  (256  + 64 * (j))
#define XB_XSUB(j)  (1280 + 64 * (j))
#define XB_XGEN(j)  (2304 + 64 * (j))
#define XB_TOP      3328
#define XB_TOPGEN   3392
#define XCD_BAR_WORDS 3456
#define XB_SPIN_CAP (1u << 18)
__device__ __forceinline__ unsigned xb_ld(unsigned* p)              { return __hip_atomic_load(p, __ATOMIC_RELAXED, __HIP_MEMORY_SCOPE_AGENT); }
__device__ __forceinline__ unsigned xb_add(unsigned* p, unsigned v) { return __hip_atomic_fetch_add(p, v, __ATOMIC_RELAXED, __HIP_MEMORY_SCOPE_AGENT); }
__device__ __forceinline__ unsigned xb_xcc_id() { return (unsigned)__builtin_amdgcn_s_getreg((3 << 11) | 20) & 0xFu; }
#define XB_SPIN(cond, bar) do { unsigned _sp = 0; while (cond) { __builtin_amdgcn_s_sleep(1); \
    if ((++_sp & 255u) == 0u) { if (xb_ld(&(bar)[XB_TMO])) break; if (_sp > XB_SPIN_CAP) { atomicAdd(&(bar)[XB_TMO], 1u); break; } } } } while (0)
struct XcdBarrier { unsigned* bar; unsigned x; volatile LAS unsigned* st; };
__device__ __forceinline__ XcdBarrier xcd_barrier_post(unsigned* bar, volatile LAS unsigned* st) {
    XcdBarrier b; b.bar = bar; b.x = xb_xcc_id(); b.st = st;
    if (threadIdx.x == 0) (void)xb_add(&bar[XB_XCNT(b.x)], 1u);
    return b;
}
__device__ __forceinline__ void xcd_barrier_complete(unsigned* bar, unsigned x, unsigned& nloc, unsigned& nx) {
    const unsigned G = gridDim.x * gridDim.y * gridDim.z;
    unsigned sum, cnt, mine, sp = 0u;
    for (;;) {
        sum = 0u; cnt = 0u; mine = 0u;
#pragma unroll
        for (unsigned j = 0; j < 16; ++j) { const unsigned c = xb_ld(&bar[XB_XCNT(j)]); sum += c; cnt += (c > 0u) ? 1u : 0u; mine = (j == x) ? c : mine; }
        if (sum == G) break;
        __builtin_amdgcn_s_sleep(1);
        if ((++sp & 255u) == 0u) { if (xb_ld(&bar[XB_TMO])) break; if (sp > XB_SPIN_CAP) { atomicAdd(&bar[XB_TMO], 1u); break; } }
    }
    nloc = mine > 0u ? mine : 1u; nx = cnt > 0u ? cnt : 1u;
}
__device__ __forceinline__ void xcd_barrier(const XcdBarrier& b_in) {
    asm volatile("s_waitcnt vmcnt(0)" ::: "memory");
    __syncthreads();
    if (threadIdx.x == 0) {
        XcdBarrier b = b_in; asm volatile("" : "+s"(b.x));
        unsigned* bar = b.bar; asm volatile("" : "+s"(bar));
        __builtin_amdgcn_s_waitcnt(0);
        unsigned nloc = b.st[0], nx = b.st[1];
        if (nloc == 0u) { xcd_barrier_complete(bar, b.x, nloc, nx); b.st[0] = nloc; b.st[1] = nx; }
        const unsigned old = xb_add(&bar[XB_XSUB(b.x)], 1u);
        const unsigned gen = old / nloc;
        if (old + 1u == (gen + 1u) * nloc) {
            __builtin_amdgcn_fence(__ATOMIC_RELEASE, "agent");
            asm volatile("s_waitcnt vmcnt(0)" ::: "memory");
            const unsigned og = xb_add(&bar[XB_TOP], 1u);
            const unsigned tg = og / nx;
            if (og + 1u == (tg + 1u) * nx) xb_add(&bar[XB_TOPGEN], 1u);
            else XB_SPIN(xb_ld(&bar[XB_TOPGEN]) == tg, bar);
            __builtin_amdgcn_fence(__ATOMIC_ACQUIRE, "agent");
            xb_add(&bar[XB_XGEN(b.x)], 1u);
            asm volatile("s_waitcnt vmcnt(0)" ::: "memory");
        } else {
            XB_SPIN(xb_ld(&bar[XB_XGEN(b.x)]) == gen, bar);
            __builtin_amdgcn_fence(__ATOMIC_ACQUIRE, "agent");
            asm volatile("s_waitcnt vmcnt(0)" ::: "memory");
        }
    }
    __syncthreads();
}
using pg8::Unit; using pg8::Acc;
struct DenseSched { static constexpr bool GATHER = false;
    const char* A; const char* B; int nM, nN, nwg, G, c, K; int L0 = 0, cnt = 1 << 30, lin = 0;
    __device__ __forceinline__ void init(const void* A_, const void* B_, int M, int N, int K_, int G_, int c_) { A = (const char*)A_; B = (const char*)B_; nM = M / 256; nN = N / 256; nwg = nM * nN; G = G_; c = c_; K = K_; }
    __device__ __forceinline__ bool next(int i, Unit& u) const {
        const long L = (long)L0 + (long)i * G + c; if (c < 0 || i >= cnt || L >= nwg) return false;
        int wgid = (int)L; if (!lin) { const int q = nwg / 8, r = nwg % 8, xcd = wgid % 8, off = wgid / 8; wgid = (xcd < r ? xcd * (q + 1) : r * (q + 1) + (xcd - r) * q) + off; }
        const int nig = 8 * nN, gid = wgid / nig, fm = gid * 8, gsz = (nM - fm) < 8 ? (nM - fm) : 8;
        u.pm = fm + ((wgid % nig) % gsz); u.pn = (wgid % nig) / gsz;
        u.A = A + (size_t)u.pm * 256 * K * 2; u.B = B + (size_t)u.pn * 256 * K * 2; u.list = nullptr; u.m0 = 0; u.cnt = 0; return true;
    }
    __device__ __forceinline__ int avload(const Unit&, int, int) const { return 0; }
    __device__ __forceinline__ unsigned avfin(const Unit&, int h, int R, int C, int K_, int) const { return (unsigned)(((h * 128 + R) * K_ + C) * 2); }
    __device__ __forceinline__ unsigned avoff(const Unit&, int h, int R, int C, int K_) const { return (unsigned)(((h * 128 + R) * K_ + C) * 2); }
};
struct EpiBf16Plain { static constexpr bool PERM = true, INPLACE = false; bf16* O; int ldc;
    __device__ __forceinline__ void operator()(const Acc& acc, const Unit& u, int wr, int wc, int fr, int fq) const {
        const int row0 = u.pm * 256 + wr * 64 + fr, col0 = u.pn * 256 + wc * 32 + 8 * fq;
#pragma unroll
        for (int ai = 0; ai < 2; ++ai)
#pragma unroll
            for (int m = 0; m < 4; ++m) { bf16* rowp = O + (size_t)(row0 + ai * 128 + m * 16) * ldc + col0;
#pragma unroll
                for (int bj = 0; bj < 2; ++bj) { const f32x4 v0 = acc[ai][bj][m][0], v1 = acc[ai][bj][m][1];
                    v4u w; w.x = pk2(v0[0], v0[1]); w.y = pk2(v0[2], v0[3]); w.z = pk2(v1[0], v1[1]); w.w = pk2(v1[2], v1[3]);
                    *(v4u*)(rowp + bj * 128) = w; } }
    }
};
struct EpiProj { static constexpr bool PERM = true, INPLACE = false; bf16* O; unsigned char* G8;
    __device__ __forceinline__ void operator()(const Acc& acc, const Unit& u, int wr, int wc, int fr, int fq) const {
        const int row0 = u.pm * 256 + wr * 64 + fr;
        if (u.pn < PN_GATE) { const int col0 = u.pn * 256 + wc * 32 + 8 * fq;
#pragma unroll
            for (int ai = 0; ai < 2; ++ai)
#pragma unroll
                for (int m = 0; m < 4; ++m) { bf16* rowp = O + (size_t)(row0 + ai * 128 + m * 16) * INC + col0;
#pragma unroll
                    for (int bj = 0; bj < 2; ++bj) { const f32x4 v0 = acc[ai][bj][m][0], v1 = acc[ai][bj][m][1];
                        v4u w; w.x = pk2(v0[0], v0[1]); w.y = pk2(v0[2], v0[3]); w.z = pk2(v1[0], v1[1]); w.w = pk2(v1[2], v1[3]);
                        *(v4u*)(rowp + bj * 128) = w; } }
        } else { const int pos0 = (u.pn - PN_GATE) * 256 + wc * 64 + fq * 16;
#pragma unroll
            for (int ai = 0; ai < 2; ++ai)
#pragma unroll
                for (int m = 0; m < 4; ++m) { unsigned char* rowp = G8 + (size_t)(row0 + ai * 128 + m * 16) * GW8 + pos0;
                    v4u w;
#pragma unroll
                    for (int bj = 0; bj < 2; ++bj) { const f32x4 v0 = acc[ai][bj][m][0], v1 = acc[ai][bj][m][1];
                        unsigned q[8];
#pragma unroll
                        for (int j = 0; j < 4; ++j) { q[j] = (unsigned)fmaxf(pg8::sigmoidf_(v0[j]) * 255.f + 0.5f, 1.f); q[4 + j] = (unsigned)fmaxf(pg8::sigmoidf_(v1[j]) * 255.f + 0.5f, 1.f); }
                        const unsigned lo = q[0] | (q[1] << 8) | (q[2] << 16) | (q[3] << 24), hi = q[4] | (q[5] << 8) | (q[6] << 16) | (q[7] << 24);
                        if (bj == 0) { w.x = lo; w.y = hi; } else { w.z = lo; w.w = hi; } }
                    *(v4u*)rowp = w; }
        }
    }
};
struct BranchSched { static constexpr bool GATHER = false;
    const char* A0; const char* B; int G, c;
    __device__ __forceinline__ void init(const void* ya, const void* w, int G_, int c_) { A0 = (const char*)ya; B = (const char*)w; G = G_; c = c_; }
    __device__ __forceinline__ bool next(int i, Unit& u) const {
        const int j = i / 3, seg = i - 3 * j; constexpr int nM = NTOK / 256, nN = D / 256, nwg = nM * nN;
        const int L = j * G + c; if (L >= nwg) return false;
        int wgid = L; { const int q = nwg / 8, xcd = wgid % 8, off = wgid / 8; wgid = xcd * q + off; }
        const int nig = 8 * nN; u.pm = (wgid / nig) * 8 + ((wgid % nig) % 8); u.pn = (wgid % nig) / 8;
        u.A = A0 + (size_t)seg * (WS_YB - WS_YA) + (size_t)u.pm * 256 * CW * 2; u.B = B + (size_t)seg * 3 * MiB + (size_t)u.pn * 256 * CW * 2; u.list = nullptr; u.m0 = seg; u.cnt = 0; return true; }
    __device__ __forceinline__ int avload(const Unit&, int, int) const { return 0; }
    __device__ __forceinline__ unsigned avfin(const Unit&, int h, int R, int C, int K_, int) const { return (unsigned)(((h * 128 + R) * K_ + C) * 2); }
    __device__ __forceinline__ unsigned avoff(const Unit&, int h, int R, int C, int K_) const { return (unsigned)(((h * 128 + R) * K_ + C) * 2); }
};
struct EpiGateRT { static constexpr bool PERM = true, INPLACE = true; const unsigned char* g8; bf16* merged;
    __device__ __forceinline__ bool inplace(Acc& acc, const Unit& u, int wr, int wc, int fr, int fq) const {
        const int row0 = u.pm * 256 + wr * 64 + fr, col0 = u.pn * 256 + wc * 32 + 8 * fq, pos0 = u.pn * 256 + wc * 64 + fq * 16; const int seg = u.m0;
#pragma unroll
        for (int ai = 0; ai < 2; ++ai) {
            v4u ga[4], gb[4];
#pragma unroll
            for (int m = 0; m < 4; ++m) { const size_t row = (size_t)(row0 + ai * 128 + m * 16);
                ga[m] = *(const v4u*)(g8 + row * GW8 + seg * D + pos0); gb[m] = ga[m]; if (seg < 2) gb[m] = *(const v4u*)(g8 + row * GW8 + (seg + 1) * D + pos0); }
            asm volatile("" ::: "memory");
#pragma unroll
            for (int m = 0; m < 4; ++m) { const size_t row = (size_t)(row0 + ai * 128 + m * 16);
#pragma unroll
                for (int bj = 0; bj < 2; ++bj) { const unsigned ax = bj ? ga[m].z : ga[m].x, ay = bj ? ga[m].w : ga[m].y, bx = bj ? gb[m].z : gb[m].x, by = bj ? gb[m].w : gb[m].y;
                    f32x4 v0 = acc[ai][bj][m][0], v1 = acc[ai][bj][m][1];
                    if (seg < 2) {
                        v0[0] *= (float)(ax & 255u) * __builtin_amdgcn_rcpf((float)(bx & 255u)); v0[1] *= (float)((ax >> 8) & 255u) * __builtin_amdgcn_rcpf((float)((bx >> 8) & 255u));
                        v0[2] *= (float)((ax >> 16) & 255u) * __builtin_amdgcn_rcpf((float)((bx >> 16) & 255u)); v0[3] *= (float)(ax >> 24) * __builtin_amdgcn_rcpf((float)(bx >> 24));
                        v1[0] *= (float)(ay & 255u) * __builtin_amdgcn_rcpf((float)(by & 255u)); v1[1] *= (float)((ay >> 8) & 255u) * __builtin_amdgcn_rcpf((float)((by >> 8) & 255u));
                        v1[2] *= (float)((ay >> 16) & 255u) * __builtin_amdgcn_rcpf((float)((by >> 16) & 255u)); v1[3] *= (float)(ay >> 24) * __builtin_amdgcn_rcpf((float)(by >> 24));
                        acc[ai][bj][m][0] = v0; acc[ai][bj][m][1] = v1;
                    } else { constexpr float s8 = 1.f / 255.f;
                        v0[0] *= (float)(ax & 255u) * s8; v0[1] *= (float)((ax >> 8) & 255u) * s8; v0[2] *= (float)((ax >> 16) & 255u) * s8; v0[3] *= (float)(ax >> 24) * s8;
                        v1[0] *= (float)(ay & 255u) * s8; v1[1] *= (float)((ay >> 8) & 255u) * s8; v1[2] *= (float)((ay >> 16) & 255u) * s8; v1[3] *= (float)(ay >> 24) * s8;
                        v4u w; w.x = pk2(v0[0], v0[1]); w.y = pk2(v0[2], v0[3]); w.z = pk2(v1[0], v1[1]); w.w = pk2(v1[2], v1[3]); *(v4u*)(merged + row * D + col0 + bj * 128) = w; } } }
            asm volatile("" ::: "memory");
        }
        return seg < 2;
    }
};
template <bool RB16> struct EpiResid { static constexpr bool PERM = true, INPLACE = false; const void* xres; bf16* z;
    __device__ __forceinline__ void operator()(const Acc& acc, const Unit& u, int wr, int wc, int fr, int fq) const {
        const int row0 = u.pm * 256 + wr * 64 + fr, col0 = u.pn * 256 + wc * 32 + 8 * fq;
#pragma unroll
        for (int ai = 0; ai < 2; ++ai) {
            f32x4 xr[4][2][2];
#pragma unroll
            for (int m = 0; m < 4; ++m) { const size_t off = (size_t)(row0 + ai * 128 + m * 16) * D + col0;
#pragma unroll
                for (int bj = 0; bj < 2; ++bj) {
                    if constexpr (RB16) { const v4u w = *(const v4u*)((const bf16*)xres + off + bj * 128);
                        xr[m][bj][0] = (f32x4){pg8::bf_lo(w.x), pg8::bf_hi(w.x), pg8::bf_lo(w.y), pg8::bf_hi(w.y)}; xr[m][bj][1] = (f32x4){pg8::bf_lo(w.z), pg8::bf_hi(w.z), pg8::bf_lo(w.w), pg8::bf_hi(w.w)}; }
                    else {
#pragma unroll
                        for (int n = 0; n < 2; ++n) xr[m][bj][n] = *(const f32x4*)((const float*)xres + off + bj * 128 + n * 4); } } }
            asm volatile("" ::: "memory");
#pragma unroll
            for (int m = 0; m < 4; ++m) { const size_t off = (size_t)(row0 + ai * 128 + m * 16) * D + col0;
#pragma unroll
                for (int bj = 0; bj < 2; ++bj) { const f32x4 v0 = xr[m][bj][0] * ALPHA + acc[ai][bj][m][0], v1 = xr[m][bj][1] * ALPHA + acc[ai][bj][m][1];
                    v4u w; w.x = pk2(v0[0], v0[1]); w.y = pk2(v0[2], v0[3]); w.z = pk2(v1[0], v1[1]); w.w = pk2(v1[2], v1[3]); *(v4u*)(z + off + bj * 128) = w; } }
            asm volatile("" ::: "memory");
        }
    }
};

constexpr int NWAVES = 8;
constexpr int RING_OFF = 0, RING_BYTES = 131072;
constexpr int SCR_BYTES = 147456;
constexpr int MISC_OFF = SCR_BYTES;
constexpr int LDS_BYTES = 163840;
constexpr int PH_CVT = 0, PH_L0 = 1, PH_PER_LAYER = 10;
constexpr int P_INPROJ = 0, P_MIX = 1, P_SCAN = 2, P_HOUT = 3, P_BRANCH = 4, P_WO = 5, P_ROUTE = 6, P_GU = 7, P_DOWN = 8, P_COMB = 9;
constexpr int N_PHASES = PH_L0 + 2 * PH_PER_LAYER;

constexpr int NCV = 64;
#define CV_UNITS 2
#define GM_UNITS 15
struct Frame { LAS unsigned char* lds; int tid, lane, wave, G, gw, NGW; };

__device__ __forceinline__ void xpose_item(const float* W, int N, int k0, int n0, bf16* WTrow0, int ldk, LAS float* scr, int lane) {
    const int kk = lane >> 3, nn = (lane & 7) * 4;
    f32x4 v[8];
#pragma unroll
    for (int i = 0; i < 8; ++i) v[i] = *(const f32x4*)(W + (size_t)(k0 + kk + 8 * i) * N + n0 + nn);
#pragma unroll
    for (int i = 0; i < 8; ++i) { LAS float* s = scr + (kk + 8 * i) * 33 + nn; s[0] = v[i][0]; s[1] = v[i][1]; s[2] = v[i][2]; s[3] = v[i][3]; }
    LDS_WAIT(); asm volatile("" ::: "memory");
    const int c = lane & 7;
#pragma unroll
    for (int j = 0; j < 4; ++j) { const int n = (lane >> 3) + 8 * j; const LAS float* s = scr + (8 * c) * 33 + n;
        v4u o; o.x = pk2(s[0 * 33], s[1 * 33]); o.y = pk2(s[2 * 33], s[3 * 33]); o.z = pk2(s[4 * 33], s[5 * 33]); o.w = pk2(s[6 * 33], s[7 * 33]);
        *(v4u*)(WTrow0 + (size_t)n * ldk + 8 * c) = o; }
    LDS_WAIT(); asm volatile("" ::: "memory");
}
__device__ __forceinline__ void xpose_matrix(const Frame& F, const float* W, int K, int N, bf16* WT, int ldk, int mode, unsigned& gbase) {
    const int nblk = N / 32, nitems = (K / 64) * nblk;
    LAS float* scr = (LAS float*)(F.lds + RING_OFF + F.wave * 8704);
    int it = (int)(((unsigned)F.gw + (unsigned)F.NGW - gbase % (unsigned)F.NGW) % (unsigned)F.NGW);
    for (; it < nitems; it += F.NGW) {
        const int kb = it / nblk, nb = it % nblk, n0 = nb * 32, k0 = kb * 64;
        const int drow = mode == 0 ? n0 : ((n0 >> 7) * 256 + (n0 & 127) + (mode == 2 ? 128 : 0));
        xpose_item(W, N, k0, n0, WT + (size_t)drow * ldk + k0, ldk, scr, F.lane);
    }
    gbase += (unsigned)nitems;
}
__device__ __forceinline__ void cvt_rows(const Frame& F, const float* in, bf16* out, size_t n8) {
    for (size_t i = (size_t)blockIdx.x * 512 + F.tid; i < n8; i += (size_t)F.G * 512) {
        const f32x4 a = *(const f32x4*)(in + i * 8), b = *(const f32x4*)(in + i * 8 + 4);
        v4u w; w.x = pk2(a[0], a[1]); w.y = pk2(a[2], a[3]); w.z = pk2(b[0], b[1]); w.w = pk2(b[2], b[3]);
        *(v4u*)(out + i * 8) = w; }
}
__device__ __forceinline__ void cvt_router(const Frame& F, const float* rw, unsigned char* ws) {
    for (int i = blockIdx.x * 512 + F.tid; i < 2 * D * NE; i += F.G * 512) { const int l = i / (D * NE), k = (i / NE) % D, e = i % NE;
        const float w = rw[i]; const bf16 h = f2bf(w); const bf16 lo = f2bf(w - bf2f(h));
        bf16* dst = (bf16*)(ws + WS_RW + l * RW_L); dst[(size_t)e * D + k] = h; dst[(size_t)(NE + e) * D + k] = lo; }
}
struct XItem { const float* src; bf16* dst; int N, ldk; };
__device__ __forceinline__ void xp_decode(int I, const float* wg, const float* wu, const float* wd, const float* sg, const float* su, const float* sd, unsigned char* ws, XItem& x) {
    const int e = I / 1536, rem = I % 1536, m = rem >> 9, it = rem & 511;
    if (m < 2) { const float* W = m == 0 ? (e < NE ? wg + (size_t)e * D * EH : sg) : (e < NE ? wu + (size_t)e * D * EH : su);
        const int kb = it >> 4, nb = it & 15, n0 = nb * 32, k0 = kb * 64; const int drow = (n0 >> 7) * 256 + (n0 & 127) + (m == 1 ? 128 : 0);
        x.src = W + (size_t)k0 * EH + n0; x.N = EH; x.ldk = D; x.dst = (bf16*)(ws + WS_WGU + (size_t)e * WGU_E) + (size_t)drow * D + k0; }
    else { const float* W = e < NE ? wd + (size_t)e * EH * D : sd; const int kb = it >> 6, nb = it & 63, n0 = nb * 32, k0 = kb * 64;
        x.src = W + (size_t)k0 * D + n0; x.N = D; x.ldk = EH; x.dst = (bf16*)(ws + WS_WDN + (size_t)e * WDN_E) + (size_t)n0 * EH + k0; }
}
__device__ __forceinline__ void xp_load(const XItem& x, int lane, f32x4 (&v)[8]) {
    const int kk = lane >> 3, nn = (lane & 7) * 4;
#pragma unroll
    for (int i = 0; i < 8; ++i) v[i] = __builtin_nontemporal_load((const f32x4*)(x.src + (size_t)(kk + 8 * i) * x.N + nn));
}
__device__ __forceinline__ void xp_store(const XItem& x, const f32x4 (&v)[8], LAS float* scr, int lane) {
    const int kk = lane >> 3, nn = (lane & 7) * 4;
#pragma unroll
    for (int i = 0; i < 8; ++i) { LAS float* s = scr + (kk + 8 * i) * 33 + nn; s[0] = v[i][0]; s[1] = v[i][1]; s[2] = v[i][2]; s[3] = v[i][3]; }
    LDS_WAIT(); asm volatile("" ::: "memory");
    const int c = lane & 7;
#pragma unroll
    for (int j = 0; j < 4; ++j) { const int n = (lane >> 3) + 8 * j; const LAS float* s = scr + (8 * c) * 33 + n;
        v4u o; o.x = pk2(s[0 * 33], s[1 * 33]); o.y = pk2(s[2 * 33], s[3 * 33]); o.z = pk2(s[4 * 33], s[5 * 33]); o.w = pk2(s[6 * 33], s[7 * 33]);
        __builtin_nontemporal_store(o, (v4u*)(x.dst + (size_t)n * x.ldk + 8 * c)); }
    LDS_WAIT(); asm volatile("" ::: "memory");
}
__device__ __forceinline__ void cvt_experts(const Frame& F, const float* wg, const float* wu, const float* wd, const float* sg, const float* su, const float* sd, unsigned char* ws, unsigned& gbase) {
    (void)gbase;
    LAS float* scr = (LAS float*)(F.lds + RING_OFF + F.wave * 8704);
    const int total = (NE + 1) * 1536;
    XItem A, B; f32x4 va[8], vb[8];
    int I = F.gw;
    if (I < total) { xp_decode(I, wg, wu, wd, sg, su, sd, ws, A); xp_load(A, F.lane, va); }
    for (; I < total; I += 2 * F.NGW) {
        const int I2 = I + F.NGW, I3 = I + 2 * F.NGW;
        if (I2 < total) { xp_decode(I2, wg, wu, wd, sg, su, sd, ws, B); xp_load(B, F.lane, vb); }
        xp_store(A, va, scr, F.lane);
        if (I2 < total) { if (I3 < total) { xp_decode(I3, wg, wu, wd, sg, su, sd, ws, A); xp_load(A, F.lane, va); }
            xp_store(B, vb, scr, F.lane); }
    }
}
constexpr int NVO_OFF = MISC_OFF + 1024;  static_assert(NVO_OFF == pg8::PG8_NVO_OFF, "nvo");
constexpr int PLAN_OFF = NVO_OFF + 8192;
constexpr int PLAN_TB = PLAN_OFF, PLAN_CN = PLAN_OFF + 66 * 4, PLAN_TE = PLAN_OFF + 132 * 4;
constexpr int MAXTILES = 640;
#ifndef ROUTE_PROBE
#define ROUTE_PROBE 0
#endif
static_assert(PLAN_TE + MAXTILES * 4 <= LDS_BYTES, "LDS map");

__device__ __forceinline__ float wave_sum(float v, int lane) {
#pragma unroll
    for (int o = 1; o < 64; o <<= 1) v += shx(v, o, lane);
    return v;
}
__device__ __forceinline__ void moe_plan(const Frame& F, const unsigned* cnt) {
    LAS unsigned* tb = (LAS unsigned*)(F.lds + PLAN_TB); LAS unsigned* cn = (LAS unsigned*)(F.lds + PLAN_CN); LAS unsigned* te = (LAS unsigned*)(F.lds + PLAN_TE);
    __syncthreads();
    if (F.wave == 0) {
        const unsigned c = __hip_atomic_load(cnt + F.lane, RLX_AGENT); const unsigned t = (c + 255u) >> 8; unsigned inc = t;
#pragma unroll
        for (int o = 1; o < 64; o <<= 1) { const unsigned v = (unsigned)__builtin_amdgcn_ds_bpermute((F.lane - o) << 2, (int)inc); if (F.lane >= o) inc += v; }
        tb[F.lane] = inc - t; cn[F.lane] = c;
        if (F.lane == 63) { tb[NE] = inc; cn[NE] = (unsigned)NTOK; tb[NE + 1] = inc + NTOK / 256; } }
    __syncthreads();
    for (int t = F.tid; t < MAXTILES; t += NWAVES * 64) { unsigned e = 0; for (int q = 1; q <= NE; ++q) if (tb[q] <= (unsigned)t) e = q; te[t] = e; }
    __syncthreads();
}
template <bool GU> struct MoeSched { static constexpr bool GATHER = GU;
    const LAS unsigned* tb; const LAS unsigned* cn; const LAS unsigned* te; int nunits, nN, G, c; const char* Abase; const char* Bbase; const int* list;
    __device__ __forceinline__ void init(const Frame& F, const void* A_, const void* B_, const int* list_) {
        tb = (const LAS unsigned*)(F.lds + PLAN_TB); cn = (const LAS unsigned*)(F.lds + PLAN_CN); te = (const LAS unsigned*)(F.lds + PLAN_TE);
        nN = GU ? 4 : 8; nunits = (int)tb[NE + 1] * nN; G = F.G; const int bx = blockIdx.x; c = (G % 8 == 0) ? (bx % 8) * (G / 8) + bx / 8 : bx;
        Abase = (const char*)A_; Bbase = (const char*)B_; list = list_; }
    __device__ __forceinline__ bool next(int i, Unit& u) const {
        constexpr int RUN = GU ? 2 : 1; const int hs = c + G * (i / RUN), per = nN / RUN;
        const int tile = hs / per, pn = (hs % per) * RUN + (i % RUN); if (tile * nN >= nunits) return false;
        const int e = (int)te[tile];
        u.pm = tile; u.pn = pn;
        if (GU) { u.A = Abase; u.B = Bbase + (size_t)e * WGU_E + (size_t)pn * 256 * D * 2; u.list = e < NE ? list + (size_t)e * LISTCAP : nullptr; u.m0 = (tile - (int)tb[e]) * 256; u.cnt = (int)cn[e]; }
        else { u.A = Abase + (size_t)tile * 256 * EH * 2; u.B = Bbase + (size_t)e * WDN_E + (size_t)pn * 256 * EH * 2; u.list = nullptr; u.m0 = 0; u.cnt = 0; }
        return true; }
    __device__ __forceinline__ int avload(const Unit& u, int h, int R) const { const int pos = u.m0 + h * 128 + R; const int pc = pos < u.cnt ? pos : (u.cnt > 0 ? u.cnt - 1 : 0); const int* lp = u.list ? u.list : list; return lp[pc]; }
    __device__ __forceinline__ unsigned avfin(const Unit& u, int h, int R, int C, int K_, int v) const { const int pos = u.m0 + h * 128 + R; int row = u.list ? v : pos; row = pos < u.cnt ? row : 0; return (unsigned)((row * K_ + C) * 2); }
    __device__ __forceinline__ unsigned avoff(const Unit& u, int h, int R, int C, int K_) const {
        if (GU) return avfin(u, h, R, C, K_, avload(u, h, R));
        else return (unsigned)(((h * 128 + R) * K_ + C) * 2); }
};
struct EpiSwiGLU { static constexpr bool PERM = true, INPLACE = false; bf16* H;
    __device__ __forceinline__ void operator()(const Acc& acc, const Unit& u, int wr, int wc, int fr, int fq) const {
        const int row0 = u.pm * 256 + wr * 64 + fr, col0 = u.pn * 128 + wc * 32 + 8 * fq;
#pragma unroll
        for (int ai = 0; ai < 2; ++ai)
#pragma unroll
            for (int m = 0; m < 4; ++m) { bf16* rowp = H + (size_t)(row0 + ai * 128 + m * 16) * EH + col0;
                float hv[8];
#pragma unroll
                for (int n = 0; n < 2; ++n)
#pragma unroll
                    for (int j = 0; j < 4; ++j) { const float g = acc[ai][0][m][n][j], uu = acc[ai][1][m][n][j]; hv[n * 4 + j] = g * pg8::sigmoidf_(g) * uu; }
                v4u w; w.x = pk2(hv[0], hv[1]); w.y = pk2(hv[2], hv[3]); w.z = pk2(hv[4], hv[5]); w.w = pk2(hv[6], hv[7]);
                *(v4u*)rowp = w; }
    }
};

struct EpiY8 { static constexpr bool PERM = true, INPLACE = false; unsigned char* Y8; bf16* YS;
    __device__ __forceinline__ void operator()(const Acc& acc, const Unit& u, int wr, int wc, int fr, int fq) const {
        const int row0 = u.pm * 256 + wr * 64 + fr, pos0 = u.pn * 256 + wc * 64 + fq * 16;
#pragma unroll
        for (int ai = 0; ai < 2; ++ai)
#pragma unroll
            for (int m = 0; m < 4; ++m) { const size_t row = (size_t)(row0 + ai * 128 + m * 16);
                v4u w; unsigned sw = 0u;
#pragma unroll
                for (int bj = 0; bj < 2; ++bj) { const f32x4 v0 = acc[ai][bj][m][0], v1 = acc[ai][bj][m][1];
                    const float am = fmaxf(fmaxf(fmaxf(fabsf(v0[0]), fabsf(v0[1])), fmaxf(fabsf(v0[2]), fabsf(v0[3]))), fmaxf(fmaxf(fabsf(v1[0]), fabsf(v1[1])), fmaxf(fabsf(v1[2]), fabsf(v1[3]))));
                    const unsigned sb = f2bf(am * (1.f / 127.f)); const float sc = __uint_as_float(sb << 16); const float inv = sc > 0.f ? __builtin_amdgcn_rcpf(sc) : 0.f;
                    unsigned q[8];
#pragma unroll
                    for (int j = 0; j < 4; ++j) { q[j] = (unsigned)fminf(rintf(v0[j] * inv + 128.f), 255.f); q[4 + j] = (unsigned)fminf(rintf(v1[j] * inv + 128.f), 255.f); }
                    const unsigned lo = q[0] | (q[1] << 8) | (q[2] << 16) | (q[3] << 24), hi = q[4] | (q[5] << 8) | (q[6] << 16) | (q[7] << 24);
                    if (bj == 0) { w.x = lo; w.y = hi; sw = sb; } else { w.z = lo; w.w = hi; sw |= sb << 16; } }
                *(v4u*)(Y8 + row * D + pos0) = w; *(unsigned*)(YS + row * (D / 8) + (pos0 >> 3)) = sw; }
    }
};
__device__ __forceinline__ void route_phase(const Frame& F, const bf16* __restrict__ Z, const float* __restrict__ g, const float* __restrict__ bb, const bf16* __restrict__ rwh, const float* __restrict__ rb,
                                            bf16* __restrict__ X1L, bf16* __restrict__ X1BF, unsigned* cnt, int* list, int* tokslot, float* tokw, bool dispatch = true) {
    LAS float* part = (LAS float*)(F.lds + RING_OFF);
    LAS float* lg = part + 4 * 4096;
    LAS float* sl = lg + 64 * 65;
    LAS unsigned* cntL = (LAS unsigned*)(sl + 64 * 65);
    LAS unsigned* baseL = cntL + 64;
    LAS unsigned* ee = baseL + 64;
    LAS unsigned* pl = ee + 512;
    LAS float* ww = (LAS float*)(pl + 512);
    for (int grp = blockIdx.x; grp < NTOK / 64; grp += F.G) {
        const int t0 = grp * 64;
        if (F.tid < 64) cntL[F.tid] = 0u;
        {
#define RT_LN_LOAD(Z, q_) do { const v2u* zr_ = (const v2u*)(Z_ + (size_t)(t0 + F.wave * 8 + (q_)) * D) + F.lane; _Pragma("unroll") for (int j = 0; j < 8; ++j) Z[j] = zr_[64 * j]; } while (0)
#define RT_LN_DO(Z, q_) do { const int t = t0 + F.wave * 8 + (q_); f32x4 v[8]; float s = 0.f; \
            _Pragma("unroll") for (int j = 0; j < 8; ++j) { const v2u zw = Z[j]; v[j] = (f32x4){pg8::bf_lo(zw.x), pg8::bf_hi(zw.x), pg8::bf_lo(zw.y), pg8::bf_hi(zw.y)}; s += (v[j][0] + v[j][1]) + (v[j][2] + v[j][3]); } \
            const float mean = wave_sum(s, F.lane) * (1.f / D); float s2 = 0.f; \
            _Pragma("unroll") for (int j = 0; j < 8; ++j) { v[j] = v[j] - mean; s2 += (v[j][0] * v[j][0] + v[j][1] * v[j][1]) + (v[j][2] * v[j][2] + v[j][3] * v[j][3]); } \
            const float rstd = 1.f / sqrtf(wave_sum(s2, F.lane) * (1.f / D) + LN_EPS); \
            v2u* xl = (v2u*)(X1L + (size_t)t * D) + F.lane; v2u* xb = (v2u*)(X1BF + (size_t)t * D) + F.lane; \
            _Pragma("unroll") for (int j = 0; j < 8; ++j) { const f32x4 gg = ((const f32x4*)g)[F.lane + 64 * j], bv = ((const f32x4*)bb)[F.lane + 64 * j]; \
                const f32x4 y = v[j] * rstd * gg + bv; v2u w; w.x = pk2(y[0], y[1]); w.y = pk2(y[2], y[3]); xb[64 * j] = w; \
                v2u lo; lo.x = pk2(y[0] - pg8::bf_lo(w.x), y[1] - pg8::bf_hi(w.x)); lo.y = pk2(y[2] - pg8::bf_lo(w.y), y[3] - pg8::bf_hi(w.y)); xl[64 * j] = lo; } } while (0)
            const bf16* Z_ = Z; v2u zA[8], zB[8];
            RT_LN_LOAD(zA, 0);
#pragma unroll 1
            for (int q = 0; q < 8; q += 2) {
                RT_LN_LOAD(zB, q + 1); __builtin_amdgcn_sched_barrier(0);
                RT_LN_DO(zA, q); __builtin_amdgcn_sched_barrier(0);
                if (q + 2 < 8) RT_LN_LOAD(zA, q + 2);
                __builtin_amdgcn_sched_barrier(0);
                RT_LN_DO(zB, q + 1); __builtin_amdgcn_sched_barrier(0);
            }
#undef RT_LN_LOAD
#undef RT_LN_DO
        }
        VM_WAIT(); __syncthreads();
        for (int rp_ = 0; rp_ < (ROUTE_PROBE == 2 ? 2 : 1); ++rp_)
        { const int r = F.lane & 15, kq = F.lane >> 4, kb = (F.wave & 3) * 512, th = F.wave >> 2;
          const bf16* xh = X1BF + (size_t)(t0 + th * 32 + r) * D + kb + 8 * kq;
          const bf16* xl = X1L + (size_t)(t0 + th * 32 + r) * D + kb + 8 * kq;
          const bf16* wh = rwh + (size_t)r * D + kb + 8 * kq;
          f32x4 acc[2][4];
#pragma unroll
          for (int tt = 0; tt < 2; ++tt)
#pragma unroll
              for (int nb = 0; nb < 4; ++nb) acc[tt][nb] = (f32x4){0.f, 0.f, 0.f, 0.f};
          bf16x8 xA[2][2], xB[2][2]; bf16x8 hA[4], lA[4], hB[4], lB[4];
#define RT_LOAD(X, H, L, ks) do { const int k_ = ((ks) < 16 ? (ks) : 15) * 32; _Pragma("unroll") for (int tt = 0; tt < 2; ++tt) { X[tt][0] = *(const bf16x8*)(xh + (size_t)tt * 16 * D + k_); X[tt][1] = *(const bf16x8*)(xl + (size_t)tt * 16 * D + k_); } \
              _Pragma("unroll") for (int nb = 0; nb < 4; ++nb) { H[nb] = *(const bf16x8*)(wh + (size_t)nb * 16 * D + k_); L[nb] = *(const bf16x8*)(wh + (size_t)(64 + nb * 16) * D + k_); } } while (0)
#define RT_MMA(X, H, L) do { \
              _Pragma("unroll") for (int tt = 0; tt < 2; ++tt) _Pragma("unroll") for (int nb = 0; nb < 4; ++nb) acc[tt][nb] = __builtin_amdgcn_mfma_f32_16x16x32_bf16(X[tt][1], H[nb], acc[tt][nb], 0, 0, 0); \
              _Pragma("unroll") for (int tt = 0; tt < 2; ++tt) _Pragma("unroll") for (int nb = 0; nb < 4; ++nb) acc[tt][nb] = __builtin_amdgcn_mfma_f32_16x16x32_bf16(X[tt][0], L[nb], acc[tt][nb], 0, 0, 0); \
              _Pragma("unroll") for (int tt = 0; tt < 2; ++tt) _Pragma("unroll") for (int nb = 0; nb < 4; ++nb) acc[tt][nb] = __builtin_amdgcn_mfma_f32_16x16x32_bf16(X[tt][0], H[nb], acc[tt][nb], 0, 0, 0); } while (0)
          RT_LOAD(xA, hA, lA, 0);
#pragma unroll 1
          for (int ks = 0; ks < 16; ks += 2) {
              RT_LOAD(xB, hB, lB, ks + 1); RT_MMA(xA, hA, lA);
              RT_LOAD(xA, hA, lA, ks + 2); RT_MMA(xB, hB, lB);
          }
#undef RT_LOAD
#undef RT_MMA
#pragma unroll
          for (int tt = 0; tt < 2; ++tt)
#pragma unroll
              for (int nb = 0; nb < 4; ++nb)
#pragma unroll
                  for (int reg = 0; reg < 4; ++reg) part[(F.wave & 3) * 4096 + (th * 32 + tt * 16 + 4 * kq + reg) * 64 + nb * 16 + r] = acc[tt][nb][reg];
        }
        __syncthreads();
        for (int i = F.tid; i < 64 * 64; i += NWAVES * 64) { const int tk = i >> 6, e = i & 63; const float lgt = (part[i] + part[4096 + i]) + (part[8192 + i] + part[12288 + i]);
            const float sc = 1.f / (1.f + __expf(-lgt)); lg[tk * 65 + e] = sc; sl[tk * 65 + e] = sc + rb[e]; }
        __syncthreads();
        for (int rp_ = 0; rp_ < (ROUTE_PROBE == 3 ? 2 : 1); ++rp_)
        { const bool lastrp = (rp_ == (ROUTE_PROBE == 3 ? 1 : 0));
          const int tk = F.wave * 8 + (F.lane >> 3), gq = F.lane & 7, lane = F.lane;
          float sv[8], cv[8];
#pragma unroll
          for (int j = 0; j < 8; ++j) { sv[j] = sl[tk * 65 + gq * 8 + j]; cv[j] = lg[tk * 65 + gq * 8 + j]; }
          float m1 = -INFINITY, m2 = -INFINITY;
#pragma unroll
          for (int j = 0; j < 8; ++j) { const float x = sv[j]; const bool g1 = x > m1; m2 = g1 ? m1 : fmaxf(m2, x); m1 = g1 ? x : m1; }
          const float gs = m1 + m2;
          int rank = 0;
#pragma unroll
          for (int o = 1; o < 8; ++o) { const float og = shx(gs, o, lane); const int oq = gq ^ o; rank += (og > gs || (og == gs && oq < gq)) ? 1 : 0; }
          const bool gsel = rank < 4;
          unsigned used = gsel ? 0u : 0xffu;
          float wsum = 0.f; float my_sc = 0.f; int my_e = 0;
#pragma unroll
          for (int i = 0; i < 8; ++i) {
              float bv = -INFINITY, bs = 0.f; int be = 64;
#pragma unroll
              for (int j = 0; j < 8; ++j) { const bool ok = !((used >> j) & 1u) && sv[j] > bv; bv = ok ? sv[j] : bv; bs = ok ? cv[j] : bs; be = ok ? gq * 8 + j : be; }
#pragma unroll
              for (int o = 1; o < 8; o <<= 1) { const float ov = shx(bv, o, lane), os = shx(bs, o, lane); const int oe = __float_as_int(shx(__int_as_float(be), o, lane));
                  const bool tk_o = ov > bv || (ov == bv && oe < be); bv = tk_o ? ov : bv; bs = tk_o ? os : bs; be = tk_o ? oe : be; }
              if ((be >> 3) == gq) used |= 1u << (be & 7);
              wsum += bs; if (gq == i) { my_sc = bs; my_e = be; }
          }
          const int slot = tk * 8 + gq;
          ee[slot] = (unsigned)my_e; ww[slot] = my_sc * (RSCALE / wsum);
          pl[slot] = __hip_atomic_fetch_add(cntL + my_e, (dispatch && lastrp) ? 1u : 0u, __ATOMIC_RELAXED, __HIP_MEMORY_SCOPE_WORKGROUP);
        }
        __syncthreads();
        if (F.tid < 64) { const unsigned n = cntL[F.tid]; baseL[F.tid] = n ? __hip_atomic_fetch_add(cnt + F.tid, n, RLX_AGENT) : 0u; }
        __syncthreads();
        if (dispatch) { const int tk = F.tid >> 3, i = F.tid & 7; const unsigned e = ee[F.tid]; const unsigned pos = baseL[e] + pl[F.tid]; const int t = t0 + tk;
          list[(size_t)e * LISTCAP + pos] = t; tokslot[t * 8 + i] = (int)(e * LISTCAP + pos); tokw[t * 8 + i] = ww[F.tid]; }
        __syncthreads();
    }
}
__device__ __forceinline__ void combine_phase(const Frame& F, const bf16* X1B, const unsigned char* Y8, const bf16* YS, const int* tokslot, const float* tokw, const float* g, const float* bb, float* OUT, bf16* XBF, bool last) {
    const LAS unsigned* tb = (const LAS unsigned*)(F.lds + PLAN_TB);
    LAS int* rw = (LAS int*)(F.lds + RING_OFF) + F.wave * 32;
#define CB_LOAD(W, S, ROW) do { const int r_ = __builtin_amdgcn_readfirstlane(ROW); const v2u* yr_ = (const v2u*)(Y8 + (size_t)r_ * D) + F.lane; const bf16* ys_ = YS + (size_t)r_ * (D / 8) + F.lane; \
        _Pragma("unroll") for (int j = 0; j < 4; ++j) { W[j] = yr_[64 * j]; S[j] = ys_[64 * j]; } } while (0)
#define CB_ACC(W, S, WT) do { const float wt_ = __int_as_float(__builtin_amdgcn_readfirstlane(WT)); _Pragma("unroll") for (int j = 0; j < 4; ++j) { const float sc = bf2f(S[j]) * wt_, c0 = -128.f * sc; const unsigned x = W[j].x, y = W[j].y; \
        v[j][0] += sc * (float)(x & 255u) + c0; v[j][1] += sc * (float)((x >> 8) & 255u) + c0; v[j][2] += sc * (float)((x >> 16) & 255u) + c0; v[j][3] += sc * (float)(x >> 24) + c0; \
        v[j][4] += sc * (float)(y & 255u) + c0; v[j][5] += sc * (float)((y >> 8) & 255u) + c0; v[j][6] += sc * (float)((y >> 16) & 255u) + c0; v[j][7] += sc * (float)(y >> 24) + c0; } } while (0)
    const int cl = (F.lane >> 5) * 256 + (F.lane & 1) * 128 + ((F.lane >> 3) & 3) * 32 + ((F.lane >> 1) & 3) * 8;
    f32x4 gq[4][2], bq[4][2];
#pragma unroll
    for (int j = 0; j < 4; ++j) { const int c0 = cl + 512 * j; gq[j][0] = *(const f32x4*)(g + c0); gq[j][1] = *(const f32x4*)(g + c0 + 4); bq[j][0] = *(const f32x4*)(bb + c0); bq[j][1] = *(const f32x4*)(bb + c0 + 4); }
    int nsl = 0; float nwt = 0.f;
    if (F.gw < NTOK && F.lane < 8) { nsl = tokslot[F.gw * 8 + F.lane]; nwt = tokw[F.gw * 8 + F.lane]; }
    for (int t = F.gw; t < NTOK; t += F.NGW) {
        v4u xw[4];
#pragma unroll
        for (int j = 0; j < 4; ++j) xw[j] = *(const v4u*)(X1B + (size_t)t * D + 512 * j + cl);
        if (F.lane < 8) { const int sl = nsl; rw[F.lane] = (int)tb[sl / LISTCAP] * 256 + (sl % LISTCAP); rw[16 + F.lane] = __float_as_int(nwt); }
        if (F.lane == 8) { rw[8] = (int)tb[NE] * 256 + t; rw[24] = __float_as_int(1.f); }
        LDS_WAIT(); asm volatile("" ::: "memory");
        float v[4][8]; float s = 0.f;
        v2u wa[4], wb[4], wc[4]; bf16 sa[4], sb2[4], sc2[4];
        CB_LOAD(wa, sa, rw[0]); CB_LOAD(wb, sb2, rw[1]); CB_LOAD(wc, sc2, rw[2]);
        { const int tn = t + F.NGW; if (tn < NTOK && F.lane < 8) { nsl = tokslot[tn * 8 + F.lane]; nwt = tokw[tn * 8 + F.lane]; } }
        __builtin_amdgcn_sched_barrier(0);
#pragma unroll
        for (int j = 0; j < 4; ++j) {
            v[j][0] = pg8::bf_lo(xw[j].x) * ALPHA; v[j][1] = pg8::bf_hi(xw[j].x) * ALPHA; v[j][2] = pg8::bf_lo(xw[j].y) * ALPHA; v[j][3] = pg8::bf_hi(xw[j].y) * ALPHA;
            v[j][4] = pg8::bf_lo(xw[j].z) * ALPHA; v[j][5] = pg8::bf_hi(xw[j].z) * ALPHA; v[j][6] = pg8::bf_lo(xw[j].w) * ALPHA; v[j][7] = pg8::bf_hi(xw[j].w) * ALPHA; }
#pragma unroll 1
        for (int i = 0; i < 9; i += 3) {
            CB_ACC(wa, sa, rw[16 + i]); if (i < 6) CB_LOAD(wa, sa, rw[i + 3]);
            CB_ACC(wb, sb2, rw[17 + i]); if (i < 6) CB_LOAD(wb, sb2, rw[i + 4]);
            CB_ACC(wc, sc2, rw[18 + i]); if (i < 6) CB_LOAD(wc, sc2, rw[i + 5]);
        }
        asm volatile("" ::: "memory");
#pragma unroll
        for (int j = 0; j < 4; ++j)
#pragma unroll
            for (int e = 0; e < 8; ++e) s += v[j][e];
        const float mean = wave_sum(s, F.lane) * (1.f / D); float s2 = 0.f;
#pragma unroll
        for (int j = 0; j < 4; ++j)
#pragma unroll
            for (int e = 0; e < 8; ++e) { v[j][e] -= mean; s2 += v[j][e] * v[j][e]; }
        const float rstd = 1.f / sqrtf(wave_sum(s2, F.lane) * (1.f / D) + LN_EPS);
#pragma unroll
        for (int j = 0; j < 4; ++j) { const int c0 = cl + 512 * j; const f32x4 g0 = gq[j][0], g1 = gq[j][1], b0 = bq[j][0], b1 = bq[j][1];
            f32x4 y0, y1;
#pragma unroll
            for (int e = 0; e < 4; ++e) { y0[e] = v[j][e] * rstd * g0[e] + b0[e]; y1[e] = v[j][4 + e] * rstd * g1[e] + b1[e]; }
            if (last) { *(f32x4*)(OUT + (size_t)t * D + c0) = y0; *(f32x4*)(OUT + (size_t)t * D + c0 + 4) = y1; }
            else { v4u w; w.x = pk2(y0[0], y0[1]); w.y = pk2(y0[2], y0[3]); w.z = pk2(y1[0], y1[1]); w.w = pk2(y1[2], y1[3]); *(v4u*)(XBF + (size_t)t * D + c0) = w; } }
    }
#undef CB_LOAD
#undef CB_ACC
}
constexpr size_t R2_UT = 0, R2_OI = 48 * MiB, R2_QP = 96 * MiB, R2_DEC = 120 * MiB;
constexpr int NHU = NB * HGH * (SEQ / 64);
typedef __attribute__((address_space(3))) bf16 lbf16;
__device__ __forceinline__ void unpack8(const v4u w, float (&f)[8]) {
    f[0] = pg8::bf_lo(w.x); f[1] = pg8::bf_hi(w.x); f[2] = pg8::bf_lo(w.y); f[3] = pg8::bf_hi(w.y); f[4] = pg8::bf_lo(w.z); f[5] = pg8::bf_hi(w.z); f[6] = pg8::bf_lo(w.w); f[7] = pg8::bf_hi(w.w); }
__device__ __forceinline__ float exp_c(float x) { return __expf(fminf(x, 80.f)); }

__device__ __forceinline__ void conv_part(const Frame& F, const bf16* proj, const float* cw, bf16* YA, bf16* YX) {
    for (int i = blockIdx.x * 512 + F.tid; i < NTOK * 32; i += F.G * 512) *(v4u*)(YX + (size_t)(i >> 5) * YXW + XAW + (i & 31) * 8) = (v4u){0u, 0u, 0u, 0u};
    for (int i = blockIdx.x * 512 + F.tid; i < (NTOK / 4) * (CW / 8); i += F.G * 512) {
        const int t0 = (i / (CW / 8)) * 4, c = (i % (CW / 8)) * 8, pos0 = t0 & (SEQ - 1);
        const bf16* r = proj + (size_t)t0 * INC;
        const v4u z4 = {0u, 0u, 0u, 0u};
        v4u uw[6], cw4[6], bw[4]; f32x4 wq[6];
#pragma unroll
        for (int k = 0; k < 6; ++k) { const bool ok = pos0 + k - 2 >= 0; uw[k] = ok ? *(const v4u*)(r + (ptrdiff_t)(k - 2) * INC + C_U + c) : z4; cw4[k] = ok ? *(const v4u*)(r + (ptrdiff_t)(k - 2) * INC + C_C + c) : z4; }
#pragma unroll
        for (int k = 0; k < 4; ++k) bw[k] = *(const v4u*)(r + (size_t)k * INC + C_B + c);
#pragma unroll
        for (int q = 0; q < 3; ++q) { wq[2 * q] = *(const f32x4*)(cw + q * CW + c); wq[2 * q + 1] = *(const f32x4*)(cw + q * CW + c + 4); }
        __builtin_amdgcn_sched_barrier(0);
        float P[6][8];
#pragma unroll
        for (int k = 0; k < 6; ++k) { float uu[8], cc[8]; unpack8(uw[k], uu); unpack8(cw4[k], cc);
#pragma unroll
            for (int j = 0; j < 8; ++j) P[k][j] = cc[j] * uu[j]; }
#pragma unroll
        for (int k = 0; k < 4; ++k) { float bb_[8], o[8]; unpack8(bw[k], bb_);
#pragma unroll
            for (int j = 0; j < 8; ++j) { const float w0 = wq[j >> 2][j & 3], w1 = wq[2 + (j >> 2)][j & 3], w2 = wq[4 + (j >> 2)][j & 3]; o[j] = bb_[j] * (w2 * P[k + 2][j] + w1 * P[k + 1][j] + w0 * P[k][j]); }
            v4u w; w.x = pk2(o[0], o[1]); w.y = pk2(o[2], o[3]); w.z = pk2(o[4], o[5]); w.w = pk2(o[6], o[7]);
            *(v4u*)(YA + (size_t)(t0 + k) * CW + c) = w; }
    }
}

__device__ __forceinline__ void hgrn_local(const Frame& F, const bf16* proj, const float* lbl, int layer, unsigned char* r2) {
    lbf16* QS = (lbf16*)(F.lds);
    lbf16* KS = QS + 64 * 136;
    lbf16* KPT = KS + 64 * 136;
    lbf16* VT = KPT + 128 * 72;
    lbf16* PS = VT + 128 * 72;
    LAS float* SEG = (LAS float*)(PS + 64 * 72);
    bf16* UT = (bf16*)(r2 + R2_UT); bf16* OI = (bf16*)(r2 + R2_OI); bf16* QP = (bf16*)(r2 + R2_QP); float* DEC = (float*)(r2 + R2_DEC);
    const int lane = F.lane, wv = F.wave, r = lane & 15, kq = lane >> 4;
    bf16 rf[16], rq[16], rv[16];
#define HL_LOAD(U) do { const int b_ = (U) / (HGH * 64), h_ = ((U) / 64) % HGH, c_ = (U) % 64; const bf16* p_ = proj + (size_t)(b_ * SEQ + c_ * 64 + (F.tid >> 7) * 16) * INC + h_ * HGD + (F.tid & 127); \
        _Pragma("unroll") for (int i = 0; i < 16; ++i) { rf[i] = p_[(size_t)i * INC + C_F]; rq[i] = p_[(size_t)i * INC + C_Q]; rv[i] = p_[(size_t)i * INC + C_I]; } } while (0)
    if ((int)blockIdx.x < NHU) HL_LOAD((int)blockIdx.x);
    for (int unit = blockIdx.x; unit < NHU; unit += F.G) {
        const int b = unit / (HGH * 64), h = (unit / 64) % HGH, c = unit % 64, t0 = b * SEQ + c * 64;
        { const int col = F.tid & 127, seg = F.tid >> 7, ch = h * HGD + col;
          float lb = 0.f; if (layer == 1) lb = 1.f / (1.f + __expf(lbl[ch] - lbl[HGW + ch]));
          float a[16], kk[16], qv[16], vv[16]; float run = 0.f;
#pragma unroll
          for (int i = 0; i < 16; ++i) {
              const float z = bf2f(rf[i]); const float ez = __expf(-z); const float sg = 1.f / (1.f + ez);
              const float f = lb + (1.f - lb) * sg; kk[i] = (1.f - lb) * ez * sg; run += fmaxf(__logf(f), -60.f); a[i] = run;
              qv[i] = bf2f(rq[i]); vv[i] = bf2f(rv[i]); }
          if (unit + F.G < NHU) HL_LOAD(unit + F.G);
          SEG[seg * 128 + col] = run;
          __syncthreads();
          const float s0 = SEG[col], s1 = SEG[128 + col], s2 = SEG[256 + col], s3 = SEG[384 + col];
          const float base = seg == 0 ? 0.f : (seg == 1 ? s0 : (seg == 2 ? s0 + s1 : s0 + s1 + s2)), bm = s0 + s1, bl = (s0 + s1) + (s2 + s3);
          float kp[16];
#pragma unroll
          for (int i = 0; i < 16; ++i) { const float bb = base + a[i]; const int t = seg * 16 + i;
              QS[t * 136 + col] = f2bf(qv[i] * exp_c(bb - bm)); KS[t * 136 + col] = f2bf(kk[i] * exp_c(bm - bb)); kp[i] = kk[i] * exp_c(bl - bb);
              QP[(size_t)(t0 + t) * HGW + ch] = f2bf(qv[i] * exp_c(bb)); }
          v4u w0, w1; w0.x = pk2(kp[0], kp[1]); w0.y = pk2(kp[2], kp[3]); w0.z = pk2(kp[4], kp[5]); w0.w = pk2(kp[6], kp[7]); w1.x = pk2(kp[8], kp[9]); w1.y = pk2(kp[10], kp[11]); w1.z = pk2(kp[12], kp[13]); w1.w = pk2(kp[14], kp[15]);
          *(LAS v4u*)(KPT + col * 72 + seg * 16) = w0; *(LAS v4u*)(KPT + col * 72 + seg * 16 + 8) = w1;
          w0.x = pk2(vv[0], vv[1]); w0.y = pk2(vv[2], vv[3]); w0.z = pk2(vv[4], vv[5]); w0.w = pk2(vv[6], vv[7]); w1.x = pk2(vv[8], vv[9]); w1.y = pk2(vv[10], vv[11]); w1.z = pk2(vv[12], vv[13]); w1.w = pk2(vv[14], vv[15]);
          *(LAS v4u*)(VT + col * 72 + seg * 16) = w0; *(LAS v4u*)(VT + col * 72 + seg * 16 + 8) = w1;
          if (seg == 0) DEC[(size_t)unit * 128 + col] = exp_c(bl);
        }
        __syncthreads();
        { const int tm = wv >> 1, tn0 = (wv & 1) * 2;
          bf16x8 af[4];
#pragma unroll
          for (int ks = 0; ks < 4; ++ks) af[ks] = *(const LAS bf16x8*)(QS + (tm * 16 + r) * 136 + ks * 32 + kq * 8);
#pragma unroll
          for (int jn = 0; jn < 2; ++jn) { const int tn = tn0 + jn; f32x4 acc = {0.f, 0.f, 0.f, 0.f};
              if (tn <= tm) {
#pragma unroll
                  for (int ks = 0; ks < 4; ++ks) { const bf16x8 bf = *(const LAS bf16x8*)(KS + (tn * 16 + r) * 136 + ks * 32 + kq * 8); acc = __builtin_amdgcn_mfma_f32_16x16x32_bf16(af[ks], bf, acc, 0, 0, 0); } }
#pragma unroll
              for (int g = 0; g < 4; ++g) { const int t = tm * 16 + 4 * kq + g, s = tn * 16 + r; PS[t * 72 + s] = f2bf(s <= t ? acc[g] : 0.f); } } }
        { bf16x8 af[2];
#pragma unroll
          for (int ks = 0; ks < 2; ++ks) af[ks] = *(const LAS bf16x8*)(KPT + (wv * 16 + r) * 72 + ks * 32 + kq * 8);
#pragma unroll
          for (int tv = 0; tv < 8; ++tv) { f32x4 acc = {0.f, 0.f, 0.f, 0.f};
#pragma unroll
              for (int ks = 0; ks < 2; ++ks) { const bf16x8 bf = *(const LAS bf16x8*)(VT + (tv * 16 + r) * 72 + ks * 32 + kq * 8); acc = __builtin_amdgcn_mfma_f32_16x16x32_bf16(af[ks], bf, acc, 0, 0, 0); }
              v2u w; w.x = pk2(acc[0], acc[1]); w.y = pk2(acc[2], acc[3]);
              *(v2u*)(UT + (size_t)unit * 16384 + (tv * 16 + r) * 128 + wv * 16 + 4 * kq) = w; } }
        __syncthreads();
        { const int tm = wv & 3, tvg = wv >> 2;
          bf16x8 pf[2];
#pragma unroll
          for (int ks = 0; ks < 2; ++ks) pf[ks] = *(const LAS bf16x8*)(PS + (tm * 16 + r) * 72 + ks * 32 + kq * 8);
#pragma unroll
          for (int j = 0; j < 4; ++j) { const int tv = tvg * 4 + j; f32x4 acc = {0.f, 0.f, 0.f, 0.f};
#pragma unroll
              for (int ks = 0; ks < 2; ++ks) { const bf16x8 vf = *(const LAS bf16x8*)(VT + (tv * 16 + r) * 72 + ks * 32 + kq * 8); acc = __builtin_amdgcn_mfma_f32_16x16x32_bf16(vf, pf[ks], acc, 0, 0, 0); }
              v2u ow; ow.x = pk2(acc[0], acc[1]); ow.y = pk2(acc[2], acc[3]); *(v2u*)(OI + (size_t)(t0 + tm * 16 + r) * HGW + h * HGD + tv * 16 + 4 * kq) = ow; } }
        __syncthreads();
    }
#undef HL_LOAD
}
__device__ __forceinline__ void hgrn_scan(const Frame& F, const unsigned char* r2, v2u* __restrict__ SB64) {
    const v2u* __restrict__ UT64 = (const v2u*)(r2 + R2_UT); const f32x4* __restrict__ DEC4 = (const f32x4*)(r2 + R2_DEC);
    for (int it = blockIdx.x * 512 + F.tid; it < NB * HGH * 128 * 32; it += F.G * 512) {
        const int bh = it >> 12, v = (it >> 5) & 127, k4 = it & 31;
        f32x4 s = {0.f, 0.f, 0.f, 0.f};
#pragma unroll 16
        for (int c = 0; c < 64; ++c) { const size_t unit = (size_t)bh * 64 + c; const size_t idx = unit * 4096 + v * 32 + k4;
            const v2u w = UT64[idx]; const f32x4 d = DEC4[unit * 32 + k4];
            v2u o; o.x = pk2(s[0], s[1]); o.y = pk2(s[2], s[3]); SB64[idx] = o;
            s[0] = d[0] * s[0] + pg8::bf_lo(w.x); s[1] = d[1] * s[1] + pg8::bf_hi(w.x); s[2] = d[2] * s[2] + pg8::bf_lo(w.y); s[3] = d[3] * s[3] + pg8::bf_hi(w.y); }
    }
}
struct HoutOps { bf16x8 af[4]; bf16x8 bfr[4][4]; };
__device__ __forceinline__ void hout_load(HoutOps& O, int unit, const bf16* proj, const bf16* OI, const bf16* QP, const bf16* SB, int r, int kq, int tm, int tvg) {
    const int b = unit / (HGH * 64), h = (unit / 64) % HGH, c = unit % 64, t0 = b * SEQ + c * 64;
#pragma unroll
    for (int ks = 0; ks < 4; ++ks) O.af[ks] = *(const bf16x8*)(QP + (size_t)(t0 + tm * 16 + r) * HGW + h * HGD + ks * 32 + kq * 8);
#pragma unroll
    for (int j = 0; j < 4; ++j)
#pragma unroll
        for (int ks = 0; ks < 4; ++ks) O.bfr[j][ks] = *(const bf16x8*)(SB + (size_t)unit * 16384 + ((tvg * 4 + j) * 16 + r) * 128 + ks * 32 + kq * 8);
}
__device__ __forceinline__ void hout_compute(const HoutOps& O, int unit, const bf16* proj, const bf16* OI, LAS float* SSQ, const float* gain, bf16* YB, int lane, int r, int kq, int tm, int tvg) {
    const int b = unit / (HGH * 64), h = (unit / 64) % HGH, c = unit % 64, t0 = b * SEQ + c * 64;
    const size_t t = (size_t)(t0 + tm * 16 + r);
    f32x4 oi[4]; v2u gtw[4];
#pragma unroll
    for (int j = 0; j < 4; ++j) { const int ch = h * HGD + (tvg * 4 + j) * 16 + 4 * kq; { const v2u ow = *(const v2u*)(OI + t * HGW + ch); oi[j] = (f32x4){pg8::bf_lo(ow.x), pg8::bf_hi(ow.x), pg8::bf_lo(ow.y), pg8::bf_hi(ow.y)}; } gtw[j] = *(const v2u*)(proj + t * INC + C_G + ch); }
    f32x4 acc[4]; float q = 0.f;
#pragma unroll
    for (int j = 0; j < 4; ++j) { acc[j] = (f32x4){0.f, 0.f, 0.f, 0.f};
#pragma unroll
        for (int ks = 0; ks < 4; ++ks) acc[j] = __builtin_amdgcn_mfma_f32_16x16x32_bf16(O.bfr[j][ks], O.af[ks], acc[j], 0, 0, 0); }
#pragma unroll
    for (int j = 0; j < 4; ++j) { acc[j] += oi[j]; q += (acc[j][0] * acc[j][0] + acc[j][1] * acc[j][1]) + (acc[j][2] * acc[j][2] + acc[j][3] * acc[j][3]); }
    q += shx(q, 16, lane); q += shx(q, 32, lane);
    if (kq == 0) SSQ[tvg * 64 + tm * 16 + r] = q;
    __syncthreads();
    const float rs = rsqrtf((SSQ[tm * 16 + r] + SSQ[64 + tm * 16 + r]) * (1.f / 128.f) + RMS_EPS);
#pragma unroll
    for (int j = 0; j < 4; ++j) { const int ch = h * HGD + (tvg * 4 + j) * 16 + 4 * kq; const f32x4 gn = *(const f32x4*)(gain + ch);
        const float g0 = pg8::bf_lo(gtw[j].x), g1 = pg8::bf_hi(gtw[j].x), g2 = pg8::bf_lo(gtw[j].y), g3 = pg8::bf_hi(gtw[j].y);
        v2u w; w.x = pk2(acc[j][0] * rs * gn[0] * g0 * pg8::sigmoidf_(g0), acc[j][1] * rs * gn[1] * g1 * pg8::sigmoidf_(g1));
        w.y = pk2(acc[j][2] * rs * gn[2] * g2 * pg8::sigmoidf_(g2), acc[j][3] * rs * gn[3] * g3 * pg8::sigmoidf_(g3));
        *(v2u*)(YB + t * HGW + ch) = w; }
    __syncthreads();
}
__device__ __forceinline__ void hgrn_out(const Frame& F, const bf16* proj, const unsigned char* r2, const bf16* SB, const float* gain, bf16* YB) {
    LAS float* SSQ = (LAS float*)F.lds;
    const bf16* OI = (const bf16*)(r2 + R2_OI); const bf16* QP = (const bf16*)(r2 + R2_QP);
    const int lane = F.lane, wv = F.wave, r = lane & 15, kq = lane >> 4, tm = wv & 3, tvg = wv >> 2;
    HoutOps A, B;
    int unit = blockIdx.x;
    if (unit < NHU) hout_load(A, unit, proj, OI, QP, SB, r, kq, tm, tvg);
    for (; unit < NHU; unit += 2 * F.G) {
        const int u2 = unit + F.G, u3 = unit + 2 * F.G;
        if (u2 < NHU) hout_load(B, u2, proj, OI, QP, SB, r, kq, tm, tvg);
        hout_compute(A, unit, proj, OI, SSQ, gain, YB, lane, r, kq, tm, tvg);
        if (u2 < NHU) { if (u3 < NHU) hout_load(A, u3, proj, OI, QP, SB, r, kq, tm, tvg);
            hout_compute(B, u2, proj, OI, SSQ, gain, YB, lane, r, kq, tm, tvg); }
    }
}
__device__ __forceinline__ void memattn(const Frame& F, const bf16* proj, const bf16* KV, int layer, bf16* YX) {
    lbf16* Ks = (lbf16*)F.lds;
    lbf16* VTs = Ks + 256 * 136;
    const int lane = F.lane, wv = F.wave, r = lane & 15, kq = lane >> 4;
    for (int unit = blockIdx.x; unit < NB * XAH * (SEQ / 256); unit += F.G) {
        const int b = unit >> 6, hd = (unit >> 4) & 3, qt = unit & 15;
        {
            v4u kw[8], vw[8];
#pragma unroll
            for (int i = 0; i < 8; ++i) { const int p = F.tid + 512 * i, key = p >> 4, dc = (p & 15) * 8;
                const bf16* src = KV + (size_t)(b * NMEM + key) * 2048 + layer * 1024 + hd * XAD + dc;
                kw[i] = *(const v4u*)src; vw[i] = *(const v4u*)(src + 512); }
            __builtin_amdgcn_sched_barrier(0);
#pragma unroll
            for (int i = 0; i < 8; ++i) { const int p = F.tid + 512 * i, key = p >> 4, dc = (p & 15) * 8;
                *(LAS v4u*)(Ks + key * 136 + dc) = kw[i];
                const v4u w = vw[i];
                const int k5 = key & 31, pos = (key & ~31) + 8 * ((k5 >> 2) & 3) + 4 * ((k5 >> 4) & 1) + (k5 & 3);
                lbf16* d = VTs + dc * 264 + pos;
                d[0] = (bf16)(w.x & 0xffffu); d[264] = (bf16)(w.x >> 16); d[2 * 264] = (bf16)(w.y & 0xffffu); d[3 * 264] = (bf16)(w.y >> 16);
                d[4 * 264] = (bf16)(w.z & 0xffffu); d[5 * 264] = (bf16)(w.z >> 16); d[6 * 264] = (bf16)(w.w & 0xffffu); d[7 * 264] = (bf16)(w.w >> 16); }
        }
        __syncthreads();
#pragma unroll 1
        for (int g = 0; g < 2; ++g) {
            const int t = b * SEQ + qt * 256 + wv * 32 + g * 16 + r;
            bf16x8 qf[4];
#pragma unroll
            for (int ks = 0; ks < 4; ++ks) qf[ks] = *(const bf16x8*)(proj + (size_t)t * INC + C_QX + hd * XAD + ks * 32 + kq * 8);
            f32x4 s[16];
#pragma unroll
            for (int kt = 0; kt < 16; ++kt) { s[kt] = (f32x4){0.f, 0.f, 0.f, 0.f};
#pragma unroll
                for (int ks = 0; ks < 4; ++ks) { const bf16x8 a = *(const LAS bf16x8*)(Ks + (kt * 16 + r) * 136 + ks * 32 + kq * 8); s[kt] = __builtin_amdgcn_mfma_f32_16x16x32_bf16(a, qf[ks], s[kt], 0, 0, 0); }
                if (kt & 1) __builtin_amdgcn_sched_barrier(0); }
            float m = -1e30f;
#pragma unroll
            for (int kt = 0; kt < 16; ++kt) m = fmaxf(m, fmaxf(fmaxf(s[kt][0], s[kt][1]), fmaxf(s[kt][2], s[kt][3])));
            m = fmaxf(m, shx(m, 16, lane)); m = fmaxf(m, shx(m, 32, lane));
            const float cs = 0.08838834764831845f * 1.4426950408889634f; float l = 0.f;
#pragma unroll
            for (int kt = 0; kt < 16; ++kt)
#pragma unroll
                for (int e = 0; e < 4; ++e) { const float p = __builtin_amdgcn_exp2f((s[kt][e] - m) * cs); s[kt][e] = p; l += p; }
            l += shx(l, 16, lane); l += shx(l, 32, lane);
            f32x4 o[8];
#pragma unroll
            for (int dt = 0; dt < 8; ++dt) o[dt] = (f32x4){0.f, 0.f, 0.f, 0.f};
#pragma unroll
            for (int j = 0; j < 8; ++j) {
                v4u pw; pw.x = pk2(s[2 * j][0], s[2 * j][1]); pw.y = pk2(s[2 * j][2], s[2 * j][3]); pw.z = pk2(s[2 * j + 1][0], s[2 * j + 1][1]); pw.w = pk2(s[2 * j + 1][2], s[2 * j + 1][3]);
                const bf16x8 pf = __builtin_bit_cast(bf16x8, pw);
#pragma unroll
                for (int dt = 0; dt < 8; ++dt) { const bf16x8 a = *(const LAS bf16x8*)(VTs + (dt * 16 + r) * 264 + j * 32 + kq * 8); o[dt] = __builtin_amdgcn_mfma_f32_16x16x32_bf16(a, pf, o[dt], 0, 0, 0); }
                __builtin_amdgcn_sched_barrier(0); }
            const float inv = 1.f / l;
#pragma unroll
            for (int dt = 0; dt < 8; ++dt) { v2u w; w.x = pk2(o[dt][0] * inv, o[dt][1] * inv); w.y = pk2(o[dt][2] * inv, o[dt][3] * inv);
                *(v2u*)(YX + (size_t)t * YXW + hd * XAD + dt * 16 + 4 * kq) = w; }
        }
        __syncthreads();
    }
}
struct Args { const float* in[24]; float* out; unsigned char* ws; int ph_lo, ph_hi, mask, pad; };
typedef const __attribute__((address_space(4))) Args* KArgs;
__device__ __forceinline__ KArgs kargs() { KArgs p = (KArgs)__builtin_amdgcn_kernarg_segment_ptr(); asm volatile("" : "+s"(p)); return p; }
#define WSP(T, off) ((T*)(ws + (off)))
__global__ void __launch_bounds__(NWAVES * 64, 2) mk_fwd(Args args) {
    extern __shared__ __attribute__((aligned(16))) unsigned char lds_raw[];
    Frame F0; F0.lds = (LAS unsigned char*)lds_raw; F0.tid = threadIdx.x; F0.lane = F0.tid & 63; F0.wave = __builtin_amdgcn_readfirstlane(F0.tid >> 6);
    F0.G = gridDim.x; F0.gw = blockIdx.x * NWAVES + F0.wave; F0.NGW = F0.G * NWAVES;
    volatile LAS unsigned* MISC = (volatile LAS unsigned*)(F0.lds + MISC_OFF);
    for (int u = F0.tid; u < (LDS_BYTES - MISC_OFF) / 4; u += NWAVES * 64) ((LAS unsigned*)(F0.lds + MISC_OFF))[u] = 0u;
    __syncthreads();
    const int lo = args.ph_lo, hi = args.ph_hi;
    const bool multi = (hi - lo) > 1;
    XcdBarrier bar; bar.bar = (unsigned*)(args.ws + WS_CTL) + CW_BAR; bar.x = 0; bar.st = nullptr;
    if (multi) bar = xcd_barrier_post((unsigned*)(args.ws + WS_CTL) + CW_BAR, MISC + 8);
#define IN(k) (kargs()->ph_lo <= (k) && (k) < kargs()->ph_hi)
#define SEAM(k) do { if (IN((k) + 1)) xcd_barrier(bar); } while (0)
#define PH_BEGIN KArgs ka = kargs(); unsigned char* ws = ka->ws; (void)ws; Frame F = F0; { int w_ = F0.wave; asm volatile("" : "+s"(w_)); F.wave = w_; F.gw = (int)blockIdx.x * NWAVES + w_; } F.lane = pg8::lane_id_opaque(); F.tid = F.wave * 64 + F.lane
    if (IN(PH_CVT)) {
        { PH_BEGIN;
        unsigned gb = 0;
        for (int l = 0; l < 2; ++l) {
            xpose_matrix(F, ka->in[2] + (size_t)l * D * INC, D, INC, (bf16*)(ws + WS_WIN_T + l * WIN_T_L), D, 0, gb);
            xpose_matrix(F, ka->in[4] + (size_t)l * CW * D, CW, D, (bf16*)(ws + WS_WBR_T + l * WBR_T_L), CW, 0, gb);
            xpose_matrix(F, ka->in[7] + (size_t)l * HGW * D, HGW, D, (bf16*)(ws + WS_WBR_T + l * WBR_T_L + 3 * MiB), HGW, 0, gb);
            xpose_matrix(F, ka->in[10] + (size_t)l * XAW * D, XAW, D, (bf16*)(ws + WS_WBR_T + l * WBR_T_L + 6 * MiB), YXW, 0, gb);
            for (int i = blockIdx.x * 512 + F.tid; i < D * 32; i += F.G * 512) *(v4u*)((bf16*)(ws + WS_WBR_T + l * WBR_T_L + 6 * MiB) + (size_t)(i >> 5) * YXW + XAW + (i & 31) * 8) = (v4u){0u, 0u, 0u, 0u};
            xpose_matrix(F, ka->in[11] + (size_t)l * D * D, D, D, (bf16*)(ws + WS_WO_T + l * WO_T_L), D, 0, gb);
            xpose_matrix(F, ka->in[8] + (size_t)l * D * XAW, D, XAW, (bf16*)(ws + WS_WKV_T) + (size_t)(l * 1024) * D, D, 0, gb);
            xpose_matrix(F, ka->in[9] + (size_t)l * D * XAW, D, XAW, (bf16*)(ws + WS_WKV_T) + (size_t)(l * 1024 + 512) * D, D, 0, gb);
        }
        cvt_router(F, ka->in[14], ws);
        cvt_rows(F, ka->in[0], WSP(bf16, WS_XBF), (size_t)NTOK * D / 8);
        cvt_rows(F, ka->in[1], WSP(bf16, WS_MEMBF), (size_t)NB * NMEM * D / 8);
        }
        SEAM(PH_CVT);
    }
    for (int l = 0; l < 2; ++l) {
        const int pb = PH_L0 + l * PH_PER_LAYER;
        if (IN(pb + P_INPROJ)) {
            { PH_BEGIN;
            const bool split = F.G == 256;
            const int oa = (int)blockIdx.x >> 3, ox = (int)blockIdx.x & 7; const bool conv = split && ox < 2;
            const int hrank = 2 * oa + ox, grank = oa;
            static_assert((256 - NCV) * GM_UNITS + NCV * CV_UNITS == (NTOK / 256) * (INC / 256), "in-projection unit shares");
            if (conv) { Frame Fc = F; Fc.gw = hrank * NWAVES + F.wave; Fc.NGW = NCV * NWAVES; unsigned gb = 0;
                cvt_experts(Fc, ka->in[16] + (size_t)l * NE * D * EH, ka->in[17] + (size_t)l * NE * D * EH, ka->in[18] + (size_t)l * NE * EH * D, ka->in[19] + (size_t)l * D * EH, ka->in[20] + (size_t)l * D * EH, ka->in[21] + (size_t)l * EH * D, ws, gb);
                __syncthreads(); }
            if (!split) { unsigned gb = 0; cvt_experts(F, ka->in[16] + (size_t)l * NE * D * EH, ka->in[17] + (size_t)l * NE * D * EH, ka->in[18] + (size_t)l * NE * EH * D, ka->in[19] + (size_t)l * D * EH, ka->in[20] + (size_t)l * D * EH, ka->in[21] + (size_t)l * EH * D, ws, gb); __syncthreads(); }
            DenseSched S; S.init(ws + WS_XBF, ws + WS_WIN_T + l * WIN_T_L, NTOK, INC, D, F.G, (int)blockIdx.x);
            if (split) { S.lin = 1; S.cnt = conv ? CV_UNITS : GM_UNITS;
                if (conv) { S.L0 = (256 - NCV) * GM_UNITS; S.G = NCV; S.c = hrank; } else { S.L0 = (ox - 2) * 32 * GM_UNITS; S.G = 32; S.c = grank; } }
            EpiProj E{WSP(bf16, WS_R1), WSP(unsigned char, WS_GATE8)};
            pg8::gemm_phase<EpiProj, DenseSched, true>(F.lds + RING_OFF, F.wave, D, S, E);
            if (l == 0) {
                DenseSched S2; S2.init(ws + WS_MEMBF, ws + WS_WKV_T, NB * NMEM, 2048, D, split ? 32 : F.G, split ? ((conv && hrank < 32) ? hrank : -1) : (int)blockIdx.x);
                EpiBf16Plain E2{WSP(bf16, WS_KV), 2048};
                pg8::gemm_phase<EpiBf16Plain, DenseSched, true>(F.lds + RING_OFF, F.wave, D, S2, E2);
            }
            }
            SEAM(pb + P_INPROJ);
        }
        if (IN(pb + P_MIX)) {
            { PH_BEGIN;
            memattn(F, WSP(bf16, WS_R1), WSP(bf16, WS_KV), l, WSP(bf16, WS_YX));
            hgrn_local(F, WSP(bf16, WS_R1), ka->in[5], l, ws + WS_R2);
            conv_part(F, WSP(bf16, WS_R1), ka->in[3] + (size_t)l * 3 * CW, WSP(bf16, WS_YA), WSP(bf16, WS_YX));
            }
            SEAM(pb + P_MIX);
        }
        if (IN(pb + P_SCAN)) {
            { PH_BEGIN;
            hgrn_scan(F, ws + WS_R2, WSP(v2u, WS_ZF));
            }
            SEAM(pb + P_SCAN);
        }
        if (IN(pb + P_HOUT)) {
            { PH_BEGIN;
            hgrn_out(F, WSP(bf16, WS_R1), ws + WS_R2, WSP(bf16, WS_ZF), ka->in[6] + (size_t)l * HGW, WSP(bf16, WS_YB));
            }
            SEAM(pb + P_HOUT);
        }
        if (IN(pb + P_BRANCH)) {
            { PH_BEGIN;
            static_assert(WS_YX - WS_YB == WS_YB - WS_YA, "branch inputs equally spaced");
            BranchSched S; S.init(ws + WS_YA, ws + WS_WBR_T + l * WBR_T_L, F.G, (int)blockIdx.x); EpiGateRT E{WSP(unsigned char, WS_GATE8), WSP(bf16, WS_MERGED)};
            pg8::gemm_phase<EpiGateRT, BranchSched, true>(F.lds + RING_OFF, F.wave, CW, S, E);
            }
            SEAM(pb + P_BRANCH);
        }
        if (IN(pb + P_WO)) {
            { PH_BEGIN;
            DenseSched S; S.init(ws + WS_MERGED, ws + WS_WO_T + l * WO_T_L, NTOK, D, D, F.G, (int)blockIdx.x);
            EpiResid<true> E{(const void*)WSP(bf16, WS_XBF), WSP(bf16, WS_ZF)}; pg8::gemm_phase<EpiResid<true>, DenseSched, true>(F.lds + RING_OFF, F.wave, D, S, E);
            }
            SEAM(pb + P_WO);
        }
        if (IN(pb + P_ROUTE)) {
            { PH_BEGIN;
            route_phase(F, WSP(bf16, WS_ZF), ka->in[12] + (size_t)l * D, ka->in[13] + (size_t)l * D, WSP(bf16, WS_RW + l * RW_L), ka->in[15] + (size_t)l * NE, WSP(bf16, WS_X1F), WSP(bf16, WS_X1BF),
                        WSP(unsigned, WS_CTL) + CW_CNT + l * 64, WSP(int, WS_LIST), WSP(int, WS_TOKSLOT), WSP(float, WS_TOKW));
            }
            SEAM(pb + P_ROUTE);
        }
        if (IN(pb + P_GU)) {
            { PH_BEGIN;
            moe_plan(F, WSP(unsigned, WS_CTL) + CW_CNT + l * 64);
            MoeSched<true> S; S.init(F, ws + WS_X1BF, ws + WS_WGU, WSP(int, WS_LIST)); EpiSwiGLU E{WSP(bf16, WS_R2)};
            pg8::gemm_phase<EpiSwiGLU, MoeSched<true>, true>(F.lds + RING_OFF, F.wave, D, S, E);
            }
            SEAM(pb + P_GU);
        }
        if (IN(pb + P_DOWN)) {
            { PH_BEGIN;
            if (kargs()->ph_lo > pb + P_GU) moe_plan(F, WSP(unsigned, WS_CTL) + CW_CNT + l * 64);
            MoeSched<false> S; S.init(F, ws + WS_R2, ws + WS_WDN, nullptr); EpiY8 E{WSP(unsigned char, WS_R1), WSP(bf16, WS_R1 + R1_YS)};
            pg8::gemm_phase<EpiY8, MoeSched<false>, true>(F.lds + RING_OFF, F.wave, EH, S, E);
            }
            SEAM(pb + P_DOWN);
        }
        if (IN(pb + P_COMB)) {
            { PH_BEGIN;
            if (kargs()->ph_lo > pb + P_GU) moe_plan(F, WSP(unsigned, WS_CTL) + CW_CNT + l * 64);
            combine_phase(F, WSP(bf16, WS_X1BF), WSP(unsigned char, WS_R1), WSP(bf16, WS_R1 + R1_YS), WSP(int, WS_TOKSLOT), WSP(float, WS_TOKW), ka->in[22] + (size_t)l * D, ka->in[23] + (size_t)l * D, ka->out, WSP(bf16, WS_XBF), l == 1);
            }
            SEAM(pb + P_COMB);
        }
    }
#undef IN
#undef SEAM
}
static void launch_mk(Args a, int lo, int hi, int grid, hipStream_t stream) {
    a.ph_lo = lo; a.ph_hi = hi;
    hipLaunchKernelGGL(mk_fwd, dim3(grid), dim3(NWAVES * 64), LDS_BYTES, stream, a);
}
extern "C" void kernel_launch(void* const* d_in, const int* in_sizes, int n_in, void* d_out, int out_size, void* d_ws, size_t ws_size, hipStream_t stream) {
    static int grid = 0;
    if (grid == 0) {
        if (n_in != 24 || out_size != NTOK * D || ws_size < WS_END) { fprintf(stderr, "kernel_launch: unexpected sizes n_in %d out %d ws %zu\n", n_in, out_size, ws_size); grid = -1; return; }
        int dev = 0, cus = 0;
        if (hipGetDevice(&dev) != hipSuccess || hipDeviceGetAttribute(&cus, hipDeviceAttributeMultiprocessorCount, dev) != hipSuccess) { grid = -1; return; }
        if (hipFuncSetAttribute((const void*)mk_fwd, hipFuncAttributeMaxDynamicSharedMemorySize, LDS_BYTES) != hipSuccess) { fprintf(stderr, "kernel_launch: hipFuncSetAttribute failed\n"); grid = -1; return; }
        int per_cu = 0; (void)hipOccupancyMaxActiveBlocksPerMultiprocessor(&per_cu, (const void*)mk_fwd, NWAVES * 64, LDS_BYTES); (void)hipGetLastError();
        if (per_cu < 1) fprintf(stderr, "kernel_launch: occupancy query says %d\n", per_cu);
        grid = cus;
    }
    if (grid < 0) return;
    const float* x = (const float*)d_in[0];
    const float* conv_w = (const float*)d_in[3]; const float* lbl = (const float*)d_in[5];
    const float* hg_g = (const float*)d_in[6];
    const float* ln1_g = (const float*)d_in[12]; const float* ln1_b = (const float*)d_in[13]; const float* router_w = (const float*)d_in[14];
    const float* router_b = (const float*)d_in[15]; const float* exp_wg = (const float*)d_in[16]; const float* exp_wu = (const float*)d_in[17];
    const float* exp_wd = (const float*)d_in[18]; const float* sh_wg = (const float*)d_in[19]; const float* sh_wu = (const float*)d_in[20];
    const float* sh_wd = (const float*)d_in[21]; const float* ln2_g = (const float*)d_in[22]; const float* ln2_b = (const float*)d_in[23];
    unsigned char* ws = (unsigned char*)d_ws; float* out = (float*)d_out;
    unsigned* ctl = (unsigned*)(ws + WS_CTL);
    bf16* KV = (bf16*)(ws + WS_KV); bf16* XBF = (bf16*)(ws + WS_XBF); float* X1F = (float*)(ws + WS_X1F);
    bf16* X1BF = (bf16*)(ws + WS_X1BF); float* ZF = (float*)(ws + WS_ZF);
    bf16* YA = (bf16*)(ws + WS_YA); bf16* YB = (bf16*)(ws + WS_YB); bf16* YX = (bf16*)(ws + WS_YX);
    bf16* H = (bf16*)(ws + WS_R2); float* OH = (float*)(ws + WS_R2); bf16* PROJ = (bf16*)(ws + WS_R1); bf16* Y = (bf16*)(ws + WS_R1);
    int* LIST = (int*)(ws + WS_LIST); int* TOKSLOT = (int*)(ws + WS_TOKSLOT); float* TOKW = (float*)(ws + WS_TOKW);
    Args a{};
    for (int i = 0; i < 24; ++i) a.in[i] = (const float*)d_in[i];
    a.out = out; a.ws = ws;

    (void)hipMemsetAsync(ws + WS_CTL, 0, (size_t)(CW_BAR + XCD_BAR_WORDS) * 4, stream);
    a.mask = 7;
    launch_mk(a, 0, N_PHASES, grid, stream);
}
```
